# Optimizing an MI355X kernel written in HIP

```python
import math
import jax, jax.numpy as jnp
from jax import lax
import numpy as np

D_MODEL = 4096
BATCH = 2
SEQ = 8192
DEPTH = 1
DEC_BATCH = 8
DEC_SEQ = 16
PAST_LEN = 2048

CHUNK = 64
MIX_W = D_MODEL
DN_HEADS = 16
DN_DK = 128
DN_DV = 128
DN_QK_W = DN_HEADS * DN_DK
DN_V_W = DN_HEADS * DN_DV
DN_QKV_W = 2 * DN_QK_W + DN_V_W
CONV_W = 4
RW_HEAD = 64
RW_W = MIX_W - DN_V_W
RW_HEADS = RW_W // RW_HEAD
RW_LORA_W = 96
RW_LORA_A = 96
RW_LORA_G = 256
RW_SHIFT_W = 3 * RW_W + RW_LORA_W + RW_LORA_A + RW_LORA_G
IN_W = DN_QKV_W + DN_V_W + 2 * DN_HEADS + RW_SHIFT_W
D_FF = -(-8 * D_MODEL // (3 * 256)) * 256
NORM_EPS = 1e-6
RW_GN_EPS = 64e-5

kernel_name = 'hymba_gdn_rwkv7_streaming_step'


def rms_norm(x, w, eps=NORM_EPS):
    x32 = x.astype(jnp.float32)
    y = x32 * lax.rsqrt(jnp.mean(x32 * x32, axis=-1, keepdims=True) + eps)
    return (y * w.astype(jnp.float32)).astype(x.dtype)


def l2_normalize(x, eps=1e-6):
    x32 = x.astype(jnp.float32)
    return x32 * lax.rsqrt(jnp.sum(x32 * x32, axis=-1, keepdims=True) + eps)


def causal_conv(u, buf, w):
    t = u.shape[1]
    xp = jnp.concatenate([buf.astype(u.dtype), u], axis=1)
    out = xp[:, 0:t] * w[0]
    for j in range(1, CONV_W):
        out = out + xp[:, j:j + t] * w[j]
    return out, xp[:, t:]


def token_shift(u, buf, mu):
    t = u.shape[1]
    prev = jnp.concatenate([buf.astype(u.dtype), u], axis=1)[:, :t]
    return u + mu * (prev - u), u[:, t - 1:]


def gated_delta_rule(q, k, v, g, beta, s0):
    b, t, h, _ = q.shape
    dv = v.shape[-1]
    n = -(-t // CHUNK)
    pad = n * CHUNK - t

    def blocks(a):
        a = jnp.pad(a, [(0, 0), (0, pad)] + [(0, 0)] * (a.ndim - 2))
        a = a.reshape((b, n, CHUNK) + a.shape[2:])
        return jnp.moveaxis(jnp.moveaxis(a, 3, 2), 1, 0)

    q, k, v, g, beta = blocks(q), blocks(k), blocks(v), blocks(g), blocks(beta)
    gc = jnp.cumsum(g, axis=-1)
    idx = jnp.arange(CHUNK)
    causal = idx[:, None] >= idx[None, :]
    strict = idx[:, None] > idx[None, :]
    decay = jnp.exp(jnp.where(causal, gc[..., :, None] - gc[..., None, :], -jnp.inf))
    kb = k * beta[..., None]
    lower = jnp.where(strict, jnp.einsum('nbhik,nbhjk->nbhij', kb, k) * decay, 0.0)
    eye = jnp.eye(CHUNK, dtype=q.dtype)
    rhs = jnp.concatenate([v * beta[..., None], kb * jnp.exp(gc)[..., None]], axis=-1)
    sol = lax.linalg.triangular_solve(eye + lower, rhs, left_side=True, lower=True, unit_diagonal=True)
    u, wk = sol[..., :dv], sol[..., dv:]
    qk = jnp.einsum('nbhik,nbhjk->nbhij', q, k) * decay
    q_dec = q * jnp.exp(gc)[..., None]
    k_dec = k * jnp.exp(gc[..., -1:] - gc)[..., None]
    g_last = jnp.exp(gc[..., -1])

    def step(S, inp):
        u_c, w_c, qd_c, qk_c, kd_c, gl_c = inp
        v_new = u_c - jnp.einsum('bhck,bhkv->bhcv', w_c, S)
        o = jnp.einsum('bhck,bhkv->bhcv', qd_c, S) + jnp.einsum('bhij,bhjv->bhiv', qk_c, v_new)
        S = S * gl_c[..., None, None] + jnp.einsum('bhck,bhcv->bhkv', kd_c, v_new)
        return S, o

    S, o = lax.scan(step, s0, (u, wk, q_dec, qk, k_dec, g_last))
    o = jnp.moveaxis(jnp.moveaxis(o, 0, 1), 2, 3).reshape(b, n * CHUNK, h, dv)[:, :t]
    return o, S


def rwkv7_recurrence(r, w, k, v, a_vec, b_vec, s0):
    def step(S, inp):
        r_t, w_t, k_t, v_t, a_t, b_t = inp
        sa = jnp.einsum('bhvk,bhk->bhv', S, a_t)
        S = S * w_t[:, :, None, :] + sa[..., None] * b_t[:, :, None, :] + v_t[..., None] * k_t[:, :, None, :]
        return S, jnp.einsum('bhvk,bhk->bhv', S, r_t)

    xs = (jnp.moveaxis(r, 1, 0), jnp.moveaxis(w, 1, 0), jnp.moveaxis(k, 1, 0),
          jnp.moveaxis(v, 1, 0), jnp.moveaxis(a_vec, 1, 0), jnp.moveaxis(b_vec, 1, 0))
    S, ys = lax.scan(step, s0, xs)
    return jnp.moveaxis(ys, 0, 1), S


def layer(x, dn_state, dn_conv, rw_state, rw_shift, params):
    (g_mix_pre, g_mix_post, w_in, dn_conv_w, dn_a_log, dn_dt_bias, dn_norm_w,
     rw_mu, rw_w0, rw_w2, rw_a0, rw_a2, rw_g2, rw_k_k, rw_k_a, rw_r_k, rw_ln_w, rw_ln_b,
     w_out, g_ffn_pre, g_ffn_post, w_gate, w_up, w_down) = params
    f32 = jnp.float32
    b, t, _ = x.shape
    h = rms_norm(x, g_mix_pre)
    proj = h @ w_in
    o1 = DN_QKV_W
    o2 = o1 + DN_V_W
    o3 = o2 + DN_HEADS
    o4 = o3 + DN_HEADS
    dn_qkv, dn_z, dn_b, dn_a, rw_in = proj[..., :o1], proj[..., o1:o2], proj[..., o2:o3], proj[..., o3:o4], proj[..., o4:]

    qkv, new_dn_conv = causal_conv(dn_qkv, dn_conv, dn_conv_w)
    qkv = jax.nn.silu(qkv)
    q = l2_normalize(qkv[..., :DN_QK_W].reshape(b, t, DN_HEADS, DN_DK)) * (DN_DK ** -0.5)
    k = l2_normalize(qkv[..., DN_QK_W:2 * DN_QK_W].reshape(b, t, DN_HEADS, DN_DK))
    v = qkv[..., 2 * DN_QK_W:].reshape(b, t, DN_HEADS, DN_DV).astype(f32)
    beta = jax.nn.sigmoid(dn_b.astype(f32))
    g = -jnp.exp(dn_a_log.astype(f32)) * jax.nn.softplus(dn_a.astype(f32) + dn_dt_bias.astype(f32))
    o, new_dn_state = gated_delta_rule(q, k, v, g, beta, dn_state.astype(f32))
    o = rms_norm(o, dn_norm_w) * jax.nn.silu(dn_z.reshape(b, t, DN_HEADS, DN_DV).astype(f32))
    y_a = o.reshape(b, t, DN_V_W)

    rw, new_rw_shift = token_shift(rw_in, rw_shift, rw_mu)
    rw = rw.astype(f32)
    s1, s2, s3 = RW_W, 2 * RW_W, 3 * RW_W
    s4, s5 = s3 + RW_LORA_W, s3 + RW_LORA_W + RW_LORA_A
    r, kr, vr = rw[..., :s1], rw[..., s1:s2], rw[..., s2:s3]
    xw, xa, xg = rw[..., s3:s4], rw[..., s4:s5], rw[..., s5:]
    w_log = -jax.nn.softplus(-(rw_w0 + jnp.tanh(xw) @ rw_w2)) - 0.5
    w_dec = jnp.exp(-jnp.exp(w_log))
    a = jax.nn.sigmoid(rw_a0 + xa @ rw_a2)
    gate = jax.nn.sigmoid(xg) @ rw_g2
    heads = lambda z: z.reshape(b, t, RW_HEADS, RW_HEAD)
    kk = l2_normalize(heads(kr * rw_k_k))
    kr = kr * (1.0 + (a - 1.0) * rw_k_a)
    r_h, k_h, v_h, a_h = heads(r), heads(kr), heads(vr), heads(a)
    y, new_rw_state = rwkv7_recurrence(r_h, heads(w_dec), k_h, v_h, -kk, kk * a_h, rw_state.astype(f32))
    mean = jnp.mean(y, axis=-1, keepdims=True)
    var = jnp.mean(jnp.square(y - mean), axis=-1, keepdims=True)
    y = ((y - mean) * lax.rsqrt(var + RW_GN_EPS)).reshape(b, t, RW_W) * rw_ln_w + rw_ln_b
    bonus = jnp.sum(r_h * k_h * rw_r_k, axis=-1, keepdims=True) * v_h
    y_b = (y + bonus.reshape(b, t, RW_W)) * gate

    mix = jnp.concatenate([y_a, y_b], axis=-1).astype(x.dtype)
    x = x + rms_norm(mix @ w_out, g_mix_post)

    h2 = rms_norm(x, g_ffn_pre)
    f = (jax.nn.silu(h2 @ w_gate) * (h2 @ w_up)) @ w_down
    x = x + rms_norm(f, g_ffn_post)
    return x, (new_dn_state.astype(dn_state.dtype), new_dn_conv.astype(dn_conv.dtype),
               new_rw_state.astype(rw_state.dtype), new_rw_shift.astype(rw_shift.dtype))


def setup_inputs(seed: int = 0) -> dict:
    key = jax.random.key(seed)
    ks = jax.random.split(key, 32)
    f32 = jnp.float32
    L = DEPTH

    def nrm(k, shape, scale):
        return jax.random.normal(k, shape, f32) * scale

    dt = jnp.exp(jax.random.uniform(ks[11], (L, DN_HEADS), f32, math.log(1e-3), math.log(1e-1)))
    return {
        'x_prompt': nrm(ks[0], (BATCH, SEQ, D_MODEL), 1.0),
        'x_sample': nrm(ks[1], (DEC_BATCH, DEC_SEQ, D_MODEL), 1.0),
        'state_dn': nrm(ks[2], (L, DEC_BATCH, DN_HEADS, DN_DK, DN_DV), 0.1),
        'cache_dn_conv': nrm(ks[3], (L, DEC_BATCH, CONV_W - 1, DN_QKV_W), 1.0),
        'state_rwkv': nrm(ks[4], (L, DEC_BATCH, RW_HEADS, RW_HEAD, RW_HEAD), 0.1),
        'cache_rwkv_shift': nrm(ks[5], (L, DEC_BATCH, 1, RW_SHIFT_W), 1.0),
        'g_mix_pre': 1.0 + nrm(ks[6], (L, D_MODEL), 0.05),
        'g_mix_post': 1.0 + nrm(ks[7], (L, D_MODEL), 0.05),
        'w_in': nrm(ks[8], (L, D_MODEL, IN_W), D_MODEL ** -0.5),
        'dn_conv_w': nrm(ks[9], (L, CONV_W, DN_QKV_W), CONV_W ** -0.5),
        'dn_a_log': jnp.log(jax.random.uniform(ks[10], (L, DN_HEADS), f32, 1.0, 16.0)),
        'dn_dt_bias': dt + jnp.log(-jnp.expm1(-dt)),
        'dn_norm_w': 1.0 + nrm(ks[12], (L, DN_DV), 0.05),
        'rw_mu': jax.random.uniform(ks[13], (L, RW_SHIFT_W), f32, 0.0, 1.0),
        'rw_w0': jax.random.uniform(ks[14], (L, RW_W), f32, -6.0, 1.0),
        'rw_w2': nrm(ks[15], (L, RW_LORA_W, RW_W), 0.5 * RW_LORA_W ** -0.5),
        'rw_a0': nrm(ks[16], (L, RW_W), 0.5),
        'rw_a2': nrm(ks[17], (L, RW_LORA_A, RW_W), RW_LORA_A ** -0.5),
        'rw_g2': nrm(ks[18], (L, RW_LORA_G, RW_W), RW_LORA_G ** -0.5),
        'rw_k_k': 0.85 + nrm(ks[19], (L, RW_W), 0.05),
        'rw_k_a': 1.0 + nrm(ks[20], (L, RW_W), 0.05),
        'rw_r_k': nrm(ks[21], (L, RW_HEADS, RW_HEAD), 0.1),
        'rw_ln_w': 1.0 + nrm(ks[22], (L, RW_W), 0.05),
        'rw_ln_b': nrm(ks[23], (L, RW_W), 0.02),
        'w_out': nrm(ks[24], (L, MIX_W, D_MODEL), MIX_W ** -0.5),
        'g_ffn_pre': 1.0 + nrm(ks[25], (L, D_MODEL), 0.05),
        'g_ffn_post': 1.0 + nrm(ks[26], (L, D_MODEL), 0.05),
        'w_gate': nrm(ks[27], (L, D_MODEL, D_FF), D_MODEL ** -0.5),
        'w_up': nrm(ks[28], (L, D_MODEL, D_FF), D_MODEL ** -0.5),
        'w_down': nrm(ks[29], (L, D_FF, D_MODEL), D_FF ** -0.5),
    }


def reference(x_prompt, x_sample, state_dn, cache_dn_conv, state_rwkv, cache_rwkv_shift,
              g_mix_pre, g_mix_post, w_in, dn_conv_w, dn_a_log, dn_dt_bias, dn_norm_w,
              rw_mu, rw_w0, rw_w2, rw_a0, rw_a2, rw_g2, rw_k_k, rw_k_a, rw_r_k, rw_ln_w, rw_ln_b,
              w_out, g_ffn_pre, g_ffn_post, w_gate, w_up, w_down):
    bp = x_prompt.shape[0]
    dt = x_prompt.dtype
    yp, ys = x_prompt, x_sample
    p_dn, p_conv, p_rw, p_shift = [], [], [], []
    s_dn, s_conv, s_rw, s_shift = [], [], [], []
    for l in range(DEPTH):
        params = (g_mix_pre[l], g_mix_post[l], w_in[l], dn_conv_w[l], dn_a_log[l], dn_dt_bias[l], dn_norm_w[l],
                  rw_mu[l], rw_w0[l], rw_w2[l], rw_a0[l], rw_a2[l], rw_g2[l], rw_k_k[l], rw_k_a[l], rw_r_k[l],
                  rw_ln_w[l], rw_ln_b[l], w_out[l], g_ffn_pre[l], g_ffn_post[l], w_gate[l], w_up[l], w_down[l])
        yp, (a0, a1, a2, a3) = layer(
            yp,
            jnp.zeros((bp, DN_HEADS, DN_DK, DN_DV), dt),
            jnp.zeros((bp, CONV_W - 1, DN_QKV_W), dt),
            jnp.zeros((bp, RW_HEADS, RW_HEAD, RW_HEAD), dt),
            jnp.zeros((bp, 1, RW_SHIFT_W), dt),
            params)
        p_dn.append(a0); p_conv.append(a1); p_rw.append(a2); p_shift.append(a3)
        ys, (c0, c1, c2, c3) = layer(ys, state_dn[l], cache_dn_conv[l], state_rwkv[l], cache_rwkv_shift[l], params)
        s_dn.append(c0); s_conv.append(c1); s_rw.append(c2); s_shift.append(c3)
    return (yp, ys,
            jnp.stack(p_dn), jnp.stack(p_conv), jnp.stack(p_rw), jnp.stack(p_shift),
            jnp.stack(s_dn), jnp.stack(s_conv), jnp.stack(s_rw), jnp.stack(s_shift))
```

```cpp
#include <hip/hip_runtime.h>
#include <cstdio>
#include <cstdint>

namespace pg8 {
#define PG8_LAS __attribute__((address_space(3)))
typedef unsigned short bf16_t;
typedef short bf16x8 __attribute__((ext_vector_type(8)));
typedef float f32x4 __attribute__((ext_vector_type(4)));
typedef unsigned u32x4 __attribute__((ext_vector_type(4)));
constexpr int BM = 256, BK = 64, HALF = 128, HTB = HALF * BK * 2  , STAGE_BYTES = 8 * HTB, NXCD = 8, WGM = 8;

__host__ __device__ __forceinline__ int lds_byte(int r, int c) { const int st = (r >> 4) * 2 + (c >> 5), rr = r & 15, cc = c & 31, ob = rr * 64 + cc * 2; return st * 1024 + (ob ^ (((ob >> 9) & 1) << 5)); }
__host__ __device__ __forceinline__ void stage_rc(int b, int& R, int& C) { const int st = b / 1024, sb = b % 1024, swz = sb ^ (((sb >> 9) & 1) << 5); R = (st >> 1) * 16 + swz / 64; C = (st & 1) * 32 + (swz % 64) / 2; }
__host__ __device__ __forceinline__ int perm32(int rho) { const int n = rho >> 4, i = rho & 15; return 8 * (i >> 2) + 4 * n + (i & 3); }

struct Unit { int pm, pn; };
struct Gemm { const bf16_t* A; const bf16_t* Bt; int M, N, K; };

struct StaticOrder {
    int nM, nN, nwg, G, c;
    __host__ __device__ void init(int M, int N, int G_, int c_) { nM = M / BM; nN = N / BM; nwg = nM * nN; G = G_; c = c_; }
    __host__ __device__ bool next(int i, Unit& u) const {
        const long L = (long)i * G + c; if (L >= nwg) return false;
        int wgid = (int)L; { const int q = nwg / NXCD, r = nwg % NXCD, xcd = wgid % NXCD, off = wgid / NXCD; wgid = (xcd < r ? xcd * (q + 1) : r * (q + 1) + (xcd - r) * q) + off; }
        const int nig = WGM * nN, gid = wgid / nig, fm = gid * WGM, gsz = (nM - fm) < WGM ? (nM - fm) : WGM;
        u.pm = fm + ((wgid % nig) % gsz); u.pn = (wgid % nig) / gsz; return true;
    }
    __device__ __forceinline__ void a_ready(const Unit&) const {}
    __device__ __forceinline__ void done(const Unit&) const {}
};
__device__ __forceinline__ unsigned cvt_pk_bf16(float lo, float hi) { unsigned r; asm volatile("v_cvt_pk_bf16_f32 %0, %1, %2" : "=v"(r) : "v"(lo), "v"(hi)); return r; }

struct EpiBf16Plain {
    static constexpr bool PERM = true, AFTER_DRAIN = false;
    bf16_t* O; int ldc;
    __device__ __forceinline__ void operator()(const f32x4 (&acc)[2][2][4][2], const Unit& u, int wr, int wc, int fr, int fq) const {
        const int row0 = u.pm * BM + wr * 64 + fr, col0 = u.pn * BM + wc * 32 + 8 * fq;
#pragma unroll
        for (int ai = 0; ai < 2; ++ai)
#pragma unroll
            for (int m = 0; m < 4; ++m) { bf16_t* rowp = O + (size_t)(row0 + ai * HALF + m * 16) * ldc + col0;
#pragma unroll
                for (int bj = 0; bj < 2; ++bj) { const f32x4 v0 = acc[ai][bj][m][0], v1 = acc[ai][bj][m][1];
                    u32x4 w; w.x = cvt_pk_bf16(v0[0], v0[1]); w.y = cvt_pk_bf16(v0[2], v0[3]); w.z = cvt_pk_bf16(v1[0], v1[1]); w.w = cvt_pk_bf16(v1[2], v1[3]);
                    *(u32x4*)(rowp + bj * HALF) = w; } }
    }
};
__device__ __forceinline__ float silu_f(float x) { return x * __builtin_amdgcn_rcpf(1.0f + __expf(-x)); }
struct EpiSwiGLU {
    static constexpr bool PERM = true, AFTER_DRAIN = false;
    bf16_t* O; int ldc;
    __device__ __forceinline__ void operator()(const f32x4 (&acc)[2][2][4][2], const Unit& u, int wr, int wc, int fr, int fq) const {
        const int row0 = u.pm * BM + wr * 64 + fr, col0 = u.pn * HALF + wc * 32 + 8 * fq;
#pragma unroll
        for (int ai = 0; ai < 2; ++ai)
#pragma unroll
            for (int m = 0; m < 4; ++m) { bf16_t* rowp = O + (size_t)(row0 + ai * HALF + m * 16) * ldc + col0;
                const f32x4 g0 = acc[ai][0][m][0], g1 = acc[ai][0][m][1], u0 = acc[ai][1][m][0], u1 = acc[ai][1][m][1];
                u32x4 w; w.x = cvt_pk_bf16(silu_f(g0[0]) * u0[0], silu_f(g0[1]) * u0[1]); w.y = cvt_pk_bf16(silu_f(g0[2]) * u0[2], silu_f(g0[3]) * u0[3]);
                w.z = cvt_pk_bf16(silu_f(g1[0]) * u1[0], silu_f(g1[1]) * u1[1]); w.w = cvt_pk_bf16(silu_f(g1[2]) * u1[2], silu_f(g1[3]) * u1[3]);
                *(u32x4*)rowp = w; }
    }
};
struct EpiF32Ssq {
    static constexpr bool PERM = false, AFTER_DRAIN = false;
    float* C; int ldc; float* ssq; int mreal;
    __device__ __forceinline__ void operator()(const f32x4 (&acc)[2][2][4][2], const Unit& u, int wr, int wc, int fr, int fq) const {
        const int row0 = u.pm * BM + wr * 64 + fr, col0 = u.pn * BM + wc * 32 + 4 * fq;
#pragma unroll
        for (int ai = 0; ai < 2; ++ai)
#pragma unroll
            for (int m = 0; m < 4; ++m) { const int row = row0 + ai * HALF + m * 16; float s = 0.f;
#pragma unroll
                for (int bj = 0; bj < 2; ++bj)
#pragma unroll
                    for (int n = 0; n < 2; ++n) { const f32x4 v = acc[ai][bj][m][n]; s += (v[0] * v[0] + v[1] * v[1]) + (v[2] * v[2] + v[3] * v[3]);
                        if (row < mreal) *(f32x4*)(C + (size_t)row * ldc + col0 + bj * HALF + n * 16) = v; }
                s += __shfl_xor(s, 16); s += __shfl_xor(s, 32);
                if (fq == 0) ssq[(size_t)row * 64 + u.pn * 4 + wc] = s; }
    }
};
struct EpiBf16Ssq {
    static constexpr bool PERM = true, AFTER_DRAIN = false;
    bf16_t* O; int ldc; float* ssq;
    __device__ __forceinline__ void operator()(const f32x4 (&acc)[2][2][4][2], const Unit& u, int wr, int wc, int fr, int fq) const {
        const int row0 = u.pm * BM + wr * 64 + fr, col0 = u.pn * BM + wc * 32 + 8 * fq;
#pragma unroll
        for (int ai = 0; ai < 2; ++ai)
#pragma unroll
            for (int m = 0; m < 4; ++m) { const int row = row0 + ai * HALF + m * 16; bf16_t* rowp = O + (size_t)row * ldc + col0; float s = 0.f;
#pragma unroll
                for (int bj = 0; bj < 2; ++bj) { const f32x4 v0 = acc[ai][bj][m][0], v1 = acc[ai][bj][m][1];
                    s += (v0[0] * v0[0] + v0[1] * v0[1]) + (v0[2] * v0[2] + v0[3] * v0[3]) + (v1[0] * v1[0] + v1[1] * v1[1]) + (v1[2] * v1[2] + v1[3] * v1[3]);
                    u32x4 w; w.x = cvt_pk_bf16(v0[0], v0[1]); w.y = cvt_pk_bf16(v0[2], v0[3]); w.z = cvt_pk_bf16(v1[0], v1[1]); w.w = cvt_pk_bf16(v1[2], v1[3]);
                    *(u32x4*)(rowp + bj * HALF) = w; }
                s += __shfl_xor(s, 16); s += __shfl_xor(s, 32);
                if (fq == 0) ssq[(size_t)row * 64 + u.pn * 4 + wc] = s; }
    }
};
template <class Epi, class Sched, bool ALIGN_EPI = false, bool SP2 = false>
__device__ __forceinline__ void gemm_phase(PG8_LAS unsigned char* lds, const Gemm g, const Sched& S, const Epi& E) {
    const int tid = threadIdx.x, wid = __builtin_amdgcn_readfirstlane(tid >> 6), lane = tid & 63, wr = wid >> 2, wc = wid & 3, fr = lane & 15, fq = lane >> 4;
    const int K = g.K, nt = K / BK;
    unsigned voffA[2], voffB[2];
#pragma unroll
    for (int i = 0; i < 2; ++i) { int R, C; stage_rc(tid * 16 + i * 8192, R, C); const int Rb = Epi::PERM ? ((R & ~31) + perm32(R & 31)) : R;
        voffA[i] = (unsigned)(R * K + C) * 2u; voffB[i] = (unsigned)(Rb * K + C) * 2u; }
    const size_t kstep = (size_t)(BK * 2);
    const size_t hstep = (size_t)HALF * K * 2;
    const size_t tstep = 2 * hstep;
    const unsigned ldsw = (unsigned)wid * 1024u;
    const int aoff = lds_byte(wr * 64 + fr, fq * 8), boff = lds_byte(wc * 32 + fr, fq * 8);
#define PG8_SA(b, h) (((b) * 2 + (h)) * HTB)
#define PG8_SB(b, h) ((4 + (b) * 2 + (h)) * HTB)
#define PG8_STAGE(bufoff, gbase, voff) do { _Pragma("unroll") for (int _i = 0; _i < 2; ++_i) \
        __builtin_amdgcn_global_load_lds((const unsigned*)((const char*)(gbase) + (voff)[_i]), (PG8_LAS unsigned*)(lds + (bufoff) + ldsw + _i * 8192), 16, 0, 0); } while (0)
#define PG8_LDA(dst, b, h) do { _Pragma("unroll") for (int m = 0; m < 4; ++m) _Pragma("unroll") for (int k = 0; k < 2; ++k) dst[m][k] = *(const PG8_LAS bf16x8*)(lds + PG8_SA(b, h) + aoff + m * 2048 + k * 1024); } while (0)
#define PG8_LDB(dst, b, h) do { _Pragma("unroll") for (int n = 0; n < 2; ++n) _Pragma("unroll") for (int k = 0; k < 2; ++k) dst[n][k] = *(const PG8_LAS bf16x8*)(lds + PG8_SB(b, h) + boff + n * 2048 + k * 1024); } while (0)
#define PG8_MMA(ai, bj, At, Bt) do { __builtin_amdgcn_s_setprio(1); _Pragma("unroll") for (int m = 0; m < 4; ++m) _Pragma("unroll") for (int n = 0; n < 2; ++n) _Pragma("unroll") for (int k = 0; k < 2; ++k) \
        acc[ai][bj][m][n] = __builtin_amdgcn_mfma_f32_16x16x32_bf16(Bt[n][k], At[m][k], acc[ai][bj][m][n], 0, 0, 0); __builtin_amdgcn_s_setprio(0); } while (0)
#define PG8_WAIT_V(n) asm volatile("s_waitcnt vmcnt(" #n ")" ::: "memory")
#define PG8_WAIT_L(n) asm volatile("s_waitcnt lgkmcnt(" #n ")" ::: "memory")
#define PG8_BAR __builtin_amdgcn_s_barrier()
#define PG8_SCHED __builtin_amdgcn_sched_barrier(0)
    Unit cur, nxt; int ui = 0;
    if (!S.next(0, cur)) return;
    f32x4 acc[2][2][4][2];
#pragma unroll
    for (int a = 0; a < 2; ++a)
#pragma unroll
        for (int b = 0; b < 2; ++b)
#pragma unroll
            for (int m = 0; m < 4; ++m)
#pragma unroll
                for (int n = 0; n < 2; ++n) acc[a][b][m][n] = (f32x4){0.f, 0.f, 0.f, 0.f};
    bf16x8 At[4][2], B0[2][2], B1[2][2];
    const char* cA = (const char*)g.A + (size_t)cur.pm * tstep; const char* cB = (const char*)g.Bt + (size_t)cur.pn * tstep;
    S.a_ready(cur);
    if constexpr (SP2) {
        PG8_STAGE(PG8_SB(0, 0), cB, voffB); PG8_STAGE(PG8_SB(0, 1), cB + hstep, voffB); PG8_STAGE(PG8_SA(0, 0), cA, voffA); PG8_STAGE(PG8_SA(0, 1), cA + hstep, voffA);
        if (wr == 1) PG8_BAR;
        PG8_WAIT_V(2); PG8_BAR;
        PG8_STAGE(PG8_SB(1, 0), cB + kstep, voffB); PG8_STAGE(PG8_SA(1, 0), cA + kstep, voffA); PG8_STAGE(PG8_SB(1, 1), cB + hstep + kstep, voffB);
        PG8_WAIT_V(6); PG8_BAR;
    } else {
        PG8_STAGE(PG8_SB(0, 0), cB, voffB); PG8_STAGE(PG8_SA(0, 0), cA, voffA); PG8_STAGE(PG8_SB(0, 1), cB + hstep, voffB); PG8_STAGE(PG8_SA(0, 1), cA + hstep, voffA);
        if (wr == 1) PG8_BAR;
        PG8_WAIT_V(4); PG8_BAR;
        PG8_STAGE(PG8_SB(1, 0), cB + kstep, voffB); PG8_STAGE(PG8_SA(1, 0), cA + kstep, voffA); PG8_STAGE(PG8_SB(1, 1), cB + hstep + kstep, voffB);
        PG8_WAIT_V(6); PG8_BAR;
    }
    for (;;) {
        const bool has_next = S.next(ui + 1, nxt);
        const char* nA = has_next ? (const char*)g.A + (size_t)nxt.pm * tstep : cA; const char* nB = has_next ? (const char*)g.Bt + (size_t)nxt.pn * tstep : cB;
        for (int t = 0; t < nt; t += 2) {
            const bool last = (t == nt - 2);
            const char* a1 = cA + (size_t)(t + 1) * kstep;
            const char* a2 = last ? nA : cA + (size_t)(t + 2) * kstep; const char* b2 = last ? nB : cB + (size_t)(t + 2) * kstep;
            const char* a3 = a2 + kstep; const char* b3 = b2 + kstep;
            if (last && has_next) S.a_ready(nxt);
            if constexpr (SP2) {
            PG8_LDB(B0, 0, 0); PG8_LDB(B1, 0, 1); PG8_SCHED; PG8_LDA(At, 0, 0); PG8_STAGE(PG8_SA(1, 1), a1 + hstep, voffA);
            PG8_WAIT_V(8); PG8_WAIT_L(0); PG8_BAR; PG8_MMA(0, 0, At, B0); PG8_MMA(0, 1, At, B1); PG8_BAR; PG8_SCHED;
            PG8_LDA(At, 0, 1); PG8_STAGE(PG8_SB(0, 0), b2, voffB); PG8_STAGE(PG8_SB(0, 1), b2 + hstep, voffB); PG8_STAGE(PG8_SA(0, 0), a2, voffA);
            PG8_WAIT_V(8); PG8_WAIT_L(0); PG8_BAR; PG8_MMA(1, 0, At, B0); PG8_MMA(1, 1, At, B1); PG8_BAR; PG8_SCHED;
            PG8_LDB(B0, 1, 0); PG8_LDB(B1, 1, 1); PG8_SCHED; PG8_LDA(At, 1, 0); PG8_STAGE(PG8_SA(0, 1), a2 + hstep, voffA);
            PG8_WAIT_V(8); PG8_WAIT_L(0); PG8_BAR; PG8_MMA(0, 0, At, B0); PG8_MMA(0, 1, At, B1); PG8_BAR; PG8_SCHED;
            PG8_LDA(At, 1, 1); PG8_STAGE(PG8_SB(1, 0), b3, voffB); PG8_STAGE(PG8_SB(1, 1), b3 + hstep, voffB); PG8_STAGE(PG8_SA(1, 0), a3, voffA);
            PG8_WAIT_V(8); PG8_WAIT_L(0); PG8_BAR; PG8_MMA(1, 0, At, B0); PG8_MMA(1, 1, At, B1); PG8_BAR; PG8_SCHED;
            } else {
            PG8_LDB(B0, 0, 0); PG8_SCHED; PG8_LDA(At, 0, 0); PG8_STAGE(PG8_SA(1, 1), a1 + hstep, voffA);
            PG8_WAIT_L(8); PG8_BAR; PG8_WAIT_L(0); PG8_MMA(0, 0, At, B0); PG8_BAR; PG8_SCHED;
            PG8_LDB(B1, 0, 1); PG8_STAGE(PG8_SB(0, 0), b2, voffB);
            PG8_BAR; PG8_WAIT_L(0); PG8_MMA(0, 1, At, B1); PG8_BAR;
            PG8_LDA(At, 0, 1); PG8_STAGE(PG8_SA(0, 0), a2, voffA);
            PG8_BAR; PG8_WAIT_L(0); PG8_MMA(1, 0, At, B0); PG8_BAR; PG8_SCHED;
            PG8_STAGE(PG8_SB(0, 1), b2 + hstep, voffB);
            PG8_WAIT_V(6); PG8_BAR; PG8_MMA(1, 1, At, B1); PG8_BAR;
            PG8_LDB(B0, 1, 0); PG8_SCHED; PG8_LDA(At, 1, 0); PG8_STAGE(PG8_SA(0, 1), a2 + hstep, voffA);
            PG8_WAIT_L(8); PG8_BAR; PG8_WAIT_L(0); PG8_MMA(0, 0, At, B0); PG8_BAR; PG8_SCHED;
            PG8_LDB(B1, 1, 1); PG8_STAGE(PG8_SB(1, 0), b3, voffB);
            PG8_BAR; PG8_WAIT_L(0); PG8_MMA(0, 1, At, B1); PG8_BAR;
            PG8_LDA(At, 1, 1); PG8_STAGE(PG8_SA(1, 0), a3, voffA);
            PG8_BAR; PG8_WAIT_L(0); PG8_MMA(1, 0, At, B0); PG8_BAR; PG8_SCHED;
            PG8_STAGE(PG8_SB(1, 1), b3 + hstep, voffB);
            PG8_WAIT_V(6); PG8_BAR; PG8_MMA(1, 1, At, B1); PG8_BAR;
            }
        }
        if constexpr (ALIGN_EPI) { if (wr == 0) PG8_BAR; }
        if constexpr (!Epi::AFTER_DRAIN) { E(acc, cur, wr, wc, fr, fq); S.done(cur); }
        if (!has_next) break;
#pragma unroll
        for (int a = 0; a < 2; ++a)
#pragma unroll
            for (int b = 0; b < 2; ++b)
#pragma unroll
                for (int m = 0; m < 4; ++m)
#pragma unroll
                    for (int n = 0; n < 2; ++n) acc[a][b][m][n] = (f32x4){0.f, 0.f, 0.f, 0.f};
        cur = nxt; cA = nA; cB = nB; ++ui;
        if constexpr (ALIGN_EPI) { if (wr == 1) PG8_BAR; }
    }
    PG8_WAIT_V(0);
    if constexpr (!ALIGN_EPI) { if (wr == 0) PG8_BAR; }
    PG8_BAR;
    if constexpr (Epi::AFTER_DRAIN) { E.fused(acc, cur, wr, wc, fr, fq, lds, wid, lane); S.done(cur); }
#undef PG8_SA
#undef PG8_SB
#undef PG8_STAGE
#undef PG8_LDA
#undef PG8_LDB
#undef PG8_MMA
#undef PG8_WAIT_V
#undef PG8_WAIT_L
#undef PG8_BAR
#undef PG8_SCHED
}
}

constexpr int NWAVES = 8;
constexpr int D_MODEL = 4096, SEQ = 8192, DEC_SEQ = 16;
constexpr int M_PROMPT = 16384, M_REAL = 16512, MPAD = 16640;
constexpr int IN_W = 14816, IN_WP = 14848, D_FF = 11008;
constexpr int PC_Q = 0, PC_K = 2048, PC_V = 4096, PC_Z = 6144, PC_B = 8192, PC_A = 8208, PC_RW = 8224;
constexpr int RW_R = 0, RW_K = 2048, RW_V = 4096, RW_XW = 6144, RW_XA = 6240, RW_XG = 6336, RW_SHIFT_W = 6592;
constexpr float NORM_EPS = 1e-6f, RW_GN_EPS = 64e-5f;
constexpr size_t O_Y = 0, O_SDN_P = 67633152, O_CONV_P = 68157440, O_SRW_P = 68194304, O_SHIFT_P = 68456448,
                 O_SDN_S = 68469632, O_CONV_S = 70566784, O_SRW_S = 70714240, O_SHIFT_S = 71762816, O_END = 71815552;
constexpr size_t MiB = 1u << 20;
constexpr size_t WS_CTL = 0, CTL_ZERO_BYTES = 1 * MiB;
constexpr size_t WS_SSQ = 2 * MiB;
constexpr size_t WS_WOUT = 8 * MiB;
constexpr size_t WS_HBUF = 40 * MiB;
constexpr size_t WS_PROJ = 170 * MiB;
constexpr size_t WS_WIN = 642 * MiB;
constexpr size_t WS_WGU = 758 * MiB;
constexpr size_t WS_WDN = 930 * MiB;
constexpr size_t WS_END = 1016 * MiB;
static_assert(WS_SSQ + (size_t)MPAD * 64 * 4 <= WS_WOUT && WS_HBUF + (size_t)MPAD * 4096 * 2 <= WS_PROJ && WS_PROJ + (size_t)MPAD * IN_WP * 2 <= WS_WIN &&
              WS_WIN + (size_t)IN_WP * 4096 * 2 <= WS_WGU && WS_WGU + (size_t)2 * D_FF * 4096 * 2 <= WS_WDN && WS_WDN + (size_t)4096 * D_FF * 2 <= WS_END, "d_ws map");
constexpr int CW_BAR = 4096;
constexpr int RING_OFF = 0, RING_BYTES = 131072;
constexpr int LDSCTL_OFF = RING_BYTES, MISC_OFF = LDSCTL_OFF + 320;
constexpr int LDS_BYTES = 147456;

#define GAS __attribute__((address_space(1)))
#define LAS __attribute__((address_space(3)))
typedef unsigned short bf16;
typedef unsigned v4u __attribute__((ext_vector_type(4)));
typedef unsigned v2u __attribute__((ext_vector_type(2)));
typedef float f32x4 __attribute__((ext_vector_type(4)));
typedef GAS unsigned gu32;
#define RLX_AGENT __ATOMIC_RELAXED, __HIP_MEMORY_SCOPE_AGENT
#define LDS_WAIT() asm volatile("s_waitcnt lgkmcnt(0)" ::: "memory")
__device__ __forceinline__ unsigned f2bf(float f) { unsigned u = __builtin_bit_cast(unsigned, f); return (u + 0x7fffu + ((u >> 16) & 1u)) >> 16; }
__device__ __forceinline__ unsigned pk2(float lo, float hi) { return f2bf(lo) | (f2bf(hi) << 16); }
__device__ __forceinline__ float bf2f(bf16 b) { return __builtin_bit_cast(float, (unsigned)b << 16); }
__device__ __forceinline__ float wave_sum(float v) {
#pragma unroll
    for (int o = 1; o < 64; o <<= 1) v += __shfl_xor(v, o);
    return v;
}
__device__ __forceinline__ float sigmoid_f(float x) { return 1.0f / (1.0f + __expf(-x)); }
__device__ __forceinline__ float softplus_f(float x) { return x > 20.f ? x : log1pf(__expf(x)); }

#define XB_TMO      128
#define XB_XCNT(j)  (256  + 64 * (j))
#define XB_XSUB(j)  (1280 + 64 * (j))
#define XB_XGEN(j)  (2304 + 64 * (j))
#define XB_TOP      3328
#define XB_TOPGEN   3392
#define XCD_BAR_WORDS 3456
#define XB_SPIN_CAP (1u << 18)

__device__ __forceinline__ unsigned xb_ld(unsigned* p)              { return __hip_atomic_load(p, __ATOMIC_RELAXED, __HIP_MEMORY_SCOPE_AGENT); }
__device__ __forceinline__ unsigned xb_add(unsigned* p, unsigned v) { return __hip_atomic_fetch_add(p, v, __ATOMIC_RELAXED, __HIP_MEMORY_SCOPE_AGENT); }
__device__ __forceinline__ unsigned xb_xcc_id() { return (unsigned)__builtin_amdgcn_s_getreg((3 << 11) | 20) & 0xFu; }
#define XB_SPIN(cond, bar) do { unsigned _sp = 0; while (cond) { __builtin_amdgcn_s_sleep(1); \
    if ((++_sp & 255u) == 0u) { if (xb_ld(&(bar)[XB_TMO])) break; if (_sp > XB_SPIN_CAP) { atomicAdd(&(bar)[XB_TMO], 1u); break; } } } } while (0)

struct XcdBarrier {
    unsigned* bar; unsigned x;
    volatile LAS unsigned* st;
};

__device__ __forceinline__ XcdBarrier xcd_barrier_post(unsigned* bar, volatile LAS unsigned* st) {
    XcdBarrier b; b.bar = bar; b.x = xb_xcc_id(); b.st = st;
    if (threadIdx.x == 0) (void)xb_add(&bar[XB_XCNT(b.x)], 1u);
    return b;
}
__device__ __forceinline__ void xcd_barrier_complete(unsigned* bar, unsigned x, unsigned& nloc, unsigned& nx) {
    const unsigned G = gridDim.x * gridDim.y * gridDim.z;
    unsigned sum, cnt, mine, sp = 0u;
    for (;;) {
        sum = 0u; cnt = 0u; mine = 0u;
#pragma unroll
        for (unsigned j = 0; j < 16; ++j) { const unsigned c = xb_ld(&bar[XB_XCNT(j)]); sum += c; cnt += (c > 0u) ? 1u : 0u; mine = (j == x) ? c : mine; }
        if (sum == G) break;
        __builtin_amdgcn_s_sleep(1);
        if ((++sp & 255u) == 0u) { if (xb_ld(&bar[XB_TMO])) break; if (sp > XB_SPIN_CAP) { atomicAdd(&bar[XB_TMO], 1u); break; } }
    }
    nloc = mine > 0u ? mine : 1u; nx = cnt > 0u ? cnt : 1u;
}

__device__ __forceinline__ void xcd_barrier(const XcdBarrier& b) {
    asm volatile("s_waitcnt vmcnt(0)" ::: "memory");
    __syncthreads();
    if (threadIdx.x == 0) {
        unsigned* bar = b.bar;
        __builtin_amdgcn_s_waitcnt(0);
        unsigned nloc = b.st[0], nx = b.st[1];
        if (nloc == 0u) { xcd_barrier_complete(bar, b.x, nloc, nx); b.st[0] = nloc; b.st[1] = nx; }
        const unsigned old = xb_add(&bar[XB_XSUB(b.x)], 1u);
        const unsigned gen = old / nloc;
        if (old + 1u == (gen + 1u) * nloc) {
            __builtin_amdgcn_fence(__ATOMIC_RELEASE, "agent");
            asm volatile("s_waitcnt vmcnt(0)" ::: "memory");
            const unsigned og = xb_add(&bar[XB_TOP], 1u);
            const unsigned tg = og / nx;
            if (og + 1u == (tg + 1u) * nx) xb_add(&bar[XB_TOPGEN], 1u);
            else XB_SPIN(xb_ld(&bar[XB_TOPGEN]) == tg, bar);
            __builtin_amdgcn_fence(__ATOMIC_ACQUIRE, "agent");
            xb_add(&bar[XB_XGEN(b.x)], 1u);
            asm volatile("s_waitcnt vmcnt(0)" ::: "memory");
        } else {
            XB_SPIN(xb_ld(&bar[XB_XGEN(b.x)]) == gen, bar);
            __builtin_amdgcn_fence(__ATOMIC_ACQUIRE, "agent");
            asm volatile("s_waitcnt vmcnt(0)" ::: "memory");
        }
    }
    __syncthreads();
}

struct Frame {
    LAS unsigned char* lds;
    volatile LAS unsigned* MISC;
    gu32* ctl;
    int tid, lane, wave, G;
    const float* const* in;
};
struct Args { const float* in[30]; float* out; unsigned char* ws; int ph_lo, ph_hi; };

template <class RowMap>
__device__ __forceinline__ void p0_transpose_item(const float* W, int K, int N, bf16* WT, LAS float* scr, int item, int lane, RowMap rm) {
    const int nblk = N / 32, kb = item / nblk, nb = item % nblk, k0 = 64 * kb, n0 = 32 * nb;
#pragma unroll 8
    for (int i = 0; i < 32; ++i) { const int kk = 2 * i + (lane >> 5); scr[kk * 33 + (lane & 31)] = W[(size_t)(k0 + kk) * N + n0 + (lane & 31)]; }
    LDS_WAIT(); asm volatile("" ::: "memory");
    const int c = lane & 7;
#pragma unroll
    for (int j = 0; j < 4; ++j) { const int n = (lane >> 3) + 8 * j; const LAS float* s = scr + (8 * c) * 33 + n;
        v4u o; o.x = pk2(s[0 * 33], s[1 * 33]); o.y = pk2(s[2 * 33], s[3 * 33]); o.z = pk2(s[4 * 33], s[5 * 33]); o.w = pk2(s[6 * 33], s[7 * 33]);
        *(GAS v4u*)(WT + (size_t)rm(n0 + n) * K + k0 + 8 * c) = o; }
    LDS_WAIT(); asm volatile("" ::: "memory");
}
struct RmId { __device__ __forceinline__ int operator()(int n) const { return n; } };
struct RmGU { int up; __device__ __forceinline__ int operator()(int n) const { return (n >> 7) * 256 + up * 128 + (n & 127); } };

__device__ __forceinline__ void rms_row_to_bf16(const f32x4 (&v)[16], const float* g, bf16* orow, int lane) {
    float s = 0.f;
#pragma unroll
    for (int j = 0; j < 16; ++j) s += (v[j].x * v[j].x + v[j].y * v[j].y) + (v[j].z * v[j].z + v[j].w * v[j].w);
    const float rstd = 1.0f / sqrtf(wave_sum(s) * (1.f / 4096.f) + NORM_EPS);
    const GAS f32x4* gr = (const GAS f32x4*)g + lane; GAS v2u* o8 = (GAS v2u*)orow + lane;
#pragma unroll
    for (int j = 0; j < 16; ++j) { const f32x4 gv = gr[64 * j]; v2u o; o.x = pk2(v[j].x * rstd * gv.x, v[j].y * rstd * gv.y); o.y = pk2(v[j].z * rstd * gv.z, v[j].w * rstd * gv.w); o8[64 * j] = o; }
}

struct MixPtrs {
    const bf16* proj; bf16* mix;
    const float *state_dn, *cache_conv, *state_rw, *cache_shift;
    const float *conv_w, *a_log, *dt_bias, *dn_norm_w;
    const float *mu, *w0, *w2, *a0, *a2, *g2, *k_k, *k_a, *r_k, *ln_w, *ln_b;
    float* out;
};
__device__ __forceinline__ void dn_seq_item(const MixPtrs& P, LAS unsigned char* lds, int seq, int h, int tid, int lane, int wave) {
    const bool prm = seq < 2;
    const int T = prm ? SEQ : DEC_SEQ, sb = prm ? seq : seq - 2;
    const int m0 = prm ? seq * SEQ : M_PROMPT + sb * DEC_SEQ;
    const float* S0 = prm ? nullptr : P.state_dn + ((size_t)sb * 16 + h) * 16384;
    const float* cbuf = prm ? nullptr : P.cache_conv + (size_t)sb * 3 * 6144;
    float* Sout = P.out + (prm ? O_SDN_P : O_SDN_S) + ((size_t)sb * 16 + h) * 16384;
    float* cout = P.out + (prm ? O_CONV_P : O_CONV_S) + (size_t)sb * 3 * 6144;
    LAS float* qs = (LAS float*)lds; LAS float* ks = qs + 2048; LAS float* vs = ks + 2048; LAS float* zs = vs + 2048; LAS float* os = zs + 2048; LAS float* bet = os + 2048; LAS float* gg = bet + 16;
    float S[32];
    const int e = wave * 16 + (lane >> 2), dq = lane & 3;
#pragma unroll
    for (int j = 0; j < 32; ++j) S[j] = (S0 != nullptr) ? S0[(32 * dq + j) * 128 + e] : 0.f;
    const float Ah = -__expf(P.a_log[h]), dtb = P.dt_bias[h];
    for (int tb = 0; tb < T; tb += 16) {
        for (int i = tid; i < 16 * 384; i += 512) { const int t = i / 384, cc = i - t * 384, sec = cc >> 7, d = cc & 127, col = sec * 2048 + h * 128 + d;
            float acc = 0.f;
#pragma unroll
            for (int j = 0; j < 4; ++j) { const int tt = tb + t - 3 + j; float xv;
                if (tt >= 0) xv = bf2f(P.proj[(size_t)(m0 + tt) * IN_WP + col]); else xv = cbuf ? cbuf[(3 + tt) * 6144 + col] : 0.f;
                acc += xv * P.conv_w[j * 6144 + col]; }
            const float y = acc * sigmoid_f(acc);
            (sec == 0 ? qs : (sec == 1 ? ks : vs))[t * 128 + d] = y; }
        for (int i = tid; i < 16 * 128; i += 512) { const int t = i >> 7, d = i & 127; zs[i] = bf2f(P.proj[(size_t)(m0 + tb + t) * IN_WP + PC_Z + h * 128 + d]); }
        if (tid < 16) { const size_t r = (size_t)(m0 + tb + tid) * IN_WP; const float b = bf2f(P.proj[r + PC_B + h]), a = bf2f(P.proj[r + PC_A + h]);
            bet[tid] = sigmoid_f(b); gg[tid] = Ah * softplus_f(a + dtb); }
        __syncthreads();
#pragma unroll
        for (int r = 0; r < 2; ++r) { const int t = 2 * wave + r;
            const float q0 = qs[t * 128 + lane], q1 = qs[t * 128 + 64 + lane], k0 = ks[t * 128 + lane], k1 = ks[t * 128 + 64 + lane];
            const float sq = wave_sum(q0 * q0 + q1 * q1), sk = wave_sum(k0 * k0 + k1 * k1);
            const float cq = 0.08838834764831845f / sqrtf(sq + 1e-6f), ck = 1.0f / sqrtf(sk + 1e-6f);
            qs[t * 128 + lane] = q0 * cq; qs[t * 128 + 64 + lane] = q1 * cq; ks[t * 128 + lane] = k0 * ck; ks[t * 128 + 64 + lane] = k1 * ck; }
        __syncthreads();
        {
#pragma unroll 1
            for (int t = 0; t < 16; ++t) {
                const float eg = __expf(gg[t]), bt = bet[t];
                float kS = 0.f;
#pragma unroll
                for (int d4 = 0; d4 < 8; ++d4) { const f32x4 kv = *(const LAS f32x4*)(ks + t * 128 + 32 * dq + 4 * d4);
                    kS += kv.x * S[4 * d4] + kv.y * S[4 * d4 + 1] + kv.z * S[4 * d4 + 2] + kv.w * S[4 * d4 + 3]; }
                kS += __shfl_xor(kS, 1); kS += __shfl_xor(kS, 2);
                const float w = bt * (vs[t * 128 + e] - eg * kS);
                float o = 0.f;
#pragma unroll
                for (int d4 = 0; d4 < 8; ++d4) { const f32x4 kv = *(const LAS f32x4*)(ks + t * 128 + 32 * dq + 4 * d4); const f32x4 qv = *(const LAS f32x4*)(qs + t * 128 + 32 * dq + 4 * d4);
                    S[4 * d4] = eg * S[4 * d4] + kv.x * w; S[4 * d4 + 1] = eg * S[4 * d4 + 1] + kv.y * w; S[4 * d4 + 2] = eg * S[4 * d4 + 2] + kv.z * w; S[4 * d4 + 3] = eg * S[4 * d4 + 3] + kv.w * w;
                    o += qv.x * S[4 * d4] + qv.y * S[4 * d4 + 1] + qv.z * S[4 * d4 + 2] + qv.w * S[4 * d4 + 3]; }
                o += __shfl_xor(o, 1); o += __shfl_xor(o, 2);
                if (dq == 0) os[t * 128 + e] = o;
            }
        }
        __syncthreads();
#pragma unroll
        for (int r = 0; r < 2; ++r) { const int t = 2 * wave + r;
            const float o0 = os[t * 128 + lane], o1 = os[t * 128 + 64 + lane];
            const float rs = 1.0f / sqrtf(wave_sum(o0 * o0 + o1 * o1) * (1.f / 128.f) + NORM_EPS);
            const float z0 = zs[t * 128 + lane], z1 = zs[t * 128 + 64 + lane];
            bf16* mp = P.mix + (size_t)(m0 + tb + t) * 4096 + h * 128;
            mp[lane] = (bf16)f2bf(o0 * rs * P.dn_norm_w[lane] * (z0 * sigmoid_f(z0))); mp[64 + lane] = (bf16)f2bf(o1 * rs * P.dn_norm_w[64 + lane] * (z1 * sigmoid_f(z1))); }
        __syncthreads();
    }
#pragma unroll
    for (int j = 0; j < 32; ++j) Sout[(32 * dq + j) * 128 + e] = S[j];
    for (int i = tid; i < 3 * 384; i += 512) { const int r = i / 384, cc = i - r * 384, col = (cc >> 7) * 2048 + h * 128 + (cc & 127);
        cout[r * 6144 + col] = bf2f(P.proj[(size_t)(m0 + T - 3 + r) * IN_WP + col]); }
}
__device__ __forceinline__ void rw_seq_item(const MixPtrs& P, LAS unsigned char* lds, int seq, int h, int tid, int lane, int wave) {
    const bool prm = seq < 2;
    const int T = prm ? SEQ : DEC_SEQ, sb = prm ? seq : seq - 2;
    const int m0 = prm ? seq * SEQ : M_PROMPT + sb * DEC_SEQ;
    const float* S0 = prm ? nullptr : P.state_rw + ((size_t)sb * 32 + h) * 4096;
    const float* sbuf = prm ? nullptr : P.cache_shift + (size_t)sb * RW_SHIFT_W;
    float* Sout = P.out + (prm ? O_SRW_P : O_SRW_S) + ((size_t)sb * 32 + h) * 4096;
    float* shout = P.out + (prm ? O_SHIFT_P : O_SHIFT_S) + (size_t)sb * RW_SHIFT_W;
    LAS float* rs = (LAS float*)lds; LAS float* kr = rs + 1024; LAS float* vs = kr + 1024; LAS float* xw = vs + 1024; LAS float* xa = xw + 1536; LAS float* xg = xa + 1536;
    LAS float* wd = xg + 4096; LAS float* kp = wd + 1024; LAS float* av = kp + 1024; LAS float* bv = av + 1024; LAS float* gt = bv + 1024; LAS float* ys = gt + 1024; LAS float* sbn = ys + 1024;
    float S[16];
    const int vr = (wave & 3) * 16 + (lane >> 2), kq = lane & 3;
#pragma unroll
    for (int k4 = 0; k4 < 4; ++k4) { f32x4 v = (f32x4){0.f, 0.f, 0.f, 0.f}; if (S0 != nullptr) v = *(const f32x4*)(S0 + vr * 64 + 16 * kq + 4 * k4);
        S[4 * k4] = v.x; S[4 * k4 + 1] = v.y; S[4 * k4 + 2] = v.z; S[4 * k4 + 3] = v.w; }
    const int hc = h * 64 + lane;
    const float w0c = P.w0[hc], a0c = P.a0[hc], kkc = P.k_k[hc], kac = P.k_a[hc], rkc = P.r_k[hc], lnw = P.ln_w[hc], lnb = P.ln_b[hc];
    for (int tb = 0; tb < T; tb += 16) {
        for (int i = tid; i < 16 * 640; i += 512) { const int t = i / 640, cc = i - t * 640; int col; LAS float* dst; int kind = 0;
            if (cc < 64) { col = RW_R + h * 64 + cc; dst = rs + t * 64 + cc; }
            else if (cc < 128) { col = RW_K + h * 64 + (cc - 64); dst = kr + t * 64 + (cc - 64); }
            else if (cc < 192) { col = RW_V + h * 64 + (cc - 128); dst = vs + t * 64 + (cc - 128); }
            else if (cc < 288) { col = RW_XW + (cc - 192); dst = xw + t * 96 + (cc - 192); kind = 1; }
            else if (cc < 384) { col = RW_XA + (cc - 288); dst = xa + t * 96 + (cc - 288); }
            else { col = RW_XG + (cc - 384); dst = xg + t * 256 + (cc - 384); kind = 2; }
            const int tt = tb + t; const float u = bf2f(P.proj[(size_t)(m0 + tt) * IN_WP + PC_RW + col]);
            const float up = tt > 0 ? bf2f(P.proj[(size_t)(m0 + tt - 1) * IN_WP + PC_RW + col]) : (sbuf ? sbuf[col] : 0.f);
            float v = u + P.mu[col] * (up - u);
            if (kind == 1) v = tanhf(v); else if (kind == 2) v = sigmoid_f(v);
            *dst = v; }
        __syncthreads();
        {
            float wl0 = 0.f, wl1 = 0.f, al0 = 0.f, al1 = 0.f, gl0 = 0.f, gl1 = 0.f; const int t0 = wave, t1 = wave + 8;
#pragma unroll 4
            for (int j = 0; j < 96; ++j) { const float w2v = P.w2[j * 2048 + hc], a2v = P.a2[j * 2048 + hc];
                wl0 += xw[t0 * 96 + j] * w2v; wl1 += xw[t1 * 96 + j] * w2v; al0 += xa[t0 * 96 + j] * a2v; al1 += xa[t1 * 96 + j] * a2v; }
#pragma unroll 4
            for (int j = 0; j < 256; ++j) { const float g2v = P.g2[j * 2048 + hc]; gl0 += xg[t0 * 256 + j] * g2v; gl1 += xg[t1 * 256 + j] * g2v; }
#pragma unroll
            for (int r = 0; r < 2; ++r) { const int t = r ? t1 : t0; const float wl = r ? wl1 : wl0, al = r ? al1 : al0, gl = r ? gl1 : gl0;
                const float wlog = -softplus_f(-(w0c + wl)) - 0.5f; const float wdec = __expf(-__expf(wlog));
                const float a = sigmoid_f(a0c + al);
                const float krv = kr[t * 64 + lane], kkr = krv * kkc; const float kk = kkr / sqrtf(wave_sum(kkr * kkr) + 1e-6f);
                const float kpv = krv * (1.0f + (a - 1.0f) * kac);
                const float sbv = wave_sum(rs[t * 64 + lane] * kpv * rkc);
                wd[t * 64 + lane] = wdec; kp[t * 64 + lane] = kpv; av[t * 64 + lane] = -kk; bv[t * 64 + lane] = kk * a; gt[t * 64 + lane] = gl; if (lane == 0) sbn[t] = sbv; }
        }
        __syncthreads();
        if (wave < 4) {
#pragma unroll 1
            for (int t = 0; t < 16; ++t) {
                float sa = 0.f;
#pragma unroll
                for (int k4 = 0; k4 < 4; ++k4) { const f32x4 a4 = *(const LAS f32x4*)(av + t * 64 + 16 * kq + 4 * k4); sa += a4.x * S[4 * k4] + a4.y * S[4 * k4 + 1] + a4.z * S[4 * k4 + 2] + a4.w * S[4 * k4 + 3]; }
                sa += __shfl_xor(sa, 1); sa += __shfl_xor(sa, 2);
                const float vv = vs[t * 64 + vr]; float y = 0.f;
#pragma unroll
                for (int k4 = 0; k4 < 4; ++k4) { const int o4 = t * 64 + 16 * kq + 4 * k4;
                    const f32x4 w4 = *(const LAS f32x4*)(wd + o4), b4 = *(const LAS f32x4*)(bv + o4), k4v = *(const LAS f32x4*)(kp + o4), r4 = *(const LAS f32x4*)(rs + o4);
                    S[4 * k4] = S[4 * k4] * w4.x + sa * b4.x + vv * k4v.x; S[4 * k4 + 1] = S[4 * k4 + 1] * w4.y + sa * b4.y + vv * k4v.y;
                    S[4 * k4 + 2] = S[4 * k4 + 2] * w4.z + sa * b4.z + vv * k4v.z; S[4 * k4 + 3] = S[4 * k4 + 3] * w4.w + sa * b4.w + vv * k4v.w;
                    y += r4.x * S[4 * k4] + r4.y * S[4 * k4 + 1] + r4.z * S[4 * k4 + 2] + r4.w * S[4 * k4 + 3]; }
                y += __shfl_xor(y, 1); y += __shfl_xor(y, 2);
                if (kq == 0) ys[t * 64 + vr] = y;
            }
        }
        __syncthreads();
#pragma unroll
        for (int r = 0; r < 2; ++r) { const int t = wave + 8 * r; const float y = ys[t * 64 + lane];
            const float mean = wave_sum(y) * (1.f / 64.f); const float dy = y - mean; const float var = wave_sum(dy * dy) * (1.f / 64.f);
            const float yn = dy / sqrtf(var + RW_GN_EPS) * lnw + lnb;
            P.mix[(size_t)(m0 + tb + t) * 4096 + 2048 + hc] = (bf16)f2bf((yn + sbn[t] * vs[t * 64 + lane]) * gt[t * 64 + lane]); }
        __syncthreads();
    }
    if (wave < 4) {
#pragma unroll
        for (int k4 = 0; k4 < 4; ++k4) *(f32x4*)(Sout + vr * 64 + 16 * kq + 4 * k4) = (f32x4){S[4 * k4], S[4 * k4 + 1], S[4 * k4 + 2], S[4 * k4 + 3]};
    }
    for (int i = tid; i < 206; i += 512) { const int col = h * 206 + i; shout[col] = bf2f(P.proj[(size_t)(m0 + T - 1) * IN_WP + PC_RW + col]); }
}

constexpr int NPH = 8;
#define MK_N_LAUNCHES 1
#ifndef MK_N_LAUNCHES
#define MK_N_LAUNCHES 1
#endif
__global__ void __launch_bounds__(NWAVES * 64, 2) hymba_fwd(Args args) {
    extern __shared__ __attribute__((aligned(16))) unsigned char lds_raw[];
    LAS unsigned char* lds = (LAS unsigned char*)lds_raw;
    volatile LAS unsigned* MISC = (volatile LAS unsigned*)(lds + MISC_OFF);
    const int tid = threadIdx.x, lane = tid & 63, wave = __builtin_amdgcn_readfirstlane(tid >> 6);
    const int G = gridDim.x;
    unsigned char* ws = args.ws;
    gu32* ctl = (gu32*)(ws + WS_CTL);
    for (int u = tid; u < (LDS_BYTES - LDSCTL_OFF) / 4; u += NWAVES * 64) ((LAS unsigned*)(lds + LDSCTL_OFF))[u] = 0u;
    __syncthreads();
    XcdBarrier bar; bar.bar = (unsigned*)(ctl + CW_BAR); bar.x = 0; bar.st = nullptr;
    if (MK_N_LAUNCHES == 1) bar = xcd_barrier_post((unsigned*)(ctl + CW_BAR), MISC + 8);
    const int lo = args.ph_lo, hi = args.ph_hi;
#ifdef ONLY_PHASE
#define IN(k) ((k) == ONLY_PHASE)
#else
#define IN(k) (lo <= (k) && (k) < hi)
#endif
#define SEAM(k) do { if (IN(k) && IN((k) + 1)) xcd_barrier(bar); } while (0)
    float* ssq = (float*)(ws + WS_SSQ);
    bf16* Wt_out = (bf16*)(ws + WS_WOUT); bf16* hbuf = (bf16*)(ws + WS_HBUF); bf16* proj = (bf16*)(ws + WS_PROJ); bf16* act = (bf16*)(ws + WS_PROJ);
    bf16* Wt_in = (bf16*)(ws + WS_WIN); bf16* Wt_gu = (bf16*)(ws + WS_WGU); bf16* Wt_dn = (bf16*)(ws + WS_WDN);
    const float* x_prompt = args.in[0]; const float* x_sample = args.in[1];
    const int gw = blockIdx.x * NWAVES + wave, NGW = G * NWAVES;

    if (IN(0)) {
        LAS float* scr = (LAS float*)(lds + RING_OFF + wave * 16384);
        constexpr int I_IN = 64 * (IN_W / 32), I_OUT = 64 * 128, I_G = 64 * (D_FF / 32), I_D = (D_FF / 64) * 128;
        constexpr int NITEMS = I_IN + I_OUT + 2 * I_G + I_D;
        for (int it = gw; it < NITEMS; it += NGW) {
            int r = it;
            if (r < I_IN) { p0_transpose_item(args.in[8], 4096, IN_W, Wt_in, scr, r, lane, RmId{}); continue; } r -= I_IN;
            if (r < I_OUT) { p0_transpose_item(args.in[24], 4096, 4096, Wt_out, scr, r, lane, RmId{}); continue; } r -= I_OUT;
            if (r < I_G) { p0_transpose_item(args.in[27], 4096, D_FF, Wt_gu, scr, r, lane, RmGU{0}); continue; } r -= I_G;
            if (r < I_G) { p0_transpose_item(args.in[28], 4096, D_FF, Wt_gu, scr, r, lane, RmGU{1}); continue; } r -= I_G;
            p0_transpose_item(args.in[29], D_FF, 4096, Wt_dn, scr, r, lane, RmId{});
        }
        for (int i = blockIdx.x * 512 + tid; i < 32 * 4096 / 8; i += G * 512) ((GAS v4u*)(Wt_in + (size_t)IN_W * 4096))[i] = (v4u){0u, 0u, 0u, 0u};
        for (int m = gw; m < MPAD; m += NGW) {
            bf16* orow = hbuf + (size_t)m * 4096;
            if (m < M_REAL) { const float* xrow = m < M_PROMPT ? x_prompt + (size_t)m * 4096 : x_sample + (size_t)(m - M_PROMPT) * 4096;
                const GAS f32x4* xr = (const GAS f32x4*)xrow + lane; f32x4 v[16];
#pragma unroll
                for (int j = 0; j < 16; ++j) v[j] = xr[64 * j];
                rms_row_to_bf16(v, args.in[6], orow, lane); }
            else { GAS v2u* o8 = (GAS v2u*)orow + lane;
#pragma unroll
                for (int j = 0; j < 16; ++j) o8[64 * j] = (v2u){0u, 0u}; }
        }
    }
    SEAM(0);
    if (IN(1)) {
        pg8::Gemm g{hbuf, Wt_in, MPAD, IN_WP, 4096}; pg8::StaticOrder S; S.init(MPAD, IN_WP, G, (int)blockIdx.x);
        pg8::EpiBf16Plain E{proj, IN_WP};
        pg8::gemm_phase<pg8::EpiBf16Plain, pg8::StaticOrder, true, true>(lds + RING_OFF, g, S, E);
    }
    SEAM(1);
    if (IN(2)) {
        MixPtrs P; P.proj = proj; P.mix = hbuf; P.state_dn = args.in[2]; P.cache_conv = args.in[3]; P.state_rw = args.in[4]; P.cache_shift = args.in[5];
        P.conv_w = args.in[9]; P.a_log = args.in[10]; P.dt_bias = args.in[11]; P.dn_norm_w = args.in[12];
        P.mu = args.in[13]; P.w0 = args.in[14]; P.w2 = args.in[15]; P.a0 = args.in[16]; P.a2 = args.in[17]; P.g2 = args.in[18]; P.k_k = args.in[19]; P.k_a = args.in[20]; P.r_k = args.in[21];
        P.ln_w = args.in[22]; P.ln_b = args.in[23]; P.out = args.out;
        const int wg = blockIdx.x;
        int first, stride, limit;
        if (wg < 96 && G >= 97) { first = wg; stride = 1 << 30; limit = 96; } else if (G >= 97) { first = 96 + (wg - 96); stride = G - 96; limit = 96 + 384; } else { first = wg; stride = G; limit = 96 + 384; }
        for (int it = first; it < limit; it += stride) {
            int kind, seq, h;
            if (it < 32) { kind = 0; seq = it >> 4; h = it & 15; }
            else if (it < 96) { kind = 1; seq = (it - 32) >> 5; h = (it - 32) & 31; }
            else if (it < 96 + 128) { kind = 0; seq = 2 + ((it - 96) >> 4); h = (it - 96) & 15; }
            else { kind = 1; seq = 2 + ((it - 224) >> 5); h = (it - 224) & 31; }
            #ifndef NO_DN
            if (kind == 0) dn_seq_item(P, lds + RING_OFF, seq, h, tid, lane, wave);
#endif
#ifndef NO_RW
            if (kind == 1) rw_seq_item(P, lds + RING_OFF, seq, h, tid, lane, wave);
#endif
            if (stride == (1 << 30)) break;
        }
    }
    SEAM(2);
    if (IN(3)) {
        pg8::Gemm g{hbuf, Wt_out, MPAD, 4096, 4096}; pg8::StaticOrder S; S.init(MPAD, 4096, G, (int)blockIdx.x);
        pg8::EpiF32Ssq E{args.out + O_Y, 4096, ssq, M_REAL};
        pg8::gemm_phase<pg8::EpiF32Ssq, pg8::StaticOrder, true, true>(lds + RING_OFF, g, S, E);
    }
    SEAM(3);
    if (IN(4)) {
        for (int m = gw; m < M_REAL; m += NGW) {
            const float* xrow = m < M_PROMPT ? x_prompt + (size_t)m * 4096 : x_sample + (size_t)(m - M_PROMPT) * 4096;
            float s = ssq[(size_t)m * 64 + lane]; s = wave_sum(s);
            const float rstd = 1.0f / sqrtf(s * (1.f / 4096.f) + NORM_EPS);
            const GAS f32x4* xr = (const GAS f32x4*)xrow + lane; GAS f32x4* tr = (GAS f32x4*)(args.out + O_Y + (size_t)m * 4096) + lane; const GAS f32x4* gr = (const GAS f32x4*)args.in[7] + lane;
            f32x4 v[16];
#pragma unroll
            for (int j = 0; j < 16; ++j) { const f32x4 xv = xr[64 * j], tv = tr[64 * j], gv = gr[64 * j]; v[j] = xv + tv * rstd * gv; tr[64 * j] = v[j]; }
            rms_row_to_bf16(v, args.in[25], hbuf + (size_t)m * 4096, lane);
        }
    }
    SEAM(4);
    if (IN(5)) {
        pg8::Gemm g{hbuf, Wt_gu, MPAD, 2 * D_FF, 4096}; pg8::StaticOrder S; S.init(MPAD, 2 * D_FF, G, (int)blockIdx.x);
        pg8::EpiSwiGLU E{act, D_FF};
        pg8::gemm_phase<pg8::EpiSwiGLU, pg8::StaticOrder, true, true>(lds + RING_OFF, g, S, E);
    }
    SEAM(5);
    if (IN(6)) {
        pg8::Gemm g{act, Wt_dn, MPAD, 4096, D_FF}; pg8::StaticOrder S; S.init(MPAD, 4096, G, (int)blockIdx.x);
        pg8::EpiBf16Ssq E{hbuf, 4096, ssq};
        pg8::gemm_phase<pg8::EpiBf16Ssq, pg8::StaticOrder, true, true>(lds + RING_OFF, g, S, E);
    }
    SEAM(6);
    if (IN(7)) {
        for (int m = gw; m < M_REAL; m += NGW) {
            float s = ssq[(size_t)m * 64 + lane]; s = wave_sum(s);
            const float rstd = 1.0f / sqrtf(s * (1.f / 4096.f) + NORM_EPS);
            GAS f32x4* orow = (GAS f32x4*)(args.out + O_Y + (size_t)m * 4096) + lane; const GAS v2u* fr = (const GAS v2u*)(hbuf + (size_t)m * 4096) + lane; const GAS f32x4* gr = (const GAS f32x4*)args.in[26] + lane;
#pragma unroll
            for (int j = 0; j < 16; ++j) { const f32x4 xv = orow[64 * j], gv = gr[64 * j]; const v2u fv = fr[64 * j];
                f32x4 f; f.x = __builtin_bit_cast(float, fv.x << 16); f.y = __builtin_bit_cast(float, fv.x & 0xffff0000u); f.z = __builtin_bit_cast(float, fv.y << 16); f.w = __builtin_bit_cast(float, fv.y & 0xffff0000u);
                orow[64 * j] = xv + f * rstd * gv; }
        }
    }
#undef IN
#undef SEAM
}

extern "C" void kernel_launch(void* const* d_in, const int* in_sizes, int n_in, void* d_out, int out_size, void* d_ws, size_t ws_size, hipStream_t stream) {
    static int grid = 0;
    if (grid == 0) {
        if (n_in != 30 || out_size != (int)O_END || ws_size < WS_END) { fprintf(stderr, "kernel_launch: unexpected shapes (n_in %d out %d ws %zu)\n", n_in, out_size, ws_size); grid = -1; return; }
        int dev = 0, cus = 0, per_cu = 0;
        if (hipGetDevice(&dev) != hipSuccess || hipDeviceGetAttribute(&cus, hipDeviceAttributeMultiprocessorCount, dev) != hipSuccess) { grid = -1; return; }
        if (hipFuncSetAttribute((const void*)hymba_fwd, hipFuncAttributeMaxDynamicSharedMemorySize, LDS_BYTES) != hipSuccess) { grid = -1; return; }
        if (hipOccupancyMaxActiveBlocksPerMultiprocessor(&per_cu, (const void*)hymba_fwd, NWAVES * 64, LDS_BYTES) != hipSuccess || per_cu < 1) { fprintf(stderr, "kernel_launch: occupancy query says %d\n", per_cu); }
        (void)hipGetLastError();
        grid = cus;
    }
    if (grid < 0) return;
    if (hipMemsetAsync((char*)d_ws + WS_CTL, 0, CTL_ZERO_BYTES, stream) != hipSuccess) return;
    Args a{};
    for (int i = 0; i < 30; ++i) a.in[i] = (const float*)d_in[i];
    a.out = (float*)d_out; a.ws = (unsigned char*)d_ws;
    if (MK_N_LAUNCHES == 1) { a.ph_lo = 0; a.ph_hi = NPH; hipLaunchKernelGGL(hymba_fwd, dim3(grid), dim3(NWAVES * 64), LDS_BYTES, stream, a); }
    else for (int p = 0; p < NPH; ++p) { a.ph_lo = p; a.ph_hi = p + 1; hipLaunchKernelGGL(hymba_fwd, dim3(grid), dim3(NWAVES * 64), LDS_BYTES, stream, a); }
}
```

```cpp
#include <hip/hip_runtime.h>
#include <cstdio>
#include <cstdint>

namespace pg8 {
#define PG8_LAS __attribute__((address_space(3)))
typedef unsigned short bf16_t;
typedef short bf16x8 __attribute__((ext_vector_type(8)));
typedef float f32x4 __attribute__((ext_vector_type(4)));
typedef unsigned u32x4 __attribute__((ext_vector_type(4)));
constexpr int BM = 256, BK = 64, HALF = 128, HTB = HALF * BK * 2  , STAGE_BYTES = 8 * HTB, NXCD = 8, WGM = 8;

__host__ __device__ __forceinline__ int lds_byte(int r, int c) { const int st = (r >> 4) * 2 + (c >> 5), rr = r & 15, cc = c & 31, ob = rr * 64 + cc * 2; return st * 1024 + (ob ^ (((ob >> 9) & 1) << 5)); }
__host__ __device__ __forceinline__ void stage_rc(int b, int& R, int& C) { const int st = b / 1024, sb = b % 1024, swz = sb ^ (((sb >> 9) & 1) << 5); R = (st >> 1) * 16 + swz / 64; C = (st & 1) * 32 + (swz % 64) / 2; }
__host__ __device__ __forceinline__ int perm32(int rho) { const int n = rho >> 4, i = rho & 15; return 8 * (i >> 2) + 4 * n + (i & 3); }

struct Unit { int pm, pn; };
struct Gemm { const bf16_t* A; const bf16_t* Bt; int M, N, K; };

struct StaticOrder {
    int nM, nN, nwg, G, c;
    __host__ __device__ void init(int M, int N, int G_, int c_) { nM = M / BM; nN = N / BM; nwg = nM * nN; G = G_; c = c_; }
    __host__ __device__ bool next(int i, Unit& u) const {
        const long L = (long)i * G + c; if (L >= nwg) return false;
        int wgid = (int)L; { const int q = nwg / NXCD, r = nwg % NXCD, xcd = wgid % NXCD, off = wgid / NXCD; wgid = (xcd < r ? xcd * (q + 1) : r * (q + 1) + (xcd - r) * q) + off; }
        const int nig = WGM * nN, gid = wgid / nig, fm = gid * WGM, gsz = (nM - fm) < WGM ? (nM - fm) : WGM;
        u.pm = fm + ((wgid % nig) % gsz); u.pn = (wgid % nig) / gsz; return true;
    }
    __device__ __forceinline__ void a_ready(const Unit&) const {}
    __device__ __forceinline__ void done(const Unit&) const {}
};
__device__ __forceinline__ unsigned cvt_pk_bf16(float lo, float hi) { unsigned r; asm volatile("v_cvt_pk_bf16_f32 %0, %1, %2" : "=v"(r) : "v"(lo), "v"(hi)); return r; }

struct EpiBf16Plain {
    static constexpr bool PERM = true, AFTER_DRAIN = false;
    bf16_t* O; int ldc;
    __device__ __forceinline__ void operator()(const f32x4 (&acc)[2][2][4][2], const Unit& u, int wr, int wc, int fr, int fq) const {
        const int row0 = u.pm * BM + wr * 64 + fr, col0 = u.pn * BM + wc * 32 + 8 * fq;
#pragma unroll
        for (int ai = 0; ai < 2; ++ai)
#pragma unroll
            for (int m = 0; m < 4; ++m) { bf16_t* rowp = O + (size_t)(row0 + ai * HALF + m * 16) * ldc + col0;
#pragma unroll
                for (int bj = 0; bj < 2; ++bj) { const f32x4 v0 = acc[ai][bj][m][0], v1 = acc[ai][bj][m][1];
                    u32x4 w; w.x = cvt_pk_bf16(v0[0], v0[1]); w.y = cvt_pk_bf16(v0[2], v0[3]); w.z = cvt_pk_bf16(v1[0], v1[1]); w.w = cvt_pk_bf16(v1[2], v1[3]);
                    *(u32x4*)(rowp + bj * HALF) = w; } }
    }
};
__device__ __forceinline__ float silu_f(float x) { return x * __builtin_amdgcn_rcpf(1.0f + __expf(-x)); }
struct EpiSwiGLU {
    static constexpr bool PERM = true, AFTER_DRAIN = false;
    bf16_t* O; int ldc;
    __device__ __forceinline__ void operator()(const f32x4 (&acc)[2][2][4][2], const Unit& u, int wr, int wc, int fr, int fq) const {
        const int row0 = u.pm * BM + wr * 64 + fr, col0 = u.pn * HALF + wc * 32 + 8 * fq;
#pragma unroll
        for (int ai = 0; ai < 2; ++ai)
#pragma unroll
            for (int m = 0; m < 4; ++m) { bf16_t* rowp = O + (size_t)(row0 + ai * HALF + m * 16) * ldc + col0;
                const f32x4 g0 = acc[ai][0][m][0], g1 = acc[ai][0][m][1], u0 = acc[ai][1][m][0], u1 = acc[ai][1][m][1];
                u32x4 w; w.x = cvt_pk_bf16(silu_f(g0[0]) * u0[0], silu_f(g0[1]) * u0[1]); w.y = cvt_pk_bf16(silu_f(g0[2]) * u0[2], silu_f(g0[3]) * u0[3]);
                w.z = cvt_pk_bf16(silu_f(g1[0]) * u1[0], silu_f(g1[1]) * u1[1]); w.w = cvt_pk_bf16(silu_f(g1[2]) * u1[2], silu_f(g1[3]) * u1[3]);
                *(u32x4*)rowp = w; }
    }
};
struct EpiF32Ssq {
    static constexpr bool PERM = false, AFTER_DRAIN = false;
    float* C; int ldc; float* ssq; int mreal;
    __device__ __forceinline__ void operator()(const f32x4 (&acc)[2][2][4][2], const Unit& u, int wr, int wc, int fr, int fq) const {
        const int row0 = u.pm * BM + wr * 64 + fr, col0 = u.pn * BM + wc * 32 + 4 * fq;
#pragma unroll
        for (int ai = 0; ai < 2; ++ai)
#pragma unroll
            for (int m = 0; m < 4; ++m) { const int row = row0 + ai * HALF + m * 16; float s = 0.f;
#pragma unroll
                for (int bj = 0; bj < 2; ++bj)
#pragma unroll
                    for (int n = 0; n < 2; ++n) { const f32x4 v = acc[ai][bj][m][n]; s += (v[0] * v[0] + v[1] * v[1]) + (v[2] * v[2] + v[3] * v[3]);
                        if (row < mreal) *(f32x4*)(C + (size_t)row * ldc + col0 + bj * HALF + n * 16) = v; }
                s += __shfl_xor(s, 16); s += __shfl_xor(s, 32);
                if (fq == 0) ssq[(size_t)row * 64 + u.pn * 4 + wc] = s; }
    }
};
struct EpiBf16Ssq {
    static constexpr bool PERM = true, AFTER_DRAIN = false;
    bf16_t* O; int ldc; float* ssq;
    __device__ __forceinline__ void operator()(const f32x4 (&acc)[2][2][4][2], const Unit& u, int wr, int wc, int fr, int fq) const {
        const int row0 = u.pm * BM + wr * 64 + fr, col0 = u.pn * BM + wc * 32 + 8 * fq;
#pragma unroll
        for (int ai = 0; ai < 2; ++ai)
#pragma unroll
            for (int m = 0; m < 4; ++m) { const int row = row0 + ai * HALF + m * 16; bf16_t* rowp = O + (size_t)row * ldc + col0; float s = 0.f;
#pragma unroll
                for (int bj = 0; bj < 2; ++bj) { const f32x4 v0 = acc[ai][bj][m][0], v1 = acc[ai][bj][m][1];
                    s += (v0[0] * v0[0] + v0[1] * v0[1]) + (v0[2] * v0[2] + v0[3] * v0[3]) + (v1[0] * v1[0] + v1[1] * v1[1]) + (v1[2] * v1[2] + v1[3] * v1[3]);
                    u32x4 w; w.x = cvt_pk_bf16(v0[0], v0[1]); w.y = cvt_pk_bf16(v0[2], v0[3]); w.z = cvt_pk_bf16(v1[0], v1[1]); w.w = cvt_pk_bf16(v1[2], v1[3]);
                    *(u32x4*)(rowp + bj * HALF) = w; }
                s += __shfl_xor(s, 16); s += __shfl_xor(s, 32);
                if (fq == 0) ssq[(size_t)row * 64 + u.pn * 4 + wc] = s; }
    }
};
template <class Epi, class Sched, bool ALIGN_EPI = false, bool SP2 = false>
__device__ __forceinline__ void gemm_phase(PG8_LAS unsigned char* lds, const Gemm g, const Sched& S, const Epi& E) {
    const int tid = threadIdx.x, wid = __builtin_amdgcn_readfirstlane(tid >> 6), lane = tid & 63, wr = wid >> 2, wc = wid & 3, fr = lane & 15, fq = lane >> 4;
    const int K = g.K, nt = K / BK;
    unsigned voffA[2], voffB[2];
#pragma unroll
    for (int i = 0; i < 2; ++i) { int R, C; stage_rc(tid * 16 + i * 8192, R, C); const int Rb = Epi::PERM ? ((R & ~31) + perm32(R & 31)) : R;
        voffA[i] = (unsigned)(R * K + C) * 2u; voffB[i] = (unsigned)(Rb * K + C) * 2u; }
    const size_t kstep = (size_t)(BK * 2);
    const size_t hstep = (size_t)HALF * K * 2;
    const size_t tstep = 2 * hstep;
    const unsigned ldsw = (unsigned)wid * 1024u;
    const int aoff = lds_byte(wr * 64 + fr, fq * 8), boff = lds_byte(wc * 32 + fr, fq * 8);
#define PG8_SA(b, h) (((b) * 2 + (h)) * HTB)
#define PG8_SB(b, h) ((4 + (b) * 2 + (h)) * HTB)
#define PG8_STAGE(bufoff, gbase, voff) do { _Pragma("unroll") for (int _i = 0; _i < 2; ++_i) \
        __builtin_amdgcn_global_load_lds((const unsigned*)((const char*)(gbase) + (voff)[_i]), (PG8_LAS unsigned*)(lds + (bufoff) + ldsw + _i * 8192), 16, 0, 0); } while (0)
#define PG8_LDA(dst, b, h) do { _Pragma("unroll") for (int m = 0; m < 4; ++m) _Pragma("unroll") for (int k = 0; k < 2; ++k) dst[m][k] = *(const PG8_LAS bf16x8*)(lds + PG8_SA(b, h) + aoff + m * 2048 + k * 1024); } while (0)
#define PG8_LDB(dst, b, h) do { _Pragma("unroll") for (int n = 0; n < 2; ++n) _Pragma("unroll") for (int k = 0; k < 2; ++k) dst[n][k] = *(const PG8_LAS bf16x8*)(lds + PG8_SB(b, h) + boff + n * 2048 + k * 1024); } while (0)
#define PG8_MMA(ai, bj, At, Bt) do { __builtin_amdgcn_s_setprio(1); _Pragma("unroll") for (int m = 0; m < 4; ++m) _Pragma("unroll") for (int n = 0; n < 2; ++n) _Pragma("unroll") for (int k = 0; k < 2; ++k) \
        acc[ai][bj][m][n] = __builtin_amdgcn_mfma_f32_16x16x32_bf16(Bt[n][k], At[m][k], acc[ai][bj][m][n], 0, 0, 0); __builtin_amdgcn_s_setprio(0); } while (0)
#define PG8_WAIT_V(n) asm volatile("s_waitcnt vmcnt(" #n ")" ::: "memory")
#define PG8_WAIT_L(n) asm volatile("s_waitcnt lgkmcnt(" #n ")" ::: "memory")
#define PG8_BAR __builtin_amdgcn_s_barrier()
#define PG8_SCHED __builtin_amdgcn_sched_barrier(0)
    Unit cur, nxt; int ui = 0;
    if (!S.next(0, cur)) return;
    f32x4 acc[2][2][4][2];
#pragma unroll
    for (int a = 0; a < 2; ++a)
#pragma unroll
        for (int b = 0; b < 2; ++b)
#pragma unroll
            for (int m = 0; m < 4; ++m)
#pragma unroll
                for (int n = 0; n < 2; ++n) acc[a][b][m][n] = (f32x4){0.f, 0.f, 0.f, 0.f};
    bf16x8 At[4][2], B0[2][2], B1[2][2];
    const char* cA = (const char*)g.A + (size_t)cur.pm * tstep; const char* cB = (const char*)g.Bt + (size_t)cur.pn * tstep;
    S.a_ready(cur);
    if constexpr (SP2) {
        PG8_STAGE(PG8_SB(0, 0), cB, voffB); PG8_STAGE(PG8_SB(0, 1), cB + hstep, voffB); PG8_STAGE(PG8_SA(0, 0), cA, voffA); PG8_STAGE(PG8_SA(0, 1), cA + hstep, voffA);
        if (wr == 1) PG8_BAR;
        PG8_WAIT_V(2); PG8_BAR;
        PG8_STAGE(PG8_SB(1, 0), cB + kstep, voffB); PG8_STAGE(PG8_SA(1, 0), cA + kstep, voffA); PG8_STAGE(PG8_SB(1, 1), cB + hstep + kstep, voffB);
        PG8_WAIT_V(6); PG8_BAR;
    } else {
        PG8_STAGE(PG8_SB(0, 0), cB, voffB); PG8_STAGE(PG8_SA(0, 0), cA, voffA); PG8_STAGE(PG8_SB(0, 1), cB + hstep, voffB); PG8_STAGE(PG8_SA(0, 1), cA + hstep, voffA);
        if (wr == 1) PG8_BAR;
        PG8_WAIT_V(4); PG8_BAR;
        PG8_STAGE(PG8_SB(1, 0), cB + kstep, voffB); PG8_STAGE(PG8_SA(1, 0), cA + kstep, voffA); PG8_STAGE(PG8_SB(1, 1), cB + hstep + kstep, voffB);
        PG8_WAIT_V(6); PG8_BAR;
    }
    for (;;) {
        const bool has_next = S.next(ui + 1, nxt);
        const char* nA = has_next ? (const char*)g.A + (size_t)nxt.pm * tstep : cA; const char* nB = has_next ? (const char*)g.Bt + (size_t)nxt.pn * tstep : cB;
        for (int t = 0; t < nt; t += 2) {
            const bool last = (t == nt - 2);
            const char* a1 = cA + (size_t)(t + 1) * kstep;
            const char* a2 = last ? nA : cA + (size_t)(t + 2) * kstep; const char* b2 = last ? nB : cB + (size_t)(t + 2) * kstep;
            const char* a3 = a2 + kstep; const char* b3 = b2 + kstep;
            if (last && has_next) S.a_ready(nxt);
            if constexpr (SP2) {
            PG8_LDB(B0, 0, 0); PG8_LDB(B1, 0, 1); PG8_SCHED; PG8_LDA(At, 0, 0); PG8_STAGE(PG8_SA(1, 1), a1 + hstep, voffA);
            PG8_WAIT_V(8); PG8_WAIT_L(0); PG8_BAR; PG8_MMA(0, 0, At, B0); PG8_MMA(0, 1, At, B1); PG8_BAR; PG8_SCHED;
            PG8_LDA(At, 0, 1); PG8_STAGE(PG8_SB(0, 0), b2, voffB); PG8_STAGE(PG8_SB(0, 1), b2 + hstep, voffB); PG8_STAGE(PG8_SA(0, 0), a2, voffA);
            PG8_WAIT_V(8); PG8_WAIT_L(0); PG8_BAR; PG8_MMA(1, 0, At, B0); PG8_MMA(1, 1, At, B1); PG8_BAR; PG8_SCHED;
            PG8_LDB(B0, 1, 0); PG8_LDB(B1, 1, 1); PG8_SCHED; PG8_LDA(At, 1, 0); PG8_STAGE(PG8_SA(0, 1), a2 + hstep, voffA);
            PG8_WAIT_V(8); PG8_WAIT_L(0); PG8_BAR; PG8_MMA(0, 0, At, B0); PG8_MMA(0, 1, At, B1); PG8_BAR; PG8_SCHED;
            PG8_LDA(At, 1, 1); PG8_STAGE(PG8_SB(1, 0), b3, voffB); PG8_STAGE(PG8_SB(1, 1), b3 + hstep, voffB); PG8_STAGE(PG8_SA(1, 0), a3, voffA);
            PG8_WAIT_V(8); PG8_WAIT_L(0); PG8_BAR; PG8_MMA(1, 0, At, B0); PG8_MMA(1, 1, At, B1); PG8_BAR; PG8_SCHED;
            } else {
            PG8_LDB(B0, 0, 0); PG8_SCHED; PG8_LDA(At, 0, 0); PG8_STAGE(PG8_SA(1, 1), a1 + hstep, voffA);
            PG8_WAIT_L(8); PG8_BAR; PG8_WAIT_L(0); PG8_MMA(0, 0, At, B0); PG8_BAR; PG8_SCHED;
            PG8_LDB(B1, 0, 1); PG8_STAGE(PG8_SB(0, 0), b2, voffB);
            PG8_BAR; PG8_WAIT_L(0); PG8_MMA(0, 1, At, B1); PG8_BAR;
            PG8_LDA(At, 0, 1); PG8_STAGE(PG8_SA(0, 0), a2, voffA);
            PG8_BAR; PG8_WAIT_L(0); PG8_MMA(1, 0, At, B0); PG8_BAR; PG8_SCHED;
            PG8_STAGE(PG8_SB(0, 1), b2 + hstep, voffB);
            PG8_WAIT_V(6); PG8_BAR; PG8_MMA(1, 1, At, B1); PG8_BAR;
            PG8_LDB(B0, 1, 0); PG8_SCHED; PG8_LDA(At, 1, 0); PG8_STAGE(PG8_SA(0, 1), a2 + hstep, voffA);
            PG8_WAIT_L(8); PG8_BAR; PG8_WAIT_L(0); PG8_MMA(0, 0, At, B0); PG8_BAR; PG8_SCHED;
            PG8_LDB(B1, 1, 1); PG8_STAGE(PG8_SB(1, 0), b3, voffB);
            PG8_BAR; PG8_WAIT_L(0); PG8_MMA(0, 1, At, B1); PG8_BAR;
            PG8_LDA(At, 1, 1); PG8_STAGE(PG8_SA(1, 0), a3, voffA);
            PG8_BAR; PG8_WAIT_L(0); PG8_MMA(1, 0, At, B0); PG8_BAR; PG8_SCHED;
            PG8_STAGE(PG8_SB(1, 1), b3 + hstep, voffB);
            PG8_WAIT_V(6); PG8_BAR; PG8_MMA(1, 1, At, B1); PG8_BAR;
            }
        }
        if constexpr (ALIGN_EPI) { if (wr == 0) PG8_BAR; }
        if constexpr (!Epi::AFTER_DRAIN) { E(acc, cur, wr, wc, fr, fq); S.done(cur); }
        if (!has_next) break;
#pragma unroll
        for (int a = 0; a < 2; ++a)
#pragma unroll
            for (int b = 0; b < 2; ++b)
#pragma unroll
                for (int m = 0; m < 4; ++m)
#pragma unroll
                    for (int n = 0; n < 2; ++n) acc[a][b][m][n] = (f32x4){0.f, 0.f, 0.f, 0.f};
        cur = nxt; cA = nA; cB = nB; ++ui;
        if constexpr (ALIGN_EPI) { if (wr == 1) PG8_BAR; }
    }
    PG8_WAIT_V(0);
    if constexpr (!ALIGN_EPI) { if (wr == 0) PG8_BAR; }
    PG8_BAR;
    if constexpr (Epi::AFTER_DRAIN) { E.fused(acc, cur, wr, wc, fr, fq, lds, wid, lane); S.done(cur); }
#undef PG8_SA
#undef PG8_SB
#undef PG8_STAGE
#undef PG8_LDA
#undef PG8_LDB
#undef PG8_MMA
#undef PG8_WAIT_V
#undef PG8_WAIT_L
#undef PG8_BAR
#undef PG8_SCHED
}
}

constexpr int NWAVES = 8;
constexpr int D_MODEL = 4096, SEQ = 8192, DEC_SEQ = 16;
constexpr int M_PROMPT = 16384, M_REAL = 16512, MPAD = 16640;
constexpr int IN_W = 14816, IN_WP = 14848, D_FF = 11008;
constexpr int PC_Q = 0, PC_K = 2048, PC_V = 4096, PC_Z = 6144, PC_B = 8192, PC_A = 8208, PC_RW = 8224;
constexpr int RW_R = 0, RW_K = 2048, RW_V = 4096, RW_XW = 6144, RW_XA = 6240, RW_XG = 6336, RW_SHIFT_W = 6592;
constexpr float NORM_EPS = 1e-6f, RW_GN_EPS = 64e-5f;
constexpr size_t O_Y = 0, O_SDN_P = 67633152, O_CONV_P = 68157440, O_SRW_P = 68194304, O_SHIFT_P = 68456448,
                 O_SDN_S = 68469632, O_CONV_S = 70566784, O_SRW_S = 70714240, O_SHIFT_S = 71762816, O_END = 71815552;
constexpr size_t MiB = 1u << 20;
constexpr size_t WS_CTL = 0, CTL_ZERO_BYTES = 1 * MiB;
constexpr size_t WS_SSQ = 2 * MiB;
constexpr size_t WS_W2T = 6553600, WS_A2T = 6946816, WS_G2T = 7 * MiB;
constexpr size_t WS_WOUT = 8 * MiB;
constexpr size_t WS_HBUF = 40 * MiB;
constexpr size_t WS_PROJ = 170 * MiB;
constexpr size_t WS_WIN = 642 * MiB;
constexpr size_t WS_WGU = 758 * MiB;
constexpr size_t WS_WDN = 930 * MiB;
constexpr size_t WS_END = 1016 * MiB;
constexpr size_t WS_DNQK = 642 * MiB, WS_DNGL = 674 * MiB, WS_RWSB = 675 * MiB, WS_RWOO = 678 * MiB, WS_RWPQ = 758 * MiB, WS_RWRP = 886 * MiB;
static_assert(WS_SSQ + (size_t)MPAD * 64 * 4 <= WS_WOUT && WS_HBUF + (size_t)MPAD * 4096 * 2 <= WS_PROJ && WS_PROJ + (size_t)MPAD * IN_WP * 2 <= WS_WIN &&
              WS_WIN + (size_t)IN_WP * 4096 * 2 <= WS_WGU && WS_WGU + (size_t)2 * D_FF * 4096 * 2 <= WS_WDN && WS_WDN + (size_t)4096 * D_FF * 2 <= WS_END, "d_ws map");
constexpr int CW_BAR = 4096;
constexpr int RING_OFF = 0, RING_BYTES = 131072;
constexpr int LDSCTL_OFF = RING_BYTES, MISC_OFF = LDSCTL_OFF + 320;
constexpr int LDS_BYTES = 147456;

#define GAS __attribute__((address_space(1)))
#define LAS __attribute__((address_space(3)))
typedef unsigned short bf16;
typedef unsigned v4u __attribute__((ext_vector_type(4)));
typedef unsigned v2u __attribute__((ext_vector_type(2)));
typedef float f32x4 __attribute__((ext_vector_type(4)));
typedef GAS unsigned gu32;
#define RLX_AGENT __ATOMIC_RELAXED, __HIP_MEMORY_SCOPE_AGENT
#define LDS_WAIT() asm volatile("s_waitcnt lgkmcnt(0)" ::: "memory")
__device__ __forceinline__ unsigned f2bf(float f) { unsigned u = __builtin_bit_cast(unsigned, f); return (u + 0x7fffu + ((u >> 16) & 1u)) >> 16; }
__device__ __forceinline__ unsigned pk2(float lo, float hi) { return f2bf(lo) | (f2bf(hi) << 16); }
__device__ __forceinline__ float bf2f(bf16 b) { return __builtin_bit_cast(float, (unsigned)b << 16); }
__device__ __forceinline__ float wave_sum(float v) {
#pragma unroll
    for (int o = 1; o < 64; o <<= 1) v += __shfl_xor(v, o);
    return v;
}
__device__ __forceinline__ float sigmoid_f(float x) { return 1.0f / (1.0f + __expf(-x)); }
__device__ __forceinline__ float softplus_f(float x) { return x > 20.f ? x : log1pf(__expf(x)); }

#define XB_TMO      128
#define XB_XCNT(j)  (256  + 64 * (j))
#define XB_XSUB(j)  (1280 + 64 * (j))
#define XB_XGEN(j)  (2304 + 64 * (j))
#define XB_TOP      3328
#define XB_TOPGEN   3392
#define XCD_BAR_WORDS 3456
#define XB_SPIN_CAP (1u << 18)

__device__ __forceinline__ unsigned xb_ld(unsigned* p)              { return __hip_atomic_load(p, __ATOMIC_RELAXED, __HIP_MEMORY_SCOPE_AGENT); }
__device__ __forceinline__ unsigned xb_add(unsigned* p, unsigned v) { return __hip_atomic_fetch_add(p, v, __ATOMIC_RELAXED, __HIP_MEMORY_SCOPE_AGENT); }
__device__ __forceinline__ unsigned xb_xcc_id() { return (unsigned)__builtin_amdgcn_s_getreg((3 << 11) | 20) & 0xFu; }
#define XB_SPIN(cond, bar) do { unsigned _sp = 0; while (cond) { __builtin_amdgcn_s_sleep(1); \
    if ((++_sp & 255u) == 0u) { if (xb_ld(&(bar)[XB_TMO])) break; if (_sp > XB_SPIN_CAP) { atomicAdd(&(bar)[XB_TMO], 1u); break; } } } } while (0)

struct XcdBarrier {
    unsigned* bar; unsigned x;
    volatile LAS unsigned* st;
};

__device__ __forceinline__ XcdBarrier xcd_barrier_post(unsigned* bar, volatile LAS unsigned* st) {
    XcdBarrier b; b.bar = bar; b.x = xb_xcc_id(); b.st = st;
    if (threadIdx.x == 0) (void)xb_add(&bar[XB_XCNT(b.x)], 1u);
    return b;
}
__device__ __forceinline__ void xcd_barrier_complete(unsigned* bar, unsigned x, unsigned& nloc, unsigned& nx) {
    const unsigned G = gridDim.x * gridDim.y * gridDim.z;
    unsigned sum, cnt, mine, sp = 0u;
    for (;;) {
        sum = 0u; cnt = 0u; mine = 0u;
#pragma unroll
        for (unsigned j = 0; j < 16; ++j) { const unsigned c = xb_ld(&bar[XB_XCNT(j)]); sum += c; cnt += (c > 0u) ? 1u : 0u; mine = (j == x) ? c : mine; }
        if (sum == G) break;
        __builtin_amdgcn_s_sleep(1);
        if ((++sp & 255u) == 0u) { if (xb_ld(&bar[XB_TMO])) break; if (sp > XB_SPIN_CAP) { atomicAdd(&bar[XB_TMO], 1u); break; } }
    }
    nloc = mine > 0u ? mine : 1u; nx = cnt > 0u ? cnt : 1u;
}

__device__ __forceinline__ void xcd_barrier(const XcdBarrier& b) {
    asm volatile("s_waitcnt vmcnt(0)" ::: "memory");
    __syncthreads();
    if (threadIdx.x == 0) {
        unsigned* bar = b.bar;
        __builtin_amdgcn_s_waitcnt(0);
        unsigned nloc = b.st[0], nx = b.st[1];
        if (nloc == 0u) { xcd_barrier_complete(bar, b.x, nloc, nx); b.st[0] = nloc; b.st[1] = nx; }
        const unsigned old = xb_add(&bar[XB_XSUB(b.x)], 1u);
        const unsigned gen = old / nloc;
        if (old + 1u == (gen + 1u) * nloc) {
            __builtin_amdgcn_fence(__ATOMIC_RELEASE, "agent");
            asm volatile("s_waitcnt vmcnt(0)" ::: "memory");
            const unsigned og = xb_add(&bar[XB_TOP], 1u);
            const unsigned tg = og / nx;
            if (og + 1u == (tg + 1u) * nx) xb_add(&bar[XB_TOPGEN], 1u);
            else XB_SPIN(xb_ld(&bar[XB_TOPGEN]) == tg, bar);
            __builtin_amdgcn_fence(__ATOMIC_ACQUIRE, "agent");
            xb_add(&bar[XB_XGEN(b.x)], 1u);
            asm volatile("s_waitcnt vmcnt(0)" ::: "memory");
        } else {
            XB_SPIN(xb_ld(&bar[XB_XGEN(b.x)]) == gen, bar);
            __builtin_amdgcn_fence(__ATOMIC_ACQUIRE, "agent");
            asm volatile("s_waitcnt vmcnt(0)" ::: "memory");
        }
    }
    __syncthreads();
}

struct Frame {
    LAS unsigned char* lds;
    volatile LAS unsigned* MISC;
    gu32* ctl;
    int tid, lane, wave, G;
    const float* const* in;
};
struct Args { const float* in[30]; float* out; unsigned char* ws; int ph_lo, ph_hi; };

template <class RowMap>
__device__ __forceinline__ void p0_transpose_item(const float* W, int K, int N, bf16* WT, LAS float* scr, int item, int lane, RowMap rm) {
    const int nblk = N / 32, kb = item / nblk, nb = item % nblk, k0 = 64 * kb, n0 = 32 * nb;
#pragma unroll 8
    for (int i = 0; i < 32; ++i) { const int kk = 2 * i + (lane >> 5); scr[kk * 33 + (lane & 31)] = W[(size_t)(k0 + kk) * N + n0 + (lane & 31)]; }
    LDS_WAIT(); asm volatile("" ::: "memory");
    const int c = lane & 7;
#pragma unroll
    for (int j = 0; j < 4; ++j) { const int n = (lane >> 3) + 8 * j; const LAS float* s = scr + (8 * c) * 33 + n;
        v4u o; o.x = pk2(s[0 * 33], s[1 * 33]); o.y = pk2(s[2 * 33], s[3 * 33]); o.z = pk2(s[4 * 33], s[5 * 33]); o.w = pk2(s[6 * 33], s[7 * 33]);
        *(GAS v4u*)(WT + (size_t)rm(n0 + n) * K + k0 + 8 * c) = o; }
    LDS_WAIT(); asm volatile("" ::: "memory");
}
struct RmId { __device__ __forceinline__ int operator()(int n) const { return n; } };
struct RmGU { int up; __device__ __forceinline__ int operator()(int n) const { return (n >> 7) * 256 + up * 128 + (n & 127); } };

__device__ __forceinline__ void rms_row_to_bf16(const f32x4 (&v)[16], const float* g, bf16* orow, int lane) {
    float s = 0.f;
#pragma unroll
    for (int j = 0; j < 16; ++j) s += (v[j].x * v[j].x + v[j].y * v[j].y) + (v[j].z * v[j].z + v[j].w * v[j].w);
    const float rstd = 1.0f / sqrtf(wave_sum(s) * (1.f / 4096.f) + NORM_EPS);
    const GAS f32x4* gr = (const GAS f32x4*)g + lane; GAS v2u* o8 = (GAS v2u*)orow + lane;
#pragma unroll
    for (int j = 0; j < 16; ++j) { const f32x4 gv = gr[64 * j]; v2u o; o.x = pk2(v[j].x * rstd * gv.x, v[j].y * rstd * gv.y); o.y = pk2(v[j].z * rstd * gv.z, v[j].w * rstd * gv.w); o8[64 * j] = o; }
}

struct MixPtrs {
    const bf16* proj; bf16* mix;
    const float *state_dn, *cache_conv, *state_rw, *cache_shift;
    const float *conv_w, *a_log, *dt_bias, *dn_norm_w;
    const float *mu, *w0, *w2, *a0, *a2, *g2, *k_k, *k_a, *r_k, *ln_w, *ln_b;
    float* out;
};
__device__ __forceinline__ void dn_seq_item(const MixPtrs& P, LAS unsigned char* lds, int seq, int h, int tid, int lane, int wave) {
    const bool prm = seq < 2;
    const int T = prm ? SEQ : DEC_SEQ, sb = prm ? seq : seq - 2;
    const int m0 = prm ? seq * SEQ : M_PROMPT + sb * DEC_SEQ;
    const float* S0 = prm ? nullptr : P.state_dn + ((size_t)sb * 16 + h) * 16384;
    const float* cbuf = prm ? nullptr : P.cache_conv + (size_t)sb * 3 * 6144;
    float* Sout = P.out + (prm ? O_SDN_P : O_SDN_S) + ((size_t)sb * 16 + h) * 16384;
    float* cout = P.out + (prm ? O_CONV_P : O_CONV_S) + (size_t)sb * 3 * 6144;
    LAS float* qs = (LAS float*)lds; LAS float* ks = qs + 2048; LAS float* vs = ks + 2048; LAS float* zs = vs + 2048; LAS float* os = zs + 2048; LAS float* bet = os + 2048; LAS float* gg = bet + 16;
    float S[32];
    const int e = wave * 16 + (lane >> 2), dq = lane & 3;
#pragma unroll
    for (int j = 0; j < 32; ++j) S[j] = (S0 != nullptr) ? S0[(32 * dq + j) * 128 + e] : 0.f;
    const float Ah = -__expf(P.a_log[h]), dtb = P.dt_bias[h];
    for (int tb = 0; tb < T; tb += 16) {
        for (int i = tid; i < 16 * 384; i += 512) { const int t = i / 384, cc = i - t * 384, sec = cc >> 7, d = cc & 127, col = sec * 2048 + h * 128 + d;
            float acc = 0.f;
#pragma unroll
            for (int j = 0; j < 4; ++j) { const int tt = tb + t - 3 + j; float xv;
                if (tt >= 0) xv = bf2f(P.proj[(size_t)(m0 + tt) * IN_WP + col]); else xv = cbuf ? cbuf[(3 + tt) * 6144 + col] : 0.f;
                acc += xv * P.conv_w[j * 6144 + col]; }
            const float y = acc * sigmoid_f(acc);
            (sec == 0 ? qs : (sec == 1 ? ks : vs))[t * 128 + d] = y; }
        for (int i = tid; i < 16 * 128; i += 512) { const int t = i >> 7, d = i & 127; zs[i] = bf2f(P.proj[(size_t)(m0 + tb + t) * IN_WP + PC_Z + h * 128 + d]); }
        if (tid < 16) { const size_t r = (size_t)(m0 + tb + tid) * IN_WP; const float b = bf2f(P.proj[r + PC_B + h]), a = bf2f(P.proj[r + PC_A + h]);
            bet[tid] = sigmoid_f(b); gg[tid] = Ah * softplus_f(a + dtb); }
        __syncthreads();
#pragma unroll
        for (int r = 0; r < 2; ++r) { const int t = 2 * wave + r;
            const float q0 = qs[t * 128 + lane], q1 = qs[t * 128 + 64 + lane], k0 = ks[t * 128 + lane], k1 = ks[t * 128 + 64 + lane];
            const float sq = wave_sum(q0 * q0 + q1 * q1), sk = wave_sum(k0 * k0 + k1 * k1);
            const float cq = 0.08838834764831845f / sqrtf(sq + 1e-6f), ck = 1.0f / sqrtf(sk + 1e-6f);
            qs[t * 128 + lane] = q0 * cq; qs[t * 128 + 64 + lane] = q1 * cq; ks[t * 128 + lane] = k0 * ck; ks[t * 128 + 64 + lane] = k1 * ck; }
        __syncthreads();
        {
#pragma unroll 1
            for (int t = 0; t < 16; ++t) {
                const float eg = __expf(gg[t]), bt = bet[t];
                float kS = 0.f;
#pragma unroll
                for (int d4 = 0; d4 < 8; ++d4) { const f32x4 kv = *(const LAS f32x4*)(ks + t * 128 + 32 * dq + 4 * d4);
                    kS += kv.x * S[4 * d4] + kv.y * S[4 * d4 + 1] + kv.z * S[4 * d4 + 2] + kv.w * S[4 * d4 + 3]; }
                kS += __shfl_xor(kS, 1); kS += __shfl_xor(kS, 2);
                const float w = bt * (vs[t * 128 + e] - eg * kS);
                float o = 0.f;
#pragma unroll
                for (int d4 = 0; d4 < 8; ++d4) { const f32x4 kv = *(const LAS f32x4*)(ks + t * 128 + 32 * dq + 4 * d4); const f32x4 qv = *(const LAS f32x4*)(qs + t * 128 + 32 * dq + 4 * d4);
                    S[4 * d4] = eg * S[4 * d4] + kv.x * w; S[4 * d4 + 1] = eg * S[4 * d4 + 1] + kv.y * w; S[4 * d4 + 2] = eg * S[4 * d4 + 2] + kv.z * w; S[4 * d4 + 3] = eg * S[4 * d4 + 3] + kv.w * w;
                    o += qv.x * S[4 * d4] + qv.y * S[4 * d4 + 1] + qv.z * S[4 * d4 + 2] + qv.w * S[4 * d4 + 3]; }
                o += __shfl_xor(o, 1); o += __shfl_xor(o, 2);
                if (dq == 0) os[t * 128 + e] = o;
            }
        }
        __syncthreads();
#pragma unroll
        for (int r = 0; r < 2; ++r) { const int t = 2 * wave + r;
            const float o0 = os[t * 128 + lane], o1 = os[t * 128 + 64 + lane];
            const float rs = 1.0f / sqrtf(wave_sum(o0 * o0 + o1 * o1) * (1.f / 128.f) + NORM_EPS);
            const float z0 = zs[t * 128 + lane], z1 = zs[t * 128 + 64 + lane];
            bf16* mp = P.mix + (size_t)(m0 + tb + t) * 4096 + h * 128;
            mp[lane] = (bf16)f2bf(o0 * rs * P.dn_norm_w[lane] * (z0 * sigmoid_f(z0))); mp[64 + lane] = (bf16)f2bf(o1 * rs * P.dn_norm_w[64 + lane] * (z1 * sigmoid_f(z1))); }
        __syncthreads();
    }
#pragma unroll
    for (int j = 0; j < 32; ++j) Sout[(32 * dq + j) * 128 + e] = S[j];
    for (int i = tid; i < 3 * 384; i += 512) { const int r = i / 384, cc = i - r * 384, col = (cc >> 7) * 2048 + h * 128 + (cc & 127);
        cout[r * 6144 + col] = bf2f(P.proj[(size_t)(m0 + T - 3 + r) * IN_WP + col]); }
}
__device__ __forceinline__ void rw_seq_item(const MixPtrs& P, LAS unsigned char* lds, int seq, int h, int tid, int lane, int wave) {
    const bool prm = seq < 2;
    const int T = prm ? SEQ : DEC_SEQ, sb = prm ? seq : seq - 2;
    const int m0 = prm ? seq * SEQ : M_PROMPT + sb * DEC_SEQ;
    const float* S0 = prm ? nullptr : P.state_rw + ((size_t)sb * 32 + h) * 4096;
    const float* sbuf = prm ? nullptr : P.cache_shift + (size_t)sb * RW_SHIFT_W;
    float* Sout = P.out + (prm ? O_SRW_P : O_SRW_S) + ((size_t)sb * 32 + h) * 4096;
    float* shout = P.out + (prm ? O_SHIFT_P : O_SHIFT_S) + (size_t)sb * RW_SHIFT_W;
    LAS float* rs = (LAS float*)lds; LAS float* kr = rs + 1024; LAS float* vs = kr + 1024; LAS float* xw = vs + 1024; LAS float* xa = xw + 1536; LAS float* xg = xa + 1536;
    LAS float* wd = xg + 4096; LAS float* kp = wd + 1024; LAS float* av = kp + 1024; LAS float* bv = av + 1024; LAS float* gt = bv + 1024; LAS float* ys = gt + 1024; LAS float* sbn = ys + 1024;
    float S[16];
    const int vr = (wave & 3) * 16 + (lane >> 2), kq = lane & 3;
#pragma unroll
    for (int k4 = 0; k4 < 4; ++k4) { f32x4 v = (f32x4){0.f, 0.f, 0.f, 0.f}; if (S0 != nullptr) v = *(const f32x4*)(S0 + vr * 64 + 16 * kq + 4 * k4);
        S[4 * k4] = v.x; S[4 * k4 + 1] = v.y; S[4 * k4 + 2] = v.z; S[4 * k4 + 3] = v.w; }
    const int hc = h * 64 + lane;
    const float w0c = P.w0[hc], a0c = P.a0[hc], kkc = P.k_k[hc], kac = P.k_a[hc], rkc = P.r_k[hc], lnw = P.ln_w[hc], lnb = P.ln_b[hc];
    for (int tb = 0; tb < T; tb += 16) {
        for (int i = tid; i < 16 * 640; i += 512) { const int t = i / 640, cc = i - t * 640; int col; LAS float* dst; int kind = 0;
            if (cc < 64) { col = RW_R + h * 64 + cc; dst = rs + t * 64 + cc; }
            else if (cc < 128) { col = RW_K + h * 64 + (cc - 64); dst = kr + t * 64 + (cc - 64); }
            else if (cc < 192) { col = RW_V + h * 64 + (cc - 128); dst = vs + t * 64 + (cc - 128); }
            else if (cc < 288) { col = RW_XW + (cc - 192); dst = xw + t * 96 + (cc - 192); kind = 1; }
            else if (cc < 384) { col = RW_XA + (cc - 288); dst = xa + t * 96 + (cc - 288); }
            else { col = RW_XG + (cc - 384); dst = xg + t * 256 + (cc - 384); kind = 2; }
            const int tt = tb + t; const float u = bf2f(P.proj[(size_t)(m0 + tt) * IN_WP + PC_RW + col]);
            const float up = tt > 0 ? bf2f(P.proj[(size_t)(m0 + tt - 1) * IN_WP + PC_RW + col]) : (sbuf ? sbuf[col] : 0.f);
            float v = u + P.mu[col] * (up - u);
            if (kind == 1) v = tanhf(v); else if (kind == 2) v = sigmoid_f(v);
            *dst = v; }
        __syncthreads();
        {
            float wl0 = 0.f, wl1 = 0.f, al0 = 0.f, al1 = 0.f, gl0 = 0.f, gl1 = 0.f; const int t0 = wave, t1 = wave + 8;
#pragma unroll 4
            for (int j = 0; j < 96; ++j) { const float w2v = P.w2[j * 2048 + hc], a2v = P.a2[j * 2048 + hc];
                wl0 += xw[t0 * 96 + j] * w2v; wl1 += xw[t1 * 96 + j] * w2v; al0 += xa[t0 * 96 + j] * a2v; al1 += xa[t1 * 96 + j] * a2v; }
#pragma unroll 4
            for (int j = 0; j < 256; ++j) { const float g2v = P.g2[j * 2048 + hc]; gl0 += xg[t0 * 256 + j] * g2v; gl1 += xg[t1 * 256 + j] * g2v; }
#pragma unroll
            for (int r = 0; r < 2; ++r) { const int t = r ? t1 : t0; const float wl = r ? wl1 : wl0, al = r ? al1 : al0, gl = r ? gl1 : gl0;
                const float wlog = -softplus_f(-(w0c + wl)) - 0.5f; const float wdec = __expf(-__expf(wlog));
                const float a = sigmoid_f(a0c + al);
                const float krv = kr[t * 64 + lane], kkr = krv * kkc; const float kk = kkr / sqrtf(wave_sum(kkr * kkr) + 1e-6f);
                const float kpv = krv * (1.0f + (a - 1.0f) * kac);
                const float sbv = wave_sum(rs[t * 64 + lane] * kpv * rkc);
                wd[t * 64 + lane] = wdec; kp[t * 64 + lane] = kpv; av[t * 64 + lane] = -kk; bv[t * 64 + lane] = kk * a; gt[t * 64 + lane] = gl; if (lane == 0) sbn[t] = sbv; }
        }
        __syncthreads();
        if (wave < 4) {
#pragma unroll 1
            for (int t = 0; t < 16; ++t) {
                float sa = 0.f;
#pragma unroll
                for (int k4 = 0; k4 < 4; ++k4) { const f32x4 a4 = *(const LAS f32x4*)(av + t * 64 + 16 * kq + 4 * k4); sa += a4.x * S[4 * k4] + a4.y * S[4 * k4 + 1] + a4.z * S[4 * k4 + 2] + a4.w * S[4 * k4 + 3]; }
                sa += __shfl_xor(sa, 1); sa += __shfl_xor(sa, 2);
                const float vv = vs[t * 64 + vr]; float y = 0.f;
#pragma unroll
                for (int k4 = 0; k4 < 4; ++k4) { const int o4 = t * 64 + 16 * kq + 4 * k4;
                    const f32x4 w4 = *(const LAS f32x4*)(wd + o4), b4 = *(const LAS f32x4*)(bv + o4), k4v = *(const LAS f32x4*)(kp + o4), r4 = *(const LAS f32x4*)(rs + o4);
                    S[4 * k4] = S[4 * k4] * w4.x + sa * b4.x + vv * k4v.x; S[4 * k4 + 1] = S[4 * k4 + 1] * w4.y + sa * b4.y + vv * k4v.y;
                    S[4 * k4 + 2] = S[4 * k4 + 2] * w4.z + sa * b4.z + vv * k4v.z; S[4 * k4 + 3] = S[4 * k4 + 3] * w4.w + sa * b4.w + vv * k4v.w;
                    y += r4.x * S[4 * k4] + r4.y * S[4 * k4 + 1] + r4.z * S[4 * k4 + 2] + r4.w * S[4 * k4 + 3]; }
                y += __shfl_xor(y, 1); y += __shfl_xor(y, 2);
                if (kq == 0) ys[t * 64 + vr] = y;
            }
        }
        __syncthreads();
#pragma unroll
        for (int r = 0; r < 2; ++r) { const int t = wave + 8 * r; const float y = ys[t * 64 + lane];
            const float mean = wave_sum(y) * (1.f / 64.f); const float dy = y - mean; const float var = wave_sum(dy * dy) * (1.f / 64.f);
            const float yn = dy / sqrtf(var + RW_GN_EPS) * lnw + lnb;
            P.mix[(size_t)(m0 + tb + t) * 4096 + 2048 + hc] = (bf16)f2bf((yn + sbn[t] * vs[t * 64 + lane]) * gt[t * 64 + lane]); }
        __syncthreads();
    }
    if (wave < 4) {
#pragma unroll
        for (int k4 = 0; k4 < 4; ++k4) *(f32x4*)(Sout + vr * 64 + 16 * kq + 4 * k4) = (f32x4){S[4 * k4], S[4 * k4 + 1], S[4 * k4 + 2], S[4 * k4 + 3]};
    }
    for (int i = tid; i < 206; i += 512) { const int col = h * 206 + i; shout[col] = bf2f(P.proj[(size_t)(m0 + T - 1) * IN_WP + PC_RW + col]); }
}

typedef short bf16x8 __attribute__((ext_vector_type(8)));
typedef float f32x16 __attribute__((ext_vector_type(16)));
typedef __bf16 bf16x2_t __attribute__((ext_vector_type(2)));
typedef float f32x2_t __attribute__((ext_vector_type(2)));
__device__ __forceinline__ unsigned cvt2(float lo, float hi) { f32x2_t v = {lo, hi}; return __builtin_bit_cast(unsigned, __builtin_convertvector(v, bf16x2_t)); }
__device__ __forceinline__ float bflo(unsigned u) { return __builtin_bit_cast(float, u << 16); }
__device__ __forceinline__ float bfhi(unsigned u) { return __builtin_bit_cast(float, u & 0xffff0000u); }
#define MFMA16(a, b, c) __builtin_amdgcn_mfma_f32_16x16x32_bf16((a), (b), (c), 0, 0, 0)
#define MFMA32(a, b, c) __builtin_amdgcn_mfma_f32_32x32x16_bf16((a), (b), (c), 0, 0, 0)
__device__ __forceinline__ bf16x8 pack_step(const f32x16& x, int s) {
    v4u p; p.x = cvt2(x[8 * s], x[8 * s + 1]); p.y = cvt2(x[8 * s + 2], x[8 * s + 3]); p.z = cvt2(x[8 * s + 4], x[8 * s + 5]); p.w = cvt2(x[8 * s + 6], x[8 * s + 7]);
    return __builtin_bit_cast(bf16x8, p);
}
struct DnRec { unsigned char* rec; unsigned char* qk; float* gl; };
constexpr int DP_QN = 0, DP_KN = 17408, DP_VBT = 34816, DP_KBGT = 53248, DP_LM = 71680, DP_TM = 88320, DP_TB = 104960, DP_DINV = 114176, DP_YB = 118528, DP_SC = 122688;

__device__ __forceinline__ void dn_prep_item(const MixPtrs& P, const DnRec& R, LAS unsigned char* lds, int b, int c, int h, int tid, int lane, int wave) {
    const int m0 = b * SEQ + 64 * c; const int item = (b * 128 + c) * 16 + h;
    LAS bf16* Qn = (LAS bf16*)(lds + DP_QN); LAS bf16* Kn = (LAS bf16*)(lds + DP_KN); LAS bf16* VbT = (LAS bf16*)(lds + DP_VBT); LAS bf16* KbgT = (LAS bf16*)(lds + DP_KBGT);
    LAS float* Lm = (LAS float*)(lds + DP_LM); LAS float* Tm = (LAS float*)(lds + DP_TM); LAS bf16* Tb = (LAS bf16*)(lds + DP_TB); LAS float* Dinv = (LAS float*)(lds + DP_DINV); LAS float* Yb = (LAS float*)(lds + DP_YB);
    LAS float* sc = (LAS float*)(lds + DP_SC); LAS float* beta = sc; LAS float* gc = sc + 64; LAS float* egc = sc + 128; LAS float* ekd = sc + 192;
    unsigned char* rec = R.rec + (size_t)item * 65536; unsigned char* qkr = R.qk + (size_t)item * 8192;
    if (wave == 0) { const int t = lane; const size_t r = (size_t)(m0 + t) * IN_WP; const float bb = bf2f(P.proj[r + PC_B + h]), aa = bf2f(P.proj[r + PC_A + h]);
        const float Ah = -__expf(P.a_log[h]), dtb = P.dt_bias[h];
        float x = Ah * softplus_f(aa + dtb);
#pragma unroll
        for (int o = 1; o < 64; o <<= 1) { const float v = __shfl_up(x, o); if (lane >= o) x += v; }
        const float gl = __shfl(x, 63);
        beta[t] = sigmoid_f(bb); gc[t] = x; egc[t] = __expf(x); ekd[t] = __expf(gl - x); if (lane == 0) R.gl[item] = __expf(gl); }
    __syncthreads();
#pragma unroll
    for (int r = 0; r < 6; ++r) {
        const int sec = r >> 1; const int idx = (tid + 512 * r) & 1023; const int t = idx >> 4, g8 = idx & 15; const int col = sec * 2048 + h * 128 + 8 * g8;
        float acc[8];
#pragma unroll
        for (int i = 0; i < 8; ++i) acc[i] = 0.f;
#pragma unroll
        for (int j = 0; j < 4; ++j) { const int tt = 64 * c + t - 3 + j;
            v4u xv = (v4u){0u, 0u, 0u, 0u}; if (tt >= 0) xv = *(const GAS v4u*)(P.proj + (size_t)(b * SEQ + tt) * IN_WP + col);
            const f32x4 w0 = *(const GAS f32x4*)(P.conv_w + j * 6144 + col), w1 = *(const GAS f32x4*)(P.conv_w + j * 6144 + col + 4);
            acc[0] += bflo(xv.x) * w0.x; acc[1] += bfhi(xv.x) * w0.y; acc[2] += bflo(xv.y) * w0.z; acc[3] += bfhi(xv.y) * w0.w;
            acc[4] += bflo(xv.z) * w1.x; acc[5] += bfhi(xv.z) * w1.y; acc[6] += bflo(xv.w) * w1.z; acc[7] += bfhi(xv.w) * w1.w; }
        float y[8]; float ss = 0.f;
#pragma unroll
        for (int i = 0; i < 8; ++i) { y[i] = acc[i] * sigmoid_f(acc[i]); ss += y[i] * y[i]; }
        if (sec < 2) { ss += __shfl_xor(ss, 1); ss += __shfl_xor(ss, 2); ss += __shfl_xor(ss, 4); ss += __shfl_xor(ss, 8);
            const float scl = (sec == 0 ? 0.08838834764831845f : 1.0f) / sqrtf(ss + 1e-6f);
#pragma unroll
            for (int i = 0; i < 8; ++i) y[i] *= scl; }
        if (sec == 0) { v4u o; o.x = cvt2(y[0], y[1]); o.y = cvt2(y[2], y[3]); o.z = cvt2(y[4], y[5]); o.w = cvt2(y[6], y[7]); *(LAS v4u*)(Qn + t * 136 + 8 * g8) = o; }
        else if (sec == 1) { v4u o; o.x = cvt2(y[0], y[1]); o.y = cvt2(y[2], y[3]); o.z = cvt2(y[4], y[5]); o.w = cvt2(y[6], y[7]); *(LAS v4u*)(Kn + t * 136 + 8 * g8) = o;
            const float f = beta[t] * egc[t];
#pragma unroll
            for (int i = 0; i < 8; ++i) KbgT[(8 * g8 + i) * 72 + t] = (bf16)(cvt2(y[i] * f, 0.f) & 0xffffu); }
        else { const float f = beta[t];
#pragma unroll
            for (int i = 0; i < 8; ++i) VbT[(8 * g8 + i) * 72 + t] = (bf16)(cvt2(y[i] * f, 0.f) & 0xffffu); }
    }
    __syncthreads();
    {   const int tt = wave & 3, sp = wave >> 2, l15 = lane & 15, q = lane >> 4;
#pragma unroll
        for (int si = 0; si < 2; ++si) { const int st = 2 * sp + si;
            f32x4 aL = (f32x4){0.f, 0.f, 0.f, 0.f}, aQ = (f32x4){0.f, 0.f, 0.f, 0.f};
#pragma unroll
            for (int ks = 0; ks < 4; ++ks) {
                const bf16x8 fs = *(const LAS bf16x8*)(Kn + (16 * st + l15) * 136 + 32 * ks + 8 * q);
                const bf16x8 ft = *(const LAS bf16x8*)(Kn + (16 * tt + l15) * 136 + 32 * ks + 8 * q);
                const bf16x8 fq = *(const LAS bf16x8*)(Qn + (16 * tt + l15) * 136 + 32 * ks + 8 * q);
                aL = MFMA16(fs, ft, aL); aQ = MFMA16(fs, fq, aQ); }
            const int t = 16 * tt + l15; const float gct = gc[t], bt = beta[t]; float qv[4];
#pragma unroll
            for (int reg = 0; reg < 4; ++reg) { const int s = 16 * st + 4 * q + reg; const float dec = __expf(gct - gc[s]);
                Lm[t * 65 + s] = (t > s) ? bt * aL[reg] * dec : 0.f; qv[reg] = (t >= s) ? aQ[reg] * dec : 0.f; }
            v2u qkp; qkp.x = cvt2(qv[0], qv[1]); qkp.y = cvt2(qv[2], qv[3]);
            *(GAS v2u*)(qkr + ((((t >> 5) * 4 + st) * 64 + (t & 31) + 32 * (q & 1)) * 16 + 8 * (q >> 1))) = qkp;
        }
    }
#pragma unroll
    for (int r = 0; r < 2; ++r) { const int fl = tid + 512 * r; const int ln = fl & 63, ks = (fl >> 6) & 7, mt = fl >> 9;
        const int t = 32 * mt + (ln & 31), d0 = 16 * ks + 4 * (ln >> 5); const float f = egc[t];
        const v2u a = *(const LAS v2u*)(Qn + t * 136 + d0), bq = *(const LAS v2u*)(Qn + t * 136 + d0 + 8);
        v4u o; o.x = cvt2(bflo(a.x) * f, bfhi(a.x) * f); o.y = cvt2(bflo(a.y) * f, bfhi(a.y) * f); o.z = cvt2(bflo(bq.x) * f, bfhi(bq.x) * f); o.w = cvt2(bflo(bq.y) * f, bfhi(bq.y) * f);
        *(GAS v4u*)(rec + 16384 + fl * 16) = o; }
#pragma unroll
    for (int r = 0; r < 2; ++r) { const int fl = tid + 512 * r; const int ln = fl & 63, kt = (fl >> 6) & 3, mtd = fl >> 8;
        const int d = 32 * mtd + (ln & 31), t0 = 16 * kt + 4 * (ln >> 5); float v[8];
#pragma unroll
        for (int j = 0; j < 8; ++j) { const int t = t0 + 8 * (j >> 2) + (j & 3); v[j] = bf2f(Kn[t * 136 + d]) * ekd[t]; }
        v4u o; o.x = cvt2(v[0], v[1]); o.y = cvt2(v[2], v[3]); o.z = cvt2(v[4], v[5]); o.w = cvt2(v[6], v[7]);
        *(GAS v4u*)(rec + 32768 + fl * 16) = o; }
    __syncthreads();
    if (tid < 64) { const int bi = tid >> 4, j = tid & 15; float x[16];
#pragma unroll
        for (int r = 0; r < 16; ++r) { float a = (r == j) ? 1.f : 0.f;
#pragma unroll
            for (int k = 0; k < r; ++k) a -= Lm[(16 * bi + r) * 65 + 16 * bi + k] * x[k];
            x[r] = a; }
#pragma unroll
        for (int r = 0; r < 16; ++r) Dinv[(bi * 16 + r) * 17 + j] = x[r]; }
    __syncthreads();
#pragma unroll 1
    for (int i = 0; i < 4; ++i) {
        if (i > 0) {
            const int w = 16 * i;
            for (int o = tid; o < 16 * w; o += 512) { const int r = o / w, cidx = o - r * w; float a = 0.f;
                for (int k = cidx; k < w; ++k) a -= Lm[(w + r) * 65 + k] * Tm[k * 65 + cidx];
                Yb[r * 65 + cidx] = a; }
            __syncthreads();
        }
        for (int o = tid; o < 1024; o += 512) { const int r = o >> 6, cidx = o & 63; float a = 0.f;
            if (cidx < 16 * i) {
#pragma unroll
                for (int k = 0; k < 16; ++k) a += Dinv[(i * 16 + r) * 17 + k] * Yb[k * 65 + cidx]; }
            else if (cidx < 16 * i + 16) a = Dinv[(i * 16 + r) * 17 + cidx - 16 * i];
            Tm[(16 * i + r) * 65 + cidx] = a; Tb[(16 * i + r) * 72 + cidx] = (bf16)(cvt2(a, 0.f) & 0xffffu); }
        __syncthreads();
    }
    {   const int tt = wave & 3, hf = wave >> 2, l15 = lane & 15, q = lane >> 4;
        bf16x8 tf[2];
#pragma unroll
        for (int ks = 0; ks < 2; ++ks) tf[ks] = *(const LAS bf16x8*)(Tb + (16 * tt + l15) * 72 + 32 * ks + 8 * q);
#pragma unroll
        for (int n = 0; n < 4; ++n) { const int et = 4 * hf + n;
            f32x4 au = (f32x4){0.f, 0.f, 0.f, 0.f}, aw = (f32x4){0.f, 0.f, 0.f, 0.f};
#pragma unroll
            for (int ks = 0; ks < 2; ++ks) { const bf16x8 fv = *(const LAS bf16x8*)(VbT + (16 * et + l15) * 72 + 32 * ks + 8 * q); const bf16x8 fk = *(const LAS bf16x8*)(KbgT + (16 * et + l15) * 72 + 32 * ks + 8 * q);
                au = MFMA16(tf[ks], fv, au);
                aw = MFMA16(fk, tf[ks], aw); }
            v2u up; up.x = cvt2(au[0], au[1]); up.y = cvt2(au[2], au[3]);
            *(GAS v2u*)(rec + 49152 + ((16 * et + l15) * 64 + 16 * tt + 4 * q) * 2) = up;
            const int t = 16 * tt + l15; v2u wp; wp.x = cvt2(aw[0], aw[1]); wp.y = cvt2(aw[2], aw[3]);
            *(GAS v2u*)(rec + ((((t >> 5) * 8 + et) * 64 + (t & 31) + 32 * (q & 1)) * 16 + 8 * (q >> 1))) = wp; }
    }
    __syncthreads();
}

__device__ __forceinline__ void dn_scan(const MixPtrs& P, const DnRec& R, LAS unsigned char* lds, int b, int h, int tid, int lane, int wave) {
    constexpr int SB = 57344; LAS unsigned char* obuf = lds + 2 * SB;
    const int item0 = b * 128 * 16 + h;
    const bool scan = wave < 4; const int ht = tid - 256;
    const int e = 32 * (wave & 3) + (lane & 31), hh = lane >> 5;
    f32x16 S[4];
#pragma unroll
    for (int dt = 0; dt < 4; ++dt)
#pragma unroll
        for (int i = 0; i < 16; ++i) S[dt][i] = 0.f;
#define DN_LOAD_STAGE(itm, dstbuf) do { const unsigned char* _r = R.rec + (size_t)(itm) * 65536; const unsigned char* _q = R.qk + (size_t)(itm) * 8192; v4u _t[14]; \
        _Pragma("unroll") for (int _k = 0; _k < 12; ++_k) _t[_k] = *(const GAS v4u*)(_r + (ht + 256 * _k) * 16); \
        _Pragma("unroll") for (int _k = 0; _k < 2; ++_k) _t[12 + _k] = *(const GAS v4u*)(_q + (ht + 256 * _k) * 16); \
        _Pragma("unroll") for (int _k = 0; _k < 14; ++_k) *(LAS v4u*)((dstbuf) + (ht + 256 * _k) * 16) = _t[_k]; } while (0)
#define DN_POST(cc) do { const int _t = ht >> 2, _qd = ht & 3; const int _m = b * SEQ + 64 * (cc) + _t; \
        v4u _o[4], _z[4]; _Pragma("unroll") for (int _k = 0; _k < 4; ++_k) { _o[_k] = *(const LAS v4u*)(obuf + (_t * 128 + 32 * _qd + 8 * _k) * 2); _z[_k] = *(const GAS v4u*)(P.proj + (size_t)_m * IN_WP + PC_Z + h * 128 + 32 * _qd + 8 * _k); } \
        float _ss = 0.f; _Pragma("unroll") for (int _k = 0; _k < 4; ++_k) { const float a0 = bflo(_o[_k].x), a1 = bfhi(_o[_k].x), a2 = bflo(_o[_k].y), a3 = bfhi(_o[_k].y), a4 = bflo(_o[_k].z), a5 = bfhi(_o[_k].z), a6 = bflo(_o[_k].w), a7 = bfhi(_o[_k].w); \
            _ss += (a0 * a0 + a1 * a1) + (a2 * a2 + a3 * a3) + (a4 * a4 + a5 * a5) + (a6 * a6 + a7 * a7); } \
        _ss += __shfl_xor(_ss, 1); _ss += __shfl_xor(_ss, 2); const float _rs = 1.0f / sqrtf(_ss * (1.f / 128.f) + NORM_EPS); \
        _Pragma("unroll") for (int _k = 0; _k < 4; ++_k) { const GAS f32x4* _nw = (const GAS f32x4*)(P.dn_norm_w + 32 * _qd + 8 * _k); const f32x4 n0 = _nw[0], n1 = _nw[1]; \
            const float z0 = bflo(_z[_k].x), z1 = bfhi(_z[_k].x), z2 = bflo(_z[_k].y), z3 = bfhi(_z[_k].y), z4 = bflo(_z[_k].z), z5 = bfhi(_z[_k].z), z6 = bflo(_z[_k].w), z7 = bfhi(_z[_k].w); \
            v4u _w; _w.x = cvt2(bflo(_o[_k].x) * _rs * n0.x * (z0 * sigmoid_f(z0)), bfhi(_o[_k].x) * _rs * n0.y * (z1 * sigmoid_f(z1))); \
            _w.y = cvt2(bflo(_o[_k].y) * _rs * n0.z * (z2 * sigmoid_f(z2)), bfhi(_o[_k].y) * _rs * n0.w * (z3 * sigmoid_f(z3))); \
            _w.z = cvt2(bflo(_o[_k].z) * _rs * n1.x * (z4 * sigmoid_f(z4)), bfhi(_o[_k].z) * _rs * n1.y * (z5 * sigmoid_f(z5))); \
            _w.w = cvt2(bflo(_o[_k].w) * _rs * n1.z * (z6 * sigmoid_f(z6)), bfhi(_o[_k].w) * _rs * n1.w * (z7 * sigmoid_f(z7))); \
            *(GAS v4u*)(P.mix + (size_t)_m * 4096 + h * 128 + 32 * _qd + 8 * _k) = _w; } } while (0)
    if (!scan) DN_LOAD_STAGE(item0, lds);
    __syncthreads();
#pragma unroll 1
    for (int c = 0; c < 128; ++c) {
        LAS unsigned char* buf = lds + (c & 1) * SB;
        f32x16 o0, o1;
        if (scan) {
            const unsigned char* rec = R.rec + (size_t)(item0 + 16 * c) * 65536;
            v2u uu[2][4];
#pragma unroll
            for (int mt = 0; mt < 2; ++mt)
#pragma unroll
                for (int g = 0; g < 4; ++g) uu[mt][g] = *(const GAS v2u*)(rec + 49152 + (e * 64 + 32 * mt + 8 * g + 4 * hh) * 2);
            const float egl = R.gl[item0 + 16 * c];
            bf16x8 Sf[8];
#pragma unroll
            for (int dt = 0; dt < 4; ++dt) { Sf[2 * dt] = pack_step(S[dt], 0); Sf[2 * dt + 1] = pack_step(S[dt], 1); }
            f32x16 w0, w1;
#pragma unroll
            for (int i = 0; i < 16; ++i) { w0[i] = 0.f; w1[i] = 0.f; o0[i] = 0.f; o1[i] = 0.f; }
#pragma unroll
            for (int ks = 0; ks < 8; ++ks) { const bf16x8 a0 = *(const LAS bf16x8*)(buf + (ks * 64 + lane) * 16), a1 = *(const LAS bf16x8*)(buf + ((8 + ks) * 64 + lane) * 16);
                w0 = MFMA32(a0, Sf[ks], w0); w1 = MFMA32(a1, Sf[ks], w1); }
#pragma unroll
            for (int g = 0; g < 4; ++g) {
                w0[4 * g] = bflo(uu[0][g].x) - w0[4 * g]; w0[4 * g + 1] = bfhi(uu[0][g].x) - w0[4 * g + 1]; w0[4 * g + 2] = bflo(uu[0][g].y) - w0[4 * g + 2]; w0[4 * g + 3] = bfhi(uu[0][g].y) - w0[4 * g + 3];
                w1[4 * g] = bflo(uu[1][g].x) - w1[4 * g]; w1[4 * g + 1] = bfhi(uu[1][g].x) - w1[4 * g + 1]; w1[4 * g + 2] = bflo(uu[1][g].y) - w1[4 * g + 2]; w1[4 * g + 3] = bfhi(uu[1][g].y) - w1[4 * g + 3]; }
            bf16x8 Vf[4]; Vf[0] = pack_step(w0, 0); Vf[1] = pack_step(w0, 1); Vf[2] = pack_step(w1, 0); Vf[3] = pack_step(w1, 1);
#pragma unroll
            for (int ks = 0; ks < 8; ++ks) { const bf16x8 a0 = *(const LAS bf16x8*)(buf + 16384 + (ks * 64 + lane) * 16), a1 = *(const LAS bf16x8*)(buf + 16384 + ((8 + ks) * 64 + lane) * 16);
                o0 = MFMA32(a0, Sf[ks], o0); o1 = MFMA32(a1, Sf[ks], o1); }
#pragma unroll
            for (int kt = 0; kt < 4; ++kt) { const bf16x8 a0 = *(const LAS bf16x8*)(buf + 49152 + (kt * 64 + lane) * 16), a1 = *(const LAS bf16x8*)(buf + 49152 + ((4 + kt) * 64 + lane) * 16);
                o0 = MFMA32(a0, Vf[kt], o0); o1 = MFMA32(a1, Vf[kt], o1); }
#pragma unroll
            for (int dt = 0; dt < 4; ++dt) {
#pragma unroll
                for (int i = 0; i < 16; ++i) S[dt][i] *= egl;
#pragma unroll
                for (int kt = 0; kt < 4; ++kt) { const bf16x8 a = *(const LAS bf16x8*)(buf + 32768 + ((dt * 4 + kt) * 64 + lane) * 16); S[dt] = MFMA32(a, Vf[kt], S[dt]); } }
        } else {
            if (c + 1 < 128) DN_LOAD_STAGE(item0 + 16 * (c + 1), lds + ((c + 1) & 1) * SB);
            if (c > 0) DN_POST(c - 1);
        }
        __syncthreads();
        if (scan) {
#pragma unroll
            for (int i = 0; i < 16; ++i) { const int row = (i & 3) + 8 * (i >> 2) + 4 * hh;
                ((LAS bf16*)obuf)[row * 128 + e] = (bf16)(cvt2(o0[i], 0.f) & 0xffffu); ((LAS bf16*)obuf)[(32 + row) * 128 + e] = (bf16)(cvt2(o1[i], 0.f) & 0xffffu); }
        }
        __syncthreads();
    }
    if (!scan) DN_POST(127);
    else {
        float* Sout = P.out + O_SDN_P + ((size_t)b * 16 + h) * 16384;
#pragma unroll
        for (int dt = 0; dt < 4; ++dt)
#pragma unroll
            for (int i = 0; i < 16; ++i) Sout[(32 * dt + (i & 3) + 8 * (i >> 2) + 4 * hh) * 128 + e] = S[dt][i];
    }
    {   float* cout = P.out + O_CONV_P + (size_t)b * 3 * 6144;
        for (int i = tid; i < 3 * 384; i += 512) { const int r = i / 384, cc = i - r * 384, col = (cc >> 7) * 2048 + h * 128 + (cc & 127);
            cout[r * 6144 + col] = bf2f(P.proj[(size_t)(b * SEQ + SEQ - 3 + r) * IN_WP + col]); } }
    __syncthreads();
#undef DN_LOAD_STAGE
#undef DN_POST
}
struct RwRec { unsigned char* pq; unsigned char* rp; unsigned char* oo; float* sb; const bf16* w2T; const bf16* a2T; const bf16* g2T; };
constexpr int RSL = 9216;

__device__ __forceinline__ void tri_inv64(const LAS float* Lm, LAS float* Tm, LAS bf16* Tb, LAS float* Dinv, LAS float* Yb, int tid) {
    if (tid < 64) { const int bi = tid >> 4, j = tid & 15; float x[16];
#pragma unroll
        for (int r = 0; r < 16; ++r) { float a = (r == j) ? 1.f : 0.f;
#pragma unroll
            for (int k = 0; k < r; ++k) a -= Lm[(16 * bi + r) * 65 + 16 * bi + k] * x[k];
            x[r] = a; }
#pragma unroll
        for (int r = 0; r < 16; ++r) Dinv[(bi * 16 + r) * 17 + j] = x[r]; }
    __syncthreads();
#pragma unroll 1
    for (int i = 0; i < 4; ++i) {
        if (i > 0) {
            const int w = 16 * i;
            for (int o = tid; o < 16 * w; o += 512) { const int r = o / w, cidx = o - r * w; float a = 0.f;
                for (int k = cidx; k < w; ++k) a -= Lm[(w + r) * 65 + k] * Tm[k * 65 + cidx];
                Yb[r * 65 + cidx] = a; }
            __syncthreads();
        }
        for (int o = tid; o < 1024; o += 512) { const int r = o >> 6, cidx = o & 63; float a = 0.f;
            if (cidx < 16 * i) {
#pragma unroll
                for (int k = 0; k < 16; ++k) a += Dinv[(i * 16 + r) * 17 + k] * Yb[k * 65 + cidx]; }
            else if (cidx < 16 * i + 16) a = Dinv[(i * 16 + r) * 17 + cidx - 16 * i];
            Tm[(16 * i + r) * 65 + cidx] = a; Tb[(16 * i + r) * 72 + cidx] = (bf16)(cvt2(a, 0.f) & 0xffffu); }
        __syncthreads();
    }
}

__device__ __forceinline__ void rw_prep_item(const MixPtrs& P, const RwRec& W, LAS unsigned char* lds, int b, int c, int h, int tid, int lane, int wave) {
    const int m0 = b * SEQ + 64 * c; const int item = (b * 128 + c) * 32 + h; const int hc = h * 64 + lane;
    const int l15 = lane & 15, q = lane >> 4;
    LAS bf16* Rt = (LAS bf16*)(lds + 0 * RSL); LAS bf16* Kt = (LAS bf16*)(lds + 1 * RSL); LAS bf16* Bt = (LAS bf16*)(lds + 2 * RSL); LAS bf16* At = (LAS bf16*)(lds + 3 * RSL);
    LAS bf16* AtT = (LAS bf16*)(lds + 4 * RSL); LAS bf16* KhT = (LAS bf16*)(lds + 5 * RSL); LAS bf16* BhT = (LAS bf16*)(lds + 6 * RSL); LAS bf16* VT = (LAS bf16*)(lds + 7 * RSL);
    LAS bf16* Aak = (LAS bf16*)(lds + 8 * RSL); LAS bf16* Ark = (LAS bf16*)(lds + 9 * RSL); LAS bf16* Arb = (LAS bf16*)(lds + 10 * RSL);
    LAS float* Lm = (LAS float*)(lds + 11 * RSL); LAS float* Tm = (LAS float*)(lds + 1 * RSL); LAS bf16* Tb = (LAS bf16*)(lds + 3 * RSL);
    LAS bf16* WtT = (LAS bf16*)(lds + 11 * RSL); LAS bf16* XT = (LAS bf16*)(lds + 12 * RSL); LAS bf16* U0T = (LAS bf16*)(lds + 1 * RSL);
    LAS float* Dinv = (LAS float*)(lds + 13 * RSL); LAS float* Yb = (LAS float*)(lds + 13 * RSL + 4352);
    LAS float* wl = (LAS float*)(lds + 0); LAS float* al = (LAS float*)(lds + 2 * RSL);
    LAS bf16* txw = (LAS bf16*)(lds + 8 * RSL); LAS bf16* xas = txw + 64 * 104; LAS bf16* w2s = xas + 64 * 104; LAS bf16* a2s = w2s + 64 * 104;
    LAS float* wtot = (LAS float*)(lds + 126976); LAS float* eGCs = (LAS float*)(lds + 129024);
    for (int i = tid; i < 64 * 96; i += 512) { const int t = i / 96, j = i - t * 96; const int tt = 64 * c + t;
        { const int col = RW_XW + j; const float u = bf2f(P.proj[(size_t)(m0 + t) * IN_WP + PC_RW + col]); const float up = tt > 0 ? bf2f(P.proj[(size_t)(m0 + t - 1) * IN_WP + PC_RW + col]) : 0.f;
          txw[t * 104 + j] = (bf16)(cvt2(tanhf(u + P.mu[col] * (up - u)), 0.f) & 0xffffu); }
        { const int col = RW_XA + j; const float u = bf2f(P.proj[(size_t)(m0 + t) * IN_WP + PC_RW + col]); const float up = tt > 0 ? bf2f(P.proj[(size_t)(m0 + t - 1) * IN_WP + PC_RW + col]) : 0.f;
          xas[t * 104 + j] = (bf16)(cvt2(u + P.mu[col] * (up - u), 0.f) & 0xffffu); } }
    for (int i = tid; i < 2 * 768; i += 512) { const int which = i >= 768, ii = which ? i - 768 : i; const int row = ii / 12, part = ii - row * 12;
        const v4u v = *(const GAS v4u*)((which ? W.a2T : W.w2T) + (size_t)(h * 64 + row) * 96 + part * 8);
        *(LAS v4u*)((which ? a2s : w2s) + row * 104 + part * 8) = v; }
    float rr[8], kr[8], vv[8];
    {   float ur[9], uk[9], uv[9];
#pragma unroll
        for (int i = 0; i < 9; ++i) { const int tt = 64 * c + wave * 8 + i - 1;
            if (tt >= 0) { const size_t ro = (size_t)(b * SEQ + tt) * IN_WP + PC_RW + hc; ur[i] = bf2f(P.proj[ro + RW_R]); uk[i] = bf2f(P.proj[ro + RW_K]); uv[i] = bf2f(P.proj[ro + RW_V]); }
            else { ur[i] = 0.f; uk[i] = 0.f; uv[i] = 0.f; } }
        const float mr = P.mu[RW_R + hc], mk = P.mu[RW_K + hc], mv = P.mu[RW_V + hc];
#pragma unroll
        for (int i = 0; i < 8; ++i) { rr[i] = ur[i + 1] + mr * (ur[i] - ur[i + 1]); kr[i] = uk[i + 1] + mk * (uk[i] - uk[i + 1]); vv[i] = uv[i + 1] + mv * (uv[i] - uv[i + 1]); }
    }
    __syncthreads();
    {   const int tt = wave & 3, cp = wave >> 2;
#pragma unroll
        for (int ci = 0; ci < 2; ++ci) { const int ct = 2 * cp + ci;
            f32x4 aw = (f32x4){0.f, 0.f, 0.f, 0.f}, aa = (f32x4){0.f, 0.f, 0.f, 0.f};
#pragma unroll
            for (int ks = 0; ks < 3; ++ks) {
                const bf16x8 fx = *(const LAS bf16x8*)(txw + (16 * tt + l15) * 104 + 32 * ks + 8 * q), fa = *(const LAS bf16x8*)(xas + (16 * tt + l15) * 104 + 32 * ks + 8 * q);
                const bf16x8 fw = *(const LAS bf16x8*)(w2s + (16 * ct + l15) * 104 + 32 * ks + 8 * q), f2 = *(const LAS bf16x8*)(a2s + (16 * ct + l15) * 104 + 32 * ks + 8 * q);
                aw = MFMA16(fx, fw, aw); aa = MFMA16(fa, f2, aa); }
#pragma unroll
            for (int reg = 0; reg < 4; ++reg) { wl[(16 * tt + 4 * q + reg) * 65 + 16 * ct + l15] = aw[reg]; al[(16 * tt + 4 * q + reg) * 65 + 16 * ct + l15] = aa[reg]; } }
    }
    __syncthreads();
    float lw[8], av[8], bvv[8], kp[8], Gt[8];
    {   const float w0c = P.w0[hc], a0c = P.a0[hc], kkc = P.k_k[hc], kac = P.k_a[hc], rkc = P.r_k[hc];
        float run = 0.f;
#pragma unroll
        for (int i = 0; i < 8; ++i) { const int t = wave * 8 + i;
            const float wlog = -softplus_f(-(w0c + wl[t * 65 + lane])) - 0.5f; lw[i] = -__expf(wlog);
            const float alr = sigmoid_f(a0c + al[t * 65 + lane]);
            const float kkr = kr[i] * kkc; const float kk = kkr / sqrtf(wave_sum(kkr * kkr) + 1e-6f);
            kp[i] = kr[i] * (1.0f + (alr - 1.0f) * kac); av[i] = -kk; bvv[i] = kk * alr;
            const float sbv = wave_sum(rr[i] * kp[i] * rkc); if (lane == 0) W.sb[(size_t)item * 64 + t] = sbv;
            run += lw[i]; Gt[i] = run; }
        wtot[wave * 64 + lane] = run;
    }
    __syncthreads();
    {   float off = 0.f, gcv = 0.f;
#pragma unroll
        for (int w = 0; w < 8; ++w) { const float x = wtot[w * 64 + lane]; gcv += x; if (w < wave) off += x; }
        if (wave == 0) eGCs[lane] = __expf(gcv);
        float tA[8], tK[8], tB[8];
#pragma unroll
        for (int i = 0; i < 8; ++i) { const int t = wave * 8 + i; const float G = Gt[i] + off;
            const float eG = __expf(G), eGm = __expf(-G), eGp = __expf(G - lw[i]), eH = __expf(gcv - G);
            Rt[t * 72 + lane] = (bf16)(cvt2(rr[i] * eG, 0.f) & 0xffffu); Kt[t * 72 + lane] = (bf16)(cvt2(kp[i] * eGm, 0.f) & 0xffffu);
            Bt[t * 72 + lane] = (bf16)(cvt2(bvv[i] * eGm, 0.f) & 0xffffu); tA[i] = av[i] * eGp; At[t * 72 + lane] = (bf16)(cvt2(tA[i], 0.f) & 0xffffu);
            tK[i] = kp[i] * eH; tB[i] = bvv[i] * eH; }
        v4u o;
        o.x = cvt2(tA[0], tA[1]); o.y = cvt2(tA[2], tA[3]); o.z = cvt2(tA[4], tA[5]); o.w = cvt2(tA[6], tA[7]); *(LAS v4u*)(AtT + lane * 72 + wave * 8) = o;
        o.x = cvt2(tK[0], tK[1]); o.y = cvt2(tK[2], tK[3]); o.z = cvt2(tK[4], tK[5]); o.w = cvt2(tK[6], tK[7]); *(LAS v4u*)(KhT + lane * 72 + wave * 8) = o;
        o.x = cvt2(tB[0], tB[1]); o.y = cvt2(tB[2], tB[3]); o.z = cvt2(tB[4], tB[5]); o.w = cvt2(tB[6], tB[7]); *(LAS v4u*)(BhT + lane * 72 + wave * 8) = o;
        o.x = cvt2(vv[0], vv[1]); o.y = cvt2(vv[2], vv[3]); o.z = cvt2(vv[4], vv[5]); o.w = cvt2(vv[6], vv[7]); *(LAS v4u*)(VT + lane * 72 + wave * 8) = o;
    }
    __syncthreads();
    {   const int tt = wave & 3, sp = wave >> 2;
        bf16x8 fA[2], fR[2];
#pragma unroll
        for (int ks = 0; ks < 2; ++ks) { fA[ks] = *(const LAS bf16x8*)(At + (16 * tt + l15) * 72 + 32 * ks + 8 * q); fR[ks] = *(const LAS bf16x8*)(Rt + (16 * tt + l15) * 72 + 32 * ks + 8 * q); }
#pragma unroll
        for (int si = 0; si < 2; ++si) { const int st = 2 * sp + si;
            f32x4 ab = (f32x4){0.f, 0.f, 0.f, 0.f}, ak = ab, rk = ab, rb = ab;
#pragma unroll
            for (int ks = 0; ks < 2; ++ks) { const bf16x8 fB = *(const LAS bf16x8*)(Bt + (16 * st + l15) * 72 + 32 * ks + 8 * q), fK = *(const LAS bf16x8*)(Kt + (16 * st + l15) * 72 + 32 * ks + 8 * q);
                ab = MFMA16(fB, fA[ks], ab); ak = MFMA16(fK, fA[ks], ak); rk = MFMA16(fK, fR[ks], rk); rb = MFMA16(fB, fR[ks], rb); }
            const int t = 16 * tt + l15, s0 = 16 * st + 4 * q; float vak[4], vrk[4], vrb[4];
#pragma unroll
            for (int reg = 0; reg < 4; ++reg) { const int s = s0 + reg; Lm[t * 65 + s] = (t > s) ? -ab[reg] : 0.f; vak[reg] = (t > s) ? ak[reg] : 0.f; vrk[reg] = (t >= s) ? rk[reg] : 0.f; vrb[reg] = (t >= s) ? rb[reg] : 0.f; }
            v2u o; o.x = cvt2(vak[0], vak[1]); o.y = cvt2(vak[2], vak[3]); *(LAS v2u*)(Aak + t * 72 + s0) = o;
            o.x = cvt2(vrk[0], vrk[1]); o.y = cvt2(vrk[2], vrk[3]); *(LAS v2u*)(Ark + t * 72 + s0) = o;
            o.x = cvt2(vrb[0], vrb[1]); o.y = cvt2(vrb[2], vrb[3]); *(LAS v2u*)(Arb + t * 72 + s0) = o; }
    }
    __syncthreads();
    tri_inv64(Lm, Tm, Tb, Dinv, Yb, tid);
    {   const int tt = wave & 3, cp = wave >> 2;
        bf16x8 fT[2], fK[2];
#pragma unroll
        for (int ks = 0; ks < 2; ++ks) { fT[ks] = *(const LAS bf16x8*)(Tb + (16 * tt + l15) * 72 + 32 * ks + 8 * q); fK[ks] = *(const LAS bf16x8*)(Aak + (16 * tt + l15) * 72 + 32 * ks + 8 * q); }
#pragma unroll
        for (int ci = 0; ci < 2; ++ci) { const int ct = 2 * cp + ci;
            f32x4 aw = (f32x4){0.f, 0.f, 0.f, 0.f}, ax = aw;
#pragma unroll
            for (int ks = 0; ks < 2; ++ks) { const bf16x8 fa = *(const LAS bf16x8*)(AtT + (16 * ct + l15) * 72 + 32 * ks + 8 * q), fv = *(const LAS bf16x8*)(VT + (16 * ct + l15) * 72 + 32 * ks + 8 * q);
                aw = MFMA16(fT[ks], fa, aw); ax = MFMA16(fK[ks], fv, ax); }
            v2u o; o.x = cvt2(aw[0], aw[1]); o.y = cvt2(aw[2], aw[3]); *(LAS v2u*)(WtT + (16 * ct + l15) * 72 + 16 * tt + 4 * q) = o;
            o.x = cvt2(ax[0], ax[1]); o.y = cvt2(ax[2], ax[3]); *(LAS v2u*)(XT + (16 * ct + l15) * 72 + 16 * tt + 4 * q) = o; }
    }
    __syncthreads();
    {   const int tt = wave & 3, cp = wave >> 2;
#pragma unroll
        for (int ci = 0; ci < 2; ++ci) { const int et = 2 * cp + ci; f32x4 au = (f32x4){0.f, 0.f, 0.f, 0.f};
#pragma unroll
            for (int ks = 0; ks < 2; ++ks) { const bf16x8 fT = *(const LAS bf16x8*)(Tb + (16 * tt + l15) * 72 + 32 * ks + 8 * q), fx = *(const LAS bf16x8*)(XT + (16 * et + l15) * 72 + 32 * ks + 8 * q);
                au = MFMA16(fT, fx, au); }
            v2u o; o.x = cvt2(au[0], au[1]); o.y = cvt2(au[2], au[3]); *(LAS v2u*)(U0T + (16 * et + l15) * 72 + 16 * tt + 4 * q) = o; }
    }
    __syncthreads();
    {   const int bt = wave & 3, ap = wave >> 2;
        unsigned char* pq = W.pq + (size_t)item * 16384; unsigned char* rp = W.rp + (size_t)item * 8192; unsigned char* oo = W.oo + (size_t)item * 8192;
        bf16x8 fArb[2], fArk[2], fBh[2], fV[2], fU[2];
#pragma unroll
        for (int ks = 0; ks < 2; ++ks) { fArb[ks] = *(const LAS bf16x8*)(Arb + (16 * bt + l15) * 72 + 32 * ks + 8 * q); fArk[ks] = *(const LAS bf16x8*)(Ark + (16 * bt + l15) * 72 + 32 * ks + 8 * q);
            fBh[ks] = *(const LAS bf16x8*)(BhT + (16 * bt + l15) * 72 + 32 * ks + 8 * q); fV[ks] = *(const LAS bf16x8*)(VT + (16 * bt + l15) * 72 + 32 * ks + 8 * q); fU[ks] = *(const LAS bf16x8*)(U0T + (16 * bt + l15) * 72 + 32 * ks + 8 * q); }
#pragma unroll
        for (int ai = 0; ai < 2; ++ai) { const int at = 2 * ap + ai;
            f32x4 aR = (f32x4){0.f, 0.f, 0.f, 0.f}, aP = aR, aO = aR, aQ = aR;
#pragma unroll
            for (int ks = 0; ks < 2; ++ks) {
                const bf16x8 fW = *(const LAS bf16x8*)(WtT + (16 * at + l15) * 72 + 32 * ks + 8 * q);
                aR = MFMA16(fW, fArb[ks], aR);
                aP = MFMA16(fW, fBh[ks], aP);
                const bf16x8 fk = *(const LAS bf16x8*)(Ark + (16 * at + l15) * 72 + 32 * ks + 8 * q), fb = *(const LAS bf16x8*)(Arb + (16 * at + l15) * 72 + 32 * ks + 8 * q);
                aO = MFMA16(fk, fV[ks], aO); aO = MFMA16(fb, fU[ks], aO);
                const bf16x8 fkh = *(const LAS bf16x8*)(KhT + (16 * at + l15) * 72 + 32 * ks + 8 * q), fbh = *(const LAS bf16x8*)(BhT + (16 * at + l15) * 72 + 32 * ks + 8 * q);
                aQ = MFMA16(fkh, fV[ks], aQ); aQ = MFMA16(fbh, fU[ks], aQ); }
            const int x = 16 * bt + l15, y0 = 16 * at + 4 * q;
            {   const v2u rt = *(const LAS v2u*)(Rt + x * 72 + y0);
                v2u o; o.x = cvt2(aR[0] + bflo(rt.x), aR[1] + bfhi(rt.x)); o.y = cvt2(aR[2] + bflo(rt.y), aR[3] + bfhi(rt.y));
                *(GAS v2u*)(rp + ((((x >> 5) * 4 + at) * 64 + (x & 31) + 32 * (q & 1)) * 16 + 8 * (q >> 1))) = o; }
            {   const float dg = eGCs[x]; float p[4];
#pragma unroll
                for (int reg = 0; reg < 4; ++reg) p[reg] = aP[reg] + ((y0 + reg == x) ? dg : 0.f);
                v2u o; o.x = cvt2(p[0], p[1]); o.y = cvt2(p[2], p[3]);
                *(GAS v2u*)(pq + ((((x >> 5) * 4 + at) * 64 + (x & 31) + 32 * (q & 1)) * 16 + 8 * (q >> 1))) = o; }
            {   v2u o; o.x = cvt2(aO[0], aO[1]); o.y = cvt2(aO[2], aO[3]); *(GAS v2u*)(oo + (x * 64 + y0) * 2) = o; }
            {   v2u o; o.x = cvt2(aQ[0], aQ[1]); o.y = cvt2(aQ[2], aQ[3]); *(GAS v2u*)(pq + 8192 + (x * 64 + y0) * 2) = o; }
        }
    }
    __syncthreads();
}

__device__ __forceinline__ void rw_scan(const MixPtrs& P, const RwRec& W, LAS unsigned char* lds, int b, int h, int tid, int lane, int wave) {
    constexpr int SB = 33792;
    const int item0 = b * 128 * 32 + h;
    const bool scan = wave < 2; const int ht = tid - 128;
    const int e = 32 * (wave & 1) + (lane & 31), hh = lane >> 5;
    f32x16 H[2];
#pragma unroll
    for (int i = 0; i < 16; ++i) { H[0][i] = 0.f; H[1][i] = 0.f; }
#define RW_LOAD_STAGE(itm, dstbuf) do { const unsigned char* _pq = W.pq + (size_t)(itm) * 16384; const unsigned char* _rp = W.rp + (size_t)(itm) * 8192; const unsigned char* _oo = W.oo + (size_t)(itm) * 8192; v4u _t[6]; \
        _Pragma("unroll") for (int _k = 0; _k < 6; ++_k) { const int _i = ht + 384 * _k; if (_i < 2048) _t[_k] = *(const GAS v4u*)(_i < 512 ? _pq + _i * 16 : (_i < 1024 ? _rp + (_i - 512) * 16 : (_i < 1536 ? _pq + 8192 + (_i - 1024) * 16 : _oo + (_i - 1536) * 16))); } \
        _Pragma("unroll") for (int _k = 0; _k < 6; ++_k) { const int _i = ht + 384 * _k; if (_i < 1024) *(LAS v4u*)((dstbuf) + _i * 16) = _t[_k]; \
            else if (_i < 2048) { const int _j = _i - 1024; LAS unsigned char* _d = (dstbuf) + 16384 + (_j >> 3) * 136 + (_j & 7) * 16; *(LAS v2u*)_d = (v2u){_t[_k].x, _t[_k].y}; *(LAS v2u*)(_d + 8) = (v2u){_t[_k].z, _t[_k].w}; } } } while (0)
#define RW_STORE_O(itm, srcbuf) do { unsigned char* _oo = W.oo + (size_t)(itm) * 8192; \
        _Pragma("unroll") for (int _k = 4; _k < 6; ++_k) { const int _i = ht + 384 * _k; if (_i < 2048) { const int _j = _i - 1024; const LAS unsigned char* _s = (srcbuf) + 16384 + (_j >> 3) * 136 + (_j & 7) * 16; \
            const v2u _a = *(const LAS v2u*)_s, _b = *(const LAS v2u*)(_s + 8); *(GAS v4u*)(_oo + (_i - 1536) * 16) = (v4u){_a.x, _a.y, _b.x, _b.y}; } } } while (0)
    if (!scan) RW_LOAD_STAGE(item0, lds);
    __syncthreads();
#pragma unroll 1
    for (int c = 0; c < 128; ++c) {
        LAS unsigned char* buf = lds + (c & 1) * SB;
        if (scan) {
            bf16x8 Hf[4]; Hf[0] = pack_step(H[0], 0); Hf[1] = pack_step(H[0], 1); Hf[2] = pack_step(H[1], 0); Hf[3] = pack_step(H[1], 1);
#pragma unroll
            for (int mt = 0; mt < 2; ++mt) {
                f32x16 hn, ov;
#pragma unroll
                for (int g = 0; g < 4; ++g) { const v2u qv = *(const LAS v2u*)(buf + 16384 + e * 136 + (32 * mt + 8 * g + 4 * hh) * 2), o0 = *(const LAS v2u*)(buf + 16384 + 8704 + e * 136 + (32 * mt + 8 * g + 4 * hh) * 2);
                    hn[4 * g] = bflo(qv.x); hn[4 * g + 1] = bfhi(qv.x); hn[4 * g + 2] = bflo(qv.y); hn[4 * g + 3] = bfhi(qv.y);
                    ov[4 * g] = bflo(o0.x); ov[4 * g + 1] = bfhi(o0.x); ov[4 * g + 2] = bflo(o0.y); ov[4 * g + 3] = bfhi(o0.y); }
#pragma unroll
                for (int ks = 0; ks < 4; ++ks) { const bf16x8 fp = *(const LAS bf16x8*)(buf + ((mt * 4 + ks) * 64 + lane) * 16), fr = *(const LAS bf16x8*)(buf + 8192 + ((mt * 4 + ks) * 64 + lane) * 16);
                    hn = MFMA32(fp, Hf[ks], hn); ov = MFMA32(fr, Hf[ks], ov); }
#pragma unroll
                for (int g = 0; g < 4; ++g) { v2u o; o.x = cvt2(ov[4 * g], ov[4 * g + 1]); o.y = cvt2(ov[4 * g + 2], ov[4 * g + 3]); *(LAS v2u*)(buf + 16384 + 8704 + e * 136 + (32 * mt + 8 * g + 4 * hh) * 2) = o; }
                if (mt == 0) H[0] = hn; else H[1] = hn;
            }
        } else {
            if (c > 0) RW_STORE_O(item0 + 32 * (c - 1), lds + ((c - 1) & 1) * SB);
            if (c + 1 < 128) RW_LOAD_STAGE(item0 + 32 * (c + 1), lds + ((c + 1) & 1) * SB);
        }
        __syncthreads();
    }
    if (!scan) RW_STORE_O(item0 + 32 * 127, lds + SB);
    else {
        float* Sout = P.out + O_SRW_P + ((size_t)b * 32 + h) * 4096;
#pragma unroll
        for (int mt = 0; mt < 2; ++mt)
#pragma unroll
            for (int g = 0; g < 4; ++g) *(f32x4*)(Sout + e * 64 + 32 * mt + 8 * g + 4 * hh) = (f32x4){H[mt][4 * g], H[mt][4 * g + 1], H[mt][4 * g + 2], H[mt][4 * g + 3]};
    }
    {   float* shout = P.out + O_SHIFT_P + (size_t)b * RW_SHIFT_W;
        for (int i = tid; i < 206; i += 512) { const int col = h * 206 + i; shout[col] = bf2f(P.proj[(size_t)(b * SEQ + SEQ - 1) * IN_WP + PC_RW + col]); } }
    __syncthreads();
#undef RW_LOAD_STAGE
#undef RW_STORE_O
}

__device__ __forceinline__ void rw_post_item(const MixPtrs& P, const RwRec& W, LAS unsigned char* lds, int b, int c, int h, int tid, int lane, int wave) {
    const int m0 = b * SEQ + 64 * c; const int item = (b * 128 + c) * 32 + h; const int hc = h * 64 + lane;
    const int l15 = lane & 15, q = lane >> 4;
    LAS bf16* sxg = (LAS bf16*)lds; LAS bf16* g2s = (LAS bf16*)(lds + 33792); LAS float* gate = (LAS float*)(lds + 67584);
#pragma unroll
    for (int r = 0; r < 4; ++r) { const int i = tid + 512 * r; const int t = i >> 5, g8 = i & 31; const int tt = 64 * c + t; const int col = RW_XG + 8 * g8;
        const v4u u = *(const GAS v4u*)(P.proj + (size_t)(m0 + t) * IN_WP + PC_RW + col); v4u up = (v4u){0u, 0u, 0u, 0u}; if (tt > 0) up = *(const GAS v4u*)(P.proj + (size_t)(m0 + t - 1) * IN_WP + PC_RW + col);
        const f32x4 m0v = *(const GAS f32x4*)(P.mu + col), m1v = *(const GAS f32x4*)(P.mu + col + 4);
        float x[8];
        x[0] = bflo(u.x) + m0v.x * (bflo(up.x) - bflo(u.x)); x[1] = bfhi(u.x) + m0v.y * (bfhi(up.x) - bfhi(u.x)); x[2] = bflo(u.y) + m0v.z * (bflo(up.y) - bflo(u.y)); x[3] = bfhi(u.y) + m0v.w * (bfhi(up.y) - bfhi(u.y));
        x[4] = bflo(u.z) + m1v.x * (bflo(up.z) - bflo(u.z)); x[5] = bfhi(u.z) + m1v.y * (bfhi(up.z) - bfhi(u.z)); x[6] = bflo(u.w) + m1v.z * (bflo(up.w) - bflo(u.w)); x[7] = bfhi(u.w) + m1v.w * (bfhi(up.w) - bfhi(u.w));
        v4u o; o.x = cvt2(sigmoid_f(x[0]), sigmoid_f(x[1])); o.y = cvt2(sigmoid_f(x[2]), sigmoid_f(x[3])); o.z = cvt2(sigmoid_f(x[4]), sigmoid_f(x[5])); o.w = cvt2(sigmoid_f(x[6]), sigmoid_f(x[7]));
        *(LAS v4u*)(sxg + t * 264 + 8 * g8) = o; }
#pragma unroll
    for (int r = 0; r < 4; ++r) { const int i = tid + 512 * r; const int row = i >> 5, part = i & 31;
        *(LAS v4u*)(g2s + row * 264 + part * 8) = *(const GAS v4u*)(W.g2T + (size_t)(h * 64 + row) * 256 + part * 8); }
    float y[8], vv[8];
    {   const v4u ov = *(const GAS v4u*)(W.oo + (size_t)item * 8192 + (lane * 64 + wave * 8) * 2);
        y[0] = bflo(ov.x); y[1] = bfhi(ov.x); y[2] = bflo(ov.y); y[3] = bfhi(ov.y); y[4] = bflo(ov.z); y[5] = bfhi(ov.z); y[6] = bflo(ov.w); y[7] = bfhi(ov.w);
        float uv[9];
#pragma unroll
        for (int i = 0; i < 9; ++i) { const int tt = 64 * c + wave * 8 + i - 1; uv[i] = tt >= 0 ? bf2f(P.proj[(size_t)(b * SEQ + tt) * IN_WP + PC_RW + RW_V + hc]) : 0.f; }
        const float mv = P.mu[RW_V + hc];
#pragma unroll
        for (int i = 0; i < 8; ++i) vv[i] = uv[i + 1] + mv * (uv[i] - uv[i + 1]);
    }
    __syncthreads();
    {   const int tt = wave & 3, vp = wave >> 2;
#pragma unroll
        for (int vi = 0; vi < 2; ++vi) { const int vt = 2 * vp + vi; f32x4 ag = (f32x4){0.f, 0.f, 0.f, 0.f};
#pragma unroll
            for (int ks = 0; ks < 8; ++ks) { const bf16x8 fx = *(const LAS bf16x8*)(sxg + (16 * tt + l15) * 264 + 32 * ks + 8 * q), fg = *(const LAS bf16x8*)(g2s + (16 * vt + l15) * 264 + 32 * ks + 8 * q);
                ag = MFMA16(fx, fg, ag); }
#pragma unroll
            for (int reg = 0; reg < 4; ++reg) gate[(16 * tt + 4 * q + reg) * 65 + 16 * vt + l15] = ag[reg]; }
    }
    __syncthreads();
    {   const float lnw = P.ln_w[hc], lnb = P.ln_b[hc];
#pragma unroll
        for (int i = 0; i < 8; ++i) { const int t = wave * 8 + i;
            const float mean = wave_sum(y[i]) * (1.f / 64.f); const float dy = y[i] - mean; const float var = wave_sum(dy * dy) * (1.f / 64.f);
            const float yn = dy / sqrtf(var + RW_GN_EPS) * lnw + lnb; const float sbv = W.sb[(size_t)item * 64 + t];
            P.mix[(size_t)(m0 + t) * 4096 + 2048 + hc] = (bf16)(cvt2((yn + sbv * vv[i]) * gate[t * 65 + lane], 0.f) & 0xffffu); }
    }
    __syncthreads();
}

constexpr int NPH = 10;
#define MK_N_LAUNCHES 1
#ifndef MK_N_LAUNCHES
#define MK_N_LAUNCHES 1
#endif
__global__ void __launch_bounds__(NWAVES * 64, 2) hymba_fwd(Args args) {
    extern __shared__ __attribute__((aligned(16))) unsigned char lds_raw[];
    LAS unsigned char* lds = (LAS unsigned char*)lds_raw;
    volatile LAS unsigned* MISC = (volatile LAS unsigned*)(lds + MISC_OFF);
    const int tid = threadIdx.x, lane = tid & 63, wave = __builtin_amdgcn_readfirstlane(tid >> 6);
    const int G = gridDim.x;
    unsigned char* ws = args.ws;
    gu32* ctl = (gu32*)(ws + WS_CTL);
    for (int u = tid; u < (LDS_BYTES - LDSCTL_OFF) / 4; u += NWAVES * 64) ((LAS unsigned*)(lds + LDSCTL_OFF))[u] = 0u;
    __syncthreads();
    XcdBarrier bar; bar.bar = (unsigned*)(ctl + CW_BAR); bar.x = 0; bar.st = nullptr;
    if (MK_N_LAUNCHES == 1) bar = xcd_barrier_post((unsigned*)(ctl + CW_BAR), MISC + 8);
    const int lo = args.ph_lo, hi = args.ph_hi;
#ifdef ONLY_PHASE
#define IN(k) ((k) == ONLY_PHASE)
#else
#define IN(k) (lo <= (k) && (k) < hi)
#endif
#define SEAM(k) do { if (IN(k) && IN((k) + 1)) xcd_barrier(bar); } while (0)
    float* ssq = (float*)(ws + WS_SSQ);
    bf16* Wt_out = (bf16*)(ws + WS_WOUT); bf16* hbuf = (bf16*)(ws + WS_HBUF); bf16* proj = (bf16*)(ws + WS_PROJ); bf16* act = (bf16*)(ws + WS_PROJ);
    bf16* Wt_in = (bf16*)(ws + WS_WIN); bf16* Wt_gu = (bf16*)(ws + WS_WGU); bf16* Wt_dn = (bf16*)(ws + WS_WDN);
    bf16* w2T = (bf16*)(ws + WS_W2T); bf16* a2T = (bf16*)(ws + WS_A2T); bf16* g2T = (bf16*)(ws + WS_G2T);
    const float* x_prompt = args.in[0]; const float* x_sample = args.in[1];
    const int gw = blockIdx.x * NWAVES + wave, NGW = G * NWAVES;

    if (IN(0)) {
        LAS float* scr = (LAS float*)(lds + RING_OFF + wave * 16384);
        constexpr int I_IN = 64 * (IN_W / 32), I_OUT = 64 * 128;
        constexpr int NITEMS = I_IN + I_OUT;
        for (int it = gw; it < NITEMS; it += NGW) {
            if (it < I_IN) p0_transpose_item(args.in[8], 4096, IN_W, Wt_in, scr, it, lane, RmId{});
            else p0_transpose_item(args.in[24], 4096, 4096, Wt_out, scr, it - I_IN, lane, RmId{});
        }
        for (int i = blockIdx.x * 512 + tid; i < 2048 * 448; i += G * 512) {
            if (i < 2048 * 96) { const int c = i / 96, j = i - c * 96; w2T[i] = (bf16)f2bf(args.in[15][j * 2048 + c]); }
            else if (i < 2048 * 192) { const int ii = i - 2048 * 96; const int c = ii / 96, j = ii - c * 96; a2T[ii] = (bf16)f2bf(args.in[17][j * 2048 + c]); }
            else { const int ii = i - 2048 * 192; const int c = ii >> 8, j = ii & 255; g2T[ii] = (bf16)f2bf(args.in[18][j * 2048 + c]); }
        }
        for (int i = blockIdx.x * 512 + tid; i < 32 * 4096 / 8; i += G * 512) ((GAS v4u*)(Wt_in + (size_t)IN_W * 4096))[i] = (v4u){0u, 0u, 0u, 0u};
        for (int m = gw; m < MPAD; m += NGW) {
            bf16* orow = hbuf + (size_t)m * 4096;
            if (m < M_REAL) { const float* xrow = m < M_PROMPT ? x_prompt + (size_t)m * 4096 : x_sample + (size_t)(m - M_PROMPT) * 4096;
                const GAS f32x4* xr = (const GAS f32x4*)xrow + lane; f32x4 v[16];
#pragma unroll
                for (int j = 0; j < 16; ++j) v[j] = xr[64 * j];
                rms_row_to_bf16(v, args.in[6], orow, lane); }
            else { GAS v2u* o8 = (GAS v2u*)orow + lane;
#pragma unroll
                for (int j = 0; j < 16; ++j) o8[64 * j] = (v2u){0u, 0u}; }
        }
    }
    SEAM(0);
    if (IN(1)) {
        pg8::Gemm g{hbuf, Wt_in, MPAD, IN_WP, 4096}; pg8::StaticOrder S; S.init(MPAD, IN_WP, G, (int)blockIdx.x);
        pg8::EpiBf16Plain E{proj, IN_WP};
        pg8::gemm_phase<pg8::EpiBf16Plain, pg8::StaticOrder, true, true>(lds + RING_OFF, g, S, E);
    }
    SEAM(1);
    MixPtrs P; P.proj = proj; P.mix = hbuf; P.state_dn = args.in[2]; P.cache_conv = args.in[3]; P.state_rw = args.in[4]; P.cache_shift = args.in[5];
    P.conv_w = args.in[9]; P.a_log = args.in[10]; P.dt_bias = args.in[11]; P.dn_norm_w = args.in[12];
    P.mu = args.in[13]; P.w0 = args.in[14]; P.w2 = args.in[15]; P.a0 = args.in[16]; P.a2 = args.in[17]; P.g2 = args.in[18]; P.k_k = args.in[19]; P.k_a = args.in[20]; P.r_k = args.in[21];
    P.ln_w = args.in[22]; P.ln_b = args.in[23]; P.out = args.out;
    DnRec R; R.rec = (unsigned char*)args.out; R.qk = ws + WS_DNQK; R.gl = (float*)(ws + WS_DNGL);
    RwRec W; W.pq = ws + WS_RWPQ; W.rp = ws + WS_RWRP; W.oo = ws + WS_RWOO; W.sb = (float*)(ws + WS_RWSB); W.w2T = w2T; W.a2T = a2T; W.g2T = g2T;
    if (IN(2)) {
        for (int it = blockIdx.x; it < 4096; it += G) dn_prep_item(P, R, lds + RING_OFF, it >> 11, (it >> 4) & 127, it & 15, tid, lane, wave);
        for (int it = blockIdx.x; it < 8192; it += G) rw_prep_item(P, W, lds + RING_OFF, it >> 12, (it >> 5) & 127, it & 31, tid, lane, wave);
    }
    SEAM(2);
    if (IN(3)) {
        const int wg = blockIdx.x;
        if (wg < 32) dn_scan(P, R, lds + RING_OFF, wg >> 4, wg & 15, tid, lane, wave);
        else if (wg < 96) rw_scan(P, W, lds + RING_OFF, (wg - 32) >> 5, (wg - 32) & 31, tid, lane, wave);
        else {
            for (int it = wg - 96; it < 384; it += G - 96) {
                if (it < 128) dn_seq_item(P, lds + RING_OFF, 2 + (it >> 4), it & 15, tid, lane, wave);
                else rw_seq_item(P, lds + RING_OFF, 2 + ((it - 128) >> 5), (it - 128) & 31, tid, lane, wave);
            }
        }
    }
    SEAM(3);
    if (IN(4)) {
        for (int it = blockIdx.x; it < 8192; it += G) rw_post_item(P, W, lds + RING_OFF, it >> 12, (it >> 5) & 127, it & 31, tid, lane, wave);
        LAS float* scr = (LAS float*)(lds + RING_OFF + wave * 16384);
        constexpr int I_G = 64 * (D_FF / 32), I_D = (D_FF / 64) * 128;
        for (int it = gw; it < 2 * I_G + I_D; it += NGW) {
            if (it < I_G) p0_transpose_item(args.in[27], 4096, D_FF, Wt_gu, scr, it, lane, RmGU{0});
            else if (it < 2 * I_G) p0_transpose_item(args.in[28], 4096, D_FF, Wt_gu, scr, it - I_G, lane, RmGU{1});
            else p0_transpose_item(args.in[29], D_FF, 4096, Wt_dn, scr, it - 2 * I_G, lane, RmId{});
        }
    }
    SEAM(4);
    if (IN(5)) {
        pg8::Gemm g{hbuf, Wt_out, MPAD, 4096, 4096}; pg8::StaticOrder S; S.init(MPAD, 4096, G, (int)blockIdx.x);
        pg8::EpiF32Ssq E{args.out + O_Y, 4096, ssq, M_REAL};
        pg8::gemm_phase<pg8::EpiF32Ssq, pg8::StaticOrder, true, true>(lds + RING_OFF, g, S, E);
    }
    SEAM(5);
    if (IN(6)) {
        for (int m = gw; m < M_REAL; m += NGW) {
            const float* xrow = m < M_PROMPT ? x_prompt + (size_t)m * 4096 : x_sample + (size_t)(m - M_PROMPT) * 4096;
            float s = ssq[(size_t)m * 64 + lane]; s = wave_sum(s);
            const float rstd = 1.0f / sqrtf(s * (1.f / 4096.f) + NORM_EPS);
            const GAS f32x4* xr = (const GAS f32x4*)xrow + lane; GAS f32x4* tr = (GAS f32x4*)(args.out + O_Y + (size_t)m * 4096) + lane; const GAS f32x4* gr = (const GAS f32x4*)args.in[7] + lane;
            f32x4 v[16];
#pragma unroll
            for (int j = 0; j < 16; ++j) { const f32x4 xv = xr[64 * j], tv = tr[64 * j], gv = gr[64 * j]; v[j] = xv + tv * rstd * gv; tr[64 * j] = v[j]; }
            rms_row_to_bf16(v, args.in[25], hbuf + (size_t)m * 4096, lane);
        }
    }
    SEAM(6);
    if (IN(7)) {
        pg8::Gemm g{hbuf, Wt_gu, MPAD, 2 * D_FF, 4096}; pg8::StaticOrder S; S.init(MPAD, 2 * D_FF, G, (int)blockIdx.x);
        pg8::EpiSwiGLU E{act, D_FF};
        pg8::gemm_phase<pg8::EpiSwiGLU, pg8::StaticOrder, true, true>(lds + RING_OFF, g, S, E);
    }
    SEAM(7);
    if (IN(8)) {
        pg8::Gemm g{act, Wt_dn, MPAD, 4096, D_FF}; pg8::StaticOrder S; S.init(MPAD, 4096, G, (int)blockIdx.x);
        pg8::EpiBf16Ssq E{hbuf, 4096, ssq};
        pg8::gemm_phase<pg8::EpiBf16Ssq, pg8::StaticOrder, true, true>(lds + RING_OFF, g, S, E);
    }
    SEAM(8);
    if (IN(9)) {
        for (int m = gw; m < M_REAL; m += NGW) {
            float s = ssq[(size_t)m * 64 + lane]; s = wave_sum(s);
            const float rstd = 1.0f / sqrtf(s * (1.f / 4096.f) + NORM_EPS);
            GAS f32x4* orow = (GAS f32x4*)(args.out + O_Y + (size_t)m * 4096) + lane; const GAS v2u* fr = (const GAS v2u*)(hbuf + (size_t)m * 4096) + lane; const GAS f32x4* gr = (const GAS f32x4*)args.in[26] + lane;
#pragma unroll
            for (int j = 0; j < 16; ++j) { const f32x4 xv = orow[64 * j], gv = gr[64 * j]; const v2u fv = fr[64 * j];
                f32x4 f; f.x = __builtin_bit_cast(float, fv.x << 16); f.y = __builtin_bit_cast(float, fv.x & 0xffff0000u); f.z = __builtin_bit_cast(float, fv.y << 16); f.w = __builtin_bit_cast(float, fv.y & 0xffff0000u);
                orow[64 * j] = xv + f * rstd * gv; }
        }
    }
#undef IN
#undef SEAM
}

extern "C" void kernel_launch(void* const* d_in, const int* in_sizes, int n_in, void* d_out, int out_size, void* d_ws, size_t ws_size, hipStream_t stream) {
    static int grid = 0;
    if (grid == 0) {
        if (n_in != 30 || out_size != (int)O_END || ws_size < WS_END) { fprintf(stderr, "kernel_launch: unexpected shapes (n_in %d out %d ws %zu)\n", n_in, out_size, ws_size); grid = -1; return; }
        int dev = 0, cus = 0, per_cu = 0;
        if (hipGetDevice(&dev) != hipSuccess || hipDeviceGetAttribute(&cus, hipDeviceAttributeMultiprocessorCount, dev) != hipSuccess) { grid = -1; return; }
        if (hipFuncSetAttribute((const void*)hymba_fwd, hipFuncAttributeMaxDynamicSharedMemorySize, LDS_BYTES) != hipSuccess) { grid = -1; return; }
        if (hipOccupancyMaxActiveBlocksPerMultiprocessor(&per_cu, (const void*)hymba_fwd, NWAVES * 64, LDS_BYTES) != hipSuccess || per_cu < 1) { fprintf(stderr, "kernel_launch: occupancy query says %d\n", per_cu); }
        (void)hipGetLastError();
        grid = cus;
    }
    if (grid < 0) return;
    if (hipMemsetAsync((char*)d_ws + WS_CTL, 0, CTL_ZERO_BYTES, stream) != hipSuccess) return;
    Args a{};
    for (int i = 0; i < 30; ++i) a.in[i] = (const float*)d_in[i];
    a.out = (float*)d_out; a.ws = (unsigned char*)d_ws;
    if (MK_N_LAUNCHES == 1) { a.ph_lo = 0; a.ph_hi = NPH; hipLaunchKernelGGL(hymba_fwd, dim3(grid), dim3(NWAVES * 64), LDS_BYTES, stream, a); }
    else for (int p = 0; p < NPH; ++p) { a.ph_lo = p; a.ph_hi = p + 1; hipLaunchKernelGGL(hymba_fwd, dim3(grid), dim3(NWAVES * 64), LDS_BYTES, stream, a); }
}
```

```cpp
#include <hip/hip_runtime.h>
#include <cstdio>
#include <cstdint>

namespace pg8 {
#define PG8_LAS __attribute__((address_space(3)))
typedef unsigned short bf16_t;
typedef short bf16x8 __attribute__((ext_vector_type(8)));
typedef float f32x4 __attribute__((ext_vector_type(4)));
typedef unsigned u32x4 __attribute__((ext_vector_type(4)));
constexpr int BM = 256, BK = 64, HALF = 128, HTB = HALF * BK * 2  , STAGE_BYTES = 8 * HTB, NXCD = 8, WGM = 8;

__host__ __device__ __forceinline__ int lds_byte(int r, int c) { const int st = (r >> 4) * 2 + (c >> 5), rr = r & 15, cc = c & 31, ob = rr * 64 + cc * 2; return st * 1024 + (ob ^ (((ob >> 9) & 1) << 5)); }
__host__ __device__ __forceinline__ void stage_rc(int b, int& R, int& C) { const int st = b / 1024, sb = b % 1024, swz = sb ^ (((sb >> 9) & 1) << 5); R = (st >> 1) * 16 + swz / 64; C = (st & 1) * 32 + (swz % 64) / 2; }
__host__ __device__ __forceinline__ int perm32(int rho) { const int n = rho >> 4, i = rho & 15; return 8 * (i >> 2) + 4 * n + (i & 3); }

struct Unit { int pm, pn, ko, pi; };
struct Gemm { const bf16_t* A; const bf16_t* Bt; int M, N, K, lda, ldb; };

struct StaticOrder {
    int nM, nN, nwg, G, c;
    __host__ __device__ void init(int M, int N, int G_, int c_) { nM = M / BM; nN = N / BM; nwg = nM * nN; G = G_; c = c_; }
    __host__ __device__ bool next(int i, Unit& u) const {
        const long L = (long)i * G + c; if (L >= nwg) return false;
        int wgid = (int)L; { const int q = nwg / NXCD, r = nwg % NXCD, xcd = wgid % NXCD, off = wgid / NXCD; wgid = (xcd < r ? xcd * (q + 1) : r * (q + 1) + (xcd - r) * q) + off; }
        const int nig = WGM * nN, gid = wgid / nig, fm = gid * WGM, gsz = (nM - fm) < WGM ? (nM - fm) : WGM;
        u.pm = fm + ((wgid % nig) % gsz); u.pn = (wgid % nig) / gsz; u.ko = 0; u.pi = 0; return true;
    }
    __device__ __forceinline__ void a_ready(const Unit&) const {}
    __device__ __forceinline__ void done(const Unit&) const {}
};
__device__ __forceinline__ unsigned cvt_pk_bf16(float lo, float hi) { unsigned r; asm volatile("v_cvt_pk_bf16_f32 %0, %1, %2" : "=v"(r) : "v"(lo), "v"(hi)); return r; }

struct EpiBf16Plain {
    static constexpr bool PERM = true, AFTER_DRAIN = false;
    bf16_t* O; int ldc;
    __device__ __forceinline__ void operator()(const f32x4 (&acc)[2][2][4][2], const Unit& u, int wr, int wc, int fr, int fq) const {
        const int row0 = u.pm * BM + wr * 64 + fr, col0 = u.pn * BM + wc * 32 + 8 * fq;
#pragma unroll
        for (int ai = 0; ai < 2; ++ai)
#pragma unroll
            for (int m = 0; m < 4; ++m) { bf16_t* rowp = O + (size_t)(row0 + ai * HALF + m * 16) * ldc + col0;
#pragma unroll
                for (int bj = 0; bj < 2; ++bj) { const f32x4 v0 = acc[ai][bj][m][0], v1 = acc[ai][bj][m][1];
                    u32x4 w; w.x = cvt_pk_bf16(v0[0], v0[1]); w.y = cvt_pk_bf16(v0[2], v0[3]); w.z = cvt_pk_bf16(v1[0], v1[1]); w.w = cvt_pk_bf16(v1[2], v1[3]);
                    *(u32x4*)(rowp + bj * HALF) = w; } }
    }
};
__device__ __forceinline__ float silu_f(float x) { return x * __builtin_amdgcn_rcpf(1.0f + __expf(-x)); }
struct EpiSwiGLU {
    static constexpr bool PERM = true, AFTER_DRAIN = false;
    bf16_t* O; int ldc;
    __device__ __forceinline__ void operator()(const f32x4 (&acc)[2][2][4][2], const Unit& u, int wr, int wc, int fr, int fq) const {
        const int row0 = u.pm * BM + wr * 64 + fr, col0 = u.pn * HALF + wc * 32 + 8 * fq;
#pragma unroll
        for (int ai = 0; ai < 2; ++ai)
#pragma unroll
            for (int m = 0; m < 4; ++m) { bf16_t* rowp = O + (size_t)(row0 + ai * HALF + m * 16) * ldc + col0;
                const f32x4 g0 = acc[ai][0][m][0], g1 = acc[ai][0][m][1], u0 = acc[ai][1][m][0], u1 = acc[ai][1][m][1];
                u32x4 w; w.x = cvt_pk_bf16(silu_f(g0[0]) * u0[0], silu_f(g0[1]) * u0[1]); w.y = cvt_pk_bf16(silu_f(g0[2]) * u0[2], silu_f(g0[3]) * u0[3]);
                w.z = cvt_pk_bf16(silu_f(g1[0]) * u1[0], silu_f(g1[1]) * u1[1]); w.w = cvt_pk_bf16(silu_f(g1[2]) * u1[2], silu_f(g1[3]) * u1[3]);
                *(u32x4*)rowp = w; }
    }
};
struct EpiF32Ssq {
    static constexpr bool PERM = false, AFTER_DRAIN = false;
    float* C; int ldc; float* ssq; int mreal;
    __device__ __forceinline__ void operator()(const f32x4 (&acc)[2][2][4][2], const Unit& u, int wr, int wc, int fr, int fq) const {
        const int row0 = u.pm * BM + wr * 64 + fr, col0 = u.pn * BM + wc * 32 + 4 * fq;
#pragma unroll
        for (int ai = 0; ai < 2; ++ai)
#pragma unroll
            for (int m = 0; m < 4; ++m) { const int row = row0 + ai * HALF + m * 16; float s = 0.f;
#pragma unroll
                for (int bj = 0; bj < 2; ++bj)
#pragma unroll
                    for (int n = 0; n < 2; ++n) { const f32x4 v = acc[ai][bj][m][n]; s += (v[0] * v[0] + v[1] * v[1]) + (v[2] * v[2] + v[3] * v[3]);
                        if (row < mreal) *(f32x4*)(C + (size_t)row * ldc + col0 + bj * HALF + n * 16) = v; }
                s += __shfl_xor(s, 16); s += __shfl_xor(s, 32);
                if (fq == 0) ssq[(size_t)row * 64 + u.pn * 4 + wc] = s; }
    }
};
struct EpiBf16Ssq {
    static constexpr bool PERM = true, AFTER_DRAIN = false;
    bf16_t* O; int ldc; float* ssq;
    __device__ __forceinline__ void operator()(const f32x4 (&acc)[2][2][4][2], const Unit& u, int wr, int wc, int fr, int fq) const {
        const int row0 = u.pm * BM + wr * 64 + fr, col0 = u.pn * BM + wc * 32 + 8 * fq;
#pragma unroll
        for (int ai = 0; ai < 2; ++ai)
#pragma unroll
            for (int m = 0; m < 4; ++m) { const int row = row0 + ai * HALF + m * 16; bf16_t* rowp = O + (size_t)row * ldc + col0; float s = 0.f;
#pragma unroll
                for (int bj = 0; bj < 2; ++bj) { const f32x4 v0 = acc[ai][bj][m][0], v1 = acc[ai][bj][m][1];
                    s += (v0[0] * v0[0] + v0[1] * v0[1]) + (v0[2] * v0[2] + v0[3] * v0[3]) + (v1[0] * v1[0] + v1[1] * v1[1]) + (v1[2] * v1[2] + v1[3] * v1[3]);
                    u32x4 w; w.x = cvt_pk_bf16(v0[0], v0[1]); w.y = cvt_pk_bf16(v0[2], v0[3]); w.z = cvt_pk_bf16(v1[0], v1[1]); w.w = cvt_pk_bf16(v1[2], v1[3]);
                    *(u32x4*)(rowp + bj * HALF) = w; }
                s += __shfl_xor(s, 16); s += __shfl_xor(s, 32);
                if (fq == 0) ssq[(size_t)row * 64 + u.pn * 4 + wc] = s; }
    }
};
struct EpiF32Part {
    static constexpr bool PERM = false, AFTER_DRAIN = false;
    float* P; int ldc;
    __device__ __forceinline__ void operator()(const f32x4 (&acc)[2][2][4][2], const Unit& u, int wr, int wc, int fr, int fq) const {
        const int rowl = wr * 64 + fr, col0 = u.pn * BM + wc * 32 + 4 * fq; float* base = P + (size_t)u.pi * 128 * ldc;
#pragma unroll
        for (int m = 0; m < 4; ++m)
#pragma unroll
            for (int bj = 0; bj < 2; ++bj)
#pragma unroll
                for (int n = 0; n < 2; ++n) *(f32x4*)(base + (size_t)(rowl + m * 16) * ldc + col0 + bj * HALF + n * 16) = acc[0][bj][m][n];
    }
};
struct TailOrder {
    int nsub, G, c, kbase, klen, pbase;
    __device__ bool next(int i, Unit& u) const { const int idx = i * G + c; if (c < 0 || idx >= nsub) return false; const int sp = idx >> 4; u.pm = 64; u.pn = idx & 15; u.ko = kbase + sp * klen; u.pi = pbase + sp; return true; }
    __device__ __forceinline__ void a_ready(const Unit&) const {}
    __device__ __forceinline__ void done(const Unit&) const {}
};
template <class Epi, class Sched, bool ALIGN_EPI = false, bool SP2 = false>
__device__ __forceinline__ void gemm_phase(PG8_LAS unsigned char* lds, const Gemm g, const Sched& S, const Epi& E) {
    const int tid = threadIdx.x, wid = __builtin_amdgcn_readfirstlane(tid >> 6), lane = tid & 63, wr = wid >> 2, wc = wid & 3, fr = lane & 15, fq = lane >> 4;
    const int K = g.K, nt = K / BK;
    unsigned voffA[2], voffB[2];
#pragma unroll
    for (int i = 0; i < 2; ++i) { int R, C; stage_rc(tid * 16 + i * 8192, R, C); const int Rb = Epi::PERM ? ((R & ~31) + perm32(R & 31)) : R;
        voffA[i] = (unsigned)(R * g.lda + C) * 2u; voffB[i] = (unsigned)(Rb * g.ldb + C) * 2u; }
    const size_t kstep = (size_t)(BK * 2);
    const size_t hstepA = (size_t)HALF * g.lda * 2, hstepB = (size_t)HALF * g.ldb * 2;
    const size_t tstepA = 2 * hstepA, tstepB = 2 * hstepB;
    const unsigned ldsw = (unsigned)wid * 1024u;
    const int aoff = lds_byte(wr * 64 + fr, fq * 8), boff = lds_byte(wc * 32 + fr, fq * 8);
#define PG8_SA(b, h) (((b) * 2 + (h)) * HTB)
#define PG8_SB(b, h) ((4 + (b) * 2 + (h)) * HTB)
#define PG8_STAGE(bufoff, gbase, voff) do { _Pragma("unroll") for (int _i = 0; _i < 2; ++_i) \
        __builtin_amdgcn_global_load_lds((const unsigned*)((const char*)(gbase) + (voff)[_i]), (PG8_LAS unsigned*)(lds + (bufoff) + ldsw + _i * 8192), 16, 0, 0); } while (0)
#define PG8_LDA(dst, b, h) do { _Pragma("unroll") for (int m = 0; m < 4; ++m) _Pragma("unroll") for (int k = 0; k < 2; ++k) dst[m][k] = *(const PG8_LAS bf16x8*)(lds + PG8_SA(b, h) + aoff + m * 2048 + k * 1024); } while (0)
#define PG8_LDB(dst, b, h) do { _Pragma("unroll") for (int n = 0; n < 2; ++n) _Pragma("unroll") for (int k = 0; k < 2; ++k) dst[n][k] = *(const PG8_LAS bf16x8*)(lds + PG8_SB(b, h) + boff + n * 2048 + k * 1024); } while (0)
#define PG8_MMA(ai, bj, At, Bt) do { __builtin_amdgcn_s_setprio(1); _Pragma("unroll") for (int m = 0; m < 4; ++m) _Pragma("unroll") for (int n = 0; n < 2; ++n) _Pragma("unroll") for (int k = 0; k < 2; ++k) \
        acc[ai][bj][m][n] = __builtin_amdgcn_mfma_f32_16x16x32_bf16(Bt[n][k], At[m][k], acc[ai][bj][m][n], 0, 0, 0); __builtin_amdgcn_s_setprio(0); } while (0)
#define PG8_WAIT_V(n) asm volatile("s_waitcnt vmcnt(" #n ")" ::: "memory")
#define PG8_WAIT_L(n) asm volatile("s_waitcnt lgkmcnt(" #n ")" ::: "memory")
#define PG8_BAR __builtin_amdgcn_s_barrier()
#define PG8_SCHED __builtin_amdgcn_sched_barrier(0)
    Unit cur, nxt; int ui = 0;
    if (!S.next(0, cur)) return;
    f32x4 acc[2][2][4][2];
#pragma unroll
    for (int a = 0; a < 2; ++a)
#pragma unroll
        for (int b = 0; b < 2; ++b)
#pragma unroll
            for (int m = 0; m < 4; ++m)
#pragma unroll
                for (int n = 0; n < 2; ++n) acc[a][b][m][n] = (f32x4){0.f, 0.f, 0.f, 0.f};
    bf16x8 At[4][2], B0[2][2], B1[2][2];
    const char* cA = (const char*)g.A + (size_t)cur.pm * tstepA + (size_t)cur.ko * 2; const char* cB = (const char*)g.Bt + (size_t)cur.pn * tstepB + (size_t)cur.ko * 2;
    S.a_ready(cur);
    if constexpr (SP2) {
        PG8_STAGE(PG8_SB(0, 0), cB, voffB); PG8_STAGE(PG8_SB(0, 1), cB + hstepB, voffB); PG8_STAGE(PG8_SA(0, 0), cA, voffA); PG8_STAGE(PG8_SA(0, 1), cA + hstepA, voffA);
        if (wr == 1) PG8_BAR;
        PG8_WAIT_V(2); PG8_BAR;
        PG8_STAGE(PG8_SB(1, 0), cB + kstep, voffB); PG8_STAGE(PG8_SA(1, 0), cA + kstep, voffA); PG8_STAGE(PG8_SB(1, 1), cB + hstepB + kstep, voffB);
        PG8_WAIT_V(6); PG8_BAR;
    } else {
        PG8_STAGE(PG8_SB(0, 0), cB, voffB); PG8_STAGE(PG8_SA(0, 0), cA, voffA); PG8_STAGE(PG8_SB(0, 1), cB + hstepB, voffB); PG8_STAGE(PG8_SA(0, 1), cA + hstepA, voffA);
        if (wr == 1) PG8_BAR;
        PG8_WAIT_V(4); PG8_BAR;
        PG8_STAGE(PG8_SB(1, 0), cB + kstep, voffB); PG8_STAGE(PG8_SA(1, 0), cA + kstep, voffA); PG8_STAGE(PG8_SB(1, 1), cB + hstepB + kstep, voffB);
        PG8_WAIT_V(6); PG8_BAR;
    }
    for (;;) {
        const bool has_next = S.next(ui + 1, nxt);
        const char* nA = has_next ? (const char*)g.A + (size_t)nxt.pm * tstepA + (size_t)nxt.ko * 2 : cA; const char* nB = has_next ? (const char*)g.Bt + (size_t)nxt.pn * tstepB + (size_t)nxt.ko * 2 : cB;
        for (int t = 0; t < nt; t += 2) {
            const bool last = (t == nt - 2);
            const char* a1 = cA + (size_t)(t + 1) * kstep;
            const char* a2 = last ? nA : cA + (size_t)(t + 2) * kstep; const char* b2 = last ? nB : cB + (size_t)(t + 2) * kstep;
            const char* a3 = a2 + kstep; const char* b3 = b2 + kstep;
            if (last && has_next) S.a_ready(nxt);
            if constexpr (SP2) {
            PG8_LDB(B0, 0, 0); PG8_LDB(B1, 0, 1); PG8_SCHED; PG8_LDA(At, 0, 0); PG8_STAGE(PG8_SA(1, 1), a1 + hstepA, voffA);
            PG8_WAIT_V(8); PG8_WAIT_L(0); PG8_BAR; PG8_MMA(0, 0, At, B0); PG8_MMA(0, 1, At, B1); PG8_BAR; PG8_SCHED;
            PG8_LDA(At, 0, 1); PG8_STAGE(PG8_SB(0, 0), b2, voffB); PG8_STAGE(PG8_SB(0, 1), b2 + hstepB, voffB); PG8_STAGE(PG8_SA(0, 0), a2, voffA);
            PG8_WAIT_V(8); PG8_WAIT_L(0); PG8_BAR; PG8_MMA(1, 0, At, B0); PG8_MMA(1, 1, At, B1); PG8_BAR; PG8_SCHED;
            PG8_LDB(B0, 1, 0); PG8_LDB(B1, 1, 1); PG8_SCHED; PG8_LDA(At, 1, 0); PG8_STAGE(PG8_SA(0, 1), a2 + hstepA, voffA);
            PG8_WAIT_V(8); PG8_WAIT_L(0); PG8_BAR; PG8_MMA(0, 0, At, B0); PG8_MMA(0, 1, At, B1); PG8_BAR; PG8_SCHED;
            PG8_LDA(At, 1, 1); PG8_STAGE(PG8_SB(1, 0), b3, voffB); PG8_STAGE(PG8_SB(1, 1), b3 + hstepB, voffB); PG8_STAGE(PG8_SA(1, 0), a3, voffA);
            PG8_WAIT_V(8); PG8_WAIT_L(0); PG8_BAR; PG8_MMA(1, 0, At, B0); PG8_MMA(1, 1, At, B1); PG8_BAR; PG8_SCHED;
            } else {
            PG8_LDB(B0, 0, 0); PG8_SCHED; PG8_LDA(At, 0, 0); PG8_STAGE(PG8_SA(1, 1), a1 + hstepA, voffA);
            PG8_WAIT_L(8); PG8_BAR; PG8_WAIT_L(0); PG8_MMA(0, 0, At, B0); PG8_BAR; PG8_SCHED;
            PG8_LDB(B1, 0, 1); PG8_STAGE(PG8_SB(0, 0), b2, voffB);
            PG8_BAR; PG8_WAIT_L(0); PG8_MMA(0, 1, At, B1); PG8_BAR;
            PG8_LDA(At, 0, 1); PG8_STAGE(PG8_SA(0, 0), a2, voffA);
            PG8_BAR; PG8_WAIT_L(0); PG8_MMA(1, 0, At, B0); PG8_BAR; PG8_SCHED;
            PG8_STAGE(PG8_SB(0, 1), b2 + hstepB, voffB);
            PG8_WAIT_V(6); PG8_BAR; PG8_MMA(1, 1, At, B1); PG8_BAR;
            PG8_LDB(B0, 1, 0); PG8_SCHED; PG8_LDA(At, 1, 0); PG8_STAGE(PG8_SA(0, 1), a2 + hstepA, voffA);
            PG8_WAIT_L(8); PG8_BAR; PG8_WAIT_L(0); PG8_MMA(0, 0, At, B0); PG8_BAR; PG8_SCHED;
            PG8_LDB(B1, 1, 1); PG8_STAGE(PG8_SB(1, 0), b3, voffB);
            PG8_BAR; PG8_WAIT_L(0); PG8_MMA(0, 1, At, B1); PG8_BAR;
            PG8_LDA(At, 1, 1); PG8_STAGE(PG8_SA(1, 0), a3, voffA);
            PG8_BAR; PG8_WAIT_L(0); PG8_MMA(1, 0, At, B0); PG8_BAR; PG8_SCHED;
            PG8_STAGE(PG8_SB(1, 1), b3 + hstepB, voffB);
            PG8_WAIT_V(6); PG8_BAR; PG8_MMA(1, 1, At, B1); PG8_BAR;
            }
        }
        if constexpr (ALIGN_EPI) { if (wr == 0) PG8_BAR; }
        if constexpr (!Epi::AFTER_DRAIN) { E(acc, cur, wr, wc, fr, fq); S.done(cur); }
        if (!has_next) break;
#pragma unroll
        for (int a = 0; a < 2; ++a)
#pragma unroll
            for (int b = 0; b < 2; ++b)
#pragma unroll
                for (int m = 0; m < 4; ++m)
#pragma unroll
                    for (int n = 0; n < 2; ++n) acc[a][b][m][n] = (f32x4){0.f, 0.f, 0.f, 0.f};
        cur = nxt; cA = nA; cB = nB; ++ui;
        if constexpr (ALIGN_EPI) { if (wr == 1) PG8_BAR; }
    }
    PG8_WAIT_V(0);
    if constexpr (!ALIGN_EPI) { if (wr == 0) PG8_BAR; }
    PG8_BAR;
    if constexpr (Epi::AFTER_DRAIN) { E.fused(acc, cur, wr, wc, fr, fq, lds, wid, lane); S.done(cur); }
#undef PG8_SA
#undef PG8_SB
#undef PG8_STAGE
#undef PG8_LDA
#undef PG8_LDB
#undef PG8_MMA
#undef PG8_WAIT_V
#undef PG8_WAIT_L
#undef PG8_BAR
#undef PG8_SCHED
}
}

constexpr int NWAVES = 8;
constexpr int D_MODEL = 4096, SEQ = 8192, DEC_SEQ = 16;
constexpr int M_PROMPT = 16384, M_REAL = 16512, MPAD = 16640;
constexpr int IN_W = 14816, IN_WP = 14848, D_FF = 11008;
constexpr int PC_Q = 0, PC_K = 2048, PC_V = 4096, PC_Z = 6144, PC_B = 8192, PC_A = 8208, PC_RW = 8224;
constexpr int RW_R = 0, RW_K = 2048, RW_V = 4096, RW_XW = 6144, RW_XA = 6240, RW_XG = 6336, RW_SHIFT_W = 6592;
constexpr float NORM_EPS = 1e-6f, RW_GN_EPS = 64e-5f;
constexpr size_t O_Y = 0, O_SDN_P = 67633152, O_CONV_P = 68157440, O_SRW_P = 68194304, O_SHIFT_P = 68456448,
                 O_SDN_S = 68469632, O_CONV_S = 70566784, O_SRW_S = 70714240, O_SHIFT_S = 71762816, O_END = 71815552;
constexpr size_t MiB = 1u << 20;
constexpr size_t WS_CTL = 0, CTL_ZERO_BYTES = 1 * MiB;
constexpr size_t WS_SSQ = 2 * MiB;
constexpr size_t WS_W2T = 6553600, WS_A2T = WS_W2T + 2048 * 96 * 2, WS_G2T = 7 * MiB;
constexpr size_t WS_WOUT = 8 * MiB;
constexpr size_t WS_HBUF = 40 * MiB;
constexpr size_t WS_PROJ = 170 * MiB;
constexpr size_t WS_WIN = 642 * MiB;
constexpr size_t WS_WGU = 758 * MiB;
constexpr size_t WS_WDN = 930 * MiB;
constexpr size_t WS_END = 1016 * MiB;
constexpr size_t WS_PART2 = 642 * MiB, WS_PART4 = 678 * MiB;
constexpr size_t WS_DNQK = 642 * MiB, WS_DNGL = 674 * MiB, WS_RWSB = 675 * MiB, WS_RWOO = 678 * MiB, WS_RWPQ = 758 * MiB, WS_RWRP = 886 * MiB;
static_assert(WS_SSQ + (size_t)MPAD * 64 * 4 <= WS_WOUT && WS_HBUF + (size_t)MPAD * 4096 * 2 <= WS_PROJ && WS_PROJ + (size_t)MPAD * IN_WP * 2 <= WS_WIN &&
              WS_WIN + (size_t)IN_WP * 4096 * 2 <= WS_WGU && WS_WGU + (size_t)2 * D_FF * 4096 * 2 <= WS_WDN && WS_WDN + (size_t)4096 * D_FF * 2 <= WS_END, "d_ws map");
constexpr int CW_BAR = 4096;
constexpr int RING_OFF = 0, RING_BYTES = 131072;
constexpr int LDSCTL_OFF = RING_BYTES, MISC_OFF = LDSCTL_OFF + 320;
constexpr int LDS_BYTES = 147456;

#define GAS __attribute__((address_space(1)))
#define LAS __attribute__((address_space(3)))
typedef unsigned short bf16;
typedef unsigned v4u __attribute__((ext_vector_type(4)));
typedef unsigned v2u __attribute__((ext_vector_type(2)));
typedef float f32x4 __attribute__((ext_vector_type(4)));
typedef GAS unsigned gu32;
#define RLX_AGENT __ATOMIC_RELAXED, __HIP_MEMORY_SCOPE_AGENT
#define LDS_WAIT() asm volatile("s_waitcnt lgkmcnt(0)" ::: "memory")
__device__ __forceinline__ unsigned f2bf(float f) { unsigned u = __builtin_bit_cast(unsigned, f); return (u + 0x7fffu + ((u >> 16) & 1u)) >> 16; }
__device__ __forceinline__ unsigned pk2(float lo, float hi) { return f2bf(lo) | (f2bf(hi) << 16); }
__device__ __forceinline__ float bf2f(bf16 b) { return __builtin_bit_cast(float, (unsigned)b << 16); }
__device__ __forceinline__ float bflo(unsigned u) { return __builtin_bit_cast(float, u << 16); }
__device__ __forceinline__ float bfhi(unsigned u) { return __builtin_bit_cast(float, u & 0xffff0000u); }
__device__ __forceinline__ float wave_sum(float v) {
#pragma unroll
    for (int o = 1; o < 64; o <<= 1) v += __shfl_xor(v, o);
    return v;
}
#ifdef OLD_MATH
__device__ __forceinline__ float sigmoid_f(float x) { return 1.0f / (1.0f + __expf(-x)); }
__device__ __forceinline__ float softplus_f(float x) { return x > 20.f ? x : log1pf(__expf(x)); }
#else
__device__ __forceinline__ float sigmoid_f(float x) { return __builtin_amdgcn_rcpf(1.0f + __expf(-x)); }
__device__ __forceinline__ float softplus_f(float x) { return x > 20.f ? x : __logf(1.0f + __expf(x)); }
#endif
__device__ __forceinline__ void wave_sum8(float (&v)[8]) {
#pragma unroll
    for (int o = 1; o < 64; o <<= 1) {
#pragma unroll
        for (int i = 0; i < 8; ++i) v[i] += __shfl_xor(v[i], o); }
}

#define XB_TMO      128
#define XB_XCNT(j)  (256  + 64 * (j))
#define XB_XSUB(j)  (1280 + 64 * (j))
#define XB_XGEN(j)  (2304 + 64 * (j))
#define XB_TOP      3328
#define XB_TOPGEN   3392
#define XCD_BAR_WORDS 3456
#define XB_SPIN_CAP (1u << 18)

__device__ __forceinline__ unsigned xb_ld(unsigned* p)              { return __hip_atomic_load(p, __ATOMIC_RELAXED, __HIP_MEMORY_SCOPE_AGENT); }
__device__ __forceinline__ unsigned xb_add(unsigned* p, unsigned v) { return __hip_atomic_fetch_add(p, v, __ATOMIC_RELAXED, __HIP_MEMORY_SCOPE_AGENT); }
__device__ __forceinline__ unsigned xb_xcc_id() { return (unsigned)__builtin_amdgcn_s_getreg((3 << 11) | 20) & 0xFu; }
#define XB_SPIN(cond, bar) do { unsigned _sp = 0; while (cond) { __builtin_amdgcn_s_sleep(1); \
    if ((++_sp & 255u) == 0u) { if (xb_ld(&(bar)[XB_TMO])) break; if (_sp > XB_SPIN_CAP) { atomicAdd(&(bar)[XB_TMO], 1u); break; } } } } while (0)

struct XcdBarrier {
    unsigned* bar; unsigned x;
    volatile LAS unsigned* st;
};

__device__ __forceinline__ XcdBarrier xcd_barrier_post(unsigned* bar, volatile LAS unsigned* st) {
    XcdBarrier b; b.bar = bar; b.x = xb_xcc_id(); b.st = st;
    if (threadIdx.x == 0) (void)xb_add(&bar[XB_XCNT(b.x)], 1u);
    return b;
}
__device__ __forceinline__ void xcd_barrier_complete(unsigned* bar, unsigned x, unsigned& nloc, unsigned& nx) {
    const unsigned G = gridDim.x * gridDim.y * gridDim.z;
    unsigned sum, cnt, mine, sp = 0u;
    for (;;) {
        sum = 0u; cnt = 0u; mine = 0u;
#pragma unroll
        for (unsigned j = 0; j < 16; ++j) { const unsigned c = xb_ld(&bar[XB_XCNT(j)]); sum += c; cnt += (c > 0u) ? 1u : 0u; mine = (j == x) ? c : mine; }
        if (sum == G) break;
        __builtin_amdgcn_s_sleep(1);
        if ((++sp & 255u) == 0u) { if (xb_ld(&bar[XB_TMO])) break; if (sp > XB_SPIN_CAP) { atomicAdd(&bar[XB_TMO], 1u); break; } }
    }
    nloc = mine > 0u ? mine : 1u; nx = cnt > 0u ? cnt : 1u;
}

__device__ __forceinline__ void xcd_barrier(const XcdBarrier& b) {
    asm volatile("s_waitcnt vmcnt(0)" ::: "memory");
    __syncthreads();
    if (threadIdx.x == 0) {
        unsigned* bar = b.bar;
        __builtin_amdgcn_s_waitcnt(0);
        unsigned nloc = b.st[0], nx = b.st[1];
        if (nloc == 0u) { xcd_barrier_complete(bar, b.x, nloc, nx); b.st[0] = nloc; b.st[1] = nx; }
        const unsigned old = xb_add(&bar[XB_XSUB(b.x)], 1u);
        const unsigned gen = old / nloc;
        if (old + 1u == (gen + 1u) * nloc) {
            __builtin_amdgcn_fence(__ATOMIC_RELEASE, "agent");
            asm volatile("s_waitcnt vmcnt(0)" ::: "memory");
            const unsigned og = xb_add(&bar[XB_TOP], 1u);
            const unsigned tg = og / nx;
            if (og + 1u == (tg + 1u) * nx) xb_add(&bar[XB_TOPGEN], 1u);
            else XB_SPIN(xb_ld(&bar[XB_TOPGEN]) == tg, bar);
            __builtin_amdgcn_fence(__ATOMIC_ACQUIRE, "agent");
            xb_add(&bar[XB_XGEN(b.x)], 1u);
            asm volatile("s_waitcnt vmcnt(0)" ::: "memory");
        } else {
            XB_SPIN(xb_ld(&bar[XB_XGEN(b.x)]) == gen, bar);
            __builtin_amdgcn_fence(__ATOMIC_ACQUIRE, "agent");
            asm volatile("s_waitcnt vmcnt(0)" ::: "memory");
        }
    }
    __syncthreads();
}

struct Frame {
    LAS unsigned char* lds;
    volatile LAS unsigned* MISC;
    gu32* ctl;
    int tid, lane, wave, G;
    const float* const* in;
};
struct Args { const float* in[30]; float* out; unsigned char* ws; int ph_lo, ph_hi; };

template <class RowMap>
__device__ __forceinline__ void p0_transpose_item(const float* W, int K, int N, bf16* WT, LAS float* scr, int item, int lane, RowMap rm) {
    const int nblk = N / 32, kb = item / nblk, nb = item % nblk, k0 = 64 * kb, n0 = 32 * nb;
#pragma unroll 8
    for (int i = 0; i < 32; ++i) { const int kk = 2 * i + (lane >> 5); scr[kk * 33 + (lane & 31)] = W[(size_t)(k0 + kk) * N + n0 + (lane & 31)]; }
    LDS_WAIT(); asm volatile("" ::: "memory");
    const int c = lane & 7;
#pragma unroll
    for (int j = 0; j < 4; ++j) { const int n = (lane >> 3) + 8 * j; const LAS float* s = scr + (8 * c) * 33 + n;
        v4u o; o.x = pk2(s[0 * 33], s[1 * 33]); o.y = pk2(s[2 * 33], s[3 * 33]); o.z = pk2(s[4 * 33], s[5 * 33]); o.w = pk2(s[6 * 33], s[7 * 33]);
        *(GAS v4u*)(WT + (size_t)rm(n0 + n) * K + k0 + 8 * c) = o; }
    LDS_WAIT(); asm volatile("" ::: "memory");
}
struct RmId { __device__ __forceinline__ int operator()(int n) const { return n; } };
struct RmGU { int up; __device__ __forceinline__ int operator()(int n) const { return (n >> 7) * 256 + up * 128 + (n & 127); } };

__device__ __forceinline__ void rms_row_to_bf16(const f32x4 (&v)[16], const float* g, bf16* orow, int lane) {
    float s = 0.f;
#pragma unroll
    for (int j = 0; j < 16; ++j) s += (v[j].x * v[j].x + v[j].y * v[j].y) + (v[j].z * v[j].z + v[j].w * v[j].w);
    const float rstd = 1.0f / sqrtf(wave_sum(s) * (1.f / 4096.f) + NORM_EPS);
    const GAS f32x4* gr = (const GAS f32x4*)g + lane; GAS v2u* o8 = (GAS v2u*)orow + lane;
#pragma unroll
    for (int hh = 0; hh < 2; ++hh) { f32x4 gv[8];
#pragma unroll
        for (int j = 0; j < 8; ++j) gv[j] = gr[64 * (8 * hh + j)];
#pragma unroll
        for (int j = 0; j < 8; ++j) { const f32x4 x = v[8 * hh + j]; v2u o; o.x = pk2(x.x * rstd * gv[j].x, x.y * rstd * gv[j].y); o.y = pk2(x.z * rstd * gv[j].z, x.w * rstd * gv[j].w); o8[64 * (8 * hh + j)] = o; } }
}

struct MixPtrs {
    const bf16* proj; bf16* mix;
    const float *state_dn, *cache_conv, *state_rw, *cache_shift;
    const float *conv_w, *a_log, *dt_bias, *dn_norm_w;
    const float *mu, *w0, *w2, *a0, *a2, *g2, *k_k, *k_a, *r_k, *ln_w, *ln_b;
    float* out;
};
__device__ __forceinline__ void dn_seq_item(const MixPtrs& P, LAS unsigned char* lds, int seq, int h, int tid, int lane, int wave) {
    const bool prm = seq < 2;
    const int T = prm ? SEQ : DEC_SEQ, sb = prm ? seq : seq - 2;
    const int m0 = prm ? seq * SEQ : M_PROMPT + sb * DEC_SEQ;
    const float* S0 = prm ? nullptr : P.state_dn + ((size_t)sb * 16 + h) * 16384;
    const float* cbuf = prm ? nullptr : P.cache_conv + (size_t)sb * 3 * 6144;
    float* Sout = P.out + (prm ? O_SDN_P : O_SDN_S) + ((size_t)sb * 16 + h) * 16384;
    float* cout = P.out + (prm ? O_CONV_P : O_CONV_S) + (size_t)sb * 3 * 6144;
    LAS float* qs = (LAS float*)lds; LAS float* ks = qs + 2048; LAS float* vs = ks + 2048; LAS float* zs = vs + 2048; LAS float* os = zs + 2048; LAS float* bet = os + 2048; LAS float* gg = bet + 16;
    float S[32];
    const int e = wave * 16 + (lane >> 2), dq = lane & 3;
#pragma unroll
    for (int j = 0; j < 32; ++j) S[j] = (S0 != nullptr) ? S0[(32 * dq + j) * 128 + e] : 0.f;
    const float Ah = -__expf(P.a_log[h]), dtb = P.dt_bias[h];
    for (int tb = 0; tb < T; tb += 16) {
        for (int i = tid; i < 16 * 384; i += 512) { const int t = i / 384, cc = i - t * 384, sec = cc >> 7, d = cc & 127, col = sec * 2048 + h * 128 + d;
            float acc = 0.f;
#pragma unroll
            for (int j = 0; j < 4; ++j) { const int tt = tb + t - 3 + j; float xv;
                if (tt >= 0) xv = bf2f(P.proj[(size_t)(m0 + tt) * IN_WP + col]); else xv = cbuf ? cbuf[(3 + tt) * 6144 + col] : 0.f;
                acc += xv * P.conv_w[j * 6144 + col]; }
            const float y = acc * sigmoid_f(acc);
            (sec == 0 ? qs : (sec == 1 ? ks : vs))[t * 128 + d] = y; }
        for (int i = tid; i < 16 * 128; i += 512) { const int t = i >> 7, d = i & 127; zs[i] = bf2f(P.proj[(size_t)(m0 + tb + t) * IN_WP + PC_Z + h * 128 + d]); }
        if (tid < 16) { const size_t r = (size_t)(m0 + tb + tid) * IN_WP; const float b = bf2f(P.proj[r + PC_B + h]), a = bf2f(P.proj[r + PC_A + h]);
            bet[tid] = sigmoid_f(b); gg[tid] = Ah * softplus_f(a + dtb); }
        __syncthreads();
#pragma unroll
        for (int r = 0; r < 2; ++r) { const int t = 2 * wave + r;
            const float q0 = qs[t * 128 + lane], q1 = qs[t * 128 + 64 + lane], k0 = ks[t * 128 + lane], k1 = ks[t * 128 + 64 + lane];
            const float sq = wave_sum(q0 * q0 + q1 * q1), sk = wave_sum(k0 * k0 + k1 * k1);
            const float cq = 0.08838834764831845f / sqrtf(sq + 1e-6f), ck = 1.0f / sqrtf(sk + 1e-6f);
            qs[t * 128 + lane] = q0 * cq; qs[t * 128 + 64 + lane] = q1 * cq; ks[t * 128 + lane] = k0 * ck; ks[t * 128 + 64 + lane] = k1 * ck; }
        __syncthreads();
        {
#pragma unroll 1
            for (int t = 0; t < 16; ++t) {
                const float eg = __expf(gg[t]), bt = bet[t];
                float kS = 0.f;
#pragma unroll
                for (int d4 = 0; d4 < 8; ++d4) { const f32x4 kv = *(const LAS f32x4*)(ks + t * 128 + 32 * dq + 4 * d4);
                    kS += kv.x * S[4 * d4] + kv.y * S[4 * d4 + 1] + kv.z * S[4 * d4 + 2] + kv.w * S[4 * d4 + 3]; }
                kS += __shfl_xor(kS, 1); kS += __shfl_xor(kS, 2);
                const float w = bt * (vs[t * 128 + e] - eg * kS);
                float o = 0.f;
#pragma unroll
                for (int d4 = 0; d4 < 8; ++d4) { const f32x4 kv = *(const LAS f32x4*)(ks + t * 128 + 32 * dq + 4 * d4); const f32x4 qv = *(const LAS f32x4*)(qs + t * 128 + 32 * dq + 4 * d4);
                    S[4 * d4] = eg * S[4 * d4] + kv.x * w; S[4 * d4 + 1] = eg * S[4 * d4 + 1] + kv.y * w; S[4 * d4 + 2] = eg * S[4 * d4 + 2] + kv.z * w; S[4 * d4 + 3] = eg * S[4 * d4 + 3] + kv.w * w;
                    o += qv.x * S[4 * d4] + qv.y * S[4 * d4 + 1] + qv.z * S[4 * d4 + 2] + qv.w * S[4 * d4 + 3]; }
                o += __shfl_xor(o, 1); o += __shfl_xor(o, 2);
                if (dq == 0) os[t * 128 + e] = o;
            }
        }
        __syncthreads();
#pragma unroll
        for (int r = 0; r < 2; ++r) { const int t = 2 * wave + r;
            const float o0 = os[t * 128 + lane], o1 = os[t * 128 + 64 + lane];
            const float rs = 1.0f / sqrtf(wave_sum(o0 * o0 + o1 * o1) * (1.f / 128.f) + NORM_EPS);
            const float z0 = zs[t * 128 + lane], z1 = zs[t * 128 + 64 + lane];
            bf16* mp = P.mix + (size_t)(m0 + tb + t) * 4096 + h * 128;
            mp[lane] = (bf16)f2bf(o0 * rs * P.dn_norm_w[lane] * (z0 * sigmoid_f(z0))); mp[64 + lane] = (bf16)f2bf(o1 * rs * P.dn_norm_w[64 + lane] * (z1 * sigmoid_f(z1))); }
        __syncthreads();
    }
    { int so = 32 * dq * 128 + e;
#ifndef NO_LAUNDER
    asm volatile("" : "+v"(so));
#endif

#pragma unroll
    for (int j = 0; j < 32; ++j) Sout[so + j * 128] = S[j]; }
    for (int i = tid; i < 3 * 384; i += 512) { const int r = i / 384, cc = i - r * 384, col = (cc >> 7) * 2048 + h * 128 + (cc & 127);
        cout[r * 6144 + col] = bf2f(P.proj[(size_t)(m0 + T - 3 + r) * IN_WP + col]); }
}
__device__ __forceinline__ void rw_seq_item(const MixPtrs& P, const bf16* w2T_, const bf16* a2T_, const bf16* g2T_, LAS unsigned char* lds, int seq, int h, int tid, int lane, int wave) {
    const bool prm = seq < 2;
    const int T = prm ? SEQ : DEC_SEQ, sb = prm ? seq : seq - 2;
    const int m0 = prm ? seq * SEQ : M_PROMPT + sb * DEC_SEQ;
    const float* S0 = prm ? nullptr : P.state_rw + ((size_t)sb * 32 + h) * 4096;
    const float* sbuf = prm ? nullptr : P.cache_shift + (size_t)sb * RW_SHIFT_W;
    float* Sout = P.out + (prm ? O_SRW_P : O_SRW_S) + ((size_t)sb * 32 + h) * 4096;
    float* shout = P.out + (prm ? O_SHIFT_P : O_SHIFT_S) + (size_t)sb * RW_SHIFT_W;
    LAS float* rs = (LAS float*)lds; LAS float* kr = rs + 1024; LAS float* vs = kr + 1024; LAS float* xw = vs + 1024; LAS float* xa = xw + 1536; LAS float* xg = xa + 1536;
    LAS float* wd = xg + 4096; LAS float* kp = wd + 1024; LAS float* av = kp + 1024; LAS float* bv = av + 1024; LAS float* gt = bv + 1024; LAS float* ys = gt + 1024; LAS float* sbn = ys + 1024;
    float S[16];
    const int vr = (wave & 3) * 16 + (lane >> 2), kq = lane & 3;
#pragma unroll
    for (int k4 = 0; k4 < 4; ++k4) { f32x4 v = (f32x4){0.f, 0.f, 0.f, 0.f}; if (S0 != nullptr) v = *(const f32x4*)(S0 + vr * 64 + 16 * kq + 4 * k4);
        S[4 * k4] = v.x; S[4 * k4 + 1] = v.y; S[4 * k4 + 2] = v.z; S[4 * k4 + 3] = v.w; }
    const int hc = h * 64 + lane;
    const float w0c = P.w0[hc], a0c = P.a0[hc], kkc = P.k_k[hc], kac = P.k_a[hc], rkc = P.r_k[hc], lnw = P.ln_w[hc], lnb = P.ln_b[hc];
    for (int tb = 0; tb < T; tb += 16) {
        for (int i = tid; i < 16 * 640; i += 512) { const int t = i / 640, cc = i - t * 640; int col; LAS float* dst; int kind = 0;
            if (cc < 64) { col = RW_R + h * 64 + cc; dst = rs + t * 64 + cc; }
            else if (cc < 128) { col = RW_K + h * 64 + (cc - 64); dst = kr + t * 64 + (cc - 64); }
            else if (cc < 192) { col = RW_V + h * 64 + (cc - 128); dst = vs + t * 64 + (cc - 128); }
            else if (cc < 288) { col = RW_XW + (cc - 192); dst = xw + t * 96 + (cc - 192); kind = 1; }
            else if (cc < 384) { col = RW_XA + (cc - 288); dst = xa + t * 96 + (cc - 288); }
            else { col = RW_XG + (cc - 384); dst = xg + t * 256 + (cc - 384); kind = 2; }
            const int tt = tb + t; const float u = bf2f(P.proj[(size_t)(m0 + tt) * IN_WP + PC_RW + col]);
            const float up = tt > 0 ? bf2f(P.proj[(size_t)(m0 + tt - 1) * IN_WP + PC_RW + col]) : (sbuf ? sbuf[col] : 0.f);
            float v = u + P.mu[col] * (up - u);
            if (kind == 1) v = tanhf(v); else if (kind == 2) v = sigmoid_f(v);
            *dst = v; }
        __syncthreads();
        {
            float wl0 = 0.f, wl1 = 0.f, al0 = 0.f, al1 = 0.f, gl0 = 0.f, gl1 = 0.f; const int t0 = wave, t1 = wave + 8;
#ifdef OLD_SEQ
#pragma unroll 4
            for (int j = 0; j < 96; ++j) { const float w2v = P.w2[j * 2048 + hc], a2v = P.a2[j * 2048 + hc];
                wl0 += xw[t0 * 96 + j] * w2v; wl1 += xw[t1 * 96 + j] * w2v; al0 += xa[t0 * 96 + j] * a2v; al1 += xa[t1 * 96 + j] * a2v; }
#pragma unroll 4
            for (int j = 0; j < 256; ++j) { const float g2v = P.g2[j * 2048 + hc]; gl0 += xg[t0 * 256 + j] * g2v; gl1 += xg[t1 * 256 + j] * g2v; }
#else
#define SEQ_DOT8(W8, X0, X1, A0, A1) do { const v4u _w = (W8); const LAS float* _x0 = (X0); const LAS float* _x1 = (X1); \
                const f32x4 _p0 = *(const LAS f32x4*)_x0, _p1 = *(const LAS f32x4*)(_x0 + 4), _q0 = *(const LAS f32x4*)_x1, _q1 = *(const LAS f32x4*)(_x1 + 4); \
                const float _w0 = bflo(_w.x), _w1 = bfhi(_w.x), _w2 = bflo(_w.y), _w3 = bfhi(_w.y), _w4 = bflo(_w.z), _w5 = bfhi(_w.z), _w6 = bflo(_w.w), _w7 = bfhi(_w.w); \
                A0 += (_p0.x * _w0 + _p0.y * _w1) + (_p0.z * _w2 + _p0.w * _w3) + (_p1.x * _w4 + _p1.y * _w5) + (_p1.z * _w6 + _p1.w * _w7); \
                A1 += (_q0.x * _w0 + _q0.y * _w1) + (_q0.z * _w2 + _q0.w * _w3) + (_q1.x * _w4 + _q1.y * _w5) + (_q1.z * _w6 + _q1.w * _w7); } while (0)
#pragma unroll 1
            for (int cch = 0; cch < 3; ++cch) { v4u wv[4], av2[4];
#pragma unroll
                for (int p = 0; p < 4; ++p) { wv[p] = *(const GAS v4u*)(w2T_ + (size_t)hc * 96 + 32 * cch + 8 * p); av2[p] = *(const GAS v4u*)(a2T_ + (size_t)hc * 96 + 32 * cch + 8 * p); }
#pragma unroll
                for (int p = 0; p < 4; ++p) { const int j = 32 * cch + 8 * p; SEQ_DOT8(wv[p], xw + t0 * 96 + j, xw + t1 * 96 + j, wl0, wl1); SEQ_DOT8(av2[p], xa + t0 * 96 + j, xa + t1 * 96 + j, al0, al1); } }
#pragma unroll 1
            for (int cch = 0; cch < 8; ++cch) { v4u gv[4];
#pragma unroll
                for (int p = 0; p < 4; ++p) gv[p] = *(const GAS v4u*)(g2T_ + (size_t)hc * 256 + 32 * cch + 8 * p);
#pragma unroll
                for (int p = 0; p < 4; ++p) { const int j = 32 * cch + 8 * p; SEQ_DOT8(gv[p], xg + t0 * 256 + j, xg + t1 * 256 + j, gl0, gl1); } }
#undef SEQ_DOT8
#endif
#pragma unroll
            for (int r = 0; r < 2; ++r) { const int t = r ? t1 : t0; const float wl = r ? wl1 : wl0, al = r ? al1 : al0, gl = r ? gl1 : gl0;
                const float wlog = -softplus_f(-(w0c + wl)) - 0.5f; const float wdec = __expf(-__expf(wlog));
                const float a = sigmoid_f(a0c + al);
                const float krv = kr[t * 64 + lane], kkr = krv * kkc; const float kk = kkr / sqrtf(wave_sum(kkr * kkr) + 1e-6f);
                const float kpv = krv * (1.0f + (a - 1.0f) * kac);
                const float sbv = wave_sum(rs[t * 64 + lane] * kpv * rkc);
                wd[t * 64 + lane] = wdec; kp[t * 64 + lane] = kpv; av[t * 64 + lane] = -kk; bv[t * 64 + lane] = kk * a; gt[t * 64 + lane] = gl; if (lane == 0) sbn[t] = sbv; }
        }
        __syncthreads();
        if (wave < 4) {
#pragma unroll 1
            for (int t = 0; t < 16; ++t) {
                float sa = 0.f;
#pragma unroll
                for (int k4 = 0; k4 < 4; ++k4) { const f32x4 a4 = *(const LAS f32x4*)(av + t * 64 + 16 * kq + 4 * k4); sa += a4.x * S[4 * k4] + a4.y * S[4 * k4 + 1] + a4.z * S[4 * k4 + 2] + a4.w * S[4 * k4 + 3]; }
                sa += __shfl_xor(sa, 1); sa += __shfl_xor(sa, 2);
                const float vv = vs[t * 64 + vr]; float y = 0.f;
#pragma unroll
                for (int k4 = 0; k4 < 4; ++k4) { const int o4 = t * 64 + 16 * kq + 4 * k4;
                    const f32x4 w4 = *(const LAS f32x4*)(wd + o4), b4 = *(const LAS f32x4*)(bv + o4), k4v = *(const LAS f32x4*)(kp + o4), r4 = *(const LAS f32x4*)(rs + o4);
                    S[4 * k4] = S[4 * k4] * w4.x + sa * b4.x + vv * k4v.x; S[4 * k4 + 1] = S[4 * k4 + 1] * w4.y + sa * b4.y + vv * k4v.y;
                    S[4 * k4 + 2] = S[4 * k4 + 2] * w4.z + sa * b4.z + vv * k4v.z; S[4 * k4 + 3] = S[4 * k4 + 3] * w4.w + sa * b4.w + vv * k4v.w;
                    y += r4.x * S[4 * k4] + r4.y * S[4 * k4 + 1] + r4.z * S[4 * k4 + 2] + r4.w * S[4 * k4 + 3]; }
                y += __shfl_xor(y, 1); y += __shfl_xor(y, 2);
                if (kq == 0) ys[t * 64 + vr] = y;
            }
        }
        __syncthreads();
#pragma unroll
        for (int r = 0; r < 2; ++r) { const int t = wave + 8 * r; const float y = ys[t * 64 + lane];
            const float mean = wave_sum(y) * (1.f / 64.f); const float dy = y - mean; const float var = wave_sum(dy * dy) * (1.f / 64.f);
            const float yn = dy / sqrtf(var + RW_GN_EPS) * lnw + lnb;
            P.mix[(size_t)(m0 + tb + t) * 4096 + 2048 + hc] = (bf16)f2bf((yn + sbn[t] * vs[t * 64 + lane]) * gt[t * 64 + lane]); }
        __syncthreads();
    }
    if (wave < 4) { int so = vr * 64 + 16 * kq;
#ifndef NO_LAUNDER
    asm volatile("" : "+v"(so));
#endif
#pragma unroll
        for (int k4 = 0; k4 < 4; ++k4) *(f32x4*)(Sout + so + 4 * k4) = (f32x4){S[4 * k4], S[4 * k4 + 1], S[4 * k4 + 2], S[4 * k4 + 3]};
    }
    for (int i = tid; i < 206; i += 512) { const int col = h * 206 + i; shout[col] = bf2f(P.proj[(size_t)(m0 + T - 1) * IN_WP + PC_RW + col]); }
}

typedef short bf16x8 __attribute__((ext_vector_type(8)));
typedef float f32x16 __attribute__((ext_vector_type(16)));
typedef __bf16 bf16x2_t __attribute__((ext_vector_type(2)));
typedef float f32x2_t __attribute__((ext_vector_type(2)));
__device__ __forceinline__ unsigned cvt2(float lo, float hi) { f32x2_t v = {lo, hi}; return __builtin_bit_cast(unsigned, __builtin_convertvector(v, bf16x2_t)); }
#define MFMA16(a, b, c) __builtin_amdgcn_mfma_f32_16x16x32_bf16((a), (b), (c), 0, 0, 0)
#define MFMA32(a, b, c) __builtin_amdgcn_mfma_f32_32x32x16_bf16((a), (b), (c), 0, 0, 0)
__device__ __forceinline__ bf16x8 pack_step(const f32x16& x, int s) {
    v4u p; p.x = cvt2(x[8 * s], x[8 * s + 1]); p.y = cvt2(x[8 * s + 2], x[8 * s + 3]); p.z = cvt2(x[8 * s + 4], x[8 * s + 5]); p.w = cvt2(x[8 * s + 6], x[8 * s + 7]);
    return __builtin_bit_cast(bf16x8, p);
}
struct DnRec { unsigned char* rec; unsigned char* qk; float* gl; };
constexpr int DP_QN = 0, DP_KN = 17408, DP_VBT = 34816, DP_KBGT = 53248, DP_LM = 71680, DP_TM = 88320, DP_TB = 104960, DP_DINV = 114176, DP_YB = 118528, DP_SC = 122688;

__device__ __forceinline__ void tri_inv64(const LAS float* Lm, LAS float* Tm, LAS bf16* Tb, LAS float* Dinv, LAS float* Yb, int tid, int lane, int wave) {
    if (tid < 64) { const int bi = tid >> 4, j = tid & 15; float x[16];
#pragma unroll
        for (int r = 0; r < 16; ++r) { float a = (r == j) ? 1.f : 0.f;
#pragma unroll
            for (int k = 0; k < r; ++k) a -= Lm[(16 * bi + r) * 65 + 16 * bi + k] * x[k];
            x[r] = a; }
#pragma unroll
        for (int r = 0; r < 16; ++r) Dinv[(bi * 16 + r) * 17 + j] = x[r]; }
    __syncthreads();
    for (int o = tid; o < 4096; o += 512) { const int r = o >> 6, c = o & 63, bi = r >> 4;
        if (c >= 16 * bi) { const float a = (c < 16 * bi + 16) ? Dinv[r * 17 + c - 16 * bi] : 0.f; Tm[r * 65 + c] = a; Tb[r * 72 + c] = (bf16)(cvt2(a, 0.f) & 0xffffu); } }
    __syncthreads();
    const int l15 = lane & 15, q = lane >> 4;
#pragma unroll 1
    for (int i = 1; i < 4; ++i) {
        if (wave < i) { f32x4 acc = (f32x4){0.f, 0.f, 0.f, 0.f};
            for (int ks = 0; ks < 4 * i; ++ks) acc = __builtin_amdgcn_mfma_f32_16x16x4f32(Lm[(16 * i + l15) * 65 + 4 * ks + q], Tm[(4 * ks + q) * 65 + 16 * wave + l15], acc, 0, 0, 0);
#pragma unroll
            for (int reg = 0; reg < 4; ++reg) Yb[(4 * q + reg) * 65 + 16 * wave + l15] = -acc[reg]; }
        __syncthreads();
        if (wave < i) { f32x4 acc = (f32x4){0.f, 0.f, 0.f, 0.f};
#pragma unroll
            for (int ks = 0; ks < 4; ++ks) acc = __builtin_amdgcn_mfma_f32_16x16x4f32(Dinv[(16 * i + l15) * 17 + 4 * ks + q], Yb[(4 * ks + q) * 65 + 16 * wave + l15], acc, 0, 0, 0);
#pragma unroll
            for (int reg = 0; reg < 4; ++reg) { Tm[(16 * i + 4 * q + reg) * 65 + 16 * wave + l15] = acc[reg]; Tb[(16 * i + 4 * q + reg) * 72 + 16 * wave + l15] = (bf16)(cvt2(acc[reg], 0.f) & 0xffffu); } }
        __syncthreads();
    }
}

__device__ __forceinline__ void dn_prep_item(const MixPtrs& P, const DnRec& R, LAS unsigned char* lds, int b, int c, int h, int tid, int lane, int wave) {
    const int m0 = b * SEQ + 64 * c; const int item = (b * 128 + c) * 16 + h;
    LAS bf16* Qn = (LAS bf16*)(lds + DP_QN); LAS bf16* Kn = (LAS bf16*)(lds + DP_KN); LAS bf16* VbT = (LAS bf16*)(lds + DP_VBT); LAS bf16* KbgT = (LAS bf16*)(lds + DP_KBGT);
    LAS float* Lm = (LAS float*)(lds + DP_LM); LAS float* Tm = (LAS float*)(lds + DP_TM); LAS bf16* Tb = (LAS bf16*)(lds + DP_TB); LAS float* Dinv = (LAS float*)(lds + DP_DINV); LAS float* Yb = (LAS float*)(lds + DP_YB);
    LAS float* sc = (LAS float*)(lds + DP_SC); LAS float* beta = sc; LAS float* gc = sc + 64; LAS float* egc = sc + 128; LAS float* ekd = sc + 192;
    unsigned char* rec = R.rec + (size_t)item * 65536; unsigned char* qkr = R.qk + (size_t)item * 8192;
    if (wave == 0) { const int t = lane; const size_t r = (size_t)(m0 + t) * IN_WP; const float bb = bf2f(P.proj[r + PC_B + h]), aa = bf2f(P.proj[r + PC_A + h]);
        const float Ah = -__expf(P.a_log[h]), dtb = P.dt_bias[h];
        float x = Ah * softplus_f(aa + dtb);
#pragma unroll
        for (int o = 1; o < 64; o <<= 1) { const float v = __shfl_up(x, o); if (lane >= o) x += v; }
        const float gl = __shfl(x, 63);
        beta[t] = sigmoid_f(bb); gc[t] = x; egc[t] = __expf(x); ekd[t] = __expf(gl - x); if (lane == 0) R.gl[item] = __expf(gl); }
    __syncthreads();
#ifdef PD1
    for (int _pr = 0; _pr < 2; ++_pr)
#endif
#pragma unroll
    for (int r = 0; r < 6; ++r) {
        const int sec = r >> 1; const int idx = (tid + 512 * r) & 1023; const int t = idx >> 4, g8 = idx & 15; const int col = sec * 2048 + h * 128 + 8 * g8;
        float acc[8];
#pragma unroll
        for (int i = 0; i < 8; ++i) acc[i] = 0.f;
#pragma unroll
        for (int j = 0; j < 4; ++j) { const int tt = 64 * c + t - 3 + j;
            v4u xv = (v4u){0u, 0u, 0u, 0u}; if (tt >= 0) xv = *(const GAS v4u*)(P.proj + (size_t)(b * SEQ + tt) * IN_WP + col);
            const f32x4 w0 = *(const GAS f32x4*)(P.conv_w + j * 6144 + col), w1 = *(const GAS f32x4*)(P.conv_w + j * 6144 + col + 4);
            acc[0] += bflo(xv.x) * w0.x; acc[1] += bfhi(xv.x) * w0.y; acc[2] += bflo(xv.y) * w0.z; acc[3] += bfhi(xv.y) * w0.w;
            acc[4] += bflo(xv.z) * w1.x; acc[5] += bfhi(xv.z) * w1.y; acc[6] += bflo(xv.w) * w1.z; acc[7] += bfhi(xv.w) * w1.w; }
        float y[8]; float ss = 0.f;
#pragma unroll
        for (int i = 0; i < 8; ++i) { y[i] = acc[i] * sigmoid_f(acc[i]); ss += y[i] * y[i]; }
        if (sec < 2) { ss += __shfl_xor(ss, 1); ss += __shfl_xor(ss, 2); ss += __shfl_xor(ss, 4); ss += __shfl_xor(ss, 8);
            const float scl = (sec == 0 ? 0.08838834764831845f : 1.0f) / sqrtf(ss + 1e-6f);
#pragma unroll
            for (int i = 0; i < 8; ++i) y[i] *= scl; }
        if (sec == 0) { v4u o; o.x = cvt2(y[0], y[1]); o.y = cvt2(y[2], y[3]); o.z = cvt2(y[4], y[5]); o.w = cvt2(y[6], y[7]); *(LAS v4u*)(Qn + t * 136 + 8 * g8) = o; }
        else if (sec == 1) { v4u o; o.x = cvt2(y[0], y[1]); o.y = cvt2(y[2], y[3]); o.z = cvt2(y[4], y[5]); o.w = cvt2(y[6], y[7]); *(LAS v4u*)(Kn + t * 136 + 8 * g8) = o;
            const float f = beta[t] * egc[t];
#pragma unroll
            for (int i = 0; i < 8; ++i) KbgT[(8 * g8 + i) * 72 + t] = (bf16)(cvt2(y[i] * f, 0.f) & 0xffffu); }
        else { const float f = beta[t];
#pragma unroll
            for (int i = 0; i < 8; ++i) VbT[(8 * g8 + i) * 72 + t] = (bf16)(cvt2(y[i] * f, 0.f) & 0xffffu); }
    }
    __syncthreads();
#ifdef PD2
    for (int _pr = 0; _pr < 2; ++_pr) {
#else
    {
#endif
    {   const int tt = wave & 3, sp = wave >> 2, l15 = lane & 15, q = lane >> 4;
#pragma unroll
        for (int si = 0; si < 2; ++si) { const int st = 2 * sp + si;
            f32x4 aL = (f32x4){0.f, 0.f, 0.f, 0.f}, aQ = (f32x4){0.f, 0.f, 0.f, 0.f};
#pragma unroll
            for (int ks = 0; ks < 4; ++ks) {
                const bf16x8 fs = *(const LAS bf16x8*)(Kn + (16 * st + l15) * 136 + 32 * ks + 8 * q);
                const bf16x8 ft = *(const LAS bf16x8*)(Kn + (16 * tt + l15) * 136 + 32 * ks + 8 * q);
                const bf16x8 fq = *(const LAS bf16x8*)(Qn + (16 * tt + l15) * 136 + 32 * ks + 8 * q);
                aL = MFMA16(fs, ft, aL); aQ = MFMA16(fs, fq, aQ); }
            const int t = 16 * tt + l15; const float gct = gc[t], bt = beta[t]; float qv[4];
#pragma unroll
            for (int reg = 0; reg < 4; ++reg) { const int s = 16 * st + 4 * q + reg; const float dec = __expf(gct - gc[s]);
                Lm[t * 65 + s] = (t > s) ? bt * aL[reg] * dec : 0.f; qv[reg] = (t >= s) ? aQ[reg] * dec : 0.f; }
            v2u qkp; qkp.x = cvt2(qv[0], qv[1]); qkp.y = cvt2(qv[2], qv[3]);
            *(GAS v2u*)(qkr + ((((t >> 5) * 4 + st) * 64 + (t & 31) + 32 * (q & 1)) * 16 + 8 * (q >> 1))) = qkp;
        }
    }
#pragma unroll
    for (int r = 0; r < 2; ++r) { const int fl = tid + 512 * r; const int ln = fl & 63, ks = (fl >> 6) & 7, mt = fl >> 9;
        const int t = 32 * mt + (ln & 31), d0 = 16 * ks + 4 * (ln >> 5); const float f = egc[t];
        const v2u a = *(const LAS v2u*)(Qn + t * 136 + d0), bq = *(const LAS v2u*)(Qn + t * 136 + d0 + 8);
        v4u o; o.x = cvt2(bflo(a.x) * f, bfhi(a.x) * f); o.y = cvt2(bflo(a.y) * f, bfhi(a.y) * f); o.z = cvt2(bflo(bq.x) * f, bfhi(bq.x) * f); o.w = cvt2(bflo(bq.y) * f, bfhi(bq.y) * f);
        *(GAS v4u*)(rec + 16384 + fl * 16) = o; }
#pragma unroll
    for (int r = 0; r < 2; ++r) { const int fl = tid + 512 * r; const int ln = fl & 63, kt = (fl >> 6) & 3, mtd = fl >> 8;
        const int d = 32 * mtd + (ln & 31), t0 = 16 * kt + 4 * (ln >> 5); float v[8];
#pragma unroll
        for (int j = 0; j < 8; ++j) { const int t = t0 + 8 * (j >> 2) + (j & 3); v[j] = bf2f(Kn[t * 136 + d]) * ekd[t]; }
        v4u o; o.x = cvt2(v[0], v[1]); o.y = cvt2(v[2], v[3]); o.z = cvt2(v[4], v[5]); o.w = cvt2(v[6], v[7]);
        *(GAS v4u*)(rec + 32768 + fl * 16) = o; }
    __syncthreads();
    }
    tri_inv64(Lm, Tm, Tb, Dinv, Yb, tid, lane, wave);
#ifdef PD4
    for (int _pr = 0; _pr < 2; ++_pr)
#endif
    {   const int tt = wave & 3, hf = wave >> 2, l15 = lane & 15, q = lane >> 4;
        bf16x8 tf[2];
#pragma unroll
        for (int ks = 0; ks < 2; ++ks) tf[ks] = *(const LAS bf16x8*)(Tb + (16 * tt + l15) * 72 + 32 * ks + 8 * q);
#pragma unroll
        for (int n = 0; n < 4; ++n) { const int et = 4 * hf + n;
            f32x4 au = (f32x4){0.f, 0.f, 0.f, 0.f}, aw = (f32x4){0.f, 0.f, 0.f, 0.f};
#pragma unroll
            for (int ks = 0; ks < 2; ++ks) { const bf16x8 fv = *(const LAS bf16x8*)(VbT + (16 * et + l15) * 72 + 32 * ks + 8 * q); const bf16x8 fk = *(const LAS bf16x8*)(KbgT + (16 * et + l15) * 72 + 32 * ks + 8 * q);
                au = MFMA16(tf[ks], fv, au);
                aw = MFMA16(fk, tf[ks], aw); }
            v2u up; up.x = cvt2(au[0], au[1]); up.y = cvt2(au[2], au[3]);
            *(GAS v2u*)(rec + 49152 + ((16 * et + l15) * 64 + 16 * tt + 4 * q) * 2) = up;
            const int t = 16 * tt + l15; v2u wp; wp.x = cvt2(aw[0], aw[1]); wp.y = cvt2(aw[2], aw[3]);
            *(GAS v2u*)(rec + ((((t >> 5) * 8 + et) * 64 + (t & 31) + 32 * (q & 1)) * 16 + 8 * (q >> 1))) = wp; }
    }
    __syncthreads();
}

__device__ __forceinline__ void dn_scan(const MixPtrs& P, const DnRec& R, LAS unsigned char* lds, int b, int h, int tid, int lane, int wave) {
    constexpr int SB = 57344; LAS unsigned char* obuf = lds + 2 * SB;
    const int item0 = b * 128 * 16 + h;
    const bool scan = wave < 4; const int ht = tid - 256;
    const int e = 32 * (wave & 3) + (lane & 31), hh = lane >> 5;
    f32x16 S[4];
#pragma unroll
    for (int dt = 0; dt < 4; ++dt)
#pragma unroll
        for (int i = 0; i < 16; ++i) S[dt][i] = 0.f;
#define DN_LOAD_STAGE(itm, dstbuf) do { const unsigned char* _r = R.rec + (size_t)(itm) * 65536; const unsigned char* _q = R.qk + (size_t)(itm) * 8192; v4u _t[14]; \
        _Pragma("unroll") for (int _k = 0; _k < 12; ++_k) _t[_k] = *(const GAS v4u*)(_r + (ht + 256 * _k) * 16); \
        _Pragma("unroll") for (int _k = 0; _k < 2; ++_k) _t[12 + _k] = *(const GAS v4u*)(_q + (ht + 256 * _k) * 16); \
        _Pragma("unroll") for (int _k = 0; _k < 14; ++_k) *(LAS v4u*)((dstbuf) + (ht + 256 * _k) * 16) = _t[_k]; } while (0)
#define DN_POST(cc) do { const int _t = ht >> 2, _qd = ht & 3; const int _m = b * SEQ + 64 * (cc) + _t; \
        v4u _o[4], _z[4]; _Pragma("unroll") for (int _k = 0; _k < 4; ++_k) { _o[_k] = *(const LAS v4u*)(obuf + (_t * 128 + 32 * _qd + 8 * _k) * 2); _z[_k] = *(const GAS v4u*)(P.proj + (size_t)_m * IN_WP + PC_Z + h * 128 + 32 * _qd + 8 * _k); } \
        float _ss = 0.f; _Pragma("unroll") for (int _k = 0; _k < 4; ++_k) { const float a0 = bflo(_o[_k].x), a1 = bfhi(_o[_k].x), a2 = bflo(_o[_k].y), a3 = bfhi(_o[_k].y), a4 = bflo(_o[_k].z), a5 = bfhi(_o[_k].z), a6 = bflo(_o[_k].w), a7 = bfhi(_o[_k].w); \
            _ss += (a0 * a0 + a1 * a1) + (a2 * a2 + a3 * a3) + (a4 * a4 + a5 * a5) + (a6 * a6 + a7 * a7); } \
        _ss += __shfl_xor(_ss, 1); _ss += __shfl_xor(_ss, 2); const float _rs = 1.0f / sqrtf(_ss * (1.f / 128.f) + NORM_EPS); \
        _Pragma("unroll") for (int _k = 0; _k < 4; ++_k) { const GAS f32x4* _nw = (const GAS f32x4*)(P.dn_norm_w + 32 * _qd + 8 * _k); const f32x4 n0 = _nw[0], n1 = _nw[1]; \
            const float z0 = bflo(_z[_k].x), z1 = bfhi(_z[_k].x), z2 = bflo(_z[_k].y), z3 = bfhi(_z[_k].y), z4 = bflo(_z[_k].z), z5 = bfhi(_z[_k].z), z6 = bflo(_z[_k].w), z7 = bfhi(_z[_k].w); \
            v4u _w; _w.x = cvt2(bflo(_o[_k].x) * _rs * n0.x * (z0 * sigmoid_f(z0)), bfhi(_o[_k].x) * _rs * n0.y * (z1 * sigmoid_f(z1))); \
            _w.y = cvt2(bflo(_o[_k].y) * _rs * n0.z * (z2 * sigmoid_f(z2)), bfhi(_o[_k].y) * _rs * n0.w * (z3 * sigmoid_f(z3))); \
            _w.z = cvt2(bflo(_o[_k].z) * _rs * n1.x * (z4 * sigmoid_f(z4)), bfhi(_o[_k].z) * _rs * n1.y * (z5 * sigmoid_f(z5))); \
            _w.w = cvt2(bflo(_o[_k].w) * _rs * n1.z * (z6 * sigmoid_f(z6)), bfhi(_o[_k].w) * _rs * n1.w * (z7 * sigmoid_f(z7))); \
            *(GAS v4u*)(P.mix + (size_t)_m * 4096 + h * 128 + 32 * _qd + 8 * _k) = _w; } } while (0)
    if (!scan) DN_LOAD_STAGE(item0, lds);
    __syncthreads();
#pragma unroll 1
    for (int c = 0; c < 128; ++c) {
        LAS unsigned char* buf = lds + (c & 1) * SB;
        f32x16 o0, o1;
        if (scan) {
            const unsigned char* rec = R.rec + (size_t)(item0 + 16 * c) * 65536;
            v2u uu[2][4];
#pragma unroll
            for (int mt = 0; mt < 2; ++mt)
#pragma unroll
                for (int g = 0; g < 4; ++g) uu[mt][g] = *(const GAS v2u*)(rec + 49152 + (e * 64 + 32 * mt + 8 * g + 4 * hh) * 2);
            const float egl = R.gl[item0 + 16 * c];
            bf16x8 Sf[8];
#pragma unroll
            for (int dt = 0; dt < 4; ++dt) { Sf[2 * dt] = pack_step(S[dt], 0); Sf[2 * dt + 1] = pack_step(S[dt], 1); }
            f32x16 w0, w1;
#pragma unroll
            for (int i = 0; i < 16; ++i) { w0[i] = 0.f; w1[i] = 0.f; o0[i] = 0.f; o1[i] = 0.f; }
#pragma unroll
            for (int ks = 0; ks < 8; ++ks) { const bf16x8 a0 = *(const LAS bf16x8*)(buf + (ks * 64 + lane) * 16), a1 = *(const LAS bf16x8*)(buf + ((8 + ks) * 64 + lane) * 16);
                w0 = MFMA32(a0, Sf[ks], w0); w1 = MFMA32(a1, Sf[ks], w1); }
#pragma unroll
            for (int g = 0; g < 4; ++g) {
                w0[4 * g] = bflo(uu[0][g].x) - w0[4 * g]; w0[4 * g + 1] = bfhi(uu[0][g].x) - w0[4 * g + 1]; w0[4 * g + 2] = bflo(uu[0][g].y) - w0[4 * g + 2]; w0[4 * g + 3] = bfhi(uu[0][g].y) - w0[4 * g + 3];
                w1[4 * g] = bflo(uu[1][g].x) - w1[4 * g]; w1[4 * g + 1] = bfhi(uu[1][g].x) - w1[4 * g + 1]; w1[4 * g + 2] = bflo(uu[1][g].y) - w1[4 * g + 2]; w1[4 * g + 3] = bfhi(uu[1][g].y) - w1[4 * g + 3]; }
            bf16x8 Vf[4]; Vf[0] = pack_step(w0, 0); Vf[1] = pack_step(w0, 1); Vf[2] = pack_step(w1, 0); Vf[3] = pack_step(w1, 1);
#pragma unroll
            for (int ks = 0; ks < 8; ++ks) { const bf16x8 a0 = *(const LAS bf16x8*)(buf + 16384 + (ks * 64 + lane) * 16), a1 = *(const LAS bf16x8*)(buf + 16384 + ((8 + ks) * 64 + lane) * 16);
                o0 = MFMA32(a0, Sf[ks], o0); o1 = MFMA32(a1, Sf[ks], o1); }
#pragma unroll
            for (int kt = 0; kt < 4; ++kt) { const bf16x8 a0 = *(const LAS bf16x8*)(buf + 49152 + (kt * 64 + lane) * 16), a1 = *(const LAS bf16x8*)(buf + 49152 + ((4 + kt) * 64 + lane) * 16);
                o0 = MFMA32(a0, Vf[kt], o0); o1 = MFMA32(a1, Vf[kt], o1); }
#pragma unroll
            for (int dt = 0; dt < 4; ++dt) {
#pragma unroll
                for (int i = 0; i < 16; ++i) S[dt][i] *= egl;
#pragma unroll
                for (int kt = 0; kt < 4; ++kt) { const bf16x8 a = *(const LAS bf16x8*)(buf + 32768 + ((dt * 4 + kt) * 64 + lane) * 16); S[dt] = MFMA32(a, Vf[kt], S[dt]); } }
        } else {
            if (c + 1 < 128) DN_LOAD_STAGE(item0 + 16 * (c + 1), lds + ((c + 1) & 1) * SB);
            if (c > 0) DN_POST(c - 1);
        }
        __syncthreads();
        if (scan) {
#pragma unroll
            for (int i = 0; i < 16; ++i) { const int row = (i & 3) + 8 * (i >> 2) + 4 * hh;
                ((LAS bf16*)obuf)[row * 128 + e] = (bf16)(cvt2(o0[i], 0.f) & 0xffffu); ((LAS bf16*)obuf)[(32 + row) * 128 + e] = (bf16)(cvt2(o1[i], 0.f) & 0xffffu); }
        }
        __syncthreads();
    }
    if (!scan) DN_POST(127);
    else {
        float* Sout = P.out + O_SDN_P + ((size_t)b * 16 + h) * 16384;
#pragma unroll
        for (int dt = 0; dt < 4; ++dt)
#pragma unroll
            for (int i = 0; i < 16; ++i) Sout[(32 * dt + (i & 3) + 8 * (i >> 2) + 4 * hh) * 128 + e] = S[dt][i];
    }
    {   float* cout = P.out + O_CONV_P + (size_t)b * 3 * 6144;
        for (int i = tid; i < 3 * 384; i += 512) { const int r = i / 384, cc = i - r * 384, col = (cc >> 7) * 2048 + h * 128 + (cc & 127);
            cout[r * 6144 + col] = bf2f(P.proj[(size_t)(b * SEQ + SEQ - 3 + r) * IN_WP + col]); } }
    __syncthreads();
#undef DN_LOAD_STAGE
#undef DN_POST
}
struct RwRec { unsigned char* pq; unsigned char* rp; unsigned char* oo; float* sb; const bf16* w2T; const bf16* a2T; const bf16* g2T; };
constexpr int RSL = 9216;

__device__ __forceinline__ void rw_prep_item(const MixPtrs& P, const RwRec& W, LAS unsigned char* lds, int b, int c, int h, int tid, int lane, int wave) {
    const int m0 = b * SEQ + 64 * c; const int item = (b * 128 + c) * 32 + h; const int hc = h * 64 + lane;
    const int l15 = lane & 15, q = lane >> 4;
    LAS bf16* Rt = (LAS bf16*)(lds + 0 * RSL); LAS bf16* Kt = (LAS bf16*)(lds + 1 * RSL); LAS bf16* Bt = (LAS bf16*)(lds + 2 * RSL); LAS bf16* At = (LAS bf16*)(lds + 3 * RSL);
    LAS bf16* AtT = (LAS bf16*)(lds + 4 * RSL); LAS bf16* KhT = (LAS bf16*)(lds + 5 * RSL); LAS bf16* BhT = (LAS bf16*)(lds + 6 * RSL); LAS bf16* VT = (LAS bf16*)(lds + 7 * RSL);
    LAS bf16* Aak = (LAS bf16*)(lds + 8 * RSL); LAS bf16* Ark = (LAS bf16*)(lds + 9 * RSL); LAS bf16* Arb = (LAS bf16*)(lds + 10 * RSL);
    LAS float* Lm = (LAS float*)(lds + 11 * RSL); LAS float* Tm = (LAS float*)(lds + 1 * RSL); LAS bf16* Tb = (LAS bf16*)(lds + 3 * RSL);
    LAS bf16* WtT = (LAS bf16*)(lds + 11 * RSL); LAS bf16* XT = (LAS bf16*)(lds + 12 * RSL); LAS bf16* U0T = (LAS bf16*)(lds + 1 * RSL);
    LAS float* Dinv = (LAS float*)(lds + 13 * RSL); LAS float* Yb = (LAS float*)(lds + 13 * RSL + 4352);
    LAS float* wl = (LAS float*)(lds + 0); LAS float* al = (LAS float*)(lds + 2 * RSL);
    LAS bf16* txw = (LAS bf16*)(lds + 8 * RSL); LAS bf16* xas = txw + 64 * 104; LAS bf16* w2s = xas + 64 * 104; LAS bf16* a2s = w2s + 64 * 104;
    LAS float* wtot = (LAS float*)(lds + 126976); LAS float* eGCs = (LAS float*)(lds + 129024);
    float rr[8], kr[8], vv[8];
    {   float ur[9], uk[9], uv[9];
#pragma unroll
        for (int i = 0; i < 9; ++i) { const int tt = 64 * c + wave * 8 + i - 1;
            if (tt >= 0) { const size_t ro = (size_t)(b * SEQ + tt) * IN_WP + PC_RW + hc; ur[i] = bf2f(P.proj[ro + RW_R]); uk[i] = bf2f(P.proj[ro + RW_K]); uv[i] = bf2f(P.proj[ro + RW_V]); }
            else { ur[i] = 0.f; uk[i] = 0.f; uv[i] = 0.f; } }
        const float mr = P.mu[RW_R + hc], mk = P.mu[RW_K + hc], mv = P.mu[RW_V + hc];
#pragma unroll
        for (int i = 0; i < 8; ++i) { rr[i] = ur[i + 1] + mr * (ur[i] - ur[i + 1]); kr[i] = uk[i + 1] + mk * (uk[i] - uk[i + 1]); vv[i] = uv[i + 1] + mv * (uv[i] - uv[i + 1]); }
    }
#ifdef PR1
    for (int _pr = 0; _pr < 2; ++_pr) {
#else
    {
#endif
#pragma unroll
    for (int r = 0; r < 3; ++r) { const int i = tid + 512 * r; const int which = i >= 768, ii = which ? i - 768 : i; const int t = ii / 12, g8 = ii - t * 12; const int tt = 64 * c + t;
        const int col = (which ? RW_XA : RW_XW) + 8 * g8;
        const v4u u = *(const GAS v4u*)(P.proj + (size_t)(m0 + t) * IN_WP + PC_RW + col); v4u up = (v4u){0u, 0u, 0u, 0u}; if (tt > 0) up = *(const GAS v4u*)(P.proj + (size_t)(m0 + t - 1) * IN_WP + PC_RW + col);
        const f32x4 m0v = *(const GAS f32x4*)(P.mu + col), m1v = *(const GAS f32x4*)(P.mu + col + 4);
        float x[8];
        x[0] = bflo(u.x) + m0v.x * (bflo(up.x) - bflo(u.x)); x[1] = bfhi(u.x) + m0v.y * (bfhi(up.x) - bfhi(u.x)); x[2] = bflo(u.y) + m0v.z * (bflo(up.y) - bflo(u.y)); x[3] = bfhi(u.y) + m0v.w * (bfhi(up.y) - bfhi(u.y));
        x[4] = bflo(u.z) + m1v.x * (bflo(up.z) - bflo(u.z)); x[5] = bfhi(u.z) + m1v.y * (bfhi(up.z) - bfhi(u.z)); x[6] = bflo(u.w) + m1v.z * (bflo(up.w) - bflo(u.w)); x[7] = bfhi(u.w) + m1v.w * (bfhi(up.w) - bfhi(u.w));
        if (!which) {
#pragma unroll
            for (int k = 0; k < 8; ++k) { const float e2 = __expf(2.0f * x[k]); x[k] = 1.0f - 2.0f / (e2 + 1.0f); } }
        v4u o; o.x = cvt2(x[0], x[1]); o.y = cvt2(x[2], x[3]); o.z = cvt2(x[4], x[5]); o.w = cvt2(x[6], x[7]);
        *(LAS v4u*)(txw + which * 6656 + t * 104 + 8 * g8) = o; }
    bf16x8 fw2[2][3], fa2[2][3];
#pragma unroll
    for (int ci = 0; ci < 2; ++ci)
#pragma unroll
        for (int ks = 0; ks < 3; ++ks) { const size_t o = (size_t)(h * 64 + 16 * (2 * (wave >> 2) + ci) + l15) * 96 + 32 * ks + 8 * q;
            fw2[ci][ks] = *(const GAS bf16x8*)(W.w2T + o); fa2[ci][ks] = *(const GAS bf16x8*)(W.a2T + o); }
    __syncthreads();
    {   const int tt = wave & 3, cp = wave >> 2;
#pragma unroll
        for (int ci = 0; ci < 2; ++ci) { const int ct = 2 * cp + ci;
            f32x4 aw = (f32x4){0.f, 0.f, 0.f, 0.f}, aa = (f32x4){0.f, 0.f, 0.f, 0.f};
#pragma unroll
            for (int ks = 0; ks < 3; ++ks) {
                const bf16x8 fx = *(const LAS bf16x8*)(txw + (16 * tt + l15) * 104 + 32 * ks + 8 * q), fa = *(const LAS bf16x8*)(xas + (16 * tt + l15) * 104 + 32 * ks + 8 * q);
                aw = MFMA16(fx, fw2[ci][ks], aw); aa = MFMA16(fa, fa2[ci][ks], aa); }
#pragma unroll
            for (int reg = 0; reg < 4; ++reg) { wl[(16 * tt + 4 * q + reg) * 65 + 16 * ct + l15] = aw[reg]; al[(16 * tt + 4 * q + reg) * 65 + 16 * ct + l15] = aa[reg]; } }
    }
    }
    __syncthreads();
    float lw[8], av[8], bvv[8], kp[8], Gt[8];
    {   const float w0c = P.w0[hc], a0c = P.a0[hc], kkc = P.k_k[hc], kac = P.k_a[hc], rkc = P.r_k[hc];
        float run = 0.f;
#pragma unroll
        for (int i = 0; i < 8; ++i) { const int t = wave * 8 + i;
            const float wlog = -softplus_f(-(w0c + wl[t * 65 + lane])) - 0.5f; lw[i] = -__expf(wlog);
            const float alr = sigmoid_f(a0c + al[t * 65 + lane]);
            const float kkr = kr[i] * kkc; const float kk = kkr / sqrtf(wave_sum(kkr * kkr) + 1e-6f);
            kp[i] = kr[i] * (1.0f + (alr - 1.0f) * kac); av[i] = -kk; bvv[i] = kk * alr;
            const float sbv = wave_sum(rr[i] * kp[i] * rkc); if (lane == 0) W.sb[(size_t)item * 64 + t] = sbv;
            run += lw[i]; Gt[i] = run; }
        wtot[wave * 64 + lane] = run;
    }
    __syncthreads();
    {   float off = 0.f, gcv = 0.f;
#pragma unroll
        for (int w = 0; w < 8; ++w) { const float x = wtot[w * 64 + lane]; gcv += x; if (w < wave) off += x; }
        if (wave == 0) eGCs[lane] = __expf(gcv);
        float tA[8], tK[8], tB[8];
#pragma unroll
        for (int i = 0; i < 8; ++i) { const int t = wave * 8 + i; const float G = Gt[i] + off;
            const float eG = __expf(G), eGm = __expf(-G), eGp = __expf(G - lw[i]), eH = __expf(gcv - G);
            Rt[t * 72 + lane] = (bf16)(cvt2(rr[i] * eG, 0.f) & 0xffffu); Kt[t * 72 + lane] = (bf16)(cvt2(kp[i] * eGm, 0.f) & 0xffffu);
            Bt[t * 72 + lane] = (bf16)(cvt2(bvv[i] * eGm, 0.f) & 0xffffu); tA[i] = av[i] * eGp; At[t * 72 + lane] = (bf16)(cvt2(tA[i], 0.f) & 0xffffu);
            tK[i] = kp[i] * eH; tB[i] = bvv[i] * eH; }
        v4u o;
        o.x = cvt2(tA[0], tA[1]); o.y = cvt2(tA[2], tA[3]); o.z = cvt2(tA[4], tA[5]); o.w = cvt2(tA[6], tA[7]); *(LAS v4u*)(AtT + lane * 72 + wave * 8) = o;
        o.x = cvt2(tK[0], tK[1]); o.y = cvt2(tK[2], tK[3]); o.z = cvt2(tK[4], tK[5]); o.w = cvt2(tK[6], tK[7]); *(LAS v4u*)(KhT + lane * 72 + wave * 8) = o;
        o.x = cvt2(tB[0], tB[1]); o.y = cvt2(tB[2], tB[3]); o.z = cvt2(tB[4], tB[5]); o.w = cvt2(tB[6], tB[7]); *(LAS v4u*)(BhT + lane * 72 + wave * 8) = o;
        o.x = cvt2(vv[0], vv[1]); o.y = cvt2(vv[2], vv[3]); o.z = cvt2(vv[4], vv[5]); o.w = cvt2(vv[6], vv[7]); *(LAS v4u*)(VT + lane * 72 + wave * 8) = o;
    }
    __syncthreads();
#ifdef PR4
    for (int _pr = 0; _pr < 2; ++_pr)
#endif
    {   const int tt = wave & 3, sp = wave >> 2;
        bf16x8 fA[2], fR[2];
#pragma unroll
        for (int ks = 0; ks < 2; ++ks) { fA[ks] = *(const LAS bf16x8*)(At + (16 * tt + l15) * 72 + 32 * ks + 8 * q); fR[ks] = *(const LAS bf16x8*)(Rt + (16 * tt + l15) * 72 + 32 * ks + 8 * q); }
#pragma unroll
        for (int si = 0; si < 2; ++si) { const int st = 2 * sp + si;
            f32x4 ab = (f32x4){0.f, 0.f, 0.f, 0.f}, ak = ab, rk = ab, rb = ab;
#pragma unroll
            for (int ks = 0; ks < 2; ++ks) { const bf16x8 fB = *(const LAS bf16x8*)(Bt + (16 * st + l15) * 72 + 32 * ks + 8 * q), fK = *(const LAS bf16x8*)(Kt + (16 * st + l15) * 72 + 32 * ks + 8 * q);
                ab = MFMA16(fB, fA[ks], ab); ak = MFMA16(fK, fA[ks], ak); rk = MFMA16(fK, fR[ks], rk); rb = MFMA16(fB, fR[ks], rb); }
            const int t = 16 * tt + l15, s0 = 16 * st + 4 * q; float vak[4], vrk[4], vrb[4];
#pragma unroll
            for (int reg = 0; reg < 4; ++reg) { const int s = s0 + reg; Lm[t * 65 + s] = (t > s) ? -ab[reg] : 0.f; vak[reg] = (t > s) ? ak[reg] : 0.f; vrk[reg] = (t >= s) ? rk[reg] : 0.f; vrb[reg] = (t >= s) ? rb[reg] : 0.f; }
            v2u o; o.x = cvt2(vak[0], vak[1]); o.y = cvt2(vak[2], vak[3]); *(LAS v2u*)(Aak + t * 72 + s0) = o;
            o.x = cvt2(vrk[0], vrk[1]); o.y = cvt2(vrk[2], vrk[3]); *(LAS v2u*)(Ark + t * 72 + s0) = o;
            o.x = cvt2(vrb[0], vrb[1]); o.y = cvt2(vrb[2], vrb[3]); *(LAS v2u*)(Arb + t * 72 + s0) = o; }
    }
    __syncthreads();
    tri_inv64(Lm, Tm, Tb, Dinv, Yb, tid, lane, wave);
#ifdef PR2
    tri_inv64(Lm, Tm, Tb, Dinv, Yb, tid, lane, wave);
#endif
#ifdef PR5
    for (int _pr = 0; _pr < 2; ++_pr) {
#else
    {
#endif
    {   const int tt = wave & 3, cp = wave >> 2;
        bf16x8 fT[2], fK[2];
#pragma unroll
        for (int ks = 0; ks < 2; ++ks) { fT[ks] = *(const LAS bf16x8*)(Tb + (16 * tt + l15) * 72 + 32 * ks + 8 * q); fK[ks] = *(const LAS bf16x8*)(Aak + (16 * tt + l15) * 72 + 32 * ks + 8 * q); }
#pragma unroll
        for (int ci = 0; ci < 2; ++ci) { const int ct = 2 * cp + ci;
            f32x4 aw = (f32x4){0.f, 0.f, 0.f, 0.f}, ax = aw;
#pragma unroll
            for (int ks = 0; ks < 2; ++ks) { const bf16x8 fa = *(const LAS bf16x8*)(AtT + (16 * ct + l15) * 72 + 32 * ks + 8 * q), fv = *(const LAS bf16x8*)(VT + (16 * ct + l15) * 72 + 32 * ks + 8 * q);
                aw = MFMA16(fT[ks], fa, aw); ax = MFMA16(fK[ks], fv, ax); }
            v2u o; o.x = cvt2(aw[0], aw[1]); o.y = cvt2(aw[2], aw[3]); *(LAS v2u*)(WtT + (16 * ct + l15) * 72 + 16 * tt + 4 * q) = o;
            o.x = cvt2(ax[0], ax[1]); o.y = cvt2(ax[2], ax[3]); *(LAS v2u*)(XT + (16 * ct + l15) * 72 + 16 * tt + 4 * q) = o; }
    }
    __syncthreads();
    {   const int tt = wave & 3, cp = wave >> 2;
#pragma unroll
        for (int ci = 0; ci < 2; ++ci) { const int et = 2 * cp + ci; f32x4 au = (f32x4){0.f, 0.f, 0.f, 0.f};
#pragma unroll
            for (int ks = 0; ks < 2; ++ks) { const bf16x8 fT = *(const LAS bf16x8*)(Tb + (16 * tt + l15) * 72 + 32 * ks + 8 * q), fx = *(const LAS bf16x8*)(XT + (16 * et + l15) * 72 + 32 * ks + 8 * q);
                au = MFMA16(fT, fx, au); }
            v2u o; o.x = cvt2(au[0], au[1]); o.y = cvt2(au[2], au[3]); *(LAS v2u*)(U0T + (16 * et + l15) * 72 + 16 * tt + 4 * q) = o; }
    }
    __syncthreads();
    }
#ifdef PR3
    for (int _pr = 0; _pr < 2; ++_pr)
#endif
    {   const int bt = wave & 3, ap = wave >> 2;
        unsigned char* pq = W.pq + (size_t)item * 16384; unsigned char* rp = W.rp + (size_t)item * 8192; unsigned char* oo = W.oo + (size_t)item * 8192;
        bf16x8 fArb[2], fArk[2], fBh[2], fV[2], fU[2];
#pragma unroll
        for (int ks = 0; ks < 2; ++ks) { fArb[ks] = *(const LAS bf16x8*)(Arb + (16 * bt + l15) * 72 + 32 * ks + 8 * q); fArk[ks] = *(const LAS bf16x8*)(Ark + (16 * bt + l15) * 72 + 32 * ks + 8 * q);
            fBh[ks] = *(const LAS bf16x8*)(BhT + (16 * bt + l15) * 72 + 32 * ks + 8 * q); fV[ks] = *(const LAS bf16x8*)(VT + (16 * bt + l15) * 72 + 32 * ks + 8 * q); fU[ks] = *(const LAS bf16x8*)(U0T + (16 * bt + l15) * 72 + 32 * ks + 8 * q); }
#pragma unroll
        for (int ai = 0; ai < 2; ++ai) { const int at = 2 * ap + ai;
            f32x4 aR = (f32x4){0.f, 0.f, 0.f, 0.f}, aP = aR, aO = aR, aQ = aR;
#pragma unroll
            for (int ks = 0; ks < 2; ++ks) {
                const bf16x8 fW = *(const LAS bf16x8*)(WtT + (16 * at + l15) * 72 + 32 * ks + 8 * q);
                aR = MFMA16(fW, fArb[ks], aR);
                aP = MFMA16(fW, fBh[ks], aP);
                const bf16x8 fk = *(const LAS bf16x8*)(Ark + (16 * at + l15) * 72 + 32 * ks + 8 * q), fb = *(const LAS bf16x8*)(Arb + (16 * at + l15) * 72 + 32 * ks + 8 * q);
                aO = MFMA16(fk, fV[ks], aO); aO = MFMA16(fb, fU[ks], aO);
                const bf16x8 fkh = *(const LAS bf16x8*)(KhT + (16 * at + l15) * 72 + 32 * ks + 8 * q), fbh = *(const LAS bf16x8*)(BhT + (16 * at + l15) * 72 + 32 * ks + 8 * q);
                aQ = MFMA16(fkh, fV[ks], aQ); aQ = MFMA16(fbh, fU[ks], aQ); }
            const int x = 16 * bt + l15, y0 = 16 * at + 4 * q;
            {   const v2u rt = *(const LAS v2u*)(Rt + x * 72 + y0);
                v2u o; o.x = cvt2(aR[0] + bflo(rt.x), aR[1] + bfhi(rt.x)); o.y = cvt2(aR[2] + bflo(rt.y), aR[3] + bfhi(rt.y));
                *(GAS v2u*)(rp + ((((x >> 5) * 4 + at) * 64 + (x & 31) + 32 * (q & 1)) * 16 + 8 * (q >> 1))) = o; }
            {   const float dg = eGCs[x]; float p[4];
#pragma unroll
                for (int reg = 0; reg < 4; ++reg) p[reg] = aP[reg] + ((y0 + reg == x) ? dg : 0.f);
                v2u o; o.x = cvt2(p[0], p[1]); o.y = cvt2(p[2], p[3]);
                *(GAS v2u*)(pq + ((((x >> 5) * 4 + at) * 64 + (x & 31) + 32 * (q & 1)) * 16 + 8 * (q >> 1))) = o; }
            {   v2u o; o.x = cvt2(aO[0], aO[1]); o.y = cvt2(aO[2], aO[3]); *(GAS v2u*)(oo + (x * 64 + y0) * 2) = o; }
            {   v2u o; o.x = cvt2(aQ[0], aQ[1]); o.y = cvt2(aQ[2], aQ[3]); *(GAS v2u*)(pq + 8192 + (x * 64 + y0) * 2) = o; }
        }
    }
    __syncthreads();
}

__device__ __forceinline__ void rw_scan(const MixPtrs& P, const RwRec& W, LAS unsigned char* lds, int b, int h, int tid, int lane, int wave) {
    constexpr int SB = 33792;
    const int item0 = b * 128 * 32 + h;
    const bool scan = wave < 2; const int ht = tid - 128;
    const int e = 32 * (wave & 1) + (lane & 31), hh = lane >> 5;
    f32x16 H[2];
#pragma unroll
    for (int i = 0; i < 16; ++i) { H[0][i] = 0.f; H[1][i] = 0.f; }
#define RW_LOAD_STAGE(itm, dstbuf) do { const unsigned char* _pq = W.pq + (size_t)(itm) * 16384; const unsigned char* _rp = W.rp + (size_t)(itm) * 8192; const unsigned char* _oo = W.oo + (size_t)(itm) * 8192; v4u _t[6]; \
        _Pragma("unroll") for (int _k = 0; _k < 6; ++_k) { const int _i = ht + 384 * _k; if (_i < 2048) _t[_k] = *(const GAS v4u*)(_i < 512 ? _pq + _i * 16 : (_i < 1024 ? _rp + (_i - 512) * 16 : (_i < 1536 ? _pq + 8192 + (_i - 1024) * 16 : _oo + (_i - 1536) * 16))); } \
        _Pragma("unroll") for (int _k = 0; _k < 6; ++_k) { const int _i = ht + 384 * _k; if (_i < 1024) *(LAS v4u*)((dstbuf) + _i * 16) = _t[_k]; \
            else if (_i < 2048) { const int _j = _i - 1024; LAS unsigned char* _d = (dstbuf) + 16384 + (_j >> 3) * 136 + (_j & 7) * 16; *(LAS v2u*)_d = (v2u){_t[_k].x, _t[_k].y}; *(LAS v2u*)(_d + 8) = (v2u){_t[_k].z, _t[_k].w}; } } } while (0)
#define RW_STORE_O(itm, srcbuf) do { unsigned char* _oo = W.oo + (size_t)(itm) * 8192; \
        _Pragma("unroll") for (int _k = 4; _k < 6; ++_k) { const int _i = ht + 384 * _k; if (_i < 2048) { const int _j = _i - 1024; const LAS unsigned char* _s = (srcbuf) + 16384 + (_j >> 3) * 136 + (_j & 7) * 16; \
            const v2u _a = *(const LAS v2u*)_s, _b = *(const LAS v2u*)(_s + 8); *(GAS v4u*)(_oo + (_i - 1536) * 16) = (v4u){_a.x, _a.y, _b.x, _b.y}; } } } while (0)
    if (!scan) RW_LOAD_STAGE(item0, lds);
    __syncthreads();
#pragma unroll 1
    for (int c = 0; c < 128; ++c) {
        LAS unsigned char* buf = lds + (c & 1) * SB;
        if (scan) {
            bf16x8 Hf[4]; Hf[0] = pack_step(H[0], 0); Hf[1] = pack_step(H[0], 1); Hf[2] = pack_step(H[1], 0); Hf[3] = pack_step(H[1], 1);
#pragma unroll
            for (int mt = 0; mt < 2; ++mt) {
                f32x16 hn, ov;
#pragma unroll
                for (int g = 0; g < 4; ++g) { const v2u qv = *(const LAS v2u*)(buf + 16384 + e * 136 + (32 * mt + 8 * g + 4 * hh) * 2), o0 = *(const LAS v2u*)(buf + 16384 + 8704 + e * 136 + (32 * mt + 8 * g + 4 * hh) * 2);
                    hn[4 * g] = bflo(qv.x); hn[4 * g + 1] = bfhi(qv.x); hn[4 * g + 2] = bflo(qv.y); hn[4 * g + 3] = bfhi(qv.y);
                    ov[4 * g] = bflo(o0.x); ov[4 * g + 1] = bfhi(o0.x); ov[4 * g + 2] = bflo(o0.y); ov[4 * g + 3] = bfhi(o0.y); }
#pragma unroll
                for (int ks = 0; ks < 4; ++ks) { const bf16x8 fp = *(const LAS bf16x8*)(buf + ((mt * 4 + ks) * 64 + lane) * 16), fr = *(const LAS bf16x8*)(buf + 8192 + ((mt * 4 + ks) * 64 + lane) * 16);
                    hn = MFMA32(fp, Hf[ks], hn); ov = MFMA32(fr, Hf[ks], ov); }
#pragma unroll
                for (int g = 0; g < 4; ++g) { v2u o; o.x = cvt2(ov[4 * g], ov[4 * g + 1]); o.y = cvt2(ov[4 * g + 2], ov[4 * g + 3]); *(LAS v2u*)(buf + 16384 + 8704 + e * 136 + (32 * mt + 8 * g + 4 * hh) * 2) = o; }
                if (mt == 0) H[0] = hn; else H[1] = hn;
            }
        } else {
            if (c > 0) RW_STORE_O(item0 + 32 * (c - 1), lds + ((c - 1) & 1) * SB);
            if (c + 1 < 128) RW_LOAD_STAGE(item0 + 32 * (c + 1), lds + ((c + 1) & 1) * SB);
        }
        __syncthreads();
    }
    if (!scan) RW_STORE_O(item0 + 32 * 127, lds + SB);
    else {
        float* Sout = P.out + O_SRW_P + ((size_t)b * 32 + h) * 4096;
#pragma unroll
        for (int mt = 0; mt < 2; ++mt)
#pragma unroll
            for (int g = 0; g < 4; ++g) *(f32x4*)(Sout + e * 64 + 32 * mt + 8 * g + 4 * hh) = (f32x4){H[mt][4 * g], H[mt][4 * g + 1], H[mt][4 * g + 2], H[mt][4 * g + 3]};
    }
    {   float* shout = P.out + O_SHIFT_P + (size_t)b * RW_SHIFT_W;
        for (int i = tid; i < 206; i += 512) { const int col = h * 206 + i; shout[col] = bf2f(P.proj[(size_t)(b * SEQ + SEQ - 1) * IN_WP + PC_RW + col]); } }
    __syncthreads();
#undef RW_LOAD_STAGE
#undef RW_STORE_O
}

__device__ __forceinline__ void rw_post_stage_g2(const RwRec& W, LAS unsigned char* lds, int h, int tid) {
    LAS bf16* g2s = (LAS bf16*)(lds + 33792);
#pragma unroll
    for (int r = 0; r < 4; ++r) { const int i = tid + 512 * r; const int row = i >> 5, part = i & 31;
        *(LAS v4u*)(g2s + row * 264 + part * 8) = *(const GAS v4u*)(W.g2T + (size_t)(h * 64 + row) * 256 + part * 8); }
    __syncthreads();
}
__device__ __forceinline__ void rw_post_item(const MixPtrs& P, const RwRec& W, LAS unsigned char* lds, int b, int c, int h, int tid, int lane, int wave) {
    const int m0 = b * SEQ + 64 * c; const int item = (b * 128 + c) * 32 + h; const int hc = h * 64 + lane;
    const int l15 = lane & 15, q = lane >> 4;
    LAS bf16* sxg = (LAS bf16*)lds; LAS bf16* g2s = (LAS bf16*)(lds + 33792); LAS float* gate = (LAS float*)(lds + 67584);
#pragma unroll
    for (int r = 0; r < 4; ++r) { const int i = tid + 512 * r; const int t = i >> 5, g8 = i & 31; const int tt = 64 * c + t; const int col = RW_XG + 8 * g8;
        const v4u u = *(const GAS v4u*)(P.proj + (size_t)(m0 + t) * IN_WP + PC_RW + col); v4u up = (v4u){0u, 0u, 0u, 0u}; if (tt > 0) up = *(const GAS v4u*)(P.proj + (size_t)(m0 + t - 1) * IN_WP + PC_RW + col);
        const f32x4 m0v = *(const GAS f32x4*)(P.mu + col), m1v = *(const GAS f32x4*)(P.mu + col + 4);
        float x[8];
        x[0] = bflo(u.x) + m0v.x * (bflo(up.x) - bflo(u.x)); x[1] = bfhi(u.x) + m0v.y * (bfhi(up.x) - bfhi(u.x)); x[2] = bflo(u.y) + m0v.z * (bflo(up.y) - bflo(u.y)); x[3] = bfhi(u.y) + m0v.w * (bfhi(up.y) - bfhi(u.y));
        x[4] = bflo(u.z) + m1v.x * (bflo(up.z) - bflo(u.z)); x[5] = bfhi(u.z) + m1v.y * (bfhi(up.z) - bfhi(u.z)); x[6] = bflo(u.w) + m1v.z * (bflo(up.w) - bflo(u.w)); x[7] = bfhi(u.w) + m1v.w * (bfhi(up.w) - bfhi(u.w));
        v4u o; o.x = cvt2(sigmoid_f(x[0]), sigmoid_f(x[1])); o.y = cvt2(sigmoid_f(x[2]), sigmoid_f(x[3])); o.z = cvt2(sigmoid_f(x[4]), sigmoid_f(x[5])); o.w = cvt2(sigmoid_f(x[6]), sigmoid_f(x[7]));
        *(LAS v4u*)(sxg + t * 264 + 8 * g8) = o; }
    float y[8], vv[8];
    {   const v4u ov = *(const GAS v4u*)(W.oo + (size_t)item * 8192 + (lane * 64 + wave * 8) * 2);
        y[0] = bflo(ov.x); y[1] = bfhi(ov.x); y[2] = bflo(ov.y); y[3] = bfhi(ov.y); y[4] = bflo(ov.z); y[5] = bfhi(ov.z); y[6] = bflo(ov.w); y[7] = bfhi(ov.w);
        float uv[9];
#pragma unroll
        for (int i = 0; i < 9; ++i) { const int tt = 64 * c + wave * 8 + i - 1; uv[i] = tt >= 0 ? bf2f(P.proj[(size_t)(b * SEQ + tt) * IN_WP + PC_RW + RW_V + hc]) : 0.f; }
        const float mv = P.mu[RW_V + hc];
#pragma unroll
        for (int i = 0; i < 8; ++i) vv[i] = uv[i + 1] + mv * (uv[i] - uv[i + 1]);
    }
    __syncthreads();
    {   const int tt = wave & 3, vp = wave >> 2;
#pragma unroll
        for (int vi = 0; vi < 2; ++vi) { const int vt = 2 * vp + vi; f32x4 ag = (f32x4){0.f, 0.f, 0.f, 0.f};
#pragma unroll
            for (int ks = 0; ks < 8; ++ks) { const bf16x8 fx = *(const LAS bf16x8*)(sxg + (16 * tt + l15) * 264 + 32 * ks + 8 * q), fg = *(const LAS bf16x8*)(g2s + (16 * vt + l15) * 264 + 32 * ks + 8 * q);
                ag = MFMA16(fx, fg, ag); }
#pragma unroll
            for (int reg = 0; reg < 4; ++reg) gate[(16 * tt + 4 * q + reg) * 65 + 16 * vt + l15] = ag[reg]; }
    }
    __syncthreads();
    {   const float lnw = P.ln_w[hc], lnb = P.ln_b[hc];
#pragma unroll
        for (int i = 0; i < 8; ++i) { const int t = wave * 8 + i;
            const float mean = wave_sum(y[i]) * (1.f / 64.f); const float dy = y[i] - mean; const float var = wave_sum(dy * dy) * (1.f / 64.f);
            const float yn = dy / sqrtf(var + RW_GN_EPS) * lnw + lnb; const float sbv = W.sb[(size_t)item * 64 + t];
            P.mix[(size_t)(m0 + t) * 4096 + 2048 + hc] = (bf16)(cvt2((yn + sbv * vv[i]) * gate[t * 65 + lane], 0.f) & 0xffffu); }
    }
    __syncthreads();
}

constexpr int NPH = 10;
#define MK_N_LAUNCHES 1
#ifndef MK_N_LAUNCHES
#define MK_N_LAUNCHES 1
#endif
#ifndef REP_MASK
#define REP_MASK 0
#endif
__global__ void __launch_bounds__(NWAVES * 64, 2) hymba_fwd(Args args) {
    extern __shared__ __attribute__((aligned(16))) unsigned char lds_raw[];
    LAS unsigned char* lds = (LAS unsigned char*)lds_raw;
    volatile LAS unsigned* MISC = (volatile LAS unsigned*)(lds + MISC_OFF);
    const int tid = threadIdx.x, lane = tid & 63, wave = __builtin_amdgcn_readfirstlane(tid >> 6);
    const int G = gridDim.x;
    unsigned char* ws = args.ws;
    gu32* ctl = (gu32*)(ws + WS_CTL);
    for (int u = tid; u < (LDS_BYTES - LDSCTL_OFF) / 4; u += NWAVES * 64) ((LAS unsigned*)(lds + LDSCTL_OFF))[u] = 0u;
    __syncthreads();
    XcdBarrier bar; bar.bar = (unsigned*)(ctl + CW_BAR); bar.x = 0; bar.st = nullptr;
    if (MK_N_LAUNCHES == 1) bar = xcd_barrier_post((unsigned*)(ctl + CW_BAR), MISC + 8);
    const int lo = args.ph_lo, hi = args.ph_hi;
#ifdef ONLY_PHASE
#define IN(k) ((k) == ONLY_PHASE)
#else
#define IN(k) (lo <= (k) && (k) < hi)
#endif
#define SEAM(k) do { if (IN(k) && IN((k) + 1)) xcd_barrier(bar); } while (0)
    float* ssq = (float*)(ws + WS_SSQ);
    bf16* Wt_out = (bf16*)(ws + WS_WOUT); bf16* hbuf = (bf16*)(ws + WS_HBUF); bf16* proj = (bf16*)(ws + WS_PROJ); bf16* act = (bf16*)(ws + WS_PROJ);
    bf16* Wt_in = (bf16*)(ws + WS_WIN); bf16* Wt_gu = (bf16*)(ws + WS_WGU); bf16* Wt_dn = (bf16*)(ws + WS_WDN);
    bf16* w2T = (bf16*)(ws + WS_W2T); bf16* a2T = (bf16*)(ws + WS_A2T); bf16* g2T = (bf16*)(ws + WS_G2T);
    const float* x_prompt = args.in[0]; const float* x_sample = args.in[1];
    const int gw = blockIdx.x * NWAVES + wave, NGW = G * NWAVES;

    if (IN(0)) _Pragma("unroll") for (int _r = 0; _r < 1 + ((REP_MASK >> 0) & 1); ++_r) {
        LAS float* scr = (LAS float*)(lds + RING_OFF + wave * 16384);
        constexpr int I_IN = 64 * (IN_W / 32), I_OUT = 64 * 128;
        constexpr int NITEMS = I_IN + I_OUT;
        for (int it = gw; it < NITEMS; it += NGW) {
            if (it < I_IN) p0_transpose_item(args.in[8], 4096, IN_W, Wt_in, scr, it, lane, RmId{});
            else p0_transpose_item(args.in[24], 4096, 4096, Wt_out, scr, it - I_IN, lane, RmId{});
        }
        for (int i = blockIdx.x * 512 + tid; i < 2048 * 448; i += G * 512) {
            if (i < 2048 * 96) { const int c = i / 96, j = i - c * 96; w2T[i] = (bf16)f2bf(args.in[15][j * 2048 + c]); }
            else if (i < 2048 * 192) { const int ii = i - 2048 * 96; const int c = ii / 96, j = ii - c * 96; a2T[ii] = (bf16)f2bf(args.in[17][j * 2048 + c]); }
            else { const int ii = i - 2048 * 192; const int c = ii >> 8, j = ii & 255; g2T[ii] = (bf16)f2bf(args.in[18][j * 2048 + c]); }
        }
        for (int i = blockIdx.x * 512 + tid; i < 32 * 4096 / 8; i += G * 512) ((GAS v4u*)(Wt_in + (size_t)IN_W * 4096))[i] = (v4u){0u, 0u, 0u, 0u};
        for (int m = gw; m < MPAD; m += NGW) {
            bf16* orow = hbuf + (size_t)m * 4096;
            if (m < M_REAL) { const float* xrow = m < M_PROMPT ? x_prompt + (size_t)m * 4096 : x_sample + (size_t)(m - M_PROMPT) * 4096;
                const GAS f32x4* xr = (const GAS f32x4*)xrow + lane; f32x4 v[16];
#pragma unroll
                for (int j = 0; j < 16; ++j) v[j] = xr[64 * j];
                rms_row_to_bf16(v, args.in[6], orow, lane); }
            else { GAS v2u* o8 = (GAS v2u*)orow + lane;
#pragma unroll
                for (int j = 0; j < 16; ++j) o8[64 * j] = (v2u){0u, 0u}; }
        }
    }
    SEAM(0);
    if (IN(1)) _Pragma("unroll") for (int _r = 0; _r < 1 + ((REP_MASK >> 1) & 1); ++_r) {
        pg8::Gemm g{hbuf, Wt_in, MPAD, IN_WP, 4096, 4096, 4096}; pg8::StaticOrder S; S.init(MPAD, IN_WP, G, (int)blockIdx.x);
        pg8::EpiBf16Plain E{proj, IN_WP};
        pg8::gemm_phase<pg8::EpiBf16Plain, pg8::StaticOrder, true, true>(lds + RING_OFF, g, S, E);
    }
#ifdef PROBE_GEMM_RESIDENT
    if (IN(1)) {
        struct ProbeOrder : pg8::StaticOrder { __device__ bool next(int i, pg8::Unit& u) const { if (i >= 15) return false; u.pm = c & 7; u.pn = (c >> 3) & 3; return true; } };
        pg8::Gemm g{hbuf, Wt_in, MPAD, IN_WP, 4096, 4096, 4096}; ProbeOrder S; S.init(MPAD, IN_WP, G, (int)blockIdx.x);
        pg8::EpiBf16Plain E{Wt_gu, IN_WP};
        pg8::gemm_phase<pg8::EpiBf16Plain, ProbeOrder, true, true>(lds + RING_OFF, g, S, E);
    }
#endif
    SEAM(1);
    MixPtrs P; P.proj = proj; P.mix = hbuf; P.state_dn = args.in[2]; P.cache_conv = args.in[3]; P.state_rw = args.in[4]; P.cache_shift = args.in[5];
    P.conv_w = args.in[9]; P.a_log = args.in[10]; P.dt_bias = args.in[11]; P.dn_norm_w = args.in[12];
    P.mu = args.in[13]; P.w0 = args.in[14]; P.w2 = args.in[15]; P.a0 = args.in[16]; P.a2 = args.in[17]; P.g2 = args.in[18]; P.k_k = args.in[19]; P.k_a = args.in[20]; P.r_k = args.in[21];
    P.ln_w = args.in[22]; P.ln_b = args.in[23]; P.out = args.out;
    DnRec R; R.rec = (unsigned char*)args.out; R.qk = ws + WS_DNQK; R.gl = (float*)(ws + WS_DNGL);
    RwRec W; W.pq = ws + WS_RWPQ; W.rp = ws + WS_RWRP; W.oo = ws + WS_RWOO; W.sb = (float*)(ws + WS_RWSB); W.w2T = w2T; W.a2T = a2T; W.g2T = g2T;
    if (IN(2)) _Pragma("unroll") for (int _r = 0; _r < 1 + ((REP_MASK >> 2) & 1); ++_r) {
#ifndef REP_DNP
#define REP_DNP 0
#endif
#ifndef REP_RWP
#define REP_RWP 0
#endif
        for (int _q = 0; _q <= REP_DNP; ++_q)
        for (int it = blockIdx.x; it < 4096; it += G) dn_prep_item(P, R, lds + RING_OFF, it >> 11, (it >> 4) & 127, it & 15, tid, lane, wave);
        for (int _q = 0; _q <= REP_RWP; ++_q)
        for (int it = blockIdx.x; it < 8192; it += G) rw_prep_item(P, W, lds + RING_OFF, it >> 12, (it >> 5) & 127, it & 31, tid, lane, wave);
    }
    SEAM(2);
    if (IN(3)) _Pragma("unroll") for (int _r = 0; _r < 1 + ((REP_MASK >> 3) & 1); ++_r) {
        const int wg = blockIdx.x;
        if (wg < 32) dn_scan(P, R, lds + RING_OFF, wg >> 4, wg & 15, tid, lane, wave);
        else if (wg < 96) rw_scan(P, W, lds + RING_OFF, (wg - 32) >> 5, (wg - 32) & 31, tid, lane, wave);
        else {
            for (int it = wg - 96; it < 384; it += G - 96) {
                if (it < 128) dn_seq_item(P, lds + RING_OFF, 2 + (it >> 4), it & 15, tid, lane, wave);
                else rw_seq_item(P, w2T, a2T, g2T, lds + RING_OFF, 2 + ((it - 128) >> 5), (it - 128) & 31, tid, lane, wave);
            }
        }
    }
    SEAM(3);
    if (IN(4)) _Pragma("unroll") for (int _r = 0; _r < 1 + ((REP_MASK >> 4) & 1); ++_r) {
        if ((G & 31) == 0) rw_post_stage_g2(W, lds + RING_OFF, blockIdx.x & 31, tid);
        for (int it = blockIdx.x; it < 8192; it += G) rw_post_item(P, W, lds + RING_OFF, it >> 12, (it >> 5) & 127, it & 31, tid, lane, wave);
        LAS float* scr = (LAS float*)(lds + RING_OFF + wave * 16384);
        constexpr int I_G = 64 * (D_FF / 32), I_D = (D_FF / 64) * 128;
        for (int it = gw; it < 2 * I_G + I_D; it += NGW) {
            if (it < I_G) p0_transpose_item(args.in[27], 4096, D_FF, Wt_gu, scr, it, lane, RmGU{0});
            else if (it < 2 * I_G) p0_transpose_item(args.in[28], 4096, D_FF, Wt_gu, scr, it - I_G, lane, RmGU{1});
            else p0_transpose_item(args.in[29], D_FF, 4096, Wt_dn, scr, it - 2 * I_G, lane, RmId{});
        }
        __syncthreads();
    }
    SEAM(4);
    if (IN(5)) _Pragma("unroll") for (int _r = 0; _r < 1 + ((REP_MASK >> 5) & 1); ++_r) {
#ifdef OLD_TAILS
        { pg8::Gemm g{hbuf, Wt_out, MPAD, 4096, 4096, 4096, 4096}; pg8::StaticOrder S; S.init(MPAD, 4096, G, (int)blockIdx.x);
        pg8::EpiF32Ssq E{args.out + O_Y, 4096, ssq, M_REAL};
        pg8::gemm_phase<pg8::EpiF32Ssq, pg8::StaticOrder, true, true>(lds + RING_OFF, g, S, E); }
#else
        pg8::Gemm g{hbuf, Wt_out, M_PROMPT, 4096, 4096, 4096, 4096}; pg8::StaticOrder S; S.init(M_PROMPT, 4096, G, (int)blockIdx.x);
        pg8::EpiF32Ssq E{args.out + O_Y, 4096, ssq, M_REAL};
        pg8::gemm_phase<pg8::EpiF32Ssq, pg8::StaticOrder, true, true>(lds + RING_OFF, g, S, E);
        pg8::Gemm gt{hbuf, Wt_out, MPAD, 4096, 256, 4096, 4096}; pg8::TailOrder St{16 * 16, G, (int)blockIdx.x, 0, 256, 0};
        pg8::EpiF32Part Et{(float*)(ws + WS_PART2), 4096};
        pg8::gemm_phase<pg8::EpiF32Part, pg8::TailOrder, true, true>(lds + RING_OFF, gt, St, Et);
#endif
    }
    SEAM(5);
    if (IN(6)) _Pragma("unroll") for (int _r = 0; _r < 1 + ((REP_MASK >> 6) & 1); ++_r) {
        for (int m = gw; m < M_REAL; m += NGW) {
            const float* xrow = m < M_PROMPT ? x_prompt + (size_t)m * 4096 : x_sample + (size_t)(m - M_PROMPT) * 4096;
            const GAS f32x4* xr = (const GAS f32x4*)xrow + lane; GAS f32x4* tr = (GAS f32x4*)(args.out + O_Y + (size_t)m * 4096) + lane; const GAS f32x4* gr = (const GAS f32x4*)args.in[7] + lane;
            f32x4 v[16]; float s = 0.f;
#ifdef OLD_TAILS
            const bool smp = false;
#else
            const bool smp = m >= M_PROMPT;
#endif
            if (smp) {
                const GAS f32x4* pp = (const GAS f32x4*)(ws + WS_PART2) + (size_t)(m - M_PROMPT) * 1024 + lane;
#pragma unroll
                for (int j = 0; j < 16; ++j) { f32x4 t[16];
#pragma unroll
                    for (int sp = 0; sp < 16; ++sp) t[sp] = pp[(size_t)sp * 128 * 1024 + 64 * j];
                    const f32x4 a = ((t[0] + t[1]) + (t[2] + t[3])) + ((t[4] + t[5]) + (t[6] + t[7])) + (((t[8] + t[9]) + (t[10] + t[11])) + ((t[12] + t[13]) + (t[14] + t[15])));
                    v[j] = a; s += (a.x * a.x + a.y * a.y) + (a.z * a.z + a.w * a.w); }
            } else {
#pragma unroll
                for (int j = 0; j < 16; ++j) v[j] = tr[64 * j];
                s = ssq[(size_t)m * 64 + lane];
            }
            s = wave_sum(s);
            const float rstd = 1.0f / sqrtf(s * (1.f / 4096.f) + NORM_EPS);
#pragma unroll
            for (int hh = 0; hh < 2; ++hh) { f32x4 xv[8], gv[8];
#pragma unroll
                for (int j = 0; j < 8; ++j) { xv[j] = xr[64 * (8 * hh + j)]; gv[j] = gr[64 * (8 * hh + j)]; }
#pragma unroll
                for (int j = 0; j < 8; ++j) { v[8 * hh + j] = xv[j] + v[8 * hh + j] * rstd * gv[j]; tr[64 * (8 * hh + j)] = v[8 * hh + j]; } }
            rms_row_to_bf16(v, args.in[25], hbuf + (size_t)m * 4096, lane);
        }
    }
    SEAM(6);
    if (IN(7)) _Pragma("unroll") for (int _r = 0; _r < 1 + ((REP_MASK >> 7) & 1); ++_r) {
        pg8::Gemm g{hbuf, Wt_gu, MPAD, 2 * D_FF, 4096, 4096, 4096}; pg8::StaticOrder S; S.init(MPAD, 2 * D_FF, G, (int)blockIdx.x);
        pg8::EpiSwiGLU E{act, D_FF};
        pg8::gemm_phase<pg8::EpiSwiGLU, pg8::StaticOrder, true, true>(lds + RING_OFF, g, S, E);
    }
    SEAM(7);
    if (IN(8)) _Pragma("unroll") for (int _r = 0; _r < 1 + ((REP_MASK >> 8) & 1); ++_r) {
#ifdef OLD_TAILS
        { pg8::Gemm g{act, Wt_dn, MPAD, 4096, D_FF, D_FF, D_FF}; pg8::StaticOrder S; S.init(MPAD, 4096, G, (int)blockIdx.x);
        pg8::EpiBf16Ssq E{hbuf, 4096, ssq};
        pg8::gemm_phase<pg8::EpiBf16Ssq, pg8::StaticOrder, true, true>(lds + RING_OFF, g, S, E); }
#else
        pg8::Gemm g{act, Wt_dn, M_PROMPT, 4096, D_FF, D_FF, D_FF}; pg8::StaticOrder S; S.init(M_PROMPT, 4096, G, (int)blockIdx.x);
        pg8::EpiBf16Ssq E{hbuf, 4096, ssq};
        pg8::gemm_phase<pg8::EpiBf16Ssq, pg8::StaticOrder, true, true>(lds + RING_OFF, g, S, E);
#ifdef REP_G4MAIN
        pg8::gemm_phase<pg8::EpiBf16Ssq, pg8::StaticOrder, true, true>(lds + RING_OFF, g, S, E);
#endif
        pg8::EpiF32Part Et{(float*)(ws + WS_PART4), 4096};
        pg8::Gemm ga{act, Wt_dn, MPAD, 4096, 768, D_FF, D_FF}; pg8::TailOrder Sa{16 * 6, G, (int)blockIdx.x - 160, 0, 768, 0};
        pg8::gemm_phase<pg8::EpiF32Part, pg8::TailOrder, true, true>(lds + RING_OFF, ga, Sa, Et);
        pg8::Gemm gb{act, Wt_dn, MPAD, 4096, 640, D_FF, D_FF}; pg8::TailOrder Sb{16 * 10, G, (int)blockIdx.x < 160 ? (int)blockIdx.x : -1, 4608, 640, 6};
        pg8::gemm_phase<pg8::EpiF32Part, pg8::TailOrder, true, true>(lds + RING_OFF, gb, Sb, Et);
#ifdef REP_G4TAIL
        pg8::gemm_phase<pg8::EpiF32Part, pg8::TailOrder, true, true>(lds + RING_OFF, ga, Sa, Et);
        pg8::gemm_phase<pg8::EpiF32Part, pg8::TailOrder, true, true>(lds + RING_OFF, gb, Sb, Et);
#endif
#endif
    }
    SEAM(8);
    if (IN(9)) _Pragma("unroll") for (int _r = 0; _r < 1 + ((REP_MASK >> 9) & 1); ++_r) {
        for (int m = gw; m < M_REAL; m += NGW) {
            GAS f32x4* orow = (GAS f32x4*)(args.out + O_Y + (size_t)m * 4096) + lane; const GAS v2u* fr = (const GAS v2u*)(hbuf + (size_t)m * 4096) + lane; const GAS f32x4* gr = (const GAS f32x4*)args.in[26] + lane;
            f32x4 f[16]; float s = 0.f;
#ifdef OLD_TAILS
            const bool smp = false;
#else
            const bool smp = m >= M_PROMPT;
#endif
            if (smp) { const GAS f32x4* fs = (const GAS f32x4*)(ws + WS_PART4) + (size_t)(m - M_PROMPT) * 1024 + lane;
#pragma unroll
                for (int j = 0; j < 16; ++j) { f32x4 t[16];
#pragma unroll
                    for (int sp = 0; sp < 16; ++sp) t[sp] = fs[(size_t)sp * 128 * 1024 + 64 * j];
                    const f32x4 a = ((t[0] + t[1]) + (t[2] + t[3])) + ((t[4] + t[5]) + (t[6] + t[7])) + (((t[8] + t[9]) + (t[10] + t[11])) + ((t[12] + t[13]) + (t[14] + t[15])));
                    f[j] = a; s += (a.x * a.x + a.y * a.y) + (a.z * a.z + a.w * a.w); }
            } else {
                v2u fv[16];
#pragma unroll
                for (int j = 0; j < 16; ++j) fv[j] = fr[64 * j];
                s = ssq[(size_t)m * 64 + lane];
#pragma unroll
                for (int j = 0; j < 16; ++j) { f[j].x = __builtin_bit_cast(float, fv[j].x << 16); f[j].y = __builtin_bit_cast(float, fv[j].x & 0xffff0000u); f[j].z = __builtin_bit_cast(float, fv[j].y << 16); f[j].w = __builtin_bit_cast(float, fv[j].y & 0xffff0000u); }
            }
            s = wave_sum(s);
            const float rstd = 1.0f / sqrtf(s * (1.f / 4096.f) + NORM_EPS);
#pragma unroll
            for (int hh = 0; hh < 2; ++hh) { f32x4 xv[8], gv[8];
#pragma unroll
                for (int j = 0; j < 8; ++j) { xv[j] = orow[64 * (8 * hh + j)]; gv[j] = gr[64 * (8 * hh + j)]; }
#pragma unroll
                for (int j = 0; j < 8; ++j) orow[64 * (8 * hh + j)] = xv[j] + f[8 * hh + j] * rstd * gv[j]; }
        }
    }
#undef IN
#undef SEAM
}

extern "C" void kernel_launch(void* const* d_in, const int* in_sizes, int n_in, void* d_out, int out_size, void* d_ws, size_t ws_size, hipStream_t stream) {
    static int grid = 0;
    if (grid == 0) {
        if (n_in != 30 || out_size != (int)O_END || ws_size < WS_END) { fprintf(stderr, "kernel_launch: unexpected shapes (n_in %d out %d ws %zu)\n", n_in, out_size, ws_size); grid = -1; return; }
        int dev = 0, cus = 0, per_cu = 0;
        if (hipGetDevice(&dev) != hipSuccess || hipDeviceGetAttribute(&cus, hipDeviceAttributeMultiprocessorCount, dev) != hipSuccess) { grid = -1; return; }
        if (hipFuncSetAttribute((const void*)hymba_fwd, hipFuncAttributeMaxDynamicSharedMemorySize, LDS_BYTES) != hipSuccess) { grid = -1; return; }
        if (hipOccupancyMaxActiveBlocksPerMultiprocessor(&per_cu, (const void*)hymba_fwd, NWAVES * 64, LDS_BYTES) != hipSuccess || per_cu < 1) { fprintf(stderr, "kernel_launch: occupancy query says %d\n", per_cu); }
        (void)hipGetLastError();
        grid = cus;
    }
    if (grid < 0) return;
    if (hipMemsetAsync((char*)d_ws + WS_CTL, 0, CTL_ZERO_BYTES, stream) != hipSuccess) return;
    Args a{};
    for (int i = 0; i < 30; ++i) a.in[i] = (const float*)d_in[i];
    a.out = (float*)d_out; a.ws = (unsigned char*)d_ws;
    if (MK_N_LAUNCHES == 1) { a.ph_lo = 0; a.ph_hi = NPH; hipLaunchKernelGGL(hymba_fwd, dim3(grid), dim3(NWAVES * 64), LDS_BYTES, stream, a); }
    else for (int p = 0; p < NPH; ++p) { a.ph_lo = p; a.ph_hi = p + 1; hipLaunchKernelGGL(hymba_fwd, dim3(grid), dim3(NWAVES * 64), LDS_BYTES, stream, a); }
}
```

```cpp
#include <hip/hip_runtime.h>
#include <cstdio>
#include <cstdint>

namespace pg8 {
#define PG8_LAS __attribute__((address_space(3)))
typedef unsigned short bf16_t;
typedef short bf16x8 __attribute__((ext_vector_type(8)));
typedef float f32x4 __attribute__((ext_vector_type(4)));
typedef unsigned u32x4 __attribute__((ext_vector_type(4)));
constexpr int BM = 256, BK = 64, HALF = 128, HTB = HALF * BK * 2  , STAGE_BYTES = 8 * HTB, NXCD = 8, WGM = 8;

__host__ __device__ __forceinline__ int lds_byte(int r, int c) { const int st = (r >> 4) * 2 + (c >> 5), rr = r & 15, cc = c & 31, ob = rr * 64 + cc * 2; return st * 1024 + (ob ^ (((ob >> 9) & 1) << 5)); }
__host__ __device__ __forceinline__ void stage_rc(int b, int& R, int& C) { const int st = b / 1024, sb = b % 1024, swz = sb ^ (((sb >> 9) & 1) << 5); R = (st >> 1) * 16 + swz / 64; C = (st & 1) * 32 + (swz % 64) / 2; }
__host__ __device__ __forceinline__ int perm32(int rho) { const int n = rho >> 4, i = rho & 15; return 8 * (i >> 2) + 4 * n + (i & 3); }

struct Unit { int pm, pn, ko, pi; };
struct Gemm { const bf16_t* A; const bf16_t* Bt; int M, N, K, lda, ldb; };

struct StaticOrder {
    int nM, nN, nwg, G, c;
    __host__ __device__ void init(int M, int N, int G_, int c_) { nM = M / BM; nN = N / BM; nwg = nM * nN; G = G_; c = c_; }
    __host__ __device__ bool next(int i, Unit& u) const {
        const long L = (long)i * G + c; if (L >= nwg) return false;
        int wgid = (int)L; { const int q = nwg / NXCD, r = nwg % NXCD, xcd = wgid % NXCD, off = wgid / NXCD; wgid = (xcd < r ? xcd * (q + 1) : r * (q + 1) + (xcd - r) * q) + off; }
        const int nig = WGM * nN, gid = wgid / nig, fm = gid * WGM, gsz = (nM - fm) < WGM ? (nM - fm) : WGM;
        u.pm = fm + ((wgid % nig) % gsz); u.pn = (wgid % nig) / gsz; u.ko = 0; u.pi = 0; return true;
    }
    __device__ __forceinline__ void a_ready(const Unit&) const {}
    __device__ __forceinline__ void done(const Unit&) const {}
};
__device__ __forceinline__ unsigned cvt_pk_bf16(float lo, float hi) { unsigned r; asm volatile("v_cvt_pk_bf16_f32 %0, %1, %2" : "=v"(r) : "v"(lo), "v"(hi)); return r; }

struct EpiBf16Plain {
    static constexpr bool PERM = true, AFTER_DRAIN = false;
    bf16_t* O; int ldc;
    __device__ __forceinline__ void operator()(const f32x4 (&acc)[2][2][4][2], const Unit& u, int wr, int wc, int fr, int fq) const {
        const int row0 = u.pm * BM + wr * 64 + fr, col0 = u.pn * BM + wc * 32 + 8 * fq;
#pragma unroll
        for (int ai = 0; ai < 2; ++ai)
#pragma unroll
            for (int m = 0; m < 4; ++m) { bf16_t* rowp = O + (size_t)(row0 + ai * HALF + m * 16) * ldc + col0;
#pragma unroll
                for (int bj = 0; bj < 2; ++bj) { const f32x4 v0 = acc[ai][bj][m][0], v1 = acc[ai][bj][m][1];
                    u32x4 w; w.x = cvt_pk_bf16(v0[0], v0[1]); w.y = cvt_pk_bf16(v0[2], v0[3]); w.z = cvt_pk_bf16(v1[0], v1[1]); w.w = cvt_pk_bf16(v1[2], v1[3]);
                    *(u32x4*)(rowp + bj * HALF) = w; } }
    }
};
__device__ __forceinline__ float silu_f(float x) { return x * __builtin_amdgcn_rcpf(1.0f + __expf(-x)); }
struct EpiSwiGLU {
    static constexpr bool PERM = true, AFTER_DRAIN = false;
    bf16_t* O; int ldc;
    __device__ __forceinline__ void operator()(const f32x4 (&acc)[2][2][4][2], const Unit& u, int wr, int wc, int fr, int fq) const {
        const int row0 = u.pm * BM + wr * 64 + fr, col0 = u.pn * HALF + wc * 32 + 8 * fq;
#pragma unroll
        for (int ai = 0; ai < 2; ++ai)
#pragma unroll
            for (int m = 0; m < 4; ++m) { bf16_t* rowp = O + (size_t)(row0 + ai * HALF + m * 16) * ldc + col0;
                const f32x4 g0 = acc[ai][0][m][0], g1 = acc[ai][0][m][1], u0 = acc[ai][1][m][0], u1 = acc[ai][1][m][1];
                u32x4 w; w.x = cvt_pk_bf16(silu_f(g0[0]) * u0[0], silu_f(g0[1]) * u0[1]); w.y = cvt_pk_bf16(silu_f(g0[2]) * u0[2], silu_f(g0[3]) * u0[3]);
                w.z = cvt_pk_bf16(silu_f(g1[0]) * u1[0], silu_f(g1[1]) * u1[1]); w.w = cvt_pk_bf16(silu_f(g1[2]) * u1[2], silu_f(g1[3]) * u1[3]);
                *(u32x4*)rowp = w; }
    }
};
struct EpiF32Ssq {
    static constexpr bool PERM = false, AFTER_DRAIN = false;
    float* C; int ldc; float* ssq; int mreal;
    __device__ __forceinline__ void operator()(const f32x4 (&acc)[2][2][4][2], const Unit& u, int wr, int wc, int fr, int fq) const {
        const int row0 = u.pm * BM + wr * 64 + fr, col0 = u.pn * BM + wc * 32 + 4 * fq;
#pragma unroll
        for (int ai = 0; ai < 2; ++ai)
#pragma unroll
            for (int m = 0; m < 4; ++m) { const int row = row0 + ai * HALF + m * 16; float s = 0.f;
#pragma unroll
                for (int bj = 0; bj < 2; ++bj)
#pragma unroll
                    for (int n = 0; n < 2; ++n) { const f32x4 v = acc[ai][bj][m][n]; s += (v[0] * v[0] + v[1] * v[1]) + (v[2] * v[2] + v[3] * v[3]);
                        if (row < mreal) *(f32x4*)(C + (size_t)row * ldc + col0 + bj * HALF + n * 16) = v; }
                s += __shfl_xor(s, 16); s += __shfl_xor(s, 32);
                if (fq == 0) ssq[(size_t)row * 64 + u.pn * 4 + wc] = s; }
    }
};
struct EpiBf16Ssq {
    static constexpr bool PERM = true, AFTER_DRAIN = false;
    bf16_t* O; int ldc; float* ssq;
    __device__ __forceinline__ void operator()(const f32x4 (&acc)[2][2][4][2], const Unit& u, int wr, int wc, int fr, int fq) const {
        const int row0 = u.pm * BM + wr * 64 + fr, col0 = u.pn * BM + wc * 32 + 8 * fq;
#pragma unroll
        for (int ai = 0; ai < 2; ++ai)
#pragma unroll
            for (int m = 0; m < 4; ++m) { const int row = row0 + ai * HALF + m * 16; bf16_t* rowp = O + (size_t)row * ldc + col0; float s = 0.f;
#pragma unroll
                for (int bj = 0; bj < 2; ++bj) { const f32x4 v0 = acc[ai][bj][m][0], v1 = acc[ai][bj][m][1];
                    s += (v0[0] * v0[0] + v0[1] * v0[1]) + (v0[2] * v0[2] + v0[3] * v0[3]) + (v1[0] * v1[0] + v1[1] * v1[1]) + (v1[2] * v1[2] + v1[3] * v1[3]);
                    u32x4 w; w.x = cvt_pk_bf16(v0[0], v0[1]); w.y = cvt_pk_bf16(v0[2], v0[3]); w.z = cvt_pk_bf16(v1[0], v1[1]); w.w = cvt_pk_bf16(v1[2], v1[3]);
                    *(u32x4*)(rowp + bj * HALF) = w; }
                s += __shfl_xor(s, 16); s += __shfl_xor(s, 32);
                if (fq == 0) ssq[(size_t)row * 64 + u.pn * 4 + wc] = s; }
    }
};
struct EpiF32Part {
    static constexpr bool PERM = false, AFTER_DRAIN = false;
    float* P; int ldc;
    __device__ __forceinline__ void operator()(const f32x4 (&acc)[2][2][4][2], const Unit& u, int wr, int wc, int fr, int fq) const {
        const int rowl = wr * 64 + fr, col0 = u.pn * BM + wc * 32 + 4 * fq; float* base = P + (size_t)u.pi * 128 * ldc;
#pragma unroll
        for (int m = 0; m < 4; ++m)
#pragma unroll
            for (int bj = 0; bj < 2; ++bj)
#pragma unroll
                for (int n = 0; n < 2; ++n) *(f32x4*)(base + (size_t)(rowl + m * 16) * ldc + col0 + bj * HALF + n * 16) = acc[0][bj][m][n];
    }
};
struct TailOrder {
    int nsub, G, c, kbase, klen, pbase;
    __device__ bool next(int i, Unit& u) const { const int idx = i * G + c; if (c < 0 || idx >= nsub) return false; const int sp = idx >> 4; u.pm = 64; u.pn = idx & 15; u.ko = kbase + sp * klen; u.pi = pbase + sp; return true; }
    __device__ __forceinline__ void a_ready(const Unit&) const {}
    __device__ __forceinline__ void done(const Unit&) const {}
};
struct SubsetOrder {
    int nN, nunits, nw, c;
    __device__ bool next(int i, Unit& u) const { const int idx = i * nw + c; if (c < 0 || idx >= nunits) return false; u.pm = idx / nN; u.pn = idx - u.pm * nN; u.ko = 0; u.pi = 0; return true; }
    __device__ __forceinline__ void a_ready(const Unit&) const {}
    __device__ __forceinline__ void done(const Unit&) const {}
};
template <class Epi, class Sched, bool ALIGN_EPI = false, bool SP2 = false>
__device__ __forceinline__ void gemm_phase(PG8_LAS unsigned char* lds, const Gemm g, const Sched& S, const Epi& E) {
    const int tid = threadIdx.x, wid = __builtin_amdgcn_readfirstlane(tid >> 6), lane = tid & 63, wr = wid >> 2, wc = wid & 3, fr = lane & 15, fq = lane >> 4;
    const int K = g.K, nt = K / BK;
    unsigned voffA[2], voffB[2];
#pragma unroll
    for (int i = 0; i < 2; ++i) { int R, C; stage_rc(tid * 16 + i * 8192, R, C); const int Rb = Epi::PERM ? ((R & ~31) + perm32(R & 31)) : R;
        voffA[i] = (unsigned)(R * g.lda + C) * 2u; voffB[i] = (unsigned)(Rb * g.ldb + C) * 2u; }
    const size_t kstep = (size_t)(BK * 2);
    const size_t hstepA = (size_t)HALF * g.lda * 2, hstepB = (size_t)HALF * g.ldb * 2;
    const size_t tstepA = 2 * hstepA, tstepB = 2 * hstepB;
    const unsigned ldsw = (unsigned)wid * 1024u;
    const int aoff = lds_byte(wr * 64 + fr, fq * 8), boff = lds_byte(wc * 32 + fr, fq * 8);
#define PG8_SA(b, h) (((b) * 2 + (h)) * HTB)
#define PG8_SB(b, h) ((4 + (b) * 2 + (h)) * HTB)
#define PG8_STAGE(bufoff, gbase, voff) do { _Pragma("unroll") for (int _i = 0; _i < 2; ++_i) \
        __builtin_amdgcn_global_load_lds((const unsigned*)((const char*)(gbase) + (voff)[_i]), (PG8_LAS unsigned*)(lds + (bufoff) + ldsw + _i * 8192), 16, 0, 0); } while (0)
#define PG8_LDA(dst, b, h) do { _Pragma("unroll") for (int m = 0; m < 4; ++m) _Pragma("unroll") for (int k = 0; k < 2; ++k) dst[m][k] = *(const PG8_LAS bf16x8*)(lds + PG8_SA(b, h) + aoff + m * 2048 + k * 1024); } while (0)
#define PG8_LDB(dst, b, h) do { _Pragma("unroll") for (int n = 0; n < 2; ++n) _Pragma("unroll") for (int k = 0; k < 2; ++k) dst[n][k] = *(const PG8_LAS bf16x8*)(lds + PG8_SB(b, h) + boff + n * 2048 + k * 1024); } while (0)
#define PG8_MMA(ai, bj, At, Bt) do { __builtin_amdgcn_s_setprio(1); _Pragma("unroll") for (int m = 0; m < 4; ++m) _Pragma("unroll") for (int n = 0; n < 2; ++n) _Pragma("unroll") for (int k = 0; k < 2; ++k) \
        acc[ai][bj][m][n] = __builtin_amdgcn_mfma_f32_16x16x32_bf16(Bt[n][k], At[m][k], acc[ai][bj][m][n], 0, 0, 0); __builtin_amdgcn_s_setprio(0); } while (0)
#define PG8_WAIT_V(n) asm volatile("s_waitcnt vmcnt(" #n ")" ::: "memory")
#define PG8_WAIT_L(n) asm volatile("s_waitcnt lgkmcnt(" #n ")" ::: "memory")
#define PG8_BAR __builtin_amdgcn_s_barrier()
#define PG8_SCHED __builtin_amdgcn_sched_barrier(0)
    Unit cur, nxt; int ui = 0;
    if (!S.next(0, cur)) return;
    f32x4 acc[2][2][4][2];
#pragma unroll
    for (int a = 0; a < 2; ++a)
#pragma unroll
        for (int b = 0; b < 2; ++b)
#pragma unroll
            for (int m = 0; m < 4; ++m)
#pragma unroll
                for (int n = 0; n < 2; ++n) acc[a][b][m][n] = (f32x4){0.f, 0.f, 0.f, 0.f};
    bf16x8 At[4][2], B0[2][2], B1[2][2];
    const char* cA = (const char*)g.A + (size_t)cur.pm * tstepA + (size_t)cur.ko * 2; const char* cB = (const char*)g.Bt + (size_t)cur.pn * tstepB + (size_t)cur.ko * 2;
    S.a_ready(cur);
    if constexpr (SP2) {
        PG8_STAGE(PG8_SB(0, 0), cB, voffB); PG8_STAGE(PG8_SB(0, 1), cB + hstepB, voffB); PG8_STAGE(PG8_SA(0, 0), cA, voffA); PG8_STAGE(PG8_SA(0, 1), cA + hstepA, voffA);
        if (wr == 1) PG8_BAR;
        PG8_WAIT_V(2); PG8_BAR;
        PG8_STAGE(PG8_SB(1, 0), cB + kstep, voffB); PG8_STAGE(PG8_SA(1, 0), cA + kstep, voffA); PG8_STAGE(PG8_SB(1, 1), cB + hstepB + kstep, voffB);
        PG8_WAIT_V(6); PG8_BAR;
    } else {
        PG8_STAGE(PG8_SB(0, 0), cB, voffB); PG8_STAGE(PG8_SA(0, 0), cA, voffA); PG8_STAGE(PG8_SB(0, 1), cB + hstepB, voffB); PG8_STAGE(PG8_SA(0, 1), cA + hstepA, voffA);
        if (wr == 1) PG8_BAR;
        PG8_WAIT_V(4); PG8_BAR;
        PG8_STAGE(PG8_SB(1, 0), cB + kstep, voffB); PG8_STAGE(PG8_SA(1, 0), cA + kstep, voffA); PG8_STAGE(PG8_SB(1, 1), cB + hstepB + kstep, voffB);
        PG8_WAIT_V(6); PG8_BAR;
    }
    for (;;) {
        const bool has_next = S.next(ui + 1, nxt);
        const char* nA = has_next ? (const char*)g.A + (size_t)nxt.pm * tstepA + (size_t)nxt.ko * 2 : cA; const char* nB = has_next ? (const char*)g.Bt + (size_t)nxt.pn * tstepB + (size_t)nxt.ko * 2 : cB;
        for (int t = 0; t < nt; t += 2) {
            const bool last = (t == nt - 2);
            const char* a1 = cA + (size_t)(t + 1) * kstep;
            const char* a2 = last ? nA : cA + (size_t)(t + 2) * kstep; const char* b2 = last ? nB : cB + (size_t)(t + 2) * kstep;
            const char* a3 = a2 + kstep; const char* b3 = b2 + kstep;
            if (last && has_next) S.a_ready(nxt);
            if constexpr (SP2) {
            PG8_LDB(B0, 0, 0); PG8_LDB(B1, 0, 1); PG8_SCHED; PG8_LDA(At, 0, 0); PG8_STAGE(PG8_SA(1, 1), a1 + hstepA, voffA);
            PG8_WAIT_V(8); PG8_WAIT_L(0); PG8_BAR; PG8_MMA(0, 0, At, B0); PG8_MMA(0, 1, At, B1); PG8_BAR; PG8_SCHED;
            PG8_LDA(At, 0, 1); PG8_STAGE(PG8_SB(0, 0), b2, voffB); PG8_STAGE(PG8_SB(0, 1), b2 + hstepB, voffB); PG8_STAGE(PG8_SA(0, 0), a2, voffA);
            PG8_WAIT_V(8); PG8_WAIT_L(0); PG8_BAR; PG8_MMA(1, 0, At, B0); PG8_MMA(1, 1, At, B1); PG8_BAR; PG8_SCHED;
            PG8_LDB(B0, 1, 0); PG8_LDB(B1, 1, 1); PG8_SCHED; PG8_LDA(At, 1, 0); PG8_STAGE(PG8_SA(0, 1), a2 + hstepA, voffA);
            PG8_WAIT_V(8); PG8_WAIT_L(0); PG8_BAR; PG8_MMA(0, 0, At, B0); PG8_MMA(0, 1, At, B1); PG8_BAR; PG8_SCHED;
            PG8_LDA(At, 1, 1); PG8_STAGE(PG8_SB(1, 0), b3, voffB); PG8_STAGE(PG8_SB(1, 1), b3 + hstepB, voffB); PG8_STAGE(PG8_SA(1, 0), a3, voffA);
            PG8_WAIT_V(8); PG8_WAIT_L(0); PG8_BAR; PG8_MMA(1, 0, At, B0); PG8_MMA(1, 1, At, B1); PG8_BAR; PG8_SCHED;
            } else {
            PG8_LDB(B0, 0, 0); PG8_SCHED; PG8_LDA(At, 0, 0); PG8_STAGE(PG8_SA(1, 1), a1 + hstepA, voffA);
            PG8_WAIT_L(8); PG8_BAR; PG8_WAIT_L(0); PG8_MMA(0, 0, At, B0); PG8_BAR; PG8_SCHED;
            PG8_LDB(B1, 0, 1); PG8_STAGE(PG8_SB(0, 0), b2, voffB);
            PG8_BAR; PG8_WAIT_L(0); PG8_MMA(0, 1, At, B1); PG8_BAR;
            PG8_LDA(At, 0, 1); PG8_STAGE(PG8_SA(0, 0), a2, voffA);
            PG8_BAR; PG8_WAIT_L(0); PG8_MMA(1, 0, At, B0); PG8_BAR; PG8_SCHED;
            PG8_STAGE(PG8_SB(0, 1), b2 + hstepB, voffB);
            PG8_WAIT_V(6); PG8_BAR; PG8_MMA(1, 1, At, B1); PG8_BAR;
            PG8_LDB(B0, 1, 0); PG8_SCHED; PG8_LDA(At, 1, 0); PG8_STAGE(PG8_SA(0, 1), a2 + hstepA, voffA);
            PG8_WAIT_L(8); PG8_BAR; PG8_WAIT_L(0); PG8_MMA(0, 0, At, B0); PG8_BAR; PG8_SCHED;
            PG8_LDB(B1, 1, 1); PG8_STAGE(PG8_SB(1, 0), b3, voffB);
            PG8_BAR; PG8_WAIT_L(0); PG8_MMA(0, 1, At, B1); PG8_BAR;
            PG8_LDA(At, 1, 1); PG8_STAGE(PG8_SA(1, 0), a3, voffA);
            PG8_BAR; PG8_WAIT_L(0); PG8_MMA(1, 0, At, B0); PG8_BAR; PG8_SCHED;
            PG8_STAGE(PG8_SB(1, 1), b3 + hstepB, voffB);
            PG8_WAIT_V(6); PG8_BAR; PG8_MMA(1, 1, At, B1); PG8_BAR;
            }
        }
        if constexpr (ALIGN_EPI) { if (wr == 0) PG8_BAR; }
        if constexpr (!Epi::AFTER_DRAIN) { E(acc, cur, wr, wc, fr, fq); S.done(cur); }
        if (!has_next) break;
#pragma unroll
        for (int a = 0; a < 2; ++a)
#pragma unroll
            for (int b = 0; b < 2; ++b)
#pragma unroll
                for (int m = 0; m < 4; ++m)
#pragma unroll
                    for (int n = 0; n < 2; ++n) acc[a][b][m][n] = (f32x4){0.f, 0.f, 0.f, 0.f};
        cur = nxt; cA = nA; cB = nB; ++ui;
        if constexpr (ALIGN_EPI) { if (wr == 1) PG8_BAR; }
    }
    PG8_WAIT_V(0);
    if constexpr (!ALIGN_EPI) { if (wr == 0) PG8_BAR; }
    PG8_BAR;
    if constexpr (Epi::AFTER_DRAIN) { E.fused(acc, cur, wr, wc, fr, fq, lds, wid, lane); S.done(cur); }
#undef PG8_SA
#undef PG8_SB
#undef PG8_STAGE
#undef PG8_LDA
#undef PG8_LDB
#undef PG8_MMA
#undef PG8_WAIT_V
#undef PG8_WAIT_L
#undef PG8_BAR
#undef PG8_SCHED
}
}

constexpr int NWAVES = 8;
constexpr int D_MODEL = 4096, SEQ = 8192, DEC_SEQ = 16;
constexpr int M_PROMPT = 16384, M_REAL = 16512, MPAD = 16640;
constexpr int IN_W = 14816, IN_WP = 14848, D_FF = 11008;
constexpr int PC_Q = 0, PC_K = 2048, PC_V = 4096, PC_Z = 6144, PC_B = 8192, PC_A = 8208, PC_RW = 8224;
constexpr int RW_R = 0, RW_K = 2048, RW_V = 4096, RW_XW = 6144, RW_XA = 6240, RW_XG = 6336, RW_SHIFT_W = 6592;
constexpr float NORM_EPS = 1e-6f, RW_GN_EPS = 64e-5f;
constexpr size_t O_Y = 0, O_SDN_P = 67633152, O_CONV_P = 68157440, O_SRW_P = 68194304, O_SHIFT_P = 68456448,
                 O_SDN_S = 68469632, O_CONV_S = 70566784, O_SRW_S = 70714240, O_SHIFT_S = 71762816, O_END = 71815552;
constexpr size_t MiB = 1u << 20;
constexpr size_t WS_CTL = 0, CTL_ZERO_BYTES = 1 * MiB;
constexpr size_t WS_SSQ = 2 * MiB;
constexpr size_t WS_W2T = 6553600, WS_A2T = WS_W2T + 2048 * 96 * 2, WS_G2T = 7 * MiB;
constexpr size_t WS_WOUT = 8 * MiB;
constexpr size_t WS_HBUF = 40 * MiB;
constexpr size_t WS_PROJ = 170 * MiB;
constexpr size_t WS_WIN = 642 * MiB;
constexpr size_t WS_WGU = 758 * MiB;
constexpr size_t WS_WDN = 930 * MiB;
constexpr size_t WS_END = 1016 * MiB;
constexpr size_t WS_PART2 = 642 * MiB, WS_PART4 = 678 * MiB;
constexpr size_t WS_SXG = 742 * MiB;
constexpr size_t WS_DNQK = 642 * MiB, WS_DNGL = 674 * MiB, WS_RWSB = 675 * MiB, WS_RWOO = 678 * MiB, WS_RWPQ = 758 * MiB, WS_RWRP = 886 * MiB;
static_assert(WS_SSQ + (size_t)MPAD * 64 * 4 <= WS_WOUT && WS_HBUF + (size_t)MPAD * 4096 * 2 <= WS_PROJ && WS_PROJ + (size_t)MPAD * IN_WP * 2 <= WS_WIN &&
              WS_WIN + (size_t)IN_WP * 4096 * 2 <= WS_WGU && WS_WGU + (size_t)2 * D_FF * 4096 * 2 <= WS_WDN && WS_WDN + (size_t)4096 * D_FF * 2 <= WS_END, "d_ws map");
constexpr int CW_BAR = 4096;
constexpr int RING_OFF = 0, RING_BYTES = 131072;
constexpr int LDSCTL_OFF = RING_BYTES, MISC_OFF = LDSCTL_OFF + 320;
constexpr int LDS_BYTES = 147456;

#define GAS __attribute__((address_space(1)))
#define LAS __attribute__((address_space(3)))
typedef unsigned short bf16;
typedef unsigned v4u __attribute__((ext_vector_type(4)));
typedef unsigned v2u __attribute__((ext_vector_type(2)));
typedef float f32x4 __attribute__((ext_vector_type(4)));
typedef GAS unsigned gu32;
#define RLX_AGENT __ATOMIC_RELAXED, __HIP_MEMORY_SCOPE_AGENT
#define LDS_WAIT() asm volatile("s_waitcnt lgkmcnt(0)" ::: "memory")
__device__ __forceinline__ unsigned f2bf(float f) { unsigned u = __builtin_bit_cast(unsigned, f); return (u + 0x7fffu + ((u >> 16) & 1u)) >> 16; }
__device__ __forceinline__ unsigned pk2(float lo, float hi) { return f2bf(lo) | (f2bf(hi) << 16); }
__device__ __forceinline__ float bf2f(bf16 b) { return __builtin_bit_cast(float, (unsigned)b << 16); }
__device__ __forceinline__ float bflo(unsigned u) { return __builtin_bit_cast(float, u << 16); }
__device__ __forceinline__ float bfhi(unsigned u) { return __builtin_bit_cast(float, u & 0xffff0000u); }
#ifdef OLD_WAVE_SUM
__device__ __forceinline__ float wave_sum(float v) {
#pragma unroll
    for (int o = 1; o < 64; o <<= 1) v += __shfl_xor(v, o);
    return v;
}
#else
#define WS_DPP(x, ctrl, rmask) __builtin_bit_cast(float, __builtin_amdgcn_update_dpp(0, __builtin_bit_cast(int, (x)), (ctrl), (rmask), 0xf, true))
__device__ __forceinline__ float wave_sum(float v) {
    v += WS_DPP(v, 0xB1, 0xf); v += WS_DPP(v, 0x4E, 0xf); v += WS_DPP(v, 0x141, 0xf); v += WS_DPP(v, 0x140, 0xf);
    v += WS_DPP(v, 0x142, 0xa); v += WS_DPP(v, 0x143, 0xc);
    return __builtin_bit_cast(float, __builtin_amdgcn_readlane(__builtin_bit_cast(int, v), 63));
}
#endif
#ifdef OLD_MATH
__device__ __forceinline__ float sigmoid_f(float x) { return 1.0f / (1.0f + __expf(-x)); }
__device__ __forceinline__ float softplus_f(float x) { return x > 20.f ? x : log1pf(__expf(x)); }
#else
__device__ __forceinline__ float sigmoid_f(float x) { return __builtin_amdgcn_rcpf(1.0f + __expf(-x)); }
__device__ __forceinline__ float softplus_f(float x) { return x > 20.f ? x : __logf(1.0f + __expf(x)); }
#endif
__device__ __forceinline__ void wave_sum8(float (&v)[8]) {
#pragma unroll
    for (int o = 1; o < 64; o <<= 1) {
#pragma unroll
        for (int i = 0; i < 8; ++i) v[i] += __shfl_xor(v[i], o); }
}

#define XB_TMO      128
#define XB_XCNT(j)  (256  + 64 * (j))
#define XB_XSUB(j)  (1280 + 64 * (j))
#define XB_XGEN(j)  (2304 + 64 * (j))
#define XB_TOP      3328
#define XB_TOPGEN   3392
#define XCD_BAR_WORDS 3456
#define XB_SPIN_CAP (1u << 18)

__device__ __forceinline__ unsigned xb_ld(unsigned* p)              { return __hip_atomic_load(p, __ATOMIC_RELAXED, __HIP_MEMORY_SCOPE_AGENT); }
__device__ __forceinline__ unsigned xb_add(unsigned* p, unsigned v) { return __hip_atomic_fetch_add(p, v, __ATOMIC_RELAXED, __HIP_MEMORY_SCOPE_AGENT); }
__device__ __forceinline__ unsigned xb_xcc_id() { return (unsigned)__builtin_amdgcn_s_getreg((3 << 11) | 20) & 0xFu; }
#define XB_SPIN(cond, bar) do { unsigned _sp = 0; while (cond) { __builtin_amdgcn_s_sleep(1); \
    if ((++_sp & 255u) == 0u) { if (xb_ld(&(bar)[XB_TMO])) break; if (_sp > XB_SPIN_CAP) { atomicAdd(&(bar)[XB_TMO], 1u); break; } } } } while (0)

struct XcdBarrier {
    unsigned* bar; unsigned x;
    volatile LAS unsigned* st;
};

__device__ __forceinline__ XcdBarrier xcd_barrier_post(unsigned* bar, volatile LAS unsigned* st) {
    XcdBarrier b; b.bar = bar; b.x = xb_xcc_id(); b.st = st;
    if (threadIdx.x == 0) (void)xb_add(&bar[XB_XCNT(b.x)], 1u);
    return b;
}
__device__ __forceinline__ void xcd_barrier_complete(unsigned* bar, unsigned x, unsigned& nloc, unsigned& nx) {
    const unsigned G = gridDim.x * gridDim.y * gridDim.z;
    unsigned sum, cnt, mine, sp = 0u;
    for (;;) {
        sum = 0u; cnt = 0u; mine = 0u;
#pragma unroll
        for (unsigned j = 0; j < 16; ++j) { const unsigned c = xb_ld(&bar[XB_XCNT(j)]); sum += c; cnt += (c > 0u) ? 1u : 0u; mine = (j == x) ? c : mine; }
        if (sum == G) break;
        __builtin_amdgcn_s_sleep(1);
        if ((++sp & 255u) == 0u) { if (xb_ld(&bar[XB_TMO])) break; if (sp > XB_SPIN_CAP) { atomicAdd(&bar[XB_TMO], 1u); break; } }
    }
    nloc = mine > 0u ? mine : 1u; nx = cnt > 0u ? cnt : 1u;
}

__device__ __forceinline__ void xcd_barrier(const XcdBarrier& b) {
    asm volatile("s_waitcnt vmcnt(0)" ::: "memory");
    __syncthreads();
    if (threadIdx.x == 0) {
        unsigned* bar = b.bar;
        __builtin_amdgcn_s_waitcnt(0);
        unsigned nloc = b.st[0], nx = b.st[1];
        if (nloc == 0u) { xcd_barrier_complete(bar, b.x, nloc, nx); b.st[0] = nloc; b.st[1] = nx; }
        const unsigned old = xb_add(&bar[XB_XSUB(b.x)], 1u);
        const unsigned gen = old / nloc;
        if (old + 1u == (gen + 1u) * nloc) {
            __builtin_amdgcn_fence(__ATOMIC_RELEASE, "agent");
            asm volatile("s_waitcnt vmcnt(0)" ::: "memory");
            const unsigned og = xb_add(&bar[XB_TOP], 1u);
            const unsigned tg = og / nx;
            if (og + 1u == (tg + 1u) * nx) xb_add(&bar[XB_TOPGEN], 1u);
            else XB_SPIN(xb_ld(&bar[XB_TOPGEN]) == tg, bar);
            __builtin_amdgcn_fence(__ATOMIC_ACQUIRE, "agent");
            xb_add(&bar[XB_XGEN(b.x)], 1u);
            asm volatile("s_waitcnt vmcnt(0)" ::: "memory");
        } else {
            XB_SPIN(xb_ld(&bar[XB_XGEN(b.x)]) == gen, bar);
            __builtin_amdgcn_fence(__ATOMIC_ACQUIRE, "agent");
            asm volatile("s_waitcnt vmcnt(0)" ::: "memory");
        }
    }
    __syncthreads();
}

struct Frame {
    LAS unsigned char* lds;
    volatile LAS unsigned* MISC;
    gu32* ctl;
    int tid, lane, wave, G;
    const float* const* in;
};
struct Args { const float* in[30]; float* out; unsigned char* ws; int ph_lo, ph_hi; };

template <class RowMap>
__device__ __forceinline__ void p0_transpose_item(const float* W, int K, int N, bf16* WT, LAS float* scr, int item, int lane, RowMap rm) {
    const int nblk = N / 32, kb = item / nblk, nb = item % nblk, k0 = 64 * kb, n0 = 32 * nb;
#pragma unroll 8
    for (int i = 0; i < 32; ++i) { const int kk = 2 * i + (lane >> 5); scr[kk * 33 + (lane & 31)] = W[(size_t)(k0 + kk) * N + n0 + (lane & 31)]; }
    LDS_WAIT(); asm volatile("" ::: "memory");
    const int c = lane & 7;
#pragma unroll
    for (int j = 0; j < 4; ++j) { const int n = (lane >> 3) + 8 * j; const LAS float* s = scr + (8 * c) * 33 + n;
        v4u o; o.x = pk2(s[0 * 33], s[1 * 33]); o.y = pk2(s[2 * 33], s[3 * 33]); o.z = pk2(s[4 * 33], s[5 * 33]); o.w = pk2(s[6 * 33], s[7 * 33]);
        *(GAS v4u*)(WT + (size_t)rm(n0 + n) * K + k0 + 8 * c) = o; }
    LDS_WAIT(); asm volatile("" ::: "memory");
}
struct RmId { __device__ __forceinline__ int operator()(int n) const { return n; } };
struct RmGU { int up; __device__ __forceinline__ int operator()(int n) const { return (n >> 7) * 256 + up * 128 + (n & 127); } };

__device__ __forceinline__ void rms_row_to_bf16(const f32x4 (&v)[16], const float* g, bf16* orow, int lane) {
    float s = 0.f;
#pragma unroll
    for (int j = 0; j < 16; ++j) s += (v[j].x * v[j].x + v[j].y * v[j].y) + (v[j].z * v[j].z + v[j].w * v[j].w);
    const float rstd = 1.0f / sqrtf(wave_sum(s) * (1.f / 4096.f) + NORM_EPS);
    const GAS f32x4* gr = (const GAS f32x4*)g + lane; GAS v2u* o8 = (GAS v2u*)orow + lane;
#pragma unroll
    for (int hh = 0; hh < 2; ++hh) { f32x4 gv[8];
#pragma unroll
        for (int j = 0; j < 8; ++j) gv[j] = gr[64 * (8 * hh + j)];
#pragma unroll
        for (int j = 0; j < 8; ++j) { const f32x4 x = v[8 * hh + j]; v2u o; o.x = pk2(x.x * rstd * gv[j].x, x.y * rstd * gv[j].y); o.y = pk2(x.z * rstd * gv[j].z, x.w * rstd * gv[j].w); o8[64 * (8 * hh + j)] = o; } }
}

struct MixPtrs {
    const bf16* proj; bf16* mix;
    const float *state_dn, *cache_conv, *state_rw, *cache_shift;
    const float *conv_w, *a_log, *dt_bias, *dn_norm_w;
    const float *mu, *w0, *w2, *a0, *a2, *g2, *k_k, *k_a, *r_k, *ln_w, *ln_b;
    float* out;
};
__device__ __forceinline__ void dn_seq_item(const MixPtrs& P, LAS unsigned char* lds, int seq, int h, int tid, int lane, int wave) {
    const bool prm = seq < 2;
    const int T = prm ? SEQ : DEC_SEQ, sb = prm ? seq : seq - 2;
    const int m0 = prm ? seq * SEQ : M_PROMPT + sb * DEC_SEQ;
    const float* S0 = prm ? nullptr : P.state_dn + ((size_t)sb * 16 + h) * 16384;
    const float* cbuf = prm ? nullptr : P.cache_conv + (size_t)sb * 3 * 6144;
    float* Sout = P.out + (prm ? O_SDN_P : O_SDN_S) + ((size_t)sb * 16 + h) * 16384;
    float* cout = P.out + (prm ? O_CONV_P : O_CONV_S) + (size_t)sb * 3 * 6144;
    LAS float* qs = (LAS float*)lds; LAS float* ks = qs + 2048; LAS float* vs = ks + 2048; LAS float* zs = vs + 2048; LAS float* os = zs + 2048; LAS float* bet = os + 2048; LAS float* gg = bet + 16;
    float S[32];
    const int e = wave * 16 + (lane >> 2), dq = lane & 3;
#pragma unroll
    for (int j = 0; j < 32; ++j) S[j] = (S0 != nullptr) ? S0[(32 * dq + j) * 128 + e] : 0.f;
    const float Ah = -__expf(P.a_log[h]), dtb = P.dt_bias[h];
    for (int tb = 0; tb < T; tb += 16) {
        for (int i = tid; i < 16 * 384; i += 512) { const int t = i / 384, cc = i - t * 384, sec = cc >> 7, d = cc & 127, col = sec * 2048 + h * 128 + d;
            float acc = 0.f;
#pragma unroll
            for (int j = 0; j < 4; ++j) { const int tt = tb + t - 3 + j; float xv;
                if (tt >= 0) xv = bf2f(P.proj[(size_t)(m0 + tt) * IN_WP + col]); else xv = cbuf ? cbuf[(3 + tt) * 6144 + col] : 0.f;
                acc += xv * P.conv_w[j * 6144 + col]; }
            const float y = acc * sigmoid_f(acc);
            (sec == 0 ? qs : (sec == 1 ? ks : vs))[t * 128 + d] = y; }
        for (int i = tid; i < 16 * 128; i += 512) { const int t = i >> 7, d = i & 127; zs[i] = bf2f(P.proj[(size_t)(m0 + tb + t) * IN_WP + PC_Z + h * 128 + d]); }
        if (tid < 16) { const size_t r = (size_t)(m0 + tb + tid) * IN_WP; const float b = bf2f(P.proj[r + PC_B + h]), a = bf2f(P.proj[r + PC_A + h]);
            bet[tid] = sigmoid_f(b); gg[tid] = Ah * softplus_f(a + dtb); }
        __syncthreads();
#pragma unroll
        for (int r = 0; r < 2; ++r) { const int t = 2 * wave + r;
            const float q0 = qs[t * 128 + lane], q1 = qs[t * 128 + 64 + lane], k0 = ks[t * 128 + lane], k1 = ks[t * 128 + 64 + lane];
            const float sq = wave_sum(q0 * q0 + q1 * q1), sk = wave_sum(k0 * k0 + k1 * k1);
            const float cq = 0.08838834764831845f / sqrtf(sq + 1e-6f), ck = 1.0f / sqrtf(sk + 1e-6f);
            qs[t * 128 + lane] = q0 * cq; qs[t * 128 + 64 + lane] = q1 * cq; ks[t * 128 + lane] = k0 * ck; ks[t * 128 + 64 + lane] = k1 * ck; }
        __syncthreads();
        {
#pragma unroll 1
            for (int t = 0; t < 16; ++t) {
                const float eg = __expf(gg[t]), bt = bet[t];
                float kS = 0.f;
#pragma unroll
                for (int d4 = 0; d4 < 8; ++d4) { const f32x4 kv = *(const LAS f32x4*)(ks + t * 128 + 32 * dq + 4 * d4);
                    kS += kv.x * S[4 * d4] + kv.y * S[4 * d4 + 1] + kv.z * S[4 * d4 + 2] + kv.w * S[4 * d4 + 3]; }
                kS += __shfl_xor(kS, 1); kS += __shfl_xor(kS, 2);
                const float w = bt * (vs[t * 128 + e] - eg * kS);
                float o = 0.f;
#pragma unroll
                for (int d4 = 0; d4 < 8; ++d4) { const f32x4 kv = *(const LAS f32x4*)(ks + t * 128 + 32 * dq + 4 * d4); const f32x4 qv = *(const LAS f32x4*)(qs + t * 128 + 32 * dq + 4 * d4);
                    S[4 * d4] = eg * S[4 * d4] + kv.x * w; S[4 * d4 + 1] = eg * S[4 * d4 + 1] + kv.y * w; S[4 * d4 + 2] = eg * S[4 * d4 + 2] + kv.z * w; S[4 * d4 + 3] = eg * S[4 * d4 + 3] + kv.w * w;
                    o += qv.x * S[4 * d4] + qv.y * S[4 * d4 + 1] + qv.z * S[4 * d4 + 2] + qv.w * S[4 * d4 + 3]; }
                o += __shfl_xor(o, 1); o += __shfl_xor(o, 2);
                if (dq == 0) os[t * 128 + e] = o;
            }
        }
        __syncthreads();
#pragma unroll
        for (int r = 0; r < 2; ++r) { const int t = 2 * wave + r;
            const float o0 = os[t * 128 + lane], o1 = os[t * 128 + 64 + lane];
            const float rs = 1.0f / sqrtf(wave_sum(o0 * o0 + o1 * o1) * (1.f / 128.f) + NORM_EPS);
            const float z0 = zs[t * 128 + lane], z1 = zs[t * 128 + 64 + lane];
            bf16* mp = P.mix + (size_t)(m0 + tb + t) * 4096 + h * 128;
            mp[lane] = (bf16)f2bf(o0 * rs * P.dn_norm_w[lane] * (z0 * sigmoid_f(z0))); mp[64 + lane] = (bf16)f2bf(o1 * rs * P.dn_norm_w[64 + lane] * (z1 * sigmoid_f(z1))); }
        __syncthreads();
    }
    { int so = 32 * dq * 128 + e;
#ifndef NO_LAUNDER
    asm volatile("" : "+v"(so));
#endif

#pragma unroll
    for (int j = 0; j < 32; ++j) Sout[so + j * 128] = S[j]; }
    for (int i = tid; i < 3 * 384; i += 512) { const int r = i / 384, cc = i - r * 384, col = (cc >> 7) * 2048 + h * 128 + (cc & 127);
        cout[r * 6144 + col] = bf2f(P.proj[(size_t)(m0 + T - 3 + r) * IN_WP + col]); }
}
__device__ __forceinline__ void rw_seq_item(const MixPtrs& P, const bf16* w2T_, const bf16* a2T_, const bf16* g2T_, LAS unsigned char* lds, int seq, int h, int tid, int lane, int wave) {
    const bool prm = seq < 2;
    const int T = prm ? SEQ : DEC_SEQ, sb = prm ? seq : seq - 2;
    const int m0 = prm ? seq * SEQ : M_PROMPT + sb * DEC_SEQ;
    const float* S0 = prm ? nullptr : P.state_rw + ((size_t)sb * 32 + h) * 4096;
    const float* sbuf = prm ? nullptr : P.cache_shift + (size_t)sb * RW_SHIFT_W;
    float* Sout = P.out + (prm ? O_SRW_P : O_SRW_S) + ((size_t)sb * 32 + h) * 4096;
    float* shout = P.out + (prm ? O_SHIFT_P : O_SHIFT_S) + (size_t)sb * RW_SHIFT_W;
    LAS float* rs = (LAS float*)lds; LAS float* kr = rs + 1024; LAS float* vs = kr + 1024; LAS float* xw = vs + 1024; LAS float* xa = xw + 1536; LAS float* xg = xa + 1536;
    LAS float* wd = xg + 4096; LAS float* kp = wd + 1024; LAS float* av = kp + 1024; LAS float* bv = av + 1024; LAS float* gt = bv + 1024; LAS float* ys = gt + 1024; LAS float* sbn = ys + 1024;
    float S[16];
    const int vr = (wave & 3) * 16 + (lane >> 2), kq = lane & 3;
#pragma unroll
    for (int k4 = 0; k4 < 4; ++k4) { f32x4 v = (f32x4){0.f, 0.f, 0.f, 0.f}; if (S0 != nullptr) v = *(const f32x4*)(S0 + vr * 64 + 16 * kq + 4 * k4);
        S[4 * k4] = v.x; S[4 * k4 + 1] = v.y; S[4 * k4 + 2] = v.z; S[4 * k4 + 3] = v.w; }
    const int hc = h * 64 + lane;
    const float w0c = P.w0[hc], a0c = P.a0[hc], kkc = P.k_k[hc], kac = P.k_a[hc], rkc = P.r_k[hc], lnw = P.ln_w[hc], lnb = P.ln_b[hc];
    for (int tb = 0; tb < T; tb += 16) {
        for (int i = tid; i < 16 * 640; i += 512) { const int t = i / 640, cc = i - t * 640; int col; LAS float* dst; int kind = 0;
            if (cc < 64) { col = RW_R + h * 64 + cc; dst = rs + t * 64 + cc; }
            else if (cc < 128) { col = RW_K + h * 64 + (cc - 64); dst = kr + t * 64 + (cc - 64); }
            else if (cc < 192) { col = RW_V + h * 64 + (cc - 128); dst = vs + t * 64 + (cc - 128); }
            else if (cc < 288) { col = RW_XW + (cc - 192); dst = xw + t * 96 + (cc - 192); kind = 1; }
            else if (cc < 384) { col = RW_XA + (cc - 288); dst = xa + t * 96 + (cc - 288); }
            else { col = RW_XG + (cc - 384); dst = xg + t * 256 + (cc - 384); kind = 2; }
            const int tt = tb + t; const float u = bf2f(P.proj[(size_t)(m0 + tt) * IN_WP + PC_RW + col]);
            const float up = tt > 0 ? bf2f(P.proj[(size_t)(m0 + tt - 1) * IN_WP + PC_RW + col]) : (sbuf ? sbuf[col] : 0.f);
            float v = u + P.mu[col] * (up - u);
            if (kind == 1) v = tanhf(v); else if (kind == 2) v = sigmoid_f(v);
            *dst = v; }
        __syncthreads();
        {
            float wl0 = 0.f, wl1 = 0.f, al0 = 0.f, al1 = 0.f, gl0 = 0.f, gl1 = 0.f; const int t0 = wave, t1 = wave + 8;
#ifdef OLD_SEQ
#pragma unroll 4
            for (int j = 0; j < 96; ++j) { const float w2v = P.w2[j * 2048 + hc], a2v = P.a2[j * 2048 + hc];
                wl0 += xw[t0 * 96 + j] * w2v; wl1 += xw[t1 * 96 + j] * w2v; al0 += xa[t0 * 96 + j] * a2v; al1 += xa[t1 * 96 + j] * a2v; }
#pragma unroll 4
            for (int j = 0; j < 256; ++j) { const float g2v = P.g2[j * 2048 + hc]; gl0 += xg[t0 * 256 + j] * g2v; gl1 += xg[t1 * 256 + j] * g2v; }
#else
#define SEQ_DOT8(W8, X0, X1, A0, A1) do { const v4u _w = (W8); const LAS float* _x0 = (X0); const LAS float* _x1 = (X1); \
                const f32x4 _p0 = *(const LAS f32x4*)_x0, _p1 = *(const LAS f32x4*)(_x0 + 4), _q0 = *(const LAS f32x4*)_x1, _q1 = *(const LAS f32x4*)(_x1 + 4); \
                const float _w0 = bflo(_w.x), _w1 = bfhi(_w.x), _w2 = bflo(_w.y), _w3 = bfhi(_w.y), _w4 = bflo(_w.z), _w5 = bfhi(_w.z), _w6 = bflo(_w.w), _w7 = bfhi(_w.w); \
                A0 += (_p0.x * _w0 + _p0.y * _w1) + (_p0.z * _w2 + _p0.w * _w3) + (_p1.x * _w4 + _p1.y * _w5) + (_p1.z * _w6 + _p1.w * _w7); \
                A1 += (_q0.x * _w0 + _q0.y * _w1) + (_q0.z * _w2 + _q0.w * _w3) + (_q1.x * _w4 + _q1.y * _w5) + (_q1.z * _w6 + _q1.w * _w7); } while (0)
#pragma unroll 1
            for (int cch = 0; cch < 3; ++cch) { v4u wv[4], av2[4];
#pragma unroll
                for (int p = 0; p < 4; ++p) { wv[p] = *(const GAS v4u*)(w2T_ + (size_t)hc * 96 + 32 * cch + 8 * p); av2[p] = *(const GAS v4u*)(a2T_ + (size_t)hc * 96 + 32 * cch + 8 * p); }
#pragma unroll
                for (int p = 0; p < 4; ++p) { const int j = 32 * cch + 8 * p; SEQ_DOT8(wv[p], xw + t0 * 96 + j, xw + t1 * 96 + j, wl0, wl1); SEQ_DOT8(av2[p], xa + t0 * 96 + j, xa + t1 * 96 + j, al0, al1); } }
#pragma unroll 1
            for (int cch = 0; cch < 8; ++cch) { v4u gv[4];
#pragma unroll
                for (int p = 0; p < 4; ++p) gv[p] = *(const GAS v4u*)(g2T_ + (size_t)hc * 256 + 32 * cch + 8 * p);
#pragma unroll
                for (int p = 0; p < 4; ++p) { const int j = 32 * cch + 8 * p; SEQ_DOT8(gv[p], xg + t0 * 256 + j, xg + t1 * 256 + j, gl0, gl1); } }
#undef SEQ_DOT8
#endif
#pragma unroll
            for (int r = 0; r < 2; ++r) { const int t = r ? t1 : t0; const float wl = r ? wl1 : wl0, al = r ? al1 : al0, gl = r ? gl1 : gl0;
                const float wlog = -softplus_f(-(w0c + wl)) - 0.5f; const float wdec = __expf(-__expf(wlog));
                const float a = sigmoid_f(a0c + al);
                const float krv = kr[t * 64 + lane], kkr = krv * kkc; const float kk = kkr / sqrtf(wave_sum(kkr * kkr) + 1e-6f);
                const float kpv = krv * (1.0f + (a - 1.0f) * kac);
                const float sbv = wave_sum(rs[t * 64 + lane] * kpv * rkc);
                wd[t * 64 + lane] = wdec; kp[t * 64 + lane] = kpv; av[t * 64 + lane] = -kk; bv[t * 64 + lane] = kk * a; gt[t * 64 + lane] = gl; if (lane == 0) sbn[t] = sbv; }
        }
        __syncthreads();
        if (wave < 4) {
#pragma unroll 1
            for (int t = 0; t < 16; ++t) {
                float sa = 0.f;
#pragma unroll
                for (int k4 = 0; k4 < 4; ++k4) { const f32x4 a4 = *(const LAS f32x4*)(av + t * 64 + 16 * kq + 4 * k4); sa += a4.x * S[4 * k4] + a4.y * S[4 * k4 + 1] + a4.z * S[4 * k4 + 2] + a4.w * S[4 * k4 + 3]; }
                sa += __shfl_xor(sa, 1); sa += __shfl_xor(sa, 2);
                const float vv = vs[t * 64 + vr]; float y = 0.f;
#pragma unroll
                for (int k4 = 0; k4 < 4; ++k4) { const int o4 = t * 64 + 16 * kq + 4 * k4;
                    const f32x4 w4 = *(const LAS f32x4*)(wd + o4), b4 = *(const LAS f32x4*)(bv + o4), k4v = *(const LAS f32x4*)(kp + o4), r4 = *(const LAS f32x4*)(rs + o4);
                    S[4 * k4] = S[4 * k4] * w4.x + sa * b4.x + vv * k4v.x; S[4 * k4 + 1] = S[4 * k4 + 1] * w4.y + sa * b4.y + vv * k4v.y;
                    S[4 * k4 + 2] = S[4 * k4 + 2] * w4.z + sa * b4.z + vv * k4v.z; S[4 * k4 + 3] = S[4 * k4 + 3] * w4.w + sa * b4.w + vv * k4v.w;
                    y += r4.x * S[4 * k4] + r4.y * S[4 * k4 + 1] + r4.z * S[4 * k4 + 2] + r4.w * S[4 * k4 + 3]; }
                y += __shfl_xor(y, 1); y += __shfl_xor(y, 2);
                if (kq == 0) ys[t * 64 + vr] = y;
            }
        }
        __syncthreads();
#pragma unroll
        for (int r = 0; r < 2; ++r) { const int t = wave + 8 * r; const float y = ys[t * 64 + lane];
            const float mean = wave_sum(y) * (1.f / 64.f); const float dy = y - mean; const float var = wave_sum(dy * dy) * (1.f / 64.f);
            const float yn = dy / sqrtf(var + RW_GN_EPS) * lnw + lnb;
            P.mix[(size_t)(m0 + tb + t) * 4096 + 2048 + hc] = (bf16)f2bf((yn + sbn[t] * vs[t * 64 + lane]) * gt[t * 64 + lane]); }
        __syncthreads();
    }
    if (wave < 4) { int so = vr * 64 + 16 * kq;
#ifndef NO_LAUNDER
    asm volatile("" : "+v"(so));
#endif
#pragma unroll
        for (int k4 = 0; k4 < 4; ++k4) *(f32x4*)(Sout + so + 4 * k4) = (f32x4){S[4 * k4], S[4 * k4 + 1], S[4 * k4 + 2], S[4 * k4 + 3]};
    }
    for (int i = tid; i < 206; i += 512) { const int col = h * 206 + i; shout[col] = bf2f(P.proj[(size_t)(m0 + T - 1) * IN_WP + PC_RW + col]); }
}

typedef short bf16x8 __attribute__((ext_vector_type(8)));
typedef float f32x16 __attribute__((ext_vector_type(16)));
typedef __bf16 bf16x2_t __attribute__((ext_vector_type(2)));
typedef float f32x2_t __attribute__((ext_vector_type(2)));
__device__ __forceinline__ unsigned cvt2(float lo, float hi) { f32x2_t v = {lo, hi}; return __builtin_bit_cast(unsigned, __builtin_convertvector(v, bf16x2_t)); }
#define MFMA16(a, b, c) __builtin_amdgcn_mfma_f32_16x16x32_bf16((a), (b), (c), 0, 0, 0)
#define MFMA32(a, b, c) __builtin_amdgcn_mfma_f32_32x32x16_bf16((a), (b), (c), 0, 0, 0)
__device__ __forceinline__ bf16x8 pack_step(const f32x16& x, int s) {
    v4u p; p.x = cvt2(x[8 * s], x[8 * s + 1]); p.y = cvt2(x[8 * s + 2], x[8 * s + 3]); p.z = cvt2(x[8 * s + 4], x[8 * s + 5]); p.w = cvt2(x[8 * s + 6], x[8 * s + 7]);
    return __builtin_bit_cast(bf16x8, p);
}
struct DnRec { unsigned char* rec; unsigned char* qk; float* gl; };
constexpr int DP_QN = 0, DP_KN = 17408, DP_VBT = 34816, DP_KBGT = 53248, DP_LM = 71680, DP_TM = 88320, DP_TB = 104960, DP_DINV = 114176, DP_YB = 118528, DP_SC = 122688;

__device__ __forceinline__ void tri_inv64(const LAS float* Lm, LAS float* Tm, LAS bf16* Tb, LAS float* Dinv, LAS float* Yb, int tid, int lane, int wave) {
    if (tid < 64) { const int bi = tid >> 4, j = tid & 15; float x[16];
#pragma unroll
        for (int r = 0; r < 16; ++r) { float a = (r == j) ? 1.f : 0.f;
#pragma unroll
            for (int k = 0; k < r; ++k) a -= Lm[(16 * bi + r) * 65 + 16 * bi + k] * x[k];
            x[r] = a; }
#pragma unroll
        for (int r = 0; r < 16; ++r) Dinv[(bi * 16 + r) * 17 + j] = x[r]; }
    __syncthreads();
    for (int o = tid; o < 4096; o += 512) { const int r = o >> 6, c = o & 63, bi = r >> 4;
        if (c >= 16 * bi) { const float a = (c < 16 * bi + 16) ? Dinv[r * 17 + c - 16 * bi] : 0.f; Tm[r * 65 + c] = a; Tb[r * 72 + c] = (bf16)(cvt2(a, 0.f) & 0xffffu); } }
    __syncthreads();
    const int l15 = lane & 15, q = lane >> 4;
#pragma unroll 1
    for (int i = 1; i < 4; ++i) {
        if (wave < i) { f32x4 acc = (f32x4){0.f, 0.f, 0.f, 0.f};
            for (int ks = 0; ks < 4 * i; ++ks) acc = __builtin_amdgcn_mfma_f32_16x16x4f32(Lm[(16 * i + l15) * 65 + 4 * ks + q], Tm[(4 * ks + q) * 65 + 16 * wave + l15], acc, 0, 0, 0);
#pragma unroll
            for (int reg = 0; reg < 4; ++reg) Yb[(4 * q + reg) * 65 + 16 * wave + l15] = -acc[reg]; }
        __syncthreads();
        if (wave < i) { f32x4 acc = (f32x4){0.f, 0.f, 0.f, 0.f};
#pragma unroll
            for (int ks = 0; ks < 4; ++ks) acc = __builtin_amdgcn_mfma_f32_16x16x4f32(Dinv[(16 * i + l15) * 17 + 4 * ks + q], Yb[(4 * ks + q) * 65 + 16 * wave + l15], acc, 0, 0, 0);
#pragma unroll
            for (int reg = 0; reg < 4; ++reg) { Tm[(16 * i + 4 * q + reg) * 65 + 16 * wave + l15] = acc[reg]; Tb[(16 * i + 4 * q + reg) * 72 + 16 * wave + l15] = (bf16)(cvt2(acc[reg], 0.f) & 0xffffu); } }
        __syncthreads();
    }
}

__device__ __forceinline__ void dn_prep_item(const MixPtrs& P, const DnRec& R, LAS unsigned char* lds, int b, int c, int h, int tid, int lane, int wave) {
    const int m0 = b * SEQ + 64 * c; const int item = (b * 128 + c) * 16 + h;
    LAS bf16* Qn = (LAS bf16*)(lds + DP_QN); LAS bf16* Kn = (LAS bf16*)(lds + DP_KN); LAS bf16* VbT = (LAS bf16*)(lds + DP_VBT); LAS bf16* KbgT = (LAS bf16*)(lds + DP_KBGT);
    LAS float* Lm = (LAS float*)(lds + DP_LM); LAS float* Tm = (LAS float*)(lds + DP_TM); LAS bf16* Tb = (LAS bf16*)(lds + DP_TB); LAS float* Dinv = (LAS float*)(lds + DP_DINV); LAS float* Yb = (LAS float*)(lds + DP_YB);
    LAS float* sc = (LAS float*)(lds + DP_SC); LAS float* beta = sc; LAS float* gc = sc + 64; LAS float* egc = sc + 128; LAS float* ekd = sc + 192;
    unsigned char* rec = R.rec + (size_t)item * 65536; unsigned char* qkr = R.qk + (size_t)item * 8192;
    if (wave == 0) { const int t = lane; const size_t r = (size_t)(m0 + t) * IN_WP; const float bb = bf2f(P.proj[r + PC_B + h]), aa = bf2f(P.proj[r + PC_A + h]);
        const float Ah = -__expf(P.a_log[h]), dtb = P.dt_bias[h];
        float x = Ah * softplus_f(aa + dtb);
#pragma unroll
        for (int o = 1; o < 64; o <<= 1) { const float v = __shfl_up(x, o); if (lane >= o) x += v; }
        const float gl = __shfl(x, 63);
        beta[t] = sigmoid_f(bb); gc[t] = x; egc[t] = __expf(x); ekd[t] = __expf(gl - x); if (lane == 0) R.gl[item] = __expf(gl); }
    __syncthreads();
#ifdef PD1
    for (int _pr = 0; _pr < 2; ++_pr)
#endif
#pragma unroll
    for (int r = 0; r < 6; ++r) {
        const int sec = r >> 1; const int idx = (tid + 512 * r) & 1023; const int t = idx >> 4, g8 = idx & 15; const int col = sec * 2048 + h * 128 + 8 * g8;
        float acc[8];
#pragma unroll
        for (int i = 0; i < 8; ++i) acc[i] = 0.f;
#pragma unroll
        for (int j = 0; j < 4; ++j) { const int tt = 64 * c + t - 3 + j;
            v4u xv = (v4u){0u, 0u, 0u, 0u}; if (tt >= 0) xv = *(const GAS v4u*)(P.proj + (size_t)(b * SEQ + tt) * IN_WP + col);
            const f32x4 w0 = *(const GAS f32x4*)(P.conv_w + j * 6144 + col), w1 = *(const GAS f32x4*)(P.conv_w + j * 6144 + col + 4);
            acc[0] += bflo(xv.x) * w0.x; acc[1] += bfhi(xv.x) * w0.y; acc[2] += bflo(xv.y) * w0.z; acc[3] += bfhi(xv.y) * w0.w;
            acc[4] += bflo(xv.z) * w1.x; acc[5] += bfhi(xv.z) * w1.y; acc[6] += bflo(xv.w) * w1.z; acc[7] += bfhi(xv.w) * w1.w; }
        float y[8]; float ss = 0.f;
#pragma unroll
        for (int i = 0; i < 8; ++i) { y[i] = acc[i] * sigmoid_f(acc[i]); ss += y[i] * y[i]; }
        if (sec < 2) { ss += __shfl_xor(ss, 1); ss += __shfl_xor(ss, 2); ss += __shfl_xor(ss, 4); ss += __shfl_xor(ss, 8);
            const float scl = (sec == 0 ? 0.08838834764831845f : 1.0f) / sqrtf(ss + 1e-6f);
#pragma unroll
            for (int i = 0; i < 8; ++i) y[i] *= scl; }
        if (sec == 0) { v4u o; o.x = cvt2(y[0], y[1]); o.y = cvt2(y[2], y[3]); o.z = cvt2(y[4], y[5]); o.w = cvt2(y[6], y[7]); *(LAS v4u*)(Qn + t * 136 + 8 * g8) = o; }
        else if (sec == 1) { v4u o; o.x = cvt2(y[0], y[1]); o.y = cvt2(y[2], y[3]); o.z = cvt2(y[4], y[5]); o.w = cvt2(y[6], y[7]); *(LAS v4u*)(Kn + t * 136 + 8 * g8) = o;
            const float f = beta[t] * egc[t];
#pragma unroll
            for (int i = 0; i < 8; ++i) KbgT[(8 * g8 + i) * 72 + t] = (bf16)(cvt2(y[i] * f, 0.f) & 0xffffu); }
        else { const float f = beta[t];
#pragma unroll
            for (int i = 0; i < 8; ++i) VbT[(8 * g8 + i) * 72 + t] = (bf16)(cvt2(y[i] * f, 0.f) & 0xffffu); }
    }
    __syncthreads();
#ifdef PD2
    for (int _pr = 0; _pr < 2; ++_pr) {
#else
    {
#endif
    {   const int tt = wave & 3, sp = wave >> 2, l15 = lane & 15, q = lane >> 4;
#pragma unroll
        for (int si = 0; si < 2; ++si) { const int st = 2 * sp + si;
            f32x4 aL = (f32x4){0.f, 0.f, 0.f, 0.f}, aQ = (f32x4){0.f, 0.f, 0.f, 0.f};
#pragma unroll
            for (int ks = 0; ks < 4; ++ks) {
                const bf16x8 fs = *(const LAS bf16x8*)(Kn + (16 * st + l15) * 136 + 32 * ks + 8 * q);
                const bf16x8 ft = *(const LAS bf16x8*)(Kn + (16 * tt + l15) * 136 + 32 * ks + 8 * q);
                const bf16x8 fq = *(const LAS bf16x8*)(Qn + (16 * tt + l15) * 136 + 32 * ks + 8 * q);
                aL = MFMA16(fs, ft, aL); aQ = MFMA16(fs, fq, aQ); }
            const int t = 16 * tt + l15; const float gct = gc[t], bt = beta[t]; float qv[4];
#pragma unroll
            for (int reg = 0; reg < 4; ++reg) { const int s = 16 * st + 4 * q + reg; const float dec = __expf(gct - gc[s]);
                Lm[t * 65 + s] = (t > s) ? bt * aL[reg] * dec : 0.f; qv[reg] = (t >= s) ? aQ[reg] * dec : 0.f; }
            v2u qkp; qkp.x = cvt2(qv[0], qv[1]); qkp.y = cvt2(qv[2], qv[3]);
            *(GAS v2u*)(qkr + ((((t >> 5) * 4 + st) * 64 + (t & 31) + 32 * (q & 1)) * 16 + 8 * (q >> 1))) = qkp;
        }
    }
#pragma unroll
    for (int r = 0; r < 2; ++r) { const int fl = tid + 512 * r; const int ln = fl & 63, ks = (fl >> 6) & 7, mt = fl >> 9;
        const int t = 32 * mt + (ln & 31), d0 = 16 * ks + 4 * (ln >> 5); const float f = egc[t];
        const v2u a = *(const LAS v2u*)(Qn + t * 136 + d0), bq = *(const LAS v2u*)(Qn + t * 136 + d0 + 8);
        v4u o; o.x = cvt2(bflo(a.x) * f, bfhi(a.x) * f); o.y = cvt2(bflo(a.y) * f, bfhi(a.y) * f); o.z = cvt2(bflo(bq.x) * f, bfhi(bq.x) * f); o.w = cvt2(bflo(bq.y) * f, bfhi(bq.y) * f);
        *(GAS v4u*)(rec + 16384 + fl * 16) = o; }
#pragma unroll
    for (int r = 0; r < 2; ++r) { const int fl = tid + 512 * r; const int ln = fl & 63, kt = (fl >> 6) & 3, mtd = fl >> 8;
        const int d = 32 * mtd + (ln & 31), t0 = 16 * kt + 4 * (ln >> 5); float v[8];
#pragma unroll
        for (int j = 0; j < 8; ++j) { const int t = t0 + 8 * (j >> 2) + (j & 3); v[j] = bf2f(Kn[t * 136 + d]) * ekd[t]; }
        v4u o; o.x = cvt2(v[0], v[1]); o.y = cvt2(v[2], v[3]); o.z = cvt2(v[4], v[5]); o.w = cvt2(v[6], v[7]);
        *(GAS v4u*)(rec + 32768 + fl * 16) = o; }
    __syncthreads();
    }
    tri_inv64(Lm, Tm, Tb, Dinv, Yb, tid, lane, wave);
#ifdef PD4
    for (int _pr = 0; _pr < 2; ++_pr)
#endif
    {   const int tt = wave & 3, hf = wave >> 2, l15 = lane & 15, q = lane >> 4;
        bf16x8 tf[2];
#pragma unroll
        for (int ks = 0; ks < 2; ++ks) tf[ks] = *(const LAS bf16x8*)(Tb + (16 * tt + l15) * 72 + 32 * ks + 8 * q);
#pragma unroll
        for (int n = 0; n < 4; ++n) { const int et = 4 * hf + n;
            f32x4 au = (f32x4){0.f, 0.f, 0.f, 0.f}, aw = (f32x4){0.f, 0.f, 0.f, 0.f};
#pragma unroll
            for (int ks = 0; ks < 2; ++ks) { const bf16x8 fv = *(const LAS bf16x8*)(VbT + (16 * et + l15) * 72 + 32 * ks + 8 * q); const bf16x8 fk = *(const LAS bf16x8*)(KbgT + (16 * et + l15) * 72 + 32 * ks + 8 * q);
                au = MFMA16(tf[ks], fv, au);
                aw = MFMA16(fk, tf[ks], aw); }
            v2u up; up.x = cvt2(au[0], au[1]); up.y = cvt2(au[2], au[3]);
            *(GAS v2u*)(rec + 49152 + ((16 * et + l15) * 64 + 16 * tt + 4 * q) * 2) = up;
            const int t = 16 * tt + l15; v2u wp; wp.x = cvt2(aw[0], aw[1]); wp.y = cvt2(aw[2], aw[3]);
            *(GAS v2u*)(rec + ((((t >> 5) * 8 + et) * 64 + (t & 31) + 32 * (q & 1)) * 16 + 8 * (q >> 1))) = wp; }
    }
    __syncthreads();
}

#define WG_BAR_LDS() do { asm volatile("s_waitcnt lgkmcnt(0)" ::: "memory"); __builtin_amdgcn_s_barrier(); asm volatile("" ::: "memory"); } while (0)
__device__ __forceinline__ void dn_scan(const MixPtrs& P, const DnRec& R, LAS unsigned char* lds, int b, int h, int tid, int lane, int wave) {
    constexpr int SB = 57344; LAS unsigned char* obuf = lds + 2 * SB;
    const int item0 = b * 128 * 16 + h;
    if (wave < 4) {
        const int e = 32 * wave + (lane & 31), hh = lane >> 5;
        f32x16 S[4];
#pragma unroll
        for (int dt = 0; dt < 4; ++dt)
#pragma unroll
            for (int i = 0; i < 16; ++i) S[dt][i] = 0.f;
        v2u uu[2][4];
#pragma unroll
        for (int mt = 0; mt < 2; ++mt)
#pragma unroll
            for (int g = 0; g < 4; ++g) uu[mt][g] = *(const GAS v2u*)(R.rec + (size_t)item0 * 65536 + 49152 + (e * 64 + 32 * mt + 8 * g + 4 * hh) * 2);
        float egl = R.gl[item0];
        WG_BAR_LDS();
#pragma unroll 1
        for (int c = 0; c < 128; ++c) {
            LAS unsigned char* buf = lds + (c & 1) * SB;
            f32x16 o0, o1;
            bf16x8 Sf[8];
#pragma unroll
            for (int dt = 0; dt < 4; ++dt) { Sf[2 * dt] = pack_step(S[dt], 0); Sf[2 * dt + 1] = pack_step(S[dt], 1); }
            f32x16 w0, w1;
#pragma unroll
            for (int i = 0; i < 16; ++i) { w0[i] = 0.f; w1[i] = 0.f; o0[i] = 0.f; o1[i] = 0.f; }
#pragma unroll
            for (int ks = 0; ks < 8; ++ks) { const bf16x8 a0 = *(const LAS bf16x8*)(buf + (ks * 64 + lane) * 16), a1 = *(const LAS bf16x8*)(buf + ((8 + ks) * 64 + lane) * 16);
                w0 = MFMA32(a0, Sf[ks], w0); w1 = MFMA32(a1, Sf[ks], w1); }
#pragma unroll
            for (int g = 0; g < 4; ++g) {
                w0[4 * g] = bflo(uu[0][g].x) - w0[4 * g]; w0[4 * g + 1] = bfhi(uu[0][g].x) - w0[4 * g + 1]; w0[4 * g + 2] = bflo(uu[0][g].y) - w0[4 * g + 2]; w0[4 * g + 3] = bfhi(uu[0][g].y) - w0[4 * g + 3];
                w1[4 * g] = bflo(uu[1][g].x) - w1[4 * g]; w1[4 * g + 1] = bfhi(uu[1][g].x) - w1[4 * g + 1]; w1[4 * g + 2] = bflo(uu[1][g].y) - w1[4 * g + 2]; w1[4 * g + 3] = bfhi(uu[1][g].y) - w1[4 * g + 3]; }
            const float eg_cur = egl;
            if (c + 1 < 128) {
                const unsigned char* recn = R.rec + (size_t)(item0 + 16 * (c + 1)) * 65536;
#pragma unroll
                for (int mt = 0; mt < 2; ++mt)
#pragma unroll
                    for (int g = 0; g < 4; ++g) uu[mt][g] = *(const GAS v2u*)(recn + 49152 + (e * 64 + 32 * mt + 8 * g + 4 * hh) * 2);
                egl = R.gl[item0 + 16 * (c + 1)];
            }
            bf16x8 Vf[4]; Vf[0] = pack_step(w0, 0); Vf[1] = pack_step(w0, 1); Vf[2] = pack_step(w1, 0); Vf[3] = pack_step(w1, 1);
#pragma unroll
            for (int ks = 0; ks < 8; ++ks) { const bf16x8 a0 = *(const LAS bf16x8*)(buf + 16384 + (ks * 64 + lane) * 16), a1 = *(const LAS bf16x8*)(buf + 16384 + ((8 + ks) * 64 + lane) * 16);
                o0 = MFMA32(a0, Sf[ks], o0); o1 = MFMA32(a1, Sf[ks], o1); }
#pragma unroll
            for (int kt = 0; kt < 4; ++kt) { const bf16x8 a0 = *(const LAS bf16x8*)(buf + 49152 + (kt * 64 + lane) * 16), a1 = *(const LAS bf16x8*)(buf + 49152 + ((4 + kt) * 64 + lane) * 16);
                o0 = MFMA32(a0, Vf[kt], o0); o1 = MFMA32(a1, Vf[kt], o1); }
#pragma unroll
            for (int dt = 0; dt < 4; ++dt) {
#pragma unroll
                for (int i = 0; i < 16; ++i) S[dt][i] *= eg_cur;
#pragma unroll
                for (int kt = 0; kt < 4; ++kt) { const bf16x8 a = *(const LAS bf16x8*)(buf + 32768 + ((dt * 4 + kt) * 64 + lane) * 16); S[dt] = MFMA32(a, Vf[kt], S[dt]); } }
            WG_BAR_LDS();
#pragma unroll
            for (int i = 0; i < 16; ++i) { const int row = (i & 3) + 8 * (i >> 2) + 4 * hh;
                ((LAS bf16*)obuf)[row * 128 + e] = (bf16)(cvt2(o0[i], 0.f) & 0xffffu); ((LAS bf16*)obuf)[(32 + row) * 128 + e] = (bf16)(cvt2(o1[i], 0.f) & 0xffffu); }
            WG_BAR_LDS();
        }
        float* Sout = P.out + O_SDN_P + ((size_t)b * 16 + h) * 16384;
#pragma unroll
        for (int dt = 0; dt < 4; ++dt)
#pragma unroll
            for (int i = 0; i < 16; ++i) Sout[(32 * dt + (i & 3) + 8 * (i >> 2) + 4 * hh) * 128 + e] = S[dt][i];
    } else {
        const int ht = tid - 256; const int pt = ht >> 2, pq = ht & 3;
        v4u st[14], zr[4];
#define DN_STAGE_ISSUE(itm) do { const unsigned char* _r = R.rec + (size_t)(itm) * 65536; const unsigned char* _q = R.qk + (size_t)(itm) * 8192; \
        _Pragma("unroll") for (int _k = 0; _k < 12; ++_k) st[_k] = *(const GAS v4u*)(_r + (ht + 256 * _k) * 16); \
        _Pragma("unroll") for (int _k = 0; _k < 2; ++_k) st[12 + _k] = *(const GAS v4u*)(_q + (ht + 256 * _k) * 16); } while (0)
#define DN_STAGE_WRITE(dstbuf) do { _Pragma("unroll") for (int _k = 0; _k < 14; ++_k) *(LAS v4u*)((dstbuf) + (ht + 256 * _k) * 16) = st[_k]; } while (0)
#define DN_Z_ISSUE(cc) do { const size_t _m = (size_t)(b * SEQ + 64 * (cc) + pt); _Pragma("unroll") for (int _k = 0; _k < 4; ++_k) zr[_k] = *(const GAS v4u*)(P.proj + _m * IN_WP + PC_Z + h * 128 + 32 * pq + 8 * _k); } while (0)
#define DN_POST(cc) do { const int _m = b * SEQ + 64 * (cc) + pt; v4u _o[4]; \
        _Pragma("unroll") for (int _k = 0; _k < 4; ++_k) _o[_k] = *(const LAS v4u*)(obuf + (pt * 128 + 32 * pq + 8 * _k) * 2); \
        float _ss = 0.f; _Pragma("unroll") for (int _k = 0; _k < 4; ++_k) { const float a0 = bflo(_o[_k].x), a1 = bfhi(_o[_k].x), a2 = bflo(_o[_k].y), a3 = bfhi(_o[_k].y), a4 = bflo(_o[_k].z), a5 = bfhi(_o[_k].z), a6 = bflo(_o[_k].w), a7 = bfhi(_o[_k].w); \
            _ss += (a0 * a0 + a1 * a1) + (a2 * a2 + a3 * a3) + (a4 * a4 + a5 * a5) + (a6 * a6 + a7 * a7); } \
        _ss += __shfl_xor(_ss, 1); _ss += __shfl_xor(_ss, 2); const float _rs = 1.0f / sqrtf(_ss * (1.f / 128.f) + NORM_EPS); \
        _Pragma("unroll") for (int _k = 0; _k < 4; ++_k) { const GAS f32x4* _nw = (const GAS f32x4*)(P.dn_norm_w + 32 * pq + 8 * _k); const f32x4 n0 = _nw[0], n1 = _nw[1]; \
            const float z0 = bflo(zr[_k].x), z1 = bfhi(zr[_k].x), z2 = bflo(zr[_k].y), z3 = bfhi(zr[_k].y), z4 = bflo(zr[_k].z), z5 = bfhi(zr[_k].z), z6 = bflo(zr[_k].w), z7 = bfhi(zr[_k].w); \
            v4u _w; _w.x = cvt2(bflo(_o[_k].x) * _rs * n0.x * (z0 * sigmoid_f(z0)), bfhi(_o[_k].x) * _rs * n0.y * (z1 * sigmoid_f(z1))); \
            _w.y = cvt2(bflo(_o[_k].y) * _rs * n0.z * (z2 * sigmoid_f(z2)), bfhi(_o[_k].y) * _rs * n0.w * (z3 * sigmoid_f(z3))); \
            _w.z = cvt2(bflo(_o[_k].z) * _rs * n1.x * (z4 * sigmoid_f(z4)), bfhi(_o[_k].z) * _rs * n1.y * (z5 * sigmoid_f(z5))); \
            _w.w = cvt2(bflo(_o[_k].w) * _rs * n1.z * (z6 * sigmoid_f(z6)), bfhi(_o[_k].w) * _rs * n1.w * (z7 * sigmoid_f(z7))); \
            *(GAS v4u*)(P.mix + (size_t)_m * 4096 + h * 128 + 32 * pq + 8 * _k) = _w; } } while (0)
        DN_STAGE_ISSUE(item0); DN_STAGE_WRITE(lds); DN_STAGE_ISSUE(item0 + 16);
        WG_BAR_LDS();
#pragma unroll 1
        for (int c = 0; c < 128; ++c) {
            if (c + 1 < 128) DN_STAGE_WRITE(lds + ((c + 1) & 1) * SB);
            if (c + 2 < 128) DN_STAGE_ISSUE(item0 + 16 * (c + 2));
            if (c > 0) DN_POST(c - 1);
            DN_Z_ISSUE(c);
            WG_BAR_LDS();
            WG_BAR_LDS();
        }
        DN_POST(127);
#undef DN_STAGE_ISSUE
#undef DN_STAGE_WRITE
#undef DN_Z_ISSUE
#undef DN_POST
    }
    {   float* cout = P.out + O_CONV_P + (size_t)b * 3 * 6144;
        for (int i = tid; i < 3 * 384; i += 512) { const int r = i / 384, cc = i - r * 384, col = (cc >> 7) * 2048 + h * 128 + (cc & 127);
            cout[r * 6144 + col] = bf2f(P.proj[(size_t)(b * SEQ + SEQ - 3 + r) * IN_WP + col]); } }
    __syncthreads();
}
struct RwRec { unsigned char* pq; unsigned char* rp; unsigned char* oo; float* sb; const bf16* w2T; const bf16* a2T; const bf16* g2T; };
constexpr int RSL = 9216;

__device__ __forceinline__ void rw_prep_item(const MixPtrs& P, const RwRec& W, LAS unsigned char* lds, int b, int c, int h, int tid, int lane, int wave) {
    const int m0 = b * SEQ + 64 * c; const int item = (b * 128 + c) * 32 + h; const int hc = h * 64 + lane;
    const int l15 = lane & 15, q = lane >> 4;
    LAS bf16* Rt = (LAS bf16*)(lds + 0 * RSL); LAS bf16* Kt = (LAS bf16*)(lds + 1 * RSL); LAS bf16* Bt = (LAS bf16*)(lds + 2 * RSL); LAS bf16* At = (LAS bf16*)(lds + 3 * RSL);
    LAS bf16* AtT = (LAS bf16*)(lds + 4 * RSL); LAS bf16* KhT = (LAS bf16*)(lds + 5 * RSL); LAS bf16* BhT = (LAS bf16*)(lds + 6 * RSL); LAS bf16* VT = (LAS bf16*)(lds + 7 * RSL);
    LAS bf16* Aak = (LAS bf16*)(lds + 8 * RSL); LAS bf16* Ark = (LAS bf16*)(lds + 9 * RSL); LAS bf16* Arb = (LAS bf16*)(lds + 10 * RSL);
    LAS float* Lm = (LAS float*)(lds + 11 * RSL); LAS float* Tm = (LAS float*)(lds + 1 * RSL); LAS bf16* Tb = (LAS bf16*)(lds + 3 * RSL);
    LAS bf16* WtT = (LAS bf16*)(lds + 11 * RSL); LAS bf16* XT = (LAS bf16*)(lds + 12 * RSL); LAS bf16* U0T = (LAS bf16*)(lds + 1 * RSL);
    LAS float* Dinv = (LAS float*)(lds + 13 * RSL); LAS float* Yb = (LAS float*)(lds + 13 * RSL + 4352);
    LAS float* wl = (LAS float*)(lds + 0); LAS float* al = (LAS float*)(lds + 2 * RSL);
    LAS bf16* txw = (LAS bf16*)(lds + 8 * RSL); LAS bf16* xas = txw + 64 * 104; LAS bf16* w2s = xas + 64 * 104; LAS bf16* a2s = w2s + 64 * 104;
    LAS float* wtot = (LAS float*)(lds + 126976); LAS float* eGCs = (LAS float*)(lds + 129024);
    float rr[8], kr[8], vv[8];
    {   float ur[9], uk[9], uv[9];
#pragma unroll
        for (int i = 0; i < 9; ++i) { const int tt = 64 * c + wave * 8 + i - 1;
            if (tt >= 0) { const size_t ro = (size_t)(b * SEQ + tt) * IN_WP + PC_RW + hc; ur[i] = bf2f(P.proj[ro + RW_R]); uk[i] = bf2f(P.proj[ro + RW_K]); uv[i] = bf2f(P.proj[ro + RW_V]); }
            else { ur[i] = 0.f; uk[i] = 0.f; uv[i] = 0.f; } }
        const float mr = P.mu[RW_R + hc], mk = P.mu[RW_K + hc], mv = P.mu[RW_V + hc];
#pragma unroll
        for (int i = 0; i < 8; ++i) { rr[i] = ur[i + 1] + mr * (ur[i] - ur[i + 1]); kr[i] = uk[i + 1] + mk * (uk[i] - uk[i + 1]); vv[i] = uv[i + 1] + mv * (uv[i] - uv[i + 1]); }
    }
#ifdef PR1
    for (int _pr = 0; _pr < 2; ++_pr) {
#else
    {
#endif
#pragma unroll
    for (int r = 0; r < 3; ++r) { const int i = tid + 512 * r; const int which = i >= 768, ii = which ? i - 768 : i; const int t = ii / 12, g8 = ii - t * 12; const int tt = 64 * c + t;
        const int col = (which ? RW_XA : RW_XW) + 8 * g8;
        const v4u u = *(const GAS v4u*)(P.proj + (size_t)(m0 + t) * IN_WP + PC_RW + col); v4u up = (v4u){0u, 0u, 0u, 0u}; if (tt > 0) up = *(const GAS v4u*)(P.proj + (size_t)(m0 + t - 1) * IN_WP + PC_RW + col);
        const f32x4 m0v = *(const GAS f32x4*)(P.mu + col), m1v = *(const GAS f32x4*)(P.mu + col + 4);
        float x[8];
        x[0] = bflo(u.x) + m0v.x * (bflo(up.x) - bflo(u.x)); x[1] = bfhi(u.x) + m0v.y * (bfhi(up.x) - bfhi(u.x)); x[2] = bflo(u.y) + m0v.z * (bflo(up.y) - bflo(u.y)); x[3] = bfhi(u.y) + m0v.w * (bfhi(up.y) - bfhi(u.y));
        x[4] = bflo(u.z) + m1v.x * (bflo(up.z) - bflo(u.z)); x[5] = bfhi(u.z) + m1v.y * (bfhi(up.z) - bfhi(u.z)); x[6] = bflo(u.w) + m1v.z * (bflo(up.w) - bflo(u.w)); x[7] = bfhi(u.w) + m1v.w * (bfhi(up.w) - bfhi(u.w));
        if (!which) {
#pragma unroll
            for (int k = 0; k < 8; ++k) { const float e2 = __expf(2.0f * x[k]); x[k] = 1.0f - 2.0f / (e2 + 1.0f); } }
        v4u o; o.x = cvt2(x[0], x[1]); o.y = cvt2(x[2], x[3]); o.z = cvt2(x[4], x[5]); o.w = cvt2(x[6], x[7]);
        *(LAS v4u*)(txw + which * 6656 + t * 104 + 8 * g8) = o; }
    bf16x8 fw2[2][3], fa2[2][3];
#pragma unroll
    for (int ci = 0; ci < 2; ++ci)
#pragma unroll
        for (int ks = 0; ks < 3; ++ks) { const size_t o = (size_t)(h * 64 + 16 * (2 * (wave >> 2) + ci) + l15) * 96 + 32 * ks + 8 * q;
            fw2[ci][ks] = *(const GAS bf16x8*)(W.w2T + o); fa2[ci][ks] = *(const GAS bf16x8*)(W.a2T + o); }
    __syncthreads();
    {   const int tt = wave & 3, cp = wave >> 2;
#pragma unroll
        for (int ci = 0; ci < 2; ++ci) { const int ct = 2 * cp + ci;
            f32x4 aw = (f32x4){0.f, 0.f, 0.f, 0.f}, aa = (f32x4){0.f, 0.f, 0.f, 0.f};
#pragma unroll
            for (int ks = 0; ks < 3; ++ks) {
                const bf16x8 fx = *(const LAS bf16x8*)(txw + (16 * tt + l15) * 104 + 32 * ks + 8 * q), fa = *(const LAS bf16x8*)(xas + (16 * tt + l15) * 104 + 32 * ks + 8 * q);
                aw = MFMA16(fx, fw2[ci][ks], aw); aa = MFMA16(fa, fa2[ci][ks], aa); }
#pragma unroll
            for (int reg = 0; reg < 4; ++reg) { wl[(16 * tt + 4 * q + reg) * 65 + 16 * ct + l15] = aw[reg]; al[(16 * tt + 4 * q + reg) * 65 + 16 * ct + l15] = aa[reg]; } }
    }
    }
    __syncthreads();
    float lw[8], av[8], bvv[8], kp[8], Gt[8];
    {   const float w0c = P.w0[hc], a0c = P.a0[hc], kkc = P.k_k[hc], kac = P.k_a[hc], rkc = P.r_k[hc];
        float run = 0.f;
#pragma unroll
        for (int i = 0; i < 8; ++i) { const int t = wave * 8 + i;
            const float wlog = -softplus_f(-(w0c + wl[t * 65 + lane])) - 0.5f; lw[i] = -__expf(wlog);
            const float alr = sigmoid_f(a0c + al[t * 65 + lane]);
            const float kkr = kr[i] * kkc; const float kk = kkr / sqrtf(wave_sum(kkr * kkr) + 1e-6f);
            kp[i] = kr[i] * (1.0f + (alr - 1.0f) * kac); av[i] = -kk; bvv[i] = kk * alr;
            const float sbv = wave_sum(rr[i] * kp[i] * rkc); if (lane == 0) W.sb[(size_t)item * 64 + t] = sbv;
            run += lw[i]; Gt[i] = run; }
        wtot[wave * 64 + lane] = run;
    }
    __syncthreads();
    {   float off = 0.f, gcv = 0.f;
#pragma unroll
        for (int w = 0; w < 8; ++w) { const float x = wtot[w * 64 + lane]; gcv += x; if (w < wave) off += x; }
        if (wave == 0) eGCs[lane] = __expf(gcv);
        float tA[8], tK[8], tB[8];
#pragma unroll
        for (int i = 0; i < 8; ++i) { const int t = wave * 8 + i; const float G = Gt[i] + off;
            const float eG = __expf(G), eGm = __expf(-G), eGp = __expf(G - lw[i]), eH = __expf(gcv - G);
            Rt[t * 72 + lane] = (bf16)(cvt2(rr[i] * eG, 0.f) & 0xffffu); Kt[t * 72 + lane] = (bf16)(cvt2(kp[i] * eGm, 0.f) & 0xffffu);
            Bt[t * 72 + lane] = (bf16)(cvt2(bvv[i] * eGm, 0.f) & 0xffffu); tA[i] = av[i] * eGp; At[t * 72 + lane] = (bf16)(cvt2(tA[i], 0.f) & 0xffffu);
            tK[i] = kp[i] * eH; tB[i] = bvv[i] * eH; }
        v4u o;
        o.x = cvt2(tA[0], tA[1]); o.y = cvt2(tA[2], tA[3]); o.z = cvt2(tA[4], tA[5]); o.w = cvt2(tA[6], tA[7]); *(LAS v4u*)(AtT + lane * 72 + wave * 8) = o;
        o.x = cvt2(tK[0], tK[1]); o.y = cvt2(tK[2], tK[3]); o.z = cvt2(tK[4], tK[5]); o.w = cvt2(tK[6], tK[7]); *(LAS v4u*)(KhT + lane * 72 + wave * 8) = o;
        o.x = cvt2(tB[0], tB[1]); o.y = cvt2(tB[2], tB[3]); o.z = cvt2(tB[4], tB[5]); o.w = cvt2(tB[6], tB[7]); *(LAS v4u*)(BhT + lane * 72 + wave * 8) = o;
        o.x = cvt2(vv[0], vv[1]); o.y = cvt2(vv[2], vv[3]); o.z = cvt2(vv[4], vv[5]); o.w = cvt2(vv[6], vv[7]); *(LAS v4u*)(VT + lane * 72 + wave * 8) = o;
    }
    __syncthreads();
#ifdef PR4
    for (int _pr = 0; _pr < 2; ++_pr)
#endif
    {   const int tt = wave & 3, sp = wave >> 2;
        bf16x8 fA[2], fR[2];
#pragma unroll
        for (int ks = 0; ks < 2; ++ks) { fA[ks] = *(const LAS bf16x8*)(At + (16 * tt + l15) * 72 + 32 * ks + 8 * q); fR[ks] = *(const LAS bf16x8*)(Rt + (16 * tt + l15) * 72 + 32 * ks + 8 * q); }
#pragma unroll
        for (int si = 0; si < 2; ++si) { const int st = 2 * sp + si;
            f32x4 ab = (f32x4){0.f, 0.f, 0.f, 0.f}, ak = ab, rk = ab, rb = ab;
#pragma unroll
            for (int ks = 0; ks < 2; ++ks) { const bf16x8 fB = *(const LAS bf16x8*)(Bt + (16 * st + l15) * 72 + 32 * ks + 8 * q), fK = *(const LAS bf16x8*)(Kt + (16 * st + l15) * 72 + 32 * ks + 8 * q);
                ab = MFMA16(fB, fA[ks], ab); ak = MFMA16(fK, fA[ks], ak); rk = MFMA16(fK, fR[ks], rk); rb = MFMA16(fB, fR[ks], rb); }
            const int t = 16 * tt + l15, s0 = 16 * st + 4 * q; float vak[4], vrk[4], vrb[4];
#pragma unroll
            for (int reg = 0; reg < 4; ++reg) { const int s = s0 + reg; Lm[t * 65 + s] = (t > s) ? -ab[reg] : 0.f; vak[reg] = (t > s) ? ak[reg] : 0.f; vrk[reg] = (t >= s) ? rk[reg] : 0.f; vrb[reg] = (t >= s) ? rb[reg] : 0.f; }
            v2u o; o.x = cvt2(vak[0], vak[1]); o.y = cvt2(vak[2], vak[3]); *(LAS v2u*)(Aak + t * 72 + s0) = o;
            o.x = cvt2(vrk[0], vrk[1]); o.y = cvt2(vrk[2], vrk[3]); *(LAS v2u*)(Ark + t * 72 + s0) = o;
            o.x = cvt2(vrb[0], vrb[1]); o.y = cvt2(vrb[2], vrb[3]); *(LAS v2u*)(Arb + t * 72 + s0) = o; }
    }
    __syncthreads();
    tri_inv64(Lm, Tm, Tb, Dinv, Yb, tid, lane, wave);
#ifdef PR2
    tri_inv64(Lm, Tm, Tb, Dinv, Yb, tid, lane, wave);
#endif
#ifdef PR5
    for (int _pr = 0; _pr < 2; ++_pr) {
#else
    {
#endif
    {   const int tt = wave & 3, cp = wave >> 2;
        bf16x8 fT[2], fK[2];
#pragma unroll
        for (int ks = 0; ks < 2; ++ks) { fT[ks] = *(const LAS bf16x8*)(Tb + (16 * tt + l15) * 72 + 32 * ks + 8 * q); fK[ks] = *(const LAS bf16x8*)(Aak + (16 * tt + l15) * 72 + 32 * ks + 8 * q); }
#pragma unroll
        for (int ci = 0; ci < 2; ++ci) { const int ct = 2 * cp + ci;
            f32x4 aw = (f32x4){0.f, 0.f, 0.f, 0.f}, ax = aw;
#pragma unroll
            for (int ks = 0; ks < 2; ++ks) { const bf16x8 fa = *(const LAS bf16x8*)(AtT + (16 * ct + l15) * 72 + 32 * ks + 8 * q), fv = *(const LAS bf16x8*)(VT + (16 * ct + l15) * 72 + 32 * ks + 8 * q);
                aw = MFMA16(fT[ks], fa, aw); ax = MFMA16(fK[ks], fv, ax); }
            v2u o; o.x = cvt2(aw[0], aw[1]); o.y = cvt2(aw[2], aw[3]); *(LAS v2u*)(WtT + (16 * ct + l15) * 72 + 16 * tt + 4 * q) = o;
            o.x = cvt2(ax[0], ax[1]); o.y = cvt2(ax[2], ax[3]); *(LAS v2u*)(XT + (16 * ct + l15) * 72 + 16 * tt + 4 * q) = o; }
    }
    __syncthreads();
    {   const int tt = wave & 3, cp = wave >> 2;
#pragma unroll
        for (int ci = 0; ci < 2; ++ci) { const int et = 2 * cp + ci; f32x4 au = (f32x4){0.f, 0.f, 0.f, 0.f};
#pragma unroll
            for (int ks = 0; ks < 2; ++ks) { const bf16x8 fT = *(const LAS bf16x8*)(Tb + (16 * tt + l15) * 72 + 32 * ks + 8 * q), fx = *(const LAS bf16x8*)(XT + (16 * et + l15) * 72 + 32 * ks + 8 * q);
                au = MFMA16(fT, fx, au); }
            v2u o; o.x = cvt2(au[0], au[1]); o.y = cvt2(au[2], au[3]); *(LAS v2u*)(U0T + (16 * et + l15) * 72 + 16 * tt + 4 * q) = o; }
    }
    __syncthreads();
    }
#ifdef PR3
    for (int _pr = 0; _pr < 2; ++_pr)
#endif
    {   const int bt = wave & 3, ap = wave >> 2;
        unsigned char* pq = W.pq + (size_t)item * 16384; unsigned char* rp = W.rp + (size_t)item * 8192; unsigned char* oo = W.oo + (size_t)item * 8192;
        bf16x8 fArb[2], fArk[2], fBh[2], fV[2], fU[2];
#pragma unroll
        for (int ks = 0; ks < 2; ++ks) { fArb[ks] = *(const LAS bf16x8*)(Arb + (16 * bt + l15) * 72 + 32 * ks + 8 * q); fArk[ks] = *(const LAS bf16x8*)(Ark + (16 * bt + l15) * 72 + 32 * ks + 8 * q);
            fBh[ks] = *(const LAS bf16x8*)(BhT + (16 * bt + l15) * 72 + 32 * ks + 8 * q); fV[ks] = *(const LAS bf16x8*)(VT + (16 * bt + l15) * 72 + 32 * ks + 8 * q); fU[ks] = *(const LAS bf16x8*)(U0T + (16 * bt + l15) * 72 + 32 * ks + 8 * q); }
#pragma unroll
        for (int ai = 0; ai < 2; ++ai) { const int at = 2 * ap + ai;
            f32x4 aR = (f32x4){0.f, 0.f, 0.f, 0.f}, aP = aR, aO = aR, aQ = aR;
#pragma unroll
            for (int ks = 0; ks < 2; ++ks) {
                const bf16x8 fW = *(const LAS bf16x8*)(WtT + (16 * at + l15) * 72 + 32 * ks + 8 * q);
                aR = MFMA16(fW, fArb[ks], aR);
                aP = MFMA16(fW, fBh[ks], aP);
                const bf16x8 fk = *(const LAS bf16x8*)(Ark + (16 * at + l15) * 72 + 32 * ks + 8 * q), fb = *(const LAS bf16x8*)(Arb + (16 * at + l15) * 72 + 32 * ks + 8 * q);
                aO = MFMA16(fk, fV[ks], aO); aO = MFMA16(fb, fU[ks], aO);
                const bf16x8 fkh = *(const LAS bf16x8*)(KhT + (16 * at + l15) * 72 + 32 * ks + 8 * q), fbh = *(const LAS bf16x8*)(BhT + (16 * at + l15) * 72 + 32 * ks + 8 * q);
                aQ = MFMA16(fkh, fV[ks], aQ); aQ = MFMA16(fbh, fU[ks], aQ); }
            const int x = 16 * bt + l15, y0 = 16 * at + 4 * q;
            {   const v2u rt = *(const LAS v2u*)(Rt + x * 72 + y0);
                v2u o; o.x = cvt2(aR[0] + bflo(rt.x), aR[1] + bfhi(rt.x)); o.y = cvt2(aR[2] + bflo(rt.y), aR[3] + bfhi(rt.y));
                *(GAS v2u*)(rp + ((((x >> 5) * 4 + at) * 64 + (x & 31) + 32 * (q & 1)) * 16 + 8 * (q >> 1))) = o; }
            {   const float dg = eGCs[x]; float p[4];
#pragma unroll
                for (int reg = 0; reg < 4; ++reg) p[reg] = aP[reg] + ((y0 + reg == x) ? dg : 0.f);
                v2u o; o.x = cvt2(p[0], p[1]); o.y = cvt2(p[2], p[3]);
                *(GAS v2u*)(pq + ((((x >> 5) * 4 + at) * 64 + (x & 31) + 32 * (q & 1)) * 16 + 8 * (q >> 1))) = o; }
            {   v2u o; o.x = cvt2(aO[0], aO[1]); o.y = cvt2(aO[2], aO[3]); *(GAS v2u*)(oo + (x * 64 + y0) * 2) = o; }
            {   v2u o; o.x = cvt2(aQ[0], aQ[1]); o.y = cvt2(aQ[2], aQ[3]); *(GAS v2u*)(pq + 8192 + (x * 64 + y0) * 2) = o; }
        }
    }
    __syncthreads();
}

__device__ __forceinline__ void rw_scan(const MixPtrs& P, const RwRec& W, LAS unsigned char* lds, int b, int h, int tid, int lane, int wave) {
    constexpr int SB = 33792;
    const int item0 = b * 128 * 32 + h;
    if (wave < 2) {
        const int e = 32 * wave + (lane & 31), hh = lane >> 5;
        f32x16 H[2];
#pragma unroll
        for (int i = 0; i < 16; ++i) { H[0][i] = 0.f; H[1][i] = 0.f; }
        WG_BAR_LDS();
#pragma unroll 1
        for (int c = 0; c < 128; ++c) {
            LAS unsigned char* buf = lds + (c & 1) * SB;
            bf16x8 Hf[4]; Hf[0] = pack_step(H[0], 0); Hf[1] = pack_step(H[0], 1); Hf[2] = pack_step(H[1], 0); Hf[3] = pack_step(H[1], 1);
#pragma unroll
            for (int mt = 0; mt < 2; ++mt) {
                f32x16 hn, ov;
#pragma unroll
                for (int g = 0; g < 4; ++g) { const v2u qv = *(const LAS v2u*)(buf + 16384 + e * 136 + (32 * mt + 8 * g + 4 * hh) * 2), o0 = *(const LAS v2u*)(buf + 16384 + 8704 + e * 136 + (32 * mt + 8 * g + 4 * hh) * 2);
                    hn[4 * g] = bflo(qv.x); hn[4 * g + 1] = bfhi(qv.x); hn[4 * g + 2] = bflo(qv.y); hn[4 * g + 3] = bfhi(qv.y);
                    ov[4 * g] = bflo(o0.x); ov[4 * g + 1] = bfhi(o0.x); ov[4 * g + 2] = bflo(o0.y); ov[4 * g + 3] = bfhi(o0.y); }
#pragma unroll
                for (int ks = 0; ks < 4; ++ks) { const bf16x8 fp = *(const LAS bf16x8*)(buf + ((mt * 4 + ks) * 64 + lane) * 16), fr = *(const LAS bf16x8*)(buf + 8192 + ((mt * 4 + ks) * 64 + lane) * 16);
                    hn = MFMA32(fp, Hf[ks], hn); ov = MFMA32(fr, Hf[ks], ov); }
#pragma unroll
                for (int g = 0; g < 4; ++g) { v2u o; o.x = cvt2(ov[4 * g], ov[4 * g + 1]); o.y = cvt2(ov[4 * g + 2], ov[4 * g + 3]); *(LAS v2u*)(buf + 16384 + 8704 + e * 136 + (32 * mt + 8 * g + 4 * hh) * 2) = o; }
                if (mt == 0) H[0] = hn; else H[1] = hn;
            }
            WG_BAR_LDS();
        }
        float* Sout = P.out + O_SRW_P + ((size_t)b * 32 + h) * 4096;
#pragma unroll
        for (int mt = 0; mt < 2; ++mt)
#pragma unroll
            for (int g = 0; g < 4; ++g) *(f32x4*)(Sout + e * 64 + 32 * mt + 8 * g + 4 * hh) = (f32x4){H[mt][4 * g], H[mt][4 * g + 1], H[mt][4 * g + 2], H[mt][4 * g + 3]};
    } else {
        const int ht = tid - 128;
        v4u st[6];
#define RW_STAGE_ISSUE(itm) do { const unsigned char* _pq = W.pq + (size_t)(itm) * 16384; const unsigned char* _rp = W.rp + (size_t)(itm) * 8192; const unsigned char* _oo = W.oo + (size_t)(itm) * 8192; \
        _Pragma("unroll") for (int _k = 0; _k < 6; ++_k) { const int _i = ht + 384 * _k; if (_i < 2048) st[_k] = *(const GAS v4u*)(_i < 512 ? _pq + _i * 16 : (_i < 1024 ? _rp + (_i - 512) * 16 : (_i < 1536 ? _pq + 8192 + (_i - 1024) * 16 : _oo + (_i - 1536) * 16))); } } while (0)
#define RW_STAGE_WRITE(dstbuf) do { _Pragma("unroll") for (int _k = 0; _k < 6; ++_k) { const int _i = ht + 384 * _k; if (_i < 1024) *(LAS v4u*)((dstbuf) + _i * 16) = st[_k]; \
            else if (_i < 2048) { const int _j = _i - 1024; LAS unsigned char* _d = (dstbuf) + 16384 + (_j >> 3) * 136 + (_j & 7) * 16; *(LAS v2u*)_d = (v2u){st[_k].x, st[_k].y}; *(LAS v2u*)(_d + 8) = (v2u){st[_k].z, st[_k].w}; } } } while (0)
#define RW_STORE_O(itm, srcbuf) do { unsigned char* _oo = W.oo + (size_t)(itm) * 8192; \
        _Pragma("unroll") for (int _k = 4; _k < 6; ++_k) { const int _i = ht + 384 * _k; if (_i < 2048) { const int _j = _i - 1024; const LAS unsigned char* _s = (srcbuf) + 16384 + (_j >> 3) * 136 + (_j & 7) * 16; \
            const v2u _a = *(const LAS v2u*)_s, _b = *(const LAS v2u*)(_s + 8); *(GAS v4u*)(_oo + (_i - 1536) * 16) = (v4u){_a.x, _a.y, _b.x, _b.y}; } } } while (0)
        RW_STAGE_ISSUE(item0); RW_STAGE_WRITE(lds); RW_STAGE_ISSUE(item0 + 32);
        WG_BAR_LDS();
#pragma unroll 1
        for (int c = 0; c < 128; ++c) {
            if (c > 0) RW_STORE_O(item0 + 32 * (c - 1), lds + ((c - 1) & 1) * SB);
            if (c + 1 < 128) RW_STAGE_WRITE(lds + ((c + 1) & 1) * SB);
            if (c + 2 < 128) RW_STAGE_ISSUE(item0 + 32 * (c + 2));
            WG_BAR_LDS();
        }
        RW_STORE_O(item0 + 32 * 127, lds + SB);
#undef RW_STAGE_ISSUE
#undef RW_STAGE_WRITE
#undef RW_STORE_O
    }
    {   float* shout = P.out + O_SHIFT_P + (size_t)b * RW_SHIFT_W;
        for (int i = tid; i < 206; i += 512) { const int col = h * 206 + i; shout[col] = bf2f(P.proj[(size_t)(b * SEQ + SEQ - 1) * IN_WP + PC_RW + col]); } }
    __syncthreads();
}

__device__ __forceinline__ void rw_gate_item(const MixPtrs& P, const RwRec& W, LAS unsigned char* lds, int b, int c, int qt, int tid, int lane, int wave) {
    const int m0 = b * SEQ + 64 * c; const int l15 = lane & 15, q = lane >> 4;
    LAS bf16* sxg = (LAS bf16*)lds;
#pragma unroll
    for (int r = 0; r < 4; ++r) { const int i = tid + 512 * r; const int t = i >> 5, g8 = i & 31; const int tt = 64 * c + t; const int col = RW_XG + 8 * g8;
        const v4u u = *(const GAS v4u*)(P.proj + (size_t)(m0 + t) * IN_WP + PC_RW + col); v4u up = (v4u){0u, 0u, 0u, 0u}; if (tt > 0) up = *(const GAS v4u*)(P.proj + (size_t)(m0 + t - 1) * IN_WP + PC_RW + col);
        const f32x4 m0v = *(const GAS f32x4*)(P.mu + col), m1v = *(const GAS f32x4*)(P.mu + col + 4);
        float x[8];
        x[0] = bflo(u.x) + m0v.x * (bflo(up.x) - bflo(u.x)); x[1] = bfhi(u.x) + m0v.y * (bfhi(up.x) - bfhi(u.x)); x[2] = bflo(u.y) + m0v.z * (bflo(up.y) - bflo(u.y)); x[3] = bfhi(u.y) + m0v.w * (bfhi(up.y) - bfhi(u.y));
        x[4] = bflo(u.z) + m1v.x * (bflo(up.z) - bflo(u.z)); x[5] = bfhi(u.z) + m1v.y * (bfhi(up.z) - bfhi(u.z)); x[6] = bflo(u.w) + m1v.z * (bflo(up.w) - bflo(u.w)); x[7] = bfhi(u.w) + m1v.w * (bfhi(up.w) - bfhi(u.w));
        v4u o; o.x = cvt2(sigmoid_f(x[0]), sigmoid_f(x[1])); o.y = cvt2(sigmoid_f(x[2]), sigmoid_f(x[3])); o.z = cvt2(sigmoid_f(x[4]), sigmoid_f(x[5])); o.w = cvt2(sigmoid_f(x[6]), sigmoid_f(x[7]));
        *(LAS v4u*)(sxg + t * 264 + 8 * g8) = o; }
    __syncthreads();
    {   const int tt = wave & 3, hf = wave >> 2;
        bf16x8 fx[8];
#pragma unroll
        for (int ks = 0; ks < 8; ++ks) fx[ks] = *(const LAS bf16x8*)(sxg + (16 * tt + l15) * 264 + 32 * ks + 8 * q);
        const int colb = qt * 512 + hf * 256;
#pragma unroll 2
        for (int vt = 0; vt < 16; ++vt) { const bf16* gr = W.g2T + (size_t)(colb + 16 * vt + l15) * 256 + 8 * q;
            bf16x8 fg[8];
#pragma unroll
            for (int ks = 0; ks < 8; ++ks) fg[ks] = *(const GAS bf16x8*)(gr + 32 * ks);
            f32x4 ag = (f32x4){0.f, 0.f, 0.f, 0.f};
#pragma unroll
            for (int ks = 0; ks < 8; ++ks) ag = MFMA16(fg[ks], fx[ks], ag);
            v2u o; o.x = cvt2(ag[0], ag[1]); o.y = cvt2(ag[2], ag[3]);
            *(GAS v2u*)(P.mix + (size_t)(m0 + 16 * tt + l15) * 4096 + 2048 + colb + 16 * vt + 4 * q) = o; }
    }
    __syncthreads();
}
__device__ __forceinline__ void rw_post_task(const MixPtrs& P, const RwRec& W, int item, int tg, int lane) {
    const int h = item & 31, c = (item >> 5) & 127, b = item >> 12; const int m0 = b * SEQ + 64 * c + 8 * tg; const int hc = h * 64 + lane;
    const v4u ov = *(const GAS v4u*)(W.oo + (size_t)item * 8192 + (lane * 64 + tg * 8) * 2);
    float uv[9], gt[8];
#pragma unroll
    for (int i = 0; i < 9; ++i) { const int tt = 64 * c + 8 * tg + i - 1; uv[i] = tt >= 0 ? bf2f(P.proj[(size_t)(b * SEQ + tt) * IN_WP + PC_RW + RW_V + hc]) : 0.f; }
#pragma unroll
    for (int i = 0; i < 8; ++i) gt[i] = bf2f(P.mix[(size_t)(m0 + i) * 4096 + 2048 + hc]);
    const float mv = P.mu[RW_V + hc], lnw = P.ln_w[hc], lnb = P.ln_b[hc];
    const float y[8] = {bflo(ov.x), bfhi(ov.x), bflo(ov.y), bfhi(ov.y), bflo(ov.z), bfhi(ov.z), bflo(ov.w), bfhi(ov.w)};
    float sbs[8];
#pragma unroll
    for (int i = 0; i < 8; ++i) sbs[i] = W.sb[(size_t)item * 64 + tg * 8 + i];
#pragma unroll
    for (int i = 0; i < 8; ++i) { const float vv = uv[i + 1] + mv * (uv[i] - uv[i + 1]);
        const float mean = wave_sum(y[i]) * (1.f / 64.f); const float dy = y[i] - mean; const float var = wave_sum(dy * dy) * (1.f / 64.f);
        const float yn = dy / sqrtf(var + RW_GN_EPS) * lnw + lnb;
        P.mix[(size_t)(m0 + i) * 4096 + 2048 + hc] = (bf16)(cvt2((yn + sbs[i] * vv) * gt[i], 0.f) & 0xffffu); }
}

constexpr int NPH = 10;
#define MK_N_LAUNCHES 1
#ifndef MK_N_LAUNCHES
#define MK_N_LAUNCHES 1
#endif
#ifndef GP_ALIGN
#define GP_ALIGN false
#endif
#ifndef GP_SP2
#define GP_SP2 true
#endif
#ifndef REP_MASK
#define REP_MASK 0
#endif
__global__ void __launch_bounds__(NWAVES * 64, 2) hymba_fwd(Args args) {
    extern __shared__ __attribute__((aligned(16))) unsigned char lds_raw[];
    LAS unsigned char* lds = (LAS unsigned char*)lds_raw;
    volatile LAS unsigned* MISC = (volatile LAS unsigned*)(lds + MISC_OFF);
    const int tid = threadIdx.x, lane = tid & 63, wave = __builtin_amdgcn_readfirstlane(tid >> 6);
    const int G = gridDim.x;
    unsigned char* ws = args.ws;
    gu32* ctl = (gu32*)(ws + WS_CTL);
    for (int u = tid; u < (LDS_BYTES - LDSCTL_OFF) / 4; u += NWAVES * 64) ((LAS unsigned*)(lds + LDSCTL_OFF))[u] = 0u;
    __syncthreads();
    XcdBarrier bar; bar.bar = (unsigned*)(ctl + CW_BAR); bar.x = 0; bar.st = nullptr;
    if (MK_N_LAUNCHES == 1) bar = xcd_barrier_post((unsigned*)(ctl + CW_BAR), MISC + 8);
    const int lo = args.ph_lo, hi = args.ph_hi;
#ifdef ONLY_PHASE
#define IN(k) ((k) == ONLY_PHASE)
#else
#define IN(k) (lo <= (k) && (k) < hi)
#endif
#define SEAM(k) do { if (IN(k) && IN((k) + 1)) xcd_barrier(bar); } while (0)
    float* ssq = (float*)(ws + WS_SSQ);
    bf16* Wt_out = (bf16*)(ws + WS_WOUT); bf16* hbuf = (bf16*)(ws + WS_HBUF); bf16* proj = (bf16*)(ws + WS_PROJ); bf16* act = (bf16*)(ws + WS_PROJ);
    bf16* Wt_in = (bf16*)(ws + WS_WIN); bf16* Wt_gu = (bf16*)(ws + WS_WGU); bf16* Wt_dn = (bf16*)(ws + WS_WDN);
    bf16* w2T = (bf16*)(ws + WS_W2T); bf16* a2T = (bf16*)(ws + WS_A2T); bf16* g2T = (bf16*)(ws + WS_G2T);
    const float* x_prompt = args.in[0]; const float* x_sample = args.in[1];
    const int gw = blockIdx.x * NWAVES + wave, NGW = G * NWAVES;

    if (IN(0)) _Pragma("unroll") for (int _r = 0; _r < 1 + ((REP_MASK >> 0) & 1); ++_r) {
        LAS float* scr = (LAS float*)(lds + RING_OFF + wave * 16384);
        constexpr int I_IN = 64 * (IN_W / 32);
        for (int it = gw; it < I_IN; it += NGW) p0_transpose_item(args.in[8], 4096, IN_W, Wt_in, scr, it, lane, RmId{});
        for (int i = blockIdx.x * 512 + tid; i < 2048 * 448; i += G * 512) {
            if (i < 2048 * 96) { const int c = i / 96, j = i - c * 96; w2T[i] = (bf16)f2bf(args.in[15][j * 2048 + c]); }
            else if (i < 2048 * 192) { const int ii = i - 2048 * 96; const int c = ii / 96, j = ii - c * 96; a2T[ii] = (bf16)f2bf(args.in[17][j * 2048 + c]); }
            else { const int ii = i - 2048 * 192; const int c = ii >> 8, j = ii & 255; g2T[ii] = (bf16)f2bf(args.in[18][j * 2048 + c]); }
        }
        for (int i = blockIdx.x * 512 + tid; i < 32 * 4096 / 8; i += G * 512) ((GAS v4u*)(Wt_in + (size_t)IN_W * 4096))[i] = (v4u){0u, 0u, 0u, 0u};
        for (int m = gw; m < MPAD; m += NGW) {
            bf16* orow = hbuf + (size_t)m * 4096;
            if (m < M_REAL) { const float* xrow = m < M_PROMPT ? x_prompt + (size_t)m * 4096 : x_sample + (size_t)(m - M_PROMPT) * 4096;
                const GAS f32x4* xr = (const GAS f32x4*)xrow + lane; f32x4 v[16];
#pragma unroll
                for (int j = 0; j < 16; ++j) v[j] = xr[64 * j];
                rms_row_to_bf16(v, args.in[6], orow, lane); }
            else { GAS v2u* o8 = (GAS v2u*)orow + lane;
#pragma unroll
                for (int j = 0; j < 16; ++j) o8[64 * j] = (v2u){0u, 0u}; }
        }
    }
    SEAM(0);
    if (IN(1)) _Pragma("unroll") for (int _r = 0; _r < 1 + ((REP_MASK >> 1) & 1); ++_r) {
        pg8::Gemm g{hbuf, Wt_in, MPAD, IN_WP, 4096, 4096, 4096}; pg8::StaticOrder S; S.init(MPAD, IN_WP, G, (int)blockIdx.x);
        pg8::EpiBf16Plain E{proj, IN_WP};
        pg8::gemm_phase<pg8::EpiBf16Plain, pg8::StaticOrder, GP_ALIGN, GP_SP2>(lds + RING_OFF, g, S, E);
    }
#ifdef PROBE_GEMM_RESIDENT
    if (IN(1)) {
        struct ProbeOrder : pg8::StaticOrder { __device__ bool next(int i, pg8::Unit& u) const { if (i >= 15) return false; u.pm = c & 7; u.pn = (c >> 3) & 3; return true; } };
        pg8::Gemm g{hbuf, Wt_in, MPAD, IN_WP, 4096, 4096, 4096}; ProbeOrder S; S.init(MPAD, IN_WP, G, (int)blockIdx.x);
        pg8::EpiBf16Plain E{Wt_gu, IN_WP};
        pg8::gemm_phase<pg8::EpiBf16Plain, ProbeOrder, GP_ALIGN, GP_SP2>(lds + RING_OFF, g, S, E);
    }
#endif
    SEAM(1);
    MixPtrs P; P.proj = proj; P.mix = hbuf; P.state_dn = args.in[2]; P.cache_conv = args.in[3]; P.state_rw = args.in[4]; P.cache_shift = args.in[5];
    P.conv_w = args.in[9]; P.a_log = args.in[10]; P.dt_bias = args.in[11]; P.dn_norm_w = args.in[12];
    P.mu = args.in[13]; P.w0 = args.in[14]; P.w2 = args.in[15]; P.a0 = args.in[16]; P.a2 = args.in[17]; P.g2 = args.in[18]; P.k_k = args.in[19]; P.k_a = args.in[20]; P.r_k = args.in[21];
    P.ln_w = args.in[22]; P.ln_b = args.in[23]; P.out = args.out;
    DnRec R; R.rec = (unsigned char*)args.out; R.qk = ws + WS_DNQK; R.gl = (float*)(ws + WS_DNGL);
    RwRec W; W.pq = ws + WS_RWPQ; W.rp = ws + WS_RWRP; W.oo = ws + WS_RWOO; W.sb = (float*)(ws + WS_RWSB); W.w2T = w2T; W.a2T = a2T; W.g2T = g2T;
    if (IN(2)) _Pragma("unroll") for (int _r = 0; _r < 1 + ((REP_MASK >> 2) & 1); ++_r) {
#ifndef REP_DNP
#define REP_DNP 0
#endif
#ifndef REP_RWP
#define REP_RWP 0
#endif
        for (int _q = 0; _q <= REP_DNP; ++_q)
        for (int it = blockIdx.x; it < 4096; it += G) dn_prep_item(P, R, lds + RING_OFF, it >> 11, (it >> 4) & 127, it & 15, tid, lane, wave);
        for (int _q = 0; _q <= REP_RWP; ++_q)
        for (int it = blockIdx.x; it < 8192; it += G) rw_prep_item(P, W, lds + RING_OFF, it >> 12, (it >> 5) & 127, it & 31, tid, lane, wave);
    }
    SEAM(2);
    if (IN(3)) _Pragma("unroll") for (int _r = 0; _r < 1 + ((REP_MASK >> 3) & 1); ++_r) {
        const int wg = blockIdx.x;
#ifndef REP_DNSCAN
#define REP_DNSCAN 0
#endif
#ifndef REP_SAMPLES
#define REP_SAMPLES 0
#endif
        if (wg < 32) { _Pragma("unroll 1") for (int _q = 0; _q <= REP_DNSCAN; ++_q) dn_scan(P, R, lds + RING_OFF, wg >> 4, wg & 15, tid, lane, wave); }
        else if (wg < 96) rw_scan(P, W, lds + RING_OFF, (wg - 32) >> 5, (wg - 32) & 31, tid, lane, wave);
        else {
            _Pragma("unroll 1") for (int _q = 0; _q <= REP_SAMPLES; ++_q)
            for (int it = wg - 96; it < 384; it += G - 96) {
                if (it < 128) dn_seq_item(P, lds + RING_OFF, 2 + (it >> 4), it & 15, tid, lane, wave);
                else rw_seq_item(P, w2T, a2T, g2T, lds + RING_OFF, 2 + ((it - 128) >> 5), (it - 128) & 31, tid, lane, wave);
            }
        }
        if (wg >= 32) {
            const int pw = wg - 32, npw = G - 32;
            for (int it = pw; it < 1024; it += npw) rw_gate_item(P, W, lds + RING_OFF, it >> 9, (it >> 2) & 127, it & 3, tid, lane, wave);
            LAS float* scr = (LAS float*)(lds + RING_OFF + wave * 16384);
            for (int it = pw * NWAVES + wave; it < 64 * 128; it += npw * NWAVES) p0_transpose_item(args.in[24], 4096, 4096, Wt_out, scr, it, lane, RmId{});
            for (int it = pw * NWAVES + wave; it < (D_FF / 64) * 98; it += npw * NWAVES) { const int kb = it / 98, nb = 30 + it % 98; p0_transpose_item(args.in[29], D_FF, 4096, Wt_dn, scr, kb * 128 + nb, lane, RmId{}); }
            __syncthreads();
        }
    }
    SEAM(3);
    if (IN(4)) _Pragma("unroll") for (int _r = 0; _r < 1 + ((REP_MASK >> 4) & 1); ++_r) {
        for (int task = gw; task < 8192 * 8; task += NGW) rw_post_task(P, W, task >> 3, task & 7, lane);
        LAS float* scr = (LAS float*)(lds + RING_OFF + wave * 16384);
        constexpr int I_G = 64 * (D_FF / 32), I_D = (D_FF / 64) * 30;
        for (int it = gw; it < 2 * I_G + I_D; it += NGW) {
            if (it < I_G) p0_transpose_item(args.in[27], 4096, D_FF, Wt_gu, scr, it, lane, RmGU{0});
            else if (it < 2 * I_G) p0_transpose_item(args.in[28], 4096, D_FF, Wt_gu, scr, it - I_G, lane, RmGU{1});
            else { const int r = it - 2 * I_G; const int kb = r / 30, nb = r % 30; p0_transpose_item(args.in[29], D_FF, 4096, Wt_dn, scr, kb * 128 + nb, lane, RmId{}); }
        }
        __syncthreads();
    }
    SEAM(4);
    if (IN(5)) _Pragma("unroll") for (int _r = 0; _r < 1 + ((REP_MASK >> 5) & 1); ++_r) {
#ifdef OLD_TAILS
        { pg8::Gemm g{hbuf, Wt_out, MPAD, 4096, 4096, 4096, 4096}; pg8::StaticOrder S; S.init(MPAD, 4096, G, (int)blockIdx.x);
        pg8::EpiF32Ssq E{args.out + O_Y, 4096, ssq, M_REAL};
        pg8::gemm_phase<pg8::EpiF32Ssq, pg8::StaticOrder, GP_ALIGN, GP_SP2>(lds + RING_OFF, g, S, E); }
#else
        pg8::Gemm g{hbuf, Wt_out, M_PROMPT, 4096, 4096, 4096, 4096}; pg8::StaticOrder S; S.init(M_PROMPT, 4096, G, (int)blockIdx.x);
        pg8::EpiF32Ssq E{args.out + O_Y, 4096, ssq, M_REAL};
        pg8::gemm_phase<pg8::EpiF32Ssq, pg8::StaticOrder, GP_ALIGN, GP_SP2>(lds + RING_OFF, g, S, E);
        pg8::Gemm gt{hbuf, Wt_out, MPAD, 4096, 256, 4096, 4096}; pg8::TailOrder St{16 * 16, G, (int)blockIdx.x, 0, 256, 0};
        pg8::EpiF32Part Et{(float*)(ws + WS_PART2), 4096};
        pg8::gemm_phase<pg8::EpiF32Part, pg8::TailOrder, GP_ALIGN, GP_SP2>(lds + RING_OFF, gt, St, Et);
#endif
    }
    SEAM(5);
    if (IN(6)) _Pragma("unroll") for (int _r = 0; _r < 1 + ((REP_MASK >> 6) & 1); ++_r) {
        for (int m = gw; m < M_REAL; m += NGW) {
            const float* xrow = m < M_PROMPT ? x_prompt + (size_t)m * 4096 : x_sample + (size_t)(m - M_PROMPT) * 4096;
            const GAS f32x4* xr = (const GAS f32x4*)xrow + lane; GAS f32x4* tr = (GAS f32x4*)(args.out + O_Y + (size_t)m * 4096) + lane; const GAS f32x4* gr = (const GAS f32x4*)args.in[7] + lane;
            f32x4 v[16]; float s = 0.f;
#ifdef OLD_TAILS
            const bool smp = false;
#else
            const bool smp = m >= M_PROMPT;
#endif
            if (smp) {
                const GAS f32x4* pp = (const GAS f32x4*)(ws + WS_PART2) + (size_t)(m - M_PROMPT) * 1024 + lane;
#pragma unroll
                for (int j = 0; j < 16; ++j) { f32x4 t[16];
#pragma unroll
                    for (int sp = 0; sp < 16; ++sp) t[sp] = pp[(size_t)sp * 128 * 1024 + 64 * j];
                    const f32x4 a = ((t[0] + t[1]) + (t[2] + t[3])) + ((t[4] + t[5]) + (t[6] + t[7])) + (((t[8] + t[9]) + (t[10] + t[11])) + ((t[12] + t[13]) + (t[14] + t[15])));
                    v[j] = a; s += (a.x * a.x + a.y * a.y) + (a.z * a.z + a.w * a.w); }
            } else {
#pragma unroll
                for (int j = 0; j < 16; ++j) v[j] = tr[64 * j];
                s = ssq[(size_t)m * 64 + lane];
            }
            s = wave_sum(s);
            const float rstd = 1.0f / sqrtf(s * (1.f / 4096.f) + NORM_EPS);
#pragma unroll
            for (int hh = 0; hh < 2; ++hh) { f32x4 xv[8], gv[8];
#pragma unroll
                for (int j = 0; j < 8; ++j) { xv[j] = xr[64 * (8 * hh + j)]; gv[j] = gr[64 * (8 * hh + j)]; }
#pragma unroll
                for (int j = 0; j < 8; ++j) { v[8 * hh + j] = xv[j] + v[8 * hh + j] * rstd * gv[j]; tr[64 * (8 * hh + j)] = v[8 * hh + j]; } }
            rms_row_to_bf16(v, args.in[25], hbuf + (size_t)m * 4096, lane);
        }
    }
    SEAM(6);
    if (IN(7)) _Pragma("unroll") for (int _r = 0; _r < 1 + ((REP_MASK >> 7) & 1); ++_r) {
        pg8::Gemm g{hbuf, Wt_gu, MPAD, 2 * D_FF, 4096, 4096, 4096}; pg8::StaticOrder S; S.init(MPAD, 2 * D_FF, G, (int)blockIdx.x);
        pg8::EpiSwiGLU E{act, D_FF};
        pg8::gemm_phase<pg8::EpiSwiGLU, pg8::StaticOrder, GP_ALIGN, GP_SP2>(lds + RING_OFF, g, S, E);
    }
    SEAM(7);
    if (IN(8)) _Pragma("unroll") for (int _r = 0; _r < 1 + ((REP_MASK >> 8) & 1); ++_r) {
#ifdef OLD_TAILS
        { pg8::Gemm g{act, Wt_dn, MPAD, 4096, D_FF, D_FF, D_FF}; pg8::StaticOrder S; S.init(MPAD, 4096, G, (int)blockIdx.x);
        pg8::EpiBf16Ssq E{hbuf, 4096, ssq};
        pg8::gemm_phase<pg8::EpiBf16Ssq, pg8::StaticOrder, GP_ALIGN, GP_SP2>(lds + RING_OFF, g, S, E); }
#else
        pg8::Gemm g{act, Wt_dn, M_PROMPT, 4096, D_FF, D_FF, D_FF}; pg8::StaticOrder S; S.init(M_PROMPT, 4096, G, (int)blockIdx.x);
        pg8::EpiBf16Ssq E{hbuf, 4096, ssq};
        pg8::gemm_phase<pg8::EpiBf16Ssq, pg8::StaticOrder, GP_ALIGN, GP_SP2>(lds + RING_OFF, g, S, E);
#ifdef REP_G4MAIN
        pg8::gemm_phase<pg8::EpiBf16Ssq, pg8::StaticOrder, GP_ALIGN, GP_SP2>(lds + RING_OFF, g, S, E);
#endif
        pg8::EpiF32Part Et{(float*)(ws + WS_PART4), 4096};
        pg8::Gemm ga{act, Wt_dn, MPAD, 4096, 768, D_FF, D_FF}; pg8::TailOrder Sa{16 * 6, G, (int)blockIdx.x - 160, 0, 768, 0};
        pg8::gemm_phase<pg8::EpiF32Part, pg8::TailOrder, GP_ALIGN, GP_SP2>(lds + RING_OFF, ga, Sa, Et);
        pg8::Gemm gb{act, Wt_dn, MPAD, 4096, 640, D_FF, D_FF}; pg8::TailOrder Sb{16 * 10, G, (int)blockIdx.x < 160 ? (int)blockIdx.x : -1, 4608, 640, 6};
        pg8::gemm_phase<pg8::EpiF32Part, pg8::TailOrder, GP_ALIGN, GP_SP2>(lds + RING_OFF, gb, Sb, Et);
#ifdef REP_G4TAIL
        pg8::gemm_phase<pg8::EpiF32Part, pg8::TailOrder, GP_ALIGN, GP_SP2>(lds + RING_OFF, ga, Sa, Et);
        pg8::gemm_phase<pg8::EpiF32Part, pg8::TailOrder, GP_ALIGN, GP_SP2>(lds + RING_OFF, gb, Sb, Et);
#endif
#endif
    }
    SEAM(8);
    if (IN(9)) _Pragma("unroll") for (int _r = 0; _r < 1 + ((REP_MASK >> 9) & 1); ++_r) {
        for (int m = gw; m < M_REAL; m += NGW) {
            GAS f32x4* orow = (GAS f32x4*)(args.out + O_Y + (size_t)m * 4096) + lane; const GAS v2u* fr = (const GAS v2u*)(hbuf + (size_t)m * 4096) + lane; const GAS f32x4* gr = (const GAS f32x4*)args.in[26] + lane;
            f32x4 f[16]; float s = 0.f;
#ifdef OLD_TAILS
            const bool smp = false;
#else
            const bool smp = m >= M_PROMPT;
#endif
            if (smp) { const GAS f32x4* fs = (const GAS f32x4*)(ws + WS_PART4) + (size_t)(m - M_PROMPT) * 1024 + lane;
#pragma unroll
                for (int j = 0; j < 16; ++j) { f32x4 t[16];
#pragma unroll
                    for (int sp = 0; sp < 16; ++sp) t[sp] = fs[(size_t)sp * 128 * 1024 + 64 * j];
                    const f32x4 a = ((t[0] + t[1]) + (t[2] + t[3])) + ((t[4] + t[5]) + (t[6] + t[7])) + (((t[8] + t[9]) + (t[10] + t[11])) + ((t[12] + t[13]) + (t[14] + t[15])));
                    f[j] = a; s += (a.x * a.x + a.y * a.y) + (a.z * a.z + a.w * a.w); }
            } else {
                v2u fv[16];
#pragma unroll
                for (int j = 0; j < 16; ++j) fv[j] = fr[64 * j];
                s = ssq[(size_t)m * 64 + lane];
#pragma unroll
                for (int j = 0; j < 16; ++j) { f[j].x = __builtin_bit_cast(float, fv[j].x << 16); f[j].y = __builtin_bit_cast(float, fv[j].x & 0xffff0000u); f[j].z = __builtin_bit_cast(float, fv[j].y << 16); f[j].w = __builtin_bit_cast(float, fv[j].y & 0xffff0000u); }
            }
            s = wave_sum(s);
            const float rstd = 1.0f / sqrtf(s * (1.f / 4096.f) + NORM_EPS);
#pragma unroll
            for (int hh = 0; hh < 2; ++hh) { f32x4 xv[8], gv[8];
#pragma unroll
                for (int j = 0; j < 8; ++j) { xv[j] = orow[64 * (8 * hh + j)]; gv[j] = gr[64 * (8 * hh + j)]; }
#pragma unroll
                for (int j = 0; j < 8; ++j) orow[64 * (8 * hh + j)] = xv[j] + f[8 * hh + j] * rstd * gv[j]; }
        }
    }
#undef IN
#undef SEAM
}

extern "C" void kernel_launch(void* const* d_in, const int* in_sizes, int n_in, void* d_out, int out_size, void* d_ws, size_t ws_size, hipStream_t stream) {
    static int grid = 0;
    if (grid == 0) {
        if (n_in != 30 || out_size != (int)O_END || ws_size < WS_END) { fprintf(stderr, "kernel_launch: unexpected shapes (n_in %d out %d ws %zu)\n", n_in, out_size, ws_size); grid = -1; return; }
        int dev = 0, cus = 0, per_cu = 0;
        if (hipGetDevice(&dev) != hipSuccess || hipDeviceGetAttribute(&cus, hipDeviceAttributeMultiprocessorCount, dev) != hipSuccess) { grid = -1; return; }
        if (hipFuncSetAttribute((const void*)hymba_fwd, hipFuncAttributeMaxDynamicSharedMemorySize, LDS_BYTES) != hipSuccess) { grid = -1; return; }
        if (hipOccupancyMaxActiveBlocksPerMultiprocessor(&per_cu, (const void*)hymba_fwd, NWAVES * 64, LDS_BYTES) != hipSuccess || per_cu < 1) { fprintf(stderr, "kernel_launch: occupancy query says %d\n", per_cu); }
        (void)hipGetLastError();
        grid = cus;
    }
    if (grid < 0) return;
    if (hipMemsetAsync((char*)d_ws + WS_CTL, 0, CTL_ZERO_BYTES, stream) != hipSuccess) return;
    Args a{};
    for (int i = 0; i < 30; ++i) a.in[i] = (const float*)d_in[i];
    a.out = (float*)d_out; a.ws = (unsigned char*)d_ws;
    if (MK_N_LAUNCHES == 1) { a.ph_lo = 0; a.ph_hi = NPH; hipLaunchKernelGGL(hymba_fwd, dim3(grid), dim3(NWAVES * 64), LDS_BYTES, stream, a); }
    else for (int p = 0; p < NPH; ++p) { a.ph_lo = p; a.ph_hi = p + 1; hipLaunchKernelGGL(hymba_fwd, dim3(grid), dim3(NWAVES * 64), LDS_BYTES, stream, a); }
}
```

```cpp
#include <hip/hip_runtime.h>
#include <cstdio>
#include <cstdint>

namespace pg8 {
#define PG8_LAS __attribute__((address_space(3)))
typedef unsigned short bf16_t;
typedef short bf16x8 __attribute__((ext_vector_type(8)));
typedef float f32x4 __attribute__((ext_vector_type(4)));
typedef unsigned u32x4 __attribute__((ext_vector_type(4)));
constexpr int BM = 256, BK = 64, HALF = 128, HTB = HALF * BK * 2  , STAGE_BYTES = 8 * HTB, NXCD = 8, WGM = 8;

__host__ __device__ __forceinline__ int lds_byte(int r, int c) { const int st = (r >> 4) * 2 + (c >> 5), rr = r & 15, cc = c & 31, ob = rr * 64 + cc * 2; return st * 1024 + (ob ^ (((ob >> 9) & 1) << 5)); }
__host__ __device__ __forceinline__ void stage_rc(int b, int& R, int& C) { const int st = b / 1024, sb = b % 1024, swz = sb ^ (((sb >> 9) & 1) << 5); R = (st >> 1) * 16 + swz / 64; C = (st & 1) * 32 + (swz % 64) / 2; }
__host__ __device__ __forceinline__ int perm32(int rho) { const int n = rho >> 4, i = rho & 15; return 8 * (i >> 2) + 4 * n + (i & 3); }

struct Unit { int pm, pn, ko, pi; };
struct Gemm { const bf16_t* A; const bf16_t* Bt; int M, N, K, lda, ldb; };

struct StaticOrder {
    int nM, nN, nwg, G, c;
    __host__ __device__ void init(int M, int N, int G_, int c_) { nM = M / BM; nN = N / BM; nwg = nM * nN; G = G_; c = c_; }
    __host__ __device__ bool next(int i, Unit& u) const {
        const long L = (long)i * G + c; if (L >= nwg) return false;
        int wgid = (int)L; { const int q = nwg / NXCD, r = nwg % NXCD, xcd = wgid % NXCD, off = wgid / NXCD; wgid = (xcd < r ? xcd * (q + 1) : r * (q + 1) + (xcd - r) * q) + off; }
        const int nig = WGM * nN, gid = wgid / nig, fm = gid * WGM, gsz = (nM - fm) < WGM ? (nM - fm) : WGM;
        u.pm = fm + ((wgid % nig) % gsz); u.pn = (wgid % nig) / gsz; u.ko = 0; u.pi = 0; return true;
    }
    __device__ __forceinline__ void a_ready(const Unit&) const {}
    __device__ __forceinline__ void done(const Unit&) const {}
};
__device__ __forceinline__ unsigned cvt_pk_bf16(float lo, float hi) { unsigned r; asm volatile("v_cvt_pk_bf16_f32 %0, %1, %2" : "=v"(r) : "v"(lo), "v"(hi)); return r; }

struct EpiBf16Plain {
    static constexpr bool PERM = true, AFTER_DRAIN = false;
    bf16_t* O; int ldc;
    __device__ __forceinline__ void operator()(const f32x4 (&acc)[2][2][4][2], const Unit& u, int wr, int wc, int fr, int fq) const {
        const int row0 = u.pm * BM + wr * 64 + fr, col0 = u.pn * BM + wc * 32 + 8 * fq;
#pragma unroll
        for (int ai = 0; ai < 2; ++ai)
#pragma unroll
            for (int m = 0; m < 4; ++m) { bf16_t* rowp = O + (size_t)(row0 + ai * HALF + m * 16) * ldc + col0;
#pragma unroll
                for (int bj = 0; bj < 2; ++bj) { const f32x4 v0 = acc[ai][bj][m][0], v1 = acc[ai][bj][m][1];
                    u32x4 w; w.x = cvt_pk_bf16(v0[0], v0[1]); w.y = cvt_pk_bf16(v0[2], v0[3]); w.z = cvt_pk_bf16(v1[0], v1[1]); w.w = cvt_pk_bf16(v1[2], v1[3]);
                    *(u32x4*)(rowp + bj * HALF) = w; } }
    }
};
__device__ __forceinline__ float silu_f(float x) { return x * __builtin_amdgcn_rcpf(1.0f + __expf(-x)); }
struct EpiSwiGLU {
    static constexpr bool PERM = true, AFTER_DRAIN = false;
    bf16_t* O; int ldc;
    __device__ __forceinline__ void operator()(const f32x4 (&acc)[2][2][4][2], const Unit& u, int wr, int wc, int fr, int fq) const {
        const int row0 = u.pm * BM + wr * 64 + fr, col0 = u.pn * HALF + wc * 32 + 8 * fq;
#pragma unroll
        for (int ai = 0; ai < 2; ++ai)
#pragma unroll
            for (int m = 0; m < 4; ++m) { bf16_t* rowp = O + (size_t)(row0 + ai * HALF + m * 16) * ldc + col0;
                const f32x4 g0 = acc[ai][0][m][0], g1 = acc[ai][0][m][1], u0 = acc[ai][1][m][0], u1 = acc[ai][1][m][1];
                u32x4 w; w.x = cvt_pk_bf16(silu_f(g0[0]) * u0[0], silu_f(g0[1]) * u0[1]); w.y = cvt_pk_bf16(silu_f(g0[2]) * u0[2], silu_f(g0[3]) * u0[3]);
                w.z = cvt_pk_bf16(silu_f(g1[0]) * u1[0], silu_f(g1[1]) * u1[1]); w.w = cvt_pk_bf16(silu_f(g1[2]) * u1[2], silu_f(g1[3]) * u1[3]);
                *(u32x4*)rowp = w; }
    }
};
struct EpiF32Ssq {
    static constexpr bool PERM = false, AFTER_DRAIN = false;
    float* C; int ldc; float* ssq; int mreal;
    __device__ __forceinline__ void operator()(const f32x4 (&acc)[2][2][4][2], const Unit& u, int wr, int wc, int fr, int fq) const {
        const int row0 = u.pm * BM + wr * 64 + fr, col0 = u.pn * BM + wc * 32 + 4 * fq;
#pragma unroll
        for (int ai = 0; ai < 2; ++ai)
#pragma unroll
            for (int m = 0; m < 4; ++m) { const int row = row0 + ai * HALF + m * 16; float s = 0.f;
#pragma unroll
                for (int bj = 0; bj < 2; ++bj)
#pragma unroll
                    for (int n = 0; n < 2; ++n) { const f32x4 v = acc[ai][bj][m][n]; s += (v[0] * v[0] + v[1] * v[1]) + (v[2] * v[2] + v[3] * v[3]);
                        if (row < mreal) *(f32x4*)(C + (size_t)row * ldc + col0 + bj * HALF + n * 16) = v; }
                s += __shfl_xor(s, 16); s += __shfl_xor(s, 32);
                if (fq == 0) ssq[(size_t)row * 64 + u.pn * 4 + wc] = s; }
    }
};
struct EpiBf16Ssq {
    static constexpr bool PERM = true, AFTER_DRAIN = false;
    bf16_t* O; int ldc; float* ssq;
    __device__ __forceinline__ void operator()(const f32x4 (&acc)[2][2][4][2], const Unit& u, int wr, int wc, int fr, int fq) const {
        const int row0 = u.pm * BM + wr * 64 + fr, col0 = u.pn * BM + wc * 32 + 8 * fq;
#pragma unroll
        for (int ai = 0; ai < 2; ++ai)
#pragma unroll
            for (int m = 0; m < 4; ++m) { const int row = row0 + ai * HALF + m * 16; bf16_t* rowp = O + (size_t)row * ldc + col0; float s = 0.f;
#pragma unroll
                for (int bj = 0; bj < 2; ++bj) { const f32x4 v0 = acc[ai][bj][m][0], v1 = acc[ai][bj][m][1];
                    s += (v0[0] * v0[0] + v0[1] * v0[1]) + (v0[2] * v0[2] + v0[3] * v0[3]) + (v1[0] * v1[0] + v1[1] * v1[1]) + (v1[2] * v1[2] + v1[3] * v1[3]);
                    u32x4 w; w.x = cvt_pk_bf16(v0[0], v0[1]); w.y = cvt_pk_bf16(v0[2], v0[3]); w.z = cvt_pk_bf16(v1[0], v1[1]); w.w = cvt_pk_bf16(v1[2], v1[3]);
                    *(u32x4*)(rowp + bj * HALF) = w; }
                s += __shfl_xor(s, 16); s += __shfl_xor(s, 32);
                if (fq == 0) ssq[(size_t)row * 64 + u.pn * 4 + wc] = s; }
    }
};
struct EpiF32Part {
    static constexpr bool PERM = false, AFTER_DRAIN = false;
    float* P; int ldc;
    __device__ __forceinline__ void operator()(const f32x4 (&acc)[2][2][4][2], const Unit& u, int wr, int wc, int fr, int fq) const {
        const int rowl = wr * 64 + fr, col0 = u.pn * BM + wc * 32 + 4 * fq; float* base = P + (size_t)u.pi * 128 * ldc;
#pragma unroll
        for (int m = 0; m < 4; ++m)
#pragma unroll
            for (int bj = 0; bj < 2; ++bj)
#pragma unroll
                for (int n = 0; n < 2; ++n) *(f32x4*)(base + (size_t)(rowl + m * 16) * ldc + col0 + bj * HALF + n * 16) = acc[0][bj][m][n];
    }
};
struct TailOrder {
    int nsub, G, c, kbase, klen, pbase;
    __device__ bool next(int i, Unit& u) const { const int idx = i * G + c; if (c < 0 || idx >= nsub) return false; const int sp = idx >> 4; u.pm = 64; u.pn = idx & 15; u.ko = kbase + sp * klen; u.pi = pbase + sp; return true; }
    __device__ __forceinline__ void a_ready(const Unit&) const {}
    __device__ __forceinline__ void done(const Unit&) const {}
};
struct SubsetOrder {
    int nN, nunits, nw, c;
    __device__ bool next(int i, Unit& u) const { const int idx = i * nw + c; if (c < 0 || idx >= nunits) return false; u.pm = idx / nN; u.pn = idx - u.pm * nN; u.ko = 0; u.pi = 0; return true; }
    __device__ __forceinline__ void a_ready(const Unit&) const {}
    __device__ __forceinline__ void done(const Unit&) const {}
};
template <class Epi, class Sched, bool ALIGN_EPI = false, bool SP2 = false>
__device__ __forceinline__ void gemm_phase(PG8_LAS unsigned char* lds, const Gemm g, const Sched& S, const Epi& E) {
    const int tid = threadIdx.x, wid = __builtin_amdgcn_readfirstlane(tid >> 6), lane = tid & 63, wr = wid >> 2, wc = wid & 3, fr = lane & 15, fq = lane >> 4;
    const int K = g.K, nt = K / BK;
    unsigned voffA[2], voffB[2];
#pragma unroll
    for (int i = 0; i < 2; ++i) { int R, C; stage_rc(tid * 16 + i * 8192, R, C); const int Rb = Epi::PERM ? ((R & ~31) + perm32(R & 31)) : R;
        voffA[i] = (unsigned)(R * g.lda + C) * 2u; voffB[i] = (unsigned)(Rb * g.ldb + C) * 2u; }
    const size_t kstep = (size_t)(BK * 2);
    const size_t hstepA = (size_t)HALF * g.lda * 2, hstepB = (size_t)HALF * g.ldb * 2;
    const size_t tstepA = 2 * hstepA, tstepB = 2 * hstepB;
    const unsigned ldsw = (unsigned)wid * 1024u;
    const int aoff = lds_byte(wr * 64 + fr, fq * 8), boff = lds_byte(wc * 32 + fr, fq * 8);
#define PG8_SA(b, h) (((b) * 2 + (h)) * HTB)
#define PG8_SB(b, h) ((4 + (b) * 2 + (h)) * HTB)
#define PG8_STAGE(bufoff, gbase, voff) do { _Pragma("unroll") for (int _i = 0; _i < 2; ++_i) \
        __builtin_amdgcn_global_load_lds((const unsigned*)((const char*)(gbase) + (voff)[_i]), (PG8_LAS unsigned*)(lds + (bufoff) + ldsw + _i * 8192), 16, 0, 0); } while (0)
#define PG8_LDA(dst, b, h) do { _Pragma("unroll") for (int m = 0; m < 4; ++m) _Pragma("unroll") for (int k = 0; k < 2; ++k) dst[m][k] = *(const PG8_LAS bf16x8*)(lds + PG8_SA(b, h) + aoff + m * 2048 + k * 1024); } while (0)
#define PG8_LDB(dst, b, h) do { _Pragma("unroll") for (int n = 0; n < 2; ++n) _Pragma("unroll") for (int k = 0; k < 2; ++k) dst[n][k] = *(const PG8_LAS bf16x8*)(lds + PG8_SB(b, h) + boff + n * 2048 + k * 1024); } while (0)
#define PG8_MMA(ai, bj, At, Bt) do { __builtin_amdgcn_s_setprio(1); _Pragma("unroll") for (int m = 0; m < 4; ++m) _Pragma("unroll") for (int n = 0; n < 2; ++n) _Pragma("unroll") for (int k = 0; k < 2; ++k) \
        acc[ai][bj][m][n] = __builtin_amdgcn_mfma_f32_16x16x32_bf16(Bt[n][k], At[m][k], acc[ai][bj][m][n], 0, 0, 0); __builtin_amdgcn_s_setprio(0); } while (0)
#define PG8_WAIT_V(n) asm volatile("s_waitcnt vmcnt(" #n ")" ::: "memory")
#define PG8_WAIT_L(n) asm volatile("s_waitcnt lgkmcnt(" #n ")" ::: "memory")
#define PG8_BAR __builtin_amdgcn_s_barrier()
#define PG8_SCHED __builtin_amdgcn_sched_barrier(0)
    Unit cur, nxt; int ui = 0;
    if (!S.next(0, cur)) return;
    f32x4 acc[2][2][4][2];
#pragma unroll
    for (int a = 0; a < 2; ++a)
#pragma unroll
        for (int b = 0; b < 2; ++b)
#pragma unroll
            for (int m = 0; m < 4; ++m)
#pragma unroll
                for (int n = 0; n < 2; ++n) acc[a][b][m][n] = (f32x4){0.f, 0.f, 0.f, 0.f};
    bf16x8 At[4][2], B0[2][2], B1[2][2];
    const char* cA = (const char*)g.A + (size_t)cur.pm * tstepA + (size_t)cur.ko * 2; const char* cB = (const char*)g.Bt + (size_t)cur.pn * tstepB + (size_t)cur.ko * 2;
    S.a_ready(cur);
    if constexpr (SP2) {
        PG8_STAGE(PG8_SB(0, 0), cB, voffB); PG8_STAGE(PG8_SB(0, 1), cB + hstepB, voffB); PG8_STAGE(PG8_SA(0, 0), cA, voffA); PG8_STAGE(PG8_SA(0, 1), cA + hstepA, voffA);
        if (wr == 1) PG8_BAR;
        PG8_WAIT_V(2); PG8_BAR;
        PG8_STAGE(PG8_SB(1, 0), cB + kstep, voffB); PG8_STAGE(PG8_SA(1, 0), cA + kstep, voffA); PG8_STAGE(PG8_SB(1, 1), cB + hstepB + kstep, voffB);
        PG8_WAIT_V(6); PG8_BAR;
    } else {
        PG8_STAGE(PG8_SB(0, 0), cB, voffB); PG8_STAGE(PG8_SA(0, 0), cA, voffA); PG8_STAGE(PG8_SB(0, 1), cB + hstepB, voffB); PG8_STAGE(PG8_SA(0, 1), cA + hstepA, voffA);
        if (wr == 1) PG8_BAR;
        PG8_WAIT_V(4); PG8_BAR;
        PG8_STAGE(PG8_SB(1, 0), cB + kstep, voffB); PG8_STAGE(PG8_SA(1, 0), cA + kstep, voffA); PG8_STAGE(PG8_SB(1, 1), cB + hstepB + kstep, voffB);
        PG8_WAIT_V(6); PG8_BAR;
    }
    for (;;) {
        const bool has_next = S.next(ui + 1, nxt);
        const char* nA = has_next ? (const char*)g.A + (size_t)nxt.pm * tstepA + (size_t)nxt.ko * 2 : cA; const char* nB = has_next ? (const char*)g.Bt + (size_t)nxt.pn * tstepB + (size_t)nxt.ko * 2 : cB;
        for (int t = 0; t < nt; t += 2) {
            const bool last = (t == nt - 2);
            const char* a1 = cA + (size_t)(t + 1) * kstep;
            const char* a2 = last ? nA : cA + (size_t)(t + 2) * kstep; const char* b2 = last ? nB : cB + (size_t)(t + 2) * kstep;
            const char* a3 = a2 + kstep; const char* b3 = b2 + kstep;
            if (last && has_next) S.a_ready(nxt);
            if constexpr (SP2) {
            PG8_LDB(B0, 0, 0); PG8_LDB(B1, 0, 1); PG8_SCHED; PG8_LDA(At, 0, 0); PG8_STAGE(PG8_SA(1, 1), a1 + hstepA, voffA);
            PG8_WAIT_V(8); PG8_WAIT_L(0); PG8_BAR; PG8_MMA(0, 0, At, B0); PG8_MMA(0, 1, At, B1); PG8_BAR; PG8_SCHED;
            PG8_LDA(At, 0, 1); PG8_STAGE(PG8_SB(0, 0), b2, voffB); PG8_STAGE(PG8_SB(0, 1), b2 + hstepB, voffB); PG8_STAGE(PG8_SA(0, 0), a2, voffA);
            PG8_WAIT_V(8); PG8_WAIT_L(0); PG8_BAR; PG8_MMA(1, 0, At, B0); PG8_MMA(1, 1, At, B1); PG8_BAR; PG8_SCHED;
            PG8_LDB(B0, 1, 0); PG8_LDB(B1, 1, 1); PG8_SCHED; PG8_LDA(At, 1, 0); PG8_STAGE(PG8_SA(0, 1), a2 + hstepA, voffA);
            PG8_WAIT_V(8); PG8_WAIT_L(0); PG8_BAR; PG8_MMA(0, 0, At, B0); PG8_MMA(0, 1, At, B1); PG8_BAR; PG8_SCHED;
            PG8_LDA(At, 1, 1); PG8_STAGE(PG8_SB(1, 0), b3, voffB); PG8_STAGE(PG8_SB(1, 1), b3 + hstepB, voffB); PG8_STAGE(PG8_SA(1, 0), a3, voffA);
            PG8_WAIT_V(8); PG8_WAIT_L(0); PG8_BAR; PG8_MMA(1, 0, At, B0); PG8_MMA(1, 1, At, B1); PG8_BAR; PG8_SCHED;
            } else {
            PG8_LDB(B0, 0, 0); PG8_SCHED; PG8_LDA(At, 0, 0); PG8_STAGE(PG8_SA(1, 1), a1 + hstepA, voffA);
            PG8_WAIT_L(8); PG8_BAR; PG8_WAIT_L(0); PG8_MMA(0, 0, At, B0); PG8_BAR; PG8_SCHED;
            PG8_LDB(B1, 0, 1); PG8_STAGE(PG8_SB(0, 0), b2, voffB);
            PG8_BAR; PG8_WAIT_L(0); PG8_MMA(0, 1, At, B1); PG8_BAR;
            PG8_LDA(At, 0, 1); PG8_STAGE(PG8_SA(0, 0), a2, voffA);
            PG8_BAR; PG8_WAIT_L(0); PG8_MMA(1, 0, At, B0); PG8_BAR; PG8_SCHED;
            PG8_STAGE(PG8_SB(0, 1), b2 + hstepB, voffB);
            PG8_WAIT_V(6); PG8_BAR; PG8_MMA(1, 1, At, B1); PG8_BAR;
            PG8_LDB(B0, 1, 0); PG8_SCHED; PG8_LDA(At, 1, 0); PG8_STAGE(PG8_SA(0, 1), a2 + hstepA, voffA);
            PG8_WAIT_L(8); PG8_BAR; PG8_WAIT_L(0); PG8_MMA(0, 0, At, B0); PG8_BAR; PG8_SCHED;
            PG8_LDB(B1, 1, 1); PG8_STAGE(PG8_SB(1, 0), b3, voffB);
            PG8_BAR; PG8_WAIT_L(0); PG8_MMA(0, 1, At, B1); PG8_BAR;
            PG8_LDA(At, 1, 1); PG8_STAGE(PG8_SA(1, 0), a3, voffA);
            PG8_BAR; PG8_WAIT_L(0); PG8_MMA(1, 0, At, B0); PG8_BAR; PG8_SCHED;
            PG8_STAGE(PG8_SB(1, 1), b3 + hstepB, voffB);
            PG8_WAIT_V(6); PG8_BAR; PG8_MMA(1, 1, At, B1); PG8_BAR;
            }
        }
        if constexpr (ALIGN_EPI) { if (wr == 0) PG8_BAR; }
        if constexpr (!Epi::AFTER_DRAIN) { E(acc, cur, wr, wc, fr, fq); S.done(cur); }
        if (!has_next) break;
#pragma unroll
        for (int a = 0; a < 2; ++a)
#pragma unroll
            for (int b = 0; b < 2; ++b)
#pragma unroll
                for (int m = 0; m < 4; ++m)
#pragma unroll
                    for (int n = 0; n < 2; ++n) acc[a][b][m][n] = (f32x4){0.f, 0.f, 0.f, 0.f};
        cur = nxt; cA = nA; cB = nB; ++ui;
        if constexpr (ALIGN_EPI) { if (wr == 1) PG8_BAR; }
    }
    PG8_WAIT_V(0);
    if constexpr (!ALIGN_EPI) { if (wr == 0) PG8_BAR; }
    PG8_BAR;
    if constexpr (Epi::AFTER_DRAIN) { E.fused(acc, cur, wr, wc, fr, fq, lds, wid, lane); S.done(cur); }
#undef PG8_SA
#undef PG8_SB
#undef PG8_STAGE
#undef PG8_LDA
#undef PG8_LDB
#undef PG8_MMA
#undef PG8_WAIT_V
#undef PG8_WAIT_L
#undef PG8_BAR
#undef PG8_SCHED
}
}

constexpr int NWAVES = 8;
constexpr int D_MODEL = 4096, SEQ = 8192, DEC_SEQ = 16;
constexpr int M_PROMPT = 16384, M_REAL = 16512, MPAD = 16640;
constexpr int IN_W = 14816, IN_WP = 14848, D_FF = 11008;
constexpr int PC_Q = 0, PC_K = 2048, PC_V = 4096, PC_Z = 6144, PC_B = 8192, PC_A = 8208, PC_RW = 8224;
constexpr int RW_R = 0, RW_K = 2048, RW_V = 4096, RW_XW = 6144, RW_XA = 6240, RW_XG = 6336, RW_SHIFT_W = 6592;
constexpr float NORM_EPS = 1e-6f, RW_GN_EPS = 64e-5f;
constexpr size_t O_Y = 0, O_SDN_P = 67633152, O_CONV_P = 68157440, O_SRW_P = 68194304, O_SHIFT_P = 68456448,
                 O_SDN_S = 68469632, O_CONV_S = 70566784, O_SRW_S = 70714240, O_SHIFT_S = 71762816, O_END = 71815552;
constexpr size_t MiB = 1u << 20;
constexpr size_t WS_CTL = 0, CTL_ZERO_BYTES = 1 * MiB;
constexpr size_t WS_SSQ = 2 * MiB;
constexpr size_t WS_W2T = 6553600, WS_A2T = WS_W2T + 2048 * 96 * 2, WS_G2T = 7 * MiB;
constexpr size_t WS_WOUT = 8 * MiB;
constexpr size_t WS_HBUF = 40 * MiB;
constexpr size_t WS_PROJ = 170 * MiB;
constexpr size_t WS_WIN = 642 * MiB;
constexpr size_t WS_WGU = 758 * MiB;
constexpr size_t WS_WDN = 930 * MiB;
constexpr size_t WS_END = 1016 * MiB;
constexpr size_t WS_X1B = 520 * MiB;
constexpr size_t WS_PART2 = 710 * MiB, WS_PART4 = 678 * MiB;
constexpr size_t WS_SXG = 742 * MiB;
constexpr size_t WS_DNQK = 642 * MiB, WS_DNGL = 674 * MiB, WS_RWSB = 675 * MiB, WS_RWOO = 678 * MiB, WS_RWPQ = 758 * MiB, WS_RWRP = 886 * MiB;
static_assert(WS_SSQ + (size_t)MPAD * 64 * 4 <= WS_WOUT && WS_HBUF + (size_t)MPAD * 4096 * 2 <= WS_PROJ && WS_PROJ + (size_t)MPAD * IN_WP * 2 <= WS_WIN &&
              WS_WIN + (size_t)IN_WP * 4096 * 2 <= WS_WGU && WS_WGU + (size_t)2 * D_FF * 4096 * 2 <= WS_WDN && WS_WDN + (size_t)4096 * D_FF * 2 <= WS_END, "d_ws map");
constexpr int CW_BAR = 4096;
constexpr int RING_OFF = 0, RING_BYTES = 131072;
constexpr int LDSCTL_OFF = RING_BYTES, MISC_OFF = LDSCTL_OFF + 320;
constexpr int LDS_BYTES = 147456;

#define GAS __attribute__((address_space(1)))
#define LAS __attribute__((address_space(3)))
typedef unsigned short bf16;
typedef unsigned v4u __attribute__((ext_vector_type(4)));
typedef unsigned v2u __attribute__((ext_vector_type(2)));
typedef float f32x4 __attribute__((ext_vector_type(4)));
typedef GAS unsigned gu32;
#define RLX_AGENT __ATOMIC_RELAXED, __HIP_MEMORY_SCOPE_AGENT
#define LDS_WAIT() asm volatile("s_waitcnt lgkmcnt(0)" ::: "memory")
__device__ __forceinline__ unsigned f2bf(float f) { unsigned u = __builtin_bit_cast(unsigned, f); return (u + 0x7fffu + ((u >> 16) & 1u)) >> 16; }
__device__ __forceinline__ unsigned pk2(float lo, float hi) { return f2bf(lo) | (f2bf(hi) << 16); }
__device__ __forceinline__ float bf2f(bf16 b) { return __builtin_bit_cast(float, (unsigned)b << 16); }
__device__ __forceinline__ float bflo(unsigned u) { return __builtin_bit_cast(float, u << 16); }
__device__ __forceinline__ float bfhi(unsigned u) { return __builtin_bit_cast(float, u & 0xffff0000u); }
#ifdef OLD_WAVE_SUM
__device__ __forceinline__ float wave_sum(float v) {
#pragma unroll
    for (int o = 1; o < 64; o <<= 1) v += __shfl_xor(v, o);
    return v;
}
#else
#define WS_DPP(x, ctrl, rmask) __builtin_bit_cast(float, __builtin_amdgcn_update_dpp(0, __builtin_bit_cast(int, (x)), (ctrl), (rmask), 0xf, true))
__device__ __forceinline__ float wave_sum(float v) {
    v += WS_DPP(v, 0xB1, 0xf); v += WS_DPP(v, 0x4E, 0xf); v += WS_DPP(v, 0x141, 0xf); v += WS_DPP(v, 0x140, 0xf);
    v += WS_DPP(v, 0x142, 0xa); v += WS_DPP(v, 0x143, 0xc);
    return __builtin_bit_cast(float, __builtin_amdgcn_readlane(__builtin_bit_cast(int, v), 63));
}
#endif
#ifdef OLD_MATH
__device__ __forceinline__ float sigmoid_f(float x) { return 1.0f / (1.0f + __expf(-x)); }
__device__ __forceinline__ float softplus_f(float x) { return x > 20.f ? x : log1pf(__expf(x)); }
#else
__device__ __forceinline__ float sigmoid_f(float x) { return __builtin_amdgcn_rcpf(1.0f + __expf(-x)); }
__device__ __forceinline__ float softplus_f(float x) { return x > 20.f ? x : __logf(1.0f + __expf(x)); }
#endif
__device__ __forceinline__ void wave_sum8(float (&v)[8]) {
#pragma unroll
    for (int o = 1; o < 64; o <<= 1) {
#pragma unroll
        for (int i = 0; i < 8; ++i) v[i] += __shfl_xor(v[i], o); }
}

#define XB_TMO      128
#define XB_XCNT(j)  (256  + 64 * (j))
#define XB_XSUB(j)  (1280 + 64 * (j))
#define XB_XGEN(j)  (2304 + 64 * (j))
#define XB_TOP      3328
#define XB_TOPGEN   3392
#define XCD_BAR_WORDS 3456
#define XB_SPIN_CAP (1u << 18)

__device__ __forceinline__ unsigned xb_ld(unsigned* p)              { return __hip_atomic_load(p, __ATOMIC_RELAXED, __HIP_MEMORY_SCOPE_AGENT); }
__device__ __forceinline__ unsigned xb_add(unsigned* p, unsigned v) { return __hip_atomic_fetch_add(p, v, __ATOMIC_RELAXED, __HIP_MEMORY_SCOPE_AGENT); }
__device__ __forceinline__ unsigned xb_xcc_id() { return (unsigned)__builtin_amdgcn_s_getreg((3 << 11) | 20) & 0xFu; }
#define XB_SPIN(cond, bar) do { unsigned _sp = 0; while (cond) { __builtin_amdgcn_s_sleep(1); \
    if ((++_sp & 255u) == 0u) { if (xb_ld(&(bar)[XB_TMO])) break; if (_sp > XB_SPIN_CAP) { atomicAdd(&(bar)[XB_TMO], 1u); break; } } } } while (0)

struct XcdBarrier {
    unsigned* bar; unsigned x;
    volatile LAS unsigned* st;
};

__device__ __forceinline__ XcdBarrier xcd_barrier_post(unsigned* bar, volatile LAS unsigned* st) {
    XcdBarrier b; b.bar = bar; b.x = xb_xcc_id(); b.st = st;
    if (threadIdx.x == 0) (void)xb_add(&bar[XB_XCNT(b.x)], 1u);
    return b;
}
__device__ __forceinline__ void xcd_barrier_complete(unsigned* bar, unsigned x, unsigned& nloc, unsigned& nx) {
    const unsigned G = gridDim.x * gridDim.y * gridDim.z;
    unsigned sum, cnt, mine, sp = 0u;
    for (;;) {
        sum = 0u; cnt = 0u; mine = 0u;
#pragma unroll
        for (unsigned j = 0; j < 16; ++j) { const unsigned c = xb_ld(&bar[XB_XCNT(j)]); sum += c; cnt += (c > 0u) ? 1u : 0u; mine = (j == x) ? c : mine; }
        if (sum == G) break;
        __builtin_amdgcn_s_sleep(1);
        if ((++sp & 255u) == 0u) { if (xb_ld(&bar[XB_TMO])) break; if (sp > XB_SPIN_CAP) { atomicAdd(&bar[XB_TMO], 1u); break; } }
    }
    nloc = mine > 0u ? mine : 1u; nx = cnt > 0u ? cnt : 1u;
}

__device__ __forceinline__ void xcd_barrier(const XcdBarrier& b) {
    asm volatile("s_waitcnt vmcnt(0)" ::: "memory");
    __syncthreads();
    if (threadIdx.x == 0) {
        unsigned* bar = b.bar;
        __builtin_amdgcn_s_waitcnt(0);
        unsigned nloc = b.st[0], nx = b.st[1];
        if (nloc == 0u) { xcd_barrier_complete(bar, b.x, nloc, nx); b.st[0] = nloc; b.st[1] = nx; }
        const unsigned old = xb_add(&bar[XB_XSUB(b.x)], 1u);
        const unsigned gen = old / nloc;
        if (old + 1u == (gen + 1u) * nloc) {
            __builtin_amdgcn_fence(__ATOMIC_RELEASE, "agent");
            asm volatile("s_waitcnt vmcnt(0)" ::: "memory");
            const unsigned og = xb_add(&bar[XB_TOP], 1u);
            const unsigned tg = og / nx;
            if (og + 1u == (tg + 1u) * nx) xb_add(&bar[XB_TOPGEN], 1u);
            else XB_SPIN(xb_ld(&bar[XB_TOPGEN]) == tg, bar);
            __builtin_amdgcn_fence(__ATOMIC_ACQUIRE, "agent");
            xb_add(&bar[XB_XGEN(b.x)], 1u);
            asm volatile("s_waitcnt vmcnt(0)" ::: "memory");
        } else {
            XB_SPIN(xb_ld(&bar[XB_XGEN(b.x)]) == gen, bar);
            __builtin_amdgcn_fence(__ATOMIC_ACQUIRE, "agent");
            asm volatile("s_waitcnt vmcnt(0)" ::: "memory");
        }
    }
    __syncthreads();
}

struct Frame {
    LAS unsigned char* lds;
    volatile LAS unsigned* MISC;
    gu32* ctl;
    int tid, lane, wave, G;
    const float* const* in;
};
struct Args { const float* in[30]; float* out; unsigned char* ws; int ph_lo, ph_hi; };

template <class RowMap>
__device__ __forceinline__ void p0_transpose_item(const float* W, int K, int N, bf16* WT, LAS float* scr, int item, int lane, RowMap rm) {
    const int nblk = N / 32, kb = item / nblk, nb = item % nblk, k0 = 64 * kb, n0 = 32 * nb;
#pragma unroll 8
    for (int i = 0; i < 32; ++i) { const int kk = 2 * i + (lane >> 5); scr[kk * 33 + (lane & 31)] = W[(size_t)(k0 + kk) * N + n0 + (lane & 31)]; }
    LDS_WAIT(); asm volatile("" ::: "memory");
    const int c = lane & 7;
#pragma unroll
    for (int j = 0; j < 4; ++j) { const int n = (lane >> 3) + 8 * j; const LAS float* s = scr + (8 * c) * 33 + n;
        v4u o; o.x = pk2(s[0 * 33], s[1 * 33]); o.y = pk2(s[2 * 33], s[3 * 33]); o.z = pk2(s[4 * 33], s[5 * 33]); o.w = pk2(s[6 * 33], s[7 * 33]);
        *(GAS v4u*)(WT + (size_t)rm(n0 + n) * K + k0 + 8 * c) = o; }
    LDS_WAIT(); asm volatile("" ::: "memory");
}
struct RmId { __device__ __forceinline__ int operator()(int n) const { return n; } };
struct RmGU { int up; __device__ __forceinline__ int operator()(int n) const { return (n >> 7) * 256 + up * 128 + (n & 127); } };

__device__ __forceinline__ void rms_row_to_bf16(const f32x4 (&v)[16], const float* g, bf16* orow, int lane) {
    float s = 0.f;
#pragma unroll
    for (int j = 0; j < 16; ++j) s += (v[j].x * v[j].x + v[j].y * v[j].y) + (v[j].z * v[j].z + v[j].w * v[j].w);
    const float rstd = 1.0f / sqrtf(wave_sum(s) * (1.f / 4096.f) + NORM_EPS);
    const GAS f32x4* gr = (const GAS f32x4*)g + lane; GAS v2u* o8 = (GAS v2u*)orow + lane;
#pragma unroll
    for (int hh = 0; hh < 2; ++hh) { f32x4 gv[8];
#pragma unroll
        for (int j = 0; j < 8; ++j) gv[j] = gr[64 * (8 * hh + j)];
#pragma unroll
        for (int j = 0; j < 8; ++j) { const f32x4 x = v[8 * hh + j]; v2u o; o.x = pk2(x.x * rstd * gv[j].x, x.y * rstd * gv[j].y); o.y = pk2(x.z * rstd * gv[j].z, x.w * rstd * gv[j].w); o8[64 * (8 * hh + j)] = o; } }
}

struct MixPtrs {
    const bf16* proj; bf16* mix;
    const float *state_dn, *cache_conv, *state_rw, *cache_shift;
    const float *conv_w, *a_log, *dt_bias, *dn_norm_w;
    const float *mu, *w0, *w2, *a0, *a2, *g2, *k_k, *k_a, *r_k, *ln_w, *ln_b;
    float* out;
};
__device__ __forceinline__ void dn_seq_item(const MixPtrs& P, LAS unsigned char* lds, int seq, int h, int tid, int lane, int wave) {
    const bool prm = seq < 2;
    const int T = prm ? SEQ : DEC_SEQ, sb = prm ? seq : seq - 2;
    const int m0 = prm ? seq * SEQ : M_PROMPT + sb * DEC_SEQ;
    const float* S0 = prm ? nullptr : P.state_dn + ((size_t)sb * 16 + h) * 16384;
    const float* cbuf = prm ? nullptr : P.cache_conv + (size_t)sb * 3 * 6144;
    float* Sout = P.out + (prm ? O_SDN_P : O_SDN_S) + ((size_t)sb * 16 + h) * 16384;
    float* cout = P.out + (prm ? O_CONV_P : O_CONV_S) + (size_t)sb * 3 * 6144;
    LAS float* qs = (LAS float*)lds; LAS float* ks = qs + 2048; LAS float* vs = ks + 2048; LAS float* zs = vs + 2048; LAS float* os = zs + 2048; LAS float* bet = os + 2048; LAS float* gg = bet + 16;
    float S[32];
    const int e = wave * 16 + (lane >> 2), dq = lane & 3;
#pragma unroll
    for (int j = 0; j < 32; ++j) S[j] = (S0 != nullptr) ? S0[(32 * dq + j) * 128 + e] : 0.f;
    const float Ah = -__expf(P.a_log[h]), dtb = P.dt_bias[h];
    for (int tb = 0; tb < T; tb += 16) {
        for (int i = tid; i < 16 * 384; i += 512) { const int t = i / 384, cc = i - t * 384, sec = cc >> 7, d = cc & 127, col = sec * 2048 + h * 128 + d;
            float acc = 0.f;
#pragma unroll
            for (int j = 0; j < 4; ++j) { const int tt = tb + t - 3 + j; float xv;
                if (tt >= 0) xv = bf2f(P.proj[(size_t)(m0 + tt) * IN_WP + col]); else xv = cbuf ? cbuf[(3 + tt) * 6144 + col] : 0.f;
                acc += xv * P.conv_w[j * 6144 + col]; }
            const float y = acc * sigmoid_f(acc);
            (sec == 0 ? qs : (sec == 1 ? ks : vs))[t * 128 + d] = y; }
        for (int i = tid; i < 16 * 128; i += 512) { const int t = i >> 7, d = i & 127; zs[i] = bf2f(P.proj[(size_t)(m0 + tb + t) * IN_WP + PC_Z + h * 128 + d]); }
        if (tid < 16) { const size_t r = (size_t)(m0 + tb + tid) * IN_WP; const float b = bf2f(P.proj[r + PC_B + h]), a = bf2f(P.proj[r + PC_A + h]);
            bet[tid] = sigmoid_f(b); gg[tid] = Ah * softplus_f(a + dtb); }
        __syncthreads();
#pragma unroll
        for (int r = 0; r < 2; ++r) { const int t = 2 * wave + r;
            const float q0 = qs[t * 128 + lane], q1 = qs[t * 128 + 64 + lane], k0 = ks[t * 128 + lane], k1 = ks[t * 128 + 64 + lane];
            const float sq = wave_sum(q0 * q0 + q1 * q1), sk = wave_sum(k0 * k0 + k1 * k1);
            const float cq = 0.08838834764831845f / sqrtf(sq + 1e-6f), ck = 1.0f / sqrtf(sk + 1e-6f);
            qs[t * 128 + lane] = q0 * cq; qs[t * 128 + 64 + lane] = q1 * cq; ks[t * 128 + lane] = k0 * ck; ks[t * 128 + 64 + lane] = k1 * ck; }
        __syncthreads();
        {
#pragma unroll 1
            for (int t = 0; t < 16; ++t) {
                const float eg = __expf(gg[t]), bt = bet[t];
                float kS = 0.f;
#pragma unroll
                for (int d4 = 0; d4 < 8; ++d4) { const f32x4 kv = *(const LAS f32x4*)(ks + t * 128 + 32 * dq + 4 * d4);
                    kS += kv.x * S[4 * d4] + kv.y * S[4 * d4 + 1] + kv.z * S[4 * d4 + 2] + kv.w * S[4 * d4 + 3]; }
                kS += __shfl_xor(kS, 1); kS += __shfl_xor(kS, 2);
                const float w = bt * (vs[t * 128 + e] - eg * kS);
                float o = 0.f;
#pragma unroll
                for (int d4 = 0; d4 < 8; ++d4) { const f32x4 kv = *(const LAS f32x4*)(ks + t * 128 + 32 * dq + 4 * d4); const f32x4 qv = *(const LAS f32x4*)(qs + t * 128 + 32 * dq + 4 * d4);
                    S[4 * d4] = eg * S[4 * d4] + kv.x * w; S[4 * d4 + 1] = eg * S[4 * d4 + 1] + kv.y * w; S[4 * d4 + 2] = eg * S[4 * d4 + 2] + kv.z * w; S[4 * d4 + 3] = eg * S[4 * d4 + 3] + kv.w * w;
                    o += qv.x * S[4 * d4] + qv.y * S[4 * d4 + 1] + qv.z * S[4 * d4 + 2] + qv.w * S[4 * d4 + 3]; }
                o += __shfl_xor(o, 1); o += __shfl_xor(o, 2);
                if (dq == 0) os[t * 128 + e] = o;
            }
        }
        __syncthreads();
#pragma unroll
        for (int r = 0; r < 2; ++r) { const int t = 2 * wave + r;
            const float o0 = os[t * 128 + lane], o1 = os[t * 128 + 64 + lane];
            const float rs = 1.0f / sqrtf(wave_sum(o0 * o0 + o1 * o1) * (1.f / 128.f) + NORM_EPS);
            const float z0 = zs[t * 128 + lane], z1 = zs[t * 128 + 64 + lane];
            bf16* mp = P.mix + (size_t)(m0 + tb + t) * 4096 + h * 128;
            mp[lane] = (bf16)f2bf(o0 * rs * P.dn_norm_w[lane] * (z0 * sigmoid_f(z0))); mp[64 + lane] = (bf16)f2bf(o1 * rs * P.dn_norm_w[64 + lane] * (z1 * sigmoid_f(z1))); }
        __syncthreads();
    }
    { int so = 32 * dq * 128 + e;
#ifndef NO_LAUNDER
    asm volatile("" : "+v"(so));
#endif

#pragma unroll
    for (int j = 0; j < 32; ++j) Sout[so + j * 128] = S[j]; }
    for (int i = tid; i < 3 * 384; i += 512) { const int r = i / 384, cc = i - r * 384, col = (cc >> 7) * 2048 + h * 128 + (cc & 127);
        cout[r * 6144 + col] = bf2f(P.proj[(size_t)(m0 + T - 3 + r) * IN_WP + col]); }
}
__device__ __forceinline__ void rw_seq_item(const MixPtrs& P, const bf16* w2T_, const bf16* a2T_, const bf16* g2T_, LAS unsigned char* lds, int seq, int h, int tid, int lane, int wave) {
    const bool prm = seq < 2;
    const int T = prm ? SEQ : DEC_SEQ, sb = prm ? seq : seq - 2;
    const int m0 = prm ? seq * SEQ : M_PROMPT + sb * DEC_SEQ;
    const float* S0 = prm ? nullptr : P.state_rw + ((size_t)sb * 32 + h) * 4096;
    const float* sbuf = prm ? nullptr : P.cache_shift + (size_t)sb * RW_SHIFT_W;
    float* Sout = P.out + (prm ? O_SRW_P : O_SRW_S) + ((size_t)sb * 32 + h) * 4096;
    float* shout = P.out + (prm ? O_SHIFT_P : O_SHIFT_S) + (size_t)sb * RW_SHIFT_W;
    LAS float* rs = (LAS float*)lds; LAS float* kr = rs + 1024; LAS float* vs = kr + 1024; LAS float* xw = vs + 1024; LAS float* xa = xw + 1536; LAS float* xg = xa + 1536;
    LAS float* wd = xg + 4096; LAS float* kp = wd + 1024; LAS float* av = kp + 1024; LAS float* bv = av + 1024; LAS float* gt = bv + 1024; LAS float* ys = gt + 1024; LAS float* sbn = ys + 1024;
    float S[16];
    const int vr = (wave & 3) * 16 + (lane >> 2), kq = lane & 3;
#pragma unroll
    for (int k4 = 0; k4 < 4; ++k4) { f32x4 v = (f32x4){0.f, 0.f, 0.f, 0.f}; if (S0 != nullptr) v = *(const f32x4*)(S0 + vr * 64 + 16 * kq + 4 * k4);
        S[4 * k4] = v.x; S[4 * k4 + 1] = v.y; S[4 * k4 + 2] = v.z; S[4 * k4 + 3] = v.w; }
    const int hc = h * 64 + lane;
    const float w0c = P.w0[hc], a0c = P.a0[hc], kkc = P.k_k[hc], kac = P.k_a[hc], rkc = P.r_k[hc], lnw = P.ln_w[hc], lnb = P.ln_b[hc];
    for (int tb = 0; tb < T; tb += 16) {
        for (int i = tid; i < 16 * 640; i += 512) { const int t = i / 640, cc = i - t * 640; int col; LAS float* dst; int kind = 0;
            if (cc < 64) { col = RW_R + h * 64 + cc; dst = rs + t * 64 + cc; }
            else if (cc < 128) { col = RW_K + h * 64 + (cc - 64); dst = kr + t * 64 + (cc - 64); }
            else if (cc < 192) { col = RW_V + h * 64 + (cc - 128); dst = vs + t * 64 + (cc - 128); }
            else if (cc < 288) { col = RW_XW + (cc - 192); dst = xw + t * 96 + (cc - 192); kind = 1; }
            else if (cc < 384) { col = RW_XA + (cc - 288); dst = xa + t * 96 + (cc - 288); }
            else { col = RW_XG + (cc - 384); dst = xg + t * 256 + (cc - 384); kind = 2; }
            const int tt = tb + t; const float u = bf2f(P.proj[(size_t)(m0 + tt) * IN_WP + PC_RW + col]);
            const float up = tt > 0 ? bf2f(P.proj[(size_t)(m0 + tt - 1) * IN_WP + PC_RW + col]) : (sbuf ? sbuf[col] : 0.f);
            float v = u + P.mu[col] * (up - u);
            if (kind == 1) v = tanhf(v); else if (kind == 2) v = sigmoid_f(v);
            *dst = v; }
        __syncthreads();
        {
            float wl0 = 0.f, wl1 = 0.f, al0 = 0.f, al1 = 0.f, gl0 = 0.f, gl1 = 0.f; const int t0 = wave, t1 = wave + 8;
#ifdef OLD_SEQ
#pragma unroll 4
            for (int j = 0; j < 96; ++j) { const float w2v = P.w2[j * 2048 + hc], a2v = P.a2[j * 2048 + hc];
                wl0 += xw[t0 * 96 + j] * w2v; wl1 += xw[t1 * 96 + j] * w2v; al0 += xa[t0 * 96 + j] * a2v; al1 += xa[t1 * 96 + j] * a2v; }
#pragma unroll 4
            for (int j = 0; j < 256; ++j) { const float g2v = P.g2[j * 2048 + hc]; gl0 += xg[t0 * 256 + j] * g2v; gl1 += xg[t1 * 256 + j] * g2v; }
#else
#define SEQ_DOT8(W8, X0, X1, A0, A1) do { const v4u _w = (W8); const LAS float* _x0 = (X0); const LAS float* _x1 = (X1); \
                const f32x4 _p0 = *(const LAS f32x4*)_x0, _p1 = *(const LAS f32x4*)(_x0 + 4), _q0 = *(const LAS f32x4*)_x1, _q1 = *(const LAS f32x4*)(_x1 + 4); \
                const float _w0 = bflo(_w.x), _w1 = bfhi(_w.x), _w2 = bflo(_w.y), _w3 = bfhi(_w.y), _w4 = bflo(_w.z), _w5 = bfhi(_w.z), _w6 = bflo(_w.w), _w7 = bfhi(_w.w); \
                A0 += (_p0.x * _w0 + _p0.y * _w1) + (_p0.z * _w2 + _p0.w * _w3) + (_p1.x * _w4 + _p1.y * _w5) + (_p1.z * _w6 + _p1.w * _w7); \
                A1 += (_q0.x * _w0 + _q0.y * _w1) + (_q0.z * _w2 + _q0.w * _w3) + (_q1.x * _w4 + _q1.y * _w5) + (_q1.z * _w6 + _q1.w * _w7); } while (0)
#pragma unroll 1
            for (int cch = 0; cch < 3; ++cch) { v4u wv[4], av2[4];
#pragma unroll
                for (int p = 0; p < 4; ++p) { wv[p] = *(const GAS v4u*)(w2T_ + (size_t)hc * 96 + 32 * cch + 8 * p); av2[p] = *(const GAS v4u*)(a2T_ + (size_t)hc * 96 + 32 * cch + 8 * p); }
#pragma unroll
                for (int p = 0; p < 4; ++p) { const int j = 32 * cch + 8 * p; SEQ_DOT8(wv[p], xw + t0 * 96 + j, xw + t1 * 96 + j, wl0, wl1); SEQ_DOT8(av2[p], xa + t0 * 96 + j, xa + t1 * 96 + j, al0, al1); } }
#pragma unroll 1
            for (int cch = 0; cch < 8; ++cch) { v4u gv[4];
#pragma unroll
                for (int p = 0; p < 4; ++p) gv[p] = *(const GAS v4u*)(g2T_ + (size_t)hc * 256 + 32 * cch + 8 * p);
#pragma unroll
                for (int p = 0; p < 4; ++p) { const int j = 32 * cch + 8 * p; SEQ_DOT8(gv[p], xg + t0 * 256 + j, xg + t1 * 256 + j, gl0, gl1); } }
#undef SEQ_DOT8
#endif
#pragma unroll
            for (int r = 0; r < 2; ++r) { const int t = r ? t1 : t0; const float wl = r ? wl1 : wl0, al = r ? al1 : al0, gl = r ? gl1 : gl0;
                const float wlog = -softplus_f(-(w0c + wl)) - 0.5f; const float wdec = __expf(-__expf(wlog));
                const float a = sigmoid_f(a0c + al);
                const float krv = kr[t * 64 + lane], kkr = krv * kkc; const float kk = kkr / sqrtf(wave_sum(kkr * kkr) + 1e-6f);
                const float kpv = krv * (1.0f + (a - 1.0f) * kac);
                const float sbv = wave_sum(rs[t * 64 + lane] * kpv * rkc);
                wd[t * 64 + lane] = wdec; kp[t * 64 + lane] = kpv; av[t * 64 + lane] = -kk; bv[t * 64 + lane] = kk * a; gt[t * 64 + lane] = gl; if (lane == 0) sbn[t] = sbv; }
        }
        __syncthreads();
        if (wave < 4) {
#pragma unroll 1
            for (int t = 0; t < 16; ++t) {
                float sa = 0.f;
#pragma unroll
                for (int k4 = 0; k4 < 4; ++k4) { const f32x4 a4 = *(const LAS f32x4*)(av + t * 64 + 16 * kq + 4 * k4); sa += a4.x * S[4 * k4] + a4.y * S[4 * k4 + 1] + a4.z * S[4 * k4 + 2] + a4.w * S[4 * k4 + 3]; }
                sa += __shfl_xor(sa, 1); sa += __shfl_xor(sa, 2);
                const float vv = vs[t * 64 + vr]; float y = 0.f;
#pragma unroll
                for (int k4 = 0; k4 < 4; ++k4) { const int o4 = t * 64 + 16 * kq + 4 * k4;
                    const f32x4 w4 = *(const LAS f32x4*)(wd + o4), b4 = *(const LAS f32x4*)(bv + o4), k4v = *(const LAS f32x4*)(kp + o4), r4 = *(const LAS f32x4*)(rs + o4);
                    S[4 * k4] = S[4 * k4] * w4.x + sa * b4.x + vv * k4v.x; S[4 * k4 + 1] = S[4 * k4 + 1] * w4.y + sa * b4.y + vv * k4v.y;
                    S[4 * k4 + 2] = S[4 * k4 + 2] * w4.z + sa * b4.z + vv * k4v.z; S[4 * k4 + 3] = S[4 * k4 + 3] * w4.w + sa * b4.w + vv * k4v.w;
                    y += r4.x * S[4 * k4] + r4.y * S[4 * k4 + 1] + r4.z * S[4 * k4 + 2] + r4.w * S[4 * k4 + 3]; }
                y += __shfl_xor(y, 1); y += __shfl_xor(y, 2);
                if (kq == 0) ys[t * 64 + vr] = y;
            }
        }
        __syncthreads();
#pragma unroll
        for (int r = 0; r < 2; ++r) { const int t = wave + 8 * r; const float y = ys[t * 64 + lane];
            const float mean = wave_sum(y) * (1.f / 64.f); const float dy = y - mean; const float var = wave_sum(dy * dy) * (1.f / 64.f);
            const float yn = dy / sqrtf(var + RW_GN_EPS) * lnw + lnb;
            P.mix[(size_t)(m0 + tb + t) * 4096 + 2048 + hc] = (bf16)f2bf((yn + sbn[t] * vs[t * 64 + lane]) * gt[t * 64 + lane]); }
        __syncthreads();
    }
    if (wave < 4) { int so = vr * 64 + 16 * kq;
#ifndef NO_LAUNDER
    asm volatile("" : "+v"(so));
#endif
#pragma unroll
        for (int k4 = 0; k4 < 4; ++k4) *(f32x4*)(Sout + so + 4 * k4) = (f32x4){S[4 * k4], S[4 * k4 + 1], S[4 * k4 + 2], S[4 * k4 + 3]};
    }
    for (int i = tid; i < 206; i += 512) { const int col = h * 206 + i; shout[col] = bf2f(P.proj[(size_t)(m0 + T - 1) * IN_WP + PC_RW + col]); }
}

typedef short bf16x8 __attribute__((ext_vector_type(8)));
typedef float f32x16 __attribute__((ext_vector_type(16)));
typedef __bf16 bf16x2_t __attribute__((ext_vector_type(2)));
typedef float f32x2_t __attribute__((ext_vector_type(2)));
__device__ __forceinline__ unsigned cvt2(float lo, float hi) { f32x2_t v = {lo, hi}; return __builtin_bit_cast(unsigned, __builtin_convertvector(v, bf16x2_t)); }
#define MFMA16(a, b, c) __builtin_amdgcn_mfma_f32_16x16x32_bf16((a), (b), (c), 0, 0, 0)
#define MFMA32(a, b, c) __builtin_amdgcn_mfma_f32_32x32x16_bf16((a), (b), (c), 0, 0, 0)
__device__ __forceinline__ bf16x8 pack_step(const f32x16& x, int s) {
    v4u p; p.x = cvt2(x[8 * s], x[8 * s + 1]); p.y = cvt2(x[8 * s + 2], x[8 * s + 3]); p.z = cvt2(x[8 * s + 4], x[8 * s + 5]); p.w = cvt2(x[8 * s + 6], x[8 * s + 7]);
    return __builtin_bit_cast(bf16x8, p);
}
struct DnRec { unsigned char* rec; unsigned char* qk; float* gl; };
constexpr int DP_QN = 0, DP_KN = 17408, DP_VBT = 34816, DP_KBGT = 53248, DP_LM = 71680, DP_TM = 88320, DP_TB = 104960, DP_DINV = 114176, DP_YB = 118528, DP_SC = 122688;

__device__ __forceinline__ void tri_inv64(const LAS float* Lm, LAS float* Tm, LAS bf16* Tb, LAS float* Dinv, LAS float* Yb, int tid, int lane, int wave) {
    if (tid < 64) { const int bi = tid >> 4, j = tid & 15; float x[16];
#pragma unroll
        for (int r = 0; r < 16; ++r) { float a = (r == j) ? 1.f : 0.f;
#pragma unroll
            for (int k = 0; k < r; ++k) a -= Lm[(16 * bi + r) * 65 + 16 * bi + k] * x[k];
            x[r] = a; }
#pragma unroll
        for (int r = 0; r < 16; ++r) Dinv[(bi * 16 + r) * 17 + j] = x[r]; }
    __syncthreads();
    for (int o = tid; o < 4096; o += 512) { const int r = o >> 6, c = o & 63, bi = r >> 4;
        if (c >= 16 * bi) { const float a = (c < 16 * bi + 16) ? Dinv[r * 17 + c - 16 * bi] : 0.f; Tm[r * 65 + c] = a; Tb[r * 72 + c] = (bf16)(cvt2(a, 0.f) & 0xffffu); } }
    __syncthreads();
    const int l15 = lane & 15, q = lane >> 4;
#pragma unroll 1
    for (int i = 1; i < 4; ++i) {
        if (wave < i) { f32x4 acc = (f32x4){0.f, 0.f, 0.f, 0.f};
            for (int ks = 0; ks < 4 * i; ++ks) acc = __builtin_amdgcn_mfma_f32_16x16x4f32(Lm[(16 * i + l15) * 65 + 4 * ks + q], Tm[(4 * ks + q) * 65 + 16 * wave + l15], acc, 0, 0, 0);
#pragma unroll
            for (int reg = 0; reg < 4; ++reg) Yb[(4 * q + reg) * 65 + 16 * wave + l15] = -acc[reg]; }
        __syncthreads();
        if (wave < i) { f32x4 acc = (f32x4){0.f, 0.f, 0.f, 0.f};
#pragma unroll
            for (int ks = 0; ks < 4; ++ks) acc = __builtin_amdgcn_mfma_f32_16x16x4f32(Dinv[(16 * i + l15) * 17 + 4 * ks + q], Yb[(4 * ks + q) * 65 + 16 * wave + l15], acc, 0, 0, 0);
#pragma unroll
            for (int reg = 0; reg < 4; ++reg) { Tm[(16 * i + 4 * q + reg) * 65 + 16 * wave + l15] = acc[reg]; Tb[(16 * i + 4 * q + reg) * 72 + 16 * wave + l15] = (bf16)(cvt2(acc[reg], 0.f) & 0xffffu); } }
        __syncthreads();
    }
}

__device__ __forceinline__ void dn_prep_item(const MixPtrs& P, const DnRec& R, LAS unsigned char* lds, int b, int c, int h, int tid, int lane, int wave) {
    const int m0 = b * SEQ + 64 * c; const int item = (b * 128 + c) * 16 + h;
    LAS bf16* Qn = (LAS bf16*)(lds + DP_QN); LAS bf16* Kn = (LAS bf16*)(lds + DP_KN); LAS bf16* VbT = (LAS bf16*)(lds + DP_VBT); LAS bf16* KbgT = (LAS bf16*)(lds + DP_KBGT);
    LAS float* Lm = (LAS float*)(lds + DP_LM); LAS float* Tm = (LAS float*)(lds + DP_TM); LAS bf16* Tb = (LAS bf16*)(lds + DP_TB); LAS float* Dinv = (LAS float*)(lds + DP_DINV); LAS float* Yb = (LAS float*)(lds + DP_YB);
    LAS float* sc = (LAS float*)(lds + DP_SC); LAS float* beta = sc; LAS float* gc = sc + 64; LAS float* egc = sc + 128; LAS float* ekd = sc + 192;
    unsigned char* rec = R.rec + (size_t)item * 65536; unsigned char* qkr = R.qk + (size_t)item * 8192;
    if (wave == 0) { const int t = lane; const size_t r = (size_t)(m0 + t) * IN_WP; const float bb = bf2f(P.proj[r + PC_B + h]), aa = bf2f(P.proj[r + PC_A + h]);
        const float Ah = -__expf(P.a_log[h]), dtb = P.dt_bias[h];
        float x = Ah * softplus_f(aa + dtb);
#pragma unroll
        for (int o = 1; o < 64; o <<= 1) { const float v = __shfl_up(x, o); if (lane >= o) x += v; }
        const float gl = __shfl(x, 63);
        beta[t] = sigmoid_f(bb); gc[t] = x; egc[t] = __expf(x); ekd[t] = __expf(gl - x); if (lane == 0) R.gl[item] = __expf(gl); }
    __syncthreads();
#ifdef PD1
    for (int _pr = 0; _pr < 2; ++_pr)
#endif
#pragma unroll
    for (int r = 0; r < 6; ++r) {
        const int sec = r >> 1; const int idx = (tid + 512 * r) & 1023; const int t = idx >> 4, g8 = idx & 15; const int col = sec * 2048 + h * 128 + 8 * g8;
        float acc[8];
#pragma unroll
        for (int i = 0; i < 8; ++i) acc[i] = 0.f;
#pragma unroll
        for (int j = 0; j < 4; ++j) { const int tt = 64 * c + t - 3 + j;
            v4u xv = (v4u){0u, 0u, 0u, 0u}; if (tt >= 0) xv = *(const GAS v4u*)(P.proj + (size_t)(b * SEQ + tt) * IN_WP + col);
            const f32x4 w0 = *(const GAS f32x4*)(P.conv_w + j * 6144 + col), w1 = *(const GAS f32x4*)(P.conv_w + j * 6144 + col + 4);
            acc[0] += bflo(xv.x) * w0.x; acc[1] += bfhi(xv.x) * w0.y; acc[2] += bflo(xv.y) * w0.z; acc[3] += bfhi(xv.y) * w0.w;
            acc[4] += bflo(xv.z) * w1.x; acc[5] += bfhi(xv.z) * w1.y; acc[6] += bflo(xv.w) * w1.z; acc[7] += bfhi(xv.w) * w1.w; }
        float y[8]; float ss = 0.f;
#pragma unroll
        for (int i = 0; i < 8; ++i) { y[i] = acc[i] * sigmoid_f(acc[i]); ss += y[i] * y[i]; }
        if (sec < 2) { ss += __shfl_xor(ss, 1); ss += __shfl_xor(ss, 2); ss += __shfl_xor(ss, 4); ss += __shfl_xor(ss, 8);
            const float scl = (sec == 0 ? 0.08838834764831845f : 1.0f) / sqrtf(ss + 1e-6f);
#pragma unroll
            for (int i = 0; i < 8; ++i) y[i] *= scl; }
        if (sec == 0) { v4u o; o.x = cvt2(y[0], y[1]); o.y = cvt2(y[2], y[3]); o.z = cvt2(y[4], y[5]); o.w = cvt2(y[6], y[7]); *(LAS v4u*)(Qn + t * 136 + 8 * g8) = o; }
        else if (sec == 1) { v4u o; o.x = cvt2(y[0], y[1]); o.y = cvt2(y[2], y[3]); o.z = cvt2(y[4], y[5]); o.w = cvt2(y[6], y[7]); *(LAS v4u*)(Kn + t * 136 + 8 * g8) = o;
            const float f = beta[t] * egc[t];
#pragma unroll
            for (int i = 0; i < 8; ++i) KbgT[(8 * g8 + i) * 72 + 8 * (((t >> 3) ^ (g8 >> 1)) & 7) + (t & 7)] = (bf16)(cvt2(y[i] * f, 0.f) & 0xffffu); }
        else { const float f = beta[t];
#pragma unroll
            for (int i = 0; i < 8; ++i) VbT[(8 * g8 + i) * 72 + 8 * (((t >> 3) ^ (g8 >> 1)) & 7) + (t & 7)] = (bf16)(cvt2(y[i] * f, 0.f) & 0xffffu); }
    }
    __syncthreads();
#ifdef PD2
    for (int _pr = 0; _pr < 2; ++_pr) {
#else
    {
#endif
    {   const int tt = wave & 3, sp = wave >> 2, l15 = lane & 15, q = lane >> 4;
#pragma unroll
        for (int si = 0; si < 2; ++si) { const int st = 2 * sp + si;
            f32x4 aL = (f32x4){0.f, 0.f, 0.f, 0.f}, aQ = (f32x4){0.f, 0.f, 0.f, 0.f};
#pragma unroll
            for (int ks = 0; ks < 4; ++ks) {
                const bf16x8 fs = *(const LAS bf16x8*)(Kn + (16 * st + l15) * 136 + 32 * ks + 8 * q);
                const bf16x8 ft = *(const LAS bf16x8*)(Kn + (16 * tt + l15) * 136 + 32 * ks + 8 * q);
                const bf16x8 fq = *(const LAS bf16x8*)(Qn + (16 * tt + l15) * 136 + 32 * ks + 8 * q);
                aL = MFMA16(fs, ft, aL); aQ = MFMA16(fs, fq, aQ); }
            const int t = 16 * tt + l15; const float gct = gc[t], bt = beta[t]; float qv[4];
#pragma unroll
            for (int reg = 0; reg < 4; ++reg) { const int s = 16 * st + 4 * q + reg; const float dec = __expf(gct - gc[s]);
                Lm[t * 65 + s] = (t > s) ? bt * aL[reg] * dec : 0.f; qv[reg] = (t >= s) ? aQ[reg] * dec : 0.f; }
            v2u qkp; qkp.x = cvt2(qv[0], qv[1]); qkp.y = cvt2(qv[2], qv[3]);
            *(GAS v2u*)(qkr + ((((t >> 5) * 4 + st) * 64 + (t & 31) + 32 * (q & 1)) * 16 + 8 * (q >> 1))) = qkp;
        }
    }
#pragma unroll
    for (int r = 0; r < 2; ++r) { const int fl = tid + 512 * r; const int ln = fl & 63, ks = (fl >> 6) & 7, mt = fl >> 9;
        const int t = 32 * mt + (ln & 31), d0 = 16 * ks + 4 * (ln >> 5); const float f = egc[t];
        const v2u a = *(const LAS v2u*)(Qn + t * 136 + d0), bq = *(const LAS v2u*)(Qn + t * 136 + d0 + 8);
        v4u o; o.x = cvt2(bflo(a.x) * f, bfhi(a.x) * f); o.y = cvt2(bflo(a.y) * f, bfhi(a.y) * f); o.z = cvt2(bflo(bq.x) * f, bfhi(bq.x) * f); o.w = cvt2(bflo(bq.y) * f, bfhi(bq.y) * f);
        *(GAS v4u*)(rec + 16384 + fl * 16) = o; }
#pragma unroll
    for (int r = 0; r < 2; ++r) { const int fl = tid + 512 * r; const int ln = fl & 63, kt = (fl >> 6) & 3, mtd = fl >> 8;
        const int d = 32 * mtd + (ln & 31), t0 = 16 * kt + 4 * (ln >> 5); float v[8];
#pragma unroll
        for (int j = 0; j < 8; ++j) { const int t = t0 + 8 * (j >> 2) + (j & 3); v[j] = bf2f(Kn[t * 136 + d]) * ekd[t]; }
        v4u o; o.x = cvt2(v[0], v[1]); o.y = cvt2(v[2], v[3]); o.z = cvt2(v[4], v[5]); o.w = cvt2(v[6], v[7]);
        *(GAS v4u*)(rec + 32768 + fl * 16) = o; }
    __syncthreads();
    }
    tri_inv64(Lm, Tm, Tb, Dinv, Yb, tid, lane, wave);
#ifdef PD4
    for (int _pr = 0; _pr < 2; ++_pr)
#endif
    {   const int tt = wave & 3, hf = wave >> 2, l15 = lane & 15, q = lane >> 4;
        bf16x8 tf[2];
#pragma unroll
        for (int ks = 0; ks < 2; ++ks) tf[ks] = *(const LAS bf16x8*)(Tb + (16 * tt + l15) * 72 + 32 * ks + 8 * q);
#pragma unroll
        for (int n = 0; n < 4; ++n) { const int et = 4 * hf + n;
            f32x4 au = (f32x4){0.f, 0.f, 0.f, 0.f}, aw = (f32x4){0.f, 0.f, 0.f, 0.f};
#pragma unroll
            for (int ks = 0; ks < 2; ++ks) { const bf16x8 fv = *(const LAS bf16x8*)(VbT + (16 * et + l15) * 72 + 8 * ((4 * ks + q) ^ (et & 7))); const bf16x8 fk = *(const LAS bf16x8*)(KbgT + (16 * et + l15) * 72 + 8 * ((4 * ks + q) ^ (et & 7)));
                au = MFMA16(tf[ks], fv, au);
                aw = MFMA16(fk, tf[ks], aw); }
            v2u up; up.x = cvt2(au[0], au[1]); up.y = cvt2(au[2], au[3]);
            *(GAS v2u*)(rec + 49152 + ((16 * et + l15) * 64 + 16 * tt + 4 * q) * 2) = up;
            const int t = 16 * tt + l15; v2u wp; wp.x = cvt2(aw[0], aw[1]); wp.y = cvt2(aw[2], aw[3]);
            *(GAS v2u*)(rec + ((((t >> 5) * 8 + et) * 64 + (t & 31) + 32 * (q & 1)) * 16 + 8 * (q >> 1))) = wp; }
    }
    __syncthreads();
}

#define WG_BAR_LDS() do { asm volatile("s_waitcnt lgkmcnt(0)" ::: "memory"); __builtin_amdgcn_s_barrier(); asm volatile("" ::: "memory"); } while (0)
__device__ __forceinline__ void dn_scan(const MixPtrs& P, const DnRec& R, LAS unsigned char* lds, int b, int h, int tid, int lane, int wave) {
    constexpr int SB = 57344; LAS unsigned char* obuf = lds + 2 * SB;
    const int item0 = b * 128 * 16 + h;
    if (wave < 4) {
        const int e = 32 * wave + (lane & 31), hh = lane >> 5;
        f32x16 S[4];
#pragma unroll
        for (int dt = 0; dt < 4; ++dt)
#pragma unroll
            for (int i = 0; i < 16; ++i) S[dt][i] = 0.f;
        v2u uu[2][4];
#pragma unroll
        for (int mt = 0; mt < 2; ++mt)
#pragma unroll
            for (int g = 0; g < 4; ++g) uu[mt][g] = *(const GAS v2u*)(R.rec + (size_t)item0 * 65536 + 49152 + (e * 64 + 32 * mt + 8 * g + 4 * hh) * 2);
        float egl = R.gl[item0];
        WG_BAR_LDS();
#pragma unroll 1
        for (int c = 0; c < 128; ++c) {
            LAS unsigned char* buf = lds + (c & 1) * SB;
            f32x16 o0, o1;
            bf16x8 Sf[8];
#pragma unroll
            for (int dt = 0; dt < 4; ++dt) { Sf[2 * dt] = pack_step(S[dt], 0); Sf[2 * dt + 1] = pack_step(S[dt], 1); }
            f32x16 w0, w1;
#pragma unroll
            for (int i = 0; i < 16; ++i) { w0[i] = 0.f; w1[i] = 0.f; o0[i] = 0.f; o1[i] = 0.f; }
#pragma unroll
            for (int ks = 0; ks < 8; ++ks) { const bf16x8 a0 = *(const LAS bf16x8*)(buf + (ks * 64 + lane) * 16), a1 = *(const LAS bf16x8*)(buf + ((8 + ks) * 64 + lane) * 16);
                w0 = MFMA32(a0, Sf[ks], w0); w1 = MFMA32(a1, Sf[ks], w1); }
#pragma unroll
            for (int g = 0; g < 4; ++g) {
                w0[4 * g] = bflo(uu[0][g].x) - w0[4 * g]; w0[4 * g + 1] = bfhi(uu[0][g].x) - w0[4 * g + 1]; w0[4 * g + 2] = bflo(uu[0][g].y) - w0[4 * g + 2]; w0[4 * g + 3] = bfhi(uu[0][g].y) - w0[4 * g + 3];
                w1[4 * g] = bflo(uu[1][g].x) - w1[4 * g]; w1[4 * g + 1] = bfhi(uu[1][g].x) - w1[4 * g + 1]; w1[4 * g + 2] = bflo(uu[1][g].y) - w1[4 * g + 2]; w1[4 * g + 3] = bfhi(uu[1][g].y) - w1[4 * g + 3]; }
            const float eg_cur = egl;
            if (c + 1 < 128) {
                const unsigned char* recn = R.rec + (size_t)(item0 + 16 * (c + 1)) * 65536;
#pragma unroll
                for (int mt = 0; mt < 2; ++mt)
#pragma unroll
                    for (int g = 0; g < 4; ++g) uu[mt][g] = *(const GAS v2u*)(recn + 49152 + (e * 64 + 32 * mt + 8 * g + 4 * hh) * 2);
                egl = R.gl[item0 + 16 * (c + 1)];
            }
            bf16x8 Vf[4]; Vf[0] = pack_step(w0, 0); Vf[1] = pack_step(w0, 1); Vf[2] = pack_step(w1, 0); Vf[3] = pack_step(w1, 1);
#pragma unroll
            for (int ks = 0; ks < 8; ++ks) { const bf16x8 a0 = *(const LAS bf16x8*)(buf + 16384 + (ks * 64 + lane) * 16), a1 = *(const LAS bf16x8*)(buf + 16384 + ((8 + ks) * 64 + lane) * 16);
                o0 = MFMA32(a0, Sf[ks], o0); o1 = MFMA32(a1, Sf[ks], o1); }
#pragma unroll
            for (int kt = 0; kt < 4; ++kt) { const bf16x8 a0 = *(const LAS bf16x8*)(buf + 49152 + (kt * 64 + lane) * 16), a1 = *(const LAS bf16x8*)(buf + 49152 + ((4 + kt) * 64 + lane) * 16);
                o0 = MFMA32(a0, Vf[kt], o0); o1 = MFMA32(a1, Vf[kt], o1); }
#pragma unroll
            for (int dt = 0; dt < 4; ++dt) {
#pragma unroll
                for (int i = 0; i < 16; ++i) S[dt][i] *= eg_cur;
#pragma unroll
                for (int kt = 0; kt < 4; ++kt) { const bf16x8 a = *(const LAS bf16x8*)(buf + 32768 + ((dt * 4 + kt) * 64 + lane) * 16); S[dt] = MFMA32(a, Vf[kt], S[dt]); } }
            WG_BAR_LDS();
#pragma unroll
            for (int i = 0; i < 16; ++i) { const int row = (i & 3) + 8 * (i >> 2) + 4 * hh;
                ((LAS bf16*)obuf)[row * 128 + e] = (bf16)(cvt2(o0[i], 0.f) & 0xffffu); ((LAS bf16*)obuf)[(32 + row) * 128 + e] = (bf16)(cvt2(o1[i], 0.f) & 0xffffu); }
            WG_BAR_LDS();
        }
        float* Sout = P.out + O_SDN_P + ((size_t)b * 16 + h) * 16384;
#pragma unroll
        for (int dt = 0; dt < 4; ++dt)
#pragma unroll
            for (int i = 0; i < 16; ++i) Sout[(32 * dt + (i & 3) + 8 * (i >> 2) + 4 * hh) * 128 + e] = S[dt][i];
    } else {
        const int ht = tid - 256; const int pt = ht >> 2, pq = ht & 3;
        v4u st[14], zr[4];
#define DN_STAGE_ISSUE(itm) do { const unsigned char* _r = R.rec + (size_t)(itm) * 65536; const unsigned char* _q = R.qk + (size_t)(itm) * 8192; \
        _Pragma("unroll") for (int _k = 0; _k < 12; ++_k) st[_k] = *(const GAS v4u*)(_r + (ht + 256 * _k) * 16); \
        _Pragma("unroll") for (int _k = 0; _k < 2; ++_k) st[12 + _k] = *(const GAS v4u*)(_q + (ht + 256 * _k) * 16); } while (0)
#define DN_STAGE_WRITE(dstbuf) do { _Pragma("unroll") for (int _k = 0; _k < 14; ++_k) *(LAS v4u*)((dstbuf) + (ht + 256 * _k) * 16) = st[_k]; } while (0)
#define DN_Z_ISSUE(cc) do { const size_t _m = (size_t)(b * SEQ + 64 * (cc) + pt); _Pragma("unroll") for (int _k = 0; _k < 4; ++_k) zr[_k] = *(const GAS v4u*)(P.proj + _m * IN_WP + PC_Z + h * 128 + 32 * pq + 8 * _k); } while (0)
#define DN_POST(cc) do { const int _m = b * SEQ + 64 * (cc) + pt; v4u _o[4]; \
        _Pragma("unroll") for (int _k = 0; _k < 4; ++_k) _o[_k] = *(const LAS v4u*)(obuf + (pt * 128 + 32 * pq + 8 * _k) * 2); \
        float _ss = 0.f; _Pragma("unroll") for (int _k = 0; _k < 4; ++_k) { const float a0 = bflo(_o[_k].x), a1 = bfhi(_o[_k].x), a2 = bflo(_o[_k].y), a3 = bfhi(_o[_k].y), a4 = bflo(_o[_k].z), a5 = bfhi(_o[_k].z), a6 = bflo(_o[_k].w), a7 = bfhi(_o[_k].w); \
            _ss += (a0 * a0 + a1 * a1) + (a2 * a2 + a3 * a3) + (a4 * a4 + a5 * a5) + (a6 * a6 + a7 * a7); } \
        _ss += __shfl_xor(_ss, 1); _ss += __shfl_xor(_ss, 2); const float _rs = 1.0f / sqrtf(_ss * (1.f / 128.f) + NORM_EPS); \
        _Pragma("unroll") for (int _k = 0; _k < 4; ++_k) { const GAS f32x4* _nw = (const GAS f32x4*)(P.dn_norm_w + 32 * pq + 8 * _k); const f32x4 n0 = _nw[0], n1 = _nw[1]; \
            const float z0 = bflo(zr[_k].x), z1 = bfhi(zr[_k].x), z2 = bflo(zr[_k].y), z3 = bfhi(zr[_k].y), z4 = bflo(zr[_k].z), z5 = bfhi(zr[_k].z), z6 = bflo(zr[_k].w), z7 = bfhi(zr[_k].w); \
            v4u _w; _w.x = cvt2(bflo(_o[_k].x) * _rs * n0.x * (z0 * sigmoid_f(z0)), bfhi(_o[_k].x) * _rs * n0.y * (z1 * sigmoid_f(z1))); \
            _w.y = cvt2(bflo(_o[_k].y) * _rs * n0.z * (z2 * sigmoid_f(z2)), bfhi(_o[_k].y) * _rs * n0.w * (z3 * sigmoid_f(z3))); \
            _w.z = cvt2(bflo(_o[_k].z) * _rs * n1.x * (z4 * sigmoid_f(z4)), bfhi(_o[_k].z) * _rs * n1.y * (z5 * sigmoid_f(z5))); \
            _w.w = cvt2(bflo(_o[_k].w) * _rs * n1.z * (z6 * sigmoid_f(z6)), bfhi(_o[_k].w) * _rs * n1.w * (z7 * sigmoid_f(z7))); \
            *(GAS v4u*)(P.mix + (size_t)_m * 4096 + h * 128 + 32 * pq + 8 * _k) = _w; } } while (0)
        DN_STAGE_ISSUE(item0); DN_STAGE_WRITE(lds); DN_STAGE_ISSUE(item0 + 16);
        WG_BAR_LDS();
#pragma unroll 1
        for (int c = 0; c < 128; ++c) {
            if (c + 1 < 128) DN_STAGE_WRITE(lds + ((c + 1) & 1) * SB);
            if (c + 2 < 128) DN_STAGE_ISSUE(item0 + 16 * (c + 2));
            if (c > 0) DN_POST(c - 1);
            DN_Z_ISSUE(c);
            WG_BAR_LDS();
            WG_BAR_LDS();
        }
        DN_POST(127);
#undef DN_STAGE_ISSUE
#undef DN_STAGE_WRITE
#undef DN_Z_ISSUE
#undef DN_POST
    }
    {   float* cout = P.out + O_CONV_P + (size_t)b * 3 * 6144;
        for (int i = tid; i < 3 * 384; i += 512) { const int r = i / 384, cc = i - r * 384, col = (cc >> 7) * 2048 + h * 128 + (cc & 127);
            cout[r * 6144 + col] = bf2f(P.proj[(size_t)(b * SEQ + SEQ - 3 + r) * IN_WP + col]); } }
    __syncthreads();
}
struct RwRec { unsigned char* pq; unsigned char* rp; unsigned char* oo; float* sb; const bf16* w2T; const bf16* a2T; const bf16* g2T; };
constexpr int RSL = 9216;

struct RwRaw { unsigned ur[9], uk[9], uv[9]; v4u xu[3], xp[3]; };
__device__ __forceinline__ void rw_prep_issue(const MixPtrs& P, RwRaw& R, int b, int c, int h, int tid, int lane, int wave) {
    const int hc = h * 64 + lane;
#pragma unroll
    for (int i = 0; i < 9; ++i) { int tt = 64 * c + wave * 8 + i - 1; tt = tt < 0 ? 0 : tt;
        const size_t ro = (size_t)(b * SEQ + tt) * IN_WP + PC_RW + hc; R.ur[i] = P.proj[ro + RW_R]; R.uk[i] = P.proj[ro + RW_K]; R.uv[i] = P.proj[ro + RW_V]; }
#pragma unroll
    for (int r = 0; r < 3; ++r) { const int i = tid + 512 * r; const int which = i >= 768, ii = which ? i - 768 : i; const int t = ii / 12, g8 = ii - t * 12; int tp = 64 * c + t - 1; tp = tp < 0 ? 0 : tp;
        const int col = (which ? RW_XA : RW_XW) + 8 * g8;
        R.xu[r] = *(const GAS v4u*)(P.proj + (size_t)(b * SEQ + 64 * c + t) * IN_WP + PC_RW + col); R.xp[r] = *(const GAS v4u*)(P.proj + (size_t)(b * SEQ + tp) * IN_WP + PC_RW + col); }
}
__device__ __forceinline__ void rw_prep_item(const MixPtrs& P, const RwRec& W, LAS unsigned char* lds, int b, int c, int h, RwRaw& raw, int nb, int nc, int nh, int tid, int lane, int wave) {
    const int m0 = b * SEQ + 64 * c; const int item = (b * 128 + c) * 32 + h; const int hc = h * 64 + lane;
    const int l15 = lane & 15, q = lane >> 4;
    LAS bf16* Rt = (LAS bf16*)(lds + 0 * RSL); LAS bf16* Kt = (LAS bf16*)(lds + 1 * RSL); LAS bf16* Bt = (LAS bf16*)(lds + 2 * RSL); LAS bf16* At = (LAS bf16*)(lds + 3 * RSL);
    LAS bf16* AtT = (LAS bf16*)(lds + 4 * RSL); LAS bf16* KhT = (LAS bf16*)(lds + 5 * RSL); LAS bf16* BhT = (LAS bf16*)(lds + 6 * RSL); LAS bf16* VT = (LAS bf16*)(lds + 7 * RSL);
    LAS bf16* Aak = (LAS bf16*)(lds + 8 * RSL); LAS bf16* Ark = (LAS bf16*)(lds + 9 * RSL); LAS bf16* Arb = (LAS bf16*)(lds + 10 * RSL);
    LAS float* Lm = (LAS float*)(lds + 11 * RSL); LAS float* Tm = (LAS float*)(lds + 1 * RSL); LAS bf16* Tb = (LAS bf16*)(lds + 3 * RSL);
    LAS bf16* WtT = (LAS bf16*)(lds + 11 * RSL); LAS bf16* XT = (LAS bf16*)(lds + 12 * RSL); LAS bf16* U0T = (LAS bf16*)(lds + 1 * RSL);
    LAS float* Dinv = (LAS float*)(lds + 13 * RSL); LAS float* Yb = (LAS float*)(lds + 13 * RSL + 4352);
    LAS float* wl = (LAS float*)(lds + 0); LAS float* al = (LAS float*)(lds + 2 * RSL);
    LAS bf16* txw = (LAS bf16*)(lds + 8 * RSL); LAS bf16* xas = txw + 64 * 104; LAS bf16* w2s = xas + 64 * 104; LAS bf16* a2s = w2s + 64 * 104;
    LAS float* wtot = (LAS float*)(lds + 126976); LAS float* eGCs = (LAS float*)(lds + 129024);
    float rr[8], kr[8], vv[8];
    {   float ur[9], uk[9], uv[9];
#pragma unroll
        for (int i = 0; i < 9; ++i) { const bool ok = (64 * c + wave * 8 + i - 1) >= 0;
            ur[i] = ok ? bf2f((bf16)raw.ur[i]) : 0.f; uk[i] = ok ? bf2f((bf16)raw.uk[i]) : 0.f; uv[i] = ok ? bf2f((bf16)raw.uv[i]) : 0.f; }
        const float mr = P.mu[RW_R + hc], mk = P.mu[RW_K + hc], mv = P.mu[RW_V + hc];
#pragma unroll
        for (int i = 0; i < 8; ++i) { rr[i] = ur[i + 1] + mr * (ur[i] - ur[i + 1]); kr[i] = uk[i + 1] + mk * (uk[i] - uk[i + 1]); vv[i] = uv[i + 1] + mv * (uv[i] - uv[i + 1]); }
    }
#ifdef PR1
    for (int _pr = 0; _pr < 2; ++_pr) {
#else
    {
#endif
#pragma unroll
    for (int r = 0; r < 3; ++r) { const int i = tid + 512 * r; const int which = i >= 768, ii = which ? i - 768 : i; const int t = ii / 12, g8 = ii - t * 12; const int tt = 64 * c + t;
        const int col = (which ? RW_XA : RW_XW) + 8 * g8;
        const v4u u = raw.xu[r]; v4u up = raw.xp[r]; if (tt <= 0) up = (v4u){0u, 0u, 0u, 0u};
        const f32x4 m0v = *(const GAS f32x4*)(P.mu + col), m1v = *(const GAS f32x4*)(P.mu + col + 4);
        float x[8];
        x[0] = bflo(u.x) + m0v.x * (bflo(up.x) - bflo(u.x)); x[1] = bfhi(u.x) + m0v.y * (bfhi(up.x) - bfhi(u.x)); x[2] = bflo(u.y) + m0v.z * (bflo(up.y) - bflo(u.y)); x[3] = bfhi(u.y) + m0v.w * (bfhi(up.y) - bfhi(u.y));
        x[4] = bflo(u.z) + m1v.x * (bflo(up.z) - bflo(u.z)); x[5] = bfhi(u.z) + m1v.y * (bfhi(up.z) - bfhi(u.z)); x[6] = bflo(u.w) + m1v.z * (bflo(up.w) - bflo(u.w)); x[7] = bfhi(u.w) + m1v.w * (bfhi(up.w) - bfhi(u.w));
        if (!which) {
#pragma unroll
            for (int k = 0; k < 8; ++k) { const float e2 = __expf(2.0f * x[k]); x[k] = 1.0f - 2.0f / (e2 + 1.0f); } }
        v4u o; o.x = cvt2(x[0], x[1]); o.y = cvt2(x[2], x[3]); o.z = cvt2(x[4], x[5]); o.w = cvt2(x[6], x[7]);
        *(LAS v4u*)(txw + which * 6656 + t * 104 + 8 * g8) = o; }
    bf16x8 fw2[2][3], fa2[2][3];
#pragma unroll
    for (int ci = 0; ci < 2; ++ci)
#pragma unroll
        for (int ks = 0; ks < 3; ++ks) { const size_t o = (size_t)(h * 64 + 16 * (2 * (wave >> 2) + ci) + l15) * 96 + 32 * ks + 8 * q;
            fw2[ci][ks] = *(const GAS bf16x8*)(W.w2T + o); fa2[ci][ks] = *(const GAS bf16x8*)(W.a2T + o); }
    __syncthreads();
    {   const int tt = wave & 3, cp = wave >> 2;
#pragma unroll
        for (int ci = 0; ci < 2; ++ci) { const int ct = 2 * cp + ci;
            f32x4 aw = (f32x4){0.f, 0.f, 0.f, 0.f}, aa = (f32x4){0.f, 0.f, 0.f, 0.f};
#pragma unroll
            for (int ks = 0; ks < 3; ++ks) {
                const bf16x8 fx = *(const LAS bf16x8*)(txw + (16 * tt + l15) * 104 + 32 * ks + 8 * q), fa = *(const LAS bf16x8*)(xas + (16 * tt + l15) * 104 + 32 * ks + 8 * q);
                aw = MFMA16(fx, fw2[ci][ks], aw); aa = MFMA16(fa, fa2[ci][ks], aa); }
#pragma unroll
            for (int reg = 0; reg < 4; ++reg) { wl[(16 * tt + 4 * q + reg) * 65 + 16 * ct + l15] = aw[reg]; al[(16 * tt + 4 * q + reg) * 65 + 16 * ct + l15] = aa[reg]; } }
    }
    }
    __syncthreads();
    float lw[8], av[8], bvv[8], kp[8], Gt[8];
    {   const float w0c = P.w0[hc], a0c = P.a0[hc], kkc = P.k_k[hc], kac = P.k_a[hc], rkc = P.r_k[hc];
        float run = 0.f;
#pragma unroll
        for (int i = 0; i < 8; ++i) { const int t = wave * 8 + i;
            const float wlog = -softplus_f(-(w0c + wl[t * 65 + lane])) - 0.5f; lw[i] = -__expf(wlog);
            const float alr = sigmoid_f(a0c + al[t * 65 + lane]);
            const float kkr = kr[i] * kkc; const float kk = kkr / sqrtf(wave_sum(kkr * kkr) + 1e-6f);
            kp[i] = kr[i] * (1.0f + (alr - 1.0f) * kac); av[i] = -kk; bvv[i] = kk * alr;
            const float sbv = wave_sum(rr[i] * kp[i] * rkc); if (lane == 0) W.sb[(size_t)item * 64 + t] = sbv;
            run += lw[i]; Gt[i] = run; }
        wtot[wave * 64 + lane] = run;
    }
    __syncthreads();
    {   float off = 0.f, gcv = 0.f;
#pragma unroll
        for (int w = 0; w < 8; ++w) { const float x = wtot[w * 64 + lane]; gcv += x; if (w < wave) off += x; }
        if (wave == 0) eGCs[lane] = __expf(gcv);
        float tA[8], tK[8], tB[8];
#pragma unroll
        for (int i = 0; i < 8; ++i) { const int t = wave * 8 + i; const float G = Gt[i] + off;
            const float eG = __expf(G), eGm = __expf(-G), eGp = __expf(G - lw[i]), eH = __expf(gcv - G);
            Rt[t * 72 + lane] = (bf16)(cvt2(rr[i] * eG, 0.f) & 0xffffu); Kt[t * 72 + lane] = (bf16)(cvt2(kp[i] * eGm, 0.f) & 0xffffu);
            Bt[t * 72 + lane] = (bf16)(cvt2(bvv[i] * eGm, 0.f) & 0xffffu); tA[i] = av[i] * eGp; At[t * 72 + lane] = (bf16)(cvt2(tA[i], 0.f) & 0xffffu);
            tK[i] = kp[i] * eH; tB[i] = bvv[i] * eH; }
        v4u o;
        o.x = cvt2(tA[0], tA[1]); o.y = cvt2(tA[2], tA[3]); o.z = cvt2(tA[4], tA[5]); o.w = cvt2(tA[6], tA[7]); *(LAS v4u*)(AtT + lane * 72 + wave * 8) = o;
        o.x = cvt2(tK[0], tK[1]); o.y = cvt2(tK[2], tK[3]); o.z = cvt2(tK[4], tK[5]); o.w = cvt2(tK[6], tK[7]); *(LAS v4u*)(KhT + lane * 72 + wave * 8) = o;
        o.x = cvt2(tB[0], tB[1]); o.y = cvt2(tB[2], tB[3]); o.z = cvt2(tB[4], tB[5]); o.w = cvt2(tB[6], tB[7]); *(LAS v4u*)(BhT + lane * 72 + wave * 8) = o;
        o.x = cvt2(vv[0], vv[1]); o.y = cvt2(vv[2], vv[3]); o.z = cvt2(vv[4], vv[5]); o.w = cvt2(vv[6], vv[7]); *(LAS v4u*)(VT + lane * 72 + wave * 8) = o;
    }
    __syncthreads();
#ifdef PR4
    for (int _pr = 0; _pr < 2; ++_pr)
#endif
    {   const int tt = wave & 3, sp = wave >> 2;
        bf16x8 fA[2], fR[2];
#pragma unroll
        for (int ks = 0; ks < 2; ++ks) { fA[ks] = *(const LAS bf16x8*)(At + (16 * tt + l15) * 72 + 32 * ks + 8 * q); fR[ks] = *(const LAS bf16x8*)(Rt + (16 * tt + l15) * 72 + 32 * ks + 8 * q); }
#pragma unroll
        for (int si = 0; si < 2; ++si) { const int st = 2 * sp + si;
            f32x4 ab = (f32x4){0.f, 0.f, 0.f, 0.f}, ak = ab, rk = ab, rb = ab;
#pragma unroll
            for (int ks = 0; ks < 2; ++ks) { const bf16x8 fB = *(const LAS bf16x8*)(Bt + (16 * st + l15) * 72 + 32 * ks + 8 * q), fK = *(const LAS bf16x8*)(Kt + (16 * st + l15) * 72 + 32 * ks + 8 * q);
                ab = MFMA16(fB, fA[ks], ab); ak = MFMA16(fK, fA[ks], ak); rk = MFMA16(fK, fR[ks], rk); rb = MFMA16(fB, fR[ks], rb); }
            const int t = 16 * tt + l15, s0 = 16 * st + 4 * q; float vak[4], vrk[4], vrb[4];
#pragma unroll
            for (int reg = 0; reg < 4; ++reg) { const int s = s0 + reg; Lm[t * 65 + s] = (t > s) ? -ab[reg] : 0.f; vak[reg] = (t > s) ? ak[reg] : 0.f; vrk[reg] = (t >= s) ? rk[reg] : 0.f; vrb[reg] = (t >= s) ? rb[reg] : 0.f; }
            v2u o; o.x = cvt2(vak[0], vak[1]); o.y = cvt2(vak[2], vak[3]); *(LAS v2u*)(Aak + t * 72 + s0) = o;
            o.x = cvt2(vrk[0], vrk[1]); o.y = cvt2(vrk[2], vrk[3]); *(LAS v2u*)(Ark + t * 72 + s0) = o;
            o.x = cvt2(vrb[0], vrb[1]); o.y = cvt2(vrb[2], vrb[3]); *(LAS v2u*)(Arb + t * 72 + s0) = o; }
    }
    __syncthreads();
    tri_inv64(Lm, Tm, Tb, Dinv, Yb, tid, lane, wave);
#ifdef PR2
    tri_inv64(Lm, Tm, Tb, Dinv, Yb, tid, lane, wave);
#endif
#ifdef PR5
    for (int _pr = 0; _pr < 2; ++_pr) {
#else
    {
#endif
    {   const int tt = wave & 3, cp = wave >> 2;
        bf16x8 fT[2], fK[2];
#pragma unroll
        for (int ks = 0; ks < 2; ++ks) { fT[ks] = *(const LAS bf16x8*)(Tb + (16 * tt + l15) * 72 + 32 * ks + 8 * q); fK[ks] = *(const LAS bf16x8*)(Aak + (16 * tt + l15) * 72 + 32 * ks + 8 * q); }
#pragma unroll
        for (int ci = 0; ci < 2; ++ci) { const int ct = 2 * cp + ci;
            f32x4 aw = (f32x4){0.f, 0.f, 0.f, 0.f}, ax = aw;
#pragma unroll
            for (int ks = 0; ks < 2; ++ks) { const bf16x8 fa = *(const LAS bf16x8*)(AtT + (16 * ct + l15) * 72 + 32 * ks + 8 * q), fv = *(const LAS bf16x8*)(VT + (16 * ct + l15) * 72 + 32 * ks + 8 * q);
                aw = MFMA16(fT[ks], fa, aw); ax = MFMA16(fK[ks], fv, ax); }
            v2u o; o.x = cvt2(aw[0], aw[1]); o.y = cvt2(aw[2], aw[3]); *(LAS v2u*)(WtT + (16 * ct + l15) * 72 + 16 * tt + 4 * q) = o;
            o.x = cvt2(ax[0], ax[1]); o.y = cvt2(ax[2], ax[3]); *(LAS v2u*)(XT + (16 * ct + l15) * 72 + 16 * tt + 4 * q) = o; }
    }
    __syncthreads();
    {   const int tt = wave & 3, cp = wave >> 2;
#pragma unroll
        for (int ci = 0; ci < 2; ++ci) { const int et = 2 * cp + ci; f32x4 au = (f32x4){0.f, 0.f, 0.f, 0.f};
#pragma unroll
            for (int ks = 0; ks < 2; ++ks) { const bf16x8 fT = *(const LAS bf16x8*)(Tb + (16 * tt + l15) * 72 + 32 * ks + 8 * q), fx = *(const LAS bf16x8*)(XT + (16 * et + l15) * 72 + 32 * ks + 8 * q);
                au = MFMA16(fT, fx, au); }
            v2u o; o.x = cvt2(au[0], au[1]); o.y = cvt2(au[2], au[3]); *(LAS v2u*)(U0T + (16 * et + l15) * 72 + 16 * tt + 4 * q) = o; }
    }
    __syncthreads();
    }
    if (nb >= 0) rw_prep_issue(P, raw, nb, nc, nh, tid, lane, wave);
#ifdef PR3
    for (int _pr = 0; _pr < 2; ++_pr)
#endif
    {   const int bt = wave & 3, ap = wave >> 2;
        unsigned char* pq = W.pq + (size_t)item * 16384; unsigned char* rp = W.rp + (size_t)item * 8192; unsigned char* oo = W.oo + (size_t)item * 8192;
        bf16x8 fArb[2], fArk[2], fBh[2], fV[2], fU[2];
#pragma unroll
        for (int ks = 0; ks < 2; ++ks) { fArb[ks] = *(const LAS bf16x8*)(Arb + (16 * bt + l15) * 72 + 32 * ks + 8 * q); fArk[ks] = *(const LAS bf16x8*)(Ark + (16 * bt + l15) * 72 + 32 * ks + 8 * q);
            fBh[ks] = *(const LAS bf16x8*)(BhT + (16 * bt + l15) * 72 + 32 * ks + 8 * q); fV[ks] = *(const LAS bf16x8*)(VT + (16 * bt + l15) * 72 + 32 * ks + 8 * q); fU[ks] = *(const LAS bf16x8*)(U0T + (16 * bt + l15) * 72 + 32 * ks + 8 * q); }
#pragma unroll
        for (int ai = 0; ai < 2; ++ai) { const int at = 2 * ap + ai;
            f32x4 aR = (f32x4){0.f, 0.f, 0.f, 0.f}, aP = aR, aO = aR, aQ = aR;
#pragma unroll
            for (int ks = 0; ks < 2; ++ks) {
                const bf16x8 fW = *(const LAS bf16x8*)(WtT + (16 * at + l15) * 72 + 32 * ks + 8 * q);
                aR = MFMA16(fW, fArb[ks], aR);
                aP = MFMA16(fW, fBh[ks], aP);
                const bf16x8 fk = *(const LAS bf16x8*)(Ark + (16 * at + l15) * 72 + 32 * ks + 8 * q), fb = *(const LAS bf16x8*)(Arb + (16 * at + l15) * 72 + 32 * ks + 8 * q);
                aO = MFMA16(fk, fV[ks], aO); aO = MFMA16(fb, fU[ks], aO);
                const bf16x8 fkh = *(const LAS bf16x8*)(KhT + (16 * at + l15) * 72 + 32 * ks + 8 * q), fbh = *(const LAS bf16x8*)(BhT + (16 * at + l15) * 72 + 32 * ks + 8 * q);
                aQ = MFMA16(fkh, fV[ks], aQ); aQ = MFMA16(fbh, fU[ks], aQ); }
            const int x = 16 * bt + l15, y0 = 16 * at + 4 * q;
            {   const v2u rt = *(const LAS v2u*)(Rt + x * 72 + y0);
                v2u o; o.x = cvt2(aR[0] + bflo(rt.x), aR[1] + bfhi(rt.x)); o.y = cvt2(aR[2] + bflo(rt.y), aR[3] + bfhi(rt.y));
                *(GAS v2u*)(rp + ((((x >> 5) * 4 + at) * 64 + (x & 31) + 32 * (q & 1)) * 16 + 8 * (q >> 1))) = o; }
            {   const float dg = eGCs[x]; float p[4];
#pragma unroll
                for (int reg = 0; reg < 4; ++reg) p[reg] = aP[reg] + ((y0 + reg == x) ? dg : 0.f);
                v2u o; o.x = cvt2(p[0], p[1]); o.y = cvt2(p[2], p[3]);
                *(GAS v2u*)(pq + ((((x >> 5) * 4 + at) * 64 + (x & 31) + 32 * (q & 1)) * 16 + 8 * (q >> 1))) = o; }
            {   v2u o; o.x = cvt2(aO[0], aO[1]); o.y = cvt2(aO[2], aO[3]); *(GAS v2u*)(oo + (x * 64 + y0) * 2) = o; }
            {   v2u o; o.x = cvt2(aQ[0], aQ[1]); o.y = cvt2(aQ[2], aQ[3]); *(GAS v2u*)(pq + 8192 + (x * 64 + y0) * 2) = o; }
        }
    }
    __syncthreads();
}

__device__ __forceinline__ void rw_scan(const MixPtrs& P, const RwRec& W, LAS unsigned char* lds, int b, int h, int tid, int lane, int wave) {
    constexpr int SB = 33792;
    const int item0 = b * 128 * 32 + h;
    if (wave < 2) {
        const int e = 32 * wave + (lane & 31), hh = lane >> 5;
        f32x16 H[2];
#pragma unroll
        for (int i = 0; i < 16; ++i) { H[0][i] = 0.f; H[1][i] = 0.f; }
        WG_BAR_LDS();
#pragma unroll 1
        for (int c = 0; c < 128; ++c) {
            LAS unsigned char* buf = lds + (c & 1) * SB;
            bf16x8 Hf[4]; Hf[0] = pack_step(H[0], 0); Hf[1] = pack_step(H[0], 1); Hf[2] = pack_step(H[1], 0); Hf[3] = pack_step(H[1], 1);
#pragma unroll
            for (int mt = 0; mt < 2; ++mt) {
                f32x16 hn, ov;
#pragma unroll
                for (int g = 0; g < 4; ++g) { const v2u qv = *(const LAS v2u*)(buf + 16384 + e * 136 + (32 * mt + 8 * g + 4 * hh) * 2), o0 = *(const LAS v2u*)(buf + 16384 + 8704 + e * 136 + (32 * mt + 8 * g + 4 * hh) * 2);
                    hn[4 * g] = bflo(qv.x); hn[4 * g + 1] = bfhi(qv.x); hn[4 * g + 2] = bflo(qv.y); hn[4 * g + 3] = bfhi(qv.y);
                    ov[4 * g] = bflo(o0.x); ov[4 * g + 1] = bfhi(o0.x); ov[4 * g + 2] = bflo(o0.y); ov[4 * g + 3] = bfhi(o0.y); }
#pragma unroll
                for (int ks = 0; ks < 4; ++ks) { const bf16x8 fp = *(const LAS bf16x8*)(buf + ((mt * 4 + ks) * 64 + lane) * 16), fr = *(const LAS bf16x8*)(buf + 8192 + ((mt * 4 + ks) * 64 + lane) * 16);
                    hn = MFMA32(fp, Hf[ks], hn); ov = MFMA32(fr, Hf[ks], ov); }
#pragma unroll
                for (int g = 0; g < 4; ++g) { v2u o; o.x = cvt2(ov[4 * g], ov[4 * g + 1]); o.y = cvt2(ov[4 * g + 2], ov[4 * g + 3]); *(LAS v2u*)(buf + 16384 + 8704 + e * 136 + (32 * mt + 8 * g + 4 * hh) * 2) = o; }
                if (mt == 0) H[0] = hn; else H[1] = hn;
            }
            WG_BAR_LDS();
        }
        float* Sout = P.out + O_SRW_P + ((size_t)b * 32 + h) * 4096;
#pragma unroll
        for (int mt = 0; mt < 2; ++mt)
#pragma unroll
            for (int g = 0; g < 4; ++g) *(f32x4*)(Sout + e * 64 + 32 * mt + 8 * g + 4 * hh) = (f32x4){H[mt][4 * g], H[mt][4 * g + 1], H[mt][4 * g + 2], H[mt][4 * g + 3]};
    } else {
        const int ht = tid - 128;
        v4u st[6];
#define RW_STAGE_ISSUE(itm) do { const unsigned char* _pq = W.pq + (size_t)(itm) * 16384; const unsigned char* _rp = W.rp + (size_t)(itm) * 8192; const unsigned char* _oo = W.oo + (size_t)(itm) * 8192; \
        _Pragma("unroll") for (int _k = 0; _k < 6; ++_k) { const int _i = ht + 384 * _k; if (_i < 2048) st[_k] = *(const GAS v4u*)(_i < 512 ? _pq + _i * 16 : (_i < 1024 ? _rp + (_i - 512) * 16 : (_i < 1536 ? _pq + 8192 + (_i - 1024) * 16 : _oo + (_i - 1536) * 16))); } } while (0)
#define RW_STAGE_WRITE(dstbuf) do { _Pragma("unroll") for (int _k = 0; _k < 6; ++_k) { const int _i = ht + 384 * _k; if (_i < 1024) *(LAS v4u*)((dstbuf) + _i * 16) = st[_k]; \
            else if (_i < 2048) { const int _j = _i - 1024; LAS unsigned char* _d = (dstbuf) + 16384 + (_j >> 3) * 136 + (_j & 7) * 16; *(LAS v2u*)_d = (v2u){st[_k].x, st[_k].y}; *(LAS v2u*)(_d + 8) = (v2u){st[_k].z, st[_k].w}; } } } while (0)
#define RW_STORE_O(itm, srcbuf) do { unsigned char* _oo = W.oo + (size_t)(itm) * 8192; \
        _Pragma("unroll") for (int _k = 4; _k < 6; ++_k) { const int _i = ht + 384 * _k; if (_i < 2048) { const int _j = _i - 1024; const LAS unsigned char* _s = (srcbuf) + 16384 + (_j >> 3) * 136 + (_j & 7) * 16; \
            const v2u _a = *(const LAS v2u*)_s, _b = *(const LAS v2u*)(_s + 8); *(GAS v4u*)(_oo + (_i - 1536) * 16) = (v4u){_a.x, _a.y, _b.x, _b.y}; } } } while (0)
        RW_STAGE_ISSUE(item0); RW_STAGE_WRITE(lds); RW_STAGE_ISSUE(item0 + 32);
        WG_BAR_LDS();
#pragma unroll 1
        for (int c = 0; c < 128; ++c) {
            if (c > 0) RW_STORE_O(item0 + 32 * (c - 1), lds + ((c - 1) & 1) * SB);
            if (c + 1 < 128) RW_STAGE_WRITE(lds + ((c + 1) & 1) * SB);
            if (c + 2 < 128) RW_STAGE_ISSUE(item0 + 32 * (c + 2));
            WG_BAR_LDS();
        }
        RW_STORE_O(item0 + 32 * 127, lds + SB);
#undef RW_STAGE_ISSUE
#undef RW_STAGE_WRITE
#undef RW_STORE_O
    }
    {   float* shout = P.out + O_SHIFT_P + (size_t)b * RW_SHIFT_W;
        for (int i = tid; i < 206; i += 512) { const int col = h * 206 + i; shout[col] = bf2f(P.proj[(size_t)(b * SEQ + SEQ - 1) * IN_WP + PC_RW + col]); } }
    __syncthreads();
}

__device__ __forceinline__ void rw_gate_item(const MixPtrs& P, const RwRec& W, LAS unsigned char* lds, int b, int c, int qt, int tid, int lane, int wave) {
    const int m0 = b * SEQ + 64 * c; const int l15 = lane & 15, q = lane >> 4;
    LAS bf16* sxg = (LAS bf16*)lds;
#pragma unroll
    for (int r = 0; r < 4; ++r) { const int i = tid + 512 * r; const int t = i >> 5, g8 = i & 31; const int tt = 64 * c + t; const int col = RW_XG + 8 * g8;
        const v4u u = *(const GAS v4u*)(P.proj + (size_t)(m0 + t) * IN_WP + PC_RW + col); v4u up = (v4u){0u, 0u, 0u, 0u}; if (tt > 0) up = *(const GAS v4u*)(P.proj + (size_t)(m0 + t - 1) * IN_WP + PC_RW + col);
        const f32x4 m0v = *(const GAS f32x4*)(P.mu + col), m1v = *(const GAS f32x4*)(P.mu + col + 4);
        float x[8];
        x[0] = bflo(u.x) + m0v.x * (bflo(up.x) - bflo(u.x)); x[1] = bfhi(u.x) + m0v.y * (bfhi(up.x) - bfhi(u.x)); x[2] = bflo(u.y) + m0v.z * (bflo(up.y) - bflo(u.y)); x[3] = bfhi(u.y) + m0v.w * (bfhi(up.y) - bfhi(u.y));
        x[4] = bflo(u.z) + m1v.x * (bflo(up.z) - bflo(u.z)); x[5] = bfhi(u.z) + m1v.y * (bfhi(up.z) - bfhi(u.z)); x[6] = bflo(u.w) + m1v.z * (bflo(up.w) - bflo(u.w)); x[7] = bfhi(u.w) + m1v.w * (bfhi(up.w) - bfhi(u.w));
        v4u o; o.x = cvt2(sigmoid_f(x[0]), sigmoid_f(x[1])); o.y = cvt2(sigmoid_f(x[2]), sigmoid_f(x[3])); o.z = cvt2(sigmoid_f(x[4]), sigmoid_f(x[5])); o.w = cvt2(sigmoid_f(x[6]), sigmoid_f(x[7]));
        *(LAS v4u*)(sxg + t * 264 + 8 * g8) = o; }
    __syncthreads();
    {   const int tt = wave & 3, hf = wave >> 2;
        bf16x8 fx[8];
#pragma unroll
        for (int ks = 0; ks < 8; ++ks) fx[ks] = *(const LAS bf16x8*)(sxg + (16 * tt + l15) * 264 + 32 * ks + 8 * q);
        const int colb = qt * 512 + hf * 256;
#pragma unroll 2
        for (int vt = 0; vt < 16; ++vt) { const bf16* gr = W.g2T + (size_t)(colb + 16 * vt + l15) * 256 + 8 * q;
            bf16x8 fg[8];
#pragma unroll
            for (int ks = 0; ks < 8; ++ks) fg[ks] = *(const GAS bf16x8*)(gr + 32 * ks);
            f32x4 ag = (f32x4){0.f, 0.f, 0.f, 0.f};
#pragma unroll
            for (int ks = 0; ks < 8; ++ks) ag = MFMA16(fg[ks], fx[ks], ag);
            v2u o; o.x = cvt2(ag[0], ag[1]); o.y = cvt2(ag[2], ag[3]);
            *(GAS v2u*)(P.mix + (size_t)(m0 + 16 * tt + l15) * 4096 + 2048 + colb + 16 * vt + 4 * q) = o; }
    }
    __syncthreads();
}
__device__ __forceinline__ void rw_post_task(const MixPtrs& P, const RwRec& W, int item, int tg, int lane) {
    const int h = item & 31, c = (item >> 5) & 127, b = item >> 12; const int m0 = b * SEQ + 64 * c + 8 * tg; const int hc = h * 64 + lane;
    const v4u ov = *(const GAS v4u*)(W.oo + (size_t)item * 8192 + (lane * 64 + tg * 8) * 2);
    float uv[9], gt[8];
#pragma unroll
    for (int i = 0; i < 9; ++i) { const int tt = 64 * c + 8 * tg + i - 1; uv[i] = tt >= 0 ? bf2f(P.proj[(size_t)(b * SEQ + tt) * IN_WP + PC_RW + RW_V + hc]) : 0.f; }
#pragma unroll
    for (int i = 0; i < 8; ++i) gt[i] = bf2f(P.mix[(size_t)(m0 + i) * 4096 + 2048 + hc]);
    const float mv = P.mu[RW_V + hc], lnw = P.ln_w[hc], lnb = P.ln_b[hc];
    const float y[8] = {bflo(ov.x), bfhi(ov.x), bflo(ov.y), bfhi(ov.y), bflo(ov.z), bfhi(ov.z), bflo(ov.w), bfhi(ov.w)};
    float sbs[8];
#pragma unroll
    for (int i = 0; i < 8; ++i) sbs[i] = W.sb[(size_t)item * 64 + tg * 8 + i];
#pragma unroll
    for (int i = 0; i < 8; ++i) { const float vv = uv[i + 1] + mv * (uv[i] - uv[i + 1]);
        const float mean = wave_sum(y[i]) * (1.f / 64.f); const float dy = y[i] - mean; const float var = wave_sum(dy * dy) * (1.f / 64.f);
        const float yn = dy / sqrtf(var + RW_GN_EPS) * lnw + lnb;
        P.mix[(size_t)(m0 + i) * 4096 + 2048 + hc] = (bf16)(cvt2((yn + sbs[i] * vv) * gt[i], 0.f) & 0xffffu); }
}

constexpr int NPH = 10;
#define MK_N_LAUNCHES 1
#ifndef MK_N_LAUNCHES
#define MK_N_LAUNCHES 1
#endif
#ifndef GP_ALIGN
#define GP_ALIGN false
#endif
#ifndef GP_SP2
#define GP_SP2 true
#endif
#ifndef REP_MASK
#define REP_MASK 0
#endif
__global__ void __launch_bounds__(NWAVES * 64, 2) hymba_fwd(Args args) {
    extern __shared__ __attribute__((aligned(16))) unsigned char lds_raw[];
    LAS unsigned char* lds = (LAS unsigned char*)lds_raw;
    volatile LAS unsigned* MISC = (volatile LAS unsigned*)(lds + MISC_OFF);
    const int tid = threadIdx.x, lane = tid & 63, wave = __builtin_amdgcn_readfirstlane(tid >> 6);
    const int G = gridDim.x;
    unsigned char* ws = args.ws;
    gu32* ctl = (gu32*)(ws + WS_CTL);
    for (int u = tid; u < (LDS_BYTES - LDSCTL_OFF) / 4; u += NWAVES * 64) ((LAS unsigned*)(lds + LDSCTL_OFF))[u] = 0u;
    __syncthreads();
    XcdBarrier bar; bar.bar = (unsigned*)(ctl + CW_BAR); bar.x = 0; bar.st = nullptr;
    if (MK_N_LAUNCHES == 1) bar = xcd_barrier_post((unsigned*)(ctl + CW_BAR), MISC + 8);
    const int lo = args.ph_lo, hi = args.ph_hi;
#ifdef ONLY_PHASE
#define IN(k) ((k) == ONLY_PHASE)
#else
#define IN(k) (lo <= (k) && (k) < hi)
#endif
#define SEAM(k) do { if (IN(k) && IN((k) + 1)) xcd_barrier(bar); } while (0)
    float* ssq = (float*)(ws + WS_SSQ);
    bf16* Wt_out = (bf16*)(ws + WS_WOUT); bf16* hbuf = (bf16*)(ws + WS_HBUF); bf16* proj = (bf16*)(ws + WS_PROJ); bf16* act = (bf16*)(ws + WS_PROJ);
    bf16* Wt_in = (bf16*)(ws + WS_WIN); bf16* Wt_gu = (bf16*)(ws + WS_WGU); bf16* Wt_dn = (bf16*)(ws + WS_WDN);
    bf16* w2T = (bf16*)(ws + WS_W2T); bf16* a2T = (bf16*)(ws + WS_A2T); bf16* g2T = (bf16*)(ws + WS_G2T);
    const float* x_prompt = args.in[0]; const float* x_sample = args.in[1];
    const int gw = blockIdx.x * NWAVES + wave, NGW = G * NWAVES;

    if (IN(0)) _Pragma("unroll") for (int _r = 0; _r < 1 + ((REP_MASK >> 0) & 1); ++_r) {
        LAS float* scr = (LAS float*)(lds + RING_OFF + wave * 16384);
        constexpr int I_IN = 64 * (IN_W / 32);
        for (int it = gw; it < I_IN; it += NGW) p0_transpose_item(args.in[8], 4096, IN_W, Wt_in, scr, it, lane, RmId{});
        for (int i = blockIdx.x * 512 + tid; i < 2048 * 448; i += G * 512) {
            if (i < 2048 * 96) { const int c = i / 96, j = i - c * 96; w2T[i] = (bf16)f2bf(args.in[15][j * 2048 + c]); }
            else if (i < 2048 * 192) { const int ii = i - 2048 * 96; const int c = ii / 96, j = ii - c * 96; a2T[ii] = (bf16)f2bf(args.in[17][j * 2048 + c]); }
            else { const int ii = i - 2048 * 192; const int c = ii >> 8, j = ii & 255; g2T[ii] = (bf16)f2bf(args.in[18][j * 2048 + c]); }
        }
        for (int i = blockIdx.x * 512 + tid; i < 32 * 4096 / 8; i += G * 512) ((GAS v4u*)(Wt_in + (size_t)IN_W * 4096))[i] = (v4u){0u, 0u, 0u, 0u};
        for (int m = gw; m < MPAD; m += NGW) {
            bf16* orow = hbuf + (size_t)m * 4096;
            if (m < M_REAL) { const float* xrow = m < M_PROMPT ? x_prompt + (size_t)m * 4096 : x_sample + (size_t)(m - M_PROMPT) * 4096;
                const GAS f32x4* xr = (const GAS f32x4*)xrow + lane; f32x4 v[16];
#pragma unroll
                for (int j = 0; j < 16; ++j) v[j] = xr[64 * j];
                rms_row_to_bf16(v, args.in[6], orow, lane); }
            else { GAS v2u* o8 = (GAS v2u*)orow + lane;
#pragma unroll
                for (int j = 0; j < 16; ++j) o8[64 * j] = (v2u){0u, 0u}; }
        }
    }
    SEAM(0);
    if (IN(1)) _Pragma("unroll") for (int _r = 0; _r < 1 + ((REP_MASK >> 1) & 1); ++_r) {
        pg8::Gemm g{hbuf, Wt_in, MPAD, IN_WP, 4096, 4096, 4096}; pg8::StaticOrder S; S.init(MPAD, IN_WP, G, (int)blockIdx.x);
        pg8::EpiBf16Plain E{proj, IN_WP};
        pg8::gemm_phase<pg8::EpiBf16Plain, pg8::StaticOrder, GP_ALIGN, GP_SP2>(lds + RING_OFF, g, S, E);
    }
#ifdef PROBE_GEMM_RESIDENT
    if (IN(1)) {
        struct ProbeOrder : pg8::StaticOrder { __device__ bool next(int i, pg8::Unit& u) const { if (i >= 15) return false; u.pm = c & 7; u.pn = (c >> 3) & 3; return true; } };
        pg8::Gemm g{hbuf, Wt_in, MPAD, IN_WP, 4096, 4096, 4096}; ProbeOrder S; S.init(MPAD, IN_WP, G, (int)blockIdx.x);
        pg8::EpiBf16Plain E{Wt_gu, IN_WP};
        pg8::gemm_phase<pg8::EpiBf16Plain, ProbeOrder, GP_ALIGN, GP_SP2>(lds + RING_OFF, g, S, E);
    }
#endif
    SEAM(1);
    MixPtrs P; P.proj = proj; P.mix = hbuf; P.state_dn = args.in[2]; P.cache_conv = args.in[3]; P.state_rw = args.in[4]; P.cache_shift = args.in[5];
    P.conv_w = args.in[9]; P.a_log = args.in[10]; P.dt_bias = args.in[11]; P.dn_norm_w = args.in[12];
    P.mu = args.in[13]; P.w0 = args.in[14]; P.w2 = args.in[15]; P.a0 = args.in[16]; P.a2 = args.in[17]; P.g2 = args.in[18]; P.k_k = args.in[19]; P.k_a = args.in[20]; P.r_k = args.in[21];
    P.ln_w = args.in[22]; P.ln_b = args.in[23]; P.out = args.out;
    DnRec R; R.rec = (unsigned char*)args.out; R.qk = ws + WS_DNQK; R.gl = (float*)(ws + WS_DNGL);
    RwRec W; W.pq = ws + WS_RWPQ; W.rp = ws + WS_RWRP; W.oo = ws + WS_RWOO; W.sb = (float*)(ws + WS_RWSB); W.w2T = w2T; W.a2T = a2T; W.g2T = g2T;
    if (IN(2)) _Pragma("unroll") for (int _r = 0; _r < 1 + ((REP_MASK >> 2) & 1); ++_r) {
#ifndef REP_DNP
#define REP_DNP 0
#endif
#ifndef REP_RWP
#define REP_RWP 0
#endif
        for (int _q = 0; _q <= REP_DNP; ++_q)
        for (int it = blockIdx.x; it < 4096; it += G) dn_prep_item(P, R, lds + RING_OFF, it >> 11, (it >> 4) & 127, it & 15, tid, lane, wave);
        for (int _q = 0; _q <= REP_RWP; ++_q) {
            RwRaw raw; { const int it = blockIdx.x; rw_prep_issue(P, raw, it >> 12, (it >> 5) & 127, it & 31, tid, lane, wave); }
            for (int it = blockIdx.x; it < 8192; it += G) { const int nx = it + G; const bool hn = nx < 8192;
                rw_prep_item(P, W, lds + RING_OFF, it >> 12, (it >> 5) & 127, it & 31, raw, hn ? (nx >> 12) : -1, (nx >> 5) & 127, nx & 31, tid, lane, wave); }
        }
    }
    SEAM(2);
    if (IN(3)) _Pragma("unroll") for (int _r = 0; _r < 1 + ((REP_MASK >> 3) & 1); ++_r) {
        const int wg = blockIdx.x;
#ifndef REP_DNSCAN
#define REP_DNSCAN 0
#endif
#ifndef REP_SAMPLES
#define REP_SAMPLES 0
#endif
        if (wg < 32) { _Pragma("unroll 1") for (int _q = 0; _q <= REP_DNSCAN; ++_q) dn_scan(P, R, lds + RING_OFF, wg >> 4, wg & 15, tid, lane, wave); }
        else if (wg < 96) rw_scan(P, W, lds + RING_OFF, (wg - 32) >> 5, (wg - 32) & 31, tid, lane, wave);
        else {
            _Pragma("unroll 1") for (int _q = 0; _q <= REP_SAMPLES; ++_q)
            for (int it = wg - 96; it < 384; it += G - 96) {
                if (it < 128) dn_seq_item(P, lds + RING_OFF, 2 + (it >> 4), it & 15, tid, lane, wave);
                else rw_seq_item(P, w2T, a2T, g2T, lds + RING_OFF, 2 + ((it - 128) >> 5), (it - 128) & 31, tid, lane, wave);
            }
        }
        if (wg >= 32) {
            const int pw = wg - 32, npw = G - 32;
            for (int it = pw; it < 1024; it += npw) rw_gate_item(P, W, lds + RING_OFF, it >> 9, (it >> 2) & 127, it & 3, tid, lane, wave);
            LAS float* scr = (LAS float*)(lds + RING_OFF + wave * 16384);
            for (int it = pw * NWAVES + wave; it < 64 * 128; it += npw * NWAVES) p0_transpose_item(args.in[24], 4096, 4096, Wt_out, scr, it, lane, RmId{});
            for (int it = pw * NWAVES + wave; it < (D_FF / 64) * 98; it += npw * NWAVES) { const int kb = it / 98, nb = 30 + it % 98; p0_transpose_item(args.in[29], D_FF, 4096, Wt_dn, scr, kb * 128 + nb, lane, RmId{}); }
            __syncthreads();
        }
    }
    SEAM(3);
    if (IN(4)) _Pragma("unroll") for (int _r = 0; _r < 1 + ((REP_MASK >> 4) & 1); ++_r) {
        for (int task = gw; task < 8192 * 8; task += NGW) rw_post_task(P, W, task >> 3, task & 7, lane);
        LAS float* scr = (LAS float*)(lds + RING_OFF + wave * 16384);
        constexpr int I_G = 64 * (D_FF / 32), I_D = (D_FF / 64) * 30;
        for (int it = gw; it < 2 * I_G + I_D; it += NGW) {
            if (it < I_G) p0_transpose_item(args.in[27], 4096, D_FF, Wt_gu, scr, it, lane, RmGU{0});
            else if (it < 2 * I_G) p0_transpose_item(args.in[28], 4096, D_FF, Wt_gu, scr, it - I_G, lane, RmGU{1});
            else { const int r = it - 2 * I_G; const int kb = r / 30, nb = r % 30; p0_transpose_item(args.in[29], D_FF, 4096, Wt_dn, scr, kb * 128 + nb, lane, RmId{}); }
        }
        __syncthreads();
    }
    SEAM(4);
    if (IN(5)) _Pragma("unroll") for (int _r = 0; _r < 1 + ((REP_MASK >> 5) & 1); ++_r) {
#ifdef OLD_TAILS
        { pg8::Gemm g{hbuf, Wt_out, MPAD, 4096, 4096, 4096, 4096}; pg8::StaticOrder S; S.init(MPAD, 4096, G, (int)blockIdx.x);
        pg8::EpiF32Ssq E{args.out + O_Y, 4096, ssq, M_REAL};
        pg8::gemm_phase<pg8::EpiF32Ssq, pg8::StaticOrder, GP_ALIGN, GP_SP2>(lds + RING_OFF, g, S, E); }
#else
        pg8::Gemm g{hbuf, Wt_out, M_PROMPT, 4096, 4096, 4096, 4096}; pg8::StaticOrder S; S.init(M_PROMPT, 4096, G, (int)blockIdx.x);
        pg8::EpiBf16Ssq E{proj, 4096, ssq};
        pg8::gemm_phase<pg8::EpiBf16Ssq, pg8::StaticOrder, GP_ALIGN, GP_SP2>(lds + RING_OFF, g, S, E);
        pg8::Gemm gt{hbuf, Wt_out, MPAD, 4096, 256, 4096, 4096}; pg8::TailOrder St{16 * 16, G, (int)blockIdx.x, 0, 256, 0};
        pg8::EpiF32Part Et{(float*)(ws + WS_PART2), 4096};
        pg8::gemm_phase<pg8::EpiF32Part, pg8::TailOrder, GP_ALIGN, GP_SP2>(lds + RING_OFF, gt, St, Et);
#endif
    }
    SEAM(5);
    if (IN(6)) _Pragma("unroll") for (int _r = 0; _r < 1 + ((REP_MASK >> 6) & 1); ++_r) {
        for (int m = gw; m < M_REAL; m += NGW) {
            const float* xrow = m < M_PROMPT ? x_prompt + (size_t)m * 4096 : x_sample + (size_t)(m - M_PROMPT) * 4096;
            const GAS f32x4* xr = (const GAS f32x4*)xrow + lane; GAS f32x4* tr = (GAS f32x4*)(args.out + O_Y + (size_t)m * 4096) + lane; const GAS f32x4* gr = (const GAS f32x4*)args.in[7] + lane;
            f32x4 v[16]; float s = 0.f;
#ifdef OLD_TAILS
            const bool smp = false;
#else
            const bool smp = m >= M_PROMPT;
#endif
            if (smp) {
                const GAS f32x4* pp = (const GAS f32x4*)(ws + WS_PART2) + (size_t)(m - M_PROMPT) * 1024 + lane;
#pragma unroll
                for (int j = 0; j < 16; ++j) { f32x4 t[16];
#pragma unroll
                    for (int sp = 0; sp < 16; ++sp) t[sp] = pp[(size_t)sp * 128 * 1024 + 64 * j];
                    const f32x4 a = ((t[0] + t[1]) + (t[2] + t[3])) + ((t[4] + t[5]) + (t[6] + t[7])) + (((t[8] + t[9]) + (t[10] + t[11])) + ((t[12] + t[13]) + (t[14] + t[15])));
                    v[j] = a; s += (a.x * a.x + a.y * a.y) + (a.z * a.z + a.w * a.w); }
            } else {
                const GAS v2u* tb = (const GAS v2u*)(proj + (size_t)m * 4096) + lane; v2u tv[16];
#pragma unroll
                for (int j = 0; j < 16; ++j) tv[j] = tb[64 * j];
#pragma unroll
                for (int j = 0; j < 16; ++j) { v[j].x = bflo(tv[j].x); v[j].y = bfhi(tv[j].x); v[j].z = bflo(tv[j].y); v[j].w = bfhi(tv[j].y); }
                s = ssq[(size_t)m * 64 + lane];
            }
            s = wave_sum(s);
            const float rstd = 1.0f / sqrtf(s * (1.f / 4096.f) + NORM_EPS);
#pragma unroll
            for (int hh = 0; hh < 2; ++hh) { f32x4 xv[8], gv[8];
#pragma unroll
                for (int j = 0; j < 8; ++j) { xv[j] = xr[64 * (8 * hh + j)]; gv[j] = gr[64 * (8 * hh + j)]; }
#pragma unroll
                for (int j = 0; j < 8; ++j) { const f32x4 x1 = xv[j] + v[8 * hh + j] * rstd * gv[j]; v[8 * hh + j] = x1;
                    if (smp) tr[64 * (8 * hh + j)] = x1;
                    else { v2u o; o.x = cvt2(x1.x, x1.y); o.y = cvt2(x1.z, x1.w); ((GAS v2u*)(ws + WS_X1B) + (size_t)m * 1024 + lane)[64 * (8 * hh + j)] = o; } } }
            rms_row_to_bf16(v, args.in[25], hbuf + (size_t)m * 4096, lane);
        }
    }
    SEAM(6);
    if (IN(7)) _Pragma("unroll") for (int _r = 0; _r < 1 + ((REP_MASK >> 7) & 1); ++_r) {
        pg8::Gemm g{hbuf, Wt_gu, MPAD, 2 * D_FF, 4096, 4096, 4096}; pg8::StaticOrder S; S.init(MPAD, 2 * D_FF, G, (int)blockIdx.x);
        pg8::EpiSwiGLU E{act, D_FF};
        pg8::gemm_phase<pg8::EpiSwiGLU, pg8::StaticOrder, GP_ALIGN, GP_SP2>(lds + RING_OFF, g, S, E);
    }
    SEAM(7);
    if (IN(8)) _Pragma("unroll") for (int _r = 0; _r < 1 + ((REP_MASK >> 8) & 1); ++_r) {
#ifdef OLD_TAILS
        { pg8::Gemm g{act, Wt_dn, MPAD, 4096, D_FF, D_FF, D_FF}; pg8::StaticOrder S; S.init(MPAD, 4096, G, (int)blockIdx.x);
        pg8::EpiBf16Ssq E{hbuf, 4096, ssq};
        pg8::gemm_phase<pg8::EpiBf16Ssq, pg8::StaticOrder, GP_ALIGN, GP_SP2>(lds + RING_OFF, g, S, E); }
#else
        pg8::Gemm g{act, Wt_dn, M_PROMPT, 4096, D_FF, D_FF, D_FF}; pg8::StaticOrder S; S.init(M_PROMPT, 4096, G, (int)blockIdx.x);
        pg8::EpiBf16Ssq E{hbuf, 4096, ssq};
        pg8::gemm_phase<pg8::EpiBf16Ssq, pg8::StaticOrder, GP_ALIGN, GP_SP2>(lds + RING_OFF, g, S, E);
#ifdef REP_G4MAIN
        pg8::gemm_phase<pg8::EpiBf16Ssq, pg8::StaticOrder, GP_ALIGN, GP_SP2>(lds + RING_OFF, g, S, E);
#endif
        pg8::EpiF32Part Et{(float*)(ws + WS_PART4), 4096};
        pg8::Gemm ga{act, Wt_dn, MPAD, 4096, 768, D_FF, D_FF}; pg8::TailOrder Sa{16 * 6, G, (int)blockIdx.x - 160, 0, 768, 0};
        pg8::gemm_phase<pg8::EpiF32Part, pg8::TailOrder, GP_ALIGN, GP_SP2>(lds + RING_OFF, ga, Sa, Et);
        pg8::Gemm gb{act, Wt_dn, MPAD, 4096, 640, D_FF, D_FF}; pg8::TailOrder Sb{16 * 10, G, (int)blockIdx.x < 160 ? (int)blockIdx.x : -1, 4608, 640, 6};
        pg8::gemm_phase<pg8::EpiF32Part, pg8::TailOrder, GP_ALIGN, GP_SP2>(lds + RING_OFF, gb, Sb, Et);
#ifdef REP_G4TAIL
        pg8::gemm_phase<pg8::EpiF32Part, pg8::TailOrder, GP_ALIGN, GP_SP2>(lds + RING_OFF, ga, Sa, Et);
        pg8::gemm_phase<pg8::EpiF32Part, pg8::TailOrder, GP_ALIGN, GP_SP2>(lds + RING_OFF, gb, Sb, Et);
#endif
#endif
    }
    SEAM(8);
    if (IN(9)) _Pragma("unroll") for (int _r = 0; _r < 1 + ((REP_MASK >> 9) & 1); ++_r) {
        for (int m = gw; m < M_REAL; m += NGW) {
            GAS f32x4* orow = (GAS f32x4*)(args.out + O_Y + (size_t)m * 4096) + lane; const GAS v2u* fr = (const GAS v2u*)(hbuf + (size_t)m * 4096) + lane; const GAS f32x4* gr = (const GAS f32x4*)args.in[26] + lane;
            f32x4 f[16]; float s = 0.f;
#ifdef OLD_TAILS
            const bool smp = false;
#else
            const bool smp = m >= M_PROMPT;
#endif
            if (smp) { const GAS f32x4* fs = (const GAS f32x4*)(ws + WS_PART4) + (size_t)(m - M_PROMPT) * 1024 + lane;
#pragma unroll
                for (int j = 0; j < 16; ++j) { f32x4 t[16];
#pragma unroll
                    for (int sp = 0; sp < 16; ++sp) t[sp] = fs[(size_t)sp * 128 * 1024 + 64 * j];
                    const f32x4 a = ((t[0] + t[1]) + (t[2] + t[3])) + ((t[4] + t[5]) + (t[6] + t[7])) + (((t[8] + t[9]) + (t[10] + t[11])) + ((t[12] + t[13]) + (t[14] + t[15])));
                    f[j] = a; s += (a.x * a.x + a.y * a.y) + (a.z * a.z + a.w * a.w); }
            } else {
                v2u fv[16];
#pragma unroll
                for (int j = 0; j < 16; ++j) fv[j] = fr[64 * j];
                s = ssq[(size_t)m * 64 + lane];
#pragma unroll
                for (int j = 0; j < 16; ++j) { f[j].x = __builtin_bit_cast(float, fv[j].x << 16); f[j].y = __builtin_bit_cast(float, fv[j].x & 0xffff0000u); f[j].z = __builtin_bit_cast(float, fv[j].y << 16); f[j].w = __builtin_bit_cast(float, fv[j].y & 0xffff0000u); }
            }
            s = wave_sum(s);
            const float rstd = 1.0f / sqrtf(s * (1.f / 4096.f) + NORM_EPS);
            const GAS v2u* xb = (const GAS v2u*)(ws + WS_X1B) + (size_t)m * 1024 + lane;
#pragma unroll
            for (int hh = 0; hh < 2; ++hh) { f32x4 xv[8], gv[8];
                if (smp) {
#pragma unroll
                    for (int j = 0; j < 8; ++j) { xv[j] = orow[64 * (8 * hh + j)]; gv[j] = gr[64 * (8 * hh + j)]; }
                } else { v2u xq[8];
#pragma unroll
                    for (int j = 0; j < 8; ++j) { xq[j] = xb[64 * (8 * hh + j)]; gv[j] = gr[64 * (8 * hh + j)]; }
#pragma unroll
                    for (int j = 0; j < 8; ++j) { xv[j].x = bflo(xq[j].x); xv[j].y = bfhi(xq[j].x); xv[j].z = bflo(xq[j].y); xv[j].w = bfhi(xq[j].y); } }
#pragma unroll
                for (int j = 0; j < 8; ++j) orow[64 * (8 * hh + j)] = xv[j] + f[8 * hh + j] * rstd * gv[j]; }
        }
    }
#undef IN
#undef SEAM
}

extern "C" void kernel_launch(void* const* d_in, const int* in_sizes, int n_in, void* d_out, int out_size, void* d_ws, size_t ws_size, hipStream_t stream) {
    static int grid = 0;
    if (grid == 0) {
        if (n_in != 30 || out_size != (int)O_END || ws_size < WS_END) { fprintf(stderr, "kernel_launch: unexpected shapes (n_in %d out %d ws %zu)\n", n_in, out_size, ws_size); grid = -1; return; }
        int dev = 0, cus = 0, per_cu = 0;
        if (hipGetDevice(&dev) != hipSuccess || hipDeviceGetAttribute(&cus, hipDeviceAttributeMultiprocessorCount, dev) != hipSuccess) { grid = -1; return; }
        if (hipFuncSetAttribute((const void*)hymba_fwd, hipFuncAttributeMaxDynamicSharedMemorySize, LDS_BYTES) != hipSuccess) { grid = -1; return; }
        if (hipOccupancyMaxActiveBlocksPerMultiprocessor(&per_cu, (const void*)hymba_fwd, NWAVES * 64, LDS_BYTES) != hipSuccess || per_cu < 1) { fprintf(stderr, "kernel_launch: occupancy query says %d\n", per_cu); }
        (void)hipGetLastError();
        grid = cus;
    }
    if (grid < 0) return;
    if (hipMemsetAsync((char*)d_ws + WS_CTL, 0, CTL_ZERO_BYTES, stream) != hipSuccess) return;
    Args a{};
    for (int i = 0; i < 30; ++i) a.in[i] = (const float*)d_in[i];
    a.out = (float*)d_out; a.ws = (unsigned char*)d_ws;
    if (MK_N_LAUNCHES == 1) { a.ph_lo = 0; a.ph_hi = NPH; hipLaunchKernelGGL(hymba_fwd, dim3(grid), dim3(NWAVES * 64), LDS_BYTES, stream, a); }
    else for (int p = 0; p < NPH; ++p) { a.ph_lo = p; a.ph_hi = p + 1; hipLaunchKernelGGL(hymba_fwd, dim3(grid), dim3(NWAVES * 64), LDS_BYTES, stream, a); }
}
```

```cpp
#include <hip/hip_runtime.h>
#include <cstdio>
#include <cstdint>

namespace pg8 {
#define PG8_LAS __attribute__((address_space(3)))
typedef unsigned short bf16_t;
typedef short bf16x8 __attribute__((ext_vector_type(8)));
typedef float f32x4 __attribute__((ext_vector_type(4)));
typedef unsigned u32x4 __attribute__((ext_vector_type(4)));
constexpr int BM = 256, BK = 64, HALF = 128, HTB = HALF * BK * 2  , STAGE_BYTES = 8 * HTB, NXCD = 8, WGM = 8;

__host__ __device__ __forceinline__ int lds_byte(int r, int c) { const int st = (r >> 4) * 2 + (c >> 5), rr = r & 15, cc = c & 31, ob = rr * 64 + cc * 2; return st * 1024 + (ob ^ (((ob >> 9) & 1) << 5)); }
__host__ __device__ __forceinline__ void stage_rc(int b, int& R, int& C) { const int st = b / 1024, sb = b % 1024, swz = sb ^ (((sb >> 9) & 1) << 5); R = (st >> 1) * 16 + swz / 64; C = (st & 1) * 32 + (swz % 64) / 2; }
__host__ __device__ __forceinline__ int perm32(int rho) { const int n = rho >> 4, i = rho & 15; return 8 * (i >> 2) + 4 * n + (i & 3); }

struct Unit { int pm, pn, ko, pi; };
struct Gemm { const bf16_t* A; const bf16_t* Bt; int M, N, K, lda, ldb; };

struct StaticOrder {
    int nM, nN, nwg, G, c;
    __host__ __device__ void init(int M, int N, int G_, int c_) { nM = M / BM; nN = N / BM; nwg = nM * nN; G = G_; c = c_; }
    __host__ __device__ bool next(int i, Unit& u) const {
        const long L = (long)i * G + c; if (L >= nwg) return false;
        int wgid = (int)L; { const int q = nwg / NXCD, r = nwg % NXCD, xcd = wgid % NXCD, off = wgid / NXCD; wgid = (xcd < r ? xcd * (q + 1) : r * (q + 1) + (xcd - r) * q) + off; }
        const int nig = WGM * nN, gid = wgid / nig, fm = gid * WGM, gsz = (nM - fm) < WGM ? (nM - fm) : WGM;
        u.pm = fm + ((wgid % nig) % gsz); u.pn = (wgid % nig) / gsz; u.ko = 0; u.pi = 0; return true;
    }
    __device__ __forceinline__ void a_ready(const Unit&) const {}
    __device__ __forceinline__ void done(const Unit&) const {}
};
__device__ __forceinline__ unsigned cvt_pk_bf16(float lo, float hi) { unsigned r; asm volatile("v_cvt_pk_bf16_f32 %0, %1, %2" : "=v"(r) : "v"(lo), "v"(hi)); return r; }

struct EpiBf16Plain {
    static constexpr bool PERM = true, AFTER_DRAIN = false;
    bf16_t* O; int ldc;
    __device__ __forceinline__ void operator()(const f32x4 (&acc)[2][2][4][2], const Unit& u, int wr, int wc, int fr, int fq) const {
        const int row0 = u.pm * BM + wr * 64 + fr, col0 = u.pn * BM + wc * 32 + 8 * fq;
#pragma unroll
        for (int ai = 0; ai < 2; ++ai)
#pragma unroll
            for (int m = 0; m < 4; ++m) { bf16_t* rowp = O + (size_t)(row0 + ai * HALF + m * 16) * ldc + col0;
#pragma unroll
                for (int bj = 0; bj < 2; ++bj) { const f32x4 v0 = acc[ai][bj][m][0], v1 = acc[ai][bj][m][1];
                    u32x4 w; w.x = cvt_pk_bf16(v0[0], v0[1]); w.y = cvt_pk_bf16(v0[2], v0[3]); w.z = cvt_pk_bf16(v1[0], v1[1]); w.w = cvt_pk_bf16(v1[2], v1[3]);
                    *(u32x4*)(rowp + bj * HALF) = w; } }
    }
};
__device__ __forceinline__ float silu_f(float x) { return x * __builtin_amdgcn_rcpf(1.0f + __expf(-x)); }
struct EpiSwiGLU {
    static constexpr bool PERM = true, AFTER_DRAIN = false;
    bf16_t* O; int ldc;
    __device__ __forceinline__ void operator()(const f32x4 (&acc)[2][2][4][2], const Unit& u, int wr, int wc, int fr, int fq) const {
        const int row0 = u.pm * BM + wr * 64 + fr, col0 = u.pn * HALF + wc * 32 + 8 * fq;
#pragma unroll
        for (int ai = 0; ai < 2; ++ai)
#pragma unroll
            for (int m = 0; m < 4; ++m) { bf16_t* rowp = O + (size_t)(row0 + ai * HALF + m * 16) * ldc + col0;
                const f32x4 g0 = acc[ai][0][m][0], g1 = acc[ai][0][m][1], u0 = acc[ai][1][m][0], u1 = acc[ai][1][m][1];
                u32x4 w; w.x = cvt_pk_bf16(silu_f(g0[0]) * u0[0], silu_f(g0[1]) * u0[1]); w.y = cvt_pk_bf16(silu_f(g0[2]) * u0[2], silu_f(g0[3]) * u0[3]);
                w.z = cvt_pk_bf16(silu_f(g1[0]) * u1[0], silu_f(g1[1]) * u1[1]); w.w = cvt_pk_bf16(silu_f(g1[2]) * u1[2], silu_f(g1[3]) * u1[3]);
                *(u32x4*)rowp = w; }
    }
};
struct EpiF32Ssq {
    static constexpr bool PERM = false, AFTER_DRAIN = false;
    float* C; int ldc; float* ssq; int mreal;
    __device__ __forceinline__ void operator()(const f32x4 (&acc)[2][2][4][2], const Unit& u, int wr, int wc, int fr, int fq) const {
        const int row0 = u.pm * BM + wr * 64 + fr, col0 = u.pn * BM + wc * 32 + 4 * fq;
#pragma unroll
        for (int ai = 0; ai < 2; ++ai)
#pragma unroll
            for (int m = 0; m < 4; ++m) { const int row = row0 + ai * HALF + m * 16; float s = 0.f;
#pragma unroll
                for (int bj = 0; bj < 2; ++bj)
#pragma unroll
                    for (int n = 0; n < 2; ++n) { const f32x4 v = acc[ai][bj][m][n]; s += (v[0] * v[0] + v[1] * v[1]) + (v[2] * v[2] + v[3] * v[3]);
                        if (row < mreal) *(f32x4*)(C + (size_t)row * ldc + col0 + bj * HALF + n * 16) = v; }
                s += __shfl_xor(s, 16); s += __shfl_xor(s, 32);
                if (fq == 0) ssq[(size_t)row * 64 + u.pn * 4 + wc] = s; }
    }
};
struct EpiBf16Ssq {
    static constexpr bool PERM = true, AFTER_DRAIN = false;
    bf16_t* O; int ldc; float* ssq;
    __device__ __forceinline__ void operator()(const f32x4 (&acc)[2][2][4][2], const Unit& u, int wr, int wc, int fr, int fq) const {
        const int row0 = u.pm * BM + wr * 64 + fr, col0 = u.pn * BM + wc * 32 + 8 * fq;
#pragma unroll
        for (int ai = 0; ai < 2; ++ai)
#pragma unroll
            for (int m = 0; m < 4; ++m) { const int row = row0 + ai * HALF + m * 16; bf16_t* rowp = O + (size_t)row * ldc + col0; float s = 0.f;
#pragma unroll
                for (int bj = 0; bj < 2; ++bj) { const f32x4 v0 = acc[ai][bj][m][0], v1 = acc[ai][bj][m][1];
                    s += (v0[0] * v0[0] + v0[1] * v0[1]) + (v0[2] * v0[2] + v0[3] * v0[3]) + (v1[0] * v1[0] + v1[1] * v1[1]) + (v1[2] * v1[2] + v1[3] * v1[3]);
                    u32x4 w; w.x = cvt_pk_bf16(v0[0], v0[1]); w.y = cvt_pk_bf16(v0[2], v0[3]); w.z = cvt_pk_bf16(v1[0], v1[1]); w.w = cvt_pk_bf16(v1[2], v1[3]);
                    *(u32x4*)(rowp + bj * HALF) = w; }
                s += __shfl_xor(s, 16); s += __shfl_xor(s, 32);
                if (fq == 0) ssq[(size_t)row * 64 + u.pn * 4 + wc] = s; }
    }
};
struct EpiF32Part {
    static constexpr bool PERM = false, AFTER_DRAIN = false;
    float* P; int ldc;
    __device__ __forceinline__ void operator()(const f32x4 (&acc)[2][2][4][2], const Unit& u, int wr, int wc, int fr, int fq) const {
        const int rowl = wr * 64 + fr, col0 = u.pn * BM + wc * 32 + 4 * fq; float* base = P + (size_t)u.pi * 128 * ldc;
#pragma unroll
        for (int m = 0; m < 4; ++m)
#pragma unroll
            for (int bj = 0; bj < 2; ++bj)
#pragma unroll
                for (int n = 0; n < 2; ++n) *(f32x4*)(base + (size_t)(rowl + m * 16) * ldc + col0 + bj * HALF + n * 16) = acc[0][bj][m][n];
    }
};
struct TailOrder {
    int nsub, G, c, kbase, klen, pbase;
    __device__ bool next(int i, Unit& u) const { const int idx = i * G + c; if (c < 0 || idx >= nsub) return false; const int sp = idx >> 4; u.pm = 64; u.pn = idx & 15; u.ko = kbase + sp * klen; u.pi = pbase + sp; return true; }
    __device__ __forceinline__ void a_ready(const Unit&) const {}
    __device__ __forceinline__ void done(const Unit&) const {}
};
struct SubsetOrder {
    int nN, nunits, nw, c;
    __device__ bool next(int i, Unit& u) const { const int idx = i * nw + c; if (c < 0 || idx >= nunits) return false; u.pm = idx / nN; u.pn = idx - u.pm * nN; u.ko = 0; u.pi = 0; return true; }
    __device__ __forceinline__ void a_ready(const Unit&) const {}
    __device__ __forceinline__ void done(const Unit&) const {}
};
template <class Epi, class Sched, bool ALIGN_EPI = false, bool SP2 = false>
__device__ __forceinline__ void gemm_phase(PG8_LAS unsigned char* lds, const Gemm g, const Sched& S, const Epi& E) {
    const int tid = threadIdx.x, wid = __builtin_amdgcn_readfirstlane(tid >> 6), lane = tid & 63, wr = wid >> 2, wc = wid & 3, fr = lane & 15, fq = lane >> 4;
    const int K = g.K, nt = K / BK;
    unsigned voffA[2], voffB[2];
#pragma unroll
    for (int i = 0; i < 2; ++i) { int R, C; stage_rc(tid * 16 + i * 8192, R, C); const int Rb = Epi::PERM ? ((R & ~31) + perm32(R & 31)) : R;
        voffA[i] = (unsigned)(R * g.lda + C) * 2u; voffB[i] = (unsigned)(Rb * g.ldb + C) * 2u; }
    const size_t kstep = (size_t)(BK * 2);
    const size_t hstepA = (size_t)HALF * g.lda * 2, hstepB = (size_t)HALF * g.ldb * 2;
    const size_t tstepA = 2 * hstepA, tstepB = 2 * hstepB;
    const unsigned ldsw = (unsigned)wid * 1024u;
    const int aoff = lds_byte(wr * 64 + fr, fq * 8), boff = lds_byte(wc * 32 + fr, fq * 8);
#define PG8_SA(b, h) (((b) * 2 + (h)) * HTB)
#define PG8_SB(b, h) ((4 + (b) * 2 + (h)) * HTB)
#define PG8_STAGE(bufoff, gbase, voff) do { _Pragma("unroll") for (int _i = 0; _i < 2; ++_i) \
        __builtin_amdgcn_global_load_lds((const unsigned*)((const char*)(gbase) + (voff)[_i]), (PG8_LAS unsigned*)(lds + (bufoff) + ldsw + _i * 8192), 16, 0, 0); } while (0)
#define PG8_LDA(dst, b, h) do { _Pragma("unroll") for (int m = 0; m < 4; ++m) _Pragma("unroll") for (int k = 0; k < 2; ++k) dst[m][k] = *(const PG8_LAS bf16x8*)(lds + PG8_SA(b, h) + aoff + m * 2048 + k * 1024); } while (0)
#define PG8_LDB(dst, b, h) do { _Pragma("unroll") for (int n = 0; n < 2; ++n) _Pragma("unroll") for (int k = 0; k < 2; ++k) dst[n][k] = *(const PG8_LAS bf16x8*)(lds + PG8_SB(b, h) + boff + n * 2048 + k * 1024); } while (0)
#define PG8_MMA(ai, bj, At, Bt) do { __builtin_amdgcn_s_setprio(1); _Pragma("unroll") for (int m = 0; m < 4; ++m) _Pragma("unroll") for (int n = 0; n < 2; ++n) _Pragma("unroll") for (int k = 0; k < 2; ++k) \
        acc[ai][bj][m][n] = __builtin_amdgcn_mfma_f32_16x16x32_bf16(Bt[n][k], At[m][k], acc[ai][bj][m][n], 0, 0, 0); __builtin_amdgcn_s_setprio(0); } while (0)
#define PG8_WAIT_V(n) asm volatile("s_waitcnt vmcnt(" #n ")" ::: "memory")
#define PG8_WAIT_L(n) asm volatile("s_waitcnt lgkmcnt(" #n ")" ::: "memory")
#define PG8_BAR __builtin_amdgcn_s_barrier()
#define PG8_SCHED __builtin_amdgcn_sched_barrier(0)
    Unit cur, nxt; int ui = 0;
    if (!S.next(0, cur)) return;
    f32x4 acc[2][2][4][2];
#pragma unroll
    for (int a = 0; a < 2; ++a)
#pragma unroll
        for (int b = 0; b < 2; ++b)
#pragma unroll
            for (int m = 0; m < 4; ++m)
#pragma unroll
                for (int n = 0; n < 2; ++n) acc[a][b][m][n] = (f32x4){0.f, 0.f, 0.f, 0.f};
    bf16x8 At[4][2], B0[2][2], B1[2][2];
    const char* cA = (const char*)g.A + (size_t)cur.pm * tstepA + (size_t)cur.ko * 2; const char* cB = (const char*)g.Bt + (size_t)cur.pn * tstepB + (size_t)cur.ko * 2;
    S.a_ready(cur);
    if constexpr (SP2) {
        PG8_STAGE(PG8_SB(0, 0), cB, voffB); PG8_STAGE(PG8_SB(0, 1), cB + hstepB, voffB); PG8_STAGE(PG8_SA(0, 0), cA, voffA); PG8_STAGE(PG8_SA(0, 1), cA + hstepA, voffA);
        if (wr == 1) PG8_BAR;
        PG8_WAIT_V(2); PG8_BAR;
        PG8_STAGE(PG8_SB(1, 0), cB + kstep, voffB); PG8_STAGE(PG8_SA(1, 0), cA + kstep, voffA); PG8_STAGE(PG8_SB(1, 1), cB + hstepB + kstep, voffB);
        PG8_WAIT_V(6); PG8_BAR;
    } else {
        PG8_STAGE(PG8_SB(0, 0), cB, voffB); PG8_STAGE(PG8_SA(0, 0), cA, voffA); PG8_STAGE(PG8_SB(0, 1), cB + hstepB, voffB); PG8_STAGE(PG8_SA(0, 1), cA + hstepA, voffA);
        if (wr == 1) PG8_BAR;
        PG8_WAIT_V(4); PG8_BAR;
        PG8_STAGE(PG8_SB(1, 0), cB + kstep, voffB); PG8_STAGE(PG8_SA(1, 0), cA + kstep, voffA); PG8_STAGE(PG8_SB(1, 1), cB + hstepB + kstep, voffB);
        PG8_WAIT_V(6); PG8_BAR;
    }
    for (;;) {
        const bool has_next = S.next(ui + 1, nxt);
        const char* nA = has_next ? (const char*)g.A + (size_t)nxt.pm * tstepA + (size_t)nxt.ko * 2 : cA; const char* nB = has_next ? (const char*)g.Bt + (size_t)nxt.pn * tstepB + (size_t)nxt.ko * 2 : cB;
        for (int t = 0; t < nt; t += 2) {
            const bool last = (t == nt - 2);
            const char* a1 = cA + (size_t)(t + 1) * kstep;
            const char* a2 = last ? nA : cA + (size_t)(t + 2) * kstep; const char* b2 = last ? nB : cB + (size_t)(t + 2) * kstep;
            const char* a3 = a2 + kstep; const char* b3 = b2 + kstep;
            if (last && has_next) S.a_ready(nxt);
            if constexpr (SP2) {
            PG8_LDB(B0, 0, 0); PG8_LDB(B1, 0, 1); PG8_SCHED; PG8_LDA(At, 0, 0); PG8_STAGE(PG8_SA(1, 1), a1 + hstepA, voffA);
            PG8_WAIT_V(8); PG8_WAIT_L(0); PG8_BAR; PG8_MMA(0, 0, At, B0); PG8_MMA(0, 1, At, B1); PG8_BAR; PG8_SCHED;
            PG8_LDA(At, 0, 1); PG8_STAGE(PG8_SB(0, 0), b2, voffB); PG8_STAGE(PG8_SB(0, 1), b2 + hstepB, voffB); PG8_STAGE(PG8_SA(0, 0), a2, voffA);
            PG8_WAIT_V(8); PG8_WAIT_L(0); PG8_BAR; PG8_MMA(1, 0, At, B0); PG8_MMA(1, 1, At, B1); PG8_BAR; PG8_SCHED;
            PG8_LDB(B0, 1, 0); PG8_LDB(B1, 1, 1); PG8_SCHED; PG8_LDA(At, 1, 0); PG8_STAGE(PG8_SA(0, 1), a2 + hstepA, voffA);
            PG8_WAIT_V(8); PG8_WAIT_L(0); PG8_BAR; PG8_MMA(0, 0, At, B0); PG8_MMA(0, 1, At, B1); PG8_BAR; PG8_SCHED;
            PG8_LDA(At, 1, 1); PG8_STAGE(PG8_SB(1, 0), b3, voffB); PG8_STAGE(PG8_SB(1, 1), b3 + hstepB, voffB); PG8_STAGE(PG8_SA(1, 0), a3, voffA);
            PG8_WAIT_V(8); PG8_WAIT_L(0); PG8_BAR; PG8_MMA(1, 0, At, B0); PG8_MMA(1, 1, At, B1); PG8_BAR; PG8_SCHED;
            } else {
            PG8_LDB(B0, 0, 0); PG8_SCHED; PG8_LDA(At, 0, 0); PG8_STAGE(PG8_SA(1, 1), a1 + hstepA, voffA);
            PG8_WAIT_L(8); PG8_BAR; PG8_WAIT_L(0); PG8_MMA(0, 0, At, B0); PG8_BAR; PG8_SCHED;
            PG8_LDB(B1, 0, 1); PG8_STAGE(PG8_SB(0, 0), b2, voffB);
            PG8_BAR; PG8_WAIT_L(0); PG8_MMA(0, 1, At, B1); PG8_BAR;
            PG8_LDA(At, 0, 1); PG8_STAGE(PG8_SA(0, 0), a2, voffA);
            PG8_BAR; PG8_WAIT_L(0); PG8_MMA(1, 0, At, B0); PG8_BAR; PG8_SCHED;
            PG8_STAGE(PG8_SB(0, 1), b2 + hstepB, voffB);
            PG8_WAIT_V(6); PG8_BAR; PG8_MMA(1, 1, At, B1); PG8_BAR;
            PG8_LDB(B0, 1, 0); PG8_SCHED; PG8_LDA(At, 1, 0); PG8_STAGE(PG8_SA(0, 1), a2 + hstepA, voffA);
            PG8_WAIT_L(8); PG8_BAR; PG8_WAIT_L(0); PG8_MMA(0, 0, At, B0); PG8_BAR; PG8_SCHED;
            PG8_LDB(B1, 1, 1); PG8_STAGE(PG8_SB(1, 0), b3, voffB);
            PG8_BAR; PG8_WAIT_L(0); PG8_MMA(0, 1, At, B1); PG8_BAR;
            PG8_LDA(At, 1, 1); PG8_STAGE(PG8_SA(1, 0), a3, voffA);
            PG8_BAR; PG8_WAIT_L(0); PG8_MMA(1, 0, At, B0); PG8_BAR; PG8_SCHED;
            PG8_STAGE(PG8_SB(1, 1), b3 + hstepB, voffB);
            PG8_WAIT_V(6); PG8_BAR; PG8_MMA(1, 1, At, B1); PG8_BAR;
            }
        }
        if constexpr (ALIGN_EPI) { if (wr == 0) PG8_BAR; }
        if constexpr (!Epi::AFTER_DRAIN) { E(acc, cur, wr, wc, fr, fq); S.done(cur); }
        if (!has_next) break;
#pragma unroll
        for (int a = 0; a < 2; ++a)
#pragma unroll
            for (int b = 0; b < 2; ++b)
#pragma unroll
                for (int m = 0; m < 4; ++m)
#pragma unroll
                    for (int n = 0; n < 2; ++n) acc[a][b][m][n] = (f32x4){0.f, 0.f, 0.f, 0.f};
        cur = nxt; cA = nA; cB = nB; ++ui;
        if constexpr (ALIGN_EPI) { if (wr == 1) PG8_BAR; }
    }
    PG8_WAIT_V(0);
    if constexpr (!ALIGN_EPI) { if (wr == 0) PG8_BAR; }
    PG8_BAR;
    if constexpr (Epi::AFTER_DRAIN) { E.fused(acc, cur, wr, wc, fr, fq, lds, wid, lane); S.done(cur); }
#undef PG8_SA
#undef PG8_SB
#undef PG8_STAGE
#undef PG8_LDA
#undef PG8_LDB
#undef PG8_MMA
#undef PG8_WAIT_V
#undef PG8_WAIT_L
#undef PG8_BAR
#undef PG8_SCHED
}
}

constexpr int NWAVES = 8;
constexpr int D_MODEL = 4096, SEQ = 8192, DEC_SEQ = 16;
constexpr int M_PROMPT = 16384, M_REAL = 16512, MPAD = 16640;
constexpr int IN_W = 14816, IN_WP = 14848, D_FF = 11008;
constexpr int PC_Q = 0, PC_K = 2048, PC_V = 4096, PC_Z = 6144, PC_B = 8192, PC_A = 8208, PC_RW = 8224;
constexpr int RW_R = 0, RW_K = 2048, RW_V = 4096, RW_XW = 6144, RW_XA = 6240, RW_XG = 6336, RW_SHIFT_W = 6592;
constexpr float NORM_EPS = 1e-6f, RW_GN_EPS = 64e-5f;
constexpr size_t O_Y = 0, O_SDN_P = 67633152, O_CONV_P = 68157440, O_SRW_P = 68194304, O_SHIFT_P = 68456448,
                 O_SDN_S = 68469632, O_CONV_S = 70566784, O_SRW_S = 70714240, O_SHIFT_S = 71762816, O_END = 71815552;
constexpr size_t MiB = 1u << 20;
constexpr size_t WS_CTL = 0, CTL_ZERO_BYTES = 1 * MiB;
constexpr size_t WS_SSQ = 2 * MiB;
constexpr size_t WS_W2T = 6553600, WS_A2T = WS_W2T + 2048 * 96 * 2, WS_G2T = 7 * MiB;
constexpr size_t WS_WOUT = 8 * MiB;
constexpr size_t WS_HBUF = 40 * MiB;
constexpr size_t WS_PROJ = 170 * MiB;
constexpr size_t WS_WIN = 642 * MiB;
constexpr size_t WS_WGU = 758 * MiB;
constexpr size_t WS_WDN = 930 * MiB;
constexpr size_t WS_END = 1016 * MiB;
constexpr size_t WS_X1B = 520 * MiB;
constexpr size_t WS_PART2 = 710 * MiB, WS_PART4 = 678 * MiB;
constexpr size_t WS_SXG = 742 * MiB;
constexpr size_t WS_DNQK = 642 * MiB, WS_DNGL = 674 * MiB, WS_RWSB = 675 * MiB, WS_RWOO = 678 * MiB, WS_RWPQ = 758 * MiB, WS_RWRP = 886 * MiB;
static_assert(WS_SSQ + (size_t)MPAD * 64 * 4 <= WS_WOUT && WS_HBUF + (size_t)MPAD * 4096 * 2 <= WS_PROJ && WS_PROJ + (size_t)MPAD * IN_WP * 2 <= WS_WIN &&
              WS_WIN + (size_t)IN_WP * 4096 * 2 <= WS_WGU && WS_WGU + (size_t)2 * D_FF * 4096 * 2 <= WS_WDN && WS_WDN + (size_t)4096 * D_FF * 2 <= WS_END, "d_ws map");
constexpr int CW_BAR = 4096;
constexpr int RING_OFF = 0, RING_BYTES = 131072;
constexpr int LDSCTL_OFF = RING_BYTES, MISC_OFF = LDSCTL_OFF + 320;
constexpr int LDS_BYTES = 147456;

#define GAS __attribute__((address_space(1)))
#define LAS __attribute__((address_space(3)))
typedef unsigned short bf16;
typedef unsigned v4u __attribute__((ext_vector_type(4)));
typedef unsigned v2u __attribute__((ext_vector_type(2)));
typedef float f32x4 __attribute__((ext_vector_type(4)));
typedef GAS unsigned gu32;
#define RLX_AGENT __ATOMIC_RELAXED, __HIP_MEMORY_SCOPE_AGENT
#define LDS_WAIT() asm volatile("s_waitcnt lgkmcnt(0)" ::: "memory")
__device__ __forceinline__ unsigned f2bf(float f) { unsigned u = __builtin_bit_cast(unsigned, f); return (u + 0x7fffu + ((u >> 16) & 1u)) >> 16; }
__device__ __forceinline__ unsigned pk2(float lo, float hi) { return f2bf(lo) | (f2bf(hi) << 16); }
__device__ __forceinline__ float bf2f(bf16 b) { return __builtin_bit_cast(float, (unsigned)b << 16); }
__device__ __forceinline__ float bflo(unsigned u) { return __builtin_bit_cast(float, u << 16); }
__device__ __forceinline__ float bfhi(unsigned u) { return __builtin_bit_cast(float, u & 0xffff0000u); }
#ifdef OLD_WAVE_SUM
__device__ __forceinline__ float wave_sum(float v) {
#pragma unroll
    for (int o = 1; o < 64; o <<= 1) v += __shfl_xor(v, o);
    return v;
}
#else
#define WS_DPP(x, ctrl, rmask) __builtin_bit_cast(float, __builtin_amdgcn_update_dpp(0, __builtin_bit_cast(int, (x)), (ctrl), (rmask), 0xf, true))
__device__ __forceinline__ float wave_sum(float v) {
    v += WS_DPP(v, 0xB1, 0xf); v += WS_DPP(v, 0x4E, 0xf); v += WS_DPP(v, 0x141, 0xf); v += WS_DPP(v, 0x140, 0xf);
    v += WS_DPP(v, 0x142, 0xa); v += WS_DPP(v, 0x143, 0xc);
    return __builtin_bit_cast(float, __builtin_amdgcn_readlane(__builtin_bit_cast(int, v), 63));
}
#endif
#ifdef OLD_MATH
__device__ __forceinline__ float sigmoid_f(float x) { return 1.0f / (1.0f + __expf(-x)); }
__device__ __forceinline__ float softplus_f(float x) { return x > 20.f ? x : log1pf(__expf(x)); }
#else
__device__ __forceinline__ float sigmoid_f(float x) { return __builtin_amdgcn_rcpf(1.0f + __expf(-x)); }
__device__ __forceinline__ float softplus_f(float x) { return x > 20.f ? x : __logf(1.0f + __expf(x)); }
#endif
__device__ __forceinline__ void wave_sum8(float (&v)[8]) {
#pragma unroll
    for (int o = 1; o < 64; o <<= 1) {
#pragma unroll
        for (int i = 0; i < 8; ++i) v[i] += __shfl_xor(v[i], o); }
}

#define XB_TMO      128
#define XB_XCNT(j)  (256  + 64 * (j))
#define XB_XSUB(j)  (1280 + 64 * (j))
#define XB_XGEN(j)  (2304 + 64 * (j))
#define XB_TOP      3328
#define XB_TOPGEN   3392
#define XCD_BAR_WORDS 3456
#define XB_SPIN_CAP (1u << 18)

__device__ __forceinline__ unsigned xb_ld(unsigned* p)              { return __hip_atomic_load(p, __ATOMIC_RELAXED, __HIP_MEMORY_SCOPE_AGENT); }
__device__ __forceinline__ unsigned xb_add(unsigned* p, unsigned v) { return __hip_atomic_fetch_add(p, v, __ATOMIC_RELAXED, __HIP_MEMORY_SCOPE_AGENT); }
__device__ __forceinline__ unsigned xb_xcc_id() { return (unsigned)__builtin_amdgcn_s_getreg((3 << 11) | 20) & 0xFu; }
#define XB_SPIN(cond, bar) do { unsigned _sp = 0; while (cond) { __builtin_amdgcn_s_sleep(1); \
    if ((++_sp & 255u) == 0u) { if (xb_ld(&(bar)[XB_TMO])) break; if (_sp > XB_SPIN_CAP) { atomicAdd(&(bar)[XB_TMO], 1u); break; } } } } while (0)

struct XcdBarrier {
    unsigned* bar; unsigned x;
    volatile LAS unsigned* st;
};

__device__ __forceinline__ XcdBarrier xcd_barrier_post(unsigned* bar, volatile LAS unsigned* st) {
    XcdBarrier b; b.bar = bar; b.x = xb_xcc_id(); b.st = st;
    if (threadIdx.x == 0) (void)xb_add(&bar[XB_XCNT(b.x)], 1u);
    return b;
}
__device__ __forceinline__ void xcd_barrier_complete(unsigned* bar, unsigned x, unsigned& nloc, unsigned& nx) {
    const unsigned G = gridDim.x * gridDim.y * gridDim.z;
    unsigned sum, cnt, mine, sp = 0u;
    for (;;) {
        sum = 0u; cnt = 0u; mine = 0u;
#pragma unroll
        for (unsigned j = 0; j < 16; ++j) { const unsigned c = xb_ld(&bar[XB_XCNT(j)]); sum += c; cnt += (c > 0u) ? 1u : 0u; mine = (j == x) ? c : mine; }
        if (sum == G) break;
        __builtin_amdgcn_s_sleep(1);
        if ((++sp & 255u) == 0u) { if (xb_ld(&bar[XB_TMO])) break; if (sp > XB_SPIN_CAP) { atomicAdd(&bar[XB_TMO], 1u); break; } }
    }
    nloc = mine > 0u ? mine : 1u; nx = cnt > 0u ? cnt : 1u;
}

__device__ __forceinline__ void xcd_barrier(const XcdBarrier& b) {
    asm volatile("s_waitcnt vmcnt(0)" ::: "memory");
    __syncthreads();
    if (threadIdx.x == 0) {
        unsigned* bar = b.bar;
        __builtin_amdgcn_s_waitcnt(0);
        unsigned nloc = b.st[0], nx = b.st[1];
        if (nloc == 0u) { xcd_barrier_complete(bar, b.x, nloc, nx); b.st[0] = nloc; b.st[1] = nx; }
        const unsigned old = xb_add(&bar[XB_XSUB(b.x)], 1u);
        const unsigned gen = old / nloc;
        if (old + 1u == (gen + 1u) * nloc) {
            __builtin_amdgcn_fence(__ATOMIC_RELEASE, "agent");
            asm volatile("s_waitcnt vmcnt(0)" ::: "memory");
            const unsigned og = xb_add(&bar[XB_TOP], 1u);
            const unsigned tg = og / nx;
            if (og + 1u == (tg + 1u) * nx) xb_add(&bar[XB_TOPGEN], 1u);
            else XB_SPIN(xb_ld(&bar[XB_TOPGEN]) == tg, bar);
            __builtin_amdgcn_fence(__ATOMIC_ACQUIRE, "agent");
            xb_add(&bar[XB_XGEN(b.x)], 1u);
            asm volatile("s_waitcnt vmcnt(0)" ::: "memory");
        } else {
            XB_SPIN(xb_ld(&bar[XB_XGEN(b.x)]) == gen, bar);
            __builtin_amdgcn_fence(__ATOMIC_ACQUIRE, "agent");
            asm volatile("s_waitcnt vmcnt(0)" ::: "memory");
        }
    }
    __syncthreads();
}

struct Frame {
    LAS unsigned char* lds;
    volatile LAS unsigned* MISC;
    gu32* ctl;
    int tid, lane, wave, G;
    const float* const* in;
};
struct Args { const float* in[30]; float* out; unsigned char* ws; int ph_lo, ph_hi; };

template <class RowMap>
__device__ __forceinline__ void p0_transpose_item(const float* W, int K, int N, bf16* WT, LAS float* scr, int item, int lane, RowMap rm) {
    const int nblk = N / 32, kb = item / nblk, nb = item % nblk, k0 = 64 * kb, n0 = 32 * nb;
#pragma unroll 8
    for (int i = 0; i < 32; ++i) { const int kk = 2 * i + (lane >> 5); scr[kk * 33 + (lane & 31)] = W[(size_t)(k0 + kk) * N + n0 + (lane & 31)]; }
    LDS_WAIT(); asm volatile("" ::: "memory");
    const int c = lane & 7;
#pragma unroll
    for (int j = 0; j < 4; ++j) { const int n = (lane >> 3) + 8 * j; const LAS float* s = scr + (8 * c) * 33 + n;
        v4u o; o.x = pk2(s[0 * 33], s[1 * 33]); o.y = pk2(s[2 * 33], s[3 * 33]); o.z = pk2(s[4 * 33], s[5 * 33]); o.w = pk2(s[6 * 33], s[7 * 33]);
        *(GAS v4u*)(WT + (size_t)rm(n0 + n) * K + k0 + 8 * c) = o; }
    LDS_WAIT(); asm volatile("" ::: "memory");
}
struct RmId { __device__ __forceinline__ int operator()(int n) const { return n; } };
struct RmGU { int up; __device__ __forceinline__ int operator()(int n) const { return (n >> 7) * 256 + up * 128 + (n & 127); } };

__device__ __forceinline__ void rms_row_to_bf16(const f32x4 (&v)[16], const float* g, bf16* orow, int lane) {
    float s = 0.f;
#pragma unroll
    for (int j = 0; j < 16; ++j) s += (v[j].x * v[j].x + v[j].y * v[j].y) + (v[j].z * v[j].z + v[j].w * v[j].w);
    const float rstd = 1.0f / sqrtf(wave_sum(s) * (1.f / 4096.f) + NORM_EPS);
    const GAS f32x4* gr = (const GAS f32x4*)g + lane; GAS v2u* o8 = (GAS v2u*)orow + lane;
#pragma unroll
    for (int hh = 0; hh < 2; ++hh) { f32x4 gv[8];
#pragma unroll
        for (int j = 0; j < 8; ++j) gv[j] = gr[64 * (8 * hh + j)];
#pragma unroll
        for (int j = 0; j < 8; ++j) { const f32x4 x = v[8 * hh + j]; v2u o; o.x = pk2(x.x * rstd * gv[j].x, x.y * rstd * gv[j].y); o.y = pk2(x.z * rstd * gv[j].z, x.w * rstd * gv[j].w); o8[64 * (8 * hh + j)] = o; } }
}

struct MixPtrs {
    const bf16* proj; bf16* mix;
    const float *state_dn, *cache_conv, *state_rw, *cache_shift;
    const float *conv_w, *a_log, *dt_bias, *dn_norm_w;
    const float *mu, *w0, *w2, *a0, *a2, *g2, *k_k, *k_a, *r_k, *ln_w, *ln_b;
    float* out;
};
__device__ __forceinline__ void dn_seq_item(const MixPtrs& P, LAS unsigned char* lds, int seq, int h, int tid, int lane, int wave) {
    const bool prm = seq < 2;
    const int T = prm ? SEQ : DEC_SEQ, sb = prm ? seq : seq - 2;
    const int m0 = prm ? seq * SEQ : M_PROMPT + sb * DEC_SEQ;
    const float* S0 = prm ? nullptr : P.state_dn + ((size_t)sb * 16 + h) * 16384;
    const float* cbuf = prm ? nullptr : P.cache_conv + (size_t)sb * 3 * 6144;
    float* Sout = P.out + (prm ? O_SDN_P : O_SDN_S) + ((size_t)sb * 16 + h) * 16384;
    float* cout = P.out + (prm ? O_CONV_P : O_CONV_S) + (size_t)sb * 3 * 6144;
    LAS float* qs = (LAS float*)lds; LAS float* ks = qs + 2048; LAS float* vs = ks + 2048; LAS float* zs = vs + 2048; LAS float* os = zs + 2048; LAS float* bet = os + 2048; LAS float* gg = bet + 16;
    float S[32];
    const int e = wave * 16 + (lane >> 2), dq = lane & 3;
#pragma unroll
    for (int j = 0; j < 32; ++j) S[j] = (S0 != nullptr) ? S0[(32 * dq + j) * 128 + e] : 0.f;
    const float Ah = -__expf(P.a_log[h]), dtb = P.dt_bias[h];
    for (int tb = 0; tb < T; tb += 16) {
        for (int i = tid; i < 16 * 384; i += 512) { const int t = i / 384, cc = i - t * 384, sec = cc >> 7, d = cc & 127, col = sec * 2048 + h * 128 + d;
            float acc = 0.f;
#pragma unroll
            for (int j = 0; j < 4; ++j) { const int tt = tb + t - 3 + j; float xv;
                if (tt >= 0) xv = bf2f(P.proj[(size_t)(m0 + tt) * IN_WP + col]); else xv = cbuf ? cbuf[(3 + tt) * 6144 + col] : 0.f;
                acc += xv * P.conv_w[j * 6144 + col]; }
            const float y = acc * sigmoid_f(acc);
            (sec == 0 ? qs : (sec == 1 ? ks : vs))[t * 128 + d] = y; }
        for (int i = tid; i < 16 * 128; i += 512) { const int t = i >> 7, d = i & 127; zs[i] = bf2f(P.proj[(size_t)(m0 + tb + t) * IN_WP + PC_Z + h * 128 + d]); }
        if (tid < 16) { const size_t r = (size_t)(m0 + tb + tid) * IN_WP; const float b = bf2f(P.proj[r + PC_B + h]), a = bf2f(P.proj[r + PC_A + h]);
            bet[tid] = sigmoid_f(b); gg[tid] = Ah * softplus_f(a + dtb); }
        __syncthreads();
#pragma unroll
        for (int r = 0; r < 2; ++r) { const int t = 2 * wave + r;
            const float q0 = qs[t * 128 + lane], q1 = qs[t * 128 + 64 + lane], k0 = ks[t * 128 + lane], k1 = ks[t * 128 + 64 + lane];
            const float sq = wave_sum(q0 * q0 + q1 * q1), sk = wave_sum(k0 * k0 + k1 * k1);
            const float cq = 0.08838834764831845f / sqrtf(sq + 1e-6f), ck = 1.0f / sqrtf(sk + 1e-6f);
            qs[t * 128 + lane] = q0 * cq; qs[t * 128 + 64 + lane] = q1 * cq; ks[t * 128 + lane] = k0 * ck; ks[t * 128 + 64 + lane] = k1 * ck; }
        __syncthreads();
        {
#pragma unroll 1
            for (int t = 0; t < 16; ++t) {
                const float eg = __expf(gg[t]), bt = bet[t];
                float kS = 0.f;
#pragma unroll
                for (int d4 = 0; d4 < 8; ++d4) { const f32x4 kv = *(const LAS f32x4*)(ks + t * 128 + 32 * dq + 4 * d4);
                    kS += kv.x * S[4 * d4] + kv.y * S[4 * d4 + 1] + kv.z * S[4 * d4 + 2] + kv.w * S[4 * d4 + 3]; }
                kS += __shfl_xor(kS, 1); kS += __shfl_xor(kS, 2);
                const float w = bt * (vs[t * 128 + e] - eg * kS);
                float o = 0.f;
#pragma unroll
                for (int d4 = 0; d4 < 8; ++d4) { const f32x4 kv = *(const LAS f32x4*)(ks + t * 128 + 32 * dq + 4 * d4); const f32x4 qv = *(const LAS f32x4*)(qs + t * 128 + 32 * dq + 4 * d4);
                    S[4 * d4] = eg * S[4 * d4] + kv.x * w; S[4 * d4 + 1] = eg * S[4 * d4 + 1] + kv.y * w; S[4 * d4 + 2] = eg * S[4 * d4 + 2] + kv.z * w; S[4 * d4 + 3] = eg * S[4 * d4 + 3] + kv.w * w;
                    o += qv.x * S[4 * d4] + qv.y * S[4 * d4 + 1] + qv.z * S[4 * d4 + 2] + qv.w * S[4 * d4 + 3]; }
                o += __shfl_xor(o, 1); o += __shfl_xor(o, 2);
                if (dq == 0) os[t * 128 + e] = o;
            }
        }
        __syncthreads();
#pragma unroll
        for (int r = 0; r < 2; ++r) { const int t = 2 * wave + r;
            const float o0 = os[t * 128 + lane], o1 = os[t * 128 + 64 + lane];
            const float rs = 1.0f / sqrtf(wave_sum(o0 * o0 + o1 * o1) * (1.f / 128.f) + NORM_EPS);
            const float z0 = zs[t * 128 + lane], z1 = zs[t * 128 + 64 + lane];
            bf16* mp = P.mix + (size_t)(m0 + tb + t) * 4096 + h * 128;
            mp[lane] = (bf16)f2bf(o0 * rs * P.dn_norm_w[lane] * (z0 * sigmoid_f(z0))); mp[64 + lane] = (bf16)f2bf(o1 * rs * P.dn_norm_w[64 + lane] * (z1 * sigmoid_f(z1))); }
        __syncthreads();
    }
    { int so = 32 * dq * 128 + e;
#ifndef NO_LAUNDER
    asm volatile("" : "+v"(so));
#endif

#pragma unroll
    for (int j = 0; j < 32; ++j) Sout[so + j * 128] = S[j]; }
    for (int i = tid; i < 3 * 384; i += 512) { const int r = i / 384, cc = i - r * 384, col = (cc >> 7) * 2048 + h * 128 + (cc & 127);
        cout[r * 6144 + col] = bf2f(P.proj[(size_t)(m0 + T - 3 + r) * IN_WP + col]); }
}
__device__ __forceinline__ void rw_seq_item(const MixPtrs& P, const bf16* w2T_, const bf16* a2T_, const bf16* g2T_, LAS unsigned char* lds, int seq, int h, int tid, int lane, int wave) {
    const bool prm = seq < 2;
    const int T = prm ? SEQ : DEC_SEQ, sb = prm ? seq : seq - 2;
    const int m0 = prm ? seq * SEQ : M_PROMPT + sb * DEC_SEQ;
    const float* S0 = prm ? nullptr : P.state_rw + ((size_t)sb * 32 + h) * 4096;
    const float* sbuf = prm ? nullptr : P.cache_shift + (size_t)sb * RW_SHIFT_W;
    float* Sout = P.out + (prm ? O_SRW_P : O_SRW_S) + ((size_t)sb * 32 + h) * 4096;
    float* shout = P.out + (prm ? O_SHIFT_P : O_SHIFT_S) + (size_t)sb * RW_SHIFT_W;
    LAS float* rs = (LAS float*)lds; LAS float* kr = rs + 1024; LAS float* vs = kr + 1024; LAS float* xw = vs + 1024; LAS float* xa = xw + 1536; LAS float* xg = xa + 1536;
    LAS float* wd = xg + 4096; LAS float* kp = wd + 1024; LAS float* av = kp + 1024; LAS float* bv = av + 1024; LAS float* gt = bv + 1024; LAS float* ys = gt + 1024; LAS float* sbn = ys + 1024;
    float S[16];
    const int vr = (wave & 3) * 16 + (lane >> 2), kq = lane & 3;
#pragma unroll
    for (int k4 = 0; k4 < 4; ++k4) { f32x4 v = (f32x4){0.f, 0.f, 0.f, 0.f}; if (S0 != nullptr) v = *(const f32x4*)(S0 + vr * 64 + 16 * kq + 4 * k4);
        S[4 * k4] = v.x; S[4 * k4 + 1] = v.y; S[4 * k4 + 2] = v.z; S[4 * k4 + 3] = v.w; }
    const int hc = h * 64 + lane;
    const float w0c = P.w0[hc], a0c = P.a0[hc], kkc = P.k_k[hc], kac = P.k_a[hc], rkc = P.r_k[hc], lnw = P.ln_w[hc], lnb = P.ln_b[hc];
    for (int tb = 0; tb < T; tb += 16) {
        for (int i = tid; i < 16 * 640; i += 512) { const int t = i / 640, cc = i - t * 640; int col; LAS float* dst; int kind = 0;
            if (cc < 64) { col = RW_R + h * 64 + cc; dst = rs + t * 64 + cc; }
            else if (cc < 128) { col = RW_K + h * 64 + (cc - 64); dst = kr + t * 64 + (cc - 64); }
            else if (cc < 192) { col = RW_V + h * 64 + (cc - 128); dst = vs + t * 64 + (cc - 128); }
            else if (cc < 288) { col = RW_XW + (cc - 192); dst = xw + t * 96 + (cc - 192); kind = 1; }
            else if (cc < 384) { col = RW_XA + (cc - 288); dst = xa + t * 96 + (cc - 288); }
            else { col = RW_XG + (cc - 384); dst = xg + t * 256 + (cc - 384); kind = 2; }
            const int tt = tb + t; const float u = bf2f(P.proj[(size_t)(m0 + tt) * IN_WP + PC_RW + col]);
            const float up = tt > 0 ? bf2f(P.proj[(size_t)(m0 + tt - 1) * IN_WP + PC_RW + col]) : (sbuf ? sbuf[col] : 0.f);
            float v = u + P.mu[col] * (up - u);
            if (kind == 1) v = tanhf(v); else if (kind == 2) v = sigmoid_f(v);
            *dst = v; }
        __syncthreads();
        {
            float wl0 = 0.f, wl1 = 0.f, al0 = 0.f, al1 = 0.f, gl0 = 0.f, gl1 = 0.f; const int t0 = wave, t1 = wave + 8;
#ifdef OLD_SEQ
#pragma unroll 4
            for (int j = 0; j < 96; ++j) { const float w2v = P.w2[j * 2048 + hc], a2v = P.a2[j * 2048 + hc];
                wl0 += xw[t0 * 96 + j] * w2v; wl1 += xw[t1 * 96 + j] * w2v; al0 += xa[t0 * 96 + j] * a2v; al1 += xa[t1 * 96 + j] * a2v; }
#pragma unroll 4
            for (int j = 0; j < 256; ++j) { const float g2v = P.g2[j * 2048 + hc]; gl0 += xg[t0 * 256 + j] * g2v; gl1 += xg[t1 * 256 + j] * g2v; }
#else
#define SEQ_DOT8(W8, X0, X1, A0, A1) do { const v4u _w = (W8); const LAS float* _x0 = (X0); const LAS float* _x1 = (X1); \
                const f32x4 _p0 = *(const LAS f32x4*)_x0, _p1 = *(const LAS f32x4*)(_x0 + 4), _q0 = *(const LAS f32x4*)_x1, _q1 = *(const LAS f32x4*)(_x1 + 4); \
                const float _w0 = bflo(_w.x), _w1 = bfhi(_w.x), _w2 = bflo(_w.y), _w3 = bfhi(_w.y), _w4 = bflo(_w.z), _w5 = bfhi(_w.z), _w6 = bflo(_w.w), _w7 = bfhi(_w.w); \
                A0 += (_p0.x * _w0 + _p0.y * _w1) + (_p0.z * _w2 + _p0.w * _w3) + (_p1.x * _w4 + _p1.y * _w5) + (_p1.z * _w6 + _p1.w * _w7); \
                A1 += (_q0.x * _w0 + _q0.y * _w1) + (_q0.z * _w2 + _q0.w * _w3) + (_q1.x * _w4 + _q1.y * _w5) + (_q1.z * _w6 + _q1.w * _w7); } while (0)
#pragma unroll 1
            for (int cch = 0; cch < 3; ++cch) { v4u wv[4], av2[4];
#pragma unroll
                for (int p = 0; p < 4; ++p) { wv[p] = *(const GAS v4u*)(w2T_ + (size_t)hc * 96 + 32 * cch + 8 * p); av2[p] = *(const GAS v4u*)(a2T_ + (size_t)hc * 96 + 32 * cch + 8 * p); }
#pragma unroll
                for (int p = 0; p < 4; ++p) { const int j = 32 * cch + 8 * p; SEQ_DOT8(wv[p], xw + t0 * 96 + j, xw + t1 * 96 + j, wl0, wl1); SEQ_DOT8(av2[p], xa + t0 * 96 + j, xa + t1 * 96 + j, al0, al1); } }
#pragma unroll 1
            for (int cch = 0; cch < 8; ++cch) { v4u gv[4];
#pragma unroll
                for (int p = 0; p < 4; ++p) gv[p] = *(const GAS v4u*)(g2T_ + (size_t)hc * 256 + 32 * cch + 8 * p);
#pragma unroll
                for (int p = 0; p < 4; ++p) { const int j = 32 * cch + 8 * p; SEQ_DOT8(gv[p], xg + t0 * 256 + j, xg + t1 * 256 + j, gl0, gl1); } }
#undef SEQ_DOT8
#endif
#pragma unroll
            for (int r = 0; r < 2; ++r) { const int t = r ? t1 : t0; const float wl = r ? wl1 : wl0, al = r ? al1 : al0, gl = r ? gl1 : gl0;
                const float wlog = -softplus_f(-(w0c + wl)) - 0.5f; const float wdec = __expf(-__expf(wlog));
                const float a = sigmoid_f(a0c + al);
                const float krv = kr[t * 64 + lane], kkr = krv * kkc; const float kk = kkr / sqrtf(wave_sum(kkr * kkr) + 1e-6f);
                const float kpv = krv * (1.0f + (a - 1.0f) * kac);
                const float sbv = wave_sum(rs[t * 64 + lane] * kpv * rkc);
                wd[t * 64 + lane] = wdec; kp[t * 64 + lane] = kpv; av[t * 64 + lane] = -kk; bv[t * 64 + lane] = kk * a; gt[t * 64 + lane] = gl; if (lane == 0) sbn[t] = sbv; }
        }
        __syncthreads();
        if (wave < 4) {
#pragma unroll 1
            for (int t = 0; t < 16; ++t) {
                float sa = 0.f;
#pragma unroll
                for (int k4 = 0; k4 < 4; ++k4) { const f32x4 a4 = *(const LAS f32x4*)(av + t * 64 + 16 * kq + 4 * k4); sa += a4.x * S[4 * k4] + a4.y * S[4 * k4 + 1] + a4.z * S[4 * k4 + 2] + a4.w * S[4 * k4 + 3]; }
                sa += __shfl_xor(sa, 1); sa += __shfl_xor(sa, 2);
                const float vv = vs[t * 64 + vr]; float y = 0.f;
#pragma unroll
                for (int k4 = 0; k4 < 4; ++k4) { const int o4 = t * 64 + 16 * kq + 4 * k4;
                    const f32x4 w4 = *(const LAS f32x4*)(wd + o4), b4 = *(const LAS f32x4*)(bv + o4), k4v = *(const LAS f32x4*)(kp + o4), r4 = *(const LAS f32x4*)(rs + o4);
                    S[4 * k4] = S[4 * k4] * w4.x + sa * b4.x + vv * k4v.x; S[4 * k4 + 1] = S[4 * k4 + 1] * w4.y + sa * b4.y + vv * k4v.y;
                    S[4 * k4 + 2] = S[4 * k4 + 2] * w4.z + sa * b4.z + vv * k4v.z; S[4 * k4 + 3] = S[4 * k4 + 3] * w4.w + sa * b4.w + vv * k4v.w;
                    y += r4.x * S[4 * k4] + r4.y * S[4 * k4 + 1] + r4.z * S[4 * k4 + 2] + r4.w * S[4 * k4 + 3]; }
                y += __shfl_xor(y, 1); y += __shfl_xor(y, 2);
                if (kq == 0) ys[t * 64 + vr] = y;
            }
        }
        __syncthreads();
#pragma unroll
        for (int r = 0; r < 2; ++r) { const int t = wave + 8 * r; const float y = ys[t * 64 + lane];
            const float mean = wave_sum(y) * (1.f / 64.f); const float dy = y - mean; const float var = wave_sum(dy * dy) * (1.f / 64.f);
            const float yn = dy / sqrtf(var + RW_GN_EPS) * lnw + lnb;
            P.mix[(size_t)(m0 + tb + t) * 4096 + 2048 + hc] = (bf16)f2bf((yn + sbn[t] * vs[t * 64 + lane]) * gt[t * 64 + lane]); }
        __syncthreads();
    }
    if (wave < 4) { int so = vr * 64 + 16 * kq;
#ifndef NO_LAUNDER
    asm volatile("" : "+v"(so));
#endif
#pragma unroll
        for (int k4 = 0; k4 < 4; ++k4) *(f32x4*)(Sout + so + 4 * k4) = (f32x4){S[4 * k4], S[4 * k4 + 1], S[4 * k4 + 2], S[4 * k4 + 3]};
    }
    for (int i = tid; i < 206; i += 512) { const int col = h * 206 + i; shout[col] = bf2f(P.proj[(size_t)(m0 + T - 1) * IN_WP + PC_RW + col]); }
}

typedef short bf16x8 __attribute__((ext_vector_type(8)));
typedef float f32x16 __attribute__((ext_vector_type(16)));
typedef __bf16 bf16x2_t __attribute__((ext_vector_type(2)));
typedef float f32x2_t __attribute__((ext_vector_type(2)));
__device__ __forceinline__ unsigned cvt2(float lo, float hi) { f32x2_t v = {lo, hi}; return __builtin_bit_cast(unsigned, __builtin_convertvector(v, bf16x2_t)); }
#define MFMA16(a, b, c) __builtin_amdgcn_mfma_f32_16x16x32_bf16((a), (b), (c), 0, 0, 0)
#define MFMA32(a, b, c) __builtin_amdgcn_mfma_f32_32x32x16_bf16((a), (b), (c), 0, 0, 0)
__device__ __forceinline__ bf16x8 pack_step(const f32x16& x, int s) {
    v4u p; p.x = cvt2(x[8 * s], x[8 * s + 1]); p.y = cvt2(x[8 * s + 2], x[8 * s + 3]); p.z = cvt2(x[8 * s + 4], x[8 * s + 5]); p.w = cvt2(x[8 * s + 6], x[8 * s + 7]);
    return __builtin_bit_cast(bf16x8, p);
}
struct DnRec { unsigned char* rec; unsigned char* qk; float* gl; };
constexpr int DP_QN = 0, DP_KN = 17408, DP_VBT = 34816, DP_KBGT = 53248, DP_LM = 71680, DP_TM = 88320, DP_TB = 104960, DP_DINV = 114176, DP_YB = 118528, DP_SC = 122688;

__device__ __forceinline__ void tri_inv64(const LAS float* Lm, LAS float* Tm, LAS bf16* Tb, LAS float* Dinv, LAS float* Yb, int tid, int lane, int wave) {
    if (tid < 64) { const int bi = tid >> 4, j = tid & 15; float x[16];
#pragma unroll
        for (int r = 0; r < 16; ++r) { float a = (r == j) ? 1.f : 0.f;
#pragma unroll
            for (int k = 0; k < r; ++k) a -= Lm[(16 * bi + r) * 65 + 16 * bi + k] * x[k];
            x[r] = a; }
#pragma unroll
        for (int r = 0; r < 16; ++r) Dinv[(bi * 16 + r) * 17 + j] = x[r]; }
    __syncthreads();
    for (int o = tid; o < 4096; o += 512) { const int r = o >> 6, c = o & 63, bi = r >> 4;
        if (c >= 16 * bi) { const float a = (c < 16 * bi + 16) ? Dinv[r * 17 + c - 16 * bi] : 0.f; Tm[r * 65 + c] = a; Tb[r * 72 + c] = (bf16)(cvt2(a, 0.f) & 0xffffu); } }
    __syncthreads();
    const int l15 = lane & 15, q = lane >> 4;
#pragma unroll 1
    for (int i = 1; i < 4; ++i) {
        if (wave < i) { f32x4 acc = (f32x4){0.f, 0.f, 0.f, 0.f};
            for (int ks = 0; ks < 4 * i; ++ks) acc = __builtin_amdgcn_mfma_f32_16x16x4f32(Lm[(16 * i + l15) * 65 + 4 * ks + q], Tm[(4 * ks + q) * 65 + 16 * wave + l15], acc, 0, 0, 0);
#pragma unroll
            for (int reg = 0; reg < 4; ++reg) Yb[(4 * q + reg) * 65 + 16 * wave + l15] = -acc[reg]; }
        __syncthreads();
        if (wave < i) { f32x4 acc = (f32x4){0.f, 0.f, 0.f, 0.f};
#pragma unroll
            for (int ks = 0; ks < 4; ++ks) acc = __builtin_amdgcn_mfma_f32_16x16x4f32(Dinv[(16 * i + l15) * 17 + 4 * ks + q], Yb[(4 * ks + q) * 65 + 16 * wave + l15], acc, 0, 0, 0);
#pragma unroll
            for (int reg = 0; reg < 4; ++reg) { Tm[(16 * i + 4 * q + reg) * 65 + 16 * wave + l15] = acc[reg]; Tb[(16 * i + 4 * q + reg) * 72 + 16 * wave + l15] = (bf16)(cvt2(acc[reg], 0.f) & 0xffffu); } }
        __syncthreads();
    }
}

__device__ __forceinline__ void dn_prep_item(const MixPtrs& P, const DnRec& R, LAS unsigned char* lds, int b, int c, int h, int tid, int lane, int wave) {
    const int m0 = b * SEQ + 64 * c; const int item = (b * 128 + c) * 16 + h;
    LAS bf16* Qn = (LAS bf16*)(lds + DP_QN); LAS bf16* Kn = (LAS bf16*)(lds + DP_KN); LAS bf16* VbT = (LAS bf16*)(lds + DP_VBT); LAS bf16* KbgT = (LAS bf16*)(lds + DP_KBGT);
    LAS float* Lm = (LAS float*)(lds + DP_LM); LAS float* Tm = (LAS float*)(lds + DP_TM); LAS bf16* Tb = (LAS bf16*)(lds + DP_TB); LAS float* Dinv = (LAS float*)(lds + DP_DINV); LAS float* Yb = (LAS float*)(lds + DP_YB);
    LAS float* sc = (LAS float*)(lds + DP_SC); LAS float* beta = sc; LAS float* gc = sc + 64; LAS float* egc = sc + 128; LAS float* ekd = sc + 192;
    unsigned char* rec = R.rec + (size_t)item * 65536; unsigned char* qkr = R.qk + (size_t)item * 8192;
    if (wave == 0) { const int t = lane; const size_t r = (size_t)(m0 + t) * IN_WP; const float bb = bf2f(P.proj[r + PC_B + h]), aa = bf2f(P.proj[r + PC_A + h]);
        const float Ah = -__expf(P.a_log[h]), dtb = P.dt_bias[h];
        float x = Ah * softplus_f(aa + dtb);
#pragma unroll
        for (int o = 1; o < 64; o <<= 1) { const float v = __shfl_up(x, o); if (lane >= o) x += v; }
        const float gl = __shfl(x, 63);
        beta[t] = sigmoid_f(bb); gc[t] = x; egc[t] = __expf(x); ekd[t] = __expf(gl - x); if (lane == 0) R.gl[item] = __expf(gl); }
    __syncthreads();
#ifdef PD1
    for (int _pr = 0; _pr < 2; ++_pr)
#endif
#pragma unroll
    for (int r = 0; r < 6; ++r) {
        const int sec = r >> 1; const int idx = (tid + 512 * r) & 1023; const int t = idx >> 4, g8 = idx & 15; const int col = sec * 2048 + h * 128 + 8 * g8;
        float acc[8];
#pragma unroll
        for (int i = 0; i < 8; ++i) acc[i] = 0.f;
#pragma unroll
        for (int j = 0; j < 4; ++j) { const int tt = 64 * c + t - 3 + j;
            v4u xv = (v4u){0u, 0u, 0u, 0u}; if (tt >= 0) xv = *(const GAS v4u*)(P.proj + (size_t)(b * SEQ + tt) * IN_WP + col);
            const f32x4 w0 = *(const GAS f32x4*)(P.conv_w + j * 6144 + col), w1 = *(const GAS f32x4*)(P.conv_w + j * 6144 + col + 4);
            acc[0] += bflo(xv.x) * w0.x; acc[1] += bfhi(xv.x) * w0.y; acc[2] += bflo(xv.y) * w0.z; acc[3] += bfhi(xv.y) * w0.w;
            acc[4] += bflo(xv.z) * w1.x; acc[5] += bfhi(xv.z) * w1.y; acc[6] += bflo(xv.w) * w1.z; acc[7] += bfhi(xv.w) * w1.w; }
        float y[8]; float ss = 0.f;
#pragma unroll
        for (int i = 0; i < 8; ++i) { y[i] = acc[i] * sigmoid_f(acc[i]); ss += y[i] * y[i]; }
        if (sec < 2) { ss += __shfl_xor(ss, 1); ss += __shfl_xor(ss, 2); ss += __shfl_xor(ss, 4); ss += __shfl_xor(ss, 8);
            const float scl = (sec == 0 ? 0.08838834764831845f : 1.0f) * __builtin_amdgcn_rsqf(ss + 1e-6f);
#pragma unroll
            for (int i = 0; i < 8; ++i) y[i] *= scl; }
        if (sec == 0) { v4u o; o.x = cvt2(y[0], y[1]); o.y = cvt2(y[2], y[3]); o.z = cvt2(y[4], y[5]); o.w = cvt2(y[6], y[7]); *(LAS v4u*)(Qn + t * 136 + 8 * g8) = o; }
        else if (sec == 1) { v4u o; o.x = cvt2(y[0], y[1]); o.y = cvt2(y[2], y[3]); o.z = cvt2(y[4], y[5]); o.w = cvt2(y[6], y[7]); *(LAS v4u*)(Kn + t * 136 + 8 * g8) = o;
            const float f = beta[t] * egc[t];
#pragma unroll
            for (int i = 0; i < 8; ++i) KbgT[(8 * g8 + i) * 72 + 8 * (((t >> 3) ^ (g8 >> 1)) & 7) + (t & 7)] = (bf16)(cvt2(y[i] * f, 0.f) & 0xffffu); }
        else { const float f = beta[t];
#pragma unroll
            for (int i = 0; i < 8; ++i) VbT[(8 * g8 + i) * 72 + 8 * (((t >> 3) ^ (g8 >> 1)) & 7) + (t & 7)] = (bf16)(cvt2(y[i] * f, 0.f) & 0xffffu); }
    }
    __syncthreads();
#ifdef PD2
    for (int _pr = 0; _pr < 2; ++_pr) {
#else
    {
#endif
    {   const int tt = wave & 3, sp = wave >> 2, l15 = lane & 15, q = lane >> 4;
#pragma unroll
        for (int si = 0; si < 2; ++si) { const int st = 2 * sp + si;
            f32x4 aL = (f32x4){0.f, 0.f, 0.f, 0.f}, aQ = (f32x4){0.f, 0.f, 0.f, 0.f};
#pragma unroll
            for (int ks = 0; ks < 4; ++ks) {
                const bf16x8 fs = *(const LAS bf16x8*)(Kn + (16 * st + l15) * 136 + 32 * ks + 8 * q);
                const bf16x8 ft = *(const LAS bf16x8*)(Kn + (16 * tt + l15) * 136 + 32 * ks + 8 * q);
                const bf16x8 fq = *(const LAS bf16x8*)(Qn + (16 * tt + l15) * 136 + 32 * ks + 8 * q);
                aL = MFMA16(fs, ft, aL); aQ = MFMA16(fs, fq, aQ); }
            const int t = 16 * tt + l15; const float gct = gc[t], bt = beta[t]; float qv[4];
#pragma unroll
            for (int reg = 0; reg < 4; ++reg) { const int s = 16 * st + 4 * q + reg; const float dec = __expf(gct - gc[s]);
                Lm[t * 65 + s] = (t > s) ? bt * aL[reg] * dec : 0.f; qv[reg] = (t >= s) ? aQ[reg] * dec : 0.f; }
            v2u qkp; qkp.x = cvt2(qv[0], qv[1]); qkp.y = cvt2(qv[2], qv[3]);
            *(GAS v2u*)(qkr + ((((t >> 5) * 4 + st) * 64 + (t & 31) + 32 * (q & 1)) * 16 + 8 * (q >> 1))) = qkp;
        }
    }
#pragma unroll
    for (int r = 0; r < 2; ++r) { const int fl = tid + 512 * r; const int ln = fl & 63, ks = (fl >> 6) & 7, mt = fl >> 9;
        const int t = 32 * mt + (ln & 31), d0 = 16 * ks + 4 * (ln >> 5); const float f = egc[t];
        const v2u a = *(const LAS v2u*)(Qn + t * 136 + d0), bq = *(const LAS v2u*)(Qn + t * 136 + d0 + 8);
        v4u o; o.x = cvt2(bflo(a.x) * f, bfhi(a.x) * f); o.y = cvt2(bflo(a.y) * f, bfhi(a.y) * f); o.z = cvt2(bflo(bq.x) * f, bfhi(bq.x) * f); o.w = cvt2(bflo(bq.y) * f, bfhi(bq.y) * f);
        *(GAS v4u*)(rec + 16384 + fl * 16) = o; }
#pragma unroll
    for (int r = 0; r < 2; ++r) { const int fl = tid + 512 * r; const int ln = fl & 63, kt = (fl >> 6) & 3, mtd = fl >> 8;
        const int d = 32 * mtd + (ln & 31), t0 = 16 * kt + 4 * (ln >> 5); float v[8];
#pragma unroll
        for (int j = 0; j < 8; ++j) { const int t = t0 + 8 * (j >> 2) + (j & 3); v[j] = bf2f(Kn[t * 136 + d]) * ekd[t]; }
        v4u o; o.x = cvt2(v[0], v[1]); o.y = cvt2(v[2], v[3]); o.z = cvt2(v[4], v[5]); o.w = cvt2(v[6], v[7]);
        *(GAS v4u*)(rec + 32768 + fl * 16) = o; }
    __syncthreads();
    }
    tri_inv64(Lm, Tm, Tb, Dinv, Yb, tid, lane, wave);
#ifdef PD4
    for (int _pr = 0; _pr < 2; ++_pr)
#endif
    {   const int tt = wave & 3, hf = wave >> 2, l15 = lane & 15, q = lane >> 4;
        bf16x8 tf[2];
#pragma unroll
        for (int ks = 0; ks < 2; ++ks) tf[ks] = *(const LAS bf16x8*)(Tb + (16 * tt + l15) * 72 + 32 * ks + 8 * q);
#pragma unroll
        for (int n = 0; n < 4; ++n) { const int et = 4 * hf + n;
            f32x4 au = (f32x4){0.f, 0.f, 0.f, 0.f}, aw = (f32x4){0.f, 0.f, 0.f, 0.f};
#pragma unroll
            for (int ks = 0; ks < 2; ++ks) { const bf16x8 fv = *(const LAS bf16x8*)(VbT + (16 * et + l15) * 72 + 8 * ((4 * ks + q) ^ (et & 7))); const bf16x8 fk = *(const LAS bf16x8*)(KbgT + (16 * et + l15) * 72 + 8 * ((4 * ks + q) ^ (et & 7)));
                au = MFMA16(tf[ks], fv, au);
                aw = MFMA16(fk, tf[ks], aw); }
            v2u up; up.x = cvt2(au[0], au[1]); up.y = cvt2(au[2], au[3]);
            *(GAS v2u*)(rec + 49152 + ((16 * et + l15) * 64 + 16 * tt + 4 * q) * 2) = up;
            const int t = 16 * tt + l15; v2u wp; wp.x = cvt2(aw[0], aw[1]); wp.y = cvt2(aw[2], aw[3]);
            *(GAS v2u*)(rec + ((((t >> 5) * 8 + et) * 64 + (t & 31) + 32 * (q & 1)) * 16 + 8 * (q >> 1))) = wp; }
    }
    __syncthreads();
}

#define WG_BAR_LDS() do { asm volatile("s_waitcnt lgkmcnt(0)" ::: "memory"); __builtin_amdgcn_s_barrier(); asm volatile("" ::: "memory"); } while (0)
__device__ __forceinline__ void dn_scan(const MixPtrs& P, const DnRec& R, LAS unsigned char* lds, int b, int h, int tid, int lane, int wave) {
    constexpr int SB = 57344; LAS unsigned char* obuf = lds + 2 * SB;
    const int item0 = b * 128 * 16 + h;
    if (wave < 4) {
        const int e = 32 * wave + (lane & 31), hh = lane >> 5;
        f32x16 S[4];
#pragma unroll
        for (int dt = 0; dt < 4; ++dt)
#pragma unroll
            for (int i = 0; i < 16; ++i) S[dt][i] = 0.f;
        v2u uu[2][4];
#pragma unroll
        for (int mt = 0; mt < 2; ++mt)
#pragma unroll
            for (int g = 0; g < 4; ++g) uu[mt][g] = *(const GAS v2u*)(R.rec + (size_t)item0 * 65536 + 49152 + (e * 64 + 32 * mt + 8 * g + 4 * hh) * 2);
        float egl = R.gl[item0];
        WG_BAR_LDS();
#pragma unroll 1
        for (int c = 0; c < 128; ++c) {
            LAS unsigned char* buf = lds + (c & 1) * SB;
            f32x16 o0, o1;
            bf16x8 Sf[8];
#pragma unroll
            for (int dt = 0; dt < 4; ++dt) { Sf[2 * dt] = pack_step(S[dt], 0); Sf[2 * dt + 1] = pack_step(S[dt], 1); }
            f32x16 w0, w1;
#pragma unroll
            for (int i = 0; i < 16; ++i) { w0[i] = 0.f; w1[i] = 0.f; o0[i] = 0.f; o1[i] = 0.f; }
#pragma unroll
            for (int ks = 0; ks < 8; ++ks) { const bf16x8 a0 = *(const LAS bf16x8*)(buf + (ks * 64 + lane) * 16), a1 = *(const LAS bf16x8*)(buf + ((8 + ks) * 64 + lane) * 16);
                w0 = MFMA32(a0, Sf[ks], w0); w1 = MFMA32(a1, Sf[ks], w1); }
#pragma unroll
            for (int g = 0; g < 4; ++g) {
                w0[4 * g] = bflo(uu[0][g].x) - w0[4 * g]; w0[4 * g + 1] = bfhi(uu[0][g].x) - w0[4 * g + 1]; w0[4 * g + 2] = bflo(uu[0][g].y) - w0[4 * g + 2]; w0[4 * g + 3] = bfhi(uu[0][g].y) - w0[4 * g + 3];
                w1[4 * g] = bflo(uu[1][g].x) - w1[4 * g]; w1[4 * g + 1] = bfhi(uu[1][g].x) - w1[4 * g + 1]; w1[4 * g + 2] = bflo(uu[1][g].y) - w1[4 * g + 2]; w1[4 * g + 3] = bfhi(uu[1][g].y) - w1[4 * g + 3]; }
            const float eg_cur = egl;
            if (c + 1 < 128) {
                const unsigned char* recn = R.rec + (size_t)(item0 + 16 * (c + 1)) * 65536;
#pragma unroll
                for (int mt = 0; mt < 2; ++mt)
#pragma unroll
                    for (int g = 0; g < 4; ++g) uu[mt][g] = *(const GAS v2u*)(recn + 49152 + (e * 64 + 32 * mt + 8 * g + 4 * hh) * 2);
                egl = R.gl[item0 + 16 * (c + 1)];
            }
            bf16x8 Vf[4]; Vf[0] = pack_step(w0, 0); Vf[1] = pack_step(w0, 1); Vf[2] = pack_step(w1, 0); Vf[3] = pack_step(w1, 1);
#pragma unroll
            for (int ks = 0; ks < 8; ++ks) { const bf16x8 a0 = *(const LAS bf16x8*)(buf + 16384 + (ks * 64 + lane) * 16), a1 = *(const LAS bf16x8*)(buf + 16384 + ((8 + ks) * 64 + lane) * 16);
                o0 = MFMA32(a0, Sf[ks], o0); o1 = MFMA32(a1, Sf[ks], o1); }
#pragma unroll
            for (int kt = 0; kt < 4; ++kt) { const bf16x8 a0 = *(const LAS bf16x8*)(buf + 49152 + (kt * 64 + lane) * 16), a1 = *(const LAS bf16x8*)(buf + 49152 + ((4 + kt) * 64 + lane) * 16);
                o0 = MFMA32(a0, Vf[kt], o0); o1 = MFMA32(a1, Vf[kt], o1); }
#pragma unroll
            for (int dt = 0; dt < 4; ++dt) {
#pragma unroll
                for (int i = 0; i < 16; ++i) S[dt][i] *= eg_cur;
#pragma unroll
                for (int kt = 0; kt < 4; ++kt) { const bf16x8 a = *(const LAS bf16x8*)(buf + 32768 + ((dt * 4 + kt) * 64 + lane) * 16); S[dt] = MFMA32(a, Vf[kt], S[dt]); } }
            WG_BAR_LDS();
#pragma unroll
            for (int i = 0; i < 16; ++i) { const int row = (i & 3) + 8 * (i >> 2) + 4 * hh;
                ((LAS bf16*)obuf)[row * 128 + e] = (bf16)(cvt2(o0[i], 0.f) & 0xffffu); ((LAS bf16*)obuf)[(32 + row) * 128 + e] = (bf16)(cvt2(o1[i], 0.f) & 0xffffu); }
            WG_BAR_LDS();
        }
        float* Sout = P.out + O_SDN_P + ((size_t)b * 16 + h) * 16384;
#pragma unroll
        for (int dt = 0; dt < 4; ++dt)
#pragma unroll
            for (int i = 0; i < 16; ++i) Sout[(32 * dt + (i & 3) + 8 * (i >> 2) + 4 * hh) * 128 + e] = S[dt][i];
    } else {
        const int ht = tid - 256; const int pt = ht >> 2, pq = ht & 3;
        v4u st[14], zr[4];
#define DN_STAGE_ISSUE(itm) do { const unsigned char* _r = R.rec + (size_t)(itm) * 65536; const unsigned char* _q = R.qk + (size_t)(itm) * 8192; \
        _Pragma("unroll") for (int _k = 0; _k < 12; ++_k) st[_k] = *(const GAS v4u*)(_r + (ht + 256 * _k) * 16); \
        _Pragma("unroll") for (int _k = 0; _k < 2; ++_k) st[12 + _k] = *(const GAS v4u*)(_q + (ht + 256 * _k) * 16); } while (0)
#define DN_STAGE_WRITE(dstbuf) do { _Pragma("unroll") for (int _k = 0; _k < 14; ++_k) *(LAS v4u*)((dstbuf) + (ht + 256 * _k) * 16) = st[_k]; } while (0)
#define DN_Z_ISSUE(cc) do { const size_t _m = (size_t)(b * SEQ + 64 * (cc) + pt); _Pragma("unroll") for (int _k = 0; _k < 4; ++_k) zr[_k] = *(const GAS v4u*)(P.proj + _m * IN_WP + PC_Z + h * 128 + 32 * pq + 8 * _k); } while (0)
#define DN_POST(cc) do { const int _m = b * SEQ + 64 * (cc) + pt; v4u _o[4]; \
        _Pragma("unroll") for (int _k = 0; _k < 4; ++_k) _o[_k] = *(const LAS v4u*)(obuf + (pt * 128 + 32 * pq + 8 * _k) * 2); \
        float _ss = 0.f; _Pragma("unroll") for (int _k = 0; _k < 4; ++_k) { const float a0 = bflo(_o[_k].x), a1 = bfhi(_o[_k].x), a2 = bflo(_o[_k].y), a3 = bfhi(_o[_k].y), a4 = bflo(_o[_k].z), a5 = bfhi(_o[_k].z), a6 = bflo(_o[_k].w), a7 = bfhi(_o[_k].w); \
            _ss += (a0 * a0 + a1 * a1) + (a2 * a2 + a3 * a3) + (a4 * a4 + a5 * a5) + (a6 * a6 + a7 * a7); } \
        _ss += __shfl_xor(_ss, 1); _ss += __shfl_xor(_ss, 2); const float _rs = __builtin_amdgcn_rsqf(_ss * (1.f / 128.f) + NORM_EPS); \
        _Pragma("unroll") for (int _k = 0; _k < 4; ++_k) { const GAS f32x4* _nw = (const GAS f32x4*)(P.dn_norm_w + 32 * pq + 8 * _k); const f32x4 n0 = _nw[0], n1 = _nw[1]; \
            const float z0 = bflo(zr[_k].x), z1 = bfhi(zr[_k].x), z2 = bflo(zr[_k].y), z3 = bfhi(zr[_k].y), z4 = bflo(zr[_k].z), z5 = bfhi(zr[_k].z), z6 = bflo(zr[_k].w), z7 = bfhi(zr[_k].w); \
            v4u _w; _w.x = cvt2(bflo(_o[_k].x) * _rs * n0.x * (z0 * sigmoid_f(z0)), bfhi(_o[_k].x) * _rs * n0.y * (z1 * sigmoid_f(z1))); \
            _w.y = cvt2(bflo(_o[_k].y) * _rs * n0.z * (z2 * sigmoid_f(z2)), bfhi(_o[_k].y) * _rs * n0.w * (z3 * sigmoid_f(z3))); \
            _w.z = cvt2(bflo(_o[_k].z) * _rs * n1.x * (z4 * sigmoid_f(z4)), bfhi(_o[_k].z) * _rs * n1.y * (z5 * sigmoid_f(z5))); \
            _w.w = cvt2(bflo(_o[_k].w) * _rs * n1.z * (z6 * sigmoid_f(z6)), bfhi(_o[_k].w) * _rs * n1.w * (z7 * sigmoid_f(z7))); \
            *(GAS v4u*)(P.mix + (size_t)_m * 4096 + h * 128 + 32 * pq + 8 * _k) = _w; } } while (0)
        DN_STAGE_ISSUE(item0); DN_STAGE_WRITE(lds); DN_STAGE_ISSUE(item0 + 16);
        WG_BAR_LDS();
#pragma unroll 1
        for (int c = 0; c < 128; ++c) {
            if (c + 1 < 128) DN_STAGE_WRITE(lds + ((c + 1) & 1) * SB);
            if (c + 2 < 128) DN_STAGE_ISSUE(item0 + 16 * (c + 2));
            if (c > 0) DN_POST(c - 1);
            DN_Z_ISSUE(c);
            WG_BAR_LDS();
            WG_BAR_LDS();
        }
        DN_POST(127);
#undef DN_STAGE_ISSUE
#undef DN_STAGE_WRITE
#undef DN_Z_ISSUE
#undef DN_POST
    }
    {   float* cout = P.out + O_CONV_P + (size_t)b * 3 * 6144;
        for (int i = tid; i < 3 * 384; i += 512) { const int r = i / 384, cc = i - r * 384, col = (cc >> 7) * 2048 + h * 128 + (cc & 127);
            cout[r * 6144 + col] = bf2f(P.proj[(size_t)(b * SEQ + SEQ - 3 + r) * IN_WP + col]); } }
    __syncthreads();
}
struct RwRec { unsigned char* pq; unsigned char* rp; unsigned char* oo; float* sb; const bf16* w2T; const bf16* a2T; const bf16* g2T; };
constexpr int RSL = 9216;

struct RwRaw { unsigned ur[9], uk[9], uv[9]; v4u xu[3], xp[3]; };
__device__ __forceinline__ void rw_prep_issue(const MixPtrs& P, RwRaw& R, int b, int c, int h, int tid, int lane, int wave) {
    const int hc = h * 64 + lane;
#pragma unroll
    for (int i = 0; i < 9; ++i) { int tt = 64 * c + wave * 8 + i - 1; tt = tt < 0 ? 0 : tt;
        const size_t ro = (size_t)(b * SEQ + tt) * IN_WP + PC_RW + hc; R.ur[i] = P.proj[ro + RW_R]; R.uk[i] = P.proj[ro + RW_K]; R.uv[i] = P.proj[ro + RW_V]; }
#pragma unroll
    for (int r = 0; r < 3; ++r) { const int i = tid + 512 * r; const int which = i >= 768, ii = which ? i - 768 : i; const int t = ii / 12, g8 = ii - t * 12; int tp = 64 * c + t - 1; tp = tp < 0 ? 0 : tp;
        const int col = (which ? RW_XA : RW_XW) + 8 * g8;
        R.xu[r] = *(const GAS v4u*)(P.proj + (size_t)(b * SEQ + 64 * c + t) * IN_WP + PC_RW + col); R.xp[r] = *(const GAS v4u*)(P.proj + (size_t)(b * SEQ + tp) * IN_WP + PC_RW + col); }
}
__device__ __forceinline__ void rw_prep_item(const MixPtrs& P, const RwRec& W, LAS unsigned char* lds, int b, int c, int h, RwRaw& raw, int nb, int nc, int nh, int tid, int lane, int wave) {
    const int m0 = b * SEQ + 64 * c; const int item = (b * 128 + c) * 32 + h; const int hc = h * 64 + lane;
    const int l15 = lane & 15, q = lane >> 4;
    LAS bf16* Rt = (LAS bf16*)(lds + 0 * RSL); LAS bf16* Kt = (LAS bf16*)(lds + 1 * RSL); LAS bf16* Bt = (LAS bf16*)(lds + 2 * RSL); LAS bf16* At = (LAS bf16*)(lds + 3 * RSL);
    LAS bf16* AtT = (LAS bf16*)(lds + 4 * RSL); LAS bf16* KhT = (LAS bf16*)(lds + 5 * RSL); LAS bf16* BhT = (LAS bf16*)(lds + 6 * RSL); LAS bf16* VT = (LAS bf16*)(lds + 7 * RSL);
    LAS bf16* Aak = (LAS bf16*)(lds + 8 * RSL); LAS bf16* Ark = (LAS bf16*)(lds + 9 * RSL); LAS bf16* Arb = (LAS bf16*)(lds + 10 * RSL);
    LAS float* Lm = (LAS float*)(lds + 11 * RSL); LAS float* Tm = (LAS float*)(lds + 1 * RSL); LAS bf16* Tb = (LAS bf16*)(lds + 3 * RSL);
    LAS bf16* WtT = (LAS bf16*)(lds + 11 * RSL); LAS bf16* XT = (LAS bf16*)(lds + 12 * RSL); LAS bf16* U0T = (LAS bf16*)(lds + 1 * RSL);
    LAS float* Dinv = (LAS float*)(lds + 13 * RSL); LAS float* Yb = (LAS float*)(lds + 13 * RSL + 4352);
    LAS float* wl = (LAS float*)(lds + 0); LAS float* al = (LAS float*)(lds + 2 * RSL);
    LAS bf16* txw = (LAS bf16*)(lds + 8 * RSL); LAS bf16* xas = txw + 64 * 104; LAS bf16* w2s = xas + 64 * 104; LAS bf16* a2s = w2s + 64 * 104;
    LAS float* wtot = (LAS float*)(lds + 126976); LAS float* eGCs = (LAS float*)(lds + 129024);
    float rr[8], kr[8], vv[8];
    {   float ur[9], uk[9], uv[9];
#pragma unroll
        for (int i = 0; i < 9; ++i) { const bool ok = (64 * c + wave * 8 + i - 1) >= 0;
            ur[i] = ok ? bf2f((bf16)raw.ur[i]) : 0.f; uk[i] = ok ? bf2f((bf16)raw.uk[i]) : 0.f; uv[i] = ok ? bf2f((bf16)raw.uv[i]) : 0.f; }
        const float mr = P.mu[RW_R + hc], mk = P.mu[RW_K + hc], mv = P.mu[RW_V + hc];
#pragma unroll
        for (int i = 0; i < 8; ++i) { rr[i] = ur[i + 1] + mr * (ur[i] - ur[i + 1]); kr[i] = uk[i + 1] + mk * (uk[i] - uk[i + 1]); vv[i] = uv[i + 1] + mv * (uv[i] - uv[i + 1]); }
    }
#ifdef PR1
    for (int _pr = 0; _pr < 2; ++_pr) {
#else
    {
#endif
#pragma unroll
    for (int r = 0; r < 3; ++r) { const int i = tid + 512 * r; const int which = i >= 768, ii = which ? i - 768 : i; const int t = ii / 12, g8 = ii - t * 12; const int tt = 64 * c + t;
        const int col = (which ? RW_XA : RW_XW) + 8 * g8;
        const v4u u = raw.xu[r]; v4u up = raw.xp[r]; if (tt <= 0) up = (v4u){0u, 0u, 0u, 0u};
        const f32x4 m0v = *(const GAS f32x4*)(P.mu + col), m1v = *(const GAS f32x4*)(P.mu + col + 4);
        float x[8];
        x[0] = bflo(u.x) + m0v.x * (bflo(up.x) - bflo(u.x)); x[1] = bfhi(u.x) + m0v.y * (bfhi(up.x) - bfhi(u.x)); x[2] = bflo(u.y) + m0v.z * (bflo(up.y) - bflo(u.y)); x[3] = bfhi(u.y) + m0v.w * (bfhi(up.y) - bfhi(u.y));
        x[4] = bflo(u.z) + m1v.x * (bflo(up.z) - bflo(u.z)); x[5] = bfhi(u.z) + m1v.y * (bfhi(up.z) - bfhi(u.z)); x[6] = bflo(u.w) + m1v.z * (bflo(up.w) - bflo(u.w)); x[7] = bfhi(u.w) + m1v.w * (bfhi(up.w) - bfhi(u.w));
        if (!which) {
#pragma unroll
            for (int k = 0; k < 8; ++k) { const float e2 = __expf(2.0f * x[k]); x[k] = 1.0f - 2.0f * __builtin_amdgcn_rcpf(e2 + 1.0f); } }
        v4u o; o.x = cvt2(x[0], x[1]); o.y = cvt2(x[2], x[3]); o.z = cvt2(x[4], x[5]); o.w = cvt2(x[6], x[7]);
        *(LAS v4u*)(txw + which * 6656 + t * 104 + 8 * g8) = o; }
    bf16x8 fw2[2][3], fa2[2][3];
#pragma unroll
    for (int ci = 0; ci < 2; ++ci)
#pragma unroll
        for (int ks = 0; ks < 3; ++ks) { const size_t o = (size_t)(h * 64 + 16 * (2 * (wave >> 2) + ci) + l15) * 96 + 32 * ks + 8 * q;
            fw2[ci][ks] = *(const GAS bf16x8*)(W.w2T + o); fa2[ci][ks] = *(const GAS bf16x8*)(W.a2T + o); }
    __syncthreads();
    {   const int tt = wave & 3, cp = wave >> 2;
#pragma unroll
        for (int ci = 0; ci < 2; ++ci) { const int ct = 2 * cp + ci;
            f32x4 aw = (f32x4){0.f, 0.f, 0.f, 0.f}, aa = (f32x4){0.f, 0.f, 0.f, 0.f};
#pragma unroll
            for (int ks = 0; ks < 3; ++ks) {
                const bf16x8 fx = *(const LAS bf16x8*)(txw + (16 * tt + l15) * 104 + 32 * ks + 8 * q), fa = *(const LAS bf16x8*)(xas + (16 * tt + l15) * 104 + 32 * ks + 8 * q);
                aw = MFMA16(fx, fw2[ci][ks], aw); aa = MFMA16(fa, fa2[ci][ks], aa); }
#pragma unroll
            for (int reg = 0; reg < 4; ++reg) { wl[(16 * tt + 4 * q + reg) * 65 + 16 * ct + l15] = aw[reg]; al[(16 * tt + 4 * q + reg) * 65 + 16 * ct + l15] = aa[reg]; } }
    }
    }
    __syncthreads();
    float lw[8], av[8], bvv[8], kp[8], Gt[8];
    {   const float w0c = P.w0[hc], a0c = P.a0[hc], kkc = P.k_k[hc], kac = P.k_a[hc], rkc = P.r_k[hc];
        float run = 0.f;
#pragma unroll
        for (int i = 0; i < 8; ++i) { const int t = wave * 8 + i;
            const float wlog = -softplus_f(-(w0c + wl[t * 65 + lane])) - 0.5f; lw[i] = -__expf(wlog);
            const float alr = sigmoid_f(a0c + al[t * 65 + lane]);
            const float kkr = kr[i] * kkc; const float kk = kkr * __builtin_amdgcn_rsqf(wave_sum(kkr * kkr) + 1e-6f);
            kp[i] = kr[i] * (1.0f + (alr - 1.0f) * kac); av[i] = -kk; bvv[i] = kk * alr;
            const float sbv = wave_sum(rr[i] * kp[i] * rkc); if (lane == 0) W.sb[(size_t)item * 64 + t] = sbv;
            run += lw[i]; Gt[i] = run; }
        wtot[wave * 64 + lane] = run;
    }
    __syncthreads();
    {   float off = 0.f, gcv = 0.f;
#pragma unroll
        for (int w = 0; w < 8; ++w) { const float x = wtot[w * 64 + lane]; gcv += x; if (w < wave) off += x; }
        if (wave == 0) eGCs[lane] = __expf(gcv);
        float tA[8], tK[8], tB[8];
#pragma unroll
        for (int i = 0; i < 8; ++i) { const int t = wave * 8 + i; const float G = Gt[i] + off;
            const float eG = __expf(G), eGm = __expf(-G), eGp = __expf(G - lw[i]), eH = __expf(gcv - G);
            Rt[t * 72 + lane] = (bf16)(cvt2(rr[i] * eG, 0.f) & 0xffffu); Kt[t * 72 + lane] = (bf16)(cvt2(kp[i] * eGm, 0.f) & 0xffffu);
            Bt[t * 72 + lane] = (bf16)(cvt2(bvv[i] * eGm, 0.f) & 0xffffu); tA[i] = av[i] * eGp; At[t * 72 + lane] = (bf16)(cvt2(tA[i], 0.f) & 0xffffu);
            tK[i] = kp[i] * eH; tB[i] = bvv[i] * eH; }
        v4u o;
        o.x = cvt2(tA[0], tA[1]); o.y = cvt2(tA[2], tA[3]); o.z = cvt2(tA[4], tA[5]); o.w = cvt2(tA[6], tA[7]); *(LAS v4u*)(AtT + lane * 72 + wave * 8) = o;
        o.x = cvt2(tK[0], tK[1]); o.y = cvt2(tK[2], tK[3]); o.z = cvt2(tK[4], tK[5]); o.w = cvt2(tK[6], tK[7]); *(LAS v4u*)(KhT + lane * 72 + wave * 8) = o;
        o.x = cvt2(tB[0], tB[1]); o.y = cvt2(tB[2], tB[3]); o.z = cvt2(tB[4], tB[5]); o.w = cvt2(tB[6], tB[7]); *(LAS v4u*)(BhT + lane * 72 + wave * 8) = o;
        o.x = cvt2(vv[0], vv[1]); o.y = cvt2(vv[2], vv[3]); o.z = cvt2(vv[4], vv[5]); o.w = cvt2(vv[6], vv[7]); *(LAS v4u*)(VT + lane * 72 + wave * 8) = o;
    }
    __syncthreads();
#ifdef PR4
    for (int _pr = 0; _pr < 2; ++_pr)
#endif
    {   const int tt = wave & 3, sp = wave >> 2;
        bf16x8 fA[2], fR[2];
#pragma unroll
        for (int ks = 0; ks < 2; ++ks) { fA[ks] = *(const LAS bf16x8*)(At + (16 * tt + l15) * 72 + 32 * ks + 8 * q); fR[ks] = *(const LAS bf16x8*)(Rt + (16 * tt + l15) * 72 + 32 * ks + 8 * q); }
#pragma unroll
        for (int si = 0; si < 2; ++si) { const int st = 2 * sp + si;
            f32x4 ab = (f32x4){0.f, 0.f, 0.f, 0.f}, ak = ab, rk = ab, rb = ab;
#pragma unroll
            for (int ks = 0; ks < 2; ++ks) { const bf16x8 fB = *(const LAS bf16x8*)(Bt + (16 * st + l15) * 72 + 32 * ks + 8 * q), fK = *(const LAS bf16x8*)(Kt + (16 * st + l15) * 72 + 32 * ks + 8 * q);
                ab = MFMA16(fB, fA[ks], ab); ak = MFMA16(fK, fA[ks], ak); rk = MFMA16(fK, fR[ks], rk); rb = MFMA16(fB, fR[ks], rb); }
            const int t = 16 * tt + l15, s0 = 16 * st + 4 * q; float vak[4], vrk[4], vrb[4];
#pragma unroll
            for (int reg = 0; reg < 4; ++reg) { const int s = s0 + reg; Lm[t * 65 + s] = (t > s) ? -ab[reg] : 0.f; vak[reg] = (t > s) ? ak[reg] : 0.f; vrk[reg] = (t >= s) ? rk[reg] : 0.f; vrb[reg] = (t >= s) ? rb[reg] : 0.f; }
            v2u o; o.x = cvt2(vak[0], vak[1]); o.y = cvt2(vak[2], vak[3]); *(LAS v2u*)(Aak + t * 72 + s0) = o;
            o.x = cvt2(vrk[0], vrk[1]); o.y = cvt2(vrk[2], vrk[3]); *(LAS v2u*)(Ark + t * 72 + s0) = o;
            o.x = cvt2(vrb[0], vrb[1]); o.y = cvt2(vrb[2], vrb[3]); *(LAS v2u*)(Arb + t * 72 + s0) = o; }
    }
    __syncthreads();
    tri_inv64(Lm, Tm, Tb, Dinv, Yb, tid, lane, wave);
#ifdef PR2
    tri_inv64(Lm, Tm, Tb, Dinv, Yb, tid, lane, wave);
#endif
#ifdef PR5
    for (int _pr = 0; _pr < 2; ++_pr) {
#else
    {
#endif
    {   const int tt = wave & 3, cp = wave >> 2;
        bf16x8 fT[2], fK[2];
#pragma unroll
        for (int ks = 0; ks < 2; ++ks) { fT[ks] = *(const LAS bf16x8*)(Tb + (16 * tt + l15) * 72 + 32 * ks + 8 * q); fK[ks] = *(const LAS bf16x8*)(Aak + (16 * tt + l15) * 72 + 32 * ks + 8 * q); }
#pragma unroll
        for (int ci = 0; ci < 2; ++ci) { const int ct = 2 * cp + ci;
            f32x4 aw = (f32x4){0.f, 0.f, 0.f, 0.f}, ax = aw;
#pragma unroll
            for (int ks = 0; ks < 2; ++ks) { const bf16x8 fa = *(const LAS bf16x8*)(AtT + (16 * ct + l15) * 72 + 32 * ks + 8 * q), fv = *(const LAS bf16x8*)(VT + (16 * ct + l15) * 72 + 32 * ks + 8 * q);
                aw = MFMA16(fT[ks], fa, aw); ax = MFMA16(fK[ks], fv, ax); }
            v2u o; o.x = cvt2(aw[0], aw[1]); o.y = cvt2(aw[2], aw[3]); *(LAS v2u*)(WtT + (16 * ct + l15) * 72 + 16 * tt + 4 * q) = o;
            o.x = cvt2(ax[0], ax[1]); o.y = cvt2(ax[2], ax[3]); *(LAS v2u*)(XT + (16 * ct + l15) * 72 + 16 * tt + 4 * q) = o; }
    }
    __syncthreads();
    {   const int tt = wave & 3, cp = wave >> 2;
#pragma unroll
        for (int ci = 0; ci < 2; ++ci) { const int et = 2 * cp + ci; f32x4 au = (f32x4){0.f, 0.f, 0.f, 0.f};
#pragma unroll
            for (int ks = 0; ks < 2; ++ks) { const bf16x8 fT = *(const LAS bf16x8*)(Tb + (16 * tt + l15) * 72 + 32 * ks + 8 * q), fx = *(const LAS bf16x8*)(XT + (16 * et + l15) * 72 + 32 * ks + 8 * q);
                au = MFMA16(fT, fx, au); }
            v2u o; o.x = cvt2(au[0], au[1]); o.y = cvt2(au[2], au[3]); *(LAS v2u*)(U0T + (16 * et + l15) * 72 + 16 * tt + 4 * q) = o; }
    }
    __syncthreads();
    }
    if (nb >= 0) rw_prep_issue(P, raw, nb, nc, nh, tid, lane, wave);
#ifdef PR3
    for (int _pr = 0; _pr < 2; ++_pr)
#endif
    {   const int bt = wave & 3, ap = wave >> 2;
        unsigned char* pq = W.pq + (size_t)item * 16384; unsigned char* rp = W.rp + (size_t)item * 8192; unsigned char* oo = W.oo + (size_t)item * 8192;
        bf16x8 fArb[2], fArk[2], fBh[2], fV[2], fU[2];
#pragma unroll
        for (int ks = 0; ks < 2; ++ks) { fArb[ks] = *(const LAS bf16x8*)(Arb + (16 * bt + l15) * 72 + 32 * ks + 8 * q); fArk[ks] = *(const LAS bf16x8*)(Ark + (16 * bt + l15) * 72 + 32 * ks + 8 * q);
            fBh[ks] = *(const LAS bf16x8*)(BhT + (16 * bt + l15) * 72 + 32 * ks + 8 * q); fV[ks] = *(const LAS bf16x8*)(VT + (16 * bt + l15) * 72 + 32 * ks + 8 * q); fU[ks] = *(const LAS bf16x8*)(U0T + (16 * bt + l15) * 72 + 32 * ks + 8 * q); }
#pragma unroll
        for (int ai = 0; ai < 2; ++ai) { const int at = 2 * ap + ai;
            f32x4 aR = (f32x4){0.f, 0.f, 0.f, 0.f}, aP = aR, aO = aR, aQ = aR;
#pragma unroll
            for (int ks = 0; ks < 2; ++ks) {
                const bf16x8 fW = *(const LAS bf16x8*)(WtT + (16 * at + l15) * 72 + 32 * ks + 8 * q);
                aR = MFMA16(fW, fArb[ks], aR);
                aP = MFMA16(fW, fBh[ks], aP);
                const bf16x8 fk = *(const LAS bf16x8*)(Ark + (16 * at + l15) * 72 + 32 * ks + 8 * q), fb = *(const LAS bf16x8*)(Arb + (16 * at + l15) * 72 + 32 * ks + 8 * q);
                aO = MFMA16(fk, fV[ks], aO); aO = MFMA16(fb, fU[ks], aO);
                const bf16x8 fkh = *(const LAS bf16x8*)(KhT + (16 * at + l15) * 72 + 32 * ks + 8 * q), fbh = *(const LAS bf16x8*)(BhT + (16 * at + l15) * 72 + 32 * ks + 8 * q);
                aQ = MFMA16(fkh, fV[ks], aQ); aQ = MFMA16(fbh, fU[ks], aQ); }
            const int x = 16 * bt + l15, y0 = 16 * at + 4 * q;
            {   const v2u rt = *(const LAS v2u*)(Rt + x * 72 + y0);
                v2u o; o.x = cvt2(aR[0] + bflo(rt.x), aR[1] + bfhi(rt.x)); o.y = cvt2(aR[2] + bflo(rt.y), aR[3] + bfhi(rt.y));
                *(GAS v2u*)(rp + ((((x >> 5) * 4 + at) * 64 + (x & 31) + 32 * (q & 1)) * 16 + 8 * (q >> 1))) = o; }
            {   const float dg = eGCs[x]; float p[4];
#pragma unroll
                for (int reg = 0; reg < 4; ++reg) p[reg] = aP[reg] + ((y0 + reg == x) ? dg : 0.f);
                v2u o; o.x = cvt2(p[0], p[1]); o.y = cvt2(p[2], p[3]);
                *(GAS v2u*)(pq + ((((x >> 5) * 4 + at) * 64 + (x & 31) + 32 * (q & 1)) * 16 + 8 * (q >> 1))) = o; }
            {   v2u o; o.x = cvt2(aO[0], aO[1]); o.y = cvt2(aO[2], aO[3]); *(GAS v2u*)(oo + (x * 64 + y0) * 2) = o; }
            {   v2u o; o.x = cvt2(aQ[0], aQ[1]); o.y = cvt2(aQ[2], aQ[3]); *(GAS v2u*)(pq + 8192 + (x * 64 + y0) * 2) = o; }
        }
    }
    __syncthreads();
}

__device__ __forceinline__ void rw_scan(const MixPtrs& P, const RwRec& W, LAS unsigned char* lds, int b, int h, int tid, int lane, int wave) {
    constexpr int SB = 33792;
    const int item0 = b * 128 * 32 + h;
    if (wave < 2) {
        const int e = 32 * wave + (lane & 31), hh = lane >> 5;
        f32x16 H[2];
#pragma unroll
        for (int i = 0; i < 16; ++i) { H[0][i] = 0.f; H[1][i] = 0.f; }
        WG_BAR_LDS();
#pragma unroll 1
        for (int c = 0; c < 128; ++c) {
            LAS unsigned char* buf = lds + (c & 1) * SB;
            bf16x8 Hf[4]; Hf[0] = pack_step(H[0], 0); Hf[1] = pack_step(H[0], 1); Hf[2] = pack_step(H[1], 0); Hf[3] = pack_step(H[1], 1);
#pragma unroll
            for (int mt = 0; mt < 2; ++mt) {
                f32x16 hn, ov;
#pragma unroll
                for (int g = 0; g < 4; ++g) { const v2u qv = *(const LAS v2u*)(buf + 16384 + e * 136 + (32 * mt + 8 * g + 4 * hh) * 2), o0 = *(const LAS v2u*)(buf + 16384 + 8704 + e * 136 + (32 * mt + 8 * g + 4 * hh) * 2);
                    hn[4 * g] = bflo(qv.x); hn[4 * g + 1] = bfhi(qv.x); hn[4 * g + 2] = bflo(qv.y); hn[4 * g + 3] = bfhi(qv.y);
                    ov[4 * g] = bflo(o0.x); ov[4 * g + 1] = bfhi(o0.x); ov[4 * g + 2] = bflo(o0.y); ov[4 * g + 3] = bfhi(o0.y); }
#pragma unroll
                for (int ks = 0; ks < 4; ++ks) { const bf16x8 fp = *(const LAS bf16x8*)(buf + ((mt * 4 + ks) * 64 + lane) * 16), fr = *(const LAS bf16x8*)(buf + 8192 + ((mt * 4 + ks) * 64 + lane) * 16);
                    hn = MFMA32(fp, Hf[ks], hn); ov = MFMA32(fr, Hf[ks], ov); }
#pragma unroll
                for (int g = 0; g < 4; ++g) { v2u o; o.x = cvt2(ov[4 * g], ov[4 * g + 1]); o.y = cvt2(ov[4 * g + 2], ov[4 * g + 3]); *(LAS v2u*)(buf + 16384 + 8704 + e * 136 + (32 * mt + 8 * g + 4 * hh) * 2) = o; }
                if (mt == 0) H[0] = hn; else H[1] = hn;
            }
            WG_BAR_LDS();
        }
        float* Sout = P.out + O_SRW_P + ((size_t)b * 32 + h) * 4096;
#pragma unroll
        for (int mt = 0; mt < 2; ++mt)
#pragma unroll
            for (int g = 0; g < 4; ++g) *(f32x4*)(Sout + e * 64 + 32 * mt + 8 * g + 4 * hh) = (f32x4){H[mt][4 * g], H[mt][4 * g + 1], H[mt][4 * g + 2], H[mt][4 * g + 3]};
    } else {
        const int ht = tid - 128;
        v4u st[6];
#define RW_STAGE_ISSUE(itm) do { const unsigned char* _pq = W.pq + (size_t)(itm) * 16384; const unsigned char* _rp = W.rp + (size_t)(itm) * 8192; const unsigned char* _oo = W.oo + (size_t)(itm) * 8192; \
        _Pragma("unroll") for (int _k = 0; _k < 6; ++_k) { const int _i = ht + 384 * _k; if (_i < 2048) st[_k] = *(const GAS v4u*)(_i < 512 ? _pq + _i * 16 : (_i < 1024 ? _rp + (_i - 512) * 16 : (_i < 1536 ? _pq + 8192 + (_i - 1024) * 16 : _oo + (_i - 1536) * 16))); } } while (0)
#define RW_STAGE_WRITE(dstbuf) do { _Pragma("unroll") for (int _k = 0; _k < 6; ++_k) { const int _i = ht + 384 * _k; if (_i < 1024) *(LAS v4u*)((dstbuf) + _i * 16) = st[_k]; \
            else if (_i < 2048) { const int _j = _i - 1024; LAS unsigned char* _d = (dstbuf) + 16384 + (_j >> 3) * 136 + (_j & 7) * 16; *(LAS v2u*)_d = (v2u){st[_k].x, st[_k].y}; *(LAS v2u*)(_d + 8) = (v2u){st[_k].z, st[_k].w}; } } } while (0)
#define RW_STORE_O(itm, srcbuf) do { unsigned char* _oo = W.oo + (size_t)(itm) * 8192; \
        _Pragma("unroll") for (int _k = 4; _k < 6; ++_k) { const int _i = ht + 384 * _k; if (_i < 2048) { const int _j = _i - 1024; const LAS unsigned char* _s = (srcbuf) + 16384 + (_j >> 3) * 136 + (_j & 7) * 16; \
            const v2u _a = *(const LAS v2u*)_s, _b = *(const LAS v2u*)(_s + 8); *(GAS v4u*)(_oo + (_i - 1536) * 16) = (v4u){_a.x, _a.y, _b.x, _b.y}; } } } while (0)
        RW_STAGE_ISSUE(item0); RW_STAGE_WRITE(lds); RW_STAGE_ISSUE(item0 + 32);
        WG_BAR_LDS();
#pragma unroll 1
        for (int c = 0; c < 128; ++c) {
            if (c > 0) RW_STORE_O(item0 + 32 * (c - 1), lds + ((c - 1) & 1) * SB);
            if (c + 1 < 128) RW_STAGE_WRITE(lds + ((c + 1) & 1) * SB);
            if (c + 2 < 128) RW_STAGE_ISSUE(item0 + 32 * (c + 2));
            WG_BAR_LDS();
        }
        RW_STORE_O(item0 + 32 * 127, lds + SB);
#undef RW_STAGE_ISSUE
#undef RW_STAGE_WRITE
#undef RW_STORE_O
    }
    {   float* shout = P.out + O_SHIFT_P + (size_t)b * RW_SHIFT_W;
        for (int i = tid; i < 206; i += 512) { const int col = h * 206 + i; shout[col] = bf2f(P.proj[(size_t)(b * SEQ + SEQ - 1) * IN_WP + PC_RW + col]); } }
    __syncthreads();
}

__device__ __forceinline__ void rw_gate_item(const MixPtrs& P, const RwRec& W, LAS unsigned char* lds, int b, int c, int qt, int tid, int lane, int wave) {
    const int m0 = b * SEQ + 64 * c; const int l15 = lane & 15, q = lane >> 4;
    LAS bf16* sxg = (LAS bf16*)lds;
#pragma unroll
    for (int r = 0; r < 4; ++r) { const int i = tid + 512 * r; const int t = i >> 5, g8 = i & 31; const int tt = 64 * c + t; const int col = RW_XG + 8 * g8;
        const v4u u = *(const GAS v4u*)(P.proj + (size_t)(m0 + t) * IN_WP + PC_RW + col); v4u up = (v4u){0u, 0u, 0u, 0u}; if (tt > 0) up = *(const GAS v4u*)(P.proj + (size_t)(m0 + t - 1) * IN_WP + PC_RW + col);
        const f32x4 m0v = *(const GAS f32x4*)(P.mu + col), m1v = *(const GAS f32x4*)(P.mu + col + 4);
        float x[8];
        x[0] = bflo(u.x) + m0v.x * (bflo(up.x) - bflo(u.x)); x[1] = bfhi(u.x) + m0v.y * (bfhi(up.x) - bfhi(u.x)); x[2] = bflo(u.y) + m0v.z * (bflo(up.y) - bflo(u.y)); x[3] = bfhi(u.y) + m0v.w * (bfhi(up.y) - bfhi(u.y));
        x[4] = bflo(u.z) + m1v.x * (bflo(up.z) - bflo(u.z)); x[5] = bfhi(u.z) + m1v.y * (bfhi(up.z) - bfhi(u.z)); x[6] = bflo(u.w) + m1v.z * (bflo(up.w) - bflo(u.w)); x[7] = bfhi(u.w) + m1v.w * (bfhi(up.w) - bfhi(u.w));
        v4u o; o.x = cvt2(sigmoid_f(x[0]), sigmoid_f(x[1])); o.y = cvt2(sigmoid_f(x[2]), sigmoid_f(x[3])); o.z = cvt2(sigmoid_f(x[4]), sigmoid_f(x[5])); o.w = cvt2(sigmoid_f(x[6]), sigmoid_f(x[7]));
        *(LAS v4u*)(sxg + t * 264 + 8 * g8) = o; }
    __syncthreads();
    {   const int tt = wave & 3, hf = wave >> 2;
        bf16x8 fx[8];
#pragma unroll
        for (int ks = 0; ks < 8; ++ks) fx[ks] = *(const LAS bf16x8*)(sxg + (16 * tt + l15) * 264 + 32 * ks + 8 * q);
        const int colb = qt * 512 + hf * 256;
#pragma unroll 2
        for (int vt = 0; vt < 16; ++vt) { const bf16* gr = W.g2T + (size_t)(colb + 16 * vt + l15) * 256 + 8 * q;
            bf16x8 fg[8];
#pragma unroll
            for (int ks = 0; ks < 8; ++ks) fg[ks] = *(const GAS bf16x8*)(gr + 32 * ks);
            f32x4 ag = (f32x4){0.f, 0.f, 0.f, 0.f};
#pragma unroll
            for (int ks = 0; ks < 8; ++ks) ag = MFMA16(fg[ks], fx[ks], ag);
            v2u o; o.x = cvt2(ag[0], ag[1]); o.y = cvt2(ag[2], ag[3]);
            *(GAS v2u*)(P.mix + (size_t)(m0 + 16 * tt + l15) * 4096 + 2048 + colb + 16 * vt + 4 * q) = o; }
    }
    __syncthreads();
}
__device__ __forceinline__ void rw_post_task(const MixPtrs& P, const RwRec& W, int item, int tg, int lane) {
    const int h = item & 31, c = (item >> 5) & 127, b = item >> 12; const int m0 = b * SEQ + 64 * c + 8 * tg; const int hc = h * 64 + lane;
    const v4u ov = *(const GAS v4u*)(W.oo + (size_t)item * 8192 + (lane * 64 + tg * 8) * 2);
    float uv[9], gt[8];
#pragma unroll
    for (int i = 0; i < 9; ++i) { const int tt = 64 * c + 8 * tg + i - 1; uv[i] = tt >= 0 ? bf2f(P.proj[(size_t)(b * SEQ + tt) * IN_WP + PC_RW + RW_V + hc]) : 0.f; }
#pragma unroll
    for (int i = 0; i < 8; ++i) gt[i] = bf2f(P.mix[(size_t)(m0 + i) * 4096 + 2048 + hc]);
    const float mv = P.mu[RW_V + hc], lnw = P.ln_w[hc], lnb = P.ln_b[hc];
    const float y[8] = {bflo(ov.x), bfhi(ov.x), bflo(ov.y), bfhi(ov.y), bflo(ov.z), bfhi(ov.z), bflo(ov.w), bfhi(ov.w)};
    float sbs[8];
#pragma unroll
    for (int i = 0; i < 8; ++i) sbs[i] = W.sb[(size_t)item * 64 + tg * 8 + i];
#pragma unroll
    for (int i = 0; i < 8; ++i) { const float vv = uv[i + 1] + mv * (uv[i] - uv[i + 1]);
        const float mean = wave_sum(y[i]) * (1.f / 64.f); const float dy = y[i] - mean; const float var = wave_sum(dy * dy) * (1.f / 64.f);
        const float yn = dy * __builtin_amdgcn_rsqf(var + RW_GN_EPS) * lnw + lnb;
        P.mix[(size_t)(m0 + i) * 4096 + 2048 + hc] = (bf16)(cvt2((yn + sbs[i] * vv) * gt[i], 0.f) & 0xffffu); }
}

constexpr int NPH = 10;
#define MK_N_LAUNCHES 1
#ifndef MK_N_LAUNCHES
#define MK_N_LAUNCHES 1
#endif
#ifndef GP_ALIGN
#define GP_ALIGN false
#endif
#ifndef GP_SP2
#define GP_SP2 true
#endif
#ifndef REP_MASK
#define REP_MASK 0
#endif
__global__ void __launch_bounds__(NWAVES * 64, 2) hymba_fwd(Args args) {
    extern __shared__ __attribute__((aligned(16))) unsigned char lds_raw[];
    LAS unsigned char* lds = (LAS unsigned char*)lds_raw;
    volatile LAS unsigned* MISC = (volatile LAS unsigned*)(lds + MISC_OFF);
    const int tid = threadIdx.x, lane = tid & 63, wave = __builtin_amdgcn_readfirstlane(tid >> 6);
    const int G = gridDim.x;
    unsigned char* ws = args.ws;
    gu32* ctl = (gu32*)(ws + WS_CTL);
    for (int u = tid; u < (LDS_BYTES - LDSCTL_OFF) / 4; u += NWAVES * 64) ((LAS unsigned*)(lds + LDSCTL_OFF))[u] = 0u;
    __syncthreads();
    XcdBarrier bar; bar.bar = (unsigned*)(ctl + CW_BAR); bar.x = 0; bar.st = nullptr;
    if (MK_N_LAUNCHES == 1) bar = xcd_barrier_post((unsigned*)(ctl + CW_BAR), MISC + 8);
    const int lo = args.ph_lo, hi = args.ph_hi;
#ifdef ONLY_PHASE
#define IN(k) ((k) == ONLY_PHASE)
#else
#define IN(k) (lo <= (k) && (k) < hi)
#endif
#define SEAM(k) do { if (IN(k) && IN((k) + 1)) xcd_barrier(bar); } while (0)
    float* ssq = (float*)(ws + WS_SSQ);
    bf16* Wt_out = (bf16*)(ws + WS_WOUT); bf16* hbuf = (bf16*)(ws + WS_HBUF); bf16* proj = (bf16*)(ws + WS_PROJ); bf16* act = (bf16*)(ws + WS_PROJ);
    bf16* Wt_in = (bf16*)(ws + WS_WIN); bf16* Wt_gu = (bf16*)(ws + WS_WGU); bf16* Wt_dn = (bf16*)(ws + WS_WDN);
    bf16* w2T = (bf16*)(ws + WS_W2T); bf16* a2T = (bf16*)(ws + WS_A2T); bf16* g2T = (bf16*)(ws + WS_G2T);
    const float* x_prompt = args.in[0]; const float* x_sample = args.in[1];
    const int gw = blockIdx.x * NWAVES + wave, NGW = G * NWAVES;

    if (IN(0)) _Pragma("unroll") for (int _r = 0; _r < 1 + ((REP_MASK >> 0) & 1); ++_r) {
        LAS float* scr = (LAS float*)(lds + RING_OFF + wave * 16384);
        constexpr int I_IN = 64 * (IN_W / 32);
        for (int it = gw; it < I_IN; it += NGW) p0_transpose_item(args.in[8], 4096, IN_W, Wt_in, scr, it, lane, RmId{});
        for (int i = blockIdx.x * 512 + tid; i < 2048 * 448; i += G * 512) {
            if (i < 2048 * 96) { const int c = i / 96, j = i - c * 96; w2T[i] = (bf16)f2bf(args.in[15][j * 2048 + c]); }
            else if (i < 2048 * 192) { const int ii = i - 2048 * 96; const int c = ii / 96, j = ii - c * 96; a2T[ii] = (bf16)f2bf(args.in[17][j * 2048 + c]); }
            else { const int ii = i - 2048 * 192; const int c = ii >> 8, j = ii & 255; g2T[ii] = (bf16)f2bf(args.in[18][j * 2048 + c]); }
        }
        for (int i = blockIdx.x * 512 + tid; i < 32 * 4096 / 8; i += G * 512) ((GAS v4u*)(Wt_in + (size_t)IN_W * 4096))[i] = (v4u){0u, 0u, 0u, 0u};
        for (int m = gw; m < MPAD; m += NGW) {
            bf16* orow = hbuf + (size_t)m * 4096;
            if (m < M_REAL) { const float* xrow = m < M_PROMPT ? x_prompt + (size_t)m * 4096 : x_sample + (size_t)(m - M_PROMPT) * 4096;
                const GAS f32x4* xr = (const GAS f32x4*)xrow + lane; f32x4 v[16];
#pragma unroll
                for (int j = 0; j < 16; ++j) v[j] = xr[64 * j];
                rms_row_to_bf16(v, args.in[6], orow, lane); }
            else { GAS v2u* o8 = (GAS v2u*)orow + lane;
#pragma unroll
                for (int j = 0; j < 16; ++j) o8[64 * j] = (v2u){0u, 0u}; }
        }
    }
    SEAM(0);
    if (IN(1)) _Pragma("unroll") for (int _r = 0; _r < 1 + ((REP_MASK >> 1) & 1); ++_r) {
        pg8::Gemm g{hbuf, Wt_in, MPAD, IN_WP, 4096, 4096, 4096}; pg8::StaticOrder S; S.init(MPAD, IN_WP, G, (int)blockIdx.x);
        pg8::EpiBf16Plain E{proj, IN_WP};
        pg8::gemm_phase<pg8::EpiBf16Plain, pg8::StaticOrder, GP_ALIGN, GP_SP2>(lds + RING_OFF, g, S, E);
    }
#ifdef PROBE_GEMM_RESIDENT
    if (IN(1)) {
        struct ProbeOrder : pg8::StaticOrder { __device__ bool next(int i, pg8::Unit& u) const { if (i >= 15) return false; u.pm = c & 7; u.pn = (c >> 3) & 3; return true; } };
        pg8::Gemm g{hbuf, Wt_in, MPAD, IN_WP, 4096, 4096, 4096}; ProbeOrder S; S.init(MPAD, IN_WP, G, (int)blockIdx.x);
        pg8::EpiBf16Plain E{Wt_gu, IN_WP};
        pg8::gemm_phase<pg8::EpiBf16Plain, ProbeOrder, GP_ALIGN, GP_SP2>(lds + RING_OFF, g, S, E);
    }
#endif
    SEAM(1);
    MixPtrs P; P.proj = proj; P.mix = hbuf; P.state_dn = args.in[2]; P.cache_conv = args.in[3]; P.state_rw = args.in[4]; P.cache_shift = args.in[5];
    P.conv_w = args.in[9]; P.a_log = args.in[10]; P.dt_bias = args.in[11]; P.dn_norm_w = args.in[12];
    P.mu = args.in[13]; P.w0 = args.in[14]; P.w2 = args.in[15]; P.a0 = args.in[16]; P.a2 = args.in[17]; P.g2 = args.in[18]; P.k_k = args.in[19]; P.k_a = args.in[20]; P.r_k = args.in[21];
    P.ln_w = args.in[22]; P.ln_b = args.in[23]; P.out = args.out;
    DnRec R; R.rec = (unsigned char*)args.out; R.qk = ws + WS_DNQK; R.gl = (float*)(ws + WS_DNGL);
    RwRec W; W.pq = ws + WS_RWPQ; W.rp = ws + WS_RWRP; W.oo = ws + WS_RWOO; W.sb = (float*)(ws + WS_RWSB); W.w2T = w2T; W.a2T = a2T; W.g2T = g2T;
    if (IN(2)) _Pragma("unroll") for (int _r = 0; _r < 1 + ((REP_MASK >> 2) & 1); ++_r) {
#ifndef REP_DNP
#define REP_DNP 0
#endif
#ifndef REP_RWP
#define REP_RWP 0
#endif
        for (int _q = 0; _q <= REP_DNP; ++_q)
        for (int it = blockIdx.x; it < 4096; it += G) dn_prep_item(P, R, lds + RING_OFF, it >> 11, (it >> 4) & 127, it & 15, tid, lane, wave);
        for (int _q = 0; _q <= REP_RWP; ++_q) {
            RwRaw raw; { const int it = blockIdx.x; rw_prep_issue(P, raw, it >> 12, (it >> 5) & 127, it & 31, tid, lane, wave); }
            for (int it = blockIdx.x; it < 8192; it += G) { const int nx = it + G; const bool hn = nx < 8192;
                rw_prep_item(P, W, lds + RING_OFF, it >> 12, (it >> 5) & 127, it & 31, raw, hn ? (nx >> 12) : -1, (nx >> 5) & 127, nx & 31, tid, lane, wave); }
        }
    }
    SEAM(2);
    if (IN(3)) _Pragma("unroll") for (int _r = 0; _r < 1 + ((REP_MASK >> 3) & 1); ++_r) {
        const int wg = blockIdx.x;
#ifndef REP_DNSCAN
#define REP_DNSCAN 0
#endif
#ifndef REP_SAMPLES
#define REP_SAMPLES 0
#endif
        if (wg < 32) { _Pragma("unroll 1") for (int _q = 0; _q <= REP_DNSCAN; ++_q) dn_scan(P, R, lds + RING_OFF, wg >> 4, wg & 15, tid, lane, wave); }
        else if (wg < 96) rw_scan(P, W, lds + RING_OFF, (wg - 32) >> 5, (wg - 32) & 31, tid, lane, wave);
        else {
            _Pragma("unroll 1") for (int _q = 0; _q <= REP_SAMPLES; ++_q)
            for (int it = wg - 96; it < 384; it += G - 96) {
                if (it < 128) dn_seq_item(P, lds + RING_OFF, 2 + (it >> 4), it & 15, tid, lane, wave);
                else rw_seq_item(P, w2T, a2T, g2T, lds + RING_OFF, 2 + ((it - 128) >> 5), (it - 128) & 31, tid, lane, wave);
            }
        }
        if (wg >= 32) {
            const int pw = wg - 32, npw = G - 32;
            for (int it = pw; it < 1024; it += npw) rw_gate_item(P, W, lds + RING_OFF, it >> 9, (it >> 2) & 127, it & 3, tid, lane, wave);
            LAS float* scr = (LAS float*)(lds + RING_OFF + wave * 16384);
            for (int it = pw * NWAVES + wave; it < 64 * 128; it += npw * NWAVES) p0_transpose_item(args.in[24], 4096, 4096, Wt_out, scr, it, lane, RmId{});
            for (int it = pw * NWAVES + wave; it < (D_FF / 64) * 98; it += npw * NWAVES) { const int kb = it / 98, nb = 30 + it % 98; p0_transpose_item(args.in[29], D_FF, 4096, Wt_dn, scr, kb * 128 + nb, lane, RmId{}); }
            __syncthreads();
        }
    }
    SEAM(3);
    if (IN(4)) _Pragma("unroll") for (int _r = 0; _r < 1 + ((REP_MASK >> 4) & 1); ++_r) {
        for (int task = gw; task < 8192 * 8; task += NGW) rw_post_task(P, W, task >> 3, task & 7, lane);
        LAS float* scr = (LAS float*)(lds + RING_OFF + wave * 16384);
        constexpr int I_G = 64 * (D_FF / 32), I_D = (D_FF / 64) * 30;
        for (int it = gw; it < 2 * I_G + I_D; it += NGW) {
            if (it < I_G) p0_transpose_item(args.in[27], 4096, D_FF, Wt_gu, scr, it, lane, RmGU{0});
            else if (it < 2 * I_G) p0_transpose_item(args.in[28], 4096, D_FF, Wt_gu, scr, it - I_G, lane, RmGU{1});
            else { const int r = it - 2 * I_G; const int kb = r / 30, nb = r % 30; p0_transpose_item(args.in[29], D_FF, 4096, Wt_dn, scr, kb * 128 + nb, lane, RmId{}); }
        }
        __syncthreads();
    }
    SEAM(4);
    if (IN(5)) _Pragma("unroll") for (int _r = 0; _r < 1 + ((REP_MASK >> 5) & 1); ++_r) {
#ifdef OLD_TAILS
        { pg8::Gemm g{hbuf, Wt_out, MPAD, 4096, 4096, 4096, 4096}; pg8::StaticOrder S; S.init(MPAD, 4096, G, (int)blockIdx.x);
        pg8::EpiF32Ssq E{args.out + O_Y, 4096, ssq, M_REAL};
        pg8::gemm_phase<pg8::EpiF32Ssq, pg8::StaticOrder, GP_ALIGN, GP_SP2>(lds + RING_OFF, g, S, E); }
#else
        pg8::Gemm g{hbuf, Wt_out, M_PROMPT, 4096, 4096, 4096, 4096}; pg8::StaticOrder S; S.init(M_PROMPT, 4096, G, (int)blockIdx.x);
        pg8::EpiBf16Ssq E{proj, 4096, ssq};
        pg8::gemm_phase<pg8::EpiBf16Ssq, pg8::StaticOrder, GP_ALIGN, GP_SP2>(lds + RING_OFF, g, S, E);
        pg8::Gemm gt{hbuf, Wt_out, MPAD, 4096, 256, 4096, 4096}; pg8::TailOrder St{16 * 16, G, (int)blockIdx.x, 0, 256, 0};
        pg8::EpiF32Part Et{(float*)(ws + WS_PART2), 4096};
        pg8::gemm_phase<pg8::EpiF32Part, pg8::TailOrder, GP_ALIGN, GP_SP2>(lds + RING_OFF, gt, St, Et);
#endif
    }
    SEAM(5);
    if (IN(6)) _Pragma("unroll") for (int _r = 0; _r < 1 + ((REP_MASK >> 6) & 1); ++_r) {
        for (int m = gw; m < M_REAL; m += NGW) {
            const float* xrow = m < M_PROMPT ? x_prompt + (size_t)m * 4096 : x_sample + (size_t)(m - M_PROMPT) * 4096;
            const GAS f32x4* xr = (const GAS f32x4*)xrow + lane; GAS f32x4* tr = (GAS f32x4*)(args.out + O_Y + (size_t)m * 4096) + lane; const GAS f32x4* gr = (const GAS f32x4*)args.in[7] + lane;
            f32x4 v[16]; float s = 0.f;
#ifdef OLD_TAILS
            const bool smp = false;
#else
            const bool smp = m >= M_PROMPT;
#endif
            if (smp) {
                const GAS f32x4* pp = (const GAS f32x4*)(ws + WS_PART2) + (size_t)(m - M_PROMPT) * 1024 + lane;
#pragma unroll
                for (int j = 0; j < 16; ++j) { f32x4 t[16];
#pragma unroll
                    for (int sp = 0; sp < 16; ++sp) t[sp] = pp[(size_t)sp * 128 * 1024 + 64 * j];
                    const f32x4 a = ((t[0] + t[1]) + (t[2] + t[3])) + ((t[4] + t[5]) + (t[6] + t[7])) + (((t[8] + t[9]) + (t[10] + t[11])) + ((t[12] + t[13]) + (t[14] + t[15])));
                    v[j] = a; s += (a.x * a.x + a.y * a.y) + (a.z * a.z + a.w * a.w); }
            } else {
                const GAS v2u* tb = (const GAS v2u*)(proj + (size_t)m * 4096) + lane; v2u tv[16];
#pragma unroll
                for (int j = 0; j < 16; ++j) tv[j] = tb[64 * j];
#pragma unroll
                for (int j = 0; j < 16; ++j) { v[j].x = bflo(tv[j].x); v[j].y = bfhi(tv[j].x); v[j].z = bflo(tv[j].y); v[j].w = bfhi(tv[j].y); }
                s = ssq[(size_t)m * 64 + lane];
            }
            s = wave_sum(s);
            const float rstd = 1.0f / sqrtf(s * (1.f / 4096.f) + NORM_EPS);
#pragma unroll
            for (int hh = 0; hh < 2; ++hh) { f32x4 xv[8], gv[8];
#pragma unroll
                for (int j = 0; j < 8; ++j) { xv[j] = xr[64 * (8 * hh + j)]; gv[j] = gr[64 * (8 * hh + j)]; }
#pragma unroll
                for (int j = 0; j < 8; ++j) { const f32x4 x1 = xv[j] + v[8 * hh + j] * rstd * gv[j]; v[8 * hh + j] = x1;
                    if (smp) tr[64 * (8 * hh + j)] = x1;
                    else { v2u o; o.x = cvt2(x1.x, x1.y); o.y = cvt2(x1.z, x1.w); ((GAS v2u*)(ws + WS_X1B) + (size_t)m * 1024 + lane)[64 * (8 * hh + j)] = o; } } }
            rms_row_to_bf16(v, args.in[25], hbuf + (size_t)m * 4096, lane);
        }
    }
    SEAM(6);
    if (IN(7)) _Pragma("unroll") for (int _r = 0; _r < 1 + ((REP_MASK >> 7) & 1); ++_r) {
        pg8::Gemm g{hbuf, Wt_gu, MPAD, 2 * D_FF, 4096, 4096, 4096}; pg8::StaticOrder S; S.init(MPAD, 2 * D_FF, G, (int)blockIdx.x);
        pg8::EpiSwiGLU E{act, D_FF};
        pg8::gemm_phase<pg8::EpiSwiGLU, pg8::StaticOrder, GP_ALIGN, GP_SP2>(lds + RING_OFF, g, S, E);
    }
    SEAM(7);
    if (IN(8)) _Pragma("unroll") for (int _r = 0; _r < 1 + ((REP_MASK >> 8) & 1); ++_r) {
#ifdef OLD_TAILS
        { pg8::Gemm g{act, Wt_dn, MPAD, 4096, D_FF, D_FF, D_FF}; pg8::StaticOrder S; S.init(MPAD, 4096, G, (int)blockIdx.x);
        pg8::EpiBf16Ssq E{hbuf, 4096, ssq};
        pg8::gemm_phase<pg8::EpiBf16Ssq, pg8::StaticOrder, GP_ALIGN, GP_SP2>(lds + RING_OFF, g, S, E); }
#else
        pg8::Gemm g{act, Wt_dn, M_PROMPT, 4096, D_FF, D_FF, D_FF}; pg8::StaticOrder S; S.init(M_PROMPT, 4096, G, (int)blockIdx.x);
        pg8::EpiBf16Ssq E{hbuf, 4096, ssq};
        pg8::gemm_phase<pg8::EpiBf16Ssq, pg8::StaticOrder, GP_ALIGN, GP_SP2>(lds + RING_OFF, g, S, E);
#ifdef REP_G4MAIN
        pg8::gemm_phase<pg8::EpiBf16Ssq, pg8::StaticOrder, GP_ALIGN, GP_SP2>(lds + RING_OFF, g, S, E);
#endif
        pg8::EpiF32Part Et{(float*)(ws + WS_PART4), 4096};
        pg8::Gemm ga{act, Wt_dn, MPAD, 4096, 768, D_FF, D_FF}; pg8::TailOrder Sa{16 * 6, G, (int)blockIdx.x - 160, 0, 768, 0};
        pg8::gemm_phase<pg8::EpiF32Part, pg8::TailOrder, GP_ALIGN, GP_SP2>(lds + RING_OFF, ga, Sa, Et);
        pg8::Gemm gb{act, Wt_dn, MPAD, 4096, 640, D_FF, D_FF}; pg8::TailOrder Sb{16 * 10, G, (int)blockIdx.x < 160 ? (int)blockIdx.x : -1, 4608, 640, 6};
        pg8::gemm_phase<pg8::EpiF32Part, pg8::TailOrder, GP_ALIGN, GP_SP2>(lds + RING_OFF, gb, Sb, Et);
#ifdef REP_G4TAIL
        pg8::gemm_phase<pg8::EpiF32Part, pg8::TailOrder, GP_ALIGN, GP_SP2>(lds + RING_OFF, ga, Sa, Et);
        pg8::gemm_phase<pg8::EpiF32Part, pg8::TailOrder, GP_ALIGN, GP_SP2>(lds + RING_OFF, gb, Sb, Et);
#endif
#endif
    }
    SEAM(8);
    if (IN(9)) _Pragma("unroll") for (int _r = 0; _r < 1 + ((REP_MASK >> 9) & 1); ++_r) {
        for (int m = gw; m < M_REAL; m += NGW) {
            GAS f32x4* orow = (GAS f32x4*)(args.out + O_Y + (size_t)m * 4096) + lane; const GAS v2u* fr = (const GAS v2u*)(hbuf + (size_t)m * 4096) + lane; const GAS f32x4* gr = (const GAS f32x4*)args.in[26] + lane;
            f32x4 f[16]; float s = 0.f;
#ifdef OLD_TAILS
            const bool smp = false;
#else
            const bool smp = m >= M_PROMPT;
#endif
            if (smp) { const GAS f32x4* fs = (const GAS f32x4*)(ws + WS_PART4) + (size_t)(m - M_PROMPT) * 1024 + lane;
#pragma unroll
                for (int j = 0; j < 16; ++j) { f32x4 t[16];
#pragma unroll
                    for (int sp = 0; sp < 16; ++sp) t[sp] = fs[(size_t)sp * 128 * 1024 + 64 * j];
                    const f32x4 a = ((t[0] + t[1]) + (t[2] + t[3])) + ((t[4] + t[5]) + (t[6] + t[7])) + (((t[8] + t[9]) + (t[10] + t[11])) + ((t[12] + t[13]) + (t[14] + t[15])));
                    f[j] = a; s += (a.x * a.x + a.y * a.y) + (a.z * a.z + a.w * a.w); }
            } else {
                v2u fv[16];
#pragma unroll
                for (int j = 0; j < 16; ++j) fv[j] = fr[64 * j];
                s = ssq[(size_t)m * 64 + lane];
#pragma unroll
                for (int j = 0; j < 16; ++j) { f[j].x = __builtin_bit_cast(float, fv[j].x << 16); f[j].y = __builtin_bit_cast(float, fv[j].x & 0xffff0000u); f[j].z = __builtin_bit_cast(float, fv[j].y << 16); f[j].w = __builtin_bit_cast(float, fv[j].y & 0xffff0000u); }
            }
            s = wave_sum(s);
            const float rstd = 1.0f / sqrtf(s * (1.f / 4096.f) + NORM_EPS);
            const GAS v2u* xb = (const GAS v2u*)(ws + WS_X1B) + (size_t)m * 1024 + lane;
#pragma unroll
            for (int hh = 0; hh < 2; ++hh) { f32x4 xv[8], gv[8];
                if (smp) {
#pragma unroll
                    for (int j = 0; j < 8; ++j) { xv[j] = orow[64 * (8 * hh + j)]; gv[j] = gr[64 * (8 * hh + j)]; }
                } else { v2u xq[8];
#pragma unroll
                    for (int j = 0; j < 8; ++j) { xq[j] = xb[64 * (8 * hh + j)]; gv[j] = gr[64 * (8 * hh + j)]; }
#pragma unroll
                    for (int j = 0; j < 8; ++j) { xv[j].x = bflo(xq[j].x); xv[j].y = bfhi(xq[j].x); xv[j].z = bflo(xq[j].y); xv[j].w = bfhi(xq[j].y); } }
#pragma unroll
                for (int j = 0; j < 8; ++j) orow[64 * (8 * hh + j)] = xv[j] + f[8 * hh + j] * rstd * gv[j]; }
        }
    }
#undef IN
#undef SEAM
}

extern "C" void kernel_launch(void* const* d_in, const int* in_sizes, int n_in, void* d_out, int out_size, void* d_ws, size_t ws_size, hipStream_t stream) {
    static int grid = 0;
    if (grid == 0) {
        if (n_in != 30 || out_size != (int)O_END || ws_size < WS_END) { fprintf(stderr, "kernel_launch: unexpected shapes (n_in %d out %d ws %zu)\n", n_in, out_size, ws_size); grid = -1; return; }
        int dev = 0, cus = 0, per_cu = 0;
        if (hipGetDevice(&dev) != hipSuccess || hipDeviceGetAttribute(&cus, hipDeviceAttributeMultiprocessorCount, dev) != hipSuccess) { grid = -1; return; }
        if (hipFuncSetAttribute((const void*)hymba_fwd, hipFuncAttributeMaxDynamicSharedMemorySize, LDS_BYTES) != hipSuccess) { grid = -1; return; }
        if (hipOccupancyMaxActiveBlocksPerMultiprocessor(&per_cu, (const void*)hymba_fwd, NWAVES * 64, LDS_BYTES) != hipSuccess || per_cu < 1) { fprintf(stderr, "kernel_launch: occupancy query says %d\n", per_cu); }
        (void)hipGetLastError();
        grid = cus;
    }
    if (grid < 0) return;
    if (hipMemsetAsync((char*)d_ws + WS_CTL, 0, CTL_ZERO_BYTES, stream) != hipSuccess) return;
    Args a{};
    for (int i = 0; i < 30; ++i) a.in[i] = (const float*)d_in[i];
    a.out = (float*)d_out; a.ws = (unsigned char*)d_ws;
    if (MK_N_LAUNCHES == 1) { a.ph_lo = 0; a.ph_hi = NPH; hipLaunchKernelGGL(hymba_fwd, dim3(grid), dim3(NWAVES * 64), LDS_BYTES, stream, a); }
    else for (int p = 0; p < NPH; ++p) { a.ph_lo = p; a.ph_hi = p + 1; hipLaunchKernelGGL(hymba_fwd, dim3(grid), dim3(NWAVES * 64), LDS_BYTES, stream, a); }
}
```

```cpp
#include <hip/hip_runtime.h>
#include <cstdio>
#include <cstdint>

namespace pg8 {
#define PG8_LAS __attribute__((address_space(3)))
typedef unsigned short bf16_t;
typedef short bf16x8 __attribute__((ext_vector_type(8)));
typedef float f32x4 __attribute__((ext_vector_type(4)));
typedef unsigned u32x4 __attribute__((ext_vector_type(4)));
constexpr int BM = 256, BK = 64, HALF = 128, HTB = HALF * BK * 2  , STAGE_BYTES = 8 * HTB, NXCD = 8, WGM = 8;

__host__ __device__ __forceinline__ int lds_byte(int r, int c) { const int st = (r >> 4) * 2 + (c >> 5), rr = r & 15, cc = c & 31, ob = rr * 64 + cc * 2; return st * 1024 + (ob ^ (((ob >> 9) & 1) << 5)); }
__host__ __device__ __forceinline__ void stage_rc(int b, int& R, int& C) { const int st = b / 1024, sb = b % 1024, swz = sb ^ (((sb >> 9) & 1) << 5); R = (st >> 1) * 16 + swz / 64; C = (st & 1) * 32 + (swz % 64) / 2; }
__host__ __device__ __forceinline__ int perm32(int rho) { const int n = rho >> 4, i = rho & 15; return 8 * (i >> 2) + 4 * n + (i & 3); }

struct Unit { int pm, pn, ko, pi; };
struct Gemm { const bf16_t* A; const bf16_t* Bt; int M, N, K, lda, ldb; };

struct StaticOrder {
    int nM, nN, nwg, G, c;
    __host__ __device__ void init(int M, int N, int G_, int c_) { nM = M / BM; nN = N / BM; nwg = nM * nN; G = G_; c = c_; }
    __host__ __device__ bool next(int i, Unit& u) const {
        const long L = (long)i * G + c; if (L >= nwg) return false;
        int wgid = (int)L; { const int q = nwg / NXCD, r = nwg % NXCD, xcd = wgid % NXCD, off = wgid / NXCD; wgid = (xcd < r ? xcd * (q + 1) : r * (q + 1) + (xcd - r) * q) + off; }
        const int nig = WGM * nN, gid = wgid / nig, fm = gid * WGM, gsz = (nM - fm) < WGM ? (nM - fm) : WGM;
        u.pm = fm + ((wgid % nig) % gsz); u.pn = (wgid % nig) / gsz; u.ko = 0; u.pi = 0; return true;
    }
    __device__ __forceinline__ void a_ready(const Unit&) const {}
    __device__ __forceinline__ void done(const Unit&) const {}
};
__device__ __forceinline__ unsigned cvt_pk_bf16(float lo, float hi) { unsigned r; asm volatile("v_cvt_pk_bf16_f32 %0, %1, %2" : "=v"(r) : "v"(lo), "v"(hi)); return r; }

struct EpiBf16Plain {
    static constexpr bool PERM = true, AFTER_DRAIN = false;
    bf16_t* O; int ldc;
    __device__ __forceinline__ void operator()(const f32x4 (&acc)[2][2][4][2], const Unit& u, int wr, int wc, int fr, int fq) const {
        const int row0 = u.pm * BM + wr * 64 + fr, col0 = u.pn * BM + wc * 32 + 8 * fq;
#pragma unroll
        for (int ai = 0; ai < 2; ++ai)
#pragma unroll
            for (int m = 0; m < 4; ++m) { bf16_t* rowp = O + (size_t)(row0 + ai * HALF + m * 16) * ldc + col0;
#pragma unroll
                for (int bj = 0; bj < 2; ++bj) { const f32x4 v0 = acc[ai][bj][m][0], v1 = acc[ai][bj][m][1];
                    u32x4 w; w.x = cvt_pk_bf16(v0[0], v0[1]); w.y = cvt_pk_bf16(v0[2], v0[3]); w.z = cvt_pk_bf16(v1[0], v1[1]); w.w = cvt_pk_bf16(v1[2], v1[3]);
                    *(u32x4*)(rowp + bj * HALF) = w; } }
    }
};
__device__ __forceinline__ float silu_f(float x) { return x * __builtin_amdgcn_rcpf(1.0f + __expf(-x)); }
struct EpiSwiGLU {
    static constexpr bool PERM = true, AFTER_DRAIN = false;
    bf16_t* O; int ldc;
    __device__ __forceinline__ void operator()(const f32x4 (&acc)[2][2][4][2], const Unit& u, int wr, int wc, int fr, int fq) const {
        const int row0 = u.pm * BM + wr * 64 + fr, col0 = u.pn * HALF + wc * 32 + 8 * fq;
#pragma unroll
        for (int ai = 0; ai < 2; ++ai)
#pragma unroll
            for (int m = 0; m < 4; ++m) { bf16_t* rowp = O + (size_t)(row0 + ai * HALF + m * 16) * ldc + col0;
                const f32x4 g0 = acc[ai][0][m][0], g1 = acc[ai][0][m][1], u0 = acc[ai][1][m][0], u1 = acc[ai][1][m][1];
                u32x4 w; w.x = cvt_pk_bf16(silu_f(g0[0]) * u0[0], silu_f(g0[1]) * u0[1]); w.y = cvt_pk_bf16(silu_f(g0[2]) * u0[2], silu_f(g0[3]) * u0[3]);
                w.z = cvt_pk_bf16(silu_f(g1[0]) * u1[0], silu_f(g1[1]) * u1[1]); w.w = cvt_pk_bf16(silu_f(g1[2]) * u1[2], silu_f(g1[3]) * u1[3]);
                *(u32x4*)rowp = w; }
    }
};
struct EpiF32Ssq {
    static constexpr bool PERM = false, AFTER_DRAIN = false;
    float* C; int ldc; float* ssq; int mreal;
    __device__ __forceinline__ void operator()(const f32x4 (&acc)[2][2][4][2], const Unit& u, int wr, int wc, int fr, int fq) const {
        const int row0 = u.pm * BM + wr * 64 + fr, col0 = u.pn * BM + wc * 32 + 4 * fq;
#pragma unroll
        for (int ai = 0; ai < 2; ++ai)
#pragma unroll
            for (int m = 0; m < 4; ++m) { const int row = row0 + ai * HALF + m * 16; float s = 0.f;
#pragma unroll
                for (int bj = 0; bj < 2; ++bj)
#pragma unroll
                    for (int n = 0; n < 2; ++n) { const f32x4 v = acc[ai][bj][m][n]; s += (v[0] * v[0] + v[1] * v[1]) + (v[2] * v[2] + v[3] * v[3]);
                        if (row < mreal) *(f32x4*)(C + (size_t)row * ldc + col0 + bj * HALF + n * 16) = v; }
                s += __shfl_xor(s, 16); s += __shfl_xor(s, 32);
                if (fq == 0) ssq[(size_t)row * 64 + u.pn * 4 + wc] = s; }
    }
};
struct EpiBf16Ssq {
    static constexpr bool PERM = true, AFTER_DRAIN = false;
    bf16_t* O; int ldc; float* ssq;
    __device__ __forceinline__ void operator()(const f32x4 (&acc)[2][2][4][2], const Unit& u, int wr, int wc, int fr, int fq) const {
        const int row0 = u.pm * BM + wr * 64 + fr, col0 = u.pn * BM + wc * 32 + 8 * fq;
#pragma unroll
        for (int ai = 0; ai < 2; ++ai)
#pragma unroll
            for (int m = 0; m < 4; ++m) { const int row = row0 + ai * HALF + m * 16; bf16_t* rowp = O + (size_t)row * ldc + col0; float s = 0.f;
#pragma unroll
                for (int bj = 0; bj < 2; ++bj) { const f32x4 v0 = acc[ai][bj][m][0], v1 = acc[ai][bj][m][1];
                    s += (v0[0] * v0[0] + v0[1] * v0[1]) + (v0[2] * v0[2] + v0[3] * v0[3]) + (v1[0] * v1[0] + v1[1] * v1[1]) + (v1[2] * v1[2] + v1[3] * v1[3]);
                    u32x4 w; w.x = cvt_pk_bf16(v0[0], v0[1]); w.y = cvt_pk_bf16(v0[2], v0[3]); w.z = cvt_pk_bf16(v1[0], v1[1]); w.w = cvt_pk_bf16(v1[2], v1[3]);
                    *(u32x4*)(rowp + bj * HALF) = w; }
                s += __shfl_xor(s, 16); s += __shfl_xor(s, 32);
                if (fq == 0) ssq[(size_t)row * 64 + u.pn * 4 + wc] = s; }
    }
};
struct EpiF32Part {
    static constexpr bool PERM = false, AFTER_DRAIN = false;
    float* P; int ldc;
    __device__ __forceinline__ void operator()(const f32x4 (&acc)[2][2][4][2], const Unit& u, int wr, int wc, int fr, int fq) const {
        const int rowl = wr * 64 + fr, col0 = u.pn * BM + wc * 32 + 4 * fq; float* base = P + (size_t)u.pi * 128 * ldc;
#pragma unroll
        for (int m = 0; m < 4; ++m)
#pragma unroll
            for (int bj = 0; bj < 2; ++bj)
#pragma unroll
                for (int n = 0; n < 2; ++n) *(f32x4*)(base + (size_t)(rowl + m * 16) * ldc + col0 + bj * HALF + n * 16) = acc[0][bj][m][n];
    }
};
struct TailOrder {
    int nsub, G, c, kbase, klen, pbase;
    __device__ bool next(int i, Unit& u) const { const int idx = i * G + c; if (c < 0 || idx >= nsub) return false; const int sp = idx >> 4; u.pm = 64; u.pn = idx & 15; u.ko = kbase + sp * klen; u.pi = pbase + sp; return true; }
    __device__ __forceinline__ void a_ready(const Unit&) const {}
    __device__ __forceinline__ void done(const Unit&) const {}
};
struct SubsetOrder {
    int nN, nunits, nw, c;
    __device__ bool next(int i, Unit& u) const { const int idx = i * nw + c; if (c < 0 || idx >= nunits) return false; u.pm = idx / nN; u.pn = idx - u.pm * nN; u.ko = 0; u.pi = 0; return true; }
    __device__ __forceinline__ void a_ready(const Unit&) const {}
    __device__ __forceinline__ void done(const Unit&) const {}
};
template <class Epi, class Sched, bool ALIGN_EPI = false, bool SP2 = false>
__device__ __forceinline__ void gemm_phase(PG8_LAS unsigned char* lds, const Gemm g, const Sched& S, const Epi& E) {
    const int tid = threadIdx.x, wid = __builtin_amdgcn_readfirstlane(tid >> 6), lane = tid & 63, wr = wid >> 2, wc = wid & 3, fr = lane & 15, fq = lane >> 4;
    const int K = g.K, nt = K / BK;
    unsigned voffA[2], voffB[2];
#pragma unroll
    for (int i = 0; i < 2; ++i) { int R, C; stage_rc(tid * 16 + i * 8192, R, C); const int Rb = Epi::PERM ? ((R & ~31) + perm32(R & 31)) : R;
        voffA[i] = (unsigned)(R * g.lda + C) * 2u; voffB[i] = (unsigned)(Rb * g.ldb + C) * 2u; }
    const size_t kstep = (size_t)(BK * 2);
    const size_t hstepA = (size_t)HALF * g.lda * 2, hstepB = (size_t)HALF * g.ldb * 2;
    const size_t tstepA = 2 * hstepA, tstepB = 2 * hstepB;
    const unsigned ldsw = (unsigned)wid * 1024u;
    const int aoff = lds_byte(wr * 64 + fr, fq * 8), boff = lds_byte(wc * 32 + fr, fq * 8);
#define PG8_SA(b, h) (((b) * 2 + (h)) * HTB)
#define PG8_SB(b, h) ((4 + (b) * 2 + (h)) * HTB)
#define PG8_STAGE(bufoff, gbase, voff) do { _Pragma("unroll") for (int _i = 0; _i < 2; ++_i) \
        __builtin_amdgcn_global_load_lds((const unsigned*)((const char*)(gbase) + (voff)[_i]), (PG8_LAS unsigned*)(lds + (bufoff) + ldsw + _i * 8192), 16, 0, 0); } while (0)
#define PG8_LDA(dst, b, h) do { _Pragma("unroll") for (int m = 0; m < 4; ++m) _Pragma("unroll") for (int k = 0; k < 2; ++k) dst[m][k] = *(const PG8_LAS bf16x8*)(lds + PG8_SA(b, h) + aoff + m * 2048 + k * 1024); } while (0)
#define PG8_LDB(dst, b, h) do { _Pragma("unroll") for (int n = 0; n < 2; ++n) _Pragma("unroll") for (int k = 0; k < 2; ++k) dst[n][k] = *(const PG8_LAS bf16x8*)(lds + PG8_SB(b, h) + boff + n * 2048 + k * 1024); } while (0)
#define PG8_MMA(ai, bj, At, Bt) do { __builtin_amdgcn_s_setprio(1); _Pragma("unroll") for (int m = 0; m < 4; ++m) _Pragma("unroll") for (int n = 0; n < 2; ++n) _Pragma("unroll") for (int k = 0; k < 2; ++k) \
        acc[ai][bj][m][n] = __builtin_amdgcn_mfma_f32_16x16x32_bf16(Bt[n][k], At[m][k], acc[ai][bj][m][n], 0, 0, 0); __builtin_amdgcn_s_setprio(0); } while (0)
#define PG8_WAIT_V(n) asm volatile("s_waitcnt vmcnt(" #n ")" ::: "memory")
#define PG8_WAIT_L(n) asm volatile("s_waitcnt lgkmcnt(" #n ")" ::: "memory")
#define PG8_BAR __builtin_amdgcn_s_barrier()
#define PG8_SCHED __builtin_amdgcn_sched_barrier(0)
    Unit cur, nxt; int ui = 0;
    if (!S.next(0, cur)) return;
    f32x4 acc[2][2][4][2];
#pragma unroll
    for (int a = 0; a < 2; ++a)
#pragma unroll
        for (int b = 0; b < 2; ++b)
#pragma unroll
            for (int m = 0; m < 4; ++m)
#pragma unroll
                for (int n = 0; n < 2; ++n) acc[a][b][m][n] = (f32x4){0.f, 0.f, 0.f, 0.f};
    bf16x8 At[4][2], B0[2][2], B1[2][2];
    const char* cA = (const char*)g.A + (size_t)cur.pm * tstepA + (size_t)cur.ko * 2; const char* cB = (const char*)g.Bt + (size_t)cur.pn * tstepB + (size_t)cur.ko * 2;
    S.a_ready(cur);
    if constexpr (SP2) {
        PG8_STAGE(PG8_SB(0, 0), cB, voffB); PG8_STAGE(PG8_SB(0, 1), cB + hstepB, voffB); PG8_STAGE(PG8_SA(0, 0), cA, voffA); PG8_STAGE(PG8_SA(0, 1), cA + hstepA, voffA);
        if (wr == 1) PG8_BAR;
        PG8_WAIT_V(2); PG8_BAR;
        PG8_STAGE(PG8_SB(1, 0), cB + kstep, voffB); PG8_STAGE(PG8_SA(1, 0), cA + kstep, voffA); PG8_STAGE(PG8_SB(1, 1), cB + hstepB + kstep, voffB);
        PG8_WAIT_V(6); PG8_BAR;
    } else {
        PG8_STAGE(PG8_SB(0, 0), cB, voffB); PG8_STAGE(PG8_SA(0, 0), cA, voffA); PG8_STAGE(PG8_SB(0, 1), cB + hstepB, voffB); PG8_STAGE(PG8_SA(0, 1), cA + hstepA, voffA);
        if (wr == 1) PG8_BAR;
        PG8_WAIT_V(4); PG8_BAR;
        PG8_STAGE(PG8_SB(1, 0), cB + kstep, voffB); PG8_STAGE(PG8_SA(1, 0), cA + kstep, voffA); PG8_STAGE(PG8_SB(1, 1), cB + hstepB + kstep, voffB);
        PG8_WAIT_V(6); PG8_BAR;
    }
    for (;;) {
        const bool has_next = S.next(ui + 1, nxt);
        const char* nA = has_next ? (const char*)g.A + (size_t)nxt.pm * tstepA + (size_t)nxt.ko * 2 : cA; const char* nB = has_next ? (const char*)g.Bt + (size_t)nxt.pn * tstepB + (size_t)nxt.ko * 2 : cB;
        for (int t = 0; t < nt; t += 2) {
            const bool last = (t == nt - 2);
            const char* a1 = cA + (size_t)(t + 1) * kstep;
            const char* a2 = last ? nA : cA + (size_t)(t + 2) * kstep; const char* b2 = last ? nB : cB + (size_t)(t + 2) * kstep;
            const char* a3 = a2 + kstep; const char* b3 = b2 + kstep;
            if (last && has_next) S.a_ready(nxt);
            if constexpr (SP2) {
            PG8_LDB(B0, 0, 0); PG8_LDB(B1, 0, 1); PG8_SCHED; PG8_LDA(At, 0, 0); PG8_STAGE(PG8_SA(1, 1), a1 + hstepA, voffA);
            PG8_WAIT_V(8); PG8_WAIT_L(0); PG8_BAR; PG8_MMA(0, 0, At, B0); PG8_MMA(0, 1, At, B1); PG8_BAR; PG8_SCHED;
            PG8_LDA(At, 0, 1); PG8_STAGE(PG8_SB(0, 0), b2, voffB); PG8_STAGE(PG8_SB(0, 1), b2 + hstepB, voffB); PG8_STAGE(PG8_SA(0, 0), a2, voffA);
            PG8_WAIT_V(8); PG8_WAIT_L(0); PG8_BAR; PG8_MMA(1, 0, At, B0); PG8_MMA(1, 1, At, B1); PG8_BAR; PG8_SCHED;
            PG8_LDB(B0, 1, 0); PG8_LDB(B1, 1, 1); PG8_SCHED; PG8_LDA(At, 1, 0); PG8_STAGE(PG8_SA(0, 1), a2 + hstepA, voffA);
            PG8_WAIT_V(8); PG8_WAIT_L(0); PG8_BAR; PG8_MMA(0, 0, At, B0); PG8_MMA(0, 1, At, B1); PG8_BAR; PG8_SCHED;
            PG8_LDA(At, 1, 1); PG8_STAGE(PG8_SB(1, 0), b3, voffB); PG8_STAGE(PG8_SB(1, 1), b3 + hstepB, voffB); PG8_STAGE(PG8_SA(1, 0), a3, voffA);
            PG8_WAIT_V(8); PG8_WAIT_L(0); PG8_BAR; PG8_MMA(1, 0, At, B0); PG8_MMA(1, 1, At, B1); PG8_BAR; PG8_SCHED;
            } else {
            PG8_LDB(B0, 0, 0); PG8_SCHED; PG8_LDA(At, 0, 0); PG8_STAGE(PG8_SA(1, 1), a1 + hstepA, voffA);
            PG8_WAIT_L(8); PG8_BAR; PG8_WAIT_L(0); PG8_MMA(0, 0, At, B0); PG8_BAR; PG8_SCHED;
            PG8_LDB(B1, 0, 1); PG8_STAGE(PG8_SB(0, 0), b2, voffB);
            PG8_BAR; PG8_WAIT_L(0); PG8_MMA(0, 1, At, B1); PG8_BAR;
            PG8_LDA(At, 0, 1); PG8_STAGE(PG8_SA(0, 0), a2, voffA);
            PG8_BAR; PG8_WAIT_L(0); PG8_MMA(1, 0, At, B0); PG8_BAR; PG8_SCHED;
            PG8_STAGE(PG8_SB(0, 1), b2 + hstepB, voffB);
            PG8_WAIT_V(6); PG8_BAR; PG8_MMA(1, 1, At, B1); PG8_BAR;
            PG8_LDB(B0, 1, 0); PG8_SCHED; PG8_LDA(At, 1, 0); PG8_STAGE(PG8_SA(0, 1), a2 + hstepA, voffA);
            PG8_WAIT_L(8); PG8_BAR; PG8_WAIT_L(0); PG8_MMA(0, 0, At, B0); PG8_BAR; PG8_SCHED;
            PG8_LDB(B1, 1, 1); PG8_STAGE(PG8_SB(1, 0), b3, voffB);
            PG8_BAR; PG8_WAIT_L(0); PG8_MMA(0, 1, At, B1); PG8_BAR;
            PG8_LDA(At, 1, 1); PG8_STAGE(PG8_SA(1, 0), a3, voffA);
            PG8_BAR; PG8_WAIT_L(0); PG8_MMA(1, 0, At, B0); PG8_BAR; PG8_SCHED;
            PG8_STAGE(PG8_SB(1, 1), b3 + hstepB, voffB);
            PG8_WAIT_V(6); PG8_BAR; PG8_MMA(1, 1, At, B1); PG8_BAR;
            }
        }
        if constexpr (ALIGN_EPI) { if (wr == 0) PG8_BAR; }
        if constexpr (!Epi::AFTER_DRAIN) { E(acc, cur, wr, wc, fr, fq); S.done(cur); }
        if (!has_next) break;
#pragma unroll
        for (int a = 0; a < 2; ++a)
#pragma unroll
            for (int b = 0; b < 2; ++b)
#pragma unroll
                for (int m = 0; m < 4; ++m)
#pragma unroll
                    for (int n = 0; n < 2; ++n) acc[a][b][m][n] = (f32x4){0.f, 0.f, 0.f, 0.f};
        cur = nxt; cA = nA; cB = nB; ++ui;
        if constexpr (ALIGN_EPI) { if (wr == 1) PG8_BAR; }
    }
    PG8_WAIT_V(0);
    if constexpr (!ALIGN_EPI) { if (wr == 0) PG8_BAR; }
    PG8_BAR;
    if constexpr (Epi::AFTER_DRAIN) { E.fused(acc, cur, wr, wc, fr, fq, lds, wid, lane); S.done(cur); }
#undef PG8_SA
#undef PG8_SB
#undef PG8_STAGE
#undef PG8_LDA
#undef PG8_LDB
#undef PG8_MMA
#undef PG8_WAIT_V
#undef PG8_WAIT_L
#undef PG8_BAR
#undef PG8_SCHED
}
}

constexpr int NWAVES = 8;
constexpr int D_MODEL = 4096, SEQ = 8192, DEC_SEQ = 16;
constexpr int M_PROMPT = 16384, M_REAL = 16512, MPAD = 16640;
constexpr int IN_W = 14816, IN_WP = 14848, D_FF = 11008;
constexpr int PC_Q = 0, PC_K = 2048, PC_V = 4096, PC_Z = 6144, PC_B = 8192, PC_A = 8208, PC_RW = 8224;
constexpr int RW_R = 0, RW_K = 2048, RW_V = 4096, RW_XW = 6144, RW_XA = 6240, RW_XG = 6336, RW_SHIFT_W = 6592;
constexpr float NORM_EPS = 1e-6f, RW_GN_EPS = 64e-5f;
constexpr size_t O_Y = 0, O_SDN_P = 67633152, O_CONV_P = 68157440, O_SRW_P = 68194304, O_SHIFT_P = 68456448,
                 O_SDN_S = 68469632, O_CONV_S = 70566784, O_SRW_S = 70714240, O_SHIFT_S = 71762816, O_END = 71815552;
constexpr size_t MiB = 1u << 20;
constexpr size_t WS_CTL = 0, CTL_ZERO_BYTES = 1 * MiB;
constexpr size_t WS_SSQ = 2 * MiB;
constexpr size_t WS_W2T = 6553600, WS_A2T = WS_W2T + 2048 * 96 * 2, WS_G2T = 7 * MiB;
constexpr size_t WS_WOUT = 8 * MiB;
constexpr size_t WS_HBUF = 40 * MiB;
constexpr size_t WS_PROJ = 170 * MiB;
constexpr size_t WS_WIN = 642 * MiB;
constexpr size_t WS_WGU = 758 * MiB;
constexpr size_t WS_WDN = 930 * MiB;
constexpr size_t WS_END = 1016 * MiB;
constexpr size_t WS_X1B = 520 * MiB;
constexpr size_t WS_PART2 = 710 * MiB, WS_PART4 = 678 * MiB;
constexpr size_t WS_SXG = 742 * MiB;
constexpr size_t WS_DNQK = 642 * MiB, WS_DNGL = 674 * MiB, WS_RWSB = 675 * MiB, WS_RWOO = 678 * MiB, WS_RWPQ = 758 * MiB, WS_RWRP = 886 * MiB;
static_assert(WS_SSQ + (size_t)MPAD * 64 * 4 <= WS_WOUT && WS_HBUF + (size_t)MPAD * 4096 * 2 <= WS_PROJ && WS_PROJ + (size_t)MPAD * IN_WP * 2 <= WS_WIN &&
              WS_WIN + (size_t)IN_WP * 4096 * 2 <= WS_WGU && WS_WGU + (size_t)2 * D_FF * 4096 * 2 <= WS_WDN && WS_WDN + (size_t)4096 * D_FF * 2 <= WS_END, "d_ws map");
constexpr int CW_BAR = 4096;
constexpr int RING_OFF = 0, RING_BYTES = 131072;
constexpr int LDSCTL_OFF = RING_BYTES, MISC_OFF = LDSCTL_OFF + 320;
constexpr int LDS_BYTES = 147456;

#define GAS __attribute__((address_space(1)))
#define LAS __attribute__((address_space(3)))
typedef unsigned short bf16;
typedef unsigned v4u __attribute__((ext_vector_type(4)));
typedef unsigned v2u __attribute__((ext_vector_type(2)));
typedef float f32x4 __attribute__((ext_vector_type(4)));
typedef GAS unsigned gu32;
#define RLX_AGENT __ATOMIC_RELAXED, __HIP_MEMORY_SCOPE_AGENT
#define LDS_WAIT() asm volatile("s_waitcnt lgkmcnt(0)" ::: "memory")
__device__ __forceinline__ unsigned f2bf(float f) { unsigned u = __builtin_bit_cast(unsigned, f); return (u + 0x7fffu + ((u >> 16) & 1u)) >> 16; }
__device__ __forceinline__ unsigned pk2(float lo, float hi) { return f2bf(lo) | (f2bf(hi) << 16); }
__device__ __forceinline__ float bf2f(bf16 b) { return __builtin_bit_cast(float, (unsigned)b << 16); }
__device__ __forceinline__ float bflo(unsigned u) { return __builtin_bit_cast(float, u << 16); }
__device__ __forceinline__ float bfhi(unsigned u) { return __builtin_bit_cast(float, u & 0xffff0000u); }
#ifdef OLD_WAVE_SUM
__device__ __forceinline__ float wave_sum(float v) {
#pragma unroll
    for (int o = 1; o < 64; o <<= 1) v += __shfl_xor(v, o);
    return v;
}
#else
#define WS_DPP(x, ctrl, rmask) __builtin_bit_cast(float, __builtin_amdgcn_update_dpp(0, __builtin_bit_cast(int, (x)), (ctrl), (rmask), 0xf, true))
__device__ __forceinline__ float wave_sum(float v) {
    v += WS_DPP(v, 0xB1, 0xf); v += WS_DPP(v, 0x4E, 0xf); v += WS_DPP(v, 0x141, 0xf); v += WS_DPP(v, 0x140, 0xf);
    v += WS_DPP(v, 0x142, 0xa); v += WS_DPP(v, 0x143, 0xc);
    return __builtin_bit_cast(float, __builtin_amdgcn_readlane(__builtin_bit_cast(int, v), 63));
}
#endif
#ifdef OLD_MATH
__device__ __forceinline__ float sigmoid_f(float x) { return 1.0f / (1.0f + __expf(-x)); }
__device__ __forceinline__ float softplus_f(float x) { return x > 20.f ? x : log1pf(__expf(x)); }
#else
__device__ __forceinline__ float sigmoid_f(float x) { return __builtin_amdgcn_rcpf(1.0f + __expf(-x)); }
__device__ __forceinline__ float softplus_f(float x) { return x > 20.f ? x : __logf(1.0f + __expf(x)); }
#endif
__device__ __forceinline__ void wave_sum8(float (&v)[8]) {
#pragma unroll
    for (int o = 1; o < 64; o <<= 1) {
#pragma unroll
        for (int i = 0; i < 8; ++i) v[i] += __shfl_xor(v[i], o); }
}

#define XB_TMO      128
#define XB_XCNT(j)  (256  + 64 * (j))
#define XB_XSUB(j)  (1280 + 64 * (j))
#define XB_XGEN(j)  (2304 + 64 * (j))
#define XB_TOP      3328
#define XB_TOPGEN   3392
#define XCD_BAR_WORDS 3456
#define XB_SPIN_CAP (1u << 18)

__device__ __forceinline__ unsigned xb_ld(unsigned* p)              { return __hip_atomic_load(p, __ATOMIC_RELAXED, __HIP_MEMORY_SCOPE_AGENT); }
__device__ __forceinline__ unsigned xb_add(unsigned* p, unsigned v) { return __hip_atomic_fetch_add(p, v, __ATOMIC_RELAXED, __HIP_MEMORY_SCOPE_AGENT); }
__device__ __forceinline__ unsigned xb_xcc_id() { return (unsigned)__builtin_amdgcn_s_getreg((3 << 11) | 20) & 0xFu; }
#define XB_SPIN(cond, bar) do { unsigned _sp = 0; while (cond) { __builtin_amdgcn_s_sleep(1); \
    if ((++_sp & 255u) == 0u) { if (xb_ld(&(bar)[XB_TMO])) break; if (_sp > XB_SPIN_CAP) { atomicAdd(&(bar)[XB_TMO], 1u); break; } } } } while (0)

struct XcdBarrier {
    unsigned* bar; unsigned x;
    volatile LAS unsigned* st;
};

__device__ __forceinline__ XcdBarrier xcd_barrier_post(unsigned* bar, volatile LAS unsigned* st) {
    XcdBarrier b; b.bar = bar; b.x = xb_xcc_id(); b.st = st;
    if (threadIdx.x == 0) (void)xb_add(&bar[XB_XCNT(b.x)], 1u);
    return b;
}
__device__ __forceinline__ void xcd_barrier_complete(unsigned* bar, unsigned x, unsigned& nloc, unsigned& nx) {
    const unsigned G = gridDim.x * gridDim.y * gridDim.z;
    unsigned sum, cnt, mine, sp = 0u;
    for (;;) {
        sum = 0u; cnt = 0u; mine = 0u;
#pragma unroll
        for (unsigned j = 0; j < 16; ++j) { const unsigned c = xb_ld(&bar[XB_XCNT(j)]); sum += c; cnt += (c > 0u) ? 1u : 0u; mine = (j == x) ? c : mine; }
        if (sum == G) break;
        __builtin_amdgcn_s_sleep(1);
        if ((++sp & 255u) == 0u) { if (xb_ld(&bar[XB_TMO])) break; if (sp > XB_SPIN_CAP) { atomicAdd(&bar[XB_TMO], 1u); break; } }
    }
    nloc = mine > 0u ? mine : 1u; nx = cnt > 0u ? cnt : 1u;
}

__device__ __forceinline__ void xcd_barrier(const XcdBarrier& b) {
    asm volatile("s_waitcnt vmcnt(0)" ::: "memory");
    __syncthreads();
    if (threadIdx.x == 0) {
        unsigned* bar = b.bar;
        __builtin_amdgcn_s_waitcnt(0);
        unsigned nloc = b.st[0], nx = b.st[1];
        if (nloc == 0u) { xcd_barrier_complete(bar, b.x, nloc, nx); b.st[0] = nloc; b.st[1] = nx; }
        const unsigned old = xb_add(&bar[XB_XSUB(b.x)], 1u);
        const unsigned gen = old / nloc;
        if (old + 1u == (gen + 1u) * nloc) {
            __builtin_amdgcn_fence(__ATOMIC_RELEASE, "agent");
            asm volatile("s_waitcnt vmcnt(0)" ::: "memory");
            const unsigned og = xb_add(&bar[XB_TOP], 1u);
            const unsigned tg = og / nx;
            if (og + 1u == (tg + 1u) * nx) xb_add(&bar[XB_TOPGEN], 1u);
            else XB_SPIN(xb_ld(&bar[XB_TOPGEN]) == tg, bar);
            __builtin_amdgcn_fence(__ATOMIC_ACQUIRE, "agent");
            xb_add(&bar[XB_XGEN(b.x)], 1u);
            asm volatile("s_waitcnt vmcnt(0)" ::: "memory");
        } else {
            XB_SPIN(xb_ld(&bar[XB_XGEN(b.x)]) == gen, bar);
            __builtin_amdgcn_fence(__ATOMIC_ACQUIRE, "agent");
            asm volatile("s_waitcnt vmcnt(0)" ::: "memory");
        }
    }
    __syncthreads();
}

struct Frame {
    LAS unsigned char* lds;
    volatile LAS unsigned* MISC;
    gu32* ctl;
    int tid, lane, wave, G;
    const float* const* in;
};
struct Args { const float* in[30]; float* out; unsigned char* ws; int ph_lo, ph_hi; };

template <class RowMap>
__device__ __forceinline__ void p0_transpose_item(const float* W, int K, int N, bf16* WT, LAS float* scr, int item, int lane, RowMap rm) {
    const int nblk = N / 32, kb = item / nblk, nb = item % nblk, k0 = 64 * kb, n0 = 32 * nb;
#pragma unroll 8
    for (int i = 0; i < 32; ++i) { const int kk = 2 * i + (lane >> 5); scr[kk * 33 + (lane & 31)] = W[(size_t)(k0 + kk) * N + n0 + (lane & 31)]; }
    LDS_WAIT(); asm volatile("" ::: "memory");
    const int c = lane & 7;
#pragma unroll
    for (int j = 0; j < 4; ++j) { const int n = (lane >> 3) + 8 * j; const LAS float* s = scr + (8 * c) * 33 + n;
        v4u o; o.x = pk2(s[0 * 33], s[1 * 33]); o.y = pk2(s[2 * 33], s[3 * 33]); o.z = pk2(s[4 * 33], s[5 * 33]); o.w = pk2(s[6 * 33], s[7 * 33]);
        *(GAS v4u*)(WT + (size_t)rm(n0 + n) * K + k0 + 8 * c) = o; }
    LDS_WAIT(); asm volatile("" ::: "memory");
}
struct RmId { __device__ __forceinline__ int operator()(int n) const { return n; } };
struct RmGU { int up; __device__ __forceinline__ int operator()(int n) const { return (n >> 7) * 256 + up * 128 + (n & 127); } };

__device__ __forceinline__ void rms_row_to_bf16(const f32x4 (&v)[16], const float* g, bf16* orow, int lane) {
    float s = 0.f;
#pragma unroll
    for (int j = 0; j < 16; ++j) s += (v[j].x * v[j].x + v[j].y * v[j].y) + (v[j].z * v[j].z + v[j].w * v[j].w);
    const float rstd = 1.0f / sqrtf(wave_sum(s) * (1.f / 4096.f) + NORM_EPS);
    const GAS f32x4* gr = (const GAS f32x4*)g + lane; GAS v2u* o8 = (GAS v2u*)orow + lane;
#pragma unroll
    for (int hh = 0; hh < 2; ++hh) { f32x4 gv[8];
#pragma unroll
        for (int j = 0; j < 8; ++j) gv[j] = gr[64 * (8 * hh + j)];
#pragma unroll
        for (int j = 0; j < 8; ++j) { const f32x4 x = v[8 * hh + j]; v2u o; o.x = pk2(x.x * rstd * gv[j].x, x.y * rstd * gv[j].y); o.y = pk2(x.z * rstd * gv[j].z, x.w * rstd * gv[j].w); o8[64 * (8 * hh + j)] = o; } }
}

struct MixPtrs {
    const bf16* proj; bf16* mix;
    const float *state_dn, *cache_conv, *state_rw, *cache_shift;
    const float *conv_w, *a_log, *dt_bias, *dn_norm_w;
    const float *mu, *w0, *w2, *a0, *a2, *g2, *k_k, *k_a, *r_k, *ln_w, *ln_b;
    float* out;
};
__device__ __forceinline__ void dn_seq_item(const MixPtrs& P, LAS unsigned char* lds, int seq, int h, int tid, int lane, int wave) {
    const bool prm = seq < 2;
    const int T = prm ? SEQ : DEC_SEQ, sb = prm ? seq : seq - 2;
    const int m0 = prm ? seq * SEQ : M_PROMPT + sb * DEC_SEQ;
    const float* S0 = prm ? nullptr : P.state_dn + ((size_t)sb * 16 + h) * 16384;
    const float* cbuf = prm ? nullptr : P.cache_conv + (size_t)sb * 3 * 6144;
    float* Sout = P.out + (prm ? O_SDN_P : O_SDN_S) + ((size_t)sb * 16 + h) * 16384;
    float* cout = P.out + (prm ? O_CONV_P : O_CONV_S) + (size_t)sb * 3 * 6144;
    LAS float* qs = (LAS float*)lds; LAS float* ks = qs + 2048; LAS float* vs = ks + 2048; LAS float* zs = vs + 2048; LAS float* os = zs + 2048; LAS float* bet = os + 2048; LAS float* gg = bet + 16;
    float S[32];
    const int e = wave * 16 + (lane >> 2), dq = lane & 3;
#pragma unroll
    for (int j = 0; j < 32; ++j) S[j] = (S0 != nullptr) ? S0[(32 * dq + j) * 128 + e] : 0.f;
    const float Ah = -__expf(P.a_log[h]), dtb = P.dt_bias[h];
    for (int tb = 0; tb < T; tb += 16) {
        for (int i = tid; i < 16 * 384; i += 512) { const int t = i / 384, cc = i - t * 384, sec = cc >> 7, d = cc & 127, col = sec * 2048 + h * 128 + d;
            float acc = 0.f;
#pragma unroll
            for (int j = 0; j < 4; ++j) { const int tt = tb + t - 3 + j; float xv;
                if (tt >= 0) xv = bf2f(P.proj[(size_t)(m0 + tt) * IN_WP + col]); else xv = cbuf ? cbuf[(3 + tt) * 6144 + col] : 0.f;
                acc += xv * P.conv_w[j * 6144 + col]; }
            const float y = acc * sigmoid_f(acc);
            (sec == 0 ? qs : (sec == 1 ? ks : vs))[t * 128 + d] = y; }
        for (int i = tid; i < 16 * 128; i += 512) { const int t = i >> 7, d = i & 127; zs[i] = bf2f(P.proj[(size_t)(m0 + tb + t) * IN_WP + PC_Z + h * 128 + d]); }
        if (tid < 16) { const size_t r = (size_t)(m0 + tb + tid) * IN_WP; const float b = bf2f(P.proj[r + PC_B + h]), a = bf2f(P.proj[r + PC_A + h]);
            bet[tid] = sigmoid_f(b); gg[tid] = Ah * softplus_f(a + dtb); }
        __syncthreads();
#pragma unroll
        for (int r = 0; r < 2; ++r) { const int t = 2 * wave + r;
            const float q0 = qs[t * 128 + lane], q1 = qs[t * 128 + 64 + lane], k0 = ks[t * 128 + lane], k1 = ks[t * 128 + 64 + lane];
            const float sq = wave_sum(q0 * q0 + q1 * q1), sk = wave_sum(k0 * k0 + k1 * k1);
            const float cq = 0.08838834764831845f / sqrtf(sq + 1e-6f), ck = 1.0f / sqrtf(sk + 1e-6f);
            qs[t * 128 + lane] = q0 * cq; qs[t * 128 + 64 + lane] = q1 * cq; ks[t * 128 + lane] = k0 * ck; ks[t * 128 + 64 + lane] = k1 * ck; }
        __syncthreads();
        {
#pragma unroll 1
            for (int t = 0; t < 16; ++t) {
                const float eg = __expf(gg[t]), bt = bet[t];
                float kS = 0.f;
#pragma unroll
                for (int d4 = 0; d4 < 8; ++d4) { const f32x4 kv = *(const LAS f32x4*)(ks + t * 128 + 32 * dq + 4 * d4);
                    kS += kv.x * S[4 * d4] + kv.y * S[4 * d4 + 1] + kv.z * S[4 * d4 + 2] + kv.w * S[4 * d4 + 3]; }
                kS += __shfl_xor(kS, 1); kS += __shfl_xor(kS, 2);
                const float w = bt * (vs[t * 128 + e] - eg * kS);
                float o = 0.f;
#pragma unroll
                for (int d4 = 0; d4 < 8; ++d4) { const f32x4 kv = *(const LAS f32x4*)(ks + t * 128 + 32 * dq + 4 * d4); const f32x4 qv = *(const LAS f32x4*)(qs + t * 128 + 32 * dq + 4 * d4);
                    S[4 * d4] = eg * S[4 * d4] + kv.x * w; S[4 * d4 + 1] = eg * S[4 * d4 + 1] + kv.y * w; S[4 * d4 + 2] = eg * S[4 * d4 + 2] + kv.z * w; S[4 * d4 + 3] = eg * S[4 * d4 + 3] + kv.w * w;
                    o += qv.x * S[4 * d4] + qv.y * S[4 * d4 + 1] + qv.z * S[4 * d4 + 2] + qv.w * S[4 * d4 + 3]; }
                o += __shfl_xor(o, 1); o += __shfl_xor(o, 2);
                if (dq == 0) os[t * 128 + e] = o;
            }
        }
        __syncthreads();
#pragma unroll
        for (int r = 0; r < 2; ++r) { const int t = 2 * wave + r;
            const float o0 = os[t * 128 + lane], o1 = os[t * 128 + 64 + lane];
            const float rs = 1.0f / sqrtf(wave_sum(o0 * o0 + o1 * o1) * (1.f / 128.f) + NORM_EPS);
            const float z0 = zs[t * 128 + lane], z1 = zs[t * 128 + 64 + lane];
            bf16* mp = P.mix + (size_t)(m0 + tb + t) * 4096 + h * 128;
            mp[lane] = (bf16)f2bf(o0 * rs * P.dn_norm_w[lane] * (z0 * sigmoid_f(z0))); mp[64 + lane] = (bf16)f2bf(o1 * rs * P.dn_norm_w[64 + lane] * (z1 * sigmoid_f(z1))); }
        __syncthreads();
    }
    { int so = 32 * dq * 128 + e;
#ifndef NO_LAUNDER
    asm volatile("" : "+v"(so));
#endif

#pragma unroll
    for (int j = 0; j < 32; ++j) Sout[so + j * 128] = S[j]; }
    for (int i = tid; i < 3 * 384; i += 512) { const int r = i / 384, cc = i - r * 384, col = (cc >> 7) * 2048 + h * 128 + (cc & 127);
        cout[r * 6144 + col] = bf2f(P.proj[(size_t)(m0 + T - 3 + r) * IN_WP + col]); }
}
__device__ __forceinline__ void rw_seq_item(const MixPtrs& P, const bf16* w2T_, const bf16* a2T_, const bf16* g2T_, LAS unsigned char* lds, int seq, int h, int tid, int lane, int wave) {
    const bool prm = seq < 2;
    const int T = prm ? SEQ : DEC_SEQ, sb = prm ? seq : seq - 2;
    const int m0 = prm ? seq * SEQ : M_PROMPT + sb * DEC_SEQ;
    const float* S0 = prm ? nullptr : P.state_rw + ((size_t)sb * 32 + h) * 4096;
    const float* sbuf = prm ? nullptr : P.cache_shift + (size_t)sb * RW_SHIFT_W;
    float* Sout = P.out + (prm ? O_SRW_P : O_SRW_S) + ((size_t)sb * 32 + h) * 4096;
    float* shout = P.out + (prm ? O_SHIFT_P : O_SHIFT_S) + (size_t)sb * RW_SHIFT_W;
    LAS float* rs = (LAS float*)lds; LAS float* kr = rs + 1024; LAS float* vs = kr + 1024; LAS float* xw = vs + 1024; LAS float* xa = xw + 1536; LAS float* xg = xa + 1536;
    LAS float* wd = xg + 4096; LAS float* kp = wd + 1024; LAS float* av = kp + 1024; LAS float* bv = av + 1024; LAS float* gt = bv + 1024; LAS float* ys = gt + 1024; LAS float* sbn = ys + 1024;
    float S[16];
    const int vr = (wave & 3) * 16 + (lane >> 2), kq = lane & 3;
#pragma unroll
    for (int k4 = 0; k4 < 4; ++k4) { f32x4 v = (f32x4){0.f, 0.f, 0.f, 0.f}; if (S0 != nullptr) v = *(const f32x4*)(S0 + vr * 64 + 16 * kq + 4 * k4);
        S[4 * k4] = v.x; S[4 * k4 + 1] = v.y; S[4 * k4 + 2] = v.z; S[4 * k4 + 3] = v.w; }
    const int hc = h * 64 + lane;
    const float w0c = P.w0[hc], a0c = P.a0[hc], kkc = P.k_k[hc], kac = P.k_a[hc], rkc = P.r_k[hc], lnw = P.ln_w[hc], lnb = P.ln_b[hc];
    for (int tb = 0; tb < T; tb += 16) {
        for (int i = tid; i < 16 * 640; i += 512) { const int t = i / 640, cc = i - t * 640; int col; LAS float* dst; int kind = 0;
            if (cc < 64) { col = RW_R + h * 64 + cc; dst = rs + t * 64 + cc; }
            else if (cc < 128) { col = RW_K + h * 64 + (cc - 64); dst = kr + t * 64 + (cc - 64); }
            else if (cc < 192) { col = RW_V + h * 64 + (cc - 128); dst = vs + t * 64 + (cc - 128); }
            else if (cc < 288) { col = RW_XW + (cc - 192); dst = xw + t * 96 + (cc - 192); kind = 1; }
            else if (cc < 384) { col = RW_XA + (cc - 288); dst = xa + t * 96 + (cc - 288); }
            else { col = RW_XG + (cc - 384); dst = xg + t * 256 + (cc - 384); kind = 2; }
            const int tt = tb + t; const float u = bf2f(P.proj[(size_t)(m0 + tt) * IN_WP + PC_RW + col]);
            const float up = tt > 0 ? bf2f(P.proj[(size_t)(m0 + tt - 1) * IN_WP + PC_RW + col]) : (sbuf ? sbuf[col] : 0.f);
            float v = u + P.mu[col] * (up - u);
            if (kind == 1) v = tanhf(v); else if (kind == 2) v = sigmoid_f(v);
            *dst = v; }
        __syncthreads();
        {
            float wl0 = 0.f, wl1 = 0.f, al0 = 0.f, al1 = 0.f, gl0 = 0.f, gl1 = 0.f; const int t0 = wave, t1 = wave + 8;
#ifdef OLD_SEQ
#pragma unroll 4
            for (int j = 0; j < 96; ++j) { const float w2v = P.w2[j * 2048 + hc], a2v = P.a2[j * 2048 + hc];
                wl0 += xw[t0 * 96 + j] * w2v; wl1 += xw[t1 * 96 + j] * w2v; al0 += xa[t0 * 96 + j] * a2v; al1 += xa[t1 * 96 + j] * a2v; }
#pragma unroll 4
            for (int j = 0; j < 256; ++j) { const float g2v = P.g2[j * 2048 + hc]; gl0 += xg[t0 * 256 + j] * g2v; gl1 += xg[t1 * 256 + j] * g2v; }
#else
#define SEQ_DOT8(W8, X0, X1, A0, A1) do { const v4u _w = (W8); const LAS float* _x0 = (X0); const LAS float* _x1 = (X1); \
                const f32x4 _p0 = *(const LAS f32x4*)_x0, _p1 = *(const LAS f32x4*)(_x0 + 4), _q0 = *(const LAS f32x4*)_x1, _q1 = *(const LAS f32x4*)(_x1 + 4); \
                const float _w0 = bflo(_w.x), _w1 = bfhi(_w.x), _w2 = bflo(_w.y), _w3 = bfhi(_w.y), _w4 = bflo(_w.z), _w5 = bfhi(_w.z), _w6 = bflo(_w.w), _w7 = bfhi(_w.w); \
                A0 += (_p0.x * _w0 + _p0.y * _w1) + (_p0.z * _w2 + _p0.w * _w3) + (_p1.x * _w4 + _p1.y * _w5) + (_p1.z * _w6 + _p1.w * _w7); \
                A1 += (_q0.x * _w0 + _q0.y * _w1) + (_q0.z * _w2 + _q0.w * _w3) + (_q1.x * _w4 + _q1.y * _w5) + (_q1.z * _w6 + _q1.w * _w7); } while (0)
#pragma unroll 1
            for (int cch = 0; cch < 3; ++cch) { v4u wv[4], av2[4];
#pragma unroll
                for (int p = 0; p < 4; ++p) { wv[p] = *(const GAS v4u*)(w2T_ + (size_t)hc * 96 + 32 * cch + 8 * p); av2[p] = *(const GAS v4u*)(a2T_ + (size_t)hc * 96 + 32 * cch + 8 * p); }
#pragma unroll
                for (int p = 0; p < 4; ++p) { const int j = 32 * cch + 8 * p; SEQ_DOT8(wv[p], xw + t0 * 96 + j, xw + t1 * 96 + j, wl0, wl1); SEQ_DOT8(av2[p], xa + t0 * 96 + j, xa + t1 * 96 + j, al0, al1); } }
#pragma unroll 1
            for (int cch = 0; cch < 8; ++cch) { v4u gv[4];
#pragma unroll
                for (int p = 0; p < 4; ++p) gv[p] = *(const GAS v4u*)(g2T_ + (size_t)hc * 256 + 32 * cch + 8 * p);
#pragma unroll
                for (int p = 0; p < 4; ++p) { const int j = 32 * cch + 8 * p; SEQ_DOT8(gv[p], xg + t0 * 256 + j, xg + t1 * 256 + j, gl0, gl1); } }
#undef SEQ_DOT8
#endif
#pragma unroll
            for (int r = 0; r < 2; ++r) { const int t = r ? t1 : t0; const float wl = r ? wl1 : wl0, al = r ? al1 : al0, gl = r ? gl1 : gl0;
                const float wlog = -softplus_f(-(w0c + wl)) - 0.5f; const float wdec = __expf(-__expf(wlog));
                const float a = sigmoid_f(a0c + al);
                const float krv = kr[t * 64 + lane], kkr = krv * kkc; const float kk = kkr / sqrtf(wave_sum(kkr * kkr) + 1e-6f);
                const float kpv = krv * (1.0f + (a - 1.0f) * kac);
                const float sbv = wave_sum(rs[t * 64 + lane] * kpv * rkc);
                wd[t * 64 + lane] = wdec; kp[t * 64 + lane] = kpv; av[t * 64 + lane] = -kk; bv[t * 64 + lane] = kk * a; gt[t * 64 + lane] = gl; if (lane == 0) sbn[t] = sbv; }
        }
        __syncthreads();
        if (wave < 4) {
#pragma unroll 1
            for (int t = 0; t < 16; ++t) {
                float sa = 0.f;
#pragma unroll
                for (int k4 = 0; k4 < 4; ++k4) { const f32x4 a4 = *(const LAS f32x4*)(av + t * 64 + 16 * kq + 4 * k4); sa += a4.x * S[4 * k4] + a4.y * S[4 * k4 + 1] + a4.z * S[4 * k4 + 2] + a4.w * S[4 * k4 + 3]; }
                sa += __shfl_xor(sa, 1); sa += __shfl_xor(sa, 2);
                const float vv = vs[t * 64 + vr]; float y = 0.f;
#pragma unroll
                for (int k4 = 0; k4 < 4; ++k4) { const int o4 = t * 64 + 16 * kq + 4 * k4;
                    const f32x4 w4 = *(const LAS f32x4*)(wd + o4), b4 = *(const LAS f32x4*)(bv + o4), k4v = *(const LAS f32x4*)(kp + o4), r4 = *(const LAS f32x4*)(rs + o4);
                    S[4 * k4] = S[4 * k4] * w4.x + sa * b4.x + vv * k4v.x; S[4 * k4 + 1] = S[4 * k4 + 1] * w4.y + sa * b4.y + vv * k4v.y;
                    S[4 * k4 + 2] = S[4 * k4 + 2] * w4.z + sa * b4.z + vv * k4v.z; S[4 * k4 + 3] = S[4 * k4 + 3] * w4.w + sa * b4.w + vv * k4v.w;
                    y += r4.x * S[4 * k4] + r4.y * S[4 * k4 + 1] + r4.z * S[4 * k4 + 2] + r4.w * S[4 * k4 + 3]; }
                y += __shfl_xor(y, 1); y += __shfl_xor(y, 2);
                if (kq == 0) ys[t * 64 + vr] = y;
            }
        }
        __syncthreads();
#pragma unroll
        for (int r = 0; r < 2; ++r) { const int t = wave + 8 * r; const float y = ys[t * 64 + lane];
            const float mean = wave_sum(y) * (1.f / 64.f); const float dy = y - mean; const float var = wave_sum(dy * dy) * (1.f / 64.f);
            const float yn = dy / sqrtf(var + RW_GN_EPS) * lnw + lnb;
            P.mix[(size_t)(m0 + tb + t) * 4096 + 2048 + hc] = (bf16)f2bf((yn + sbn[t] * vs[t * 64 + lane]) * gt[t * 64 + lane]); }
        __syncthreads();
    }
    if (wave < 4) { int so = vr * 64 + 16 * kq;
#ifndef NO_LAUNDER
    asm volatile("" : "+v"(so));
#endif
#pragma unroll
        for (int k4 = 0; k4 < 4; ++k4) *(f32x4*)(Sout + so + 4 * k4) = (f32x4){S[4 * k4], S[4 * k4 + 1], S[4 * k4 + 2], S[4 * k4 + 3]};
    }
    for (int i = tid; i < 206; i += 512) { const int col = h * 206 + i; shout[col] = bf2f(P.proj[(size_t)(m0 + T - 1) * IN_WP + PC_RW + col]); }
}

typedef short bf16x8 __attribute__((ext_vector_type(8)));
typedef float f32x16 __attribute__((ext_vector_type(16)));
typedef __bf16 bf16x2_t __attribute__((ext_vector_type(2)));
typedef float f32x2_t __attribute__((ext_vector_type(2)));
__device__ __forceinline__ unsigned cvt2(float lo, float hi) { f32x2_t v = {lo, hi}; return __builtin_bit_cast(unsigned, __builtin_convertvector(v, bf16x2_t)); }
#define MFMA16(a, b, c) __builtin_amdgcn_mfma_f32_16x16x32_bf16((a), (b), (c), 0, 0, 0)
#define MFMA32(a, b, c) __builtin_amdgcn_mfma_f32_32x32x16_bf16((a), (b), (c), 0, 0, 0)
__device__ __forceinline__ bf16x8 pack_step(const f32x16& x, int s) {
    v4u p; p.x = cvt2(x[8 * s], x[8 * s + 1]); p.y = cvt2(x[8 * s + 2], x[8 * s + 3]); p.z = cvt2(x[8 * s + 4], x[8 * s + 5]); p.w = cvt2(x[8 * s + 6], x[8 * s + 7]);
    return __builtin_bit_cast(bf16x8, p);
}
struct DnRec { unsigned char* rec; unsigned char* qk; float* gl; };
constexpr int DP_QN = 0, DP_KN = 17408, DP_VBT = 34816, DP_KBGT = 53248, DP_LM = 71680, DP_TM = 88320, DP_TB = 104960, DP_DINV = 114176, DP_YB = 118528, DP_SC = 122688;

__device__ __forceinline__ void tri_inv64(const LAS float* Lm, LAS float* Tm, LAS bf16* Tb, LAS float* Dinv, LAS float* Yb, int tid, int lane, int wave) {
    if (tid < 64) { const int bi = tid >> 4, j = tid & 15; float x[16];
#pragma unroll
        for (int r = 0; r < 16; ++r) { float a = (r == j) ? 1.f : 0.f;
#pragma unroll
            for (int k = 0; k < r; ++k) a -= Lm[(16 * bi + r) * 65 + 16 * bi + k] * x[k];
            x[r] = a; }
#pragma unroll
        for (int r = 0; r < 16; ++r) Dinv[(bi * 16 + r) * 17 + j] = x[r]; }
    __syncthreads();
    for (int o = tid; o < 4096; o += 512) { const int r = o >> 6, c = o & 63, bi = r >> 4;
        if (c >= 16 * bi) { const float a = (c < 16 * bi + 16) ? Dinv[r * 17 + c - 16 * bi] : 0.f; Tm[r * 65 + c] = a; Tb[r * 72 + c] = (bf16)(cvt2(a, 0.f) & 0xffffu); } }
    __syncthreads();
    const int l15 = lane & 15, q = lane >> 4;
#pragma unroll 1
    for (int i = 1; i < 4; ++i) {
        if (wave < i) { f32x4 acc = (f32x4){0.f, 0.f, 0.f, 0.f};
            for (int ks = 0; ks < 4 * i; ++ks) acc = __builtin_amdgcn_mfma_f32_16x16x4f32(Lm[(16 * i + l15) * 65 + 4 * ks + q], Tm[(4 * ks + q) * 65 + 16 * wave + l15], acc, 0, 0, 0);
#pragma unroll
            for (int reg = 0; reg < 4; ++reg) Yb[(4 * q + reg) * 65 + 16 * wave + l15] = -acc[reg]; }
        __syncthreads();
        if (wave < i) { f32x4 acc = (f32x4){0.f, 0.f, 0.f, 0.f};
#pragma unroll
            for (int ks = 0; ks < 4; ++ks) acc = __builtin_amdgcn_mfma_f32_16x16x4f32(Dinv[(16 * i + l15) * 17 + 4 * ks + q], Yb[(4 * ks + q) * 65 + 16 * wave + l15], acc, 0, 0, 0);
#pragma unroll
            for (int reg = 0; reg < 4; ++reg) { Tm[(16 * i + 4 * q + reg) * 65 + 16 * wave + l15] = acc[reg]; Tb[(16 * i + 4 * q + reg) * 72 + 16 * wave + l15] = (bf16)(cvt2(acc[reg], 0.f) & 0xffffu); } }
        __syncthreads();
    }
}

__device__ __forceinline__ void dn_prep_item(const MixPtrs& P, const DnRec& R, LAS unsigned char* lds, int b, int c, int h, int tid, int lane, int wave) {
    const int m0 = b * SEQ + 64 * c; const int item = (b * 128 + c) * 16 + h;
    LAS bf16* Qn = (LAS bf16*)(lds + DP_QN); LAS bf16* Kn = (LAS bf16*)(lds + DP_KN); LAS bf16* VbT = (LAS bf16*)(lds + DP_VBT); LAS bf16* KbgT = (LAS bf16*)(lds + DP_KBGT);
    LAS float* Lm = (LAS float*)(lds + DP_LM); LAS float* Tm = (LAS float*)(lds + DP_TM); LAS bf16* Tb = (LAS bf16*)(lds + DP_TB); LAS float* Dinv = (LAS float*)(lds + DP_DINV); LAS float* Yb = (LAS float*)(lds + DP_YB);
    LAS float* sc = (LAS float*)(lds + DP_SC); LAS float* beta = sc; LAS float* gc = sc + 64; LAS float* egc = sc + 128; LAS float* ekd = sc + 192;
    unsigned char* rec = R.rec + (size_t)item * 65536; unsigned char* qkr = R.qk + (size_t)item * 8192;
    if (wave == 0) { const int t = lane; const size_t r = (size_t)(m0 + t) * IN_WP; const float bb = bf2f(P.proj[r + PC_B + h]), aa = bf2f(P.proj[r + PC_A + h]);
        const float Ah = -__expf(P.a_log[h]), dtb = P.dt_bias[h];
        float x = Ah * softplus_f(aa + dtb);
#pragma unroll
        for (int o = 1; o < 64; o <<= 1) { const float v = __shfl_up(x, o); if (lane >= o) x += v; }
        const float gl = __shfl(x, 63);
        beta[t] = sigmoid_f(bb); gc[t] = x; egc[t] = __expf(x); ekd[t] = __expf(gl - x); if (lane == 0) R.gl[item] = __expf(gl); }
    __syncthreads();
#ifdef PD1
    for (int _pr = 0; _pr < 2; ++_pr)
#endif
#pragma unroll
    for (int r = 0; r < 6; ++r) {
        const int sec = r >> 1; const int idx = (tid + 512 * r) & 1023; const int t = idx >> 4, g8 = idx & 15; const int col = sec * 2048 + h * 128 + 8 * g8;
        float acc[8];
#pragma unroll
        for (int i = 0; i < 8; ++i) acc[i] = 0.f;
#pragma unroll
        for (int j = 0; j < 4; ++j) { const int tt = 64 * c + t - 3 + j;
            v4u xv = (v4u){0u, 0u, 0u, 0u}; if (tt >= 0) xv = *(const GAS v4u*)(P.proj + (size_t)(b * SEQ + tt) * IN_WP + col);
            const f32x4 w0 = *(const GAS f32x4*)(P.conv_w + j * 6144 + col), w1 = *(const GAS f32x4*)(P.conv_w + j * 6144 + col + 4);
            acc[0] += bflo(xv.x) * w0.x; acc[1] += bfhi(xv.x) * w0.y; acc[2] += bflo(xv.y) * w0.z; acc[3] += bfhi(xv.y) * w0.w;
            acc[4] += bflo(xv.z) * w1.x; acc[5] += bfhi(xv.z) * w1.y; acc[6] += bflo(xv.w) * w1.z; acc[7] += bfhi(xv.w) * w1.w; }
        float y[8]; float ss = 0.f;
#pragma unroll
        for (int i = 0; i < 8; ++i) { y[i] = acc[i] * sigmoid_f(acc[i]); ss += y[i] * y[i]; }
        if (sec < 2) { ss += __shfl_xor(ss, 1); ss += __shfl_xor(ss, 2); ss += __shfl_xor(ss, 4); ss += __shfl_xor(ss, 8);
            const float scl = (sec == 0 ? 0.08838834764831845f : 1.0f) * __builtin_amdgcn_rsqf(ss + 1e-6f);
#pragma unroll
            for (int i = 0; i < 8; ++i) y[i] *= scl; }
        if (sec == 0) { v4u o; o.x = cvt2(y[0], y[1]); o.y = cvt2(y[2], y[3]); o.z = cvt2(y[4], y[5]); o.w = cvt2(y[6], y[7]); *(LAS v4u*)(Qn + t * 136 + 8 * g8) = o; }
        else if (sec == 1) { v4u o; o.x = cvt2(y[0], y[1]); o.y = cvt2(y[2], y[3]); o.z = cvt2(y[4], y[5]); o.w = cvt2(y[6], y[7]); *(LAS v4u*)(Kn + t * 136 + 8 * g8) = o;
            const float f = beta[t] * egc[t];
#pragma unroll
            for (int i = 0; i < 8; ++i) KbgT[(8 * g8 + i) * 72 + 8 * (((t >> 3) ^ (g8 >> 1)) & 7) + (t & 7)] = (bf16)(cvt2(y[i] * f, 0.f) & 0xffffu); }
        else { const float f = beta[t];
#pragma unroll
            for (int i = 0; i < 8; ++i) VbT[(8 * g8 + i) * 72 + 8 * (((t >> 3) ^ (g8 >> 1)) & 7) + (t & 7)] = (bf16)(cvt2(y[i] * f, 0.f) & 0xffffu); }
    }
    __syncthreads();
#ifdef PD2
    for (int _pr = 0; _pr < 2; ++_pr) {
#else
    {
#endif
    {   const int tt = wave & 3, sp = wave >> 2, l15 = lane & 15, q = lane >> 4;
#pragma unroll
        for (int si = 0; si < 2; ++si) { const int st = 2 * sp + si;
            f32x4 aL = (f32x4){0.f, 0.f, 0.f, 0.f}, aQ = (f32x4){0.f, 0.f, 0.f, 0.f};
#pragma unroll
            for (int ks = 0; ks < 4; ++ks) {
                const bf16x8 fs = *(const LAS bf16x8*)(Kn + (16 * st + l15) * 136 + 32 * ks + 8 * q);
                const bf16x8 ft = *(const LAS bf16x8*)(Kn + (16 * tt + l15) * 136 + 32 * ks + 8 * q);
                const bf16x8 fq = *(const LAS bf16x8*)(Qn + (16 * tt + l15) * 136 + 32 * ks + 8 * q);
                aL = MFMA16(fs, ft, aL); aQ = MFMA16(fs, fq, aQ); }
            const int t = 16 * tt + l15; const float gct = gc[t], bt = beta[t]; float qv[4];
#pragma unroll
            for (int reg = 0; reg < 4; ++reg) { const int s = 16 * st + 4 * q + reg; const float dec = __expf(gct - gc[s]);
                Lm[t * 65 + s] = (t > s) ? bt * aL[reg] * dec : 0.f; qv[reg] = (t >= s) ? aQ[reg] * dec : 0.f; }
            v2u qkp; qkp.x = cvt2(qv[0], qv[1]); qkp.y = cvt2(qv[2], qv[3]);
            *(GAS v2u*)(qkr + ((((t >> 5) * 4 + st) * 64 + (t & 31) + 32 * (q & 1)) * 16 + 8 * (q >> 1))) = qkp;
        }
    }
#pragma unroll
    for (int r = 0; r < 2; ++r) { const int fl = tid + 512 * r; const int ln = fl & 63, ks = (fl >> 6) & 7, mt = fl >> 9;
        const int t = 32 * mt + (ln & 31), d0 = 16 * ks + 4 * (ln >> 5); const float f = egc[t];
        const v2u a = *(const LAS v2u*)(Qn + t * 136 + d0), bq = *(const LAS v2u*)(Qn + t * 136 + d0 + 8);
        v4u o; o.x = cvt2(bflo(a.x) * f, bfhi(a.x) * f); o.y = cvt2(bflo(a.y) * f, bfhi(a.y) * f); o.z = cvt2(bflo(bq.x) * f, bfhi(bq.x) * f); o.w = cvt2(bflo(bq.y) * f, bfhi(bq.y) * f);
        *(GAS v4u*)(rec + 16384 + fl * 16) = o; }
#pragma unroll
    for (int r = 0; r < 2; ++r) { const int fl = tid + 512 * r; const int ln = fl & 63, kt = (fl >> 6) & 3, mtd = fl >> 8;
        const int d = 32 * mtd + (ln & 31), t0 = 16 * kt + 4 * (ln >> 5); float v[8];
#pragma unroll
        for (int j = 0; j < 8; ++j) { const int t = t0 + 8 * (j >> 2) + (j & 3); v[j] = bf2f(Kn[t * 136 + d]) * ekd[t]; }
        v4u o; o.x = cvt2(v[0], v[1]); o.y = cvt2(v[2], v[3]); o.z = cvt2(v[4], v[5]); o.w = cvt2(v[6], v[7]);
        *(GAS v4u*)(rec + 32768 + fl * 16) = o; }
    __syncthreads();
    }
    tri_inv64(Lm, Tm, Tb, Dinv, Yb, tid, lane, wave);
#ifdef PD4
    for (int _pr = 0; _pr < 2; ++_pr)
#endif
    {   const int tt = wave & 3, hf = wave >> 2, l15 = lane & 15, q = lane >> 4;
        bf16x8 tf[2];
#pragma unroll
        for (int ks = 0; ks < 2; ++ks) tf[ks] = *(const LAS bf16x8*)(Tb + (16 * tt + l15) * 72 + 32 * ks + 8 * q);
#pragma unroll
        for (int n = 0; n < 4; ++n) { const int et = 4 * hf + n;
            f32x4 au = (f32x4){0.f, 0.f, 0.f, 0.f}, aw = (f32x4){0.f, 0.f, 0.f, 0.f};
#pragma unroll
            for (int ks = 0; ks < 2; ++ks) { const bf16x8 fv = *(const LAS bf16x8*)(VbT + (16 * et + l15) * 72 + 8 * ((4 * ks + q) ^ (et & 7))); const bf16x8 fk = *(const LAS bf16x8*)(KbgT + (16 * et + l15) * 72 + 8 * ((4 * ks + q) ^ (et & 7)));
                au = MFMA16(tf[ks], fv, au);
                aw = MFMA16(fk, tf[ks], aw); }
            v2u up; up.x = cvt2(au[0], au[1]); up.y = cvt2(au[2], au[3]);
            *(GAS v2u*)(rec + 49152 + ((16 * et + l15) * 64 + 16 * tt + 4 * q) * 2) = up;
            const int t = 16 * tt + l15; v2u wp; wp.x = cvt2(aw[0], aw[1]); wp.y = cvt2(aw[2], aw[3]);
            *(GAS v2u*)(rec + ((((t >> 5) * 8 + et) * 64 + (t & 31) + 32 * (q & 1)) * 16 + 8 * (q >> 1))) = wp; }
    }
    __syncthreads();
}

#define WG_BAR_LDS() do { asm volatile("s_waitcnt lgkmcnt(0)" ::: "memory"); __builtin_amdgcn_s_barrier(); asm volatile("" ::: "memory"); } while (0)
__device__ __forceinline__ void dn_scan(const MixPtrs& P, const DnRec& R, LAS unsigned char* lds, int b, int h, int tid, int lane, int wave) {
    constexpr int SB = 57344; LAS unsigned char* obuf = lds + 2 * SB;
    const int item0 = b * 128 * 16 + h;
    if (wave < 4) {
        const int e = 32 * wave + (lane & 31), hh = lane >> 5;
        f32x16 S[4];
#pragma unroll
        for (int dt = 0; dt < 4; ++dt)
#pragma unroll
            for (int i = 0; i < 16; ++i) S[dt][i] = 0.f;
        v2u uu[2][4];
#pragma unroll
        for (int mt = 0; mt < 2; ++mt)
#pragma unroll
            for (int g = 0; g < 4; ++g) uu[mt][g] = *(const GAS v2u*)(R.rec + (size_t)item0 * 65536 + 49152 + (e * 64 + 32 * mt + 8 * g + 4 * hh) * 2);
        float egl = R.gl[item0];
        WG_BAR_LDS();
#pragma unroll 1
        for (int c = 0; c < 128; ++c) {
            LAS unsigned char* buf = lds + (c & 1) * SB;
            f32x16 o0, o1;
            bf16x8 Sf[8];
#pragma unroll
            for (int dt = 0; dt < 4; ++dt) { Sf[2 * dt] = pack_step(S[dt], 0); Sf[2 * dt + 1] = pack_step(S[dt], 1); }
            f32x16 w0, w1;
#pragma unroll
            for (int i = 0; i < 16; ++i) { w0[i] = 0.f; w1[i] = 0.f; o0[i] = 0.f; o1[i] = 0.f; }
#pragma unroll
            for (int ks = 0; ks < 8; ++ks) { const bf16x8 a0 = *(const LAS bf16x8*)(buf + (ks * 64 + lane) * 16), a1 = *(const LAS bf16x8*)(buf + ((8 + ks) * 64 + lane) * 16);
                w0 = MFMA32(a0, Sf[ks], w0); w1 = MFMA32(a1, Sf[ks], w1); }
#pragma unroll
            for (int g = 0; g < 4; ++g) {
                w0[4 * g] = bflo(uu[0][g].x) - w0[4 * g]; w0[4 * g + 1] = bfhi(uu[0][g].x) - w0[4 * g + 1]; w0[4 * g + 2] = bflo(uu[0][g].y) - w0[4 * g + 2]; w0[4 * g + 3] = bfhi(uu[0][g].y) - w0[4 * g + 3];
                w1[4 * g] = bflo(uu[1][g].x) - w1[4 * g]; w1[4 * g + 1] = bfhi(uu[1][g].x) - w1[4 * g + 1]; w1[4 * g + 2] = bflo(uu[1][g].y) - w1[4 * g + 2]; w1[4 * g + 3] = bfhi(uu[1][g].y) - w1[4 * g + 3]; }
            const float eg_cur = egl;
            if (c + 1 < 128) {
                const unsigned char* recn = R.rec + (size_t)(item0 + 16 * (c + 1)) * 65536;
#pragma unroll
                for (int mt = 0; mt < 2; ++mt)
#pragma unroll
                    for (int g = 0; g < 4; ++g) uu[mt][g] = *(const GAS v2u*)(recn + 49152 + (e * 64 + 32 * mt + 8 * g + 4 * hh) * 2);
                egl = R.gl[item0 + 16 * (c + 1)];
            }
            bf16x8 Vf[4]; Vf[0] = pack_step(w0, 0); Vf[1] = pack_step(w0, 1); Vf[2] = pack_step(w1, 0); Vf[3] = pack_step(w1, 1);
#pragma unroll
            for (int ks = 0; ks < 8; ++ks) { const bf16x8 a0 = *(const LAS bf16x8*)(buf + 16384 + (ks * 64 + lane) * 16), a1 = *(const LAS bf16x8*)(buf + 16384 + ((8 + ks) * 64 + lane) * 16);
                o0 = MFMA32(a0, Sf[ks], o0); o1 = MFMA32(a1, Sf[ks], o1); }
#pragma unroll
            for (int kt = 0; kt < 4; ++kt) { const bf16x8 a0 = *(const LAS bf16x8*)(buf + 49152 + (kt * 64 + lane) * 16), a1 = *(const LAS bf16x8*)(buf + 49152 + ((4 + kt) * 64 + lane) * 16);
                o0 = MFMA32(a0, Vf[kt], o0); o1 = MFMA32(a1, Vf[kt], o1); }
#pragma unroll
            for (int dt = 0; dt < 4; ++dt) {
#pragma unroll
                for (int i = 0; i < 16; ++i) S[dt][i] *= eg_cur;
#pragma unroll
                for (int kt = 0; kt < 4; ++kt) { const bf16x8 a = *(const LAS bf16x8*)(buf + 32768 + ((dt * 4 + kt) * 64 + lane) * 16); S[dt] = MFMA32(a, Vf[kt], S[dt]); } }
            WG_BAR_LDS();
#pragma unroll
            for (int i = 0; i < 16; ++i) { const int row = (i & 3) + 8 * (i >> 2) + 4 * hh;
                ((LAS bf16*)obuf)[row * 128 + e] = (bf16)(cvt2(o0[i], 0.f) & 0xffffu); ((LAS bf16*)obuf)[(32 + row) * 128 + e] = (bf16)(cvt2(o1[i], 0.f) & 0xffffu); }
            WG_BAR_LDS();
        }
        float* Sout = P.out + O_SDN_P + ((size_t)b * 16 + h) * 16384;
#pragma unroll
        for (int dt = 0; dt < 4; ++dt)
#pragma unroll
            for (int i = 0; i < 16; ++i) Sout[(32 * dt + (i & 3) + 8 * (i >> 2) + 4 * hh) * 128 + e] = S[dt][i];
    } else {
        const int ht = tid - 256; const int pt = ht >> 2, pq = ht & 3;
        v4u st[14], zr[4];
#define DN_STAGE_ISSUE(itm) do { const unsigned char* _r = R.rec + (size_t)(itm) * 65536; const unsigned char* _q = R.qk + (size_t)(itm) * 8192; \
        _Pragma("unroll") for (int _k = 0; _k < 12; ++_k) st[_k] = *(const GAS v4u*)(_r + (ht + 256 * _k) * 16); \
        _Pragma("unroll") for (int _k = 0; _k < 2; ++_k) st[12 + _k] = *(const GAS v4u*)(_q + (ht + 256 * _k) * 16); } while (0)
#define DN_STAGE_WRITE(dstbuf) do { _Pragma("unroll") for (int _k = 0; _k < 14; ++_k) *(LAS v4u*)((dstbuf) + (ht + 256 * _k) * 16) = st[_k]; } while (0)
#define DN_Z_ISSUE(cc) do { const size_t _m = (size_t)(b * SEQ + 64 * (cc) + pt); _Pragma("unroll") for (int _k = 0; _k < 4; ++_k) zr[_k] = *(const GAS v4u*)(P.proj + _m * IN_WP + PC_Z + h * 128 + 32 * pq + 8 * _k); } while (0)
#define DN_POST(cc) do { const int _m = b * SEQ + 64 * (cc) + pt; v4u _o[4]; \
        _Pragma("unroll") for (int _k = 0; _k < 4; ++_k) _o[_k] = *(const LAS v4u*)(obuf + (pt * 128 + 32 * pq + 8 * _k) * 2); \
        float _ss = 0.f; _Pragma("unroll") for (int _k = 0; _k < 4; ++_k) { const float a0 = bflo(_o[_k].x), a1 = bfhi(_o[_k].x), a2 = bflo(_o[_k].y), a3 = bfhi(_o[_k].y), a4 = bflo(_o[_k].z), a5 = bfhi(_o[_k].z), a6 = bflo(_o[_k].w), a7 = bfhi(_o[_k].w); \
            _ss += (a0 * a0 + a1 * a1) + (a2 * a2 + a3 * a3) + (a4 * a4 + a5 * a5) + (a6 * a6 + a7 * a7); } \
        _ss += __shfl_xor(_ss, 1); _ss += __shfl_xor(_ss, 2); const float _rs = __builtin_amdgcn_rsqf(_ss * (1.f / 128.f) + NORM_EPS); \
        _Pragma("unroll") for (int _k = 0; _k < 4; ++_k) { const GAS f32x4* _nw = (const GAS f32x4*)(P.dn_norm_w + 32 * pq + 8 * _k); const f32x4 n0 = _nw[0], n1 = _nw[1]; \
            const float z0 = bflo(zr[_k].x), z1 = bfhi(zr[_k].x), z2 = bflo(zr[_k].y), z3 = bfhi(zr[_k].y), z4 = bflo(zr[_k].z), z5 = bfhi(zr[_k].z), z6 = bflo(zr[_k].w), z7 = bfhi(zr[_k].w); \
            v4u _w; _w.x = cvt2(bflo(_o[_k].x) * _rs * n0.x * (z0 * sigmoid_f(z0)), bfhi(_o[_k].x) * _rs * n0.y * (z1 * sigmoid_f(z1))); \
            _w.y = cvt2(bflo(_o[_k].y) * _rs * n0.z * (z2 * sigmoid_f(z2)), bfhi(_o[_k].y) * _rs * n0.w * (z3 * sigmoid_f(z3))); \
            _w.z = cvt2(bflo(_o[_k].z) * _rs * n1.x * (z4 * sigmoid_f(z4)), bfhi(_o[_k].z) * _rs * n1.y * (z5 * sigmoid_f(z5))); \
            _w.w = cvt2(bflo(_o[_k].w) * _rs * n1.z * (z6 * sigmoid_f(z6)), bfhi(_o[_k].w) * _rs * n1.w * (z7 * sigmoid_f(z7))); \
            *(GAS v4u*)(P.mix + (size_t)_m * 4096 + h * 128 + 32 * pq + 8 * _k) = _w; } } while (0)
        DN_STAGE_ISSUE(item0); DN_STAGE_WRITE(lds); DN_STAGE_ISSUE(item0 + 16);
        WG_BAR_LDS();
#pragma unroll 1
        for (int c = 0; c < 128; ++c) {
            if (c + 1 < 128) DN_STAGE_WRITE(lds + ((c + 1) & 1) * SB);
            if (c + 2 < 128) DN_STAGE_ISSUE(item0 + 16 * (c + 2));
            if (c > 0) DN_POST(c - 1);
            DN_Z_ISSUE(c);
            WG_BAR_LDS();
            WG_BAR_LDS();
        }
        DN_POST(127);
#undef DN_STAGE_ISSUE
#undef DN_STAGE_WRITE
#undef DN_Z_ISSUE
#undef DN_POST
    }
    {   float* cout = P.out + O_CONV_P + (size_t)b * 3 * 6144;
        for (int i = tid; i < 3 * 384; i += 512) { const int r = i / 384, cc = i - r * 384, col = (cc >> 7) * 2048 + h * 128 + (cc & 127);
            cout[r * 6144 + col] = bf2f(P.proj[(size_t)(b * SEQ + SEQ - 3 + r) * IN_WP + col]); } }
    __syncthreads();
}
struct RwRec { unsigned char* pq; unsigned char* rp; unsigned char* oo; float* sb; const bf16* w2T; const bf16* a2T; const bf16* g2T; };
constexpr int RSL = 9216;

struct RwRaw { unsigned ur[9], uk[9], uv[9]; v4u xu[3], xp[3]; };
__device__ __forceinline__ void rw_prep_issue(const MixPtrs& P, RwRaw& R, int b, int c, int h, int tid, int lane, int wave) {
    const int hc = h * 64 + lane;
#pragma unroll
    for (int i = 0; i < 9; ++i) { int tt = 64 * c + wave * 8 + i - 1; tt = tt < 0 ? 0 : tt;
        const size_t ro = (size_t)(b * SEQ + tt) * IN_WP + PC_RW + hc; R.ur[i] = P.proj[ro + RW_R]; R.uk[i] = P.proj[ro + RW_K]; R.uv[i] = P.proj[ro + RW_V]; }
#pragma unroll
    for (int r = 0; r < 3; ++r) { const int i = tid + 512 * r; const int which = i >= 768, ii = which ? i - 768 : i; const int t = ii / 12, g8 = ii - t * 12; int tp = 64 * c + t - 1; tp = tp < 0 ? 0 : tp;
        const int col = (which ? RW_XA : RW_XW) + 8 * g8;
        R.xu[r] = *(const GAS v4u*)(P.proj + (size_t)(b * SEQ + 64 * c + t) * IN_WP + PC_RW + col); R.xp[r] = *(const GAS v4u*)(P.proj + (size_t)(b * SEQ + tp) * IN_WP + PC_RW + col); }
}
__device__ __forceinline__ void rw_prep_item(const MixPtrs& P, const RwRec& W, LAS unsigned char* lds, int b, int c, int h, RwRaw& raw, int nb, int nc, int nh, int tid, int lane, int wave) {
    const int m0 = b * SEQ + 64 * c; const int item = (b * 128 + c) * 32 + h; const int hc = h * 64 + lane;
    const int l15 = lane & 15, q = lane >> 4;
    LAS bf16* Rt = (LAS bf16*)(lds + 0 * RSL); LAS bf16* Kt = (LAS bf16*)(lds + 1 * RSL); LAS bf16* Bt = (LAS bf16*)(lds + 2 * RSL); LAS bf16* At = (LAS bf16*)(lds + 3 * RSL);
    LAS bf16* AtT = (LAS bf16*)(lds + 4 * RSL); LAS bf16* KhT = (LAS bf16*)(lds + 5 * RSL); LAS bf16* BhT = (LAS bf16*)(lds + 6 * RSL); LAS bf16* VT = (LAS bf16*)(lds + 7 * RSL);
    LAS bf16* Aak = (LAS bf16*)(lds + 8 * RSL); LAS bf16* Ark = (LAS bf16*)(lds + 9 * RSL); LAS bf16* Arb = (LAS bf16*)(lds + 10 * RSL);
    LAS float* Lm = (LAS float*)(lds + 11 * RSL); LAS float* Tm = (LAS float*)(lds + 1 * RSL); LAS bf16* Tb = (LAS bf16*)(lds + 3 * RSL);
    LAS bf16* WtT = (LAS bf16*)(lds + 11 * RSL); LAS bf16* XT = (LAS bf16*)(lds + 12 * RSL); LAS bf16* U0T = (LAS bf16*)(lds + 1 * RSL);
    LAS float* Dinv = (LAS float*)(lds + 13 * RSL); LAS float* Yb = (LAS float*)(lds + 13 * RSL + 4352);
    LAS float* wl = (LAS float*)(lds + 0); LAS float* al = (LAS float*)(lds + 2 * RSL);
    LAS bf16* txw = (LAS bf16*)(lds + 8 * RSL); LAS bf16* xas = txw + 64 * 104; LAS bf16* w2s = xas + 64 * 104; LAS bf16* a2s = w2s + 64 * 104;
    LAS float* wtot = (LAS float*)(lds + 126976); LAS float* eGCs = (LAS float*)(lds + 129024);
    float rr[8], kr[8], vv[8];
    {   float ur[9], uk[9], uv[9];
#pragma unroll
        for (int i = 0; i < 9; ++i) { const bool ok = (64 * c + wave * 8 + i - 1) >= 0;
            ur[i] = ok ? bf2f((bf16)raw.ur[i]) : 0.f; uk[i] = ok ? bf2f((bf16)raw.uk[i]) : 0.f; uv[i] = ok ? bf2f((bf16)raw.uv[i]) : 0.f; }
        const float mr = P.mu[RW_R + hc], mk = P.mu[RW_K + hc], mv = P.mu[RW_V + hc];
#pragma unroll
        for (int i = 0; i < 8; ++i) { rr[i] = ur[i + 1] + mr * (ur[i] - ur[i + 1]); kr[i] = uk[i + 1] + mk * (uk[i] - uk[i + 1]); vv[i] = uv[i + 1] + mv * (uv[i] - uv[i + 1]); }
    }
#ifdef PR1
    for (int _pr = 0; _pr < 2; ++_pr) {
#else
    {
#endif
#pragma unroll
    for (int r = 0; r < 3; ++r) { const int i = tid + 512 * r; const int which = i >= 768, ii = which ? i - 768 : i; const int t = ii / 12, g8 = ii - t * 12; const int tt = 64 * c + t;
        const int col = (which ? RW_XA : RW_XW) + 8 * g8;
        const v4u u = raw.xu[r]; v4u up = raw.xp[r]; if (tt <= 0) up = (v4u){0u, 0u, 0u, 0u};
        const f32x4 m0v = *(const GAS f32x4*)(P.mu + col), m1v = *(const GAS f32x4*)(P.mu + col + 4);
        float x[8];
        x[0] = bflo(u.x) + m0v.x * (bflo(up.x) - bflo(u.x)); x[1] = bfhi(u.x) + m0v.y * (bfhi(up.x) - bfhi(u.x)); x[2] = bflo(u.y) + m0v.z * (bflo(up.y) - bflo(u.y)); x[3] = bfhi(u.y) + m0v.w * (bfhi(up.y) - bfhi(u.y));
        x[4] = bflo(u.z) + m1v.x * (bflo(up.z) - bflo(u.z)); x[5] = bfhi(u.z) + m1v.y * (bfhi(up.z) - bfhi(u.z)); x[6] = bflo(u.w) + m1v.z * (bflo(up.w) - bflo(u.w)); x[7] = bfhi(u.w) + m1v.w * (bfhi(up.w) - bfhi(u.w));
        if (!which) {
#pragma unroll
            for (int k = 0; k < 8; ++k) { const float e2 = __expf(2.0f * x[k]); x[k] = 1.0f - 2.0f * __builtin_amdgcn_rcpf(e2 + 1.0f); } }
        v4u o; o.x = cvt2(x[0], x[1]); o.y = cvt2(x[2], x[3]); o.z = cvt2(x[4], x[5]); o.w = cvt2(x[6], x[7]);
        *(LAS v4u*)(txw + which * 6656 + t * 104 + 8 * g8) = o; }
    bf16x8 fw2[2][3], fa2[2][3];
#pragma unroll
    for (int ci = 0; ci < 2; ++ci)
#pragma unroll
        for (int ks = 0; ks < 3; ++ks) { const size_t o = (size_t)(h * 64 + 16 * (2 * (wave >> 2) + ci) + l15) * 96 + 32 * ks + 8 * q;
            fw2[ci][ks] = *(const GAS bf16x8*)(W.w2T + o); fa2[ci][ks] = *(const GAS bf16x8*)(W.a2T + o); }
    __syncthreads();
    {   const int tt = wave & 3, cp = wave >> 2;
#pragma unroll
        for (int ci = 0; ci < 2; ++ci) { const int ct = 2 * cp + ci;
            f32x4 aw = (f32x4){0.f, 0.f, 0.f, 0.f}, aa = (f32x4){0.f, 0.f, 0.f, 0.f};
#pragma unroll
            for (int ks = 0; ks < 3; ++ks) {
                const bf16x8 fx = *(const LAS bf16x8*)(txw + (16 * tt + l15) * 104 + 32 * ks + 8 * q), fa = *(const LAS bf16x8*)(xas + (16 * tt + l15) * 104 + 32 * ks + 8 * q);
                aw = MFMA16(fx, fw2[ci][ks], aw); aa = MFMA16(fa, fa2[ci][ks], aa); }
#pragma unroll
            for (int reg = 0; reg < 4; ++reg) { wl[(16 * tt + 4 * q + reg) * 65 + 16 * ct + l15] = aw[reg]; al[(16 * tt + 4 * q + reg) * 65 + 16 * ct + l15] = aa[reg]; } }
    }
    }
    __syncthreads();
    float lw[8], av[8], bvv[8], kp[8], Gt[8];
    {   const float w0c = P.w0[hc], a0c = P.a0[hc], kkc = P.k_k[hc], kac = P.k_a[hc], rkc = P.r_k[hc];
        float run = 0.f;
#pragma unroll
        for (int i = 0; i < 8; ++i) { const int t = wave * 8 + i;
            const float wlog = -softplus_f(-(w0c + wl[t * 65 + lane])) - 0.5f; lw[i] = -__expf(wlog);
            const float alr = sigmoid_f(a0c + al[t * 65 + lane]);
            const float kkr = kr[i] * kkc; const float kk = kkr * __builtin_amdgcn_rsqf(wave_sum(kkr * kkr) + 1e-6f);
            kp[i] = kr[i] * (1.0f + (alr - 1.0f) * kac); av[i] = -kk; bvv[i] = kk * alr;
            const float sbv = wave_sum(rr[i] * kp[i] * rkc); if (lane == 0) W.sb[(size_t)item * 64 + t] = sbv;
            run += lw[i]; Gt[i] = run; }
        wtot[wave * 64 + lane] = run;
    }
    __syncthreads();
    {   float off = 0.f, gcv = 0.f;
#pragma unroll
        for (int w = 0; w < 8; ++w) { const float x = wtot[w * 64 + lane]; gcv += x; if (w < wave) off += x; }
        if (wave == 0) eGCs[lane] = __expf(gcv);
        float tA[8], tK[8], tB[8];
#pragma unroll
        for (int i = 0; i < 8; ++i) { const int t = wave * 8 + i; const float G = Gt[i] + off;
            const float eG = __expf(G), eGm = __expf(-G), eGp = __expf(G - lw[i]), eH = __expf(gcv - G);
            Rt[t * 72 + lane] = (bf16)(cvt2(rr[i] * eG, 0.f) & 0xffffu); Kt[t * 72 + lane] = (bf16)(cvt2(kp[i] * eGm, 0.f) & 0xffffu);
            Bt[t * 72 + lane] = (bf16)(cvt2(bvv[i] * eGm, 0.f) & 0xffffu); tA[i] = av[i] * eGp; At[t * 72 + lane] = (bf16)(cvt2(tA[i], 0.f) & 0xffffu);
            tK[i] = kp[i] * eH; tB[i] = bvv[i] * eH; }
        v4u o;
        o.x = cvt2(tA[0], tA[1]); o.y = cvt2(tA[2], tA[3]); o.z = cvt2(tA[4], tA[5]); o.w = cvt2(tA[6], tA[7]); *(LAS v4u*)(AtT + lane * 72 + wave * 8) = o;
        o.x = cvt2(tK[0], tK[1]); o.y = cvt2(tK[2], tK[3]); o.z = cvt2(tK[4], tK[5]); o.w = cvt2(tK[6], tK[7]); *(LAS v4u*)(KhT + lane * 72 + wave * 8) = o;
        o.x = cvt2(tB[0], tB[1]); o.y = cvt2(tB[2], tB[3]); o.z = cvt2(tB[4], tB[5]); o.w = cvt2(tB[6], tB[7]); *(LAS v4u*)(BhT + lane * 72 + wave * 8) = o;
        o.x = cvt2(vv[0], vv[1]); o.y = cvt2(vv[2], vv[3]); o.z = cvt2(vv[4], vv[5]); o.w = cvt2(vv[6], vv[7]); *(LAS v4u*)(VT + lane * 72 + wave * 8) = o;
    }
    __syncthreads();
#ifdef PR4
    for (int _pr = 0; _pr < 2; ++_pr)
#endif
    {   const int tt = wave & 3, sp = wave >> 2;
        bf16x8 fA[2], fR[2];
#pragma unroll
        for (int ks = 0; ks < 2; ++ks) { fA[ks] = *(const LAS bf16x8*)(At + (16 * tt + l15) * 72 + 32 * ks + 8 * q); fR[ks] = *(const LAS bf16x8*)(Rt + (16 * tt + l15) * 72 + 32 * ks + 8 * q); }
#pragma unroll
        for (int si = 0; si < 2; ++si) { const int st = 2 * sp + si;
            f32x4 ab = (f32x4){0.f, 0.f, 0.f, 0.f}, ak = ab, rk = ab, rb = ab;
#pragma unroll
            for (int ks = 0; ks < 2; ++ks) { const bf16x8 fB = *(const LAS bf16x8*)(Bt + (16 * st + l15) * 72 + 32 * ks + 8 * q), fK = *(const LAS bf16x8*)(Kt + (16 * st + l15) * 72 + 32 * ks + 8 * q);
                ab = MFMA16(fB, fA[ks], ab); ak = MFMA16(fK, fA[ks], ak); rk = MFMA16(fK, fR[ks], rk); rb = MFMA16(fB, fR[ks], rb); }
            const int t = 16 * tt + l15, s0 = 16 * st + 4 * q; float vak[4], vrk[4], vrb[4];
#pragma unroll
            for (int reg = 0; reg < 4; ++reg) { const int s = s0 + reg; Lm[t * 65 + s] = (t > s) ? -ab[reg] : 0.f; vak[reg] = (t > s) ? ak[reg] : 0.f; vrk[reg] = (t >= s) ? rk[reg] : 0.f; vrb[reg] = (t >= s) ? rb[reg] : 0.f; }
            v2u o; o.x = cvt2(vak[0], vak[1]); o.y = cvt2(vak[2], vak[3]); *(LAS v2u*)(Aak + t * 72 + s0) = o;
            o.x = cvt2(vrk[0], vrk[1]); o.y = cvt2(vrk[2], vrk[3]); *(LAS v2u*)(Ark + t * 72 + s0) = o;
            o.x = cvt2(vrb[0], vrb[1]); o.y = cvt2(vrb[2], vrb[3]); *(LAS v2u*)(Arb + t * 72 + s0) = o; }
    }
    __syncthreads();
    tri_inv64(Lm, Tm, Tb, Dinv, Yb, tid, lane, wave);
#ifdef PR2
    tri_inv64(Lm, Tm, Tb, Dinv, Yb, tid, lane, wave);
#endif
#ifdef PR5
    for (int _pr = 0; _pr < 2; ++_pr) {
#else
    {
#endif
    {   const int tt = wave & 3, cp = wave >> 2;
        bf16x8 fT[2], fK[2];
#pragma unroll
        for (int ks = 0; ks < 2; ++ks) { fT[ks] = *(const LAS bf16x8*)(Tb + (16 * tt + l15) * 72 + 32 * ks + 8 * q); fK[ks] = *(const LAS bf16x8*)(Aak + (16 * tt + l15) * 72 + 32 * ks + 8 * q); }
#pragma unroll
        for (int ci = 0; ci < 2; ++ci) { const int ct = 2 * cp + ci;
            f32x4 aw = (f32x4){0.f, 0.f, 0.f, 0.f}, ax = aw;
#pragma unroll
            for (int ks = 0; ks < 2; ++ks) { const bf16x8 fa = *(const LAS bf16x8*)(AtT + (16 * ct + l15) * 72 + 32 * ks + 8 * q), fv = *(const LAS bf16x8*)(VT + (16 * ct + l15) * 72 + 32 * ks + 8 * q);
                aw = MFMA16(fT[ks], fa, aw); ax = MFMA16(fK[ks], fv, ax); }
            v2u o; o.x = cvt2(aw[0], aw[1]); o.y = cvt2(aw[2], aw[3]); *(LAS v2u*)(WtT + (16 * ct + l15) * 72 + 16 * tt + 4 * q) = o;
            o.x = cvt2(ax[0], ax[1]); o.y = cvt2(ax[2], ax[3]); *(LAS v2u*)(XT + (16 * ct + l15) * 72 + 16 * tt + 4 * q) = o; }
    }
    __syncthreads();
    {   const int tt = wave & 3, cp = wave >> 2;
#pragma unroll
        for (int ci = 0; ci < 2; ++ci) { const int et = 2 * cp + ci; f32x4 au = (f32x4){0.f, 0.f, 0.f, 0.f};
#pragma unroll
            for (int ks = 0; ks < 2; ++ks) { const bf16x8 fT = *(const LAS bf16x8*)(Tb + (16 * tt + l15) * 72 + 32 * ks + 8 * q), fx = *(const LAS bf16x8*)(XT + (16 * et + l15) * 72 + 32 * ks + 8 * q);
                au = MFMA16(fT, fx, au); }
            v2u o; o.x = cvt2(au[0], au[1]); o.y = cvt2(au[2], au[3]); *(LAS v2u*)(U0T + (16 * et + l15) * 72 + 16 * tt + 4 * q) = o; }
    }
    __syncthreads();
    }
    if (nb >= 0) rw_prep_issue(P, raw, nb, nc, nh, tid, lane, wave);
#ifdef PR3
    for (int _pr = 0; _pr < 2; ++_pr)
#endif
    {   const int bt = wave & 3, ap = wave >> 2;
        unsigned char* pq = W.pq + (size_t)item * 16384; unsigned char* rp = W.rp + (size_t)item * 8192; unsigned char* oo = W.oo + (size_t)item * 8192;
        bf16x8 fArb[2], fArk[2], fBh[2], fV[2], fU[2];
#pragma unroll
        for (int ks = 0; ks < 2; ++ks) { fArb[ks] = *(const LAS bf16x8*)(Arb + (16 * bt + l15) * 72 + 32 * ks + 8 * q); fArk[ks] = *(const LAS bf16x8*)(Ark + (16 * bt + l15) * 72 + 32 * ks + 8 * q);
            fBh[ks] = *(const LAS bf16x8*)(BhT + (16 * bt + l15) * 72 + 32 * ks + 8 * q); fV[ks] = *(const LAS bf16x8*)(VT + (16 * bt + l15) * 72 + 32 * ks + 8 * q); fU[ks] = *(const LAS bf16x8*)(U0T + (16 * bt + l15) * 72 + 32 * ks + 8 * q); }
#pragma unroll
        for (int ai = 0; ai < 2; ++ai) { const int at = 2 * ap + ai;
            f32x4 aR = (f32x4){0.f, 0.f, 0.f, 0.f}, aP = aR, aO = aR, aQ = aR;
#pragma unroll
            for (int ks = 0; ks < 2; ++ks) {
                const bf16x8 fW = *(const LAS bf16x8*)(WtT + (16 * at + l15) * 72 + 32 * ks + 8 * q);
                aR = MFMA16(fW, fArb[ks], aR);
                aP = MFMA16(fW, fBh[ks], aP);
                const bf16x8 fk = *(const LAS bf16x8*)(Ark + (16 * at + l15) * 72 + 32 * ks + 8 * q), fb = *(const LAS bf16x8*)(Arb + (16 * at + l15) * 72 + 32 * ks + 8 * q);
                aO = MFMA16(fk, fV[ks], aO); aO = MFMA16(fb, fU[ks], aO);
                const bf16x8 fkh = *(const LAS bf16x8*)(KhT + (16 * at + l15) * 72 + 32 * ks + 8 * q), fbh = *(const LAS bf16x8*)(BhT + (16 * at + l15) * 72 + 32 * ks + 8 * q);
                aQ = MFMA16(fkh, fV[ks], aQ); aQ = MFMA16(fbh, fU[ks], aQ); }
            const int x = 16 * bt + l15, y0 = 16 * at + 4 * q;
            {   const v2u rt = *(const LAS v2u*)(Rt + x * 72 + y0);
                v2u o; o.x = cvt2(aR[0] + bflo(rt.x), aR[1] + bfhi(rt.x)); o.y = cvt2(aR[2] + bflo(rt.y), aR[3] + bfhi(rt.y));
                *(LAS v2u*)(lds + 2 * RSL + ((((x >> 5) * 4 + at) * 64 + (x & 31) + 32 * (q & 1)) * 16 + 8 * (q >> 1))) = o; }
            {   const float dg = eGCs[x]; float p[4];
#pragma unroll
                for (int reg = 0; reg < 4; ++reg) p[reg] = aP[reg] + ((y0 + reg == x) ? dg : 0.f);
                v2u o; o.x = cvt2(p[0], p[1]); o.y = cvt2(p[2], p[3]);
                *(LAS v2u*)(lds + 3 * RSL + ((((x >> 5) * 4 + at) * 64 + (x & 31) + 32 * (q & 1)) * 16 + 8 * (q >> 1))) = o; }
            {   v2u o; o.x = cvt2(aO[0], aO[1]); o.y = cvt2(aO[2], aO[3]); *(LAS v2u*)(lds + 4 * RSL + x * 136 + y0 * 2) = o; }
            {   v2u o; o.x = cvt2(aQ[0], aQ[1]); o.y = cvt2(aQ[2], aQ[3]); *(LAS v2u*)(lds + 8 * RSL + x * 136 + y0 * 2) = o; }
        }
        __syncthreads();
        {
            const v4u c0 = *(const LAS v4u*)(lds + 2 * RSL + tid * 16), c1 = *(const LAS v4u*)(lds + 3 * RSL + tid * 16);
            const LAS unsigned char* s2 = lds + 4 * RSL + (tid >> 3) * 136 + (tid & 7) * 16; const LAS unsigned char* s3 = lds + 8 * RSL + (tid >> 3) * 136 + (tid & 7) * 16;
            const v2u a2 = *(const LAS v2u*)s2, b2 = *(const LAS v2u*)(s2 + 8), a3 = *(const LAS v2u*)s3, b3 = *(const LAS v2u*)(s3 + 8);
            *(GAS v4u*)(rp + tid * 16) = c0; *(GAS v4u*)(pq + tid * 16) = c1;
            *(GAS v4u*)(oo + tid * 16) = (v4u){a2.x, a2.y, b2.x, b2.y}; *(GAS v4u*)(pq + 8192 + tid * 16) = (v4u){a3.x, a3.y, b3.x, b3.y}; }
    }
    __syncthreads();
}

__device__ __forceinline__ void rw_scan(const MixPtrs& P, const RwRec& W, LAS unsigned char* lds, int b, int h, int tid, int lane, int wave) {
    constexpr int SB = 33792;
    const int item0 = b * 128 * 32 + h;
    if (wave < 2) {
        const int e = 32 * wave + (lane & 31), hh = lane >> 5;
        f32x16 H[2];
#pragma unroll
        for (int i = 0; i < 16; ++i) { H[0][i] = 0.f; H[1][i] = 0.f; }
        WG_BAR_LDS();
#pragma unroll 1
        for (int c = 0; c < 128; ++c) {
            LAS unsigned char* buf = lds + (c & 1) * SB;
            bf16x8 Hf[4]; Hf[0] = pack_step(H[0], 0); Hf[1] = pack_step(H[0], 1); Hf[2] = pack_step(H[1], 0); Hf[3] = pack_step(H[1], 1);
#pragma unroll
            for (int mt = 0; mt < 2; ++mt) {
                f32x16 hn, ov;
#pragma unroll
                for (int g = 0; g < 4; ++g) { const v2u qv = *(const LAS v2u*)(buf + 16384 + e * 136 + (32 * mt + 8 * g + 4 * hh) * 2), o0 = *(const LAS v2u*)(buf + 16384 + 8704 + e * 136 + (32 * mt + 8 * g + 4 * hh) * 2);
                    hn[4 * g] = bflo(qv.x); hn[4 * g + 1] = bfhi(qv.x); hn[4 * g + 2] = bflo(qv.y); hn[4 * g + 3] = bfhi(qv.y);
                    ov[4 * g] = bflo(o0.x); ov[4 * g + 1] = bfhi(o0.x); ov[4 * g + 2] = bflo(o0.y); ov[4 * g + 3] = bfhi(o0.y); }
#pragma unroll
                for (int ks = 0; ks < 4; ++ks) { const bf16x8 fp = *(const LAS bf16x8*)(buf + ((mt * 4 + ks) * 64 + lane) * 16), fr = *(const LAS bf16x8*)(buf + 8192 + ((mt * 4 + ks) * 64 + lane) * 16);
                    hn = MFMA32(fp, Hf[ks], hn); ov = MFMA32(fr, Hf[ks], ov); }
#pragma unroll
                for (int g = 0; g < 4; ++g) { v2u o; o.x = cvt2(ov[4 * g], ov[4 * g + 1]); o.y = cvt2(ov[4 * g + 2], ov[4 * g + 3]); *(LAS v2u*)(buf + 16384 + 8704 + e * 136 + (32 * mt + 8 * g + 4 * hh) * 2) = o; }
                if (mt == 0) H[0] = hn; else H[1] = hn;
            }
            WG_BAR_LDS();
        }
        float* Sout = P.out + O_SRW_P + ((size_t)b * 32 + h) * 4096;
#pragma unroll
        for (int mt = 0; mt < 2; ++mt)
#pragma unroll
            for (int g = 0; g < 4; ++g) *(f32x4*)(Sout + e * 64 + 32 * mt + 8 * g + 4 * hh) = (f32x4){H[mt][4 * g], H[mt][4 * g + 1], H[mt][4 * g + 2], H[mt][4 * g + 3]};
    } else {
        const int ht = tid - 128;
        v4u st[6];
#define RW_STAGE_ISSUE(itm) do { const unsigned char* _pq = W.pq + (size_t)(itm) * 16384; const unsigned char* _rp = W.rp + (size_t)(itm) * 8192; const unsigned char* _oo = W.oo + (size_t)(itm) * 8192; \
        _Pragma("unroll") for (int _k = 0; _k < 6; ++_k) { const int _i = ht + 384 * _k; if (_i < 2048) st[_k] = *(const GAS v4u*)(_i < 512 ? _pq + _i * 16 : (_i < 1024 ? _rp + (_i - 512) * 16 : (_i < 1536 ? _pq + 8192 + (_i - 1024) * 16 : _oo + (_i - 1536) * 16))); } } while (0)
#define RW_STAGE_WRITE(dstbuf) do { _Pragma("unroll") for (int _k = 0; _k < 6; ++_k) { const int _i = ht + 384 * _k; if (_i < 1024) *(LAS v4u*)((dstbuf) + _i * 16) = st[_k]; \
            else if (_i < 2048) { const int _j = _i - 1024; LAS unsigned char* _d = (dstbuf) + 16384 + (_j >> 3) * 136 + (_j & 7) * 16; *(LAS v2u*)_d = (v2u){st[_k].x, st[_k].y}; *(LAS v2u*)(_d + 8) = (v2u){st[_k].z, st[_k].w}; } } } while (0)
#define RW_STORE_O(itm, srcbuf) do { unsigned char* _oo = W.oo + (size_t)(itm) * 8192; \
        _Pragma("unroll") for (int _k = 4; _k < 6; ++_k) { const int _i = ht + 384 * _k; if (_i < 2048) { const int _j = _i - 1024; const LAS unsigned char* _s = (srcbuf) + 16384 + (_j >> 3) * 136 + (_j & 7) * 16; \
            const v2u _a = *(const LAS v2u*)_s, _b = *(const LAS v2u*)(_s + 8); *(GAS v4u*)(_oo + (_i - 1536) * 16) = (v4u){_a.x, _a.y, _b.x, _b.y}; } } } while (0)
        RW_STAGE_ISSUE(item0); RW_STAGE_WRITE(lds); RW_STAGE_ISSUE(item0 + 32);
        WG_BAR_LDS();
#pragma unroll 1
        for (int c = 0; c < 128; ++c) {
            if (c > 0) RW_STORE_O(item0 + 32 * (c - 1), lds + ((c - 1) & 1) * SB);
            if (c + 1 < 128) RW_STAGE_WRITE(lds + ((c + 1) & 1) * SB);
            if (c + 2 < 128) RW_STAGE_ISSUE(item0 + 32 * (c + 2));
            WG_BAR_LDS();
        }
        RW_STORE_O(item0 + 32 * 127, lds + SB);
#undef RW_STAGE_ISSUE
#undef RW_STAGE_WRITE
#undef RW_STORE_O
    }
    {   float* shout = P.out + O_SHIFT_P + (size_t)b * RW_SHIFT_W;
        for (int i = tid; i < 206; i += 512) { const int col = h * 206 + i; shout[col] = bf2f(P.proj[(size_t)(b * SEQ + SEQ - 1) * IN_WP + PC_RW + col]); } }
    __syncthreads();
}

__device__ __forceinline__ void rw_gate_item(const MixPtrs& P, const RwRec& W, LAS unsigned char* lds, int b, int c, int qt, int tid, int lane, int wave) {
    const int m0 = b * SEQ + 64 * c; const int l15 = lane & 15, q = lane >> 4;
    LAS bf16* sxg = (LAS bf16*)lds;
#pragma unroll
    for (int r = 0; r < 4; ++r) { const int i = tid + 512 * r; const int t = i >> 5, g8 = i & 31; const int tt = 64 * c + t; const int col = RW_XG + 8 * g8;
        const v4u u = *(const GAS v4u*)(P.proj + (size_t)(m0 + t) * IN_WP + PC_RW + col); v4u up = (v4u){0u, 0u, 0u, 0u}; if (tt > 0) up = *(const GAS v4u*)(P.proj + (size_t)(m0 + t - 1) * IN_WP + PC_RW + col);
        const f32x4 m0v = *(const GAS f32x4*)(P.mu + col), m1v = *(const GAS f32x4*)(P.mu + col + 4);
        float x[8];
        x[0] = bflo(u.x) + m0v.x * (bflo(up.x) - bflo(u.x)); x[1] = bfhi(u.x) + m0v.y * (bfhi(up.x) - bfhi(u.x)); x[2] = bflo(u.y) + m0v.z * (bflo(up.y) - bflo(u.y)); x[3] = bfhi(u.y) + m0v.w * (bfhi(up.y) - bfhi(u.y));
        x[4] = bflo(u.z) + m1v.x * (bflo(up.z) - bflo(u.z)); x[5] = bfhi(u.z) + m1v.y * (bfhi(up.z) - bfhi(u.z)); x[6] = bflo(u.w) + m1v.z * (bflo(up.w) - bflo(u.w)); x[7] = bfhi(u.w) + m1v.w * (bfhi(up.w) - bfhi(u.w));
        v4u o; o.x = cvt2(sigmoid_f(x[0]), sigmoid_f(x[1])); o.y = cvt2(sigmoid_f(x[2]), sigmoid_f(x[3])); o.z = cvt2(sigmoid_f(x[4]), sigmoid_f(x[5])); o.w = cvt2(sigmoid_f(x[6]), sigmoid_f(x[7]));
        *(LAS v4u*)(sxg + t * 264 + 8 * g8) = o; }
    __syncthreads();
    {   const int tt = wave & 3, hf = wave >> 2;
        bf16x8 fx[8];
#pragma unroll
        for (int ks = 0; ks < 8; ++ks) fx[ks] = *(const LAS bf16x8*)(sxg + (16 * tt + l15) * 264 + 32 * ks + 8 * q);
        const int colb = qt * 512 + hf * 256;
#pragma unroll 2
        for (int vt = 0; vt < 16; ++vt) { const bf16* gr = W.g2T + (size_t)(colb + 16 * vt + l15) * 256 + 8 * q;
            bf16x8 fg[8];
#pragma unroll
            for (int ks = 0; ks < 8; ++ks) fg[ks] = *(const GAS bf16x8*)(gr + 32 * ks);
            f32x4 ag = (f32x4){0.f, 0.f, 0.f, 0.f};
#pragma unroll
            for (int ks = 0; ks < 8; ++ks) ag = MFMA16(fg[ks], fx[ks], ag);
            v2u o; o.x = cvt2(ag[0], ag[1]); o.y = cvt2(ag[2], ag[3]);
            *(GAS v2u*)(P.mix + (size_t)(m0 + 16 * tt + l15) * 4096 + 2048 + colb + 16 * vt + 4 * q) = o; }
    }
    __syncthreads();
}
__device__ __forceinline__ void rw_post_task(const MixPtrs& P, const RwRec& W, int item, int tg, int lane) {
    const int h = item & 31, c = (item >> 5) & 127, b = item >> 12; const int m0 = b * SEQ + 64 * c + 8 * tg; const int hc = h * 64 + lane;
    const v4u ov = *(const GAS v4u*)(W.oo + (size_t)item * 8192 + (lane * 64 + tg * 8) * 2);
    float uv[9], gt[8];
#pragma unroll
    for (int i = 0; i < 9; ++i) { const int tt = 64 * c + 8 * tg + i - 1; uv[i] = tt >= 0 ? bf2f(P.proj[(size_t)(b * SEQ + tt) * IN_WP + PC_RW + RW_V + hc]) : 0.f; }
#pragma unroll
    for (int i = 0; i < 8; ++i) gt[i] = bf2f(P.mix[(size_t)(m0 + i) * 4096 + 2048 + hc]);
    const float mv = P.mu[RW_V + hc], lnw = P.ln_w[hc], lnb = P.ln_b[hc];
    const float y[8] = {bflo(ov.x), bfhi(ov.x), bflo(ov.y), bfhi(ov.y), bflo(ov.z), bfhi(ov.z), bflo(ov.w), bfhi(ov.w)};
    float sbs[8];
#pragma unroll
    for (int i = 0; i < 8; ++i) sbs[i] = W.sb[(size_t)item * 64 + tg * 8 + i];
#pragma unroll
    for (int i = 0; i < 8; ++i) { const float vv = uv[i + 1] + mv * (uv[i] - uv[i + 1]);
        const float mean = wave_sum(y[i]) * (1.f / 64.f); const float dy = y[i] - mean; const float var = wave_sum(dy * dy) * (1.f / 64.f);
        const float yn = dy * __builtin_amdgcn_rsqf(var + RW_GN_EPS) * lnw + lnb;
        P.mix[(size_t)(m0 + i) * 4096 + 2048 + hc] = (bf16)(cvt2((yn + sbs[i] * vv) * gt[i], 0.f) & 0xffffu); }
}

constexpr int NPH = 10;
#define MK_N_LAUNCHES 1
#ifndef MK_N_LAUNCHES
#define MK_N_LAUNCHES 1
#endif
#ifndef GP_ALIGN
#define GP_ALIGN false
#endif
#ifndef GP_SP2
#define GP_SP2 true
#endif
#ifndef REP_MASK
#define REP_MASK 0
#endif
__global__ void __launch_bounds__(NWAVES * 64, 2) hymba_fwd(Args args) {
    extern __shared__ __attribute__((aligned(16))) unsigned char lds_raw[];
    LAS unsigned char* lds = (LAS unsigned char*)lds_raw;
    volatile LAS unsigned* MISC = (volatile LAS unsigned*)(lds + MISC_OFF);
    const int tid = threadIdx.x, lane = tid & 63, wave = __builtin_amdgcn_readfirstlane(tid >> 6);
    const int G = gridDim.x;
    unsigned char* ws = args.ws;
    gu32* ctl = (gu32*)(ws + WS_CTL);
    for (int u = tid; u < (LDS_BYTES - LDSCTL_OFF) / 4; u += NWAVES * 64) ((LAS unsigned*)(lds + LDSCTL_OFF))[u] = 0u;
    __syncthreads();
    XcdBarrier bar; bar.bar = (unsigned*)(ctl + CW_BAR); bar.x = 0; bar.st = nullptr;
    if (MK_N_LAUNCHES == 1) bar = xcd_barrier_post((unsigned*)(ctl + CW_BAR), MISC + 8);
    const int lo = args.ph_lo, hi = args.ph_hi;
#ifdef ONLY_PHASE
#define IN(k) ((k) == ONLY_PHASE)
#else
#define IN(k) (lo <= (k) && (k) < hi)
#endif
#define SEAM(k) do { if (IN(k) && IN((k) + 1)) xcd_barrier(bar); } while (0)
    float* ssq = (float*)(ws + WS_SSQ);
    bf16* Wt_out = (bf16*)(ws + WS_WOUT); bf16* hbuf = (bf16*)(ws + WS_HBUF); bf16* proj = (bf16*)(ws + WS_PROJ); bf16* act = (bf16*)(ws + WS_PROJ);
    bf16* Wt_in = (bf16*)(ws + WS_WIN); bf16* Wt_gu = (bf16*)(ws + WS_WGU); bf16* Wt_dn = (bf16*)(ws + WS_WDN);
    bf16* w2T = (bf16*)(ws + WS_W2T); bf16* a2T = (bf16*)(ws + WS_A2T); bf16* g2T = (bf16*)(ws + WS_G2T);
    const float* x_prompt = args.in[0]; const float* x_sample = args.in[1];
    const int gw = blockIdx.x * NWAVES + wave, NGW = G * NWAVES;

    if (IN(0)) _Pragma("unroll") for (int _r = 0; _r < 1 + ((REP_MASK >> 0) & 1); ++_r) {
        LAS float* scr = (LAS float*)(lds + RING_OFF + wave * 16384);
        constexpr int I_IN = 64 * (IN_W / 32);
        for (int it = gw; it < I_IN; it += NGW) p0_transpose_item(args.in[8], 4096, IN_W, Wt_in, scr, it, lane, RmId{});
        for (int i = blockIdx.x * 512 + tid; i < 2048 * 448; i += G * 512) {
            if (i < 2048 * 96) { const int c = i / 96, j = i - c * 96; w2T[i] = (bf16)f2bf(args.in[15][j * 2048 + c]); }
            else if (i < 2048 * 192) { const int ii = i - 2048 * 96; const int c = ii / 96, j = ii - c * 96; a2T[ii] = (bf16)f2bf(args.in[17][j * 2048 + c]); }
            else { const int ii = i - 2048 * 192; const int c = ii >> 8, j = ii & 255; g2T[ii] = (bf16)f2bf(args.in[18][j * 2048 + c]); }
        }
        for (int i = blockIdx.x * 512 + tid; i < 32 * 4096 / 8; i += G * 512) ((GAS v4u*)(Wt_in + (size_t)IN_W * 4096))[i] = (v4u){0u, 0u, 0u, 0u};
        for (int m = gw; m < MPAD; m += NGW) {
            bf16* orow = hbuf + (size_t)m * 4096;
            if (m < M_REAL) { const float* xrow = m < M_PROMPT ? x_prompt + (size_t)m * 4096 : x_sample + (size_t)(m - M_PROMPT) * 4096;
                const GAS f32x4* xr = (const GAS f32x4*)xrow + lane; f32x4 v[16];
#pragma unroll
                for (int j = 0; j < 16; ++j) v[j] = xr[64 * j];
                rms_row_to_bf16(v, args.in[6], orow, lane); }
            else { GAS v2u* o8 = (GAS v2u*)orow + lane;
#pragma unroll
                for (int j = 0; j < 16; ++j) o8[64 * j] = (v2u){0u, 0u}; }
        }
    }
    SEAM(0);
    if (IN(1)) _Pragma("unroll") for (int _r = 0; _r < 1 + ((REP_MASK >> 1) & 1); ++_r) {
        pg8::Gemm g{hbuf, Wt_in, MPAD, IN_WP, 4096, 4096, 4096}; pg8::StaticOrder S; S.init(MPAD, IN_WP, G, (int)blockIdx.x);
        pg8::EpiBf16Plain E{proj, IN_WP};
        pg8::gemm_phase<pg8::EpiBf16Plain, pg8::StaticOrder, GP_ALIGN, GP_SP2>(lds + RING_OFF, g, S, E);
    }
#ifdef PROBE_GEMM_RESIDENT
    if (IN(1)) {
        struct ProbeOrder : pg8::StaticOrder { __device__ bool next(int i, pg8::Unit& u) const { if (i >= 15) return false; u.pm = c & 7; u.pn = (c >> 3) & 3; u.ko = 0; u.pi = 0; return true; } };
#ifndef PROBE_LD
#define PROBE_LD 4096
#endif
        pg8::Gemm g{hbuf, Wt_in, MPAD, IN_WP, 4096, PROBE_LD, PROBE_LD}; ProbeOrder S; S.init(MPAD, IN_WP, G, (int)blockIdx.x);
        pg8::EpiBf16Plain E{Wt_gu, IN_WP};
        pg8::gemm_phase<pg8::EpiBf16Plain, ProbeOrder, GP_ALIGN, GP_SP2>(lds + RING_OFF, g, S, E);
    }
#endif
    SEAM(1);
    MixPtrs P; P.proj = proj; P.mix = hbuf; P.state_dn = args.in[2]; P.cache_conv = args.in[3]; P.state_rw = args.in[4]; P.cache_shift = args.in[5];
    P.conv_w = args.in[9]; P.a_log = args.in[10]; P.dt_bias = args.in[11]; P.dn_norm_w = args.in[12];
    P.mu = args.in[13]; P.w0 = args.in[14]; P.w2 = args.in[15]; P.a0 = args.in[16]; P.a2 = args.in[17]; P.g2 = args.in[18]; P.k_k = args.in[19]; P.k_a = args.in[20]; P.r_k = args.in[21];
    P.ln_w = args.in[22]; P.ln_b = args.in[23]; P.out = args.out;
    DnRec R; R.rec = (unsigned char*)args.out; R.qk = ws + WS_DNQK; R.gl = (float*)(ws + WS_DNGL);
    RwRec W; W.pq = ws + WS_RWPQ; W.rp = ws + WS_RWRP; W.oo = ws + WS_RWOO; W.sb = (float*)(ws + WS_RWSB); W.w2T = w2T; W.a2T = a2T; W.g2T = g2T;
    if (IN(2)) _Pragma("unroll") for (int _r = 0; _r < 1 + ((REP_MASK >> 2) & 1); ++_r) {
#ifndef REP_DNP
#define REP_DNP 0
#endif
#ifndef REP_RWP
#define REP_RWP 0
#endif
        for (int _q = 0; _q <= REP_DNP; ++_q)
        for (int it = blockIdx.x; it < 4096; it += G) dn_prep_item(P, R, lds + RING_OFF, it >> 11, (it >> 4) & 127, it & 15, tid, lane, wave);
        for (int _q = 0; _q <= REP_RWP; ++_q) {
            RwRaw raw; { const int it = blockIdx.x; rw_prep_issue(P, raw, it >> 12, (it >> 5) & 127, it & 31, tid, lane, wave); }
            for (int it = blockIdx.x; it < 8192; it += G) { const int nx = it + G; const bool hn = nx < 8192;
                rw_prep_item(P, W, lds + RING_OFF, it >> 12, (it >> 5) & 127, it & 31, raw, hn ? (nx >> 12) : -1, (nx >> 5) & 127, nx & 31, tid, lane, wave); }
        }
    }
    SEAM(2);
    if (IN(3)) _Pragma("unroll") for (int _r = 0; _r < 1 + ((REP_MASK >> 3) & 1); ++_r) {
        const int wg = blockIdx.x;
#ifndef REP_DNSCAN
#define REP_DNSCAN 0
#endif
#ifndef REP_SAMPLES
#define REP_SAMPLES 0
#endif
        if (wg < 32) { _Pragma("unroll 1") for (int _q = 0; _q <= REP_DNSCAN; ++_q) dn_scan(P, R, lds + RING_OFF, wg >> 4, wg & 15, tid, lane, wave); }
        else if (wg < 96) rw_scan(P, W, lds + RING_OFF, (wg - 32) >> 5, (wg - 32) & 31, tid, lane, wave);
        else {
            _Pragma("unroll 1") for (int _q = 0; _q <= REP_SAMPLES; ++_q)
            for (int it = wg - 96; it < 384; it += G - 96) {
                if (it < 128) dn_seq_item(P, lds + RING_OFF, 2 + (it >> 4), it & 15, tid, lane, wave);
                else rw_seq_item(P, w2T, a2T, g2T, lds + RING_OFF, 2 + ((it - 128) >> 5), (it - 128) & 31, tid, lane, wave);
            }
        }
        if (wg >= 32) {
            const int pw = wg - 32, npw = G - 32;
            for (int it = pw; it < 1024; it += npw) rw_gate_item(P, W, lds + RING_OFF, it >> 9, (it >> 2) & 127, it & 3, tid, lane, wave);
            LAS float* scr = (LAS float*)(lds + RING_OFF + wave * 16384);
            for (int it = pw * NWAVES + wave; it < 64 * 128; it += npw * NWAVES) p0_transpose_item(args.in[24], 4096, 4096, Wt_out, scr, it, lane, RmId{});
            for (int it = pw * NWAVES + wave; it < (D_FF / 64) * 98; it += npw * NWAVES) { const int kb = it / 98, nb = 30 + it % 98; p0_transpose_item(args.in[29], D_FF, 4096, Wt_dn, scr, kb * 128 + nb, lane, RmId{}); }
            __syncthreads();
        }
    }
    SEAM(3);
    if (IN(4)) _Pragma("unroll") for (int _r = 0; _r < 1 + ((REP_MASK >> 4) & 1); ++_r) {
        for (int task = gw; task < 8192 * 8; task += NGW) rw_post_task(P, W, task >> 3, task & 7, lane);
        LAS float* scr = (LAS float*)(lds + RING_OFF + wave * 16384);
        constexpr int I_G = 64 * (D_FF / 32), I_D = (D_FF / 64) * 30;
        for (int it = gw; it < 2 * I_G + I_D; it += NGW) {
            if (it < I_G) p0_transpose_item(args.in[27], 4096, D_FF, Wt_gu, scr, it, lane, RmGU{0});
            else if (it < 2 * I_G) p0_transpose_item(args.in[28], 4096, D_FF, Wt_gu, scr, it - I_G, lane, RmGU{1});
            else { const int r = it - 2 * I_G; const int kb = r / 30, nb = r % 30; p0_transpose_item(args.in[29], D_FF, 4096, Wt_dn, scr, kb * 128 + nb, lane, RmId{}); }
        }
        __syncthreads();
    }
    SEAM(4);
    if (IN(5)) _Pragma("unroll") for (int _r = 0; _r < 1 + ((REP_MASK >> 5) & 1); ++_r) {
#ifdef OLD_TAILS
        { pg8::Gemm g{hbuf, Wt_out, MPAD, 4096, 4096, 4096, 4096}; pg8::StaticOrder S; S.init(MPAD, 4096, G, (int)blockIdx.x);
        pg8::EpiF32Ssq E{args.out + O_Y, 4096, ssq, M_REAL};
        pg8::gemm_phase<pg8::EpiF32Ssq, pg8::StaticOrder, GP_ALIGN, GP_SP2>(lds + RING_OFF, g, S, E); }
#else
        pg8::Gemm g{hbuf, Wt_out, M_PROMPT, 4096, 4096, 4096, 4096}; pg8::StaticOrder S; S.init(M_PROMPT, 4096, G, (int)blockIdx.x);
        pg8::EpiBf16Ssq E{proj, 4096, ssq};
        pg8::gemm_phase<pg8::EpiBf16Ssq, pg8::StaticOrder, GP_ALIGN, GP_SP2>(lds + RING_OFF, g, S, E);
        pg8::Gemm gt{hbuf, Wt_out, MPAD, 4096, 256, 4096, 4096}; pg8::TailOrder St{16 * 16, G, (int)blockIdx.x, 0, 256, 0};
        pg8::EpiF32Part Et{(float*)(ws + WS_PART2), 4096};
        pg8::gemm_phase<pg8::EpiF32Part, pg8::TailOrder, GP_ALIGN, GP_SP2>(lds + RING_OFF, gt, St, Et);
#endif
    }
    SEAM(5);
    if (IN(6)) _Pragma("unroll") for (int _r = 0; _r < 1 + ((REP_MASK >> 6) & 1); ++_r) {
        for (int m = gw; m < M_REAL; m += NGW) {
            const float* xrow = m < M_PROMPT ? x_prompt + (size_t)m * 4096 : x_sample + (size_t)(m - M_PROMPT) * 4096;
            const GAS f32x4* xr = (const GAS f32x4*)xrow + lane; GAS f32x4* tr = (GAS f32x4*)(args.out + O_Y + (size_t)m * 4096) + lane; const GAS f32x4* gr = (const GAS f32x4*)args.in[7] + lane;
            f32x4 v[16]; float s = 0.f;
#ifdef OLD_TAILS
            const bool smp = false;
#else
            const bool smp = m >= M_PROMPT;
#endif
            if (smp) {
                const GAS f32x4* pp = (const GAS f32x4*)(ws + WS_PART2) + (size_t)(m - M_PROMPT) * 1024 + lane;
#pragma unroll
                for (int j = 0; j < 16; ++j) { f32x4 t[16];
#pragma unroll
                    for (int sp = 0; sp < 16; ++sp) t[sp] = pp[(size_t)sp * 128 * 1024 + 64 * j];
                    const f32x4 a = ((t[0] + t[1]) + (t[2] + t[3])) + ((t[4] + t[5]) + (t[6] + t[7])) + (((t[8] + t[9]) + (t[10] + t[11])) + ((t[12] + t[13]) + (t[14] + t[15])));
                    v[j] = a; s += (a.x * a.x + a.y * a.y) + (a.z * a.z + a.w * a.w); }
            } else {
                const GAS v2u* tb = (const GAS v2u*)(proj + (size_t)m * 4096) + lane; v2u tv[16];
#pragma unroll
                for (int j = 0; j < 16; ++j) tv[j] = tb[64 * j];
#pragma unroll
                for (int j = 0; j < 16; ++j) { v[j].x = bflo(tv[j].x); v[j].y = bfhi(tv[j].x); v[j].z = bflo(tv[j].y); v[j].w = bfhi(tv[j].y); }
                s = ssq[(size_t)m * 64 + lane];
            }
            s = wave_sum(s);
            const float rstd = 1.0f / sqrtf(s * (1.f / 4096.f) + NORM_EPS);
#pragma unroll
            for (int hh = 0; hh < 2; ++hh) { f32x4 xv[8], gv[8];
#pragma unroll
                for (int j = 0; j < 8; ++j) { xv[j] = xr[64 * (8 * hh + j)]; gv[j] = gr[64 * (8 * hh + j)]; }
#pragma unroll
                for (int j = 0; j < 8; ++j) { const f32x4 x1 = xv[j] + v[8 * hh + j] * rstd * gv[j]; v[8 * hh + j] = x1;
                    if (smp) tr[64 * (8 * hh + j)] = x1;
                    else { v2u o; o.x = cvt2(x1.x, x1.y); o.y = cvt2(x1.z, x1.w); ((GAS v2u*)(ws + WS_X1B) + (size_t)m * 1024 + lane)[64 * (8 * hh + j)] = o; } } }
            rms_row_to_bf16(v, args.in[25], hbuf + (size_t)m * 4096, lane);
        }
    }
    SEAM(6);
    if (IN(7)) _Pragma("unroll") for (int _r = 0; _r < 1 + ((REP_MASK >> 7) & 1); ++_r) {
        pg8::Gemm g{hbuf, Wt_gu, MPAD, 2 * D_FF, 4096, 4096, 4096}; pg8::StaticOrder S; S.init(MPAD, 2 * D_FF, G, (int)blockIdx.x);
        pg8::EpiSwiGLU E{act, D_FF};
        pg8::gemm_phase<pg8::EpiSwiGLU, pg8::StaticOrder, GP_ALIGN, GP_SP2>(lds + RING_OFF, g, S, E);
    }
    SEAM(7);
    if (IN(8)) _Pragma("unroll") for (int _r = 0; _r < 1 + ((REP_MASK >> 8) & 1); ++_r) {
#ifdef OLD_TAILS
        { pg8::Gemm g{act, Wt_dn, MPAD, 4096, D_FF, D_FF, D_FF}; pg8::StaticOrder S; S.init(MPAD, 4096, G, (int)blockIdx.x);
        pg8::EpiBf16Ssq E{hbuf, 4096, ssq};
        pg8::gemm_phase<pg8::EpiBf16Ssq, pg8::StaticOrder, GP_ALIGN, GP_SP2>(lds + RING_OFF, g, S, E); }
#else
        pg8::Gemm g{act, Wt_dn, M_PROMPT, 4096, D_FF, D_FF, D_FF}; pg8::StaticOrder S; S.init(M_PROMPT, 4096, G, (int)blockIdx.x);
        pg8::EpiBf16Ssq E{hbuf, 4096, ssq};
        pg8::gemm_phase<pg8::EpiBf16Ssq, pg8::StaticOrder, GP_ALIGN, GP_SP2>(lds + RING_OFF, g, S, E);
#ifdef REP_G4MAIN
        pg8::gemm_phase<pg8::EpiBf16Ssq, pg8::StaticOrder, GP_ALIGN, GP_SP2>(lds + RING_OFF, g, S, E);
#endif
        pg8::EpiF32Part Et{(float*)(ws + WS_PART4), 4096};
        pg8::Gemm ga{act, Wt_dn, MPAD, 4096, 768, D_FF, D_FF}; pg8::TailOrder Sa{16 * 6, G, (int)blockIdx.x - 160, 0, 768, 0};
        pg8::gemm_phase<pg8::EpiF32Part, pg8::TailOrder, GP_ALIGN, GP_SP2>(lds + RING_OFF, ga, Sa, Et);
        pg8::Gemm gb{act, Wt_dn, MPAD, 4096, 640, D_FF, D_FF}; pg8::TailOrder Sb{16 * 10, G, (int)blockIdx.x < 160 ? (int)blockIdx.x : -1, 4608, 640, 6};
        pg8::gemm_phase<pg8::EpiF32Part, pg8::TailOrder, GP_ALIGN, GP_SP2>(lds + RING_OFF, gb, Sb, Et);
#ifdef REP_G4TAIL
        pg8::gemm_phase<pg8::EpiF32Part, pg8::TailOrder, GP_ALIGN, GP_SP2>(lds + RING_OFF, ga, Sa, Et);
        pg8::gemm_phase<pg8::EpiF32Part, pg8::TailOrder, GP_ALIGN, GP_SP2>(lds + RING_OFF, gb, Sb, Et);
#endif
#endif
    }
    SEAM(8);
    if (IN(9)) _Pragma("unroll") for (int _r = 0; _r < 1 + ((REP_MASK >> 9) & 1); ++_r) {
        for (int m = gw; m < M_REAL; m += NGW) {
            GAS f32x4* orow = (GAS f32x4*)(args.out + O_Y + (size_t)m * 4096) + lane; const GAS v2u* fr = (const GAS v2u*)(hbuf + (size_t)m * 4096) + lane; const GAS f32x4* gr = (const GAS f32x4*)args.in[26] + lane;
            f32x4 f[16]; float s = 0.f;
#ifdef OLD_TAILS
            const bool smp = false;
#else
            const bool smp = m >= M_PROMPT;
#endif
            if (smp) { const GAS f32x4* fs = (const GAS f32x4*)(ws + WS_PART4) + (size_t)(m - M_PROMPT) * 1024 + lane;
#pragma unroll
                for (int j = 0; j < 16; ++j) { f32x4 t[16];
#pragma unroll
                    for (int sp = 0; sp < 16; ++sp) t[sp] = fs[(size_t)sp * 128 * 1024 + 64 * j];
                    const f32x4 a = ((t[0] + t[1]) + (t[2] + t[3])) + ((t[4] + t[5]) + (t[6] + t[7])) + (((t[8] + t[9]) + (t[10] + t[11])) + ((t[12] + t[13]) + (t[14] + t[15])));
                    f[j] = a; s += (a.x * a.x + a.y * a.y) + (a.z * a.z + a.w * a.w); }
            } else {
                v2u fv[16];
#pragma unroll
                for (int j = 0; j < 16; ++j) fv[j] = fr[64 * j];
                s = ssq[(size_t)m * 64 + lane];
#pragma unroll
                for (int j = 0; j < 16; ++j) { f[j].x = __builtin_bit_cast(float, fv[j].x << 16); f[j].y = __builtin_bit_cast(float, fv[j].x & 0xffff0000u); f[j].z = __builtin_bit_cast(float, fv[j].y << 16); f[j].w = __builtin_bit_cast(float, fv[j].y & 0xffff0000u); }
            }
            s = wave_sum(s);
            const float rstd = 1.0f / sqrtf(s * (1.f / 4096.f) + NORM_EPS);
            const GAS v2u* xb = (const GAS v2u*)(ws + WS_X1B) + (size_t)m * 1024 + lane;
#pragma unroll
            for (int hh = 0; hh < 2; ++hh) { f32x4 xv[8], gv[8];
                if (smp) {
#pragma unroll
                    for (int j = 0; j < 8; ++j) { xv[j] = orow[64 * (8 * hh + j)]; gv[j] = gr[64 * (8 * hh + j)]; }
                } else { v2u xq[8];
#pragma unroll
                    for (int j = 0; j < 8; ++j) { xq[j] = xb[64 * (8 * hh + j)]; gv[j] = gr[64 * (8 * hh + j)]; }
#pragma unroll
                    for (int j = 0; j < 8; ++j) { xv[j].x = bflo(xq[j].x); xv[j].y = bfhi(xq[j].x); xv[j].z = bflo(xq[j].y); xv[j].w = bfhi(xq[j].y); } }
#pragma unroll
                for (int j = 0; j < 8; ++j) orow[64 * (8 * hh + j)] = xv[j] + f[8 * hh + j] * rstd * gv[j]; }
        }
    }
#undef IN
#undef SEAM
}

extern "C" void kernel_launch(void* const* d_in, const int* in_sizes, int n_in, void* d_out, int out_size, void* d_ws, size_t ws_size, hipStream_t stream) {
    static int grid = 0;
    if (grid == 0) {
        if (n_in != 30 || out_size != (int)O_END || ws_size < WS_END) { fprintf(stderr, "kernel_launch: unexpected shapes (n_in %d out %d ws %zu)\n", n_in, out_size, ws_size); grid = -1; return; }
        int dev = 0, cus = 0, per_cu = 0;
        if (hipGetDevice(&dev) != hipSuccess || hipDeviceGetAttribute(&cus, hipDeviceAttributeMultiprocessorCount, dev) != hipSuccess) { grid = -1; return; }
        if (hipFuncSetAttribute((const void*)hymba_fwd, hipFuncAttributeMaxDynamicSharedMemorySize, LDS_BYTES) != hipSuccess) { grid = -1; return; }
        if (hipOccupancyMaxActiveBlocksPerMultiprocessor(&per_cu, (const void*)hymba_fwd, NWAVES * 64, LDS_BYTES) != hipSuccess || per_cu < 1) { fprintf(stderr, "kernel_launch: occupancy query says %d\n", per_cu); }
        (void)hipGetLastError();
        grid = cus;
    }
    if (grid < 0) return;
    if (hipMemsetAsync((char*)d_ws + WS_CTL, 0, CTL_ZERO_BYTES, stream) != hipSuccess) return;
    Args a{};
    for (int i = 0; i < 30; ++i) a.in[i] = (const float*)d_in[i];
    a.out = (float*)d_out; a.ws = (unsigned char*)d_ws;
    if (MK_N_LAUNCHES == 1) { a.ph_lo = 0; a.ph_hi = NPH; hipLaunchKernelGGL(hymba_fwd, dim3(grid), dim3(NWAVES * 64), LDS_BYTES, stream, a); }
    else for (int p = 0; p < NPH; ++p) { a.ph_lo = p; a.ph_hi = p + 1; hipLaunchKernelGGL(hymba_fwd, dim3(grid), dim3(NWAVES * 64), LDS_BYTES, stream, a); }
}
```

```cpp
#include <hip/hip_runtime.h>
#include <cstdio>
#include <cstdint>

namespace pg8 {
#define PG8_LAS __attribute__((address_space(3)))
typedef unsigned short bf16_t;
typedef short bf16x8 __attribute__((ext_vector_type(8)));
typedef float f32x4 __attribute__((ext_vector_type(4)));
typedef unsigned u32x4 __attribute__((ext_vector_type(4)));
constexpr int BM = 256, BK = 64, HALF = 128, HTB = HALF * BK * 2  , STAGE_BYTES = 8 * HTB, NXCD = 8, WGM = 8;

__host__ __device__ __forceinline__ int lds_byte(int r, int c) { const int st = (r >> 4) * 2 + (c >> 5), rr = r & 15, cc = c & 31, ob = rr * 64 + cc * 2; return st * 1024 + (ob ^ (((ob >> 9) & 1) << 5)); }
__host__ __device__ __forceinline__ void stage_rc(int b, int& R, int& C) { const int st = b / 1024, sb = b % 1024, swz = sb ^ (((sb >> 9) & 1) << 5); R = (st >> 1) * 16 + swz / 64; C = (st & 1) * 32 + (swz % 64) / 2; }
__host__ __device__ __forceinline__ int perm32(int rho) { const int n = rho >> 4, i = rho & 15; return 8 * (i >> 2) + 4 * n + (i & 3); }

struct Unit { int pm, pn, ko, pi; };
struct Gemm { const bf16_t* A; const bf16_t* Bt; int M, N, K, lda, ldb; };

struct StaticOrder {
    int nM, nN, nwg, G, c;
    __host__ __device__ void init(int M, int N, int G_, int c_) { nM = M / BM; nN = N / BM; nwg = nM * nN; G = G_; c = c_; }
    __host__ __device__ bool next(int i, Unit& u) const {
        const long L = (long)i * G + c; if (L >= nwg) return false;
        int wgid = (int)L; { const int q = nwg / NXCD, r = nwg % NXCD, xcd = wgid % NXCD, off = wgid / NXCD; wgid = (xcd < r ? xcd * (q + 1) : r * (q + 1) + (xcd - r) * q) + off; }
        const int nig = WGM * nN, gid = wgid / nig, fm = gid * WGM, gsz = (nM - fm) < WGM ? (nM - fm) : WGM;
        u.pm = fm + ((wgid % nig) % gsz); u.pn = (wgid % nig) / gsz; u.ko = 0; u.pi = 0; return true;
    }
    __device__ __forceinline__ void a_ready(const Unit&) const {}
    __device__ __forceinline__ void done(const Unit&) const {}
};
__device__ __forceinline__ unsigned cvt_pk_bf16(float lo, float hi) { unsigned r; asm volatile("v_cvt_pk_bf16_f32 %0, %1, %2" : "=v"(r) : "v"(lo), "v"(hi)); return r; }

struct EpiBf16Plain {
    static constexpr bool PERM = true, AFTER_DRAIN = false;
    bf16_t* O; int ldc;
    __device__ __forceinline__ void operator()(const f32x4 (&acc)[2][2][4][2], const Unit& u, int wr, int wc, int fr, int fq) const {
        const int row0 = u.pm * BM + wr * 64 + fr, col0 = u.pn * BM + wc * 32 + 8 * fq;
#pragma unroll
        for (int ai = 0; ai < 2; ++ai)
#pragma unroll
            for (int m = 0; m < 4; ++m) { bf16_t* rowp = O + (size_t)(row0 + ai * HALF + m * 16) * ldc + col0;
#pragma unroll
                for (int bj = 0; bj < 2; ++bj) { const f32x4 v0 = acc[ai][bj][m][0], v1 = acc[ai][bj][m][1];
                    u32x4 w; w.x = cvt_pk_bf16(v0[0], v0[1]); w.y = cvt_pk_bf16(v0[2], v0[3]); w.z = cvt_pk_bf16(v1[0], v1[1]); w.w = cvt_pk_bf16(v1[2], v1[3]);
                    *(u32x4*)(rowp + bj * HALF) = w; } }
    }
};
__device__ __forceinline__ float silu_f(float x) { return x * __builtin_amdgcn_rcpf(1.0f + __expf(-x)); }
struct EpiSwiGLU {
    static constexpr bool PERM = true, AFTER_DRAIN = false;
    bf16_t* O; int ldc;
    __device__ __forceinline__ void operator()(const f32x4 (&acc)[2][2][4][2], const Unit& u, int wr, int wc, int fr, int fq) const {
        const int row0 = u.pm * BM + wr * 64 + fr, col0 = u.pn * HALF + wc * 32 + 8 * fq;
#pragma unroll
        for (int ai = 0; ai < 2; ++ai)
#pragma unroll
            for (int m = 0; m < 4; ++m) { bf16_t* rowp = O + (size_t)(row0 + ai * HALF + m * 16) * ldc + col0;
                const f32x4 g0 = acc[ai][0][m][0], g1 = acc[ai][0][m][1], u0 = acc[ai][1][m][0], u1 = acc[ai][1][m][1];
                u32x4 w; w.x = cvt_pk_bf16(silu_f(g0[0]) * u0[0], silu_f(g0[1]) * u0[1]); w.y = cvt_pk_bf16(silu_f(g0[2]) * u0[2], silu_f(g0[3]) * u0[3]);
                w.z = cvt_pk_bf16(silu_f(g1[0]) * u1[0], silu_f(g1[1]) * u1[1]); w.w = cvt_pk_bf16(silu_f(g1[2]) * u1[2], silu_f(g1[3]) * u1[3]);
                *(u32x4*)rowp = w; }
    }
};
struct EpiF32Ssq {
    static constexpr bool PERM = false, AFTER_DRAIN = false;
    float* C; int ldc; float* ssq; int mreal;
    __device__ __forceinline__ void operator()(const f32x4 (&acc)[2][2][4][2], const Unit& u, int wr, int wc, int fr, int fq) const {
        const int row0 = u.pm * BM + wr * 64 + fr, col0 = u.pn * BM + wc * 32 + 4 * fq;
#pragma unroll
        for (int ai = 0; ai < 2; ++ai)
#pragma unroll
            for (int m = 0; m < 4; ++m) { const int row = row0 + ai * HALF + m * 16; float s = 0.f;
#pragma unroll
                for (int bj = 0; bj < 2; ++bj)
#pragma unroll
                    for (int n = 0; n < 2; ++n) { const f32x4 v = acc[ai][bj][m][n]; s += (v[0] * v[0] + v[1] * v[1]) + (v[2] * v[2] + v[3] * v[3]);
                        if (row < mreal) *(f32x4*)(C + (size_t)row * ldc + col0 + bj * HALF + n * 16) = v; }
                s += __shfl_xor(s, 16); s += __shfl_xor(s, 32);
                if (fq == 0) ssq[(size_t)row * 64 + u.pn * 4 + wc] = s; }
    }
};
struct EpiBf16Ssq {
    static constexpr bool PERM = true, AFTER_DRAIN = false;
    bf16_t* O; int ldc; float* ssq;
    __device__ __forceinline__ void operator()(const f32x4 (&acc)[2][2][4][2], const Unit& u, int wr, int wc, int fr, int fq) const {
        const int row0 = u.pm * BM + wr * 64 + fr, col0 = u.pn * BM + wc * 32 + 8 * fq;
#pragma unroll
        for (int ai = 0; ai < 2; ++ai)
#pragma unroll
            for (int m = 0; m < 4; ++m) { const int row = row0 + ai * HALF + m * 16; bf16_t* rowp = O + (size_t)row * ldc + col0; float s = 0.f;
#pragma unroll
                for (int bj = 0; bj < 2; ++bj) { const f32x4 v0 = acc[ai][bj][m][0], v1 = acc[ai][bj][m][1];
                    s += (v0[0] * v0[0] + v0[1] * v0[1]) + (v0[2] * v0[2] + v0[3] * v0[3]) + (v1[0] * v1[0] + v1[1] * v1[1]) + (v1[2] * v1[2] + v1[3] * v1[3]);
                    u32x4 w; w.x = cvt_pk_bf16(v0[0], v0[1]); w.y = cvt_pk_bf16(v0[2], v0[3]); w.z = cvt_pk_bf16(v1[0], v1[1]); w.w = cvt_pk_bf16(v1[2], v1[3]);
                    *(u32x4*)(rowp + bj * HALF) = w; }
                s += __shfl_xor(s, 16); s += __shfl_xor(s, 32);
                if (fq == 0) ssq[(size_t)row * 64 + u.pn * 4 + wc] = s; }
    }
};
struct EpiSink {
    static constexpr bool PERM = true, AFTER_DRAIN = false;
    __device__ __forceinline__ void operator()(const f32x4 (&acc)[2][2][4][2], const Unit& u, int wr, int wc, int fr, int fq) const {
#pragma unroll
        for (int ai = 0; ai < 2; ++ai)
#pragma unroll
            for (int bj = 0; bj < 2; ++bj)
#pragma unroll
                for (int m = 0; m < 4; ++m)
#pragma unroll
                    for (int n = 0; n < 2; ++n) asm volatile("" :: "v"(acc[ai][bj][m][n]));
    }
};
struct EpiPair {
    static constexpr bool PERM = true, AFTER_DRAIN = false;
    bf16_t* O; int ldc;
    __device__ __forceinline__ void operator()(const f32x4 (&acc)[2][2][4][2], const Unit& u, int wr, int wc, int fr, int fq) const {
        const int row0 = u.pm * BM + wr * 64 + fr, col0 = u.pn * BM + wc * 64 + 8 * fq;
#pragma unroll
        for (int ai = 0; ai < 2; ++ai)
#pragma unroll
            for (int m = 0; m < 4; ++m) { bf16_t* rowp = O + (size_t)(row0 + ai * HALF + m * 16) * ldc + col0;
#pragma unroll
                for (int bj = 0; bj < 2; ++bj) { const f32x4 v0 = acc[ai][bj][m][0], v1 = acc[ai][bj][m][1];
                    u32x4 w; w.x = cvt_pk_bf16(v0[0], v0[1]); w.y = cvt_pk_bf16(v0[2], v0[3]); w.z = cvt_pk_bf16(v1[0], v1[1]); w.w = cvt_pk_bf16(v1[2], v1[3]);
                    *(u32x4*)(rowp + bj * 32) = w; } }
    }
};
#ifdef PROBE_ROWS
struct EpiRows {
    static constexpr bool PERM = true, AFTER_DRAIN = false;
    bf16_t* O; int ldc;
    __device__ __forceinline__ void operator()(const f32x4 (&acc)[2][2][4][2], const Unit& u, int wr, int wc, int fr, int fq) const {
        constexpr int LPR = 64 / PROBE_ROWS; const int lane = fq * 16 + fr;
        const int row0 = u.pm * BM + wr * 128 + lane / LPR, col0 = u.pn * BM + ((wc * LPR * 8) & 255) + (lane % LPR) * 8;
#pragma unroll
        for (int ai = 0; ai < 2; ++ai)
#pragma unroll
            for (int m = 0; m < 4; ++m) {
#pragma unroll
                for (int bj = 0; bj < 2; ++bj) { const f32x4 v0 = acc[ai][bj][m][0], v1 = acc[ai][bj][m][1];
                    u32x4 w; w.x = cvt_pk_bf16(v0[0], v0[1]); w.y = cvt_pk_bf16(v0[2], v0[3]); w.z = cvt_pk_bf16(v1[0], v1[1]); w.w = cvt_pk_bf16(v1[2], v1[3]);
                    *(u32x4*)(O + (size_t)(row0 + (((ai * 4 + m) * 2 + bj) * PROBE_ROWS) % 128) * ldc + col0) = w; } }
    }
};
#endif
struct EpiTile {
    static constexpr bool PERM = true, AFTER_DRAIN = false;
    bf16_t* O; int ldc;
    __device__ __forceinline__ void operator()(const f32x4 (&acc)[2][2][4][2], const Unit& u, int wr, int wc, int fr, int fq) const {
        bf16_t* base = O + (size_t)(u.pm * 58 + u.pn) * 65536 + (wr * 64 + fr) * 256 + wc * 32 + 8 * fq;
#pragma unroll
        for (int ai = 0; ai < 2; ++ai)
#pragma unroll
            for (int m = 0; m < 4; ++m) { bf16_t* rowp = base + (ai * HALF + m * 16) * 256;
#pragma unroll
                for (int bj = 0; bj < 2; ++bj) { const f32x4 v0 = acc[ai][bj][m][0], v1 = acc[ai][bj][m][1];
                    u32x4 w; w.x = cvt_pk_bf16(v0[0], v0[1]); w.y = cvt_pk_bf16(v0[2], v0[3]); w.z = cvt_pk_bf16(v1[0], v1[1]); w.w = cvt_pk_bf16(v1[2], v1[3]);
                    *(u32x4*)(rowp + bj * HALF) = w; } }
    }
};
struct EpiContig {
    static constexpr bool PERM = true, AFTER_DRAIN = false;
    bf16_t* O; int ldc;
    __device__ __forceinline__ void operator()(const f32x4 (&acc)[2][2][4][2], const Unit& u, int wr, int wc, int fr, int fq) const {
        char* base = (char*)O + ((size_t)(u.pm * 58 + u.pn) * 8 + (wr * 4 + wc)) * 16384 + (fq * 16 + fr) * 16;
#pragma unroll
        for (int ai = 0; ai < 2; ++ai)
#pragma unroll
            for (int m = 0; m < 4; ++m) {
#pragma unroll
                for (int bj = 0; bj < 2; ++bj) { const f32x4 v0 = acc[ai][bj][m][0], v1 = acc[ai][bj][m][1];
                    u32x4 w; w.x = cvt_pk_bf16(v0[0], v0[1]); w.y = cvt_pk_bf16(v0[2], v0[3]); w.z = cvt_pk_bf16(v1[0], v1[1]); w.w = cvt_pk_bf16(v1[2], v1[3]);
                    *(u32x4*)(base + ((ai * 4 + m) * 2 + bj) * 1024) = w; } }
    }
};
struct EpiF32Part {
    static constexpr bool PERM = false, AFTER_DRAIN = false;
    float* P; int ldc;
    __device__ __forceinline__ void operator()(const f32x4 (&acc)[2][2][4][2], const Unit& u, int wr, int wc, int fr, int fq) const {
        const int rowl = wr * 64 + fr, col0 = u.pn * BM + wc * 32 + 4 * fq; float* base = P + (size_t)u.pi * 128 * ldc;
#pragma unroll
        for (int m = 0; m < 4; ++m)
#pragma unroll
            for (int bj = 0; bj < 2; ++bj)
#pragma unroll
                for (int n = 0; n < 2; ++n) *(f32x4*)(base + (size_t)(rowl + m * 16) * ldc + col0 + bj * HALF + n * 16) = acc[0][bj][m][n];
    }
};
struct TailOrder {
    int nsub, G, c, kbase, klen, pbase;
    __device__ bool next(int i, Unit& u) const { const int idx = i * G + c; if (c < 0 || idx >= nsub) return false; const int sp = idx >> 4; u.pm = 64; u.pn = idx & 15; u.ko = kbase + sp * klen; u.pi = pbase + sp; return true; }
    __device__ __forceinline__ void a_ready(const Unit&) const {}
    __device__ __forceinline__ void done(const Unit&) const {}
};
struct SubsetOrder {
    int nN, nunits, nw, c;
    __device__ bool next(int i, Unit& u) const { const int idx = i * nw + c; if (c < 0 || idx >= nunits) return false; u.pm = idx / nN; u.pn = idx - u.pm * nN; u.ko = 0; u.pi = 0; return true; }
    __device__ __forceinline__ void a_ready(const Unit&) const {}
    __device__ __forceinline__ void done(const Unit&) const {}
};
template <class Epi, class Sched, bool ALIGN_EPI = false, bool SP2 = false>
__device__ __forceinline__ void gemm_phase(PG8_LAS unsigned char* lds, const Gemm g, const Sched& S, const Epi& E) {
    const int tid = threadIdx.x, wid = __builtin_amdgcn_readfirstlane(tid >> 6), lane = tid & 63, wr = wid >> 2, wc = wid & 3, fr = lane & 15, fq = lane >> 4;
    const int K = g.K, nt = K / BK;
    unsigned voffA[2], voffB[2];
#pragma unroll
    for (int i = 0; i < 2; ++i) { int R, C; stage_rc(tid * 16 + i * 8192, R, C); const int Rb = Epi::PERM ? ((R & ~31) + perm32(R & 31)) : R;
        voffA[i] = (unsigned)(R * g.lda + C) * 2u; voffB[i] = (unsigned)(Rb * g.ldb + C) * 2u; }
    const size_t kstep = (size_t)(BK * 2);
    const size_t hstepA = (size_t)HALF * g.lda * 2, hstepB = (size_t)HALF * g.ldb * 2;
    const size_t tstepA = 2 * hstepA, tstepB = 2 * hstepB;
    const unsigned ldsw = (unsigned)wid * 1024u;
    const int aoff = lds_byte(wr * 64 + fr, fq * 8), boff = lds_byte(wc * 32 + fr, fq * 8);
#define PG8_SA(b, h) (((b) * 2 + (h)) * HTB)
#define PG8_SB(b, h) ((4 + (b) * 2 + (h)) * HTB)
#define PG8_STAGE(bufoff, gbase, voff) do { _Pragma("unroll") for (int _i = 0; _i < 2; ++_i) \
        __builtin_amdgcn_global_load_lds((const unsigned*)((const char*)(gbase) + (voff)[_i]), (PG8_LAS unsigned*)(lds + (bufoff) + ldsw + _i * 8192), 16, 0, 0); } while (0)
#define PG8_LDA(dst, b, h) do { _Pragma("unroll") for (int m = 0; m < 4; ++m) _Pragma("unroll") for (int k = 0; k < 2; ++k) dst[m][k] = *(const PG8_LAS bf16x8*)(lds + PG8_SA(b, h) + aoff + m * 2048 + k * 1024); } while (0)
#define PG8_LDB(dst, b, h) do { _Pragma("unroll") for (int n = 0; n < 2; ++n) _Pragma("unroll") for (int k = 0; k < 2; ++k) dst[n][k] = *(const PG8_LAS bf16x8*)(lds + PG8_SB(b, h) + boff + n * 2048 + k * 1024); } while (0)
#ifndef PG8_PRIO
#define PG8_PRIO 3
#endif
#define PG8_MMA(ai, bj, At, Bt) do { if (PG8_PRIO) __builtin_amdgcn_s_setprio(PG8_PRIO); _Pragma("unroll") for (int m = 0; m < 4; ++m) _Pragma("unroll") for (int n = 0; n < 2; ++n) _Pragma("unroll") for (int k = 0; k < 2; ++k) \
        acc[ai][bj][m][n] = __builtin_amdgcn_mfma_f32_16x16x32_bf16(Bt[n][k], At[m][k], acc[ai][bj][m][n], 0, 0, 0); if (PG8_PRIO) __builtin_amdgcn_s_setprio(0); } while (0)
#define PG8_WAIT_V(n) asm volatile("s_waitcnt vmcnt(" #n ")" ::: "memory")
#define PG8_WAIT_L(n) asm volatile("s_waitcnt lgkmcnt(" #n ")" ::: "memory")
#define PG8_BAR __builtin_amdgcn_s_barrier()
#define PG8_SCHED __builtin_amdgcn_sched_barrier(0)
    Unit cur, nxt; int ui = 0;
    if (!S.next(0, cur)) return;
    f32x4 acc[2][2][4][2];
#pragma unroll
    for (int a = 0; a < 2; ++a)
#pragma unroll
        for (int b = 0; b < 2; ++b)
#pragma unroll
            for (int m = 0; m < 4; ++m)
#pragma unroll
                for (int n = 0; n < 2; ++n) acc[a][b][m][n] = (f32x4){0.f, 0.f, 0.f, 0.f};
    bf16x8 At[4][2], B0[2][2], B1[2][2];
    const char* cA = (const char*)g.A + (size_t)cur.pm * tstepA + (size_t)cur.ko * 2; const char* cB = (const char*)g.Bt + (size_t)cur.pn * tstepB + (size_t)cur.ko * 2;
    S.a_ready(cur);
    if constexpr (SP2) {
        PG8_STAGE(PG8_SB(0, 0), cB, voffB); PG8_STAGE(PG8_SB(0, 1), cB + hstepB, voffB); PG8_STAGE(PG8_SA(0, 0), cA, voffA); PG8_STAGE(PG8_SA(0, 1), cA + hstepA, voffA);
        if (wr == 1) PG8_BAR;
        PG8_WAIT_V(2); PG8_BAR;
        PG8_STAGE(PG8_SB(1, 0), cB + kstep, voffB); PG8_STAGE(PG8_SA(1, 0), cA + kstep, voffA); PG8_STAGE(PG8_SB(1, 1), cB + hstepB + kstep, voffB);
        PG8_WAIT_V(6); PG8_BAR;
    } else {
        PG8_STAGE(PG8_SB(0, 0), cB, voffB); PG8_STAGE(PG8_SA(0, 0), cA, voffA); PG8_STAGE(PG8_SB(0, 1), cB + hstepB, voffB); PG8_STAGE(PG8_SA(0, 1), cA + hstepA, voffA);
        if (wr == 1) PG8_BAR;
        PG8_WAIT_V(4); PG8_BAR;
        PG8_STAGE(PG8_SB(1, 0), cB + kstep, voffB); PG8_STAGE(PG8_SA(1, 0), cA + kstep, voffA); PG8_STAGE(PG8_SB(1, 1), cB + hstepB + kstep, voffB);
        PG8_WAIT_V(6); PG8_BAR;
    }
    for (;;) {
        const bool has_next = S.next(ui + 1, nxt);
        const char* nA = has_next ? (const char*)g.A + (size_t)nxt.pm * tstepA + (size_t)nxt.ko * 2 : cA; const char* nB = has_next ? (const char*)g.Bt + (size_t)nxt.pn * tstepB + (size_t)nxt.ko * 2 : cB;
        for (int t = 0; t < nt; t += 2) {
            const bool last = (t == nt - 2);
            const char* a1 = cA + (size_t)(t + 1) * kstep;
            const char* a2 = last ? nA : cA + (size_t)(t + 2) * kstep; const char* b2 = last ? nB : cB + (size_t)(t + 2) * kstep;
            const char* a3 = a2 + kstep; const char* b3 = b2 + kstep;
            if (last && has_next) S.a_ready(nxt);
            if constexpr (SP2) {
            PG8_LDB(B0, 0, 0); PG8_LDB(B1, 0, 1); PG8_SCHED; PG8_LDA(At, 0, 0); PG8_STAGE(PG8_SA(1, 1), a1 + hstepA, voffA);
            PG8_WAIT_V(8); PG8_WAIT_L(0); PG8_BAR; PG8_MMA(0, 0, At, B0); PG8_MMA(0, 1, At, B1); PG8_BAR; PG8_SCHED;
            PG8_LDA(At, 0, 1); PG8_STAGE(PG8_SB(0, 0), b2, voffB); PG8_STAGE(PG8_SB(0, 1), b2 + hstepB, voffB); PG8_STAGE(PG8_SA(0, 0), a2, voffA);
            PG8_WAIT_V(8); PG8_WAIT_L(0); PG8_BAR; PG8_MMA(1, 0, At, B0); PG8_MMA(1, 1, At, B1); PG8_BAR; PG8_SCHED;
            PG8_LDB(B0, 1, 0); PG8_LDB(B1, 1, 1); PG8_SCHED; PG8_LDA(At, 1, 0); PG8_STAGE(PG8_SA(0, 1), a2 + hstepA, voffA);
            PG8_WAIT_V(8); PG8_WAIT_L(0); PG8_BAR; PG8_MMA(0, 0, At, B0); PG8_MMA(0, 1, At, B1); PG8_BAR; PG8_SCHED;
            PG8_LDA(At, 1, 1); PG8_STAGE(PG8_SB(1, 0), b3, voffB); PG8_STAGE(PG8_SB(1, 1), b3 + hstepB, voffB); PG8_STAGE(PG8_SA(1, 0), a3, voffA);
            PG8_WAIT_V(8); PG8_WAIT_L(0); PG8_BAR; PG8_MMA(1, 0, At, B0); PG8_MMA(1, 1, At, B1); PG8_BAR; PG8_SCHED;
            } else {
            PG8_LDB(B0, 0, 0); PG8_SCHED; PG8_LDA(At, 0, 0); PG8_STAGE(PG8_SA(1, 1), a1 + hstepA, voffA);
            PG8_WAIT_L(8); PG8_BAR; PG8_WAIT_L(0); PG8_MMA(0, 0, At, B0); PG8_BAR; PG8_SCHED;
            PG8_LDB(B1, 0, 1); PG8_STAGE(PG8_SB(0, 0), b2, voffB);
            PG8_BAR; PG8_WAIT_L(0); PG8_MMA(0, 1, At, B1); PG8_BAR;
            PG8_LDA(At, 0, 1); PG8_STAGE(PG8_SA(0, 0), a2, voffA);
            PG8_BAR; PG8_WAIT_L(0); PG8_MMA(1, 0, At, B0); PG8_BAR; PG8_SCHED;
            PG8_STAGE(PG8_SB(0, 1), b2 + hstepB, voffB);
            PG8_WAIT_V(6); PG8_BAR; PG8_MMA(1, 1, At, B1); PG8_BAR;
            PG8_LDB(B0, 1, 0); PG8_SCHED; PG8_LDA(At, 1, 0); PG8_STAGE(PG8_SA(0, 1), a2 + hstepA, voffA);
            PG8_WAIT_L(8); PG8_BAR; PG8_WAIT_L(0); PG8_MMA(0, 0, At, B0); PG8_BAR; PG8_SCHED;
            PG8_LDB(B1, 1, 1); PG8_STAGE(PG8_SB(1, 0), b3, voffB);
            PG8_BAR; PG8_WAIT_L(0); PG8_MMA(0, 1, At, B1); PG8_BAR;
            PG8_LDA(At, 1, 1); PG8_STAGE(PG8_SA(1, 0), a3, voffA);
            PG8_BAR; PG8_WAIT_L(0); PG8_MMA(1, 0, At, B0); PG8_BAR; PG8_SCHED;
            PG8_STAGE(PG8_SB(1, 1), b3 + hstepB, voffB);
            PG8_WAIT_V(6); PG8_BAR; PG8_MMA(1, 1, At, B1); PG8_BAR;
            }
        }
        if constexpr (ALIGN_EPI) { if (wr == 0) PG8_BAR; }
        if constexpr (!Epi::AFTER_DRAIN) { E(acc, cur, wr, wc, fr, fq); S.done(cur); }
        if (!has_next) break;
#pragma unroll
        for (int a = 0; a < 2; ++a)
#pragma unroll
            for (int b = 0; b < 2; ++b)
#pragma unroll
                for (int m = 0; m < 4; ++m)
#pragma unroll
                    for (int n = 0; n < 2; ++n) acc[a][b][m][n] = (f32x4){0.f, 0.f, 0.f, 0.f};
        cur = nxt; cA = nA; cB = nB; ++ui;
        if constexpr (ALIGN_EPI) { if (wr == 1) PG8_BAR; }
    }
    PG8_WAIT_V(0);
    if constexpr (!ALIGN_EPI) { if (wr == 0) PG8_BAR; }
    PG8_BAR;
    if constexpr (Epi::AFTER_DRAIN) { E.fused(acc, cur, wr, wc, fr, fq, lds, wid, lane); S.done(cur); }
#undef PG8_SA
#undef PG8_SB
#undef PG8_STAGE
#undef PG8_LDA
#undef PG8_LDB
#undef PG8_MMA
#undef PG8_WAIT_V
#undef PG8_WAIT_L
#undef PG8_BAR
#undef PG8_SCHED
}
}

constexpr int NWAVES = 8;
constexpr int D_MODEL = 4096, SEQ = 8192, DEC_SEQ = 16;
constexpr int M_PROMPT = 16384, M_REAL = 16512, MPAD = 16640;
constexpr int IN_W = 14816, IN_WP = 14848, D_FF = 11008;
constexpr int PC_Q = 0, PC_K = 2048, PC_V = 4096, PC_Z = 6144, PC_B = 8192, PC_A = 8208, PC_RW = 8224;
constexpr int RW_R = 0, RW_K = 2048, RW_V = 4096, RW_XW = 6144, RW_XA = 6240, RW_XG = 6336, RW_SHIFT_W = 6592;
constexpr float NORM_EPS = 1e-6f, RW_GN_EPS = 64e-5f;
constexpr size_t O_Y = 0, O_SDN_P = 67633152, O_CONV_P = 68157440, O_SRW_P = 68194304, O_SHIFT_P = 68456448,
                 O_SDN_S = 68469632, O_CONV_S = 70566784, O_SRW_S = 70714240, O_SHIFT_S = 71762816, O_END = 71815552;
constexpr size_t MiB = 1u << 20;
constexpr size_t WS_CTL = 0, CTL_ZERO_BYTES = 1 * MiB;
constexpr size_t WS_SSQ = 2 * MiB;
constexpr size_t WS_W2T = 6553600, WS_A2T = WS_W2T + 2048 * 96 * 2, WS_G2T = 7 * MiB;
constexpr size_t WS_WOUT = 8 * MiB;
constexpr size_t WS_HBUF = 40 * MiB;
constexpr size_t WS_PROJ = 170 * MiB;
constexpr size_t WS_WIN = 642 * MiB;
constexpr size_t WS_WGU = 758 * MiB;
constexpr size_t WS_WDN = 930 * MiB;
constexpr size_t WS_END = 1016 * MiB;
constexpr size_t WS_X1B = 520 * MiB;
constexpr size_t WS_PART2 = 710 * MiB, WS_PART4 = 678 * MiB;
constexpr size_t WS_SXG = 742 * MiB;
constexpr size_t WS_DNQK = 642 * MiB, WS_DNGL = 674 * MiB, WS_RWSB = 675 * MiB, WS_RWOO = 678 * MiB, WS_RWPQ = 758 * MiB, WS_RWRP = 886 * MiB;
static_assert(WS_SSQ + (size_t)MPAD * 64 * 4 <= WS_WOUT && WS_HBUF + (size_t)MPAD * 4096 * 2 <= WS_PROJ && WS_PROJ + (size_t)MPAD * IN_WP * 2 <= WS_WIN &&
              WS_WIN + (size_t)IN_WP * 4096 * 2 <= WS_WGU && WS_WGU + (size_t)2 * D_FF * 4096 * 2 <= WS_WDN && WS_WDN + (size_t)4096 * D_FF * 2 <= WS_END, "d_ws map");
constexpr int CW_BAR = 4096;
constexpr int RING_OFF = 0, RING_BYTES = 131072;
constexpr int LDSCTL_OFF = RING_BYTES, MISC_OFF = LDSCTL_OFF + 320;
constexpr int LDS_BYTES = 163840;

#define GAS __attribute__((address_space(1)))
#define LAS __attribute__((address_space(3)))
typedef unsigned short bf16;
typedef unsigned v4u __attribute__((ext_vector_type(4)));
typedef unsigned v2u __attribute__((ext_vector_type(2)));
typedef float f32x4 __attribute__((ext_vector_type(4)));
typedef GAS unsigned gu32;
#define RLX_AGENT __ATOMIC_RELAXED, __HIP_MEMORY_SCOPE_AGENT
#define LDS_WAIT() asm volatile("s_waitcnt lgkmcnt(0)" ::: "memory")
__device__ __forceinline__ unsigned f2bf(float f) { unsigned u = __builtin_bit_cast(unsigned, f); return (u + 0x7fffu + ((u >> 16) & 1u)) >> 16; }
__device__ __forceinline__ unsigned pk2(float lo, float hi) { return f2bf(lo) | (f2bf(hi) << 16); }
__device__ __forceinline__ float bf2f(bf16 b) { return __builtin_bit_cast(float, (unsigned)b << 16); }
__device__ __forceinline__ float bflo(unsigned u) { return __builtin_bit_cast(float, u << 16); }
__device__ __forceinline__ float bfhi(unsigned u) { return __builtin_bit_cast(float, u & 0xffff0000u); }
#ifdef OLD_WAVE_SUM
__device__ __forceinline__ float wave_sum(float v) {
#pragma unroll
    for (int o = 1; o < 64; o <<= 1) v += __shfl_xor(v, o);
    return v;
}
#else
#define WS_DPP(x, ctrl, rmask) __builtin_bit_cast(float, __builtin_amdgcn_update_dpp(0, __builtin_bit_cast(int, (x)), (ctrl), (rmask), 0xf, true))
__device__ __forceinline__ float wave_sum(float v) {
    v += WS_DPP(v, 0xB1, 0xf); v += WS_DPP(v, 0x4E, 0xf); v += WS_DPP(v, 0x141, 0xf); v += WS_DPP(v, 0x140, 0xf);
    v += WS_DPP(v, 0x142, 0xa); v += WS_DPP(v, 0x143, 0xc);
    return __builtin_bit_cast(float, __builtin_amdgcn_readlane(__builtin_bit_cast(int, v), 63));
}
#endif
#ifdef OLD_MATH
__device__ __forceinline__ float sigmoid_f(float x) { return 1.0f / (1.0f + __expf(-x)); }
__device__ __forceinline__ float softplus_f(float x) { return x > 20.f ? x : log1pf(__expf(x)); }
#else
__device__ __forceinline__ float sigmoid_f(float x) { return __builtin_amdgcn_rcpf(1.0f + __expf(-x)); }
__device__ __forceinline__ float softplus_f(float x) { return x > 20.f ? x : __logf(1.0f + __expf(x)); }
#endif
__device__ __forceinline__ void wave_sum8(float (&v)[8]) {
#pragma unroll
    for (int o = 1; o < 64; o <<= 1) {
#pragma unroll
        for (int i = 0; i < 8; ++i) v[i] += __shfl_xor(v[i], o); }
}

#define XB_TMO      128
#define XB_XCNT(j)  (256  + 64 * (j))
#define XB_XSUB(j)  (1280 + 64 * (j))
#define XB_XGEN(j)  (2304 + 64 * (j))
#define XB_TOP      3328
#define XB_TOPGEN   3392
#define XCD_BAR_WORDS 3456
#define XB_SPIN_CAP (1u << 18)

__device__ __forceinline__ unsigned xb_ld(unsigned* p)              { return __hip_atomic_load(p, __ATOMIC_RELAXED, __HIP_MEMORY_SCOPE_AGENT); }
__device__ __forceinline__ unsigned xb_add(unsigned* p, unsigned v) { return __hip_atomic_fetch_add(p, v, __ATOMIC_RELAXED, __HIP_MEMORY_SCOPE_AGENT); }
__device__ __forceinline__ unsigned xb_xcc_id() { return (unsigned)__builtin_amdgcn_s_getreg((3 << 11) | 20) & 0xFu; }
#define XB_SPIN(cond, bar) do { unsigned _sp = 0; while (cond) { __builtin_amdgcn_s_sleep(1); \
    if ((++_sp & 255u) == 0u) { if (xb_ld(&(bar)[XB_TMO])) break; if (_sp > XB_SPIN_CAP) { atomicAdd(&(bar)[XB_TMO], 1u); break; } } } } while (0)

struct XcdBarrier {
    unsigned* bar; unsigned x;
    volatile LAS unsigned* st;
};

__device__ __forceinline__ XcdBarrier xcd_barrier_post(unsigned* bar, volatile LAS unsigned* st) {
    XcdBarrier b; b.bar = bar; b.x = xb_xcc_id(); b.st = st;
    if (threadIdx.x == 0) (void)xb_add(&bar[XB_XCNT(b.x)], 1u);
    return b;
}
__device__ __forceinline__ void xcd_barrier_complete(unsigned* bar, unsigned x, unsigned& nloc, unsigned& nx) {
    const unsigned G = gridDim.x * gridDim.y * gridDim.z;
    unsigned sum, cnt, mine, sp = 0u;
    for (;;) {
        sum = 0u; cnt = 0u; mine = 0u;
#pragma unroll
        for (unsigned j = 0; j < 16; ++j) { const unsigned c = xb_ld(&bar[XB_XCNT(j)]); sum += c; cnt += (c > 0u) ? 1u : 0u; mine = (j == x) ? c : mine; }
        if (sum == G) break;
        __builtin_amdgcn_s_sleep(1);
        if ((++sp & 255u) == 0u) { if (xb_ld(&bar[XB_TMO])) break; if (sp > XB_SPIN_CAP) { atomicAdd(&bar[XB_TMO], 1u); break; } }
    }
    nloc = mine > 0u ? mine : 1u; nx = cnt > 0u ? cnt : 1u;
}

__device__ __forceinline__ void xcd_barrier(const XcdBarrier& b) {
    asm volatile("s_waitcnt vmcnt(0)" ::: "memory");
    __syncthreads();
    if (threadIdx.x == 0) {
        unsigned* bar = b.bar;
        __builtin_amdgcn_s_waitcnt(0);
        unsigned nloc = b.st[0], nx = b.st[1];
        if (nloc == 0u) { xcd_barrier_complete(bar, b.x, nloc, nx); b.st[0] = nloc; b.st[1] = nx; }
        const unsigned old = xb_add(&bar[XB_XSUB(b.x)], 1u);
        const unsigned gen = old / nloc;
        if (old + 1u == (gen + 1u) * nloc) {
            __builtin_amdgcn_fence(__ATOMIC_RELEASE, "agent");
            asm volatile("s_waitcnt vmcnt(0)" ::: "memory");
            const unsigned og = xb_add(&bar[XB_TOP], 1u);
            const unsigned tg = og / nx;
            if (og + 1u == (tg + 1u) * nx) xb_add(&bar[XB_TOPGEN], 1u);
            else XB_SPIN(xb_ld(&bar[XB_TOPGEN]) == tg, bar);
            __builtin_amdgcn_fence(__ATOMIC_ACQUIRE, "agent");
            xb_add(&bar[XB_XGEN(b.x)], 1u);
            asm volatile("s_waitcnt vmcnt(0)" ::: "memory");
        } else {
            XB_SPIN(xb_ld(&bar[XB_XGEN(b.x)]) == gen, bar);
            __builtin_amdgcn_fence(__ATOMIC_ACQUIRE, "agent");
            asm volatile("s_waitcnt vmcnt(0)" ::: "memory");
        }
    }
    __syncthreads();
}

struct Frame {
    LAS unsigned char* lds;
    volatile LAS unsigned* MISC;
    gu32* ctl;
    int tid, lane, wave, G;
    const float* const* in;
};
struct Args { const float* in[30]; float* out; unsigned char* ws; int ph_lo, ph_hi; };

template <class RowMap>
__device__ __forceinline__ void p0_transpose_item(const float* W, int K, int N, bf16* WT, LAS float* scr, int item, int lane, RowMap rm) {
    const int nblk = N / 32, kb = item / nblk, nb = item % nblk, k0 = 64 * kb, n0 = 32 * nb;
    float wv[32];
#pragma unroll
    for (int i = 0; i < 32; ++i) { const int kk = 2 * i + (lane >> 5); wv[i] = W[(size_t)(k0 + kk) * N + n0 + (lane & 31)]; }
#pragma unroll
    for (int i = 0; i < 32; ++i) { const int kk = 2 * i + (lane >> 5); scr[kk * 33 + (lane & 31)] = wv[i]; }
    LDS_WAIT(); asm volatile("" ::: "memory");
    const int c = lane & 7;
#pragma unroll
    for (int j = 0; j < 4; ++j) { const int n = (lane >> 3) + 8 * j; const LAS float* s = scr + (8 * c) * 33 + n;
        v4u o; o.x = pk2(s[0 * 33], s[1 * 33]); o.y = pk2(s[2 * 33], s[3 * 33]); o.z = pk2(s[4 * 33], s[5 * 33]); o.w = pk2(s[6 * 33], s[7 * 33]);
        *(GAS v4u*)(WT + (size_t)rm(n0 + n) * K + k0 + 8 * c) = o; }
    LDS_WAIT(); asm volatile("" ::: "memory");
}
struct RmId { __device__ __forceinline__ int operator()(int n) const { return n; } };
struct RmGU { int up; __device__ __forceinline__ int operator()(int n) const { return (n >> 7) * 256 + up * 128 + (n & 127); } };

__device__ __forceinline__ void rms_row_to_bf16(const f32x4 (&v)[16], const float* g, bf16* orow, int lane) {
    float s = 0.f;
#pragma unroll
    for (int j = 0; j < 16; ++j) s += (v[j].x * v[j].x + v[j].y * v[j].y) + (v[j].z * v[j].z + v[j].w * v[j].w);
    const float rstd = 1.0f / sqrtf(wave_sum(s) * (1.f / 4096.f) + NORM_EPS);
    const GAS f32x4* gr = (const GAS f32x4*)g + lane; GAS v2u* o8 = (GAS v2u*)orow + lane;
#pragma unroll
    for (int hh = 0; hh < 2; ++hh) { f32x4 gv[8];
#pragma unroll
        for (int j = 0; j < 8; ++j) gv[j] = gr[64 * (8 * hh + j)];
#pragma unroll
        for (int j = 0; j < 8; ++j) { const f32x4 x = v[8 * hh + j]; v2u o; o.x = pk2(x.x * rstd * gv[j].x, x.y * rstd * gv[j].y); o.y = pk2(x.z * rstd * gv[j].z, x.w * rstd * gv[j].w); o8[64 * (8 * hh + j)] = o; } }
}

struct MixPtrs {
    const bf16* proj; bf16* mix;
    const float *state_dn, *cache_conv, *state_rw, *cache_shift;
    const float *conv_w, *a_log, *dt_bias, *dn_norm_w;
    const float *mu, *w0, *w2, *a0, *a2, *g2, *k_k, *k_a, *r_k, *ln_w, *ln_b;
    float* out;
};
__device__ __forceinline__ void dn_seq_item(const MixPtrs& P, LAS unsigned char* lds, int seq, int h, int tid, int lane, int wave) {
    const bool prm = seq < 2;
    const int T = prm ? SEQ : DEC_SEQ, sb = prm ? seq : seq - 2;
    const int m0 = prm ? seq * SEQ : M_PROMPT + sb * DEC_SEQ;
    const float* S0 = prm ? nullptr : P.state_dn + ((size_t)sb * 16 + h) * 16384;
    const float* cbuf = prm ? nullptr : P.cache_conv + (size_t)sb * 3 * 6144;
    float* Sout = P.out + (prm ? O_SDN_P : O_SDN_S) + ((size_t)sb * 16 + h) * 16384;
    float* cout = P.out + (prm ? O_CONV_P : O_CONV_S) + (size_t)sb * 3 * 6144;
    LAS float* qs = (LAS float*)lds; LAS float* ks = qs + 2048; LAS float* vs = ks + 2048; LAS float* zs = vs + 2048; LAS float* os = zs + 2048; LAS float* bet = os + 2048; LAS float* gg = bet + 16;
    float S[32];
    const int e = wave * 16 + (lane >> 2), dq = lane & 3;
#pragma unroll
    for (int j = 0; j < 32; ++j) S[j] = (S0 != nullptr) ? S0[(32 * dq + j) * 128 + e] : 0.f;
    const float Ah = -__expf(P.a_log[h]), dtb = P.dt_bias[h];
    for (int tb = 0; tb < T; tb += 16) {
        for (int i = tid; i < 16 * 384; i += 512) { const int t = i / 384, cc = i - t * 384, sec = cc >> 7, d = cc & 127, col = sec * 2048 + h * 128 + d;
            float acc = 0.f;
#pragma unroll
            for (int j = 0; j < 4; ++j) { const int tt = tb + t - 3 + j; float xv;
                if (tt >= 0) xv = bf2f(P.proj[(size_t)(m0 + tt) * IN_WP + col]); else xv = cbuf ? cbuf[(3 + tt) * 6144 + col] : 0.f;
                acc += xv * P.conv_w[j * 6144 + col]; }
            const float y = acc * sigmoid_f(acc);
            (sec == 0 ? qs : (sec == 1 ? ks : vs))[t * 128 + d] = y; }
        for (int i = tid; i < 16 * 128; i += 512) { const int t = i >> 7, d = i & 127; zs[i] = bf2f(P.proj[(size_t)(m0 + tb + t) * IN_WP + PC_Z + h * 128 + d]); }
        if (tid < 16) { const size_t r = (size_t)(m0 + tb + tid) * IN_WP; const float b = bf2f(P.proj[r + PC_B + h]), a = bf2f(P.proj[r + PC_A + h]);
            bet[tid] = sigmoid_f(b); gg[tid] = Ah * softplus_f(a + dtb); }
        __syncthreads();
#pragma unroll
        for (int r = 0; r < 2; ++r) { const int t = 2 * wave + r;
            const float q0 = qs[t * 128 + lane], q1 = qs[t * 128 + 64 + lane], k0 = ks[t * 128 + lane], k1 = ks[t * 128 + 64 + lane];
            const float sq = wave_sum(q0 * q0 + q1 * q1), sk = wave_sum(k0 * k0 + k1 * k1);
            const float cq = 0.08838834764831845f / sqrtf(sq + 1e-6f), ck = 1.0f / sqrtf(sk + 1e-6f);
            qs[t * 128 + lane] = q0 * cq; qs[t * 128 + 64 + lane] = q1 * cq; ks[t * 128 + lane] = k0 * ck; ks[t * 128 + 64 + lane] = k1 * ck; }
        __syncthreads();
        {
#pragma unroll 1
            for (int t = 0; t < 16; ++t) {
                const float eg = __expf(gg[t]), bt = bet[t];
                float kS = 0.f;
#pragma unroll
                for (int d4 = 0; d4 < 8; ++d4) { const f32x4 kv = *(const LAS f32x4*)(ks + t * 128 + 32 * dq + 4 * d4);
                    kS += kv.x * S[4 * d4] + kv.y * S[4 * d4 + 1] + kv.z * S[4 * d4 + 2] + kv.w * S[4 * d4 + 3]; }
                kS += __shfl_xor(kS, 1); kS += __shfl_xor(kS, 2);
                const float w = bt * (vs[t * 128 + e] - eg * kS);
                float o = 0.f;
#pragma unroll
                for (int d4 = 0; d4 < 8; ++d4) { const f32x4 kv = *(const LAS f32x4*)(ks + t * 128 + 32 * dq + 4 * d4); const f32x4 qv = *(const LAS f32x4*)(qs + t * 128 + 32 * dq + 4 * d4);
                    S[4 * d4] = eg * S[4 * d4] + kv.x * w; S[4 * d4 + 1] = eg * S[4 * d4 + 1] + kv.y * w; S[4 * d4 + 2] = eg * S[4 * d4 + 2] + kv.z * w; S[4 * d4 + 3] = eg * S[4 * d4 + 3] + kv.w * w;
                    o += qv.x * S[4 * d4] + qv.y * S[4 * d4 + 1] + qv.z * S[4 * d4 + 2] + qv.w * S[4 * d4 + 3]; }
                o += __shfl_xor(o, 1); o += __shfl_xor(o, 2);
                if (dq == 0) os[t * 128 + e] = o;
            }
        }
        __syncthreads();
#pragma unroll
        for (int r = 0; r < 2; ++r) { const int t = 2 * wave + r;
            const float o0 = os[t * 128 + lane], o1 = os[t * 128 + 64 + lane];
            const float rs = 1.0f / sqrtf(wave_sum(o0 * o0 + o1 * o1) * (1.f / 128.f) + NORM_EPS);
            const float z0 = zs[t * 128 + lane], z1 = zs[t * 128 + 64 + lane];
            bf16* mp = P.mix + (size_t)(m0 + tb + t) * 4096 + h * 128;
            mp[lane] = (bf16)f2bf(o0 * rs * P.dn_norm_w[lane] * (z0 * sigmoid_f(z0))); mp[64 + lane] = (bf16)f2bf(o1 * rs * P.dn_norm_w[64 + lane] * (z1 * sigmoid_f(z1))); }
        __syncthreads();
    }
    { int so = 32 * dq * 128 + e;
#ifndef NO_LAUNDER
    asm volatile("" : "+v"(so));
#endif

#pragma unroll
    for (int j = 0; j < 32; ++j) Sout[so + j * 128] = S[j]; }
    for (int i = tid; i < 3 * 384; i += 512) { const int r = i / 384, cc = i - r * 384, col = (cc >> 7) * 2048 + h * 128 + (cc & 127);
        cout[r * 6144 + col] = bf2f(P.proj[(size_t)(m0 + T - 3 + r) * IN_WP + col]); }
}
__device__ __forceinline__ void rw_seq_item(const MixPtrs& P, const bf16* w2T_, const bf16* a2T_, const bf16* g2T_, LAS unsigned char* lds, int seq, int h, int tid, int lane, int wave) {
    const bool prm = seq < 2;
    const int T = prm ? SEQ : DEC_SEQ, sb = prm ? seq : seq - 2;
    const int m0 = prm ? seq * SEQ : M_PROMPT + sb * DEC_SEQ;
    const float* S0 = prm ? nullptr : P.state_rw + ((size_t)sb * 32 + h) * 4096;
    const float* sbuf = prm ? nullptr : P.cache_shift + (size_t)sb * RW_SHIFT_W;
    float* Sout = P.out + (prm ? O_SRW_P : O_SRW_S) + ((size_t)sb * 32 + h) * 4096;
    float* shout = P.out + (prm ? O_SHIFT_P : O_SHIFT_S) + (size_t)sb * RW_SHIFT_W;
    LAS float* rs = (LAS float*)lds; LAS float* kr = rs + 1024; LAS float* vs = kr + 1024; LAS float* xw = vs + 1024; LAS float* xa = xw + 1536; LAS float* xg = xa + 1536;
    LAS float* wd = xg + 4096; LAS float* kp = wd + 1024; LAS float* av = kp + 1024; LAS float* bv = av + 1024; LAS float* gt = bv + 1024; LAS float* ys = gt + 1024; LAS float* sbn = ys + 1024;
    float S[16];
    const int vr = (wave & 3) * 16 + (lane >> 2), kq = lane & 3;
#pragma unroll
    for (int k4 = 0; k4 < 4; ++k4) { f32x4 v = (f32x4){0.f, 0.f, 0.f, 0.f}; if (S0 != nullptr) v = *(const f32x4*)(S0 + vr * 64 + 16 * kq + 4 * k4);
        S[4 * k4] = v.x; S[4 * k4 + 1] = v.y; S[4 * k4 + 2] = v.z; S[4 * k4 + 3] = v.w; }
    const int hc = h * 64 + lane;
    const float w0c = P.w0[hc], a0c = P.a0[hc], kkc = P.k_k[hc], kac = P.k_a[hc], rkc = P.r_k[hc], lnw = P.ln_w[hc], lnb = P.ln_b[hc];
    for (int tb = 0; tb < T; tb += 16) {
        for (int i = tid; i < 16 * 640; i += 512) { const int t = i / 640, cc = i - t * 640; int col; LAS float* dst; int kind = 0;
            if (cc < 64) { col = RW_R + h * 64 + cc; dst = rs + t * 64 + cc; }
            else if (cc < 128) { col = RW_K + h * 64 + (cc - 64); dst = kr + t * 64 + (cc - 64); }
            else if (cc < 192) { col = RW_V + h * 64 + (cc - 128); dst = vs + t * 64 + (cc - 128); }
            else if (cc < 288) { col = RW_XW + (cc - 192); dst = xw + t * 96 + (cc - 192); kind = 1; }
            else if (cc < 384) { col = RW_XA + (cc - 288); dst = xa + t * 96 + (cc - 288); }
            else { col = RW_XG + (cc - 384); dst = xg + t * 256 + (cc - 384); kind = 2; }
            const int tt = tb + t; const float u = bf2f(P.proj[(size_t)(m0 + tt) * IN_WP + PC_RW + col]);
            const float up = tt > 0 ? bf2f(P.proj[(size_t)(m0 + tt - 1) * IN_WP + PC_RW + col]) : (sbuf ? sbuf[col] : 0.f);
            float v = u + P.mu[col] * (up - u);
            if (kind == 1) v = tanhf(v); else if (kind == 2) v = sigmoid_f(v);
            *dst = v; }
        __syncthreads();
        {
            float wl0 = 0.f, wl1 = 0.f, al0 = 0.f, al1 = 0.f, gl0 = 0.f, gl1 = 0.f; const int t0 = wave, t1 = wave + 8;
#ifdef OLD_SEQ
#pragma unroll 4
            for (int j = 0; j < 96; ++j) { const float w2v = P.w2[j * 2048 + hc], a2v = P.a2[j * 2048 + hc];
                wl0 += xw[t0 * 96 + j] * w2v; wl1 += xw[t1 * 96 + j] * w2v; al0 += xa[t0 * 96 + j] * a2v; al1 += xa[t1 * 96 + j] * a2v; }
#pragma unroll 4
            for (int j = 0; j < 256; ++j) { const float g2v = P.g2[j * 2048 + hc]; gl0 += xg[t0 * 256 + j] * g2v; gl1 += xg[t1 * 256 + j] * g2v; }
#else
#define SEQ_DOT8(W8, X0, X1, A0, A1) do { const v4u _w = (W8); const LAS float* _x0 = (X0); const LAS float* _x1 = (X1); \
                const f32x4 _p0 = *(const LAS f32x4*)_x0, _p1 = *(const LAS f32x4*)(_x0 + 4), _q0 = *(const LAS f32x4*)_x1, _q1 = *(const LAS f32x4*)(_x1 + 4); \
                const float _w0 = bflo(_w.x), _w1 = bfhi(_w.x), _w2 = bflo(_w.y), _w3 = bfhi(_w.y), _w4 = bflo(_w.z), _w5 = bfhi(_w.z), _w6 = bflo(_w.w), _w7 = bfhi(_w.w); \
                A0 += (_p0.x * _w0 + _p0.y * _w1) + (_p0.z * _w2 + _p0.w * _w3) + (_p1.x * _w4 + _p1.y * _w5) + (_p1.z * _w6 + _p1.w * _w7); \
                A1 += (_q0.x * _w0 + _q0.y * _w1) + (_q0.z * _w2 + _q0.w * _w3) + (_q1.x * _w4 + _q1.y * _w5) + (_q1.z * _w6 + _q1.w * _w7); } while (0)
#pragma unroll 1
            for (int cch = 0; cch < 3; ++cch) { v4u wv[4], av2[4];
#pragma unroll
                for (int p = 0; p < 4; ++p) { wv[p] = *(const GAS v4u*)(w2T_ + (size_t)hc * 96 + 32 * cch + 8 * p); av2[p] = *(const GAS v4u*)(a2T_ + (size_t)hc * 96 + 32 * cch + 8 * p); }
#pragma unroll
                for (int p = 0; p < 4; ++p) { const int j = 32 * cch + 8 * p; SEQ_DOT8(wv[p], xw + t0 * 96 + j, xw + t1 * 96 + j, wl0, wl1); SEQ_DOT8(av2[p], xa + t0 * 96 + j, xa + t1 * 96 + j, al0, al1); } }
#pragma unroll 1
            for (int cch = 0; cch < 8; ++cch) { v4u gv[4];
#pragma unroll
                for (int p = 0; p < 4; ++p) gv[p] = *(const GAS v4u*)(g2T_ + (size_t)hc * 256 + 32 * cch + 8 * p);
#pragma unroll
                for (int p = 0; p < 4; ++p) { const int j = 32 * cch + 8 * p; SEQ_DOT8(gv[p], xg + t0 * 256 + j, xg + t1 * 256 + j, gl0, gl1); } }
#undef SEQ_DOT8
#endif
#pragma unroll
            for (int r = 0; r < 2; ++r) { const int t = r ? t1 : t0; const float wl = r ? wl1 : wl0, al = r ? al1 : al0, gl = r ? gl1 : gl0;
                const float wlog = -softplus_f(-(w0c + wl)) - 0.5f; const float wdec = __expf(-__expf(wlog));
                const float a = sigmoid_f(a0c + al);
                const float krv = kr[t * 64 + lane], kkr = krv * kkc; const float kk = kkr / sqrtf(wave_sum(kkr * kkr) + 1e-6f);
                const float kpv = krv * (1.0f + (a - 1.0f) * kac);
                const float sbv = wave_sum(rs[t * 64 + lane] * kpv * rkc);
                wd[t * 64 + lane] = wdec; kp[t * 64 + lane] = kpv; av[t * 64 + lane] = -kk; bv[t * 64 + lane] = kk * a; gt[t * 64 + lane] = gl; if (lane == 0) sbn[t] = sbv; }
        }
        __syncthreads();
        if (wave < 4) {
#pragma unroll 1
            for (int t = 0; t < 16; ++t) {
                float sa = 0.f;
#pragma unroll
                for (int k4 = 0; k4 < 4; ++k4) { const f32x4 a4 = *(const LAS f32x4*)(av + t * 64 + 16 * kq + 4 * k4); sa += a4.x * S[4 * k4] + a4.y * S[4 * k4 + 1] + a4.z * S[4 * k4 + 2] + a4.w * S[4 * k4 + 3]; }
                sa += __shfl_xor(sa, 1); sa += __shfl_xor(sa, 2);
                const float vv = vs[t * 64 + vr]; float y = 0.f;
#pragma unroll
                for (int k4 = 0; k4 < 4; ++k4) { const int o4 = t * 64 + 16 * kq + 4 * k4;
                    const f32x4 w4 = *(const LAS f32x4*)(wd + o4), b4 = *(const LAS f32x4*)(bv + o4), k4v = *(const LAS f32x4*)(kp + o4), r4 = *(const LAS f32x4*)(rs + o4);
                    S[4 * k4] = S[4 * k4] * w4.x + sa * b4.x + vv * k4v.x; S[4 * k4 + 1] = S[4 * k4 + 1] * w4.y + sa * b4.y + vv * k4v.y;
                    S[4 * k4 + 2] = S[4 * k4 + 2] * w4.z + sa * b4.z + vv * k4v.z; S[4 * k4 + 3] = S[4 * k4 + 3] * w4.w + sa * b4.w + vv * k4v.w;
                    y += r4.x * S[4 * k4] + r4.y * S[4 * k4 + 1] + r4.z * S[4 * k4 + 2] + r4.w * S[4 * k4 + 3]; }
                y += __shfl_xor(y, 1); y += __shfl_xor(y, 2);
                if (kq == 0) ys[t * 64 + vr] = y;
            }
        }
        __syncthreads();
#pragma unroll
        for (int r = 0; r < 2; ++r) { const int t = wave + 8 * r; const float y = ys[t * 64 + lane];
            const float mean = wave_sum(y) * (1.f / 64.f); const float dy = y - mean; const float var = wave_sum(dy * dy) * (1.f / 64.f);
            const float yn = dy / sqrtf(var + RW_GN_EPS) * lnw + lnb;
            P.mix[(size_t)(m0 + tb + t) * 4096 + 2048 + hc] = (bf16)f2bf((yn + sbn[t] * vs[t * 64 + lane]) * gt[t * 64 + lane]); }
        __syncthreads();
    }
    if (wave < 4) { int so = vr * 64 + 16 * kq;
#ifndef NO_LAUNDER
    asm volatile("" : "+v"(so));
#endif
#pragma unroll
        for (int k4 = 0; k4 < 4; ++k4) *(f32x4*)(Sout + so + 4 * k4) = (f32x4){S[4 * k4], S[4 * k4 + 1], S[4 * k4 + 2], S[4 * k4 + 3]};
    }
    for (int i = tid; i < 206; i += 512) { const int col = h * 206 + i; shout[col] = bf2f(P.proj[(size_t)(m0 + T - 1) * IN_WP + PC_RW + col]); }
}

typedef short bf16x8 __attribute__((ext_vector_type(8)));
typedef float f32x16 __attribute__((ext_vector_type(16)));
typedef __bf16 bf16x2_t __attribute__((ext_vector_type(2)));
typedef float f32x2_t __attribute__((ext_vector_type(2)));
__device__ __forceinline__ unsigned cvt2(float lo, float hi) { f32x2_t v = {lo, hi}; return __builtin_bit_cast(unsigned, __builtin_convertvector(v, bf16x2_t)); }
#define MFMA16(a, b, c) __builtin_amdgcn_mfma_f32_16x16x32_bf16((a), (b), (c), 0, 0, 0)
#define MFMA32(a, b, c) __builtin_amdgcn_mfma_f32_32x32x16_bf16((a), (b), (c), 0, 0, 0)
__device__ __forceinline__ bf16x8 pack_step(const f32x16& x, int s) {
    v4u p; p.x = cvt2(x[8 * s], x[8 * s + 1]); p.y = cvt2(x[8 * s + 2], x[8 * s + 3]); p.z = cvt2(x[8 * s + 4], x[8 * s + 5]); p.w = cvt2(x[8 * s + 6], x[8 * s + 7]);
    return __builtin_bit_cast(bf16x8, p);
}
struct DnRec { unsigned char* rec; unsigned char* qk; float* gl; };
constexpr int DP_CW = 132096;
constexpr int DP_QN = 0, DP_KN = 17408, DP_VBT = 34816, DP_KBGT = 53248, DP_LM = 71680, DP_TM = 88320, DP_TB = 104960, DP_DINV = 114176, DP_YB = 118528, DP_SC = 122688;

__device__ __forceinline__ bf16x8 tv_pack4(const f32x4 a) { v4u p; p.x = cvt2(a[0], a[1]); p.y = cvt2(a[2], a[3]); p.z = 0u; p.w = 0u; return __builtin_bit_cast(bf16x8, p); }
__device__ __forceinline__ bf16x8 tv_pack8(const f32x4 a, const f32x4 b) { v4u p; p.x = cvt2(a[0], a[1]); p.y = cvt2(a[2], a[3]); p.z = cvt2(b[0], b[1]); p.w = cvt2(b[2], b[3]); return __builtin_bit_cast(bf16x8, p); }
__device__ __forceinline__ f32x4 tv_blk(const LAS float* Lm, int I, int J, int l15, int q) { f32x4 v; _Pragma("unroll") for (int r = 0; r < 4; ++r) v[r] = Lm[(16 * I + 4 * q + r) * 65 + 16 * J + l15]; return v; }
__device__ __forceinline__ f32x4 tv_blkT(const LAS float* Lm, int I, int J, int l15, int q) { f32x4 v; _Pragma("unroll") for (int r = 0; r < 4; ++r) v[r] = Lm[(16 * I + l15) * 65 + 16 * J + 4 * q + r]; return v; }
__device__ __forceinline__ void tv_put(LAS bf16* Tb, int I, int J, const f32x4 vT, float sgn, int l15, int q) {
    v2u o; o.x = cvt2(sgn * vT[0], sgn * vT[1]); o.y = cvt2(sgn * vT[2], sgn * vT[3]); *(LAS v2u*)(Tb + (16 * I + l15) * 72 + 16 * J + 4 * q) = o; }
template <bool BAR = true>
__device__ __forceinline__ void tri_inv64_mfma(const LAS float* Lm, LAS bf16* Tb, int lane, int wave) {
    if (wave == 0) {
        int ln = lane; asm volatile("" : "+v"(ln));
        const int l15 = ln & 15, q = ln >> 4; const f32x4 z4 = (f32x4){0.f, 0.f, 0.f, 0.f};
        f32x4 D[4], Dt[4];
#pragma unroll
        for (int i = 0; i < 4; ++i) {
            const f32x4 N = tv_blk(Lm, i, i, l15, q), Nt = tv_blkT(Lm, i, i, l15, q);
            f32x4 P, Pt;
#pragma unroll
            for (int r = 0; r < 4; ++r) { const float e = (4 * q + r == l15) ? 1.f : 0.f; P[r] = e - N[r]; Pt[r] = e - Nt[r]; }
            bf16x8 x = tv_pack4(N), xt = tv_pack4(Nt);
#pragma unroll
            for (int lv = 0; lv < 3; ++lv) {
                const f32x4 X = MFMA16(xt, x, z4), Xt = MFMA16(x, xt, z4);
                x = tv_pack4(X); xt = tv_pack4(Xt);
                const bf16x8 p = tv_pack4(P);
                P = MFMA16(xt, p, P); Pt = MFMA16(p, xt, Pt);
            }
            D[i] = P; Dt[i] = Pt;
        }
        const f32x4 Y1 = MFMA16(tv_pack4(tv_blkT(Lm, 1, 0, l15, q)), tv_pack4(D[0]), z4), Y3 = MFMA16(tv_pack4(tv_blkT(Lm, 3, 2, l15, q)), tv_pack4(D[2]), z4);
        const bf16x8 y1 = tv_pack4(Y1), y3 = tv_pack4(Y3), d1t = tv_pack4(Dt[1]), d3t = tv_pack4(Dt[3]);
        f32x4 T10 = MFMA16(d1t, y1, z4); const f32x4 T10t = MFMA16(y1, d1t, z4), T32t = MFMA16(y3, d3t, z4);
#pragma unroll
        for (int r = 0; r < 4; ++r) T10[r] = -T10[r];
        const f32x4 M20 = tv_blkT(Lm, 2, 0, l15, q), M21 = tv_blkT(Lm, 2, 1, l15, q), M30 = tv_blkT(Lm, 3, 0, l15, q), M31 = tv_blkT(Lm, 3, 1, l15, q);
        const bf16x8 ta0 = tv_pack8(D[0], T10), d1 = tv_pack4(D[1]);
        const f32x4 Y20 = MFMA16(tv_pack8(M20, M21), ta0, z4), Y30 = MFMA16(tv_pack8(M30, M31), ta0, z4), Y21 = MFMA16(tv_pack4(M21), d1, z4), Y31 = MFMA16(tv_pack4(M31), d1, z4);
        f32x4 nT32t;
#pragma unroll
        for (int r = 0; r < 4; ++r) nT32t[r] = -T32t[r];
        const bf16x8 d2t = tv_pack4(Dt[2]), tb3 = tv_pack8(nT32t, Dt[3]);
        const f32x4 B20t = MFMA16(tv_pack4(Y20), d2t, z4), B21t = MFMA16(tv_pack4(Y21), d2t, z4), B30t = MFMA16(tv_pack8(Y20, Y30), tb3, z4), B31t = MFMA16(tv_pack8(Y21, Y31), tb3, z4);
#pragma unroll
        for (int i = 0; i < 4; ++i) {
            tv_put(Tb, i, i, Dt[i], 1.f, l15, q);
#pragma unroll
            for (int j = i + 1; j < 4; ++j) tv_put(Tb, i, j, z4, 1.f, l15, q);
        }
        tv_put(Tb, 1, 0, T10t, -1.f, l15, q); tv_put(Tb, 3, 2, T32t, -1.f, l15, q);
        tv_put(Tb, 2, 0, B20t, -1.f, l15, q); tv_put(Tb, 2, 1, B21t, -1.f, l15, q); tv_put(Tb, 3, 0, B30t, -1.f, l15, q); tv_put(Tb, 3, 1, B31t, -1.f, l15, q);
    }
    if constexpr (BAR) __syncthreads();
}

__device__ __forceinline__ void tri_inv64(const LAS float* Lm, LAS float* Tm, LAS bf16* Tb, LAS float* Dinv, LAS float* Yb, int tid, int lane, int wave) {
    if (tid < 64) { const int bi = tid >> 4, j = tid & 15; float x[16];
#pragma unroll
        for (int r = 0; r < 16; ++r) { float a = (r == j) ? 1.f : 0.f;
#pragma unroll
            for (int k = 0; k < r; ++k) a -= Lm[(16 * bi + r) * 65 + 16 * bi + k] * x[k];
            x[r] = a; }
#pragma unroll
        for (int r = 0; r < 16; ++r) Dinv[(bi * 16 + r) * 17 + j] = x[r]; }
    __syncthreads();
    for (int o = tid; o < 4096; o += 512) { const int r = o >> 6, c = o & 63, bi = r >> 4;
        if (c >= 16 * bi) { const float a = (c < 16 * bi + 16) ? Dinv[r * 17 + c - 16 * bi] : 0.f; Tm[r * 65 + c] = a; Tb[r * 72 + c] = (bf16)(cvt2(a, 0.f) & 0xffffu); } }
    __syncthreads();
    const int l15 = lane & 15, q = lane >> 4;
#pragma unroll 1
    for (int i = 1; i < 4; ++i) {
        if (wave < i) { f32x4 acc = (f32x4){0.f, 0.f, 0.f, 0.f};
            for (int ks = 0; ks < 4 * i; ++ks) acc = __builtin_amdgcn_mfma_f32_16x16x4f32(Lm[(16 * i + l15) * 65 + 4 * ks + q], Tm[(4 * ks + q) * 65 + 16 * wave + l15], acc, 0, 0, 0);
#pragma unroll
            for (int reg = 0; reg < 4; ++reg) Yb[(4 * q + reg) * 65 + 16 * wave + l15] = -acc[reg]; }
        __syncthreads();
        if (wave < i) { f32x4 acc = (f32x4){0.f, 0.f, 0.f, 0.f};
#pragma unroll
            for (int ks = 0; ks < 4; ++ks) acc = __builtin_amdgcn_mfma_f32_16x16x4f32(Dinv[(16 * i + l15) * 17 + 4 * ks + q], Yb[(4 * ks + q) * 65 + 16 * wave + l15], acc, 0, 0, 0);
#pragma unroll
            for (int reg = 0; reg < 4; ++reg) { Tm[(16 * i + 4 * q + reg) * 65 + 16 * wave + l15] = acc[reg]; Tb[(16 * i + 4 * q + reg) * 72 + 16 * wave + l15] = (bf16)(cvt2(acc[reg], 0.f) & 0xffffu); } }
        __syncthreads();
    }
}

__device__ __forceinline__ void dn_stage_conv(const MixPtrs& P, LAS unsigned char* lds, int h, int tid) {
    LAS float* cw = (LAS float*)(lds + DP_CW);
    for (int i = tid; i < 1536; i += 512) { const int sec = i >> 9, j = (i >> 7) & 3, cc = i & 127; cw[i] = P.conv_w[j * 6144 + sec * 2048 + h * 128 + cc]; }
    __syncthreads();
}
#ifdef TRI_OLD
#define TRI_INV() tri_inv64(Lm, Tm, Tb, Dinv, Yb, tid, lane, wave)
#else
#define TRI_INV() tri_inv64_mfma<true>(Lm, Tb, lane, wave)
#endif
__device__ __forceinline__ void dn_prep_item(const MixPtrs& P, const DnRec& R, LAS unsigned char* lds, int b, int c, int h, int tid, int lane, int wave) {
    const int m0 = b * SEQ + 64 * c; const int item = (b * 128 + c) * 16 + h;
    LAS bf16* Qn = (LAS bf16*)(lds + DP_QN); LAS bf16* Kn = (LAS bf16*)(lds + DP_KN); LAS bf16* VbT = (LAS bf16*)(lds + DP_VBT); LAS bf16* KbgT = (LAS bf16*)(lds + DP_KBGT);
    LAS float* Lm = (LAS float*)(lds + DP_LM); LAS float* Tm = (LAS float*)(lds + DP_TM); LAS bf16* Tb = (LAS bf16*)(lds + DP_TB); LAS float* Dinv = (LAS float*)(lds + DP_DINV); LAS float* Yb = (LAS float*)(lds + DP_YB);
    LAS float* sc = (LAS float*)(lds + DP_SC); LAS float* beta = sc; LAS float* gc = sc + 64; LAS float* egc = sc + 128; LAS float* ekd = sc + 192;
    unsigned char* rec = R.rec + (size_t)item * 65536; unsigned char* qkr = R.qk + (size_t)item * 8192;
    const LAS float* cw = (const LAS float*)(lds + DP_CW);
    bf16 ub0 = 0, ua0 = 0;
    if (wave == 0) { const size_t r = (size_t)(m0 + lane) * IN_WP; ub0 = P.proj[r + PC_B + h]; ua0 = P.proj[r + PC_A + h]; }
    const int g8 = tid & 15, tq = tid >> 4;
    v4u xv[6][4];
#pragma unroll
    for (int r = 0; r < 6; ++r) { const int t = tq + 32 * (r & 1); const int col = (r >> 1) * 2048 + h * 128 + 8 * g8;
#pragma unroll
        for (int j = 0; j < 4; ++j) { int tt = 64 * c + t - 3 + j; tt = tt < 0 ? 0 : tt; xv[r][j] = *(const GAS v4u*)(P.proj + (size_t)(b * SEQ + tt) * IN_WP + col); } }
    if (wave == 0) { const int t = lane; const float bb = bf2f(ub0), aa = bf2f(ua0);
        const float Ah = -__expf(P.a_log[h]), dtb = P.dt_bias[h];
        float x = Ah * softplus_f(aa + dtb);
#pragma unroll
        for (int o = 1; o < 64; o <<= 1) { const float v = __shfl_up(x, o); if (lane >= o) x += v; }
        const float gl = __shfl(x, 63);
        beta[t] = sigmoid_f(bb); gc[t] = x; egc[t] = __expf(x); ekd[t] = __expf(gl - x); if (lane == 0) R.gl[item] = __expf(gl); }
    __syncthreads();
#pragma unroll
    for (int r = 0; r < 6; ++r) {
        const int sec = r >> 1; const int t = tq + 32 * (r & 1);
        float acc[8];
#pragma unroll
        for (int i = 0; i < 8; ++i) acc[i] = 0.f;
#pragma unroll
        for (int j = 0; j < 4; ++j) {
            v4u x4 = xv[r][j]; if (64 * c + t - 3 + j < 0) x4 = (v4u){0u, 0u, 0u, 0u};
            const f32x4 w0 = *(const LAS f32x4*)(cw + (sec * 4 + j) * 128 + 8 * g8), w1 = *(const LAS f32x4*)(cw + (sec * 4 + j) * 128 + 8 * g8 + 4);
            acc[0] += bflo(x4.x) * w0.x; acc[1] += bfhi(x4.x) * w0.y; acc[2] += bflo(x4.y) * w0.z; acc[3] += bfhi(x4.y) * w0.w;
            acc[4] += bflo(x4.z) * w1.x; acc[5] += bfhi(x4.z) * w1.y; acc[6] += bflo(x4.w) * w1.z; acc[7] += bfhi(x4.w) * w1.w; }
        float y[8]; float ss = 0.f;
#pragma unroll
        for (int i = 0; i < 8; ++i) { y[i] = acc[i] * sigmoid_f(acc[i]); ss += y[i] * y[i]; }
        if (sec < 2) { ss += __shfl_xor(ss, 1); ss += __shfl_xor(ss, 2); ss += __shfl_xor(ss, 4); ss += __shfl_xor(ss, 8);
            const float scl = (sec == 0 ? 0.08838834764831845f : 1.0f) * __builtin_amdgcn_rsqf(ss + 1e-6f);
#pragma unroll
            for (int i = 0; i < 8; ++i) y[i] *= scl; }
        if (sec == 0) { v4u o; o.x = cvt2(y[0], y[1]); o.y = cvt2(y[2], y[3]); o.z = cvt2(y[4], y[5]); o.w = cvt2(y[6], y[7]); *(LAS v4u*)(Qn + t * 136 + 8 * g8) = o; }
        else if (sec == 1) { v4u o; o.x = cvt2(y[0], y[1]); o.y = cvt2(y[2], y[3]); o.z = cvt2(y[4], y[5]); o.w = cvt2(y[6], y[7]); *(LAS v4u*)(Kn + t * 136 + 8 * g8) = o;
            const float f = beta[t] * egc[t];
#pragma unroll
            for (int i = 0; i < 8; ++i) KbgT[(8 * g8 + i) * 72 + 8 * (((t >> 3) ^ (g8 >> 1)) & 7) + (t & 7)] = (bf16)(cvt2(y[i] * f, 0.f) & 0xffffu); }
        else { const float f = beta[t];
#pragma unroll
            for (int i = 0; i < 8; ++i) VbT[(8 * g8 + i) * 72 + 8 * (((t >> 3) ^ (g8 >> 1)) & 7) + (t & 7)] = (bf16)(cvt2(y[i] * f, 0.f) & 0xffffu); }
    }
    GAS v4u* zp = (GAS v4u*)(P.proj + (size_t)(m0 + (tid >> 3)) * IN_WP + PC_Z + h * 128 + 16 * (tid & 7));
    const v4u zv0 = zp[0], zv1 = zp[1];
    __syncthreads();
#ifdef PD2
    for (int _pr = 0; _pr < 2; ++_pr) {
#else
    {
#endif
    {   const int tt = wave & 3, sp = wave >> 2, l15 = lane & 15, q = lane >> 4;
#pragma unroll
        for (int si = 0; si < 2; ++si) { const int st = 2 * sp + si;
            f32x4 aL = (f32x4){0.f, 0.f, 0.f, 0.f}, aQ = (f32x4){0.f, 0.f, 0.f, 0.f};
#pragma unroll
            for (int ks = 0; ks < 4; ++ks) {
                const bf16x8 fs = *(const LAS bf16x8*)(Kn + (16 * st + l15) * 136 + 32 * ks + 8 * q);
                const bf16x8 ft = *(const LAS bf16x8*)(Kn + (16 * tt + l15) * 136 + 32 * ks + 8 * q);
                const bf16x8 fq = *(const LAS bf16x8*)(Qn + (16 * tt + l15) * 136 + 32 * ks + 8 * q);
                aL = MFMA16(fs, ft, aL); aQ = MFMA16(fs, fq, aQ); }
            const int t = 16 * tt + l15; const float gct = gc[t], bt = beta[t]; float qv[4];
#pragma unroll
            for (int reg = 0; reg < 4; ++reg) { const int s = 16 * st + 4 * q + reg; const float dec = __expf(gct - gc[s]);
                Lm[t * 65 + s] = (t > s) ? bt * aL[reg] * dec : 0.f; qv[reg] = (t >= s) ? aQ[reg] * dec : 0.f; }
            v2u qkp; qkp.x = cvt2(qv[0], qv[1]); qkp.y = cvt2(qv[2], qv[3]);
            *(GAS v2u*)(qkr + ((((t >> 5) * 4 + st) * 64 + (t & 31) + 32 * (q & 1)) * 16 + 8 * (q >> 1))) = qkp;
        }
    }
#pragma unroll
    for (int r = 0; r < 2; ++r) { const int fl = tid + 512 * r; const int ln = fl & 63, ks = (fl >> 6) & 7, mt = fl >> 9;
        const int t = 32 * mt + (ln & 31), d0 = 16 * ks + 4 * (ln >> 5); const float f = egc[t];
        const v2u a = *(const LAS v2u*)(Qn + t * 136 + d0), bq = *(const LAS v2u*)(Qn + t * 136 + d0 + 8);
        v4u o; o.x = cvt2(bflo(a.x) * f, bfhi(a.x) * f); o.y = cvt2(bflo(a.y) * f, bfhi(a.y) * f); o.z = cvt2(bflo(bq.x) * f, bfhi(bq.x) * f); o.w = cvt2(bflo(bq.y) * f, bfhi(bq.y) * f);
        *(GAS v4u*)(rec + 16384 + fl * 16) = o; }
#pragma unroll
    for (int r = 0; r < 2; ++r) { const int fl = tid + 512 * r; const int ln = fl & 63, kt = (fl >> 6) & 3, mtd = fl >> 8;
        const int d = 32 * mtd + (ln & 31), t0 = 16 * kt + 4 * (ln >> 5); float v[8];
#pragma unroll
        for (int j = 0; j < 8; ++j) { const int t = t0 + 8 * (j >> 2) + (j & 3); v[j] = bf2f(Kn[t * 136 + d]) * ekd[t]; }
        v4u o; o.x = cvt2(v[0], v[1]); o.y = cvt2(v[2], v[3]); o.z = cvt2(v[4], v[5]); o.w = cvt2(v[6], v[7]);
        *(GAS v4u*)(rec + 32768 + fl * 16) = o; }
    __syncthreads();
    }
    TRI_INV();
#ifdef PD4
    for (int _pr = 0; _pr < 2; ++_pr)
#endif
    {   const int tt = wave & 3, hf = wave >> 2, l15 = lane & 15, q = lane >> 4;
        bf16x8 tf[2];
#pragma unroll
        for (int ks = 0; ks < 2; ++ks) tf[ks] = *(const LAS bf16x8*)(Tb + (16 * tt + l15) * 72 + 32 * ks + 8 * q);
#pragma unroll
        for (int n = 0; n < 4; ++n) { const int et = 4 * hf + n;
            f32x4 au = (f32x4){0.f, 0.f, 0.f, 0.f}, aw = (f32x4){0.f, 0.f, 0.f, 0.f};
#pragma unroll
            for (int ks = 0; ks < 2; ++ks) { const bf16x8 fv = *(const LAS bf16x8*)(VbT + (16 * et + l15) * 72 + 8 * ((4 * ks + q) ^ (et & 7))); const bf16x8 fk = *(const LAS bf16x8*)(KbgT + (16 * et + l15) * 72 + 8 * ((4 * ks + q) ^ (et & 7)));
                au = MFMA16(tf[ks], fv, au);
                aw = MFMA16(fk, tf[ks], aw); }
            v2u up; up.x = cvt2(au[0], au[1]); up.y = cvt2(au[2], au[3]);
            *(GAS v2u*)(rec + 49152 + ((16 * et + l15) * 64 + 16 * tt + 4 * q) * 2) = up;
            const int t = 16 * tt + l15; v2u wp; wp.x = cvt2(aw[0], aw[1]); wp.y = cvt2(aw[2], aw[3]);
            *(GAS v2u*)(rec + ((((t >> 5) * 8 + et) * 64 + (t & 31) + 32 * (q & 1)) * 16 + 8 * (q >> 1))) = wp; }
    }
    {   v4u o0, o1;
#define DN_SILU2(u) cvt2(bflo(u) * sigmoid_f(bflo(u)), bfhi(u) * sigmoid_f(bfhi(u)))
        o0.x = DN_SILU2(zv0.x); o0.y = DN_SILU2(zv0.y); o0.z = DN_SILU2(zv0.z); o0.w = DN_SILU2(zv0.w); o1.x = DN_SILU2(zv1.x); o1.y = DN_SILU2(zv1.y); o1.z = DN_SILU2(zv1.z); o1.w = DN_SILU2(zv1.w);
#undef DN_SILU2
        zp[0] = o0; zp[1] = o1; }
    __syncthreads();
}

#define WG_BAR_LDS() do { asm volatile("s_waitcnt lgkmcnt(0)" ::: "memory"); __builtin_amdgcn_s_barrier(); asm volatile("" ::: "memory"); } while (0)
__device__ __forceinline__ void dn_scan(const MixPtrs& P, const DnRec& R, LAS unsigned char* lds, int b, int h, int tid, int lane, int wave) {
    constexpr int SB = 57344; LAS unsigned char* obuf0 = lds + 2 * SB; LAS unsigned char* obuf1 = lds + 132096;
    const int item0 = b * 128 * 16 + h;
    if (wave < 4) {
        const int e = 32 * wave + (lane & 31), hh = lane >> 5;
        f32x16 S[4];
#pragma unroll
        for (int dt = 0; dt < 4; ++dt)
#pragma unroll
            for (int i = 0; i < 16; ++i) S[dt][i] = 0.f;
        v2u uu[2][4];
#pragma unroll
        for (int mt = 0; mt < 2; ++mt)
#pragma unroll
            for (int g = 0; g < 4; ++g) uu[mt][g] = *(const GAS v2u*)(R.rec + (size_t)item0 * 65536 + 49152 + (e * 64 + 32 * mt + 8 * g + 4 * hh) * 2);
        float egl = R.gl[item0];
        WG_BAR_LDS();
#pragma unroll 1
        for (int c = 0; c < 128; ++c) {
            LAS unsigned char* buf = lds + (c & 1) * SB;
            f32x16 o0, o1;
            bf16x8 Sf[8];
#pragma unroll
            for (int dt = 0; dt < 4; ++dt) { Sf[2 * dt] = pack_step(S[dt], 0); Sf[2 * dt + 1] = pack_step(S[dt], 1); }
            f32x16 w0, w1;
#pragma unroll
            for (int i = 0; i < 16; ++i) { w0[i] = 0.f; w1[i] = 0.f; o0[i] = 0.f; o1[i] = 0.f; }
#pragma unroll
            for (int ks = 0; ks < 8; ++ks) { const bf16x8 a0 = *(const LAS bf16x8*)(buf + (ks * 64 + lane) * 16), a1 = *(const LAS bf16x8*)(buf + ((8 + ks) * 64 + lane) * 16);
                w0 = MFMA32(a0, Sf[ks], w0); w1 = MFMA32(a1, Sf[ks], w1); }
#pragma unroll
            for (int g = 0; g < 4; ++g) {
                w0[4 * g] = bflo(uu[0][g].x) - w0[4 * g]; w0[4 * g + 1] = bfhi(uu[0][g].x) - w0[4 * g + 1]; w0[4 * g + 2] = bflo(uu[0][g].y) - w0[4 * g + 2]; w0[4 * g + 3] = bfhi(uu[0][g].y) - w0[4 * g + 3];
                w1[4 * g] = bflo(uu[1][g].x) - w1[4 * g]; w1[4 * g + 1] = bfhi(uu[1][g].x) - w1[4 * g + 1]; w1[4 * g + 2] = bflo(uu[1][g].y) - w1[4 * g + 2]; w1[4 * g + 3] = bfhi(uu[1][g].y) - w1[4 * g + 3]; }
            const float eg_cur = egl;
            if (c + 1 < 128) {
                const unsigned char* recn = R.rec + (size_t)(item0 + 16 * (c + 1)) * 65536;
#pragma unroll
                for (int mt = 0; mt < 2; ++mt)
#pragma unroll
                    for (int g = 0; g < 4; ++g) uu[mt][g] = *(const GAS v2u*)(recn + 49152 + (e * 64 + 32 * mt + 8 * g + 4 * hh) * 2);
                egl = R.gl[item0 + 16 * (c + 1)];
            }
            bf16x8 Vf[4]; Vf[0] = pack_step(w0, 0); Vf[1] = pack_step(w0, 1); Vf[2] = pack_step(w1, 0); Vf[3] = pack_step(w1, 1);
#pragma unroll
            for (int ks = 0; ks < 8; ++ks) { const bf16x8 a0 = *(const LAS bf16x8*)(buf + 16384 + (ks * 64 + lane) * 16), a1 = *(const LAS bf16x8*)(buf + 16384 + ((8 + ks) * 64 + lane) * 16);
                o0 = MFMA32(a0, Sf[ks], o0); o1 = MFMA32(a1, Sf[ks], o1); }
#pragma unroll
            for (int kt = 0; kt < 4; ++kt) { const bf16x8 a0 = *(const LAS bf16x8*)(buf + 49152 + (kt * 64 + lane) * 16), a1 = *(const LAS bf16x8*)(buf + 49152 + ((4 + kt) * 64 + lane) * 16);
                o0 = MFMA32(a0, Vf[kt], o0); o1 = MFMA32(a1, Vf[kt], o1); }
#pragma unroll
            for (int dt = 0; dt < 4; ++dt) {
#pragma unroll
                for (int i = 0; i < 16; ++i) S[dt][i] *= eg_cur;
#pragma unroll
                for (int kt = 0; kt < 4; ++kt) { const bf16x8 a = *(const LAS bf16x8*)(buf + 32768 + ((dt * 4 + kt) * 64 + lane) * 16); S[dt] = MFMA32(a, Vf[kt], S[dt]); } }
            {   LAS bf16* ob = (LAS bf16*)((c & 1) ? obuf1 : obuf0);
#pragma unroll
                for (int i = 0; i < 16; ++i) { const int row = (i & 3) + 8 * (i >> 2) + 4 * hh;
                    ob[row * 128 + e] = (bf16)(cvt2(o0[i], 0.f) & 0xffffu); ob[(32 + row) * 128 + e] = (bf16)(cvt2(o1[i], 0.f) & 0xffffu); } }
            WG_BAR_LDS();
        }
        float* Sout = P.out + O_SDN_P + ((size_t)b * 16 + h) * 16384;
#pragma unroll
        for (int dt = 0; dt < 4; ++dt)
#pragma unroll
            for (int i = 0; i < 16; ++i) Sout[(32 * dt + (i & 3) + 8 * (i >> 2) + 4 * hh) * 128 + e] = S[dt][i];
    } else {
        const int ht = tid - 256; const int pt = ht >> 2, pq = ht & 3;
        v4u st[14], zr[4];
        f32x4 nw0[4], nw1[4];
#pragma unroll
        for (int k = 0; k < 4; ++k) { const GAS f32x4* nwp = (const GAS f32x4*)(P.dn_norm_w + 32 * pq + 8 * k); nw0[k] = nwp[0]; nw1[k] = nwp[1]; }
#define DN_STAGE_ISSUE(itm) do { const unsigned char* _r = R.rec + (size_t)(itm) * 65536; const unsigned char* _q = R.qk + (size_t)(itm) * 8192; \
        _Pragma("unroll") for (int _k = 0; _k < 12; ++_k) st[_k] = *(const GAS v4u*)(_r + (ht + 256 * _k) * 16); \
        _Pragma("unroll") for (int _k = 0; _k < 2; ++_k) st[12 + _k] = *(const GAS v4u*)(_q + (ht + 256 * _k) * 16); } while (0)
#define DN_STAGE_WRITE(dstbuf) do { _Pragma("unroll") for (int _k = 0; _k < 14; ++_k) *(LAS v4u*)((dstbuf) + (ht + 256 * _k) * 16) = st[_k]; } while (0)
#define DN_Z_ISSUE(cc) do { const size_t _m = (size_t)(b * SEQ + 64 * (cc) + pt); _Pragma("unroll") for (int _k = 0; _k < 4; ++_k) zr[_k] = *(const GAS v4u*)(P.proj + _m * IN_WP + PC_Z + h * 128 + 32 * pq + 8 * _k); } while (0)
#define DN_POST(cc) do { const int _m = b * SEQ + 64 * (cc) + pt; v4u _o[4]; const LAS unsigned char* _ob = ((cc) & 1) ? obuf1 : obuf0; \
        _Pragma("unroll") for (int _k = 0; _k < 4; ++_k) _o[_k] = *(const LAS v4u*)(_ob + (pt * 128 + 32 * pq + 8 * _k) * 2); \
        float _ss = 0.f; _Pragma("unroll") for (int _k = 0; _k < 4; ++_k) { const float a0 = bflo(_o[_k].x), a1 = bfhi(_o[_k].x), a2 = bflo(_o[_k].y), a3 = bfhi(_o[_k].y), a4 = bflo(_o[_k].z), a5 = bfhi(_o[_k].z), a6 = bflo(_o[_k].w), a7 = bfhi(_o[_k].w); \
            _ss += (a0 * a0 + a1 * a1) + (a2 * a2 + a3 * a3) + (a4 * a4 + a5 * a5) + (a6 * a6 + a7 * a7); } \
        _ss += __shfl_xor(_ss, 1); _ss += __shfl_xor(_ss, 2); const float _rs = __builtin_amdgcn_rsqf(_ss * (1.f / 128.f) + NORM_EPS); \
        _Pragma("unroll") for (int _k = 0; _k < 4; ++_k) { const f32x4 n0 = nw0[_k], n1 = nw1[_k]; \
            const float z0 = bflo(zr[_k].x), z1 = bfhi(zr[_k].x), z2 = bflo(zr[_k].y), z3 = bfhi(zr[_k].y), z4 = bflo(zr[_k].z), z5 = bfhi(zr[_k].z), z6 = bflo(zr[_k].w), z7 = bfhi(zr[_k].w); \
            v4u _w; _w.x = cvt2(bflo(_o[_k].x) * _rs * n0.x * z0, bfhi(_o[_k].x) * _rs * n0.y * z1); \
            _w.y = cvt2(bflo(_o[_k].y) * _rs * n0.z * z2, bfhi(_o[_k].y) * _rs * n0.w * z3); \
            _w.z = cvt2(bflo(_o[_k].z) * _rs * n1.x * z4, bfhi(_o[_k].z) * _rs * n1.y * z5); \
            _w.w = cvt2(bflo(_o[_k].w) * _rs * n1.z * z6, bfhi(_o[_k].w) * _rs * n1.w * z7); \
            *(GAS v4u*)(P.mix + (size_t)_m * 4096 + h * 128 + 32 * pq + 8 * _k) = _w; } } while (0)
        DN_STAGE_ISSUE(item0); DN_STAGE_WRITE(lds); DN_STAGE_ISSUE(item0 + 16);
        WG_BAR_LDS();
#pragma unroll 1
        for (int c = 0; c < 128; ++c) {
            if (c + 1 < 128) DN_STAGE_WRITE(lds + ((c + 1) & 1) * SB);
            if (c + 2 < 128) DN_STAGE_ISSUE(item0 + 16 * (c + 2));
            if (c > 0) DN_POST(c - 1);
            DN_Z_ISSUE(c);
            WG_BAR_LDS();
        }
        DN_POST(127);
#undef DN_STAGE_ISSUE
#undef DN_STAGE_WRITE
#undef DN_Z_ISSUE
#undef DN_POST
    }
    {   float* cout = P.out + O_CONV_P + (size_t)b * 3 * 6144;
        for (int i = tid; i < 3 * 384; i += 512) { const int r = i / 384, cc = i - r * 384, col = (cc >> 7) * 2048 + h * 128 + (cc & 127);
            cout[r * 6144 + col] = bf2f(P.proj[(size_t)(b * SEQ + SEQ - 3 + r) * IN_WP + col]); } }
    __syncthreads();
}
struct RwRec { unsigned char* pq; unsigned char* rp; unsigned char* oo; float* sb; const bf16* w2T; const bf16* a2T; const bf16* g2T; };
constexpr int RSL = 9216;

constexpr int RWC_W2 = 132096, RWC_A2 = RWC_W2 + 13312, RWC_MU = RWC_A2 + 13312, RWC_PAR = RWC_MU + 768, RWC_END = RWC_PAR + 2048;
__device__ __forceinline__ void rw_stage_consts(const MixPtrs& P, const RwRec& W, LAS unsigned char* lds, int h, int tid) {
    for (int i = tid; i < 768; i += 512) { const int row = i / 12, pc = i - row * 12;
        *(LAS v4u*)(lds + RWC_W2 + row * 208 + pc * 16) = ((const GAS v4u*)(W.w2T + (size_t)h * 64 * 96))[i]; *(LAS v4u*)(lds + RWC_A2 + row * 208 + pc * 16) = ((const GAS v4u*)(W.a2T + (size_t)h * 64 * 96))[i]; }
    if (tid < 192) ((LAS float*)(lds + RWC_MU))[tid] = P.mu[RW_XW + tid];
    if (tid < 64) { LAS float* par = (LAS float*)(lds + RWC_PAR); const int hc = h * 64 + tid;
        par[tid] = P.mu[RW_R + hc]; par[64 + tid] = P.mu[RW_K + hc]; par[128 + tid] = P.mu[RW_V + hc]; par[192 + tid] = P.w0[hc]; par[256 + tid] = P.a0[hc]; par[320 + tid] = P.k_k[hc]; par[384 + tid] = P.k_a[hc]; par[448 + tid] = P.r_k[hc]; }
    __syncthreads();
}
struct RwRaw { unsigned ur[9], uk[9], uv[9]; v4u xu[3], xp[3]; };
__device__ __forceinline__ void rw_prep_issue(const MixPtrs& P, RwRaw& R, int b, int c, int h, int tid, int lane, int wave) {
    const int hc = h * 64 + lane;
    const __amdgpu_buffer_rsrc_t rs = __builtin_amdgcn_make_buffer_rsrc((void*)P.proj, 0, (int)((size_t)MPAD * IN_WP * 2), 0x00020000);
#pragma unroll
    for (int i = 0; i < 9; ++i) { int tt = 64 * c + wave * 8 + i - 1; tt = tt < 0 ? 0 : tt;
        const int so = ((b * SEQ + tt) * IN_WP + PC_RW + h * 64) * 2;
        R.ur[i] = __builtin_amdgcn_raw_buffer_load_b16(rs, lane * 2, so + RW_R * 2, 0); R.uk[i] = __builtin_amdgcn_raw_buffer_load_b16(rs, lane * 2, so + RW_K * 2, 0); R.uv[i] = __builtin_amdgcn_raw_buffer_load_b16(rs, lane * 2, so + RW_V * 2, 0); }
#pragma unroll
    for (int r = 0; r < 3; ++r) { const int i = tid + 512 * r; const int which = i >= 768, ii = which ? i - 768 : i; const int t = ii / 12, g8 = ii - t * 12; int tp = 64 * c + t - 1; tp = tp < 0 ? 0 : tp;
        const int col = (which ? RW_XA : RW_XW) + 8 * g8;
        R.xu[r] = *(const GAS v4u*)(P.proj + (size_t)(b * SEQ + 64 * c + t) * IN_WP + PC_RW + col); R.xp[r] = *(const GAS v4u*)(P.proj + (size_t)(b * SEQ + tp) * IN_WP + PC_RW + col); }
}
template <bool FRONT_ONLY = false>
__device__ __forceinline__ void rw_prep_item(const MixPtrs& P, const RwRec& W, LAS unsigned char* lds, int b, int c, int h, RwRaw& raw, int nb, int nc, int nh, int tid, int lane, int wave) {
    const int m0 = b * SEQ + 64 * c; const int item = (b * 128 + c) * 32 + h; const int hc = h * 64 + lane;
    const int l15 = lane & 15, q = lane >> 4;
    LAS bf16* Rt = (LAS bf16*)(lds + 0 * RSL); LAS bf16* Kt = (LAS bf16*)(lds + 1 * RSL); LAS bf16* Bt = (LAS bf16*)(lds + 2 * RSL); LAS bf16* At = (LAS bf16*)(lds + 3 * RSL);
    LAS bf16* AtT = (LAS bf16*)(lds + 4 * RSL); LAS bf16* KhT = (LAS bf16*)(lds + 5 * RSL); LAS bf16* BhT = (LAS bf16*)(lds + 6 * RSL); LAS bf16* VT = (LAS bf16*)(lds + 7 * RSL);
    LAS bf16* Aak = (LAS bf16*)(lds + 8 * RSL); LAS bf16* Ark = (LAS bf16*)(lds + 9 * RSL); LAS bf16* Arb = (LAS bf16*)(lds + 10 * RSL);
    LAS float* Lm = (LAS float*)(lds + 11 * RSL); LAS float* Tm = (LAS float*)(lds + 1 * RSL); LAS bf16* Tb = (LAS bf16*)(lds + 3 * RSL);
    LAS bf16* WtT = (LAS bf16*)(lds + 11 * RSL); LAS bf16* XT = (LAS bf16*)(lds + 13 * RSL); LAS bf16* U0T = (LAS bf16*)(lds + 1 * RSL);
    LAS float* Dinv = (LAS float*)(lds + 13 * RSL); LAS float* Yb = (LAS float*)(lds + 13 * RSL + 4352);
    LAS float* wl = (LAS float*)(lds + 0); LAS float* al = (LAS float*)(lds + 2 * RSL);
    LAS bf16* txw = (LAS bf16*)(lds + 8 * RSL); LAS bf16* xas = txw + 64 * 104; LAS bf16* w2s = xas + 64 * 104; LAS bf16* a2s = w2s + 64 * 104;
    LAS float* wtot = (LAS float*)(lds + 126976); LAS float* eGCs = (LAS float*)(lds + 129024);
    const LAS float* par = (const LAS float*)(lds + RWC_PAR); const LAS float* muL = (const LAS float*)(lds + RWC_MU); const LAS unsigned char* w2h = lds + RWC_W2; const LAS unsigned char* a2h = lds + RWC_A2;
    float rr[8], kr[8], vv[8];
    {   float ur[9], uk[9], uv[9];
#pragma unroll
        for (int i = 0; i < 9; ++i) { const bool ok = (64 * c + wave * 8 + i - 1) >= 0;
            ur[i] = ok ? bf2f((bf16)raw.ur[i]) : 0.f; uk[i] = ok ? bf2f((bf16)raw.uk[i]) : 0.f; uv[i] = ok ? bf2f((bf16)raw.uv[i]) : 0.f; }
        const float mr = par[lane], mk = par[64 + lane], mv = par[128 + lane];
#pragma unroll
        for (int i = 0; i < 8; ++i) { rr[i] = ur[i + 1] + mr * (ur[i] - ur[i + 1]); kr[i] = uk[i + 1] + mk * (uk[i] - uk[i + 1]); vv[i] = uv[i + 1] + mv * (uv[i] - uv[i + 1]); }
    }
#ifdef PRF
    _Pragma("unroll 1") for (int _prf = 0; _prf < 2; ++_prf) {
#else
    {
#endif
#ifdef PR1
    for (int _pr = 0; _pr < 2; ++_pr) {
#else
    {
#endif
#pragma unroll
    for (int r = 0; r < 3; ++r) { const int i = tid + 512 * r; const int which = i >= 768, ii = which ? i - 768 : i; const int t = ii / 12, g8 = ii - t * 12; const int tt = 64 * c + t;
        const int col = (which ? RW_XA : RW_XW) + 8 * g8;
        const v4u u = raw.xu[r]; v4u up = raw.xp[r]; if (tt <= 0) up = (v4u){0u, 0u, 0u, 0u};
        const f32x4 m0v = *(const LAS f32x4*)(muL + which * 96 + 8 * g8), m1v = *(const LAS f32x4*)(muL + which * 96 + 8 * g8 + 4);
        float x[8];
        x[0] = bflo(u.x) + m0v.x * (bflo(up.x) - bflo(u.x)); x[1] = bfhi(u.x) + m0v.y * (bfhi(up.x) - bfhi(u.x)); x[2] = bflo(u.y) + m0v.z * (bflo(up.y) - bflo(u.y)); x[3] = bfhi(u.y) + m0v.w * (bfhi(up.y) - bfhi(u.y));
        x[4] = bflo(u.z) + m1v.x * (bflo(up.z) - bflo(u.z)); x[5] = bfhi(u.z) + m1v.y * (bfhi(up.z) - bfhi(u.z)); x[6] = bflo(u.w) + m1v.z * (bflo(up.w) - bflo(u.w)); x[7] = bfhi(u.w) + m1v.w * (bfhi(up.w) - bfhi(u.w));
        if (!which) {
#pragma unroll
            for (int k = 0; k < 8; ++k) { const float e2 = __expf(2.0f * x[k]); x[k] = 1.0f - 2.0f * __builtin_amdgcn_rcpf(e2 + 1.0f); } }
        v4u o; o.x = cvt2(x[0], x[1]); o.y = cvt2(x[2], x[3]); o.z = cvt2(x[4], x[5]); o.w = cvt2(x[6], x[7]);
        *(LAS v4u*)(txw + which * 6656 + t * 104 + 8 * g8) = o; }
    __syncthreads();
    if (nb >= 0) rw_prep_issue(P, raw, nb, nc, nh, tid, lane, wave);
    {   const int tt = wave & 3, cp = wave >> 2;
#pragma unroll
        for (int ci = 0; ci < 2; ++ci) { const int ct = 2 * cp + ci;
            f32x4 aw = (f32x4){0.f, 0.f, 0.f, 0.f}, aa = (f32x4){0.f, 0.f, 0.f, 0.f};
#pragma unroll
            for (int ks = 0; ks < 3; ++ks) {
                const bf16x8 fx = *(const LAS bf16x8*)(txw + (16 * tt + l15) * 104 + 32 * ks + 8 * q), fa = *(const LAS bf16x8*)(xas + (16 * tt + l15) * 104 + 32 * ks + 8 * q);
                const int wo = (16 * ct + l15) * 208 + 64 * ks + 16 * q;
                aw = MFMA16(fx, *(const LAS bf16x8*)(w2h + wo), aw); aa = MFMA16(fa, *(const LAS bf16x8*)(a2h + wo), aa); }
#pragma unroll
            for (int reg = 0; reg < 4; ++reg) { wl[(16 * tt + 4 * q + reg) * 65 + 16 * ct + l15] = aw[reg]; al[(16 * tt + 4 * q + reg) * 65 + 16 * ct + l15] = aa[reg]; } }
    }
    }
    __syncthreads();
    float lw[8], av[8], bvv[8], kp[8], Gt[8];
    {   const float w0c = par[192 + lane], a0c = par[256 + lane], kkc = par[320 + lane], kac = par[384 + lane], rkc = par[448 + lane];
        LAS float* red = (LAS float*)(lds + 8 * RSL + wave * 4352);
        float run = 0.f, alr[8], kkr[8];
#pragma unroll
        for (int i = 0; i < 8; ++i) { const int t = wave * 8 + i;
            lw[i] = -0.6065306597126334f * sigmoid_f(w0c + wl[t * 65 + lane]);
            alr[i] = sigmoid_f(a0c + al[t * 65 + lane]);
            kkr[i] = kr[i] * kkc; kp[i] = kr[i] * (1.0f + (alr[i] - 1.0f) * kac);
            red[i * 68 + lane] = kkr[i] * kkr[i]; red[(8 + i) * 68 + lane] = rr[i] * kp[i] * rkc;
            run += lw[i]; Gt[i] = run; }
        wtot[wave * 64 + lane] = run;
        float s;
        {   const LAS f32x4* rp = (const LAS f32x4*)(red + (lane & 15) * 68 + (lane >> 4) * 16);
            const f32x4 r0 = rp[0], r1 = rp[1], r2 = rp[2], r3 = rp[3];
            s = ((r0.x + r0.y) + (r0.z + r0.w)) + ((r1.x + r1.y) + (r1.z + r1.w)) + ((r2.x + r2.y) + (r2.z + r2.w)) + ((r3.x + r3.y) + (r3.z + r3.w)); }
        s += __shfl_xor(s, 16); s += __shfl_xor(s, 32);
        if (lane >= 8 && lane < 16) W.sb[(size_t)item * 64 + wave * 8 + lane - 8] = s;
#pragma unroll
        for (int i = 0; i < 8; ++i) { const float nrm = __builtin_bit_cast(float, __builtin_amdgcn_readlane(__builtin_bit_cast(int, s), i));
            const float kk = kkr[i] * __builtin_amdgcn_rsqf(nrm + 1e-6f); av[i] = -kk; bvv[i] = kk * alr[i]; }
    }
    __syncthreads();
    {   float off = 0.f, gcv = 0.f;
#pragma unroll
        for (int w = 0; w < 8; ++w) { const float x = wtot[w * 64 + lane]; gcv += x; if (w < wave) off += x; }
        const float egc = __expf(gcv); float eprev = __expf(off);
        if (wave == 0) eGCs[lane] = egc;
        float tA[8], tK[8], tB[8];
#pragma unroll
        for (int i = 0; i < 8; ++i) { const int t = wave * 8 + i; const float G = Gt[i] + off;
            const float eG = __expf(G), eGm = __builtin_amdgcn_rcpf(eG), eGp = eprev, eH = egc * eGm; eprev = eG;
            Rt[t * 72 + lane] = (bf16)(cvt2(rr[i] * eG, 0.f) & 0xffffu); Kt[t * 72 + lane] = (bf16)(cvt2(kp[i] * eGm, 0.f) & 0xffffu);
            Bt[t * 72 + lane] = (bf16)(cvt2(bvv[i] * eGm, 0.f) & 0xffffu); tA[i] = av[i] * eGp; At[t * 72 + lane] = (bf16)(cvt2(tA[i], 0.f) & 0xffffu);
            tK[i] = kp[i] * eH; tB[i] = bvv[i] * eH; }
        v4u o;
        o.x = cvt2(tA[0], tA[1]); o.y = cvt2(tA[2], tA[3]); o.z = cvt2(tA[4], tA[5]); o.w = cvt2(tA[6], tA[7]); *(LAS v4u*)(AtT + lane * 72 + wave * 8) = o;
        o.x = cvt2(tK[0], tK[1]); o.y = cvt2(tK[2], tK[3]); o.z = cvt2(tK[4], tK[5]); o.w = cvt2(tK[6], tK[7]); *(LAS v4u*)(KhT + lane * 72 + wave * 8) = o;
        o.x = cvt2(tB[0], tB[1]); o.y = cvt2(tB[2], tB[3]); o.z = cvt2(tB[4], tB[5]); o.w = cvt2(tB[6], tB[7]); *(LAS v4u*)(BhT + lane * 72 + wave * 8) = o;
        o.x = cvt2(vv[0], vv[1]); o.y = cvt2(vv[2], vv[3]); o.z = cvt2(vv[4], vv[5]); o.w = cvt2(vv[6], vv[7]); *(LAS v4u*)(VT + lane * 72 + wave * 8) = o;
    }
    __syncthreads();
    }
    if constexpr (FRONT_ONLY) return;
#ifdef PR4
    for (int _pr = 0; _pr < 2; ++_pr)
#endif
    {   const int tt = wave & 3, sp = wave >> 2;
        bf16x8 fA[2], fR[2];
#pragma unroll
        for (int ks = 0; ks < 2; ++ks) { fA[ks] = *(const LAS bf16x8*)(At + (16 * tt + l15) * 72 + 32 * ks + 8 * q); fR[ks] = *(const LAS bf16x8*)(Rt + (16 * tt + l15) * 72 + 32 * ks + 8 * q); }
#pragma unroll
        for (int si = 0; si < 2; ++si) { const int st = 2 * sp + si;
            f32x4 ab = (f32x4){0.f, 0.f, 0.f, 0.f}, ak = ab, rk = ab, rb = ab;
#pragma unroll
            for (int ks = 0; ks < 2; ++ks) { const bf16x8 fB = *(const LAS bf16x8*)(Bt + (16 * st + l15) * 72 + 32 * ks + 8 * q), fK = *(const LAS bf16x8*)(Kt + (16 * st + l15) * 72 + 32 * ks + 8 * q);
                ab = MFMA16(fB, fA[ks], ab); ak = MFMA16(fK, fA[ks], ak); rk = MFMA16(fK, fR[ks], rk); rb = MFMA16(fB, fR[ks], rb); }
            const int t = 16 * tt + l15, s0 = 16 * st + 4 * q; float vak[4], vrk[4], vrb[4];
#pragma unroll
            for (int reg = 0; reg < 4; ++reg) { const int s = s0 + reg; Lm[t * 65 + s] = (t > s) ? -ab[reg] : 0.f; vak[reg] = (t > s) ? ak[reg] : 0.f; vrk[reg] = (t >= s) ? rk[reg] : 0.f; vrb[reg] = (t >= s) ? rb[reg] : 0.f; }
            v2u o; o.x = cvt2(vak[0], vak[1]); o.y = cvt2(vak[2], vak[3]); *(LAS v2u*)(Aak + t * 72 + s0) = o;
            o.x = cvt2(vrk[0], vrk[1]); o.y = cvt2(vrk[2], vrk[3]); *(LAS v2u*)(Ark + t * 72 + s0) = o;
            o.x = cvt2(vrb[0], vrb[1]); o.y = cvt2(vrb[2], vrb[3]); *(LAS v2u*)(Arb + t * 72 + s0) = o; }
    }
    __syncthreads();
    {   const int tt = wave & 3, cp = wave >> 2;
        if (wave == 0) tri_inv64_mfma<false>(Lm, Tb, lane, wave);
        bf16x8 fK[2];
#pragma unroll
        for (int ks = 0; ks < 2; ++ks) fK[ks] = *(const LAS bf16x8*)(Aak + (16 * tt + l15) * 72 + 32 * ks + 8 * q);
#pragma unroll
        for (int ci = 0; ci < 2; ++ci) { const int ct = 2 * cp + ci; f32x4 ax = (f32x4){0.f, 0.f, 0.f, 0.f};
#pragma unroll
            for (int ks = 0; ks < 2; ++ks) ax = MFMA16(fK[ks], *(const LAS bf16x8*)(VT + (16 * ct + l15) * 72 + 32 * ks + 8 * q), ax);
            v2u o; o.x = cvt2(ax[0], ax[1]); o.y = cvt2(ax[2], ax[3]); *(LAS v2u*)(XT + (16 * ct + l15) * 72 + 16 * tt + 4 * q) = o; }
    }
    __syncthreads();
    {   const int tt = wave & 3, cp = wave >> 2;
        bf16x8 fT[2];
#pragma unroll
        for (int ks = 0; ks < 2; ++ks) fT[ks] = *(const LAS bf16x8*)(Tb + (16 * tt + l15) * 72 + 32 * ks + 8 * q);
#pragma unroll
        for (int ci = 0; ci < 2; ++ci) { const int ct = 2 * cp + ci;
            f32x4 aw = (f32x4){0.f, 0.f, 0.f, 0.f}, au = aw;
#pragma unroll
            for (int ks = 0; ks < 2; ++ks) { const bf16x8 fa = *(const LAS bf16x8*)(AtT + (16 * ct + l15) * 72 + 32 * ks + 8 * q), fx = *(const LAS bf16x8*)(XT + (16 * ct + l15) * 72 + 32 * ks + 8 * q);
                aw = MFMA16(fT[ks], fa, aw); au = MFMA16(fT[ks], fx, au); }
            v2u o; o.x = cvt2(aw[0], aw[1]); o.y = cvt2(aw[2], aw[3]); *(LAS v2u*)(WtT + (16 * ct + l15) * 72 + 16 * tt + 4 * q) = o;
            o.x = cvt2(au[0], au[1]); o.y = cvt2(au[2], au[3]); *(LAS v2u*)(U0T + (16 * ct + l15) * 72 + 16 * tt + 4 * q) = o; }
    }
    __syncthreads();
    {   const int bt = wave & 3, ap = wave >> 2;
        unsigned char* pq = W.pq + (size_t)item * 16384; unsigned char* rp = W.rp + (size_t)item * 8192; unsigned char* oo = W.oo + (size_t)item * 8192;
        bf16x8 fArb[2], fArk[2], fBh[2], fV[2], fU[2];
#pragma unroll
        for (int ks = 0; ks < 2; ++ks) { fArb[ks] = *(const LAS bf16x8*)(Arb + (16 * bt + l15) * 72 + 32 * ks + 8 * q); fArk[ks] = *(const LAS bf16x8*)(Ark + (16 * bt + l15) * 72 + 32 * ks + 8 * q);
            fBh[ks] = *(const LAS bf16x8*)(BhT + (16 * bt + l15) * 72 + 32 * ks + 8 * q); fV[ks] = *(const LAS bf16x8*)(VT + (16 * bt + l15) * 72 + 32 * ks + 8 * q); fU[ks] = *(const LAS bf16x8*)(U0T + (16 * bt + l15) * 72 + 32 * ks + 8 * q); }
#pragma unroll
        for (int ai = 0; ai < 2; ++ai) { const int at = 2 * ap + ai;
            f32x4 aR = (f32x4){0.f, 0.f, 0.f, 0.f}, aP = aR, aO = aR, aQ = aR;
#pragma unroll
            for (int ks = 0; ks < 2; ++ks) {
                const bf16x8 fW = *(const LAS bf16x8*)(WtT + (16 * at + l15) * 72 + 32 * ks + 8 * q);
                aR = MFMA16(fW, fArb[ks], aR);
                aP = MFMA16(fW, fBh[ks], aP);
                const bf16x8 fk = *(const LAS bf16x8*)(Ark + (16 * at + l15) * 72 + 32 * ks + 8 * q), fb = *(const LAS bf16x8*)(Arb + (16 * at + l15) * 72 + 32 * ks + 8 * q);
                aO = MFMA16(fk, fV[ks], aO); aO = MFMA16(fb, fU[ks], aO);
                const bf16x8 fkh = *(const LAS bf16x8*)(KhT + (16 * at + l15) * 72 + 32 * ks + 8 * q), fbh = *(const LAS bf16x8*)(BhT + (16 * at + l15) * 72 + 32 * ks + 8 * q);
                aQ = MFMA16(fkh, fV[ks], aQ); aQ = MFMA16(fbh, fU[ks], aQ); }
            const int x = 16 * bt + l15, y0 = 16 * at + 4 * q;
            {   const v2u rt = *(const LAS v2u*)(Rt + x * 72 + y0);
                v2u o; o.x = cvt2(aR[0] + bflo(rt.x), aR[1] + bfhi(rt.x)); o.y = cvt2(aR[2] + bflo(rt.y), aR[3] + bfhi(rt.y));
                *(LAS v2u*)(lds + 2 * RSL + ((((x >> 5) * 4 + at) * 64 + (x & 31) + 32 * (q & 1)) * 16 + 8 * (q >> 1))) = o; }
            {   const float dg = eGCs[x]; float p[4];
#pragma unroll
                for (int reg = 0; reg < 4; ++reg) p[reg] = aP[reg] + ((y0 + reg == x) ? dg : 0.f);
                v2u o; o.x = cvt2(p[0], p[1]); o.y = cvt2(p[2], p[3]);
                *(LAS v2u*)(lds + 3 * RSL + ((((x >> 5) * 4 + at) * 64 + (x & 31) + 32 * (q & 1)) * 16 + 8 * (q >> 1))) = o; }
            {   v2u o; o.x = cvt2(aO[0], aO[1]); o.y = cvt2(aO[2], aO[3]); *(LAS v2u*)(lds + 4 * RSL + x * 136 + y0 * 2) = o; }
            {   v2u o; o.x = cvt2(aQ[0], aQ[1]); o.y = cvt2(aQ[2], aQ[3]); *(LAS v2u*)(lds + 8 * RSL + x * 136 + y0 * 2) = o; }
        }
        __syncthreads();
        {
            const v4u c0 = *(const LAS v4u*)(lds + 2 * RSL + tid * 16), c1 = *(const LAS v4u*)(lds + 3 * RSL + tid * 16);
            const LAS unsigned char* s2 = lds + 4 * RSL + (tid >> 3) * 136 + (tid & 7) * 16; const LAS unsigned char* s3 = lds + 8 * RSL + (tid >> 3) * 136 + (tid & 7) * 16;
            const v2u a2 = *(const LAS v2u*)s2, b2 = *(const LAS v2u*)(s2 + 8), a3 = *(const LAS v2u*)s3, b3 = *(const LAS v2u*)(s3 + 8);
            *(GAS v4u*)(rp + tid * 16) = c0; *(GAS v4u*)(pq + tid * 16) = c1;
            *(GAS v4u*)(oo + tid * 16) = (v4u){a2.x, a2.y, b2.x, b2.y}; *(GAS v4u*)(pq + 8192 + tid * 16) = (v4u){a3.x, a3.y, b3.x, b3.y}; }
    }
    __syncthreads();
}

__device__ __forceinline__ void rw_scan(const MixPtrs& P, const RwRec& W, LAS unsigned char* lds, int b, int h, int tid, int lane, int wave) {
    constexpr int SB = 33792;
    const int item0 = b * 128 * 32 + h;
    if (wave < 2) {
        const int e = 32 * wave + (lane & 31), hh = lane >> 5;
        f32x16 H[2];
#pragma unroll
        for (int i = 0; i < 16; ++i) { H[0][i] = 0.f; H[1][i] = 0.f; }
        WG_BAR_LDS();
#pragma unroll 1
        for (int c = 0; c < 128; ++c) {
            LAS unsigned char* buf = lds + (c & 1) * SB;
            bf16x8 Hf[4]; Hf[0] = pack_step(H[0], 0); Hf[1] = pack_step(H[0], 1); Hf[2] = pack_step(H[1], 0); Hf[3] = pack_step(H[1], 1);
#pragma unroll
            for (int mt = 0; mt < 2; ++mt) {
                f32x16 hn, ov;
#pragma unroll
                for (int g = 0; g < 4; ++g) { const v2u qv = *(const LAS v2u*)(buf + 16384 + e * 136 + (32 * mt + 8 * g + 4 * hh) * 2), o0 = *(const LAS v2u*)(buf + 16384 + 8704 + e * 136 + (32 * mt + 8 * g + 4 * hh) * 2);
                    hn[4 * g] = bflo(qv.x); hn[4 * g + 1] = bfhi(qv.x); hn[4 * g + 2] = bflo(qv.y); hn[4 * g + 3] = bfhi(qv.y);
                    ov[4 * g] = bflo(o0.x); ov[4 * g + 1] = bfhi(o0.x); ov[4 * g + 2] = bflo(o0.y); ov[4 * g + 3] = bfhi(o0.y); }
#pragma unroll
                for (int ks = 0; ks < 4; ++ks) { const bf16x8 fp = *(const LAS bf16x8*)(buf + ((mt * 4 + ks) * 64 + lane) * 16), fr = *(const LAS bf16x8*)(buf + 8192 + ((mt * 4 + ks) * 64 + lane) * 16);
                    hn = MFMA32(fp, Hf[ks], hn); ov = MFMA32(fr, Hf[ks], ov); }
#pragma unroll
                for (int g = 0; g < 4; ++g) { v2u o; o.x = cvt2(ov[4 * g], ov[4 * g + 1]); o.y = cvt2(ov[4 * g + 2], ov[4 * g + 3]); *(LAS v2u*)(buf + 16384 + 8704 + e * 136 + (32 * mt + 8 * g + 4 * hh) * 2) = o; }
                if (mt == 0) H[0] = hn; else H[1] = hn;
            }
            WG_BAR_LDS();
        }
        float* Sout = P.out + O_SRW_P + ((size_t)b * 32 + h) * 4096;
#pragma unroll
        for (int mt = 0; mt < 2; ++mt)
#pragma unroll
            for (int g = 0; g < 4; ++g) *(f32x4*)(Sout + e * 64 + 32 * mt + 8 * g + 4 * hh) = (f32x4){H[mt][4 * g], H[mt][4 * g + 1], H[mt][4 * g + 2], H[mt][4 * g + 3]};
    } else {
        const int ht = tid - 128;
        v4u st[6];
#define RW_STAGE_ISSUE(itm) do { const unsigned char* _pq = W.pq + (size_t)(itm) * 16384; const unsigned char* _rp = W.rp + (size_t)(itm) * 8192; const unsigned char* _oo = W.oo + (size_t)(itm) * 8192; \
        _Pragma("unroll") for (int _k = 0; _k < 6; ++_k) { const int _i = ht + 384 * _k; if (_i < 2048) st[_k] = *(const GAS v4u*)(_i < 512 ? _pq + _i * 16 : (_i < 1024 ? _rp + (_i - 512) * 16 : (_i < 1536 ? _pq + 8192 + (_i - 1024) * 16 : _oo + (_i - 1536) * 16))); } } while (0)
#define RW_STAGE_WRITE(dstbuf) do { _Pragma("unroll") for (int _k = 0; _k < 6; ++_k) { const int _i = ht + 384 * _k; if (_i < 1024) *(LAS v4u*)((dstbuf) + _i * 16) = st[_k]; \
            else if (_i < 2048) { const int _j = _i - 1024; LAS unsigned char* _d = (dstbuf) + 16384 + (_j >> 3) * 136 + (_j & 7) * 16; *(LAS v2u*)_d = (v2u){st[_k].x, st[_k].y}; *(LAS v2u*)(_d + 8) = (v2u){st[_k].z, st[_k].w}; } } } while (0)
#define RW_STORE_O(itm, srcbuf) do { unsigned char* _oo = W.oo + (size_t)(itm) * 8192; \
        _Pragma("unroll") for (int _k = 4; _k < 6; ++_k) { const int _i = ht + 384 * _k; if (_i < 2048) { const int _j = _i - 1024; const LAS unsigned char* _s = (srcbuf) + 16384 + (_j >> 3) * 136 + (_j & 7) * 16; \
            const v2u _a = *(const LAS v2u*)_s, _b = *(const LAS v2u*)(_s + 8); *(GAS v4u*)(_oo + (_i - 1536) * 16) = (v4u){_a.x, _a.y, _b.x, _b.y}; } } } while (0)
        RW_STAGE_ISSUE(item0); RW_STAGE_WRITE(lds); RW_STAGE_ISSUE(item0 + 32);
        WG_BAR_LDS();
#pragma unroll 1
        for (int c = 0; c < 128; ++c) {
            if (c > 0) RW_STORE_O(item0 + 32 * (c - 1), lds + ((c - 1) & 1) * SB);
            if (c + 1 < 128) RW_STAGE_WRITE(lds + ((c + 1) & 1) * SB);
            if (c + 2 < 128) RW_STAGE_ISSUE(item0 + 32 * (c + 2));
            WG_BAR_LDS();
        }
        RW_STORE_O(item0 + 32 * 127, lds + SB);
#undef RW_STAGE_ISSUE
#undef RW_STAGE_WRITE
#undef RW_STORE_O
    }
    {   float* shout = P.out + O_SHIFT_P + (size_t)b * RW_SHIFT_W;
        for (int i = tid; i < 206; i += 512) { const int col = h * 206 + i; shout[col] = bf2f(P.proj[(size_t)(b * SEQ + SEQ - 1) * IN_WP + PC_RW + col]); } }
    __syncthreads();
}

__device__ __forceinline__ void rw_gate_item(const MixPtrs& P, const RwRec& W, LAS unsigned char* lds, int b, int c, int qt, int tid, int lane, int wave) {
    const int m0 = b * SEQ + 64 * c; const int l15 = lane & 15, q = lane >> 4;
    LAS bf16* sxg = (LAS bf16*)lds;
#pragma unroll
    for (int r = 0; r < 4; ++r) { const int i = tid + 512 * r; const int t = i >> 5, g8 = i & 31; const int tt = 64 * c + t; const int col = RW_XG + 8 * g8;
        const v4u u = *(const GAS v4u*)(P.proj + (size_t)(m0 + t) * IN_WP + PC_RW + col); v4u up = (v4u){0u, 0u, 0u, 0u}; if (tt > 0) up = *(const GAS v4u*)(P.proj + (size_t)(m0 + t - 1) * IN_WP + PC_RW + col);
        const f32x4 m0v = *(const GAS f32x4*)(P.mu + col), m1v = *(const GAS f32x4*)(P.mu + col + 4);
        float x[8];
        x[0] = bflo(u.x) + m0v.x * (bflo(up.x) - bflo(u.x)); x[1] = bfhi(u.x) + m0v.y * (bfhi(up.x) - bfhi(u.x)); x[2] = bflo(u.y) + m0v.z * (bflo(up.y) - bflo(u.y)); x[3] = bfhi(u.y) + m0v.w * (bfhi(up.y) - bfhi(u.y));
        x[4] = bflo(u.z) + m1v.x * (bflo(up.z) - bflo(u.z)); x[5] = bfhi(u.z) + m1v.y * (bfhi(up.z) - bfhi(u.z)); x[6] = bflo(u.w) + m1v.z * (bflo(up.w) - bflo(u.w)); x[7] = bfhi(u.w) + m1v.w * (bfhi(up.w) - bfhi(u.w));
        v4u o; o.x = cvt2(sigmoid_f(x[0]), sigmoid_f(x[1])); o.y = cvt2(sigmoid_f(x[2]), sigmoid_f(x[3])); o.z = cvt2(sigmoid_f(x[4]), sigmoid_f(x[5])); o.w = cvt2(sigmoid_f(x[6]), sigmoid_f(x[7]));
        *(LAS v4u*)(sxg + t * 264 + 8 * g8) = o; }
    __syncthreads();
    {   const int tt = wave & 3, hf = wave >> 2;
        bf16x8 fx[8];
#pragma unroll
        for (int ks = 0; ks < 8; ++ks) fx[ks] = *(const LAS bf16x8*)(sxg + (16 * tt + l15) * 264 + 32 * ks + 8 * q);
        const int colb = qt * 512 + hf * 256;
#pragma unroll 2
        for (int vt = 0; vt < 16; ++vt) { const bf16* gr = W.g2T + (size_t)(colb + 16 * vt + l15) * 256 + 8 * q;
            bf16x8 fg[8];
#pragma unroll
            for (int ks = 0; ks < 8; ++ks) fg[ks] = *(const GAS bf16x8*)(gr + 32 * ks);
            f32x4 ag = (f32x4){0.f, 0.f, 0.f, 0.f};
#pragma unroll
            for (int ks = 0; ks < 8; ++ks) ag = MFMA16(fg[ks], fx[ks], ag);
            v2u o; o.x = cvt2(ag[0], ag[1]); o.y = cvt2(ag[2], ag[3]);
            *(GAS v2u*)(P.mix + (size_t)(m0 + 16 * tt + l15) * 4096 + 2048 + colb + 16 * vt + 4 * q) = o; }
    }
    __syncthreads();
}
__device__ __forceinline__ void rw_post_task(const MixPtrs& P, const RwRec& W, int item, int tg, int lane) {
    const int h = item & 31, c = (item >> 5) & 127, b = item >> 12; const int m0 = b * SEQ + 64 * c + 8 * tg; const int hc = h * 64 + lane;
    const v4u ov = *(const GAS v4u*)(W.oo + (size_t)item * 8192 + (lane * 64 + tg * 8) * 2);
    float uv[9], gt[8];
#pragma unroll
    for (int i = 0; i < 9; ++i) { const int tt = 64 * c + 8 * tg + i - 1; uv[i] = tt >= 0 ? bf2f(P.proj[(size_t)(b * SEQ + tt) * IN_WP + PC_RW + RW_V + hc]) : 0.f; }
#pragma unroll
    for (int i = 0; i < 8; ++i) gt[i] = bf2f(P.mix[(size_t)(m0 + i) * 4096 + 2048 + hc]);
    const float mv = P.mu[RW_V + hc], lnw = P.ln_w[hc], lnb = P.ln_b[hc];
    const float y[8] = {bflo(ov.x), bfhi(ov.x), bflo(ov.y), bfhi(ov.y), bflo(ov.z), bfhi(ov.z), bflo(ov.w), bfhi(ov.w)};
    float sbs[8];
#pragma unroll
    for (int i = 0; i < 8; ++i) sbs[i] = W.sb[(size_t)item * 64 + tg * 8 + i];
#pragma unroll
    for (int i = 0; i < 8; ++i) { const float vv = uv[i + 1] + mv * (uv[i] - uv[i + 1]);
        const float mean = wave_sum(y[i]) * (1.f / 64.f); const float dy = y[i] - mean; const float var = wave_sum(dy * dy) * (1.f / 64.f);
        const float yn = dy * __builtin_amdgcn_rsqf(var + RW_GN_EPS) * lnw + lnb;
        P.mix[(size_t)(m0 + i) * 4096 + 2048 + hc] = (bf16)(cvt2((yn + sbs[i] * vv) * gt[i], 0.f) & 0xffffu); }
}

constexpr int NPH = 10;
#define MK_N_LAUNCHES 1
#ifndef MK_N_LAUNCHES
#define MK_N_LAUNCHES 1
#endif
#ifndef GP_ALIGN
#define GP_ALIGN true
#endif
#ifndef GP_SP2
#define GP_SP2 true
#endif
#ifndef STAG_US1
#define STAG_US1 0
#endif
#ifndef STAG_US2
#define STAG_US2 0
#endif
#ifndef STAG_US3
#define STAG_US3 0
#endif
#ifndef STAG_US4
#define STAG_US4 0
#endif
#ifndef STAG_MODE
#define STAG_MODE 0
#endif
#define STAGGER(us) do { if ((us) > 0) { const unsigned _g = STAG_MODE ? ((blockIdx.x >> 3) & 7u) : (blockIdx.x & 7u); const unsigned long long _t0 = __builtin_amdgcn_s_memrealtime(), _d = (unsigned long long)(_g * (us) * 100 / 8); \
        while (__builtin_amdgcn_s_memrealtime() - _t0 < _d) __builtin_amdgcn_s_sleep(4); } } while (0)
#ifndef REP_MASK
#define REP_MASK 0
#endif
__global__ void __launch_bounds__(NWAVES * 64, 2) hymba_fwd(Args args) {
    extern __shared__ __attribute__((aligned(16))) unsigned char lds_raw[];
    LAS unsigned char* lds = (LAS unsigned char*)lds_raw;
    volatile LAS unsigned* MISC = (volatile LAS unsigned*)(lds + MISC_OFF);
    const int tid = threadIdx.x, lane = tid & 63, wave = __builtin_amdgcn_readfirstlane(tid >> 6);
    const int G = gridDim.x;
    unsigned char* ws = args.ws;
    gu32* ctl = (gu32*)(ws + WS_CTL);
    for (int u = tid; u < (LDS_BYTES - LDSCTL_OFF) / 4; u += NWAVES * 64) ((LAS unsigned*)(lds + LDSCTL_OFF))[u] = 0u;
    __syncthreads();
    XcdBarrier bar; bar.bar = (unsigned*)(ctl + CW_BAR); bar.x = 0; bar.st = nullptr;
    if (MK_N_LAUNCHES == 1) bar = xcd_barrier_post((unsigned*)(ctl + CW_BAR), MISC + 8);
    const int lo = args.ph_lo, hi = args.ph_hi;
#ifdef ONLY_PHASE
#define IN(k) ((k) == ONLY_PHASE)
#else
#define IN(k) (lo <= (k) && (k) < hi)
#endif
#ifdef PROBE_BAR2
#define SEAM(k) do { if (IN(k) && IN((k) + 1)) { xcd_barrier(bar); xcd_barrier(bar); } } while (0)
#else
#define SEAM(k) do { if (IN(k) && IN((k) + 1)) xcd_barrier(bar); } while (0)
#endif
    float* ssq = (float*)(ws + WS_SSQ);
    bf16* Wt_out = (bf16*)(ws + WS_WOUT); bf16* hbuf = (bf16*)(ws + WS_HBUF); bf16* proj = (bf16*)(ws + WS_PROJ); bf16* act = (bf16*)(ws + WS_PROJ);
    bf16* Wt_in = (bf16*)(ws + WS_WIN); bf16* Wt_gu = (bf16*)(ws + WS_WGU); bf16* Wt_dn = (bf16*)(ws + WS_WDN);
    bf16* w2T = (bf16*)(ws + WS_W2T); bf16* a2T = (bf16*)(ws + WS_A2T); bf16* g2T = (bf16*)(ws + WS_G2T);
    const float* x_prompt = args.in[0]; const float* x_sample = args.in[1];
    const int gw = blockIdx.x * NWAVES + wave, NGW = G * NWAVES;

    if (IN(0)) _Pragma("unroll") for (int _r = 0; _r < 1 + ((REP_MASK >> 0) & 1); ++_r) {
        LAS float* scr = (LAS float*)(lds + RING_OFF + wave * 16384);
        constexpr int I_IN = 64 * (IN_W / 32);
        for (int it = gw; it < I_IN; it += NGW) p0_transpose_item(args.in[8], 4096, IN_W, Wt_in, scr, it, lane, RmId{});
        for (int i = blockIdx.x * 512 + tid; i < 2048 * 448; i += G * 512) {
            if (i < 2048 * 96) { const int c = i / 96, j = i - c * 96; w2T[i] = (bf16)f2bf(args.in[15][j * 2048 + c]); }
            else if (i < 2048 * 192) { const int ii = i - 2048 * 96; const int c = ii / 96, j = ii - c * 96; a2T[ii] = (bf16)f2bf(args.in[17][j * 2048 + c]); }
            else { const int ii = i - 2048 * 192; const int c = ii >> 8, j = ii & 255; g2T[ii] = (bf16)f2bf(args.in[18][j * 2048 + c]); }
        }
        for (int i = blockIdx.x * 512 + tid; i < 32 * 4096 / 8; i += G * 512) ((GAS v4u*)(Wt_in + (size_t)IN_W * 4096))[i] = (v4u){0u, 0u, 0u, 0u};
        for (int m = gw; m < MPAD; m += NGW) {
            bf16* orow = hbuf + (size_t)m * 4096;
            if (m < M_REAL) { const float* xrow = m < M_PROMPT ? x_prompt + (size_t)m * 4096 : x_sample + (size_t)(m - M_PROMPT) * 4096;
                const GAS f32x4* xr = (const GAS f32x4*)xrow + lane; f32x4 v[16];
#pragma unroll
                for (int j = 0; j < 16; ++j) v[j] = xr[64 * j];
                rms_row_to_bf16(v, args.in[6], orow, lane); }
            else { GAS v2u* o8 = (GAS v2u*)orow + lane;
#pragma unroll
                for (int j = 0; j < 16; ++j) o8[64 * j] = (v2u){0u, 0u}; }
        }
    }
    SEAM(0);
    if (IN(1)) _Pragma("unroll") for (int _r = 0; _r < 1 + ((REP_MASK >> 1) & 1); ++_r) {
        pg8::Gemm g{hbuf, Wt_in, MPAD, IN_WP, 4096, 4096, 4096}; pg8::StaticOrder S; S.init(MPAD, IN_WP, G, (int)blockIdx.x);
        pg8::EpiBf16Plain E{proj, IN_WP};
        STAGGER(STAG_US1);
        pg8::gemm_phase<pg8::EpiBf16Plain, pg8::StaticOrder, GP_ALIGN, GP_SP2>(lds + RING_OFF, g, S, E);
    }
#ifdef PROBE_GEMM_RESIDENT
    if (IN(1)) {
        struct ProbeOrder : pg8::StaticOrder { __device__ bool next(int i, pg8::Unit& u) const { if (i >= 15) return false;
#ifdef PROBE_SPREAD
            const int L = i * G + c; u.pm = L & 31; u.pn = (L >> 5) % 58;
#else
            u.pm = c & 7; u.pn = (c >> 3) & 3;
#endif
            u.ko = 0; u.pi = 0; return true; } };
#ifndef PROBE_LD
#define PROBE_LD 4096
#endif
        pg8::Gemm g{hbuf, Wt_in, MPAD, IN_WP, 4096, PROBE_LD, PROBE_LD}; ProbeOrder S; S.init(MPAD, IN_WP, G, (int)blockIdx.x);
#ifdef PROBE_SINK
        pg8::EpiSink E{};
        pg8::gemm_phase<pg8::EpiSink, ProbeOrder, GP_ALIGN, GP_SP2>(lds + RING_OFF, g, S, E);
#elif defined(PROBE_PAIR)
        pg8::EpiPair E{Wt_gu, IN_WP};
        pg8::gemm_phase<pg8::EpiPair, ProbeOrder, GP_ALIGN, GP_SP2>(lds + RING_OFF, g, S, E);
#elif defined(PROBE_ROWS)
        pg8::EpiRows E{Wt_gu, IN_WP};
        pg8::gemm_phase<pg8::EpiRows, ProbeOrder, GP_ALIGN, GP_SP2>(lds + RING_OFF, g, S, E);
#elif defined(PROBE_TILE)
        pg8::EpiTile E{Wt_gu, IN_WP};
        pg8::gemm_phase<pg8::EpiTile, ProbeOrder, GP_ALIGN, GP_SP2>(lds + RING_OFF, g, S, E);
#elif defined(PROBE_CONTIG)
        pg8::EpiContig E{Wt_gu, IN_WP};
        pg8::gemm_phase<pg8::EpiContig, ProbeOrder, GP_ALIGN, GP_SP2>(lds + RING_OFF, g, S, E);
#else
#ifndef PROBE_LDC
#define PROBE_LDC IN_WP
#endif
        pg8::EpiBf16Plain E{Wt_gu, PROBE_LDC};
        pg8::gemm_phase<pg8::EpiBf16Plain, ProbeOrder, GP_ALIGN, GP_SP2>(lds + RING_OFF, g, S, E);
#endif
    }
#endif
    SEAM(1);
    MixPtrs P; P.proj = proj; P.mix = hbuf; P.state_dn = args.in[2]; P.cache_conv = args.in[3]; P.state_rw = args.in[4]; P.cache_shift = args.in[5];
    P.conv_w = args.in[9]; P.a_log = args.in[10]; P.dt_bias = args.in[11]; P.dn_norm_w = args.in[12];
    P.mu = args.in[13]; P.w0 = args.in[14]; P.w2 = args.in[15]; P.a0 = args.in[16]; P.a2 = args.in[17]; P.g2 = args.in[18]; P.k_k = args.in[19]; P.k_a = args.in[20]; P.r_k = args.in[21];
    P.ln_w = args.in[22]; P.ln_b = args.in[23]; P.out = args.out;
    DnRec R; R.rec = (unsigned char*)args.out; R.qk = ws + WS_DNQK; R.gl = (float*)(ws + WS_DNGL);
    RwRec W; W.pq = ws + WS_RWPQ; W.rp = ws + WS_RWRP; W.oo = ws + WS_RWOO; W.sb = (float*)(ws + WS_RWSB); W.w2T = w2T; W.a2T = a2T; W.g2T = g2T;
    if (IN(2)) _Pragma("unroll") for (int _r = 0; _r < 1 + ((REP_MASK >> 2) & 1); ++_r) {
#ifndef REP_DNP
#define REP_DNP 0
#endif
#ifndef REP_RWP
#define REP_RWP 0
#endif
        for (int _q = 0; _q <= REP_DNP; ++_q)
        { int cwh = -1;
        for (int it = blockIdx.x; it < 4096; it += G) { if ((it & 15) != cwh) { cwh = it & 15; dn_stage_conv(P, lds + RING_OFF, cwh, tid); }
            dn_prep_item(P, R, lds + RING_OFF, it >> 11, (it >> 4) & 127, it & 15, tid, lane, wave); } }
        for (int _q = 0; _q <= REP_RWP; ++_q) {
            RwRaw raw; { const int it = blockIdx.x; rw_prep_issue(P, raw, it >> 12, (it >> 5) & 127, it & 31, tid, lane, wave); }
            int rch = blockIdx.x & 31; rw_stage_consts(P, W, lds + RING_OFF, rch, tid);
            for (int it = blockIdx.x; it < 8192; it += G) { const int nx = it + G; const bool hn = nx < 8192;
                if ((G & 31) != 0 && (it & 31) != rch) { rch = it & 31; rw_stage_consts(P, W, lds + RING_OFF, rch, tid); }
#ifdef PROBE_FRONT
                rw_prep_item<true>(P, W, lds + RING_OFF, it >> 12, (it >> 5) & 127, it & 31, raw, hn ? (nx >> 12) : -1, (nx >> 5) & 127, nx & 31, tid, lane, wave);
#endif
                rw_prep_item(P, W, lds + RING_OFF, it >> 12, (it >> 5) & 127, it & 31, raw, hn ? (nx >> 12) : -1, (nx >> 5) & 127, nx & 31, tid, lane, wave); }
        }
    }
    SEAM(2);
    if (IN(3)) _Pragma("unroll") for (int _r = 0; _r < 1 + ((REP_MASK >> 3) & 1); ++_r) {
        const int wg = blockIdx.x;
#ifndef REP_DNSCAN
#define REP_DNSCAN 0
#endif
#ifndef REP_SAMPLES
#define REP_SAMPLES 0
#endif
        if (wg < 32) { _Pragma("unroll 1") for (int _q = 0; _q <= REP_DNSCAN; ++_q) dn_scan(P, R, lds + RING_OFF, wg >> 4, wg & 15, tid, lane, wave); }
        else if (wg < 96) rw_scan(P, W, lds + RING_OFF, (wg - 32) >> 5, (wg - 32) & 31, tid, lane, wave);
        else {
            _Pragma("unroll 1") for (int _q = 0; _q <= REP_SAMPLES; ++_q)
            for (int it = wg - 96; it < 384; it += G - 96) {
                if (it < 128) dn_seq_item(P, lds + RING_OFF, 2 + (it >> 4), it & 15, tid, lane, wave);
                else rw_seq_item(P, w2T, a2T, g2T, lds + RING_OFF, 2 + ((it - 128) >> 5), (it - 128) & 31, tid, lane, wave);
            }
        }
#ifndef PARK_FROM
#define PARK_FROM 32
#endif
        if (wg >= PARK_FROM) {
            const int pw = wg - PARK_FROM, npw = G - PARK_FROM;
#ifdef PROBE_PARK2
            _Pragma("unroll 1") for (int _pk = 0; _pk < 2; ++_pk) {
#else
            {
#endif
#ifdef PROBE_GATE2
            _Pragma("unroll 1") for (int _g2 = 0; _g2 < 2; ++_g2)
#endif
            for (int it = pw; it < 1024; it += npw) rw_gate_item(P, W, lds + RING_OFF, it >> 9, (it >> 2) & 127, it & 3, tid, lane, wave);
            LAS float* scr = (LAS float*)(lds + RING_OFF + wave * 16384);
            for (int it = pw * NWAVES + wave; it < 64 * 128; it += npw * NWAVES) p0_transpose_item(args.in[24], 4096, 4096, Wt_out, scr, it, lane, RmId{});
            for (int it = pw * NWAVES + wave; it < (D_FF / 64) * 98; it += npw * NWAVES) { const int kb = it / 98, nb = 30 + it % 98; p0_transpose_item(args.in[29], D_FF, 4096, Wt_dn, scr, kb * 128 + nb, lane, RmId{}); }
            __syncthreads();
            }
        }
    }
    SEAM(3);
    if (IN(4)) _Pragma("unroll") for (int _r = 0; _r < 1 + ((REP_MASK >> 4) & 1); ++_r) {
        for (int task = gw; task < 8192 * 8; task += NGW) rw_post_task(P, W, task >> 3, task & 7, lane);
        LAS float* scr = (LAS float*)(lds + RING_OFF + wave * 16384);
        constexpr int I_G = 64 * (D_FF / 32), I_D = (D_FF / 64) * 30;
        for (int it = gw; it < 2 * I_G + I_D; it += NGW) {
            if (it < I_G) p0_transpose_item(args.in[27], 4096, D_FF, Wt_gu, scr, it, lane, RmGU{0});
            else if (it < 2 * I_G) p0_transpose_item(args.in[28], 4096, D_FF, Wt_gu, scr, it - I_G, lane, RmGU{1});
            else { const int r = it - 2 * I_G; const int kb = r / 30, nb = r % 30; p0_transpose_item(args.in[29], D_FF, 4096, Wt_dn, scr, kb * 128 + nb, lane, RmId{}); }
        }
        __syncthreads();
    }
    SEAM(4);
    if (IN(5)) _Pragma("unroll") for (int _r = 0; _r < 1 + ((REP_MASK >> 5) & 1); ++_r) {
#ifdef OLD_TAILS
        { pg8::Gemm g{hbuf, Wt_out, MPAD, 4096, 4096, 4096, 4096}; pg8::StaticOrder S; S.init(MPAD, 4096, G, (int)blockIdx.x);
        pg8::EpiF32Ssq E{args.out + O_Y, 4096, ssq, M_REAL};
        pg8::gemm_phase<pg8::EpiF32Ssq, pg8::StaticOrder, GP_ALIGN, GP_SP2>(lds + RING_OFF, g, S, E); }
#else
        pg8::Gemm g{hbuf, Wt_out, M_PROMPT, 4096, 4096, 4096, 4096}; pg8::StaticOrder S; S.init(M_PROMPT, 4096, G, (int)blockIdx.x);
        pg8::EpiBf16Ssq E{proj, 4096, ssq};
        STAGGER(STAG_US2);
        pg8::gemm_phase<pg8::EpiBf16Ssq, pg8::StaticOrder, GP_ALIGN, GP_SP2>(lds + RING_OFF, g, S, E);
        pg8::Gemm gt{hbuf, Wt_out, MPAD, 4096, 256, 4096, 4096}; pg8::TailOrder St{16 * 16, G, (int)blockIdx.x, 0, 256, 0};
        pg8::EpiF32Part Et{(float*)(ws + WS_PART2), 4096};
        pg8::gemm_phase<pg8::EpiF32Part, pg8::TailOrder, GP_ALIGN, GP_SP2>(lds + RING_OFF, gt, St, Et);
#endif
    }
    SEAM(5);
    if (IN(6)) _Pragma("unroll") for (int _r = 0; _r < 1 + ((REP_MASK >> 6) & 1); ++_r) {
        for (int m = gw; m < M_REAL; m += NGW) {
            const float* xrow = m < M_PROMPT ? x_prompt + (size_t)m * 4096 : x_sample + (size_t)(m - M_PROMPT) * 4096;
            const GAS f32x4* xr = (const GAS f32x4*)xrow + lane; GAS f32x4* tr = (GAS f32x4*)(args.out + O_Y + (size_t)m * 4096) + lane; const GAS f32x4* gr = (const GAS f32x4*)args.in[7] + lane;
            f32x4 v[16]; float s = 0.f;
#ifdef OLD_TAILS
            const bool smp = false;
#else
            const bool smp = m >= M_PROMPT;
#endif
            if (smp) {
                const GAS f32x4* pp = (const GAS f32x4*)(ws + WS_PART2) + (size_t)(m - M_PROMPT) * 1024 + lane;
#pragma unroll
                for (int j = 0; j < 16; ++j) { f32x4 t[16];
#pragma unroll
                    for (int sp = 0; sp < 16; ++sp) t[sp] = pp[(size_t)sp * 128 * 1024 + 64 * j];
                    const f32x4 a = ((t[0] + t[1]) + (t[2] + t[3])) + ((t[4] + t[5]) + (t[6] + t[7])) + (((t[8] + t[9]) + (t[10] + t[11])) + ((t[12] + t[13]) + (t[14] + t[15])));
                    v[j] = a; s += (a.x * a.x + a.y * a.y) + (a.z * a.z + a.w * a.w); }
            } else {
                const GAS v2u* tb = (const GAS v2u*)(proj + (size_t)m * 4096) + lane; v2u tv[16];
#pragma unroll
                for (int j = 0; j < 16; ++j) tv[j] = tb[64 * j];
#pragma unroll
                for (int j = 0; j < 16; ++j) { v[j].x = bflo(tv[j].x); v[j].y = bfhi(tv[j].x); v[j].z = bflo(tv[j].y); v[j].w = bfhi(tv[j].y); }
                s = ssq[(size_t)m * 64 + lane];
            }
            s = wave_sum(s);
            const float rstd = 1.0f / sqrtf(s * (1.f / 4096.f) + NORM_EPS);
#pragma unroll
            for (int hh = 0; hh < 2; ++hh) { f32x4 xv[8], gv[8];
#pragma unroll
                for (int j = 0; j < 8; ++j) { xv[j] = xr[64 * (8 * hh + j)]; gv[j] = gr[64 * (8 * hh + j)]; }
#pragma unroll
                for (int j = 0; j < 8; ++j) { const f32x4 x1 = xv[j] + v[8 * hh + j] * rstd * gv[j]; v[8 * hh + j] = x1;
                    if (smp) tr[64 * (8 * hh + j)] = x1;
                    else { v2u o; o.x = cvt2(x1.x, x1.y); o.y = cvt2(x1.z, x1.w); ((GAS v2u*)(ws + WS_X1B) + (size_t)m * 1024 + lane)[64 * (8 * hh + j)] = o; } } }
            rms_row_to_bf16(v, args.in[25], hbuf + (size_t)m * 4096, lane);
        }
    }
    SEAM(6);
    if (IN(7)) _Pragma("unroll") for (int _r = 0; _r < 1 + ((REP_MASK >> 7) & 1); ++_r) {
        pg8::Gemm g{hbuf, Wt_gu, MPAD, 2 * D_FF, 4096, 4096, 4096}; pg8::StaticOrder S; S.init(MPAD, 2 * D_FF, G, (int)blockIdx.x);
        pg8::EpiSwiGLU E{act, D_FF};
        STAGGER(STAG_US3);
        pg8::gemm_phase<pg8::EpiSwiGLU, pg8::StaticOrder, GP_ALIGN, GP_SP2>(lds + RING_OFF, g, S, E);
    }
    SEAM(7);
    if (IN(8)) _Pragma("unroll") for (int _r = 0; _r < 1 + ((REP_MASK >> 8) & 1); ++_r) {
#ifdef OLD_TAILS
        { pg8::Gemm g{act, Wt_dn, MPAD, 4096, D_FF, D_FF, D_FF}; pg8::StaticOrder S; S.init(MPAD, 4096, G, (int)blockIdx.x);
        pg8::EpiBf16Ssq E{hbuf, 4096, ssq};
        pg8::gemm_phase<pg8::EpiBf16Ssq, pg8::StaticOrder, GP_ALIGN, GP_SP2>(lds + RING_OFF, g, S, E); }
#else
        pg8::Gemm g{act, Wt_dn, M_PROMPT, 4096, D_FF, D_FF, D_FF}; pg8::StaticOrder S; S.init(M_PROMPT, 4096, G, (int)blockIdx.x);
        pg8::EpiBf16Ssq E{hbuf, 4096, ssq};
        STAGGER(STAG_US4);
        pg8::gemm_phase<pg8::EpiBf16Ssq, pg8::StaticOrder, GP_ALIGN, GP_SP2>(lds + RING_OFF, g, S, E);
#ifdef REP_G4MAIN
        pg8::gemm_phase<pg8::EpiBf16Ssq, pg8::StaticOrder, GP_ALIGN, GP_SP2>(lds + RING_OFF, g, S, E);
#endif
        pg8::EpiF32Part Et{(float*)(ws + WS_PART4), 4096};
        pg8::Gemm ga{act, Wt_dn, MPAD, 4096, 768, D_FF, D_FF}; pg8::TailOrder Sa{16 * 6, G, (int)blockIdx.x - 160, 0, 768, 0};
        pg8::gemm_phase<pg8::EpiF32Part, pg8::TailOrder, GP_ALIGN, GP_SP2>(lds + RING_OFF, ga, Sa, Et);
        pg8::Gemm gb{act, Wt_dn, MPAD, 4096, 640, D_FF, D_FF}; pg8::TailOrder Sb{16 * 10, G, (int)blockIdx.x < 160 ? (int)blockIdx.x : -1, 4608, 640, 6};
        pg8::gemm_phase<pg8::EpiF32Part, pg8::TailOrder, GP_ALIGN, GP_SP2>(lds + RING_OFF, gb, Sb, Et);
#ifdef REP_G4TAIL
        pg8::gemm_phase<pg8::EpiF32Part, pg8::TailOrder, GP_ALIGN, GP_SP2>(lds + RING_OFF, ga, Sa, Et);
        pg8::gemm_phase<pg8::EpiF32Part, pg8::TailOrder, GP_ALIGN, GP_SP2>(lds + RING_OFF, gb, Sb, Et);
#endif
#endif
    }
    SEAM(8);
    if (IN(9)) _Pragma("unroll") for (int _r = 0; _r < 1 + ((REP_MASK >> 9) & 1); ++_r) {
        for (int m = gw; m < M_REAL; m += NGW) {
            GAS f32x4* orow = (GAS f32x4*)(args.out + O_Y + (size_t)m * 4096) + lane; const GAS v2u* fr = (const GAS v2u*)(hbuf + (size_t)m * 4096) + lane; const GAS f32x4* gr = (const GAS f32x4*)args.in[26] + lane;
            f32x4 f[16]; float s = 0.f;
#ifdef OLD_TAILS
            const bool smp = false;
#else
            const bool smp = m >= M_PROMPT;
#endif
            if (smp) { const GAS f32x4* fs = (const GAS f32x4*)(ws + WS_PART4) + (size_t)(m - M_PROMPT) * 1024 + lane;
#pragma unroll
                for (int j = 0; j < 16; ++j) { f32x4 t[16];
#pragma unroll
                    for (int sp = 0; sp < 16; ++sp) t[sp] = fs[(size_t)sp * 128 * 1024 + 64 * j];
                    const f32x4 a = ((t[0] + t[1]) + (t[2] + t[3])) + ((t[4] + t[5]) + (t[6] + t[7])) + (((t[8] + t[9]) + (t[10] + t[11])) + ((t[12] + t[13]) + (t[14] + t[15])));
                    f[j] = a; s += (a.x * a.x + a.y * a.y) + (a.z * a.z + a.w * a.w); }
            } else {
                v2u fv[16];
#pragma unroll
                for (int j = 0; j < 16; ++j) fv[j] = fr[64 * j];
                s = ssq[(size_t)m * 64 + lane];
#pragma unroll
                for (int j = 0; j < 16; ++j) { f[j].x = __builtin_bit_cast(float, fv[j].x << 16); f[j].y = __builtin_bit_cast(float, fv[j].x & 0xffff0000u); f[j].z = __builtin_bit_cast(float, fv[j].y << 16); f[j].w = __builtin_bit_cast(float, fv[j].y & 0xffff0000u); }
            }
            s = wave_sum(s);
            const float rstd = 1.0f / sqrtf(s * (1.f / 4096.f) + NORM_EPS);
            const GAS v2u* xb = (const GAS v2u*)(ws + WS_X1B) + (size_t)m * 1024 + lane;
#pragma unroll
            for (int hh = 0; hh < 2; ++hh) { f32x4 xv[8], gv[8];
                if (smp) {
#pragma unroll
                    for (int j = 0; j < 8; ++j) { xv[j] = orow[64 * (8 * hh + j)]; gv[j] = gr[64 * (8 * hh + j)]; }
                } else { v2u xq[8];
#pragma unroll
                    for (int j = 0; j < 8; ++j) { xq[j] = xb[64 * (8 * hh + j)]; gv[j] = gr[64 * (8 * hh + j)]; }
#pragma unroll
                    for (int j = 0; j < 8; ++j) { xv[j].x = bflo(xq[j].x); xv[j].y = bfhi(xq[j].x); xv[j].z = bflo(xq[j].y); xv[j].w = bfhi(xq[j].y); } }
#pragma unroll
                for (int j = 0; j < 8; ++j) orow[64 * (8 * hh + j)] = xv[j] + f[8 * hh + j] * rstd * gv[j]; }
        }
    }
#undef IN
#undef SEAM
}

extern "C" void kernel_launch(void* const* d_in, const int* in_sizes, int n_in, void* d_out, int out_size, void* d_ws, size_t ws_size, hipStream_t stream) {
    static int grid = 0;
    if (grid == 0) {
        if (n_in != 30 || out_size != (int)O_END || ws_size < WS_END) { fprintf(stderr, "kernel_launch: unexpected shapes (n_in %d out %d ws %zu)\n", n_in, out_size, ws_size); grid = -1; return; }
        int dev = 0, cus = 0, per_cu = 0;
        if (hipGetDevice(&dev) != hipSuccess || hipDeviceGetAttribute(&cus, hipDeviceAttributeMultiprocessorCount, dev) != hipSuccess) { grid = -1; return; }
        if (hipFuncSetAttribute((const void*)hymba_fwd, hipFuncAttributeMaxDynamicSharedMemorySize, LDS_BYTES) != hipSuccess) { grid = -1; return; }
        if (hipOccupancyMaxActiveBlocksPerMultiprocessor(&per_cu, (const void*)hymba_fwd, NWAVES * 64, LDS_BYTES) != hipSuccess || per_cu < 1) { fprintf(stderr, "kernel_launch: occupancy query says %d\n", per_cu); }
        (void)hipGetLastError();
        grid = cus;
    }
    if (grid < 0) return;
    if (hipMemsetAsync((char*)d_ws + WS_CTL, 0, CTL_ZERO_BYTES, stream) != hipSuccess) return;
    Args a{};
    for (int i = 0; i < 30; ++i) a.in[i] = (const float*)d_in[i];
    a.out = (float*)d_out; a.ws = (unsigned char*)d_ws;
    if (MK_N_LAUNCHES == 1) { a.ph_lo = 0; a.ph_hi = NPH; hipLaunchKernelGGL(hymba_fwd, dim3(grid), dim3(NWAVES * 64), LDS_BYTES, stream, a); }
    else for (int p = 0; p < NPH; ++p) { a.ph_lo = p; a.ph_hi = p + 1; hipLaunchKernelGGL(hymba_fwd, dim3(grid), dim3(NWAVES * 64), LDS_BYTES, stream, a); }
}
```

```cpp
#include <hip/hip_runtime.h>
#include <cstdio>
#include <cstdint>

namespace pg8 {
#define PG8_LAS __attribute__((address_space(3)))
typedef unsigned short bf16_t;
typedef short bf16x8 __attribute__((ext_vector_type(8)));
typedef float f32x4 __attribute__((ext_vector_type(4)));
typedef unsigned u32x4 __attribute__((ext_vector_type(4)));
constexpr int BM = 256, BK = 64, HALF = 128, HTB = HALF * BK * 2  , STAGE_BYTES = 8 * HTB, NXCD = 8, WGM = 8;

__host__ __device__ __forceinline__ int lds_byte(int r, int c) { const int st = (r >> 4) * 2 + (c >> 5), rr = r & 15, cc = c & 31, ob = rr * 64 + cc * 2; return st * 1024 + (ob ^ (((ob >> 9) & 1) << 5)); }
__host__ __device__ __forceinline__ void stage_rc(int b, int& R, int& C) { const int st = b / 1024, sb = b % 1024, swz = sb ^ (((sb >> 9) & 1) << 5); R = (st >> 1) * 16 + swz / 64; C = (st & 1) * 32 + (swz % 64) / 2; }
__host__ __device__ __forceinline__ int perm32(int rho) { const int n = rho >> 4, i = rho & 15; return 8 * (i >> 2) + 4 * n + (i & 3); }

struct Unit { int pm, pn, ko, pi; };
struct Gemm { const bf16_t* A; const bf16_t* Bt; int M, N, K, lda, ldb; };

struct StaticOrder {
    int nM, nN, nwg, G, c;
    __host__ __device__ void init(int M, int N, int G_, int c_) { nM = M / BM; nN = N / BM; nwg = nM * nN; G = G_; c = c_; }
    __host__ __device__ bool next(int i, Unit& u) const {
        const long L = (long)i * G + c; if (L >= nwg) return false;
        int wgid = (int)L; { const int q = nwg / NXCD, r = nwg % NXCD, xcd = wgid % NXCD, off = wgid / NXCD; wgid = (xcd < r ? xcd * (q + 1) : r * (q + 1) + (xcd - r) * q) + off; }
        const int nig = WGM * nN, gid = wgid / nig, fm = gid * WGM, gsz = (nM - fm) < WGM ? (nM - fm) : WGM;
        u.pm = fm + ((wgid % nig) % gsz); u.pn = (wgid % nig) / gsz; u.ko = 0; u.pi = 0; return true;
    }
    __device__ __forceinline__ void a_ready(const Unit&) const {}
    __device__ __forceinline__ void done(const Unit&) const {}
};
__device__ __forceinline__ unsigned cvt_pk_bf16(float lo, float hi) { unsigned r; asm volatile("v_cvt_pk_bf16_f32 %0, %1, %2" : "=v"(r) : "v"(lo), "v"(hi)); return r; }

struct EpiBf16Plain {
    static constexpr bool PERM = true, AFTER_DRAIN = false;
    bf16_t* O; int ldc;
    __device__ __forceinline__ void operator()(const f32x4 (&acc)[2][2][4][2], const Unit& u, int wr, int wc, int fr, int fq) const {
        const int row0 = u.pm * BM + wr * 64 + fr, col0 = u.pn * BM + wc * 32 + 8 * fq;
#pragma unroll
        for (int ai = 0; ai < 2; ++ai)
#pragma unroll
            for (int m = 0; m < 4; ++m) { bf16_t* rowp = O + (size_t)(row0 + ai * HALF + m * 16) * ldc + col0;
#pragma unroll
                for (int bj = 0; bj < 2; ++bj) { const f32x4 v0 = acc[ai][bj][m][0], v1 = acc[ai][bj][m][1];
                    u32x4 w; w.x = cvt_pk_bf16(v0[0], v0[1]); w.y = cvt_pk_bf16(v0[2], v0[3]); w.z = cvt_pk_bf16(v1[0], v1[1]); w.w = cvt_pk_bf16(v1[2], v1[3]);
                    *(u32x4*)(rowp + bj * HALF) = w; } }
    }
};
__device__ __forceinline__ float silu_f(float x) { return x * __builtin_amdgcn_rcpf(1.0f + __expf(-x)); }
struct EpiSwiGLU {
    static constexpr bool PERM = true, AFTER_DRAIN = false;
    bf16_t* O; int ldc;
    __device__ __forceinline__ void operator()(const f32x4 (&acc)[2][2][4][2], const Unit& u, int wr, int wc, int fr, int fq) const {
        const int row0 = u.pm * BM + wr * 64 + fr, col0 = u.pn * HALF + wc * 32 + 8 * fq;
#pragma unroll
        for (int ai = 0; ai < 2; ++ai)
#pragma unroll
            for (int m = 0; m < 4; ++m) { bf16_t* rowp = O + (size_t)(row0 + ai * HALF + m * 16) * ldc + col0;
                const f32x4 g0 = acc[ai][0][m][0], g1 = acc[ai][0][m][1], u0 = acc[ai][1][m][0], u1 = acc[ai][1][m][1];
                u32x4 w; w.x = cvt_pk_bf16(silu_f(g0[0]) * u0[0], silu_f(g0[1]) * u0[1]); w.y = cvt_pk_bf16(silu_f(g0[2]) * u0[2], silu_f(g0[3]) * u0[3]);
                w.z = cvt_pk_bf16(silu_f(g1[0]) * u1[0], silu_f(g1[1]) * u1[1]); w.w = cvt_pk_bf16(silu_f(g1[2]) * u1[2], silu_f(g1[3]) * u1[3]);
                *(u32x4*)rowp = w; }
    }
};
struct EpiF32Ssq {
    static constexpr bool PERM = false, AFTER_DRAIN = false;
    float* C; int ldc; float* ssq; int mreal;
    __device__ __forceinline__ void operator()(const f32x4 (&acc)[2][2][4][2], const Unit& u, int wr, int wc, int fr, int fq) const {
        const int row0 = u.pm * BM + wr * 64 + fr, col0 = u.pn * BM + wc * 32 + 4 * fq;
#pragma unroll
        for (int ai = 0; ai < 2; ++ai)
#pragma unroll
            for (int m = 0; m < 4; ++m) { const int row = row0 + ai * HALF + m * 16; float s = 0.f;
#pragma unroll
                for (int bj = 0; bj < 2; ++bj)
#pragma unroll
                    for (int n = 0; n < 2; ++n) { const f32x4 v = acc[ai][bj][m][n]; s += (v[0] * v[0] + v[1] * v[1]) + (v[2] * v[2] + v[3] * v[3]);
                        if (row < mreal) *(f32x4*)(C + (size_t)row * ldc + col0 + bj * HALF + n * 16) = v; }
                s += __shfl_xor(s, 16); s += __shfl_xor(s, 32);
                if (fq == 0) ssq[(size_t)row * 64 + u.pn * 4 + wc] = s; }
    }
};
struct EpiBf16Ssq {
    static constexpr bool PERM = true, AFTER_DRAIN = false;
    bf16_t* O; int ldc; float* ssq;
    __device__ __forceinline__ void operator()(const f32x4 (&acc)[2][2][4][2], const Unit& u, int wr, int wc, int fr, int fq) const {
        const int row0 = u.pm * BM + wr * 64 + fr, col0 = u.pn * BM + wc * 32 + 8 * fq;
#pragma unroll
        for (int ai = 0; ai < 2; ++ai)
#pragma unroll
            for (int m = 0; m < 4; ++m) { const int row = row0 + ai * HALF + m * 16; bf16_t* rowp = O + (size_t)row * ldc + col0; float s = 0.f;
#pragma unroll
                for (int bj = 0; bj < 2; ++bj) { const f32x4 v0 = acc[ai][bj][m][0], v1 = acc[ai][bj][m][1];
                    s += (v0[0] * v0[0] + v0[1] * v0[1]) + (v0[2] * v0[2] + v0[3] * v0[3]) + (v1[0] * v1[0] + v1[1] * v1[1]) + (v1[2] * v1[2] + v1[3] * v1[3]);
                    u32x4 w; w.x = cvt_pk_bf16(v0[0], v0[1]); w.y = cvt_pk_bf16(v0[2], v0[3]); w.z = cvt_pk_bf16(v1[0], v1[1]); w.w = cvt_pk_bf16(v1[2], v1[3]);
                    *(u32x4*)(rowp + bj * HALF) = w; }
                s += __shfl_xor(s, 16); s += __shfl_xor(s, 32);
                if (fq == 0) ssq[(size_t)row * 64 + u.pn * 4 + wc] = s; }
    }
};
struct EpiSink {
    static constexpr bool PERM = true, AFTER_DRAIN = false;
    __device__ __forceinline__ void operator()(const f32x4 (&acc)[2][2][4][2], const Unit& u, int wr, int wc, int fr, int fq) const {
#pragma unroll
        for (int ai = 0; ai < 2; ++ai)
#pragma unroll
            for (int bj = 0; bj < 2; ++bj)
#pragma unroll
                for (int m = 0; m < 4; ++m)
#pragma unroll
                    for (int n = 0; n < 2; ++n) asm volatile("" :: "v"(acc[ai][bj][m][n]));
    }
};
struct EpiPair {
    static constexpr bool PERM = true, AFTER_DRAIN = false;
    bf16_t* O; int ldc;
    __device__ __forceinline__ void operator()(const f32x4 (&acc)[2][2][4][2], const Unit& u, int wr, int wc, int fr, int fq) const {
        const int row0 = u.pm * BM + wr * 64 + fr, col0 = u.pn * BM + wc * 64 + 8 * fq;
#pragma unroll
        for (int ai = 0; ai < 2; ++ai)
#pragma unroll
            for (int m = 0; m < 4; ++m) { bf16_t* rowp = O + (size_t)(row0 + ai * HALF + m * 16) * ldc + col0;
#pragma unroll
                for (int bj = 0; bj < 2; ++bj) { const f32x4 v0 = acc[ai][bj][m][0], v1 = acc[ai][bj][m][1];
                    u32x4 w; w.x = cvt_pk_bf16(v0[0], v0[1]); w.y = cvt_pk_bf16(v0[2], v0[3]); w.z = cvt_pk_bf16(v1[0], v1[1]); w.w = cvt_pk_bf16(v1[2], v1[3]);
                    *(u32x4*)(rowp + bj * 32) = w; } }
    }
};
#ifdef PROBE_ROWS
struct EpiRows {
    static constexpr bool PERM = true, AFTER_DRAIN = false;
    bf16_t* O; int ldc;
    __device__ __forceinline__ void operator()(const f32x4 (&acc)[2][2][4][2], const Unit& u, int wr, int wc, int fr, int fq) const {
        constexpr int LPR = 64 / PROBE_ROWS; const int lane = fq * 16 + fr;
        const int row0 = u.pm * BM + wr * 128 + lane / LPR, col0 = u.pn * BM + ((wc * LPR * 8) & 255) + (lane % LPR) * 8;
#pragma unroll
        for (int ai = 0; ai < 2; ++ai)
#pragma unroll
            for (int m = 0; m < 4; ++m) {
#pragma unroll
                for (int bj = 0; bj < 2; ++bj) { const f32x4 v0 = acc[ai][bj][m][0], v1 = acc[ai][bj][m][1];
                    u32x4 w; w.x = cvt_pk_bf16(v0[0], v0[1]); w.y = cvt_pk_bf16(v0[2], v0[3]); w.z = cvt_pk_bf16(v1[0], v1[1]); w.w = cvt_pk_bf16(v1[2], v1[3]);
                    *(u32x4*)(O + (size_t)(row0 + (((ai * 4 + m) * 2 + bj) * PROBE_ROWS) % 128) * ldc + col0) = w; } }
    }
};
#endif
struct EpiTile {
    static constexpr bool PERM = true, AFTER_DRAIN = false;
    bf16_t* O; int ldc;
    __device__ __forceinline__ void operator()(const f32x4 (&acc)[2][2][4][2], const Unit& u, int wr, int wc, int fr, int fq) const {
        bf16_t* base = O + (size_t)(u.pm * 58 + u.pn) * 65536 + (wr * 64 + fr) * 256 + wc * 32 + 8 * fq;
#pragma unroll
        for (int ai = 0; ai < 2; ++ai)
#pragma unroll
            for (int m = 0; m < 4; ++m) { bf16_t* rowp = base + (ai * HALF + m * 16) * 256;
#pragma unroll
                for (int bj = 0; bj < 2; ++bj) { const f32x4 v0 = acc[ai][bj][m][0], v1 = acc[ai][bj][m][1];
                    u32x4 w; w.x = cvt_pk_bf16(v0[0], v0[1]); w.y = cvt_pk_bf16(v0[2], v0[3]); w.z = cvt_pk_bf16(v1[0], v1[1]); w.w = cvt_pk_bf16(v1[2], v1[3]);
                    *(u32x4*)(rowp + bj * HALF) = w; } }
    }
};
struct EpiContig {
    static constexpr bool PERM = true, AFTER_DRAIN = false;
    bf16_t* O; int ldc;
    __device__ __forceinline__ void operator()(const f32x4 (&acc)[2][2][4][2], const Unit& u, int wr, int wc, int fr, int fq) const {
        char* base = (char*)O + ((size_t)(u.pm * 58 + u.pn) * 8 + (wr * 4 + wc)) * 16384 + (fq * 16 + fr) * 16;
#pragma unroll
        for (int ai = 0; ai < 2; ++ai)
#pragma unroll
            for (int m = 0; m < 4; ++m) {
#pragma unroll
                for (int bj = 0; bj < 2; ++bj) { const f32x4 v0 = acc[ai][bj][m][0], v1 = acc[ai][bj][m][1];
                    u32x4 w; w.x = cvt_pk_bf16(v0[0], v0[1]); w.y = cvt_pk_bf16(v0[2], v0[3]); w.z = cvt_pk_bf16(v1[0], v1[1]); w.w = cvt_pk_bf16(v1[2], v1[3]);
                    *(u32x4*)(base + ((ai * 4 + m) * 2 + bj) * 1024) = w; } }
    }
};
struct EpiF32Part {
    static constexpr bool PERM = false, AFTER_DRAIN = false;
    float* P; int ldc;
    __device__ __forceinline__ void operator()(const f32x4 (&acc)[2][2][4][2], const Unit& u, int wr, int wc, int fr, int fq) const {
        const int rowl = wr * 64 + fr, col0 = u.pn * BM + wc * 32 + 4 * fq; float* base = P + (size_t)u.pi * 128 * ldc;
#pragma unroll
        for (int m = 0; m < 4; ++m)
#pragma unroll
            for (int bj = 0; bj < 2; ++bj)
#pragma unroll
                for (int n = 0; n < 2; ++n) *(f32x4*)(base + (size_t)(rowl + m * 16) * ldc + col0 + bj * HALF + n * 16) = acc[0][bj][m][n];
    }
};
struct TailOrder {
    int nsub, G, c, kbase, klen, pbase;
    __device__ bool next(int i, Unit& u) const { const int idx = i * G + c; if (c < 0 || idx >= nsub) return false; const int sp = idx >> 4; u.pm = 64; u.pn = idx & 15; u.ko = kbase + sp * klen; u.pi = pbase + sp; return true; }
    __device__ __forceinline__ void a_ready(const Unit&) const {}
    __device__ __forceinline__ void done(const Unit&) const {}
};
struct SubsetOrder {
    int nN, nunits, nw, c;
    __device__ bool next(int i, Unit& u) const { const int idx = i * nw + c; if (c < 0 || idx >= nunits) return false; u.pm = idx / nN; u.pn = idx - u.pm * nN; u.ko = 0; u.pi = 0; return true; }
    __device__ __forceinline__ void a_ready(const Unit&) const {}
    __device__ __forceinline__ void done(const Unit&) const {}
};
template <class Epi, class Sched, bool ALIGN_EPI = false, bool SP2 = false>
__device__ __forceinline__ void gemm_phase(PG8_LAS unsigned char* lds, const Gemm g, const Sched& S, const Epi& E) {
    const int tid = threadIdx.x, wid = __builtin_amdgcn_readfirstlane(tid >> 6), lane = tid & 63, wr = wid >> 2, wc = wid & 3, fr = lane & 15, fq = lane >> 4;
    const int K = g.K, nt = K / BK;
    unsigned voffA[2], voffB[2];
#pragma unroll
    for (int i = 0; i < 2; ++i) { int R, C; stage_rc(tid * 16 + i * 8192, R, C); const int Rb = Epi::PERM ? ((R & ~31) + perm32(R & 31)) : R;
        voffA[i] = (unsigned)(R * g.lda + C) * 2u; voffB[i] = (unsigned)(Rb * g.ldb + C) * 2u; }
    const size_t kstep = (size_t)(BK * 2);
    const size_t hstepA = (size_t)HALF * g.lda * 2, hstepB = (size_t)HALF * g.ldb * 2;
    const size_t tstepA = 2 * hstepA, tstepB = 2 * hstepB;
    const unsigned ldsw = (unsigned)wid * 1024u;
    const int aoff = lds_byte(wr * 64 + fr, fq * 8), boff = lds_byte(wc * 32 + fr, fq * 8);
#define PG8_SA(b, h) (((b) * 2 + (h)) * HTB)
#define PG8_SB(b, h) ((4 + (b) * 2 + (h)) * HTB)
#define PG8_STAGE(bufoff, gbase, voff) do { _Pragma("unroll") for (int _i = 0; _i < 2; ++_i) \
        __builtin_amdgcn_global_load_lds((const unsigned*)((const char*)(gbase) + (voff)[_i]), (PG8_LAS unsigned*)(lds + (bufoff) + ldsw + _i * 8192), 16, 0, 0); } while (0)
#define PG8_LDA(dst, b, h) do { _Pragma("unroll") for (int m = 0; m < 4; ++m) _Pragma("unroll") for (int k = 0; k < 2; ++k) dst[m][k] = *(const PG8_LAS bf16x8*)(lds + PG8_SA(b, h) + aoff + m * 2048 + k * 1024); } while (0)
#define PG8_LDB(dst, b, h) do { _Pragma("unroll") for (int n = 0; n < 2; ++n) _Pragma("unroll") for (int k = 0; k < 2; ++k) dst[n][k] = *(const PG8_LAS bf16x8*)(lds + PG8_SB(b, h) + boff + n * 2048 + k * 1024); } while (0)
#ifndef PG8_PRIO
#define PG8_PRIO 3
#endif
#define PG8_MMA(ai, bj, At, Bt) do { if (PG8_PRIO) __builtin_amdgcn_s_setprio(PG8_PRIO); _Pragma("unroll") for (int m = 0; m < 4; ++m) _Pragma("unroll") for (int n = 0; n < 2; ++n) _Pragma("unroll") for (int k = 0; k < 2; ++k) \
        acc[ai][bj][m][n] = __builtin_amdgcn_mfma_f32_16x16x32_bf16(Bt[n][k], At[m][k], acc[ai][bj][m][n], 0, 0, 0); if (PG8_PRIO) __builtin_amdgcn_s_setprio(0); } while (0)
#define PG8_WAIT_V(n) asm volatile("s_waitcnt vmcnt(" #n ")" ::: "memory")
#define PG8_WAIT_L(n) asm volatile("s_waitcnt lgkmcnt(" #n ")" ::: "memory")
#define PG8_BAR __builtin_amdgcn_s_barrier()
#define PG8_SCHED __builtin_amdgcn_sched_barrier(0)
    Unit cur, nxt; int ui = 0;
    if (!S.next(0, cur)) return;
    f32x4 acc[2][2][4][2];
#pragma unroll
    for (int a = 0; a < 2; ++a)
#pragma unroll
        for (int b = 0; b < 2; ++b)
#pragma unroll
            for (int m = 0; m < 4; ++m)
#pragma unroll
                for (int n = 0; n < 2; ++n) acc[a][b][m][n] = (f32x4){0.f, 0.f, 0.f, 0.f};
    bf16x8 At[4][2], B0[2][2], B1[2][2];
    const char* cA = (const char*)g.A + (size_t)cur.pm * tstepA + (size_t)cur.ko * 2; const char* cB = (const char*)g.Bt + (size_t)cur.pn * tstepB + (size_t)cur.ko * 2;
    S.a_ready(cur);
    if constexpr (SP2) {
        PG8_STAGE(PG8_SB(0, 0), cB, voffB); PG8_STAGE(PG8_SB(0, 1), cB + hstepB, voffB); PG8_STAGE(PG8_SA(0, 0), cA, voffA); PG8_STAGE(PG8_SA(0, 1), cA + hstepA, voffA);
        if (wr == 1) PG8_BAR;
        PG8_WAIT_V(2); PG8_BAR;
        PG8_STAGE(PG8_SB(1, 0), cB + kstep, voffB); PG8_STAGE(PG8_SA(1, 0), cA + kstep, voffA); PG8_STAGE(PG8_SB(1, 1), cB + hstepB + kstep, voffB);
        PG8_WAIT_V(6); PG8_BAR;
    } else {
        PG8_STAGE(PG8_SB(0, 0), cB, voffB); PG8_STAGE(PG8_SA(0, 0), cA, voffA); PG8_STAGE(PG8_SB(0, 1), cB + hstepB, voffB); PG8_STAGE(PG8_SA(0, 1), cA + hstepA, voffA);
        if (wr == 1) PG8_BAR;
        PG8_WAIT_V(4); PG8_BAR;
        PG8_STAGE(PG8_SB(1, 0), cB + kstep, voffB); PG8_STAGE(PG8_SA(1, 0), cA + kstep, voffA); PG8_STAGE(PG8_SB(1, 1), cB + hstepB + kstep, voffB);
        PG8_WAIT_V(6); PG8_BAR;
    }
    for (;;) {
        const bool has_next = S.next(ui + 1, nxt);
        const char* nA = has_next ? (const char*)g.A + (size_t)nxt.pm * tstepA + (size_t)nxt.ko * 2 : cA; const char* nB = has_next ? (const char*)g.Bt + (size_t)nxt.pn * tstepB + (size_t)nxt.ko * 2 : cB;
        for (int t = 0; t < nt; t += 2) {
            const bool last = (t == nt - 2);
            const char* a1 = cA + (size_t)(t + 1) * kstep;
            const char* a2 = last ? nA : cA + (size_t)(t + 2) * kstep; const char* b2 = last ? nB : cB + (size_t)(t + 2) * kstep;
            const char* a3 = a2 + kstep; const char* b3 = b2 + kstep;
            if (last && has_next) S.a_ready(nxt);
            if constexpr (SP2) {
            PG8_LDB(B0, 0, 0); PG8_LDB(B1, 0, 1); PG8_SCHED; PG8_LDA(At, 0, 0); PG8_STAGE(PG8_SA(1, 1), a1 + hstepA, voffA);
            PG8_WAIT_V(8); PG8_WAIT_L(0); PG8_BAR; PG8_MMA(0, 0, At, B0); PG8_MMA(0, 1, At, B1); PG8_BAR; PG8_SCHED;
            PG8_LDA(At, 0, 1); PG8_STAGE(PG8_SB(0, 0), b2, voffB); PG8_STAGE(PG8_SB(0, 1), b2 + hstepB, voffB); PG8_STAGE(PG8_SA(0, 0), a2, voffA);
            PG8_WAIT_V(8); PG8_WAIT_L(0); PG8_BAR; PG8_MMA(1, 0, At, B0); PG8_MMA(1, 1, At, B1); PG8_BAR; PG8_SCHED;
            PG8_LDB(B0, 1, 0); PG8_LDB(B1, 1, 1); PG8_SCHED; PG8_LDA(At, 1, 0); PG8_STAGE(PG8_SA(0, 1), a2 + hstepA, voffA);
            PG8_WAIT_V(8); PG8_WAIT_L(0); PG8_BAR; PG8_MMA(0, 0, At, B0); PG8_MMA(0, 1, At, B1); PG8_BAR; PG8_SCHED;
            PG8_LDA(At, 1, 1); PG8_STAGE(PG8_SB(1, 0), b3, voffB); PG8_STAGE(PG8_SB(1, 1), b3 + hstepB, voffB); PG8_STAGE(PG8_SA(1, 0), a3, voffA);
            PG8_WAIT_V(8); PG8_WAIT_L(0); PG8_BAR; PG8_MMA(1, 0, At, B0); PG8_MMA(1, 1, At, B1); PG8_BAR; PG8_SCHED;
            } else {
            PG8_LDB(B0, 0, 0); PG8_SCHED; PG8_LDA(At, 0, 0); PG8_STAGE(PG8_SA(1, 1), a1 + hstepA, voffA);
            PG8_WAIT_L(8); PG8_BAR; PG8_WAIT_L(0); PG8_MMA(0, 0, At, B0); PG8_BAR; PG8_SCHED;
            PG8_LDB(B1, 0, 1); PG8_STAGE(PG8_SB(0, 0), b2, voffB);
            PG8_BAR; PG8_WAIT_L(0); PG8_MMA(0, 1, At, B1); PG8_BAR;
            PG8_LDA(At, 0, 1); PG8_STAGE(PG8_SA(0, 0), a2, voffA);
            PG8_BAR; PG8_WAIT_L(0); PG8_MMA(1, 0, At, B0); PG8_BAR; PG8_SCHED;
            PG8_STAGE(PG8_SB(0, 1), b2 + hstepB, voffB);
            PG8_WAIT_V(6); PG8_BAR; PG8_MMA(1, 1, At, B1); PG8_BAR;
            PG8_LDB(B0, 1, 0); PG8_SCHED; PG8_LDA(At, 1, 0); PG8_STAGE(PG8_SA(0, 1), a2 + hstepA, voffA);
            PG8_WAIT_L(8); PG8_BAR; PG8_WAIT_L(0); PG8_MMA(0, 0, At, B0); PG8_BAR; PG8_SCHED;
            PG8_LDB(B1, 1, 1); PG8_STAGE(PG8_SB(1, 0), b3, voffB);
            PG8_BAR; PG8_WAIT_L(0); PG8_MMA(0, 1, At, B1); PG8_BAR;
            PG8_LDA(At, 1, 1); PG8_STAGE(PG8_SA(1, 0), a3, voffA);
            PG8_BAR; PG8_WAIT_L(0); PG8_MMA(1, 0, At, B0); PG8_BAR; PG8_SCHED;
            PG8_STAGE(PG8_SB(1, 1), b3 + hstepB, voffB);
            PG8_WAIT_V(6); PG8_BAR; PG8_MMA(1, 1, At, B1); PG8_BAR;
            }
        }
        if constexpr (ALIGN_EPI) { if (wr == 0) PG8_BAR; }
        if constexpr (!Epi::AFTER_DRAIN) { E(acc, cur, wr, wc, fr, fq); S.done(cur); }
        if (!has_next) break;
#pragma unroll
        for (int a = 0; a < 2; ++a)
#pragma unroll
            for (int b = 0; b < 2; ++b)
#pragma unroll
                for (int m = 0; m < 4; ++m)
#pragma unroll
                    for (int n = 0; n < 2; ++n) acc[a][b][m][n] = (f32x4){0.f, 0.f, 0.f, 0.f};
        cur = nxt; cA = nA; cB = nB; ++ui;
        if constexpr (ALIGN_EPI) { if (wr == 1) PG8_BAR; }
    }
    PG8_WAIT_V(0);
    if constexpr (!ALIGN_EPI) { if (wr == 0) PG8_BAR; }
    PG8_BAR;
    if constexpr (Epi::AFTER_DRAIN) { E.fused(acc, cur, wr, wc, fr, fq, lds, wid, lane); S.done(cur); }
#undef PG8_SA
#undef PG8_SB
#undef PG8_STAGE
#undef PG8_LDA
#undef PG8_LDB
#undef PG8_MMA
#undef PG8_WAIT_V
#undef PG8_WAIT_L
#undef PG8_BAR
#undef PG8_SCHED
}
}

constexpr int NWAVES = 8;
constexpr int D_MODEL = 4096, SEQ = 8192, DEC_SEQ = 16;
constexpr int M_PROMPT = 16384, M_REAL = 16512, MPAD = 16640;
constexpr int IN_W = 14816, IN_WP = 14848, D_FF = 11008;
constexpr int PC_Q = 0, PC_K = 2048, PC_V = 4096, PC_Z = 6144, PC_B = 8192, PC_A = 8208, PC_RW = 8224;
constexpr int RW_R = 0, RW_K = 2048, RW_V = 4096, RW_XW = 6144, RW_XA = 6240, RW_XG = 6336, RW_SHIFT_W = 6592;
constexpr float NORM_EPS = 1e-6f, RW_GN_EPS = 64e-5f;
constexpr size_t O_Y = 0, O_SDN_P = 67633152, O_CONV_P = 68157440, O_SRW_P = 68194304, O_SHIFT_P = 68456448,
                 O_SDN_S = 68469632, O_CONV_S = 70566784, O_SRW_S = 70714240, O_SHIFT_S = 71762816, O_END = 71815552;
constexpr size_t MiB = 1u << 20;
constexpr size_t WS_CTL = 0, CTL_ZERO_BYTES = 1 * MiB;
constexpr size_t WS_SSQ = 2 * MiB;
constexpr size_t WS_W2T = 6553600, WS_A2T = WS_W2T + 2048 * 96 * 2, WS_G2T = 7 * MiB;
constexpr size_t WS_WOUT = 8 * MiB;
constexpr size_t WS_HBUF = 40 * MiB;
constexpr size_t WS_PROJ = 170 * MiB;
constexpr size_t WS_WIN = 642 * MiB;
constexpr size_t WS_WGU = 758 * MiB;
constexpr size_t WS_WDN = 930 * MiB;
constexpr size_t WS_END = 1016 * MiB;
constexpr size_t WS_X1B = 520 * MiB;
constexpr size_t WS_PART2 = 710 * MiB, WS_PART4 = 678 * MiB;
constexpr size_t WS_SXG = 742 * MiB;
constexpr size_t WS_DNQK = 642 * MiB, WS_DNGL = 674 * MiB, WS_RWSB = 675 * MiB, WS_RWOO = 678 * MiB, WS_RWPQ = 758 * MiB, WS_RWRP = 886 * MiB;
static_assert(WS_SSQ + (size_t)MPAD * 64 * 4 <= WS_WOUT && WS_HBUF + (size_t)MPAD * 4096 * 2 <= WS_PROJ && WS_PROJ + (size_t)MPAD * IN_WP * 2 <= WS_WIN &&
              WS_WIN + (size_t)IN_WP * 4096 * 2 <= WS_WGU && WS_WGU + (size_t)2 * D_FF * 4096 * 2 <= WS_WDN && WS_WDN + (size_t)4096 * D_FF * 2 <= WS_END, "d_ws map");
constexpr int CW_BAR = 4096;
constexpr int RING_OFF = 0, RING_BYTES = 131072;
constexpr int LDSCTL_OFF = RING_BYTES, MISC_OFF = LDSCTL_OFF + 320;
constexpr int LDS_BYTES = 163840;

#define GAS __attribute__((address_space(1)))
#define LAS __attribute__((address_space(3)))
typedef unsigned short bf16;
typedef unsigned v4u __attribute__((ext_vector_type(4)));
typedef unsigned v2u __attribute__((ext_vector_type(2)));
typedef float f32x4 __attribute__((ext_vector_type(4)));
typedef GAS unsigned gu32;
#define RLX_AGENT __ATOMIC_RELAXED, __HIP_MEMORY_SCOPE_AGENT
#define LDS_WAIT() asm volatile("s_waitcnt lgkmcnt(0)" ::: "memory")
__device__ __forceinline__ unsigned f2bf(float f) { unsigned u = __builtin_bit_cast(unsigned, f); return (u + 0x7fffu + ((u >> 16) & 1u)) >> 16; }
__device__ __forceinline__ unsigned pk2(float lo, float hi) { return f2bf(lo) | (f2bf(hi) << 16); }
__device__ __forceinline__ float bf2f(bf16 b) { return __builtin_bit_cast(float, (unsigned)b << 16); }
__device__ __forceinline__ float bflo(unsigned u) { return __builtin_bit_cast(float, u << 16); }
__device__ __forceinline__ float bfhi(unsigned u) { return __builtin_bit_cast(float, u & 0xffff0000u); }
#ifdef OLD_WAVE_SUM
__device__ __forceinline__ float wave_sum(float v) {
#pragma unroll
    for (int o = 1; o < 64; o <<= 1) v += __shfl_xor(v, o);
    return v;
}
#else
#define WS_DPP(x, ctrl, rmask) __builtin_bit_cast(float, __builtin_amdgcn_update_dpp(0, __builtin_bit_cast(int, (x)), (ctrl), (rmask), 0xf, true))
__device__ __forceinline__ float wave_sum(float v) {
    v += WS_DPP(v, 0xB1, 0xf); v += WS_DPP(v, 0x4E, 0xf); v += WS_DPP(v, 0x141, 0xf); v += WS_DPP(v, 0x140, 0xf);
    v += WS_DPP(v, 0x142, 0xa); v += WS_DPP(v, 0x143, 0xc);
    return __builtin_bit_cast(float, __builtin_amdgcn_readlane(__builtin_bit_cast(int, v), 63));
}
#endif
#ifdef OLD_MATH
__device__ __forceinline__ float sigmoid_f(float x) { return 1.0f / (1.0f + __expf(-x)); }
__device__ __forceinline__ float softplus_f(float x) { return x > 20.f ? x : log1pf(__expf(x)); }
#else
__device__ __forceinline__ float sigmoid_f(float x) { return __builtin_amdgcn_rcpf(1.0f + __expf(-x)); }
__device__ __forceinline__ float softplus_f(float x) { return x > 20.f ? x : __logf(1.0f + __expf(x)); }
#endif
__device__ __forceinline__ void wave_sum8(float (&v)[8]) {
#pragma unroll
    for (int o = 1; o < 64; o <<= 1) {
#pragma unroll
        for (int i = 0; i < 8; ++i) v[i] += __shfl_xor(v[i], o); }
}

#define XB_TMO      128
#define XB_XCNT(j)  (256  + 64 * (j))
#define XB_XSUB(j)  (1280 + 64 * (j))
#define XB_XGEN(j)  (2304 + 64 * (j))
#define XB_TOP      3328
#define XB_TOPGEN   3392
#define XCD_BAR_WORDS 3456
#define XB_SPIN_CAP (1u << 18)

__device__ __forceinline__ unsigned xb_ld(unsigned* p)              { return __hip_atomic_load(p, __ATOMIC_RELAXED, __HIP_MEMORY_SCOPE_AGENT); }
__device__ __forceinline__ unsigned xb_add(unsigned* p, unsigned v) { return __hip_atomic_fetch_add(p, v, __ATOMIC_RELAXED, __HIP_MEMORY_SCOPE_AGENT); }
__device__ __forceinline__ unsigned xb_xcc_id() { return (unsigned)__builtin_amdgcn_s_getreg((3 << 11) | 20) & 0xFu; }
#define XB_SPIN(cond, bar) do { unsigned _sp = 0; while (cond) { __builtin_amdgcn_s_sleep(1); \
    if ((++_sp & 255u) == 0u) { if (xb_ld(&(bar)[XB_TMO])) break; if (_sp > XB_SPIN_CAP) { atomicAdd(&(bar)[XB_TMO], 1u); break; } } } } while (0)

struct XcdBarrier {
    unsigned* bar; unsigned x;
    volatile LAS unsigned* st;
};

__device__ __forceinline__ XcdBarrier xcd_barrier_post(unsigned* bar, volatile LAS unsigned* st) {
    XcdBarrier b; b.bar = bar; b.x = xb_xcc_id(); b.st = st;
    if (threadIdx.x == 0) (void)xb_add(&bar[XB_XCNT(b.x)], 1u);
    return b;
}
__device__ __forceinline__ void xcd_barrier_complete(unsigned* bar, unsigned x, unsigned& nloc, unsigned& nx) {
    const unsigned G = gridDim.x * gridDim.y * gridDim.z;
    unsigned sum, cnt, mine, sp = 0u;
    for (;;) {
        sum = 0u; cnt = 0u; mine = 0u;
#pragma unroll
        for (unsigned j = 0; j < 16; ++j) { const unsigned c = xb_ld(&bar[XB_XCNT(j)]); sum += c; cnt += (c > 0u) ? 1u : 0u; mine = (j == x) ? c : mine; }
        if (sum == G) break;
        __builtin_amdgcn_s_sleep(1);
        if ((++sp & 255u) == 0u) { if (xb_ld(&bar[XB_TMO])) break; if (sp > XB_SPIN_CAP) { atomicAdd(&bar[XB_TMO], 1u); break; } }
    }
    nloc = mine > 0u ? mine : 1u; nx = cnt > 0u ? cnt : 1u;
}

__device__ __forceinline__ void xcd_barrier(const XcdBarrier& b) {
    asm volatile("s_waitcnt vmcnt(0)" ::: "memory");
    __syncthreads();
    if (threadIdx.x == 0) {
        unsigned* bar = b.bar;
        __builtin_amdgcn_s_waitcnt(0);
        unsigned nloc = b.st[0], nx = b.st[1];
        if (nloc == 0u) { xcd_barrier_complete(bar, b.x, nloc, nx); b.st[0] = nloc; b.st[1] = nx; }
        const unsigned old = xb_add(&bar[XB_XSUB(b.x)], 1u);
        const unsigned gen = old / nloc;
        if (old + 1u == (gen + 1u) * nloc) {
            __builtin_amdgcn_fence(__ATOMIC_RELEASE, "agent");
            asm volatile("s_waitcnt vmcnt(0)" ::: "memory");
            const unsigned og = xb_add(&bar[XB_TOP], 1u);
            const unsigned tg = og / nx;
            if (og + 1u == (tg + 1u) * nx) xb_add(&bar[XB_TOPGEN], 1u);
            else XB_SPIN(xb_ld(&bar[XB_TOPGEN]) == tg, bar);
            __builtin_amdgcn_fence(__ATOMIC_ACQUIRE, "agent");
            xb_add(&bar[XB_XGEN(b.x)], 1u);
            asm volatile("s_waitcnt vmcnt(0)" ::: "memory");
        } else {
            XB_SPIN(xb_ld(&bar[XB_XGEN(b.x)]) == gen, bar);
            __builtin_amdgcn_fence(__ATOMIC_ACQUIRE, "agent");
            asm volatile("s_waitcnt vmcnt(0)" ::: "memory");
        }
    }
    __syncthreads();
}

struct Frame {
    LAS unsigned char* lds;
    volatile LAS unsigned* MISC;
    gu32* ctl;
    int tid, lane, wave, G;
    const float* const* in;
};
struct Args { const float* in[30]; float* out; unsigned char* ws; int ph_lo, ph_hi; };

template <class RowMap>
__device__ __forceinline__ void p0_transpose_item(const float* W, int K, int N, bf16* WT, LAS float* scr, int item, int lane, RowMap rm) {
    const int nblk = N / 32, kb = item / nblk, nb = item % nblk, k0 = 64 * kb, n0 = 32 * nb;
    float wv[32];
#pragma unroll
    for (int i = 0; i < 32; ++i) { const int kk = 2 * i + (lane >> 5); wv[i] = W[(size_t)(k0 + kk) * N + n0 + (lane & 31)]; }
#pragma unroll
    for (int i = 0; i < 32; ++i) { const int kk = 2 * i + (lane >> 5); scr[kk * 33 + (lane & 31)] = wv[i]; }
    LDS_WAIT(); asm volatile("" ::: "memory");
    const int c = lane & 7;
#pragma unroll
    for (int j = 0; j < 4; ++j) { const int n = (lane >> 3) + 8 * j; const LAS float* s = scr + (8 * c) * 33 + n;
        v4u o; o.x = pk2(s[0 * 33], s[1 * 33]); o.y = pk2(s[2 * 33], s[3 * 33]); o.z = pk2(s[4 * 33], s[5 * 33]); o.w = pk2(s[6 * 33], s[7 * 33]);
        *(GAS v4u*)(WT + (size_t)rm(n0 + n) * K + k0 + 8 * c) = o; }
    LDS_WAIT(); asm volatile("" ::: "memory");
}
struct RmId { __device__ __forceinline__ int operator()(int n) const { return n; } };
struct RmGU { int up; __device__ __forceinline__ int operator()(int n) const { return (n >> 7) * 256 + up * 128 + (n & 127); } };

__device__ __forceinline__ void rms_row_to_bf16(const f32x4 (&v)[16], const float* g, bf16* orow, int lane) {
    float s = 0.f;
#pragma unroll
    for (int j = 0; j < 16; ++j) s += (v[j].x * v[j].x + v[j].y * v[j].y) + (v[j].z * v[j].z + v[j].w * v[j].w);
    const float rstd = 1.0f / sqrtf(wave_sum(s) * (1.f / 4096.f) + NORM_EPS);
    const GAS f32x4* gr = (const GAS f32x4*)g + lane; GAS v2u* o8 = (GAS v2u*)orow + lane;
#pragma unroll
    for (int hh = 0; hh < 2; ++hh) { f32x4 gv[8];
#pragma unroll
        for (int j = 0; j < 8; ++j) gv[j] = gr[64 * (8 * hh + j)];
#pragma unroll
        for (int j = 0; j < 8; ++j) { const f32x4 x = v[8 * hh + j]; v2u o; o.x = pk2(x.x * rstd * gv[j].x, x.y * rstd * gv[j].y); o.y = pk2(x.z * rstd * gv[j].z, x.w * rstd * gv[j].w); o8[64 * (8 * hh + j)] = o; } }
}

struct MixPtrs {
    const bf16* proj; bf16* mix;
    const float *state_dn, *cache_conv, *state_rw, *cache_shift;
    const float *conv_w, *a_log, *dt_bias, *dn_norm_w;
    const float *mu, *w0, *w2, *a0, *a2, *g2, *k_k, *k_a, *r_k, *ln_w, *ln_b;
    float* out;
};
__device__ __forceinline__ void dn_seq_item(const MixPtrs& P, LAS unsigned char* lds, int seq, int h, int tid, int lane, int wave) {
    const bool prm = seq < 2;
    const int T = prm ? SEQ : DEC_SEQ, sb = prm ? seq : seq - 2;
    const int m0 = prm ? seq * SEQ : M_PROMPT + sb * DEC_SEQ;
    const float* S0 = prm ? nullptr : P.state_dn + ((size_t)sb * 16 + h) * 16384;
    const float* cbuf = prm ? nullptr : P.cache_conv + (size_t)sb * 3 * 6144;
    float* Sout = P.out + (prm ? O_SDN_P : O_SDN_S) + ((size_t)sb * 16 + h) * 16384;
    float* cout = P.out + (prm ? O_CONV_P : O_CONV_S) + (size_t)sb * 3 * 6144;
    LAS float* qs = (LAS float*)lds; LAS float* ks = qs + 2048; LAS float* vs = ks + 2048; LAS float* zs = vs + 2048; LAS float* os = zs + 2048; LAS float* bet = os + 2048; LAS float* gg = bet + 16;
    float S[32];
    const int e = wave * 16 + (lane >> 2), dq = lane & 3;
#pragma unroll
    for (int j = 0; j < 32; ++j) S[j] = (S0 != nullptr) ? S0[(32 * dq + j) * 128 + e] : 0.f;
    const float Ah = -__expf(P.a_log[h]), dtb = P.dt_bias[h];
    for (int tb = 0; tb < T; tb += 16) {
        for (int i = tid; i < 16 * 384; i += 512) { const int t = i / 384, cc = i - t * 384, sec = cc >> 7, d = cc & 127, col = sec * 2048 + h * 128 + d;
            float acc = 0.f;
#pragma unroll
            for (int j = 0; j < 4; ++j) { const int tt = tb + t - 3 + j; float xv;
                if (tt >= 0) xv = bf2f(P.proj[(size_t)(m0 + tt) * IN_WP + col]); else xv = cbuf ? cbuf[(3 + tt) * 6144 + col] : 0.f;
                acc += xv * P.conv_w[j * 6144 + col]; }
            const float y = acc * sigmoid_f(acc);
            (sec == 0 ? qs : (sec == 1 ? ks : vs))[t * 128 + d] = y; }
        for (int i = tid; i < 16 * 128; i += 512) { const int t = i >> 7, d = i & 127; zs[i] = bf2f(P.proj[(size_t)(m0 + tb + t) * IN_WP + PC_Z + h * 128 + d]); }
        if (tid < 16) { const size_t r = (size_t)(m0 + tb + tid) * IN_WP; const float b = bf2f(P.proj[r + PC_B + h]), a = bf2f(P.proj[r + PC_A + h]);
            bet[tid] = sigmoid_f(b); gg[tid] = Ah * softplus_f(a + dtb); }
        __syncthreads();
#pragma unroll
        for (int r = 0; r < 2; ++r) { const int t = 2 * wave + r;
            const float q0 = qs[t * 128 + lane], q1 = qs[t * 128 + 64 + lane], k0 = ks[t * 128 + lane], k1 = ks[t * 128 + 64 + lane];
            const float sq = wave_sum(q0 * q0 + q1 * q1), sk = wave_sum(k0 * k0 + k1 * k1);
            const float cq = 0.08838834764831845f / sqrtf(sq + 1e-6f), ck = 1.0f / sqrtf(sk + 1e-6f);
            qs[t * 128 + lane] = q0 * cq; qs[t * 128 + 64 + lane] = q1 * cq; ks[t * 128 + lane] = k0 * ck; ks[t * 128 + 64 + lane] = k1 * ck; }
        __syncthreads();
        {
#pragma unroll 1
            for (int t = 0; t < 16; ++t) {
                const float eg = __expf(gg[t]), bt = bet[t];
                float kS = 0.f;
#pragma unroll
                for (int d4 = 0; d4 < 8; ++d4) { const f32x4 kv = *(const LAS f32x4*)(ks + t * 128 + 32 * dq + 4 * d4);
                    kS += kv.x * S[4 * d4] + kv.y * S[4 * d4 + 1] + kv.z * S[4 * d4 + 2] + kv.w * S[4 * d4 + 3]; }
                kS += __shfl_xor(kS, 1); kS += __shfl_xor(kS, 2);
                const float w = bt * (vs[t * 128 + e] - eg * kS);
                float o = 0.f;
#pragma unroll
                for (int d4 = 0; d4 < 8; ++d4) { const f32x4 kv = *(const LAS f32x4*)(ks + t * 128 + 32 * dq + 4 * d4); const f32x4 qv = *(const LAS f32x4*)(qs + t * 128 + 32 * dq + 4 * d4);
                    S[4 * d4] = eg * S[4 * d4] + kv.x * w; S[4 * d4 + 1] = eg * S[4 * d4 + 1] + kv.y * w; S[4 * d4 + 2] = eg * S[4 * d4 + 2] + kv.z * w; S[4 * d4 + 3] = eg * S[4 * d4 + 3] + kv.w * w;
                    o += qv.x * S[4 * d4] + qv.y * S[4 * d4 + 1] + qv.z * S[4 * d4 + 2] + qv.w * S[4 * d4 + 3]; }
                o += __shfl_xor(o, 1); o += __shfl_xor(o, 2);
                if (dq == 0) os[t * 128 + e] = o;
            }
        }
        __syncthreads();
#pragma unroll
        for (int r = 0; r < 2; ++r) { const int t = 2 * wave + r;
            const float o0 = os[t * 128 + lane], o1 = os[t * 128 + 64 + lane];
            const float rs = 1.0f / sqrtf(wave_sum(o0 * o0 + o1 * o1) * (1.f / 128.f) + NORM_EPS);
            const float z0 = zs[t * 128 + lane], z1 = zs[t * 128 + 64 + lane];
            bf16* mp = P.mix + (size_t)(m0 + tb + t) * 4096 + h * 128;
            mp[lane] = (bf16)f2bf(o0 * rs * P.dn_norm_w[lane] * (z0 * sigmoid_f(z0))); mp[64 + lane] = (bf16)f2bf(o1 * rs * P.dn_norm_w[64 + lane] * (z1 * sigmoid_f(z1))); }
        __syncthreads();
    }
    { int so = 32 * dq * 128 + e;
#ifndef NO_LAUNDER
    asm volatile("" : "+v"(so));
#endif

#pragma unroll
    for (int j = 0; j < 32; ++j) Sout[so + j * 128] = S[j]; }
    for (int i = tid; i < 3 * 384; i += 512) { const int r = i / 384, cc = i - r * 384, col = (cc >> 7) * 2048 + h * 128 + (cc & 127);
        cout[r * 6144 + col] = bf2f(P.proj[(size_t)(m0 + T - 3 + r) * IN_WP + col]); }
}
__device__ __forceinline__ void rw_seq_item(const MixPtrs& P, const bf16* w2T_, const bf16* a2T_, const bf16* g2T_, LAS unsigned char* lds, int seq, int h, int tid, int lane, int wave) {
    const bool prm = seq < 2;
    const int T = prm ? SEQ : DEC_SEQ, sb = prm ? seq : seq - 2;
    const int m0 = prm ? seq * SEQ : M_PROMPT + sb * DEC_SEQ;
    const float* S0 = prm ? nullptr : P.state_rw + ((size_t)sb * 32 + h) * 4096;
    const float* sbuf = prm ? nullptr : P.cache_shift + (size_t)sb * RW_SHIFT_W;
    float* Sout = P.out + (prm ? O_SRW_P : O_SRW_S) + ((size_t)sb * 32 + h) * 4096;
    float* shout = P.out + (prm ? O_SHIFT_P : O_SHIFT_S) + (size_t)sb * RW_SHIFT_W;
    LAS float* rs = (LAS float*)lds; LAS float* kr = rs + 1024; LAS float* vs = kr + 1024; LAS float* xw = vs + 1024; LAS float* xa = xw + 1536; LAS float* xg = xa + 1536;
    LAS float* wd = xg + 4096; LAS float* kp = wd + 1024; LAS float* av = kp + 1024; LAS float* bv = av + 1024; LAS float* gt = bv + 1024; LAS float* ys = gt + 1024; LAS float* sbn = ys + 1024;
    float S[16];
    const int vr = (wave & 3) * 16 + (lane >> 2), kq = lane & 3;
#pragma unroll
    for (int k4 = 0; k4 < 4; ++k4) { f32x4 v = (f32x4){0.f, 0.f, 0.f, 0.f}; if (S0 != nullptr) v = *(const f32x4*)(S0 + vr * 64 + 16 * kq + 4 * k4);
        S[4 * k4] = v.x; S[4 * k4 + 1] = v.y; S[4 * k4 + 2] = v.z; S[4 * k4 + 3] = v.w; }
    const int hc = h * 64 + lane;
    const float w0c = P.w0[hc], a0c = P.a0[hc], kkc = P.k_k[hc], kac = P.k_a[hc], rkc = P.r_k[hc], lnw = P.ln_w[hc], lnb = P.ln_b[hc];
    for (int tb = 0; tb < T; tb += 16) {
        for (int i = tid; i < 16 * 640; i += 512) { const int t = i / 640, cc = i - t * 640; int col; LAS float* dst; int kind = 0;
            if (cc < 64) { col = RW_R + h * 64 + cc; dst = rs + t * 64 + cc; }
            else if (cc < 128) { col = RW_K + h * 64 + (cc - 64); dst = kr + t * 64 + (cc - 64); }
            else if (cc < 192) { col = RW_V + h * 64 + (cc - 128); dst = vs + t * 64 + (cc - 128); }
            else if (cc < 288) { col = RW_XW + (cc - 192); dst = xw + t * 96 + (cc - 192); kind = 1; }
            else if (cc < 384) { col = RW_XA + (cc - 288); dst = xa + t * 96 + (cc - 288); }
            else { col = RW_XG + (cc - 384); dst = xg + t * 256 + (cc - 384); kind = 2; }
            const int tt = tb + t; const float u = bf2f(P.proj[(size_t)(m0 + tt) * IN_WP + PC_RW + col]);
            const float up = tt > 0 ? bf2f(P.proj[(size_t)(m0 + tt - 1) * IN_WP + PC_RW + col]) : (sbuf ? sbuf[col] : 0.f);
            float v = u + P.mu[col] * (up - u);
            if (kind == 1) v = tanhf(v); else if (kind == 2) v = sigmoid_f(v);
            *dst = v; }
        __syncthreads();
        {
            float wl0 = 0.f, wl1 = 0.f, al0 = 0.f, al1 = 0.f, gl0 = 0.f, gl1 = 0.f; const int t0 = wave, t1 = wave + 8;
#ifdef OLD_SEQ
#pragma unroll 4
            for (int j = 0; j < 96; ++j) { const float w2v = P.w2[j * 2048 + hc], a2v = P.a2[j * 2048 + hc];
                wl0 += xw[t0 * 96 + j] * w2v; wl1 += xw[t1 * 96 + j] * w2v; al0 += xa[t0 * 96 + j] * a2v; al1 += xa[t1 * 96 + j] * a2v; }
#pragma unroll 4
            for (int j = 0; j < 256; ++j) { const float g2v = P.g2[j * 2048 + hc]; gl0 += xg[t0 * 256 + j] * g2v; gl1 += xg[t1 * 256 + j] * g2v; }
#else
#define SEQ_DOT8(W8, X0, X1, A0, A1) do { const v4u _w = (W8); const LAS float* _x0 = (X0); const LAS float* _x1 = (X1); \
                const f32x4 _p0 = *(const LAS f32x4*)_x0, _p1 = *(const LAS f32x4*)(_x0 + 4), _q0 = *(const LAS f32x4*)_x1, _q1 = *(const LAS f32x4*)(_x1 + 4); \
                const float _w0 = bflo(_w.x), _w1 = bfhi(_w.x), _w2 = bflo(_w.y), _w3 = bfhi(_w.y), _w4 = bflo(_w.z), _w5 = bfhi(_w.z), _w6 = bflo(_w.w), _w7 = bfhi(_w.w); \
                A0 += (_p0.x * _w0 + _p0.y * _w1) + (_p0.z * _w2 + _p0.w * _w3) + (_p1.x * _w4 + _p1.y * _w5) + (_p1.z * _w6 + _p1.w * _w7); \
                A1 += (_q0.x * _w0 + _q0.y * _w1) + (_q0.z * _w2 + _q0.w * _w3) + (_q1.x * _w4 + _q1.y * _w5) + (_q1.z * _w6 + _q1.w * _w7); } while (0)
#pragma unroll 1
            for (int cch = 0; cch < 3; ++cch) { v4u wv[4], av2[4];
#pragma unroll
                for (int p = 0; p < 4; ++p) { wv[p] = *(const GAS v4u*)(w2T_ + (size_t)hc * 96 + 32 * cch + 8 * p); av2[p] = *(const GAS v4u*)(a2T_ + (size_t)hc * 96 + 32 * cch + 8 * p); }
#pragma unroll
                for (int p = 0; p < 4; ++p) { const int j = 32 * cch + 8 * p; SEQ_DOT8(wv[p], xw + t0 * 96 + j, xw + t1 * 96 + j, wl0, wl1); SEQ_DOT8(av2[p], xa + t0 * 96 + j, xa + t1 * 96 + j, al0, al1); } }
#pragma unroll 1
            for (int cch = 0; cch < 8; ++cch) { v4u gv[4];
#pragma unroll
                for (int p = 0; p < 4; ++p) gv[p] = *(const GAS v4u*)(g2T_ + (size_t)hc * 256 + 32 * cch + 8 * p);
#pragma unroll
                for (int p = 0; p < 4; ++p) { const int j = 32 * cch + 8 * p; SEQ_DOT8(gv[p], xg + t0 * 256 + j, xg + t1 * 256 + j, gl0, gl1); } }
#undef SEQ_DOT8
#endif
#pragma unroll
            for (int r = 0; r < 2; ++r) { const int t = r ? t1 : t0; const float wl = r ? wl1 : wl0, al = r ? al1 : al0, gl = r ? gl1 : gl0;
                const float wlog = -softplus_f(-(w0c + wl)) - 0.5f; const float wdec = __expf(-__expf(wlog));
                const float a = sigmoid_f(a0c + al);
                const float krv = kr[t * 64 + lane], kkr = krv * kkc; const float kk = kkr / sqrtf(wave_sum(kkr * kkr) + 1e-6f);
                const float kpv = krv * (1.0f + (a - 1.0f) * kac);
                const float sbv = wave_sum(rs[t * 64 + lane] * kpv * rkc);
                wd[t * 64 + lane] = wdec; kp[t * 64 + lane] = kpv; av[t * 64 + lane] = -kk; bv[t * 64 + lane] = kk * a; gt[t * 64 + lane] = gl; if (lane == 0) sbn[t] = sbv; }
        }
        __syncthreads();
        if (wave < 4) {
#pragma unroll 1
            for (int t = 0; t < 16; ++t) {
                float sa = 0.f;
#pragma unroll
                for (int k4 = 0; k4 < 4; ++k4) { const f32x4 a4 = *(const LAS f32x4*)(av + t * 64 + 16 * kq + 4 * k4); sa += a4.x * S[4 * k4] + a4.y * S[4 * k4 + 1] + a4.z * S[4 * k4 + 2] + a4.w * S[4 * k4 + 3]; }
                sa += __shfl_xor(sa, 1); sa += __shfl_xor(sa, 2);
                const float vv = vs[t * 64 + vr]; float y = 0.f;
#pragma unroll
                for (int k4 = 0; k4 < 4; ++k4) { const int o4 = t * 64 + 16 * kq + 4 * k4;
                    const f32x4 w4 = *(const LAS f32x4*)(wd + o4), b4 = *(const LAS f32x4*)(bv + o4), k4v = *(const LAS f32x4*)(kp + o4), r4 = *(const LAS f32x4*)(rs + o4);
                    S[4 * k4] = S[4 * k4] * w4.x + sa * b4.x + vv * k4v.x; S[4 * k4 + 1] = S[4 * k4 + 1] * w4.y + sa * b4.y + vv * k4v.y;
                    S[4 * k4 + 2] = S[4 * k4 + 2] * w4.z + sa * b4.z + vv * k4v.z; S[4 * k4 + 3] = S[4 * k4 + 3] * w4.w + sa * b4.w + vv * k4v.w;
                    y += r4.x * S[4 * k4] + r4.y * S[4 * k4 + 1] + r4.z * S[4 * k4 + 2] + r4.w * S[4 * k4 + 3]; }
                y += __shfl_xor(y, 1); y += __shfl_xor(y, 2);
                if (kq == 0) ys[t * 64 + vr] = y;
            }
        }
        __syncthreads();
#pragma unroll
        for (int r = 0; r < 2; ++r) { const int t = wave + 8 * r; const float y = ys[t * 64 + lane];
            const float mean = wave_sum(y) * (1.f / 64.f); const float dy = y - mean; const float var = wave_sum(dy * dy) * (1.f / 64.f);
            const float yn = dy / sqrtf(var + RW_GN_EPS) * lnw + lnb;
            P.mix[(size_t)(m0 + tb + t) * 4096 + 2048 + hc] = (bf16)f2bf((yn + sbn[t] * vs[t * 64 + lane]) * gt[t * 64 + lane]); }
        __syncthreads();
    }
    if (wave < 4) { int so = vr * 64 + 16 * kq;
#ifndef NO_LAUNDER
    asm volatile("" : "+v"(so));
#endif
#pragma unroll
        for (int k4 = 0; k4 < 4; ++k4) *(f32x4*)(Sout + so + 4 * k4) = (f32x4){S[4 * k4], S[4 * k4 + 1], S[4 * k4 + 2], S[4 * k4 + 3]};
    }
    for (int i = tid; i < 206; i += 512) { const int col = h * 206 + i; shout[col] = bf2f(P.proj[(size_t)(m0 + T - 1) * IN_WP + PC_RW + col]); }
}

typedef short bf16x8 __attribute__((ext_vector_type(8)));
typedef float f32x16 __attribute__((ext_vector_type(16)));
typedef __bf16 bf16x2_t __attribute__((ext_vector_type(2)));
typedef float f32x2_t __attribute__((ext_vector_type(2)));
__device__ __forceinline__ unsigned cvt2(float lo, float hi) { f32x2_t v = {lo, hi}; return __builtin_bit_cast(unsigned, __builtin_convertvector(v, bf16x2_t)); }
#define MFMA16(a, b, c) __builtin_amdgcn_mfma_f32_16x16x32_bf16((a), (b), (c), 0, 0, 0)
#define MFMA32(a, b, c) __builtin_amdgcn_mfma_f32_32x32x16_bf16((a), (b), (c), 0, 0, 0)
__device__ __forceinline__ bf16x8 pack_step(const f32x16& x, int s) {
    v4u p; p.x = cvt2(x[8 * s], x[8 * s + 1]); p.y = cvt2(x[8 * s + 2], x[8 * s + 3]); p.z = cvt2(x[8 * s + 4], x[8 * s + 5]); p.w = cvt2(x[8 * s + 6], x[8 * s + 7]);
    return __builtin_bit_cast(bf16x8, p);
}
struct DnRec { unsigned char* rec; unsigned char* qk; float* gl; };
constexpr int DP_CW = 132096;
constexpr int DP_QN = 0, DP_KN = 17408, DP_VBT = 34816, DP_KBGT = 53248, DP_LM = 71680, DP_TM = 88320, DP_TB = 104960, DP_DINV = 114176, DP_YB = 118528, DP_SC = 122688;

__device__ __forceinline__ bf16x8 tv_pack4(const f32x4 a) { v4u p; p.x = cvt2(a[0], a[1]); p.y = cvt2(a[2], a[3]); p.z = 0u; p.w = 0u; return __builtin_bit_cast(bf16x8, p); }
__device__ __forceinline__ bf16x8 tv_pack8(const f32x4 a, const f32x4 b) { v4u p; p.x = cvt2(a[0], a[1]); p.y = cvt2(a[2], a[3]); p.z = cvt2(b[0], b[1]); p.w = cvt2(b[2], b[3]); return __builtin_bit_cast(bf16x8, p); }
__device__ __forceinline__ f32x4 tv_blk(const LAS float* Lm, int I, int J, int l15, int q) { f32x4 v; _Pragma("unroll") for (int r = 0; r < 4; ++r) v[r] = Lm[(16 * I + 4 * q + r) * 65 + 16 * J + l15]; return v; }
__device__ __forceinline__ f32x4 tv_blkT(const LAS float* Lm, int I, int J, int l15, int q) { f32x4 v; _Pragma("unroll") for (int r = 0; r < 4; ++r) v[r] = Lm[(16 * I + l15) * 65 + 16 * J + 4 * q + r]; return v; }
__device__ __forceinline__ void tv_put(LAS bf16* Tb, int I, int J, const f32x4 vT, float sgn, int l15, int q) {
    v2u o; o.x = cvt2(sgn * vT[0], sgn * vT[1]); o.y = cvt2(sgn * vT[2], sgn * vT[3]); *(LAS v2u*)(Tb + (16 * I + l15) * 72 + 16 * J + 4 * q) = o; }
template <bool BAR = true>
__device__ __forceinline__ void tri_inv64_mfma(const LAS float* Lm, LAS bf16* Tb, int lane, int wave) {
    if (wave == 0) {
        int ln = lane; asm volatile("" : "+v"(ln));
        const int l15 = ln & 15, q = ln >> 4; const f32x4 z4 = (f32x4){0.f, 0.f, 0.f, 0.f};
        f32x4 D[4], Dt[4];
#pragma unroll
        for (int i = 0; i < 4; ++i) {
            const f32x4 N = tv_blk(Lm, i, i, l15, q), Nt = tv_blkT(Lm, i, i, l15, q);
            f32x4 P, Pt;
#pragma unroll
            for (int r = 0; r < 4; ++r) { const float e = (4 * q + r == l15) ? 1.f : 0.f; P[r] = e - N[r]; Pt[r] = e - Nt[r]; }
            bf16x8 x = tv_pack4(N), xt = tv_pack4(Nt);
#pragma unroll
            for (int lv = 0; lv < 3; ++lv) {
                const f32x4 X = MFMA16(xt, x, z4), Xt = MFMA16(x, xt, z4);
                x = tv_pack4(X); xt = tv_pack4(Xt);
                const bf16x8 p = tv_pack4(P);
                P = MFMA16(xt, p, P); Pt = MFMA16(p, xt, Pt);
            }
            D[i] = P; Dt[i] = Pt;
        }
        const f32x4 Y1 = MFMA16(tv_pack4(tv_blkT(Lm, 1, 0, l15, q)), tv_pack4(D[0]), z4), Y3 = MFMA16(tv_pack4(tv_blkT(Lm, 3, 2, l15, q)), tv_pack4(D[2]), z4);
        const bf16x8 y1 = tv_pack4(Y1), y3 = tv_pack4(Y3), d1t = tv_pack4(Dt[1]), d3t = tv_pack4(Dt[3]);
        f32x4 T10 = MFMA16(d1t, y1, z4); const f32x4 T10t = MFMA16(y1, d1t, z4), T32t = MFMA16(y3, d3t, z4);
#pragma unroll
        for (int r = 0; r < 4; ++r) T10[r] = -T10[r];
        const f32x4 M20 = tv_blkT(Lm, 2, 0, l15, q), M21 = tv_blkT(Lm, 2, 1, l15, q), M30 = tv_blkT(Lm, 3, 0, l15, q), M31 = tv_blkT(Lm, 3, 1, l15, q);
        const bf16x8 ta0 = tv_pack8(D[0], T10), d1 = tv_pack4(D[1]);
        const f32x4 Y20 = MFMA16(tv_pack8(M20, M21), ta0, z4), Y30 = MFMA16(tv_pack8(M30, M31), ta0, z4), Y21 = MFMA16(tv_pack4(M21), d1, z4), Y31 = MFMA16(tv_pack4(M31), d1, z4);
        f32x4 nT32t;
#pragma unroll
        for (int r = 0; r < 4; ++r) nT32t[r] = -T32t[r];
        const bf16x8 d2t = tv_pack4(Dt[2]), tb3 = tv_pack8(nT32t, Dt[3]);
        const f32x4 B20t = MFMA16(tv_pack4(Y20), d2t, z4), B21t = MFMA16(tv_pack4(Y21), d2t, z4), B30t = MFMA16(tv_pack8(Y20, Y30), tb3, z4), B31t = MFMA16(tv_pack8(Y21, Y31), tb3, z4);
#pragma unroll
        for (int i = 0; i < 4; ++i) {
            tv_put(Tb, i, i, Dt[i], 1.f, l15, q);
#pragma unroll
            for (int j = i + 1; j < 4; ++j) tv_put(Tb, i, j, z4, 1.f, l15, q);
        }
        tv_put(Tb, 1, 0, T10t, -1.f, l15, q); tv_put(Tb, 3, 2, T32t, -1.f, l15, q);
        tv_put(Tb, 2, 0, B20t, -1.f, l15, q); tv_put(Tb, 2, 1, B21t, -1.f, l15, q); tv_put(Tb, 3, 0, B30t, -1.f, l15, q); tv_put(Tb, 3, 1, B31t, -1.f, l15, q);
    }
    if constexpr (BAR) __syncthreads();
}

__device__ __forceinline__ void tri_inv64(const LAS float* Lm, LAS float* Tm, LAS bf16* Tb, LAS float* Dinv, LAS float* Yb, int tid, int lane, int wave) {
    if (tid < 64) { const int bi = tid >> 4, j = tid & 15; float x[16];
#pragma unroll
        for (int r = 0; r < 16; ++r) { float a = (r == j) ? 1.f : 0.f;
#pragma unroll
            for (int k = 0; k < r; ++k) a -= Lm[(16 * bi + r) * 65 + 16 * bi + k] * x[k];
            x[r] = a; }
#pragma unroll
        for (int r = 0; r < 16; ++r) Dinv[(bi * 16 + r) * 17 + j] = x[r]; }
    __syncthreads();
    for (int o = tid; o < 4096; o += 512) { const int r = o >> 6, c = o & 63, bi = r >> 4;
        if (c >= 16 * bi) { const float a = (c < 16 * bi + 16) ? Dinv[r * 17 + c - 16 * bi] : 0.f; Tm[r * 65 + c] = a; Tb[r * 72 + c] = (bf16)(cvt2(a, 0.f) & 0xffffu); } }
    __syncthreads();
    const int l15 = lane & 15, q = lane >> 4;
#pragma unroll 1
    for (int i = 1; i < 4; ++i) {
        if (wave < i) { f32x4 acc = (f32x4){0.f, 0.f, 0.f, 0.f};
            for (int ks = 0; ks < 4 * i; ++ks) acc = __builtin_amdgcn_mfma_f32_16x16x4f32(Lm[(16 * i + l15) * 65 + 4 * ks + q], Tm[(4 * ks + q) * 65 + 16 * wave + l15], acc, 0, 0, 0);
#pragma unroll
            for (int reg = 0; reg < 4; ++reg) Yb[(4 * q + reg) * 65 + 16 * wave + l15] = -acc[reg]; }
        __syncthreads();
        if (wave < i) { f32x4 acc = (f32x4){0.f, 0.f, 0.f, 0.f};
#pragma unroll
            for (int ks = 0; ks < 4; ++ks) acc = __builtin_amdgcn_mfma_f32_16x16x4f32(Dinv[(16 * i + l15) * 17 + 4 * ks + q], Yb[(4 * ks + q) * 65 + 16 * wave + l15], acc, 0, 0, 0);
#pragma unroll
            for (int reg = 0; reg < 4; ++reg) { Tm[(16 * i + 4 * q + reg) * 65 + 16 * wave + l15] = acc[reg]; Tb[(16 * i + 4 * q + reg) * 72 + 16 * wave + l15] = (bf16)(cvt2(acc[reg], 0.f) & 0xffffu); } }
        __syncthreads();
    }
}

__device__ __forceinline__ void dn_stage_conv(const MixPtrs& P, LAS unsigned char* lds, int h, int tid) {
    LAS float* cw = (LAS float*)(lds + DP_CW);
    for (int i = tid; i < 1536; i += 512) { const int sec = i >> 9, j = (i >> 7) & 3, cc = i & 127; cw[i] = P.conv_w[j * 6144 + sec * 2048 + h * 128 + cc]; }
    __syncthreads();
}
#ifdef TRI_OLD
#define TRI_INV() tri_inv64(Lm, Tm, Tb, Dinv, Yb, tid, lane, wave)
#else
#define TRI_INV() tri_inv64_mfma<true>(Lm, Tb, lane, wave)
#endif
__device__ __forceinline__ void dn_prep_item(const MixPtrs& P, const DnRec& R, LAS unsigned char* lds, int b, int c, int h, int tid, int lane, int wave) {
    const int m0 = b * SEQ + 64 * c; const int item = (b * 128 + c) * 16 + h;
    LAS bf16* Qn = (LAS bf16*)(lds + DP_QN); LAS bf16* Kn = (LAS bf16*)(lds + DP_KN); LAS bf16* VbT = (LAS bf16*)(lds + DP_VBT); LAS bf16* KbgT = (LAS bf16*)(lds + DP_KBGT);
    LAS float* Lm = (LAS float*)(lds + DP_LM); LAS float* Tm = (LAS float*)(lds + DP_TM); LAS bf16* Tb = (LAS bf16*)(lds + DP_TB); LAS float* Dinv = (LAS float*)(lds + DP_DINV); LAS float* Yb = (LAS float*)(lds + DP_YB);
    LAS float* sc = (LAS float*)(lds + DP_SC); LAS float* beta = sc; LAS float* gc = sc + 64; LAS float* egc = sc + 128; LAS float* ekd = sc + 192;
    unsigned char* rec = R.rec + (size_t)item * 65536; unsigned char* qkr = R.qk + (size_t)item * 8192;
    const LAS float* cw = (const LAS float*)(lds + DP_CW);
    bf16 ub0 = 0, ua0 = 0;
    if (wave == 0) { const size_t r = (size_t)(m0 + lane) * IN_WP; ub0 = P.proj[r + PC_B + h]; ua0 = P.proj[r + PC_A + h]; }
    const int g8 = tid & 15, tq = tid >> 4;
    v4u xv[6][4];
#pragma unroll
    for (int r = 0; r < 6; ++r) { const int t = tq + 32 * (r & 1); const int col = (r >> 1) * 2048 + h * 128 + 8 * g8;
#pragma unroll
        for (int j = 0; j < 4; ++j) { int tt = 64 * c + t - 3 + j; tt = tt < 0 ? 0 : tt; xv[r][j] = *(const GAS v4u*)(P.proj + (size_t)(b * SEQ + tt) * IN_WP + col); } }
    if (wave == 0) { const int t = lane; const float bb = bf2f(ub0), aa = bf2f(ua0);
        const float Ah = -__expf(P.a_log[h]), dtb = P.dt_bias[h];
        float x = Ah * softplus_f(aa + dtb);
#pragma unroll
        for (int o = 1; o < 64; o <<= 1) { const float v = __shfl_up(x, o); if (lane >= o) x += v; }
        const float gl = __shfl(x, 63);
        beta[t] = sigmoid_f(bb); gc[t] = x; egc[t] = __expf(x); ekd[t] = __expf(gl - x); if (lane == 0) R.gl[item] = __expf(gl); }
    __syncthreads();
#pragma unroll
    for (int r = 0; r < 6; ++r) {
        const int sec = r >> 1; const int t = tq + 32 * (r & 1);
        float acc[8];
#pragma unroll
        for (int i = 0; i < 8; ++i) acc[i] = 0.f;
#pragma unroll
        for (int j = 0; j < 4; ++j) {
            v4u x4 = xv[r][j]; if (64 * c + t - 3 + j < 0) x4 = (v4u){0u, 0u, 0u, 0u};
            const f32x4 w0 = *(const LAS f32x4*)(cw + (sec * 4 + j) * 128 + 8 * g8), w1 = *(const LAS f32x4*)(cw + (sec * 4 + j) * 128 + 8 * g8 + 4);
            acc[0] += bflo(x4.x) * w0.x; acc[1] += bfhi(x4.x) * w0.y; acc[2] += bflo(x4.y) * w0.z; acc[3] += bfhi(x4.y) * w0.w;
            acc[4] += bflo(x4.z) * w1.x; acc[5] += bfhi(x4.z) * w1.y; acc[6] += bflo(x4.w) * w1.z; acc[7] += bfhi(x4.w) * w1.w; }
        float y[8]; float ss = 0.f;
#pragma unroll
        for (int i = 0; i < 8; ++i) { y[i] = acc[i] * sigmoid_f(acc[i]); ss += y[i] * y[i]; }
        if (sec < 2) { ss += __shfl_xor(ss, 1); ss += __shfl_xor(ss, 2); ss += __shfl_xor(ss, 4); ss += __shfl_xor(ss, 8);
            const float scl = (sec == 0 ? 0.08838834764831845f : 1.0f) * __builtin_amdgcn_rsqf(ss + 1e-6f);
#pragma unroll
            for (int i = 0; i < 8; ++i) y[i] *= scl; }
        if (sec == 0) { v4u o; o.x = cvt2(y[0], y[1]); o.y = cvt2(y[2], y[3]); o.z = cvt2(y[4], y[5]); o.w = cvt2(y[6], y[7]); *(LAS v4u*)(Qn + t * 136 + 8 * g8) = o; }
        else if (sec == 1) { v4u o; o.x = cvt2(y[0], y[1]); o.y = cvt2(y[2], y[3]); o.z = cvt2(y[4], y[5]); o.w = cvt2(y[6], y[7]); *(LAS v4u*)(Kn + t * 136 + 8 * g8) = o;
            const float f = beta[t] * egc[t];
#pragma unroll
            for (int i = 0; i < 8; ++i) KbgT[(8 * g8 + i) * 72 + 8 * (((t >> 3) ^ (g8 >> 1)) & 7) + (t & 7)] = (bf16)(cvt2(y[i] * f, 0.f) & 0xffffu); }
        else { const float f = beta[t];
#pragma unroll
            for (int i = 0; i < 8; ++i) VbT[(8 * g8 + i) * 72 + 8 * (((t >> 3) ^ (g8 >> 1)) & 7) + (t & 7)] = (bf16)(cvt2(y[i] * f, 0.f) & 0xffffu); }
    }
    GAS v4u* zp = (GAS v4u*)(P.proj + (size_t)(m0 + (tid >> 3)) * IN_WP + PC_Z + h * 128 + 16 * (tid & 7));
    const v4u zv0 = zp[0], zv1 = zp[1];
    __syncthreads();
#ifdef PD2
    for (int _pr = 0; _pr < 2; ++_pr) {
#else
    {
#endif
    {   const int tt = wave & 3, sp = wave >> 2, l15 = lane & 15, q = lane >> 4;
#pragma unroll
        for (int si = 0; si < 2; ++si) { const int st = 2 * sp + si;
            f32x4 aL = (f32x4){0.f, 0.f, 0.f, 0.f}, aQ = (f32x4){0.f, 0.f, 0.f, 0.f};
#pragma unroll
            for (int ks = 0; ks < 4; ++ks) {
                const bf16x8 fs = *(const LAS bf16x8*)(Kn + (16 * st + l15) * 136 + 32 * ks + 8 * q);
                const bf16x8 ft = *(const LAS bf16x8*)(Kn + (16 * tt + l15) * 136 + 32 * ks + 8 * q);
                const bf16x8 fq = *(const LAS bf16x8*)(Qn + (16 * tt + l15) * 136 + 32 * ks + 8 * q);
                aL = MFMA16(fs, ft, aL); aQ = MFMA16(fs, fq, aQ); }
            const int t = 16 * tt + l15; const float gct = gc[t], bt = beta[t]; float qv[4];
#pragma unroll
            for (int reg = 0; reg < 4; ++reg) { const int s = 16 * st + 4 * q + reg; const float dec = __expf(gct - gc[s]);
                Lm[t * 65 + s] = (t > s) ? bt * aL[reg] * dec : 0.f; qv[reg] = (t >= s) ? aQ[reg] * dec : 0.f; }
            v2u qkp; qkp.x = cvt2(qv[0], qv[1]); qkp.y = cvt2(qv[2], qv[3]);
            *(GAS v2u*)(qkr + ((((t >> 5) * 4 + st) * 64 + (t & 31) + 32 * (q & 1)) * 16 + 8 * (q >> 1))) = qkp;
        }
    }
#pragma unroll
    for (int r = 0; r < 2; ++r) { const int fl = tid + 512 * r; const int ln = fl & 63, ks = (fl >> 6) & 7, mt = fl >> 9;
        const int t = 32 * mt + (ln & 31), d0 = 16 * ks + 4 * (ln >> 5); const float f = egc[t];
        const v2u a = *(const LAS v2u*)(Qn + t * 136 + d0), bq = *(const LAS v2u*)(Qn + t * 136 + d0 + 8);
        v4u o; o.x = cvt2(bflo(a.x) * f, bfhi(a.x) * f); o.y = cvt2(bflo(a.y) * f, bfhi(a.y) * f); o.z = cvt2(bflo(bq.x) * f, bfhi(bq.x) * f); o.w = cvt2(bflo(bq.y) * f, bfhi(bq.y) * f);
        *(GAS v4u*)(rec + 16384 + fl * 16) = o; }
#pragma unroll
    for (int r = 0; r < 2; ++r) { const int fl = tid + 512 * r; const int ln = fl & 63, kt = (fl >> 6) & 3, mtd = fl >> 8;
        const int d = 32 * mtd + (ln & 31), t0 = 16 * kt + 4 * (ln >> 5); float v[8];
#pragma unroll
        for (int j = 0; j < 8; ++j) { const int t = t0 + 8 * (j >> 2) + (j & 3); v[j] = bf2f(Kn[t * 136 + d]) * ekd[t]; }
        v4u o; o.x = cvt2(v[0], v[1]); o.y = cvt2(v[2], v[3]); o.z = cvt2(v[4], v[5]); o.w = cvt2(v[6], v[7]);
        *(GAS v4u*)(rec + 32768 + fl * 16) = o; }
    __syncthreads();
    }
    TRI_INV();
#ifdef PD4
    for (int _pr = 0; _pr < 2; ++_pr)
#endif
    {   const int tt = wave & 3, hf = wave >> 2, l15 = lane & 15, q = lane >> 4;
        bf16x8 tf[2];
#pragma unroll
        for (int ks = 0; ks < 2; ++ks) tf[ks] = *(const LAS bf16x8*)(Tb + (16 * tt + l15) * 72 + 32 * ks + 8 * q);
#pragma unroll
        for (int n = 0; n < 4; ++n) { const int et = 4 * hf + n;
            f32x4 au = (f32x4){0.f, 0.f, 0.f, 0.f}, aw = (f32x4){0.f, 0.f, 0.f, 0.f};
#pragma unroll
            for (int ks = 0; ks < 2; ++ks) { const bf16x8 fv = *(const LAS bf16x8*)(VbT + (16 * et + l15) * 72 + 8 * ((4 * ks + q) ^ (et & 7))); const bf16x8 fk = *(const LAS bf16x8*)(KbgT + (16 * et + l15) * 72 + 8 * ((4 * ks + q) ^ (et & 7)));
                au = MFMA16(tf[ks], fv, au);
                aw = MFMA16(fk, tf[ks], aw); }
            v2u up; up.x = cvt2(au[0], au[1]); up.y = cvt2(au[2], au[3]);
            *(GAS v2u*)(rec + 49152 + ((16 * et + l15) * 64 + 16 * tt + 4 * q) * 2) = up;
            const int t = 16 * tt + l15; v2u wp; wp.x = cvt2(aw[0], aw[1]); wp.y = cvt2(aw[2], aw[3]);
            *(GAS v2u*)(rec + ((((t >> 5) * 8 + et) * 64 + (t & 31) + 32 * (q & 1)) * 16 + 8 * (q >> 1))) = wp; }
    }
    {   v4u o0, o1;
#define DN_SILU2(u) cvt2(bflo(u) * sigmoid_f(bflo(u)), bfhi(u) * sigmoid_f(bfhi(u)))
        o0.x = DN_SILU2(zv0.x); o0.y = DN_SILU2(zv0.y); o0.z = DN_SILU2(zv0.z); o0.w = DN_SILU2(zv0.w); o1.x = DN_SILU2(zv1.x); o1.y = DN_SILU2(zv1.y); o1.z = DN_SILU2(zv1.z); o1.w = DN_SILU2(zv1.w);
#undef DN_SILU2
        zp[0] = o0; zp[1] = o1; }
    __syncthreads();
}

#define WG_BAR_LDS() do { asm volatile("s_waitcnt lgkmcnt(0)" ::: "memory"); __builtin_amdgcn_s_barrier(); asm volatile("" ::: "memory"); } while (0)
__device__ __forceinline__ void dn_scan(const MixPtrs& P, const DnRec& R, LAS unsigned char* lds, int b, int h, int tid, int lane, int wave) {
    constexpr int SB = 57344; LAS unsigned char* obuf0 = lds + 2 * SB; LAS unsigned char* obuf1 = lds + 132096;
    const int item0 = b * 128 * 16 + h;
    if (wave < 4) {
        const int e = 32 * wave + (lane & 31), hh = lane >> 5;
        f32x16 S[4];
#pragma unroll
        for (int dt = 0; dt < 4; ++dt)
#pragma unroll
            for (int i = 0; i < 16; ++i) S[dt][i] = 0.f;
        v2u uu[2][4];
#pragma unroll
        for (int mt = 0; mt < 2; ++mt)
#pragma unroll
            for (int g = 0; g < 4; ++g) uu[mt][g] = *(const GAS v2u*)(R.rec + (size_t)item0 * 65536 + 49152 + (e * 64 + 32 * mt + 8 * g + 4 * hh) * 2);
        float egl = R.gl[item0];
        WG_BAR_LDS();
#pragma unroll 1
        for (int c = 0; c < 128; ++c) {
            LAS unsigned char* buf = lds + (c & 1) * SB;
            f32x16 o0, o1;
            bf16x8 Sf[8];
#pragma unroll
            for (int dt = 0; dt < 4; ++dt) { Sf[2 * dt] = pack_step(S[dt], 0); Sf[2 * dt + 1] = pack_step(S[dt], 1); }
            f32x16 w0, w1;
#pragma unroll
            for (int i = 0; i < 16; ++i) { w0[i] = 0.f; w1[i] = 0.f; o0[i] = 0.f; o1[i] = 0.f; }
#pragma unroll
            for (int ks = 0; ks < 8; ++ks) { const bf16x8 a0 = *(const LAS bf16x8*)(buf + (ks * 64 + lane) * 16), a1 = *(const LAS bf16x8*)(buf + ((8 + ks) * 64 + lane) * 16);
                w0 = MFMA32(a0, Sf[ks], w0); w1 = MFMA32(a1, Sf[ks], w1); }
#pragma unroll
            for (int g = 0; g < 4; ++g) {
                w0[4 * g] = bflo(uu[0][g].x) - w0[4 * g]; w0[4 * g + 1] = bfhi(uu[0][g].x) - w0[4 * g + 1]; w0[4 * g + 2] = bflo(uu[0][g].y) - w0[4 * g + 2]; w0[4 * g + 3] = bfhi(uu[0][g].y) - w0[4 * g + 3];
                w1[4 * g] = bflo(uu[1][g].x) - w1[4 * g]; w1[4 * g + 1] = bfhi(uu[1][g].x) - w1[4 * g + 1]; w1[4 * g + 2] = bflo(uu[1][g].y) - w1[4 * g + 2]; w1[4 * g + 3] = bfhi(uu[1][g].y) - w1[4 * g + 3]; }
            const float eg_cur = egl;
            if (c + 1 < 128) {
                const unsigned char* recn = R.rec + (size_t)(item0 + 16 * (c + 1)) * 65536;
#pragma unroll
                for (int mt = 0; mt < 2; ++mt)
#pragma unroll
                    for (int g = 0; g < 4; ++g) uu[mt][g] = *(const GAS v2u*)(recn + 49152 + (e * 64 + 32 * mt + 8 * g + 4 * hh) * 2);
                egl = R.gl[item0 + 16 * (c + 1)];
            }
            bf16x8 Vf[4]; Vf[0] = pack_step(w0, 0); Vf[1] = pack_step(w0, 1); Vf[2] = pack_step(w1, 0); Vf[3] = pack_step(w1, 1);
#pragma unroll
            for (int ks = 0; ks < 8; ++ks) { const bf16x8 a0 = *(const LAS bf16x8*)(buf + 16384 + (ks * 64 + lane) * 16), a1 = *(const LAS bf16x8*)(buf + 16384 + ((8 + ks) * 64 + lane) * 16);
                o0 = MFMA32(a0, Sf[ks], o0); o1 = MFMA32(a1, Sf[ks], o1); }
#pragma unroll
            for (int kt = 0; kt < 4; ++kt) { const bf16x8 a0 = *(const LAS bf16x8*)(buf + 49152 + (kt * 64 + lane) * 16), a1 = *(const LAS bf16x8*)(buf + 49152 + ((4 + kt) * 64 + lane) * 16);
                o0 = MFMA32(a0, Vf[kt], o0); o1 = MFMA32(a1, Vf[kt], o1); }
#pragma unroll
            for (int dt = 0; dt < 4; ++dt) {
#pragma unroll
                for (int i = 0; i < 16; ++i) S[dt][i] *= eg_cur;
#pragma unroll
                for (int kt = 0; kt < 4; ++kt) { const bf16x8 a = *(const LAS bf16x8*)(buf + 32768 + ((dt * 4 + kt) * 64 + lane) * 16); S[dt] = MFMA32(a, Vf[kt], S[dt]); } }
            {   LAS bf16* ob = (LAS bf16*)((c & 1) ? obuf1 : obuf0);
#pragma unroll
                for (int i = 0; i < 16; ++i) { const int row = (i & 3) + 8 * (i >> 2) + 4 * hh;
                    ob[row * 128 + e] = (bf16)(cvt2(o0[i], 0.f) & 0xffffu); ob[(32 + row) * 128 + e] = (bf16)(cvt2(o1[i], 0.f) & 0xffffu); } }
            WG_BAR_LDS();
        }
        float* Sout = P.out + O_SDN_P + ((size_t)b * 16 + h) * 16384;
#pragma unroll
        for (int dt = 0; dt < 4; ++dt)
#pragma unroll
            for (int i = 0; i < 16; ++i) Sout[(32 * dt + (i & 3) + 8 * (i >> 2) + 4 * hh) * 128 + e] = S[dt][i];
    } else {
        const int ht = tid - 256; const int pt = ht >> 2, pq = ht & 3;
        v4u st[14], zr[4];
        f32x4 nw0[4], nw1[4];
#pragma unroll
        for (int k = 0; k < 4; ++k) { const GAS f32x4* nwp = (const GAS f32x4*)(P.dn_norm_w + 32 * pq + 8 * k); nw0[k] = nwp[0]; nw1[k] = nwp[1]; }
#define DN_STAGE_ISSUE(itm) do { const unsigned char* _r = R.rec + (size_t)(itm) * 65536; const unsigned char* _q = R.qk + (size_t)(itm) * 8192; \
        _Pragma("unroll") for (int _k = 0; _k < 12; ++_k) st[_k] = *(const GAS v4u*)(_r + (ht + 256 * _k) * 16); \
        _Pragma("unroll") for (int _k = 0; _k < 2; ++_k) st[12 + _k] = *(const GAS v4u*)(_q + (ht + 256 * _k) * 16); } while (0)
#define DN_STAGE_WRITE(dstbuf) do { _Pragma("unroll") for (int _k = 0; _k < 14; ++_k) *(LAS v4u*)((dstbuf) + (ht + 256 * _k) * 16) = st[_k]; } while (0)
#define DN_Z_ISSUE(cc) do { const size_t _m = (size_t)(b * SEQ + 64 * (cc) + pt); _Pragma("unroll") for (int _k = 0; _k < 4; ++_k) zr[_k] = *(const GAS v4u*)(P.proj + _m * IN_WP + PC_Z + h * 128 + 32 * pq + 8 * _k); } while (0)
#define DN_POST(cc) do { const int _m = b * SEQ + 64 * (cc) + pt; v4u _o[4]; const LAS unsigned char* _ob = ((cc) & 1) ? obuf1 : obuf0; \
        _Pragma("unroll") for (int _k = 0; _k < 4; ++_k) _o[_k] = *(const LAS v4u*)(_ob + (pt * 128 + 32 * pq + 8 * _k) * 2); \
        float _ss = 0.f; _Pragma("unroll") for (int _k = 0; _k < 4; ++_k) { const float a0 = bflo(_o[_k].x), a1 = bfhi(_o[_k].x), a2 = bflo(_o[_k].y), a3 = bfhi(_o[_k].y), a4 = bflo(_o[_k].z), a5 = bfhi(_o[_k].z), a6 = bflo(_o[_k].w), a7 = bfhi(_o[_k].w); \
            _ss += (a0 * a0 + a1 * a1) + (a2 * a2 + a3 * a3) + (a4 * a4 + a5 * a5) + (a6 * a6 + a7 * a7); } \
        _ss += __shfl_xor(_ss, 1); _ss += __shfl_xor(_ss, 2); const float _rs = __builtin_amdgcn_rsqf(_ss * (1.f / 128.f) + NORM_EPS); \
        _Pragma("unroll") for (int _k = 0; _k < 4; ++_k) { const f32x4 n0 = nw0[_k], n1 = nw1[_k]; \
            const float z0 = bflo(zr[_k].x), z1 = bfhi(zr[_k].x), z2 = bflo(zr[_k].y), z3 = bfhi(zr[_k].y), z4 = bflo(zr[_k].z), z5 = bfhi(zr[_k].z), z6 = bflo(zr[_k].w), z7 = bfhi(zr[_k].w); \
            v4u _w; _w.x = cvt2(bflo(_o[_k].x) * _rs * n0.x * z0, bfhi(_o[_k].x) * _rs * n0.y * z1); \
            _w.y = cvt2(bflo(_o[_k].y) * _rs * n0.z * z2, bfhi(_o[_k].y) * _rs * n0.w * z3); \
            _w.z = cvt2(bflo(_o[_k].z) * _rs * n1.x * z4, bfhi(_o[_k].z) * _rs * n1.y * z5); \
            _w.w = cvt2(bflo(_o[_k].w) * _rs * n1.z * z6, bfhi(_o[_k].w) * _rs * n1.w * z7); \
            *(GAS v4u*)(P.mix + (size_t)_m * 4096 + h * 128 + 32 * pq + 8 * _k) = _w; } } while (0)
        DN_STAGE_ISSUE(item0); DN_STAGE_WRITE(lds); DN_STAGE_ISSUE(item0 + 16);
        WG_BAR_LDS();
#pragma unroll 1
        for (int c = 0; c < 128; ++c) {
            if (c + 1 < 128) DN_STAGE_WRITE(lds + ((c + 1) & 1) * SB);
            if (c + 2 < 128) DN_STAGE_ISSUE(item0 + 16 * (c + 2));
            if (c > 0) DN_POST(c - 1);
            DN_Z_ISSUE(c);
            WG_BAR_LDS();
        }
        DN_POST(127);
#undef DN_STAGE_ISSUE
#undef DN_STAGE_WRITE
#undef DN_Z_ISSUE
#undef DN_POST
    }
    {   float* cout = P.out + O_CONV_P + (size_t)b * 3 * 6144;
        for (int i = tid; i < 3 * 384; i += 512) { const int r = i / 384, cc = i - r * 384, col = (cc >> 7) * 2048 + h * 128 + (cc & 127);
            cout[r * 6144 + col] = bf2f(P.proj[(size_t)(b * SEQ + SEQ - 3 + r) * IN_WP + col]); } }
    __syncthreads();
}
struct RwRec { unsigned char* pq; unsigned char* rp; unsigned char* oo; float* sb; const bf16* w2T; const bf16* a2T; const bf16* g2T; };
constexpr int RSL = 9216;

constexpr int RWC_W2 = 132096, RWC_A2 = RWC_W2 + 13312, RWC_MU = RWC_A2 + 13312, RWC_PAR = RWC_MU + 768, RWC_END = RWC_PAR + 2048;
__device__ __forceinline__ void rw_stage_consts(const MixPtrs& P, const RwRec& W, LAS unsigned char* lds, int h, int tid) {
    for (int i = tid; i < 768; i += 512) { const int row = i / 12, pc = i - row * 12;
        *(LAS v4u*)(lds + RWC_W2 + row * 208 + pc * 16) = ((const GAS v4u*)(W.w2T + (size_t)h * 64 * 96))[i]; *(LAS v4u*)(lds + RWC_A2 + row * 208 + pc * 16) = ((const GAS v4u*)(W.a2T + (size_t)h * 64 * 96))[i]; }
    if (tid < 192) ((LAS float*)(lds + RWC_MU))[tid] = P.mu[RW_XW + tid];
    if (tid < 64) { LAS float* par = (LAS float*)(lds + RWC_PAR); const int hc = h * 64 + tid;
        par[tid] = P.mu[RW_R + hc]; par[64 + tid] = P.mu[RW_K + hc]; par[128 + tid] = P.mu[RW_V + hc]; par[192 + tid] = P.w0[hc]; par[256 + tid] = P.a0[hc]; par[320 + tid] = P.k_k[hc]; par[384 + tid] = P.k_a[hc]; par[448 + tid] = P.r_k[hc]; }
    __syncthreads();
}
struct RwRaw { unsigned ur[9], uk[9], uv[9]; v4u xu[3], xp[3]; };
__device__ __forceinline__ void rw_prep_issue(const MixPtrs& P, RwRaw& R, int b, int c, int h, int tid, int lane, int wave) {
    const int hc = h * 64 + lane;
    const __amdgpu_buffer_rsrc_t rs = __builtin_amdgcn_make_buffer_rsrc((void*)P.proj, 0, (int)((size_t)MPAD * IN_WP * 2), 0x00020000);
#pragma unroll
    for (int i = 0; i < 9; ++i) { int tt = 64 * c + wave * 8 + i - 1; tt = tt < 0 ? 0 : tt;
        const int so = ((b * SEQ + tt) * IN_WP + PC_RW + h * 64) * 2;
        R.ur[i] = __builtin_amdgcn_raw_buffer_load_b16(rs, lane * 2, so + RW_R * 2, 0); R.uk[i] = __builtin_amdgcn_raw_buffer_load_b16(rs, lane * 2, so + RW_K * 2, 0); R.uv[i] = __builtin_amdgcn_raw_buffer_load_b16(rs, lane * 2, so + RW_V * 2, 0); }
#pragma unroll
    for (int r = 0; r < 3; ++r) { const int i = tid + 512 * r; const int which = i >= 768, ii = which ? i - 768 : i; const int t = ii / 12, g8 = ii - t * 12; int tp = 64 * c + t - 1; tp = tp < 0 ? 0 : tp;
        const int col = (which ? RW_XA : RW_XW) + 8 * g8;
        R.xu[r] = *(const GAS v4u*)(P.proj + (size_t)(b * SEQ + 64 * c + t) * IN_WP + PC_RW + col); R.xp[r] = *(const GAS v4u*)(P.proj + (size_t)(b * SEQ + tp) * IN_WP + PC_RW + col); }
}
template <bool FRONT_ONLY = false>
__device__ __forceinline__ void rw_prep_item(const MixPtrs& P, const RwRec& W, LAS unsigned char* lds, int b, int c, int h, RwRaw& raw, int nb, int nc, int nh, int tid, int lane, int wave) {
    const int m0 = b * SEQ + 64 * c; const int item = (b * 128 + c) * 32 + h; const int hc = h * 64 + lane;
    const int l15 = lane & 15, q = lane >> 4;
    LAS bf16* Rt = (LAS bf16*)(lds + 0 * RSL); LAS bf16* Kt = (LAS bf16*)(lds + 1 * RSL); LAS bf16* Bt = (LAS bf16*)(lds + 2 * RSL); LAS bf16* At = (LAS bf16*)(lds + 3 * RSL);
    LAS bf16* AtT = (LAS bf16*)(lds + 4 * RSL); LAS bf16* KhT = (LAS bf16*)(lds + 5 * RSL); LAS bf16* BhT = (LAS bf16*)(lds + 6 * RSL); LAS bf16* VT = (LAS bf16*)(lds + 7 * RSL);
    LAS bf16* Aak = (LAS bf16*)(lds + 8 * RSL); LAS bf16* Ark = (LAS bf16*)(lds + 9 * RSL); LAS bf16* Arb = (LAS bf16*)(lds + 10 * RSL);
    LAS float* Lm = (LAS float*)(lds + 11 * RSL); LAS float* Tm = (LAS float*)(lds + 1 * RSL); LAS bf16* Tb = (LAS bf16*)(lds + 3 * RSL);
    LAS bf16* WtT = (LAS bf16*)(lds + 11 * RSL); LAS bf16* XT = (LAS bf16*)(lds + 13 * RSL); LAS bf16* U0T = (LAS bf16*)(lds + 1 * RSL);
    LAS float* Dinv = (LAS float*)(lds + 13 * RSL); LAS float* Yb = (LAS float*)(lds + 13 * RSL + 4352);
    LAS float* wl = (LAS float*)(lds + 0); LAS float* al = (LAS float*)(lds + 2 * RSL);
    LAS bf16* txw = (LAS bf16*)(lds + 8 * RSL); LAS bf16* xas = txw + 64 * 104; LAS bf16* w2s = xas + 64 * 104; LAS bf16* a2s = w2s + 64 * 104;
    LAS float* wtot = (LAS float*)(lds + 126976); LAS float* eGCs = (LAS float*)(lds + 129024);
    const LAS float* par = (const LAS float*)(lds + RWC_PAR); const LAS float* muL = (const LAS float*)(lds + RWC_MU); const LAS unsigned char* w2h = lds + RWC_W2; const LAS unsigned char* a2h = lds + RWC_A2;
    float rr[8], kr[8], vv[8];
    {   float ur[9], uk[9], uv[9];
#pragma unroll
        for (int i = 0; i < 9; ++i) { const bool ok = (64 * c + wave * 8 + i - 1) >= 0;
            ur[i] = ok ? bf2f((bf16)raw.ur[i]) : 0.f; uk[i] = ok ? bf2f((bf16)raw.uk[i]) : 0.f; uv[i] = ok ? bf2f((bf16)raw.uv[i]) : 0.f; }
        const float mr = par[lane], mk = par[64 + lane], mv = par[128 + lane];
#pragma unroll
        for (int i = 0; i < 8; ++i) { rr[i] = ur[i + 1] + mr * (ur[i] - ur[i + 1]); kr[i] = uk[i + 1] + mk * (uk[i] - uk[i + 1]); vv[i] = uv[i + 1] + mv * (uv[i] - uv[i + 1]); }
    }
#ifdef PRF
    _Pragma("unroll 1") for (int _prf = 0; _prf < 2; ++_prf) {
#else
    {
#endif
#ifdef PR1
    for (int _pr = 0; _pr < 2; ++_pr) {
#else
    {
#endif
#pragma unroll
    for (int r = 0; r < 3; ++r) { const int i = tid + 512 * r; const int which = i >= 768, ii = which ? i - 768 : i; const int t = ii / 12, g8 = ii - t * 12; const int tt = 64 * c + t;
        const int col = (which ? RW_XA : RW_XW) + 8 * g8;
        const v4u u = raw.xu[r]; v4u up = raw.xp[r]; if (tt <= 0) up = (v4u){0u, 0u, 0u, 0u};
        const f32x4 m0v = *(const LAS f32x4*)(muL + which * 96 + 8 * g8), m1v = *(const LAS f32x4*)(muL + which * 96 + 8 * g8 + 4);
        float x[8];
        x[0] = bflo(u.x) + m0v.x * (bflo(up.x) - bflo(u.x)); x[1] = bfhi(u.x) + m0v.y * (bfhi(up.x) - bfhi(u.x)); x[2] = bflo(u.y) + m0v.z * (bflo(up.y) - bflo(u.y)); x[3] = bfhi(u.y) + m0v.w * (bfhi(up.y) - bfhi(u.y));
        x[4] = bflo(u.z) + m1v.x * (bflo(up.z) - bflo(u.z)); x[5] = bfhi(u.z) + m1v.y * (bfhi(up.z) - bfhi(u.z)); x[6] = bflo(u.w) + m1v.z * (bflo(up.w) - bflo(u.w)); x[7] = bfhi(u.w) + m1v.w * (bfhi(up.w) - bfhi(u.w));
        if (!which) {
#pragma unroll
            for (int k = 0; k < 8; ++k) { const float e2 = __expf(2.0f * x[k]); x[k] = 1.0f - 2.0f * __builtin_amdgcn_rcpf(e2 + 1.0f); } }
        v4u o; o.x = cvt2(x[0], x[1]); o.y = cvt2(x[2], x[3]); o.z = cvt2(x[4], x[5]); o.w = cvt2(x[6], x[7]);
        *(LAS v4u*)(txw + which * 6656 + t * 104 + 8 * g8) = o; }
    __syncthreads();
    if (nb >= 0) rw_prep_issue(P, raw, nb, nc, nh, tid, lane, wave);
    {   const int tt = wave & 3, cp = wave >> 2;
#pragma unroll
        for (int ci = 0; ci < 2; ++ci) { const int ct = 2 * cp + ci;
            f32x4 aw = (f32x4){0.f, 0.f, 0.f, 0.f}, aa = (f32x4){0.f, 0.f, 0.f, 0.f};
#pragma unroll
            for (int ks = 0; ks < 3; ++ks) {
                const bf16x8 fx = *(const LAS bf16x8*)(txw + (16 * tt + l15) * 104 + 32 * ks + 8 * q), fa = *(const LAS bf16x8*)(xas + (16 * tt + l15) * 104 + 32 * ks + 8 * q);
                const int wo = (16 * ct + l15) * 208 + 64 * ks + 16 * q;
                aw = MFMA16(fx, *(const LAS bf16x8*)(w2h + wo), aw); aa = MFMA16(fa, *(const LAS bf16x8*)(a2h + wo), aa); }
#pragma unroll
            for (int reg = 0; reg < 4; ++reg) { wl[(16 * tt + 4 * q + reg) * 65 + 16 * ct + l15] = aw[reg]; al[(16 * tt + 4 * q + reg) * 65 + 16 * ct + l15] = aa[reg]; } }
    }
    }
    __syncthreads();
    float lw[8], av[8], bvv[8], kp[8], Gt[8];
    {   const float w0c = par[192 + lane], a0c = par[256 + lane], kkc = par[320 + lane], kac = par[384 + lane], rkc = par[448 + lane];
        LAS float* red = (LAS float*)(lds + 8 * RSL + wave * 4352);
        float run = 0.f, alr[8], kkr[8];
#pragma unroll
        for (int i = 0; i < 8; ++i) { const int t = wave * 8 + i;
            lw[i] = -0.6065306597126334f * sigmoid_f(w0c + wl[t * 65 + lane]);
            alr[i] = sigmoid_f(a0c + al[t * 65 + lane]);
            kkr[i] = kr[i] * kkc; kp[i] = kr[i] * (1.0f + (alr[i] - 1.0f) * kac);
            red[i * 68 + lane] = kkr[i] * kkr[i]; red[(8 + i) * 68 + lane] = rr[i] * kp[i] * rkc;
            run += lw[i]; Gt[i] = run; }
        wtot[wave * 64 + lane] = run;
        float s;
        {   const LAS f32x4* rp = (const LAS f32x4*)(red + (lane & 15) * 68 + (lane >> 4) * 16);
            const f32x4 r0 = rp[0], r1 = rp[1], r2 = rp[2], r3 = rp[3];
            s = ((r0.x + r0.y) + (r0.z + r0.w)) + ((r1.x + r1.y) + (r1.z + r1.w)) + ((r2.x + r2.y) + (r2.z + r2.w)) + ((r3.x + r3.y) + (r3.z + r3.w)); }
        s += __shfl_xor(s, 16); s += __shfl_xor(s, 32);
        if (lane >= 8 && lane < 16) W.sb[(size_t)item * 64 + wave * 8 + lane - 8] = s;
#pragma unroll
        for (int i = 0; i < 8; ++i) { const float nrm = __builtin_bit_cast(float, __builtin_amdgcn_readlane(__builtin_bit_cast(int, s), i));
            const float kk = kkr[i] * __builtin_amdgcn_rsqf(nrm + 1e-6f); av[i] = -kk; bvv[i] = kk * alr[i]; }
    }
    __syncthreads();
    {   float off = 0.f, gcv = 0.f;
#pragma unroll
        for (int w = 0; w < 8; ++w) { const float x = wtot[w * 64 + lane]; gcv += x; if (w < wave) off += x; }
        const float egc = __expf(gcv); float eprev = __expf(off);
        if (wave == 0) eGCs[lane] = egc;
        float tA[8], tK[8], tB[8];
#pragma unroll
        for (int i = 0; i < 8; ++i) { const int t = wave * 8 + i; const float G = Gt[i] + off;
            const float eG = __expf(G), eGm = __builtin_amdgcn_rcpf(eG), eGp = eprev, eH = egc * eGm; eprev = eG;
            Rt[t * 72 + lane] = (bf16)(cvt2(rr[i] * eG, 0.f) & 0xffffu); Kt[t * 72 + lane] = (bf16)(cvt2(kp[i] * eGm, 0.f) & 0xffffu);
            Bt[t * 72 + lane] = (bf16)(cvt2(bvv[i] * eGm, 0.f) & 0xffffu); tA[i] = av[i] * eGp; At[t * 72 + lane] = (bf16)(cvt2(tA[i], 0.f) & 0xffffu);
            tK[i] = kp[i] * eH; tB[i] = bvv[i] * eH; }
        v4u o;
        o.x = cvt2(tA[0], tA[1]); o.y = cvt2(tA[2], tA[3]); o.z = cvt2(tA[4], tA[5]); o.w = cvt2(tA[6], tA[7]); *(LAS v4u*)(AtT + lane * 72 + wave * 8) = o;
        o.x = cvt2(tK[0], tK[1]); o.y = cvt2(tK[2], tK[3]); o.z = cvt2(tK[4], tK[5]); o.w = cvt2(tK[6], tK[7]); *(LAS v4u*)(KhT + lane * 72 + wave * 8) = o;
        o.x = cvt2(tB[0], tB[1]); o.y = cvt2(tB[2], tB[3]); o.z = cvt2(tB[4], tB[5]); o.w = cvt2(tB[6], tB[7]); *(LAS v4u*)(BhT + lane * 72 + wave * 8) = o;
        o.x = cvt2(vv[0], vv[1]); o.y = cvt2(vv[2], vv[3]); o.z = cvt2(vv[4], vv[5]); o.w = cvt2(vv[6], vv[7]); *(LAS v4u*)(VT + lane * 72 + wave * 8) = o;
    }
    __syncthreads();
    }
    if constexpr (FRONT_ONLY) return;
#ifdef PR4
    for (int _pr = 0; _pr < 2; ++_pr)
#endif
    {   const int tt = wave & 3, sp = wave >> 2;
        bf16x8 fA[2], fR[2];
#pragma unroll
        for (int ks = 0; ks < 2; ++ks) { fA[ks] = *(const LAS bf16x8*)(At + (16 * tt + l15) * 72 + 32 * ks + 8 * q); fR[ks] = *(const LAS bf16x8*)(Rt + (16 * tt + l15) * 72 + 32 * ks + 8 * q); }
#pragma unroll
        for (int si = 0; si < 2; ++si) { const int st = 2 * sp + si;
            f32x4 ab = (f32x4){0.f, 0.f, 0.f, 0.f}, ak = ab, rk = ab, rb = ab;
#pragma unroll
            for (int ks = 0; ks < 2; ++ks) { const bf16x8 fB = *(const LAS bf16x8*)(Bt + (16 * st + l15) * 72 + 32 * ks + 8 * q), fK = *(const LAS bf16x8*)(Kt + (16 * st + l15) * 72 + 32 * ks + 8 * q);
                ab = MFMA16(fB, fA[ks], ab); ak = MFMA16(fK, fA[ks], ak); rk = MFMA16(fK, fR[ks], rk); rb = MFMA16(fB, fR[ks], rb); }
            const int t = 16 * tt + l15, s0 = 16 * st + 4 * q; float vak[4], vrk[4], vrb[4];
#pragma unroll
            for (int reg = 0; reg < 4; ++reg) { const int s = s0 + reg; Lm[t * 65 + s] = (t > s) ? -ab[reg] : 0.f; vak[reg] = (t > s) ? ak[reg] : 0.f; vrk[reg] = (t >= s) ? rk[reg] : 0.f; vrb[reg] = (t >= s) ? rb[reg] : 0.f; }
            v2u o; o.x = cvt2(vak[0], vak[1]); o.y = cvt2(vak[2], vak[3]); *(LAS v2u*)(Aak + t * 72 + s0) = o;
            o.x = cvt2(vrk[0], vrk[1]); o.y = cvt2(vrk[2], vrk[3]); *(LAS v2u*)(Ark + t * 72 + s0) = o;
            o.x = cvt2(vrb[0], vrb[1]); o.y = cvt2(vrb[2], vrb[3]); *(LAS v2u*)(Arb + t * 72 + s0) = o; }
    }
    __syncthreads();
    {   const int tt = wave & 3, cp = wave >> 2;
        if (wave == 0) tri_inv64_mfma<false>(Lm, Tb, lane, wave);
        bf16x8 fK[2];
#pragma unroll
        for (int ks = 0; ks < 2; ++ks) fK[ks] = *(const LAS bf16x8*)(Aak + (16 * tt + l15) * 72 + 32 * ks + 8 * q);
#pragma unroll
        for (int ci = 0; ci < 2; ++ci) { const int ct = 2 * cp + ci; f32x4 ax = (f32x4){0.f, 0.f, 0.f, 0.f};
#pragma unroll
            for (int ks = 0; ks < 2; ++ks) ax = MFMA16(fK[ks], *(const LAS bf16x8*)(VT + (16 * ct + l15) * 72 + 32 * ks + 8 * q), ax);
            v2u o; o.x = cvt2(ax[0], ax[1]); o.y = cvt2(ax[2], ax[3]); *(LAS v2u*)(XT + (16 * ct + l15) * 72 + 16 * tt + 4 * q) = o; }
    }
    __syncthreads();
    {   const int tt = wave & 3, cp = wave >> 2;
        bf16x8 fT[2];
#pragma unroll
        for (int ks = 0; ks < 2; ++ks) fT[ks] = *(const LAS bf16x8*)(Tb + (16 * tt + l15) * 72 + 32 * ks + 8 * q);
#pragma unroll
        for (int ci = 0; ci < 2; ++ci) { const int ct = 2 * cp + ci;
            f32x4 aw = (f32x4){0.f, 0.f, 0.f, 0.f}, au = aw;
#pragma unroll
            for (int ks = 0; ks < 2; ++ks) { const bf16x8 fa = *(const LAS bf16x8*)(AtT + (16 * ct + l15) * 72 + 32 * ks + 8 * q), fx = *(const LAS bf16x8*)(XT + (16 * ct + l15) * 72 + 32 * ks + 8 * q);
                aw = MFMA16(fT[ks], fa, aw); au = MFMA16(fT[ks], fx, au); }
            v2u o; o.x = cvt2(aw[0], aw[1]); o.y = cvt2(aw[2], aw[3]); *(LAS v2u*)(WtT + (16 * ct + l15) * 72 + 16 * tt + 4 * q) = o;
            o.x = cvt2(au[0], au[1]); o.y = cvt2(au[2], au[3]); *(LAS v2u*)(U0T + (16 * ct + l15) * 72 + 16 * tt + 4 * q) = o; }
    }
    __syncthreads();
    {   const int bt = wave & 3, ap = wave >> 2;
        unsigned char* pq = W.pq + (size_t)item * 16384; unsigned char* rp = W.rp + (size_t)item * 8192; unsigned char* oo = W.oo + (size_t)item * 8192;
        bf16x8 fArb[2], fArk[2], fBh[2], fV[2], fU[2];
#pragma unroll
        for (int ks = 0; ks < 2; ++ks) { fArb[ks] = *(const LAS bf16x8*)(Arb + (16 * bt + l15) * 72 + 32 * ks + 8 * q); fArk[ks] = *(const LAS bf16x8*)(Ark + (16 * bt + l15) * 72 + 32 * ks + 8 * q);
            fBh[ks] = *(const LAS bf16x8*)(BhT + (16 * bt + l15) * 72 + 32 * ks + 8 * q); fV[ks] = *(const LAS bf16x8*)(VT + (16 * bt + l15) * 72 + 32 * ks + 8 * q); fU[ks] = *(const LAS bf16x8*)(U0T + (16 * bt + l15) * 72 + 32 * ks + 8 * q); }
#pragma unroll
        for (int ai = 0; ai < 2; ++ai) { const int at = 2 * ap + ai;
            f32x4 aR = (f32x4){0.f, 0.f, 0.f, 0.f}, aP = aR, aO = aR, aQ = aR;
#pragma unroll
            for (int ks = 0; ks < 2; ++ks) {
                const bf16x8 fW = *(const LAS bf16x8*)(WtT + (16 * at + l15) * 72 + 32 * ks + 8 * q);
                aR = MFMA16(fW, fArb[ks], aR);
                aP = MFMA16(fW, fBh[ks], aP);
                const bf16x8 fk = *(const LAS bf16x8*)(Ark + (16 * at + l15) * 72 + 32 * ks + 8 * q), fb = *(const LAS bf16x8*)(Arb + (16 * at + l15) * 72 + 32 * ks + 8 * q);
                aO = MFMA16(fk, fV[ks], aO); aO = MFMA16(fb, fU[ks], aO);
                const bf16x8 fkh = *(const LAS bf16x8*)(KhT + (16 * at + l15) * 72 + 32 * ks + 8 * q), fbh = *(const LAS bf16x8*)(BhT + (16 * at + l15) * 72 + 32 * ks + 8 * q);
                aQ = MFMA16(fkh, fV[ks], aQ); aQ = MFMA16(fbh, fU[ks], aQ); }
            const int x = 16 * bt + l15, y0 = 16 * at + 4 * q;
            {   const v2u rt = *(const LAS v2u*)(Rt + x * 72 + y0);
                v2u o; o.x = cvt2(aR[0] + bflo(rt.x), aR[1] + bfhi(rt.x)); o.y = cvt2(aR[2] + bflo(rt.y), aR[3] + bfhi(rt.y));
                *(LAS v2u*)(lds + 2 * RSL + ((((x >> 5) * 4 + at) * 64 + (x & 31) + 32 * (q & 1)) * 16 + 8 * (q >> 1))) = o; }
            {   const float dg = eGCs[x]; float p[4];
#pragma unroll
                for (int reg = 0; reg < 4; ++reg) p[reg] = aP[reg] + ((y0 + reg == x) ? dg : 0.f);
                v2u o; o.x = cvt2(p[0], p[1]); o.y = cvt2(p[2], p[3]);
                *(LAS v2u*)(lds + 3 * RSL + ((((x >> 5) * 4 + at) * 64 + (x & 31) + 32 * (q & 1)) * 16 + 8 * (q >> 1))) = o; }
            {   v2u o; o.x = cvt2(aO[0], aO[1]); o.y = cvt2(aO[2], aO[3]); *(LAS v2u*)(lds + 4 * RSL + x * 136 + y0 * 2) = o; }
            {   v2u o; o.x = cvt2(aQ[0], aQ[1]); o.y = cvt2(aQ[2], aQ[3]); *(LAS v2u*)(lds + 8 * RSL + x * 136 + y0 * 2) = o; }
        }
        __syncthreads();
        {
            const v4u c0 = *(const LAS v4u*)(lds + 2 * RSL + tid * 16), c1 = *(const LAS v4u*)(lds + 3 * RSL + tid * 16);
            const LAS unsigned char* s2 = lds + 4 * RSL + (tid >> 3) * 136 + (tid & 7) * 16; const LAS unsigned char* s3 = lds + 8 * RSL + (tid >> 3) * 136 + (tid & 7) * 16;
            const v2u a2 = *(const LAS v2u*)s2, b2 = *(const LAS v2u*)(s2 + 8), a3 = *(const LAS v2u*)s3, b3 = *(const LAS v2u*)(s3 + 8);
            *(GAS v4u*)(rp + tid * 16) = c0; *(GAS v4u*)(pq + tid * 16) = c1;
            *(GAS v4u*)(oo + tid * 16) = (v4u){a2.x, a2.y, b2.x, b2.y}; *(GAS v4u*)(pq + 8192 + tid * 16) = (v4u){a3.x, a3.y, b3.x, b3.y}; }
    }
    __syncthreads();
}

__device__ __forceinline__ void rw_scan(const MixPtrs& P, const RwRec& W, LAS unsigned char* lds, int b, int h, int tid, int lane, int wave) {
    constexpr int SB = 33792;
    const int item0 = b * 128 * 32 + h;
    if (wave < 2) {
        const int e = 32 * wave + (lane & 31), hh = lane >> 5;
        f32x16 H[2];
#pragma unroll
        for (int i = 0; i < 16; ++i) { H[0][i] = 0.f; H[1][i] = 0.f; }
        WG_BAR_LDS();
#pragma unroll 1
        for (int c = 0; c < 128; ++c) {
            LAS unsigned char* buf = lds + (c & 1) * SB;
            bf16x8 Hf[4]; Hf[0] = pack_step(H[0], 0); Hf[1] = pack_step(H[0], 1); Hf[2] = pack_step(H[1], 0); Hf[3] = pack_step(H[1], 1);
#pragma unroll
            for (int mt = 0; mt < 2; ++mt) {
                f32x16 hn, ov;
#pragma unroll
                for (int g = 0; g < 4; ++g) { const v2u qv = *(const LAS v2u*)(buf + 16384 + e * 136 + (32 * mt + 8 * g + 4 * hh) * 2), o0 = *(const LAS v2u*)(buf + 16384 + 8704 + e * 136 + (32 * mt + 8 * g + 4 * hh) * 2);
                    hn[4 * g] = bflo(qv.x); hn[4 * g + 1] = bfhi(qv.x); hn[4 * g + 2] = bflo(qv.y); hn[4 * g + 3] = bfhi(qv.y);
                    ov[4 * g] = bflo(o0.x); ov[4 * g + 1] = bfhi(o0.x); ov[4 * g + 2] = bflo(o0.y); ov[4 * g + 3] = bfhi(o0.y); }
#pragma unroll
                for (int ks = 0; ks < 4; ++ks) { const bf16x8 fp = *(const LAS bf16x8*)(buf + ((mt * 4 + ks) * 64 + lane) * 16), fr = *(const LAS bf16x8*)(buf + 8192 + ((mt * 4 + ks) * 64 + lane) * 16);
                    hn = MFMA32(fp, Hf[ks], hn); ov = MFMA32(fr, Hf[ks], ov); }
#pragma unroll
                for (int g = 0; g < 4; ++g) { v2u o; o.x = cvt2(ov[4 * g], ov[4 * g + 1]); o.y = cvt2(ov[4 * g + 2], ov[4 * g + 3]); *(LAS v2u*)(buf + 16384 + 8704 + e * 136 + (32 * mt + 8 * g + 4 * hh) * 2) = o; }
                if (mt == 0) H[0] = hn; else H[1] = hn;
            }
            WG_BAR_LDS();
        }
        float* Sout = P.out + O_SRW_P + ((size_t)b * 32 + h) * 4096;
#pragma unroll
        for (int mt = 0; mt < 2; ++mt)
#pragma unroll
            for (int g = 0; g < 4; ++g) *(f32x4*)(Sout + e * 64 + 32 * mt + 8 * g + 4 * hh) = (f32x4){H[mt][4 * g], H[mt][4 * g + 1], H[mt][4 * g + 2], H[mt][4 * g + 3]};
    } else {
        const int ht = tid - 128;
        v4u st[6];
#define RW_STAGE_ISSUE(itm) do { const unsigned char* _pq = W.pq + (size_t)(itm) * 16384; const unsigned char* _rp = W.rp + (size_t)(itm) * 8192; const unsigned char* _oo = W.oo + (size_t)(itm) * 8192; \
        _Pragma("unroll") for (int _k = 0; _k < 6; ++_k) { const int _i = ht + 384 * _k; if (_i < 2048) st[_k] = *(const GAS v4u*)(_i < 512 ? _pq + _i * 16 : (_i < 1024 ? _rp + (_i - 512) * 16 : (_i < 1536 ? _pq + 8192 + (_i - 1024) * 16 : _oo + (_i - 1536) * 16))); } } while (0)
#define RW_STAGE_WRITE(dstbuf) do { _Pragma("unroll") for (int _k = 0; _k < 6; ++_k) { const int _i = ht + 384 * _k; if (_i < 1024) *(LAS v4u*)((dstbuf) + _i * 16) = st[_k]; \
            else if (_i < 2048) { const int _j = _i - 1024; LAS unsigned char* _d = (dstbuf) + 16384 + (_j >> 3) * 136 + (_j & 7) * 16; *(LAS v2u*)_d = (v2u){st[_k].x, st[_k].y}; *(LAS v2u*)(_d + 8) = (v2u){st[_k].z, st[_k].w}; } } } while (0)
#define RW_STORE_O(itm, srcbuf) do { unsigned char* _oo = W.oo + (size_t)(itm) * 8192; \
        _Pragma("unroll") for (int _k = 4; _k < 6; ++_k) { const int _i = ht + 384 * _k; if (_i < 2048) { const int _j = _i - 1024; const LAS unsigned char* _s = (srcbuf) + 16384 + (_j >> 3) * 136 + (_j & 7) * 16; \
            const v2u _a = *(const LAS v2u*)_s, _b = *(const LAS v2u*)(_s + 8); *(GAS v4u*)(_oo + (_i - 1536) * 16) = (v4u){_a.x, _a.y, _b.x, _b.y}; } } } while (0)
        RW_STAGE_ISSUE(item0); RW_STAGE_WRITE(lds); RW_STAGE_ISSUE(item0 + 32);
        WG_BAR_LDS();
#pragma unroll 1
        for (int c = 0; c < 128; ++c) {
            if (c > 0) RW_STORE_O(item0 + 32 * (c - 1), lds + ((c - 1) & 1) * SB);
            if (c + 1 < 128) RW_STAGE_WRITE(lds + ((c + 1) & 1) * SB);
            if (c + 2 < 128) RW_STAGE_ISSUE(item0 + 32 * (c + 2));
            WG_BAR_LDS();
        }
        RW_STORE_O(item0 + 32 * 127, lds + SB);
#undef RW_STAGE_ISSUE
#undef RW_STAGE_WRITE
#undef RW_STORE_O
    }
    {   float* shout = P.out + O_SHIFT_P + (size_t)b * RW_SHIFT_W;
        for (int i = tid; i < 206; i += 512) { const int col = h * 206 + i; shout[col] = bf2f(P.proj[(size_t)(b * SEQ + SEQ - 1) * IN_WP + PC_RW + col]); } }
    __syncthreads();
}

__device__ __forceinline__ void rw_gate_item(const MixPtrs& P, const RwRec& W, LAS unsigned char* lds, int b, int c, int qt, int tid, int lane, int wave) {
    const int m0 = b * SEQ + 64 * c; const int l15 = lane & 15, q = lane >> 4;
    LAS bf16* sxg = (LAS bf16*)lds;
#pragma unroll
    for (int r = 0; r < 4; ++r) { const int i = tid + 512 * r; const int t = i >> 5, g8 = i & 31; const int tt = 64 * c + t; const int col = RW_XG + 8 * g8;
        const v4u u = *(const GAS v4u*)(P.proj + (size_t)(m0 + t) * IN_WP + PC_RW + col); v4u up = (v4u){0u, 0u, 0u, 0u}; if (tt > 0) up = *(const GAS v4u*)(P.proj + (size_t)(m0 + t - 1) * IN_WP + PC_RW + col);
        const f32x4 m0v = *(const GAS f32x4*)(P.mu + col), m1v = *(const GAS f32x4*)(P.mu + col + 4);
        float x[8];
        x[0] = bflo(u.x) + m0v.x * (bflo(up.x) - bflo(u.x)); x[1] = bfhi(u.x) + m0v.y * (bfhi(up.x) - bfhi(u.x)); x[2] = bflo(u.y) + m0v.z * (bflo(up.y) - bflo(u.y)); x[3] = bfhi(u.y) + m0v.w * (bfhi(up.y) - bfhi(u.y));
        x[4] = bflo(u.z) + m1v.x * (bflo(up.z) - bflo(u.z)); x[5] = bfhi(u.z) + m1v.y * (bfhi(up.z) - bfhi(u.z)); x[6] = bflo(u.w) + m1v.z * (bflo(up.w) - bflo(u.w)); x[7] = bfhi(u.w) + m1v.w * (bfhi(up.w) - bfhi(u.w));
        v4u o; o.x = cvt2(sigmoid_f(x[0]), sigmoid_f(x[1])); o.y = cvt2(sigmoid_f(x[2]), sigmoid_f(x[3])); o.z = cvt2(sigmoid_f(x[4]), sigmoid_f(x[5])); o.w = cvt2(sigmoid_f(x[6]), sigmoid_f(x[7]));
        *(LAS v4u*)(sxg + t * 264 + 8 * g8) = o; }
    __syncthreads();
    {   const int tt = wave & 3, hf = wave >> 2;
        bf16x8 fx[8];
#pragma unroll
        for (int ks = 0; ks < 8; ++ks) fx[ks] = *(const LAS bf16x8*)(sxg + (16 * tt + l15) * 264 + 32 * ks + 8 * q);
        const int colb = qt * 512 + hf * 256;
#pragma unroll 2
        for (int vt = 0; vt < 16; ++vt) { const bf16* gr = W.g2T + (size_t)(colb + 16 * vt + l15) * 256 + 8 * q;
            bf16x8 fg[8];
#pragma unroll
            for (int ks = 0; ks < 8; ++ks) fg[ks] = *(const GAS bf16x8*)(gr + 32 * ks);
            f32x4 ag = (f32x4){0.f, 0.f, 0.f, 0.f};
#pragma unroll
            for (int ks = 0; ks < 8; ++ks) ag = MFMA16(fg[ks], fx[ks], ag);
            v2u o; o.x = cvt2(ag[0], ag[1]); o.y = cvt2(ag[2], ag[3]);
            *(GAS v2u*)(P.mix + (size_t)(m0 + 16 * tt + l15) * 4096 + 2048 + colb + 16 * vt + 4 * q) = o; }
    }
    __syncthreads();
}
__device__ __forceinline__ void rw_post_task(const MixPtrs& P, const RwRec& W, int item, int tg, int lane) {
    const int h = item & 31, c = (item >> 5) & 127, b = item >> 12; const int m0 = b * SEQ + 64 * c + 8 * tg; const int hc = h * 64 + lane;
    const v4u ov = *(const GAS v4u*)(W.oo + (size_t)item * 8192 + (lane * 64 + tg * 8) * 2);
    float uv[9], gt[8];
#pragma unroll
    for (int i = 0; i < 9; ++i) { const int tt = 64 * c + 8 * tg + i - 1; uv[i] = tt >= 0 ? bf2f(P.proj[(size_t)(b * SEQ + tt) * IN_WP + PC_RW + RW_V + hc]) : 0.f; }
#pragma unroll
    for (int i = 0; i < 8; ++i) gt[i] = bf2f(P.mix[(size_t)(m0 + i) * 4096 + 2048 + hc]);
    const float mv = P.mu[RW_V + hc], lnw = P.ln_w[hc], lnb = P.ln_b[hc];
    const float y[8] = {bflo(ov.x), bfhi(ov.x), bflo(ov.y), bfhi(ov.y), bflo(ov.z), bfhi(ov.z), bflo(ov.w), bfhi(ov.w)};
    float sbs[8];
#pragma unroll
    for (int i = 0; i < 8; ++i) sbs[i] = W.sb[(size_t)item * 64 + tg * 8 + i];
#pragma unroll
    for (int i = 0; i < 8; ++i) { const float vv = uv[i + 1] + mv * (uv[i] - uv[i + 1]);
        const float mean = wave_sum(y[i]) * (1.f / 64.f); const float dy = y[i] - mean; const float var = wave_sum(dy * dy) * (1.f / 64.f);
        const float yn = dy * __builtin_amdgcn_rsqf(var + RW_GN_EPS) * lnw + lnb;
        P.mix[(size_t)(m0 + i) * 4096 + 2048 + hc] = (bf16)(cvt2((yn + sbs[i] * vv) * gt[i], 0.f) & 0xffffu); }
}

constexpr int NPH = 10;
#define MK_N_LAUNCHES 1
#ifndef MK_N_LAUNCHES
#define MK_N_LAUNCHES 1
#endif
#ifndef GP_ALIGN
#define GP_ALIGN false
#endif
#ifndef GP_SP2
#define GP_SP2 true
#endif
#ifndef STAG_US1
#define STAG_US1 0
#endif
#ifndef STAG_US2
#define STAG_US2 0
#endif
#ifndef STAG_US3
#define STAG_US3 0
#endif
#ifndef STAG_US4
#define STAG_US4 0
#endif
#ifndef STAG_MODE
#define STAG_MODE 0
#endif
#define STAGGER(us) do { if ((us) > 0) { const unsigned _g = STAG_MODE ? ((blockIdx.x >> 3) & 7u) : (blockIdx.x & 7u); const unsigned long long _t0 = __builtin_amdgcn_s_memrealtime(), _d = (unsigned long long)(_g * (us) * 100 / 8); \
        while (__builtin_amdgcn_s_memrealtime() - _t0 < _d) __builtin_amdgcn_s_sleep(4); } } while (0)
#ifndef REP_MASK
#define REP_MASK 0
#endif
__global__ void __launch_bounds__(NWAVES * 64, 2) hymba_fwd(Args args) {
    extern __shared__ __attribute__((aligned(16))) unsigned char lds_raw[];
    LAS unsigned char* lds = (LAS unsigned char*)lds_raw;
    volatile LAS unsigned* MISC = (volatile LAS unsigned*)(lds + MISC_OFF);
    const int tid = threadIdx.x, lane = tid & 63, wave = __builtin_amdgcn_readfirstlane(tid >> 6);
    const int G = gridDim.x;
    unsigned char* ws = args.ws;
    gu32* ctl = (gu32*)(ws + WS_CTL);
    for (int u = tid; u < (LDS_BYTES - LDSCTL_OFF) / 4; u += NWAVES * 64) ((LAS unsigned*)(lds + LDSCTL_OFF))[u] = 0u;
    __syncthreads();
    XcdBarrier bar; bar.bar = (unsigned*)(ctl + CW_BAR); bar.x = 0; bar.st = nullptr;
    if (MK_N_LAUNCHES == 1) bar = xcd_barrier_post((unsigned*)(ctl + CW_BAR), MISC + 8);
    const int lo = args.ph_lo, hi = args.ph_hi;
#ifdef ONLY_PHASE
#define IN(k) ((k) == ONLY_PHASE)
#else
#define IN(k) (lo <= (k) && (k) < hi)
#endif
#ifdef PROBE_BAR2
#define SEAM(k) do { if (IN(k) && IN((k) + 1)) { xcd_barrier(bar); xcd_barrier(bar); } } while (0)
#else
#define SEAM(k) do { if (IN(k) && IN((k) + 1)) xcd_barrier(bar); } while (0)
#endif
    float* ssq = (float*)(ws + WS_SSQ);
    bf16* Wt_out = (bf16*)(ws + WS_WOUT); bf16* hbuf = (bf16*)(ws + WS_HBUF); bf16* proj = (bf16*)(ws + WS_PROJ); bf16* act = (bf16*)(ws + WS_PROJ);
    bf16* Wt_in = (bf16*)(ws + WS_WIN); bf16* Wt_gu = (bf16*)(ws + WS_WGU); bf16* Wt_dn = (bf16*)(ws + WS_WDN);
    bf16* w2T = (bf16*)(ws + WS_W2T); bf16* a2T = (bf16*)(ws + WS_A2T); bf16* g2T = (bf16*)(ws + WS_G2T);
    const float* x_prompt = args.in[0]; const float* x_sample = args.in[1];
    const int gw = blockIdx.x * NWAVES + wave, NGW = G * NWAVES;

    if (IN(0)) _Pragma("unroll") for (int _r = 0; _r < 1 + ((REP_MASK >> 0) & 1); ++_r) {
        LAS float* scr = (LAS float*)(lds + RING_OFF + wave * 16384);
        constexpr int I_IN = 64 * (IN_W / 32);
        for (int it = gw; it < I_IN; it += NGW) p0_transpose_item(args.in[8], 4096, IN_W, Wt_in, scr, it, lane, RmId{});
        for (int i = blockIdx.x * 512 + tid; i < 2048 * 448; i += G * 512) {
            if (i < 2048 * 96) { const int c = i / 96, j = i - c * 96; w2T[i] = (bf16)f2bf(args.in[15][j * 2048 + c]); }
            else if (i < 2048 * 192) { const int ii = i - 2048 * 96; const int c = ii / 96, j = ii - c * 96; a2T[ii] = (bf16)f2bf(args.in[17][j * 2048 + c]); }
            else { const int ii = i - 2048 * 192; const int c = ii >> 8, j = ii & 255; g2T[ii] = (bf16)f2bf(args.in[18][j * 2048 + c]); }
        }
        for (int i = blockIdx.x * 512 + tid; i < 32 * 4096 / 8; i += G * 512) ((GAS v4u*)(Wt_in + (size_t)IN_W * 4096))[i] = (v4u){0u, 0u, 0u, 0u};
        for (int m = gw; m < MPAD; m += NGW) {
            bf16* orow = hbuf + (size_t)m * 4096;
            if (m < M_REAL) { const float* xrow = m < M_PROMPT ? x_prompt + (size_t)m * 4096 : x_sample + (size_t)(m - M_PROMPT) * 4096;
                const GAS f32x4* xr = (const GAS f32x4*)xrow + lane; f32x4 v[16];
#pragma unroll
                for (int j = 0; j < 16; ++j) v[j] = xr[64 * j];
                rms_row_to_bf16(v, args.in[6], orow, lane); }
            else { GAS v2u* o8 = (GAS v2u*)orow + lane;
#pragma unroll
                for (int j = 0; j < 16; ++j) o8[64 * j] = (v2u){0u, 0u}; }
        }
    }
    SEAM(0);
    if (IN(1)) _Pragma("unroll") for (int _r = 0; _r < 1 + ((REP_MASK >> 1) & 1); ++_r) {
        pg8::Gemm g{hbuf, Wt_in, MPAD, IN_WP, 4096, 4096, 4096}; pg8::StaticOrder S; S.init(MPAD, IN_WP, G, (int)blockIdx.x);
        pg8::EpiBf16Plain E{proj, IN_WP};
        STAGGER(STAG_US1);
        pg8::gemm_phase<pg8::EpiBf16Plain, pg8::StaticOrder, GP_ALIGN, GP_SP2>(lds + RING_OFF, g, S, E);
    }
#ifdef PROBE_GEMM_RESIDENT
    if (IN(1)) {
        struct ProbeOrder : pg8::StaticOrder { __device__ bool next(int i, pg8::Unit& u) const { if (i >= 15) return false;
#ifdef PROBE_SPREAD
            const int L = i * G + c; u.pm = L & 31; u.pn = (L >> 5) % 58;
#else
            u.pm = c & 7; u.pn = (c >> 3) & 3;
#endif
            u.ko = 0; u.pi = 0; return true; } };
#ifndef PROBE_LD
#define PROBE_LD 4096
#endif
        pg8::Gemm g{hbuf, Wt_in, MPAD, IN_WP, 4096, PROBE_LD, PROBE_LD}; ProbeOrder S; S.init(MPAD, IN_WP, G, (int)blockIdx.x);
#ifdef PROBE_SINK
        pg8::EpiSink E{};
        pg8::gemm_phase<pg8::EpiSink, ProbeOrder, GP_ALIGN, GP_SP2>(lds + RING_OFF, g, S, E);
#elif defined(PROBE_PAIR)
        pg8::EpiPair E{Wt_gu, IN_WP};
        pg8::gemm_phase<pg8::EpiPair, ProbeOrder, GP_ALIGN, GP_SP2>(lds + RING_OFF, g, S, E);
#elif defined(PROBE_ROWS)
        pg8::EpiRows E{Wt_gu, IN_WP};
        pg8::gemm_phase<pg8::EpiRows, ProbeOrder, GP_ALIGN, GP_SP2>(lds + RING_OFF, g, S, E);
#elif defined(PROBE_TILE)
        pg8::EpiTile E{Wt_gu, IN_WP};
        pg8::gemm_phase<pg8::EpiTile, ProbeOrder, GP_ALIGN, GP_SP2>(lds + RING_OFF, g, S, E);
#elif defined(PROBE_CONTIG)
        pg8::EpiContig E{Wt_gu, IN_WP};
        pg8::gemm_phase<pg8::EpiContig, ProbeOrder, GP_ALIGN, GP_SP2>(lds + RING_OFF, g, S, E);
#else
#ifndef PROBE_LDC
#define PROBE_LDC IN_WP
#endif
        pg8::EpiBf16Plain E{Wt_gu, PROBE_LDC};
        pg8::gemm_phase<pg8::EpiBf16Plain, ProbeOrder, GP_ALIGN, GP_SP2>(lds + RING_OFF, g, S, E);
#endif
    }
#endif
    SEAM(1);
    MixPtrs P; P.proj = proj; P.mix = hbuf; P.state_dn = args.in[2]; P.cache_conv = args.in[3]; P.state_rw = args.in[4]; P.cache_shift = args.in[5];
    P.conv_w = args.in[9]; P.a_log = args.in[10]; P.dt_bias = args.in[11]; P.dn_norm_w = args.in[12];
    P.mu = args.in[13]; P.w0 = args.in[14]; P.w2 = args.in[15]; P.a0 = args.in[16]; P.a2 = args.in[17]; P.g2 = args.in[18]; P.k_k = args.in[19]; P.k_a = args.in[20]; P.r_k = args.in[21];
    P.ln_w = args.in[22]; P.ln_b = args.in[23]; P.out = args.out;
    DnRec R; R.rec = (unsigned char*)args.out; R.qk = ws + WS_DNQK; R.gl = (float*)(ws + WS_DNGL);
    RwRec W; W.pq = ws + WS_RWPQ; W.rp = ws + WS_RWRP; W.oo = ws + WS_RWOO; W.sb = (float*)(ws + WS_RWSB); W.w2T = w2T; W.a2T = a2T; W.g2T = g2T;
    if (IN(2)) _Pragma("unroll") for (int _r = 0; _r < 1 + ((REP_MASK >> 2) & 1); ++_r) {
#ifndef REP_DNP
#define REP_DNP 0
#endif
#ifndef REP_RWP
#define REP_RWP 0
#endif
        for (int _q = 0; _q <= REP_DNP; ++_q)
        { int cwh = -1;
        for (int it = blockIdx.x; it < 4096; it += G) { if ((it & 15) != cwh) { cwh = it & 15; dn_stage_conv(P, lds + RING_OFF, cwh, tid); }
            dn_prep_item(P, R, lds + RING_OFF, it >> 11, (it >> 4) & 127, it & 15, tid, lane, wave); } }
        for (int _q = 0; _q <= REP_RWP; ++_q) {
            RwRaw raw; { const int it = blockIdx.x; rw_prep_issue(P, raw, it >> 12, (it >> 5) & 127, it & 31, tid, lane, wave); }
            int rch = blockIdx.x & 31; rw_stage_consts(P, W, lds + RING_OFF, rch, tid);
            for (int it = blockIdx.x; it < 8192; it += G) { const int nx = it + G; const bool hn = nx < 8192;
                if ((G & 31) != 0 && (it & 31) != rch) { rch = it & 31; rw_stage_consts(P, W, lds + RING_OFF, rch, tid); }
#ifdef PROBE_FRONT
                rw_prep_item<true>(P, W, lds + RING_OFF, it >> 12, (it >> 5) & 127, it & 31, raw, hn ? (nx >> 12) : -1, (nx >> 5) & 127, nx & 31, tid, lane, wave);
#endif
                rw_prep_item(P, W, lds + RING_OFF, it >> 12, (it >> 5) & 127, it & 31, raw, hn ? (nx >> 12) : -1, (nx >> 5) & 127, nx & 31, tid, lane, wave); }
        }
    }
    SEAM(2);
    if (IN(3)) _Pragma("unroll") for (int _r = 0; _r < 1 + ((REP_MASK >> 3) & 1); ++_r) {
        const int wg = blockIdx.x;
#ifndef REP_DNSCAN
#define REP_DNSCAN 0
#endif
#ifndef REP_SAMPLES
#define REP_SAMPLES 0
#endif
        if (wg < 32) { _Pragma("unroll 1") for (int _q = 0; _q <= REP_DNSCAN; ++_q) dn_scan(P, R, lds + RING_OFF, wg >> 4, wg & 15, tid, lane, wave); }
        else if (wg < 96) rw_scan(P, W, lds + RING_OFF, (wg - 32) >> 5, (wg - 32) & 31, tid, lane, wave);
        else {
            _Pragma("unroll 1") for (int _q = 0; _q <= REP_SAMPLES; ++_q)
            for (int it = wg - 96; it < 384; it += G - 96) {
                if (it < 128) dn_seq_item(P, lds + RING_OFF, 2 + (it >> 4), it & 15, tid, lane, wave);
                else rw_seq_item(P, w2T, a2T, g2T, lds + RING_OFF, 2 + ((it - 128) >> 5), (it - 128) & 31, tid, lane, wave);
            }
        }
#ifndef PARK_FROM
#define PARK_FROM 32
#endif
        if (wg >= PARK_FROM) {
            const int pw = wg - PARK_FROM, npw = G - PARK_FROM;
#ifdef PROBE_PARK2
            _Pragma("unroll 1") for (int _pk = 0; _pk < 2; ++_pk) {
#else
            {
#endif
#ifdef PROBE_GATE2
            _Pragma("unroll 1") for (int _g2 = 0; _g2 < 2; ++_g2)
#endif
            for (int it = pw; it < 1024; it += npw) rw_gate_item(P, W, lds + RING_OFF, it >> 9, (it >> 2) & 127, it & 3, tid, lane, wave);
            LAS float* scr = (LAS float*)(lds + RING_OFF + wave * 16384);
            for (int it = pw * NWAVES + wave; it < 64 * 128; it += npw * NWAVES) p0_transpose_item(args.in[24], 4096, 4096, Wt_out, scr, it, lane, RmId{});
            for (int it = pw * NWAVES + wave; it < (D_FF / 64) * 98; it += npw * NWAVES) { const int kb = it / 98, nb = 30 + it % 98; p0_transpose_item(args.in[29], D_FF, 4096, Wt_dn, scr, kb * 128 + nb, lane, RmId{}); }
            __syncthreads();
            }
        }
    }
    SEAM(3);
    if (IN(4)) _Pragma("unroll") for (int _r = 0; _r < 1 + ((REP_MASK >> 4) & 1); ++_r) {
        LAS float* scr = (LAS float*)(lds + RING_OFF + wave * 16384);
        constexpr int I_G = 64 * (D_FF / 32), I_D = (D_FF / 64) * 30;
        int task = gw, it = gw;
        _Pragma("unroll 1") while (task < 8192 * 8 || it < 2 * I_G + I_D) {
            if (task < 8192 * 8) { rw_post_task(P, W, task >> 3, task & 7, lane); task += NGW; }
            if (it < 2 * I_G + I_D) {
                if (it < I_G) p0_transpose_item(args.in[27], 4096, D_FF, Wt_gu, scr, it, lane, RmGU{0});
                else if (it < 2 * I_G) p0_transpose_item(args.in[28], 4096, D_FF, Wt_gu, scr, it - I_G, lane, RmGU{1});
                else { const int r = it - 2 * I_G; const int kb = r / 30, nb = r % 30; p0_transpose_item(args.in[29], D_FF, 4096, Wt_dn, scr, kb * 128 + nb, lane, RmId{}); }
                it += NGW; }
        }
        __syncthreads();
    }
    SEAM(4);
    if (IN(5)) _Pragma("unroll") for (int _r = 0; _r < 1 + ((REP_MASK >> 5) & 1); ++_r) {
#ifdef OLD_TAILS
        { pg8::Gemm g{hbuf, Wt_out, MPAD, 4096, 4096, 4096, 4096}; pg8::StaticOrder S; S.init(MPAD, 4096, G, (int)blockIdx.x);
        pg8::EpiF32Ssq E{args.out + O_Y, 4096, ssq, M_REAL};
        pg8::gemm_phase<pg8::EpiF32Ssq, pg8::StaticOrder, GP_ALIGN, GP_SP2>(lds + RING_OFF, g, S, E); }
#else
        pg8::Gemm g{hbuf, Wt_out, M_PROMPT, 4096, 4096, 4096, 4096}; pg8::StaticOrder S; S.init(M_PROMPT, 4096, G, (int)blockIdx.x);
        pg8::EpiBf16Ssq E{proj, 4096, ssq};
        STAGGER(STAG_US2);
        pg8::gemm_phase<pg8::EpiBf16Ssq, pg8::StaticOrder, GP_ALIGN, GP_SP2>(lds + RING_OFF, g, S, E);
        pg8::Gemm gt{hbuf, Wt_out, MPAD, 4096, 256, 4096, 4096}; pg8::TailOrder St{16 * 16, G, (int)blockIdx.x, 0, 256, 0};
        pg8::EpiF32Part Et{(float*)(ws + WS_PART2), 4096};
        pg8::gemm_phase<pg8::EpiF32Part, pg8::TailOrder, GP_ALIGN, GP_SP2>(lds + RING_OFF, gt, St, Et);
#endif
    }
    SEAM(5);
    if (IN(6)) _Pragma("unroll") for (int _r = 0; _r < 1 + ((REP_MASK >> 6) & 1); ++_r) {
        for (int m = gw; m < M_REAL; m += NGW) {
            const float* xrow = m < M_PROMPT ? x_prompt + (size_t)m * 4096 : x_sample + (size_t)(m - M_PROMPT) * 4096;
            const GAS f32x4* xr = (const GAS f32x4*)xrow + lane; GAS f32x4* tr = (GAS f32x4*)(args.out + O_Y + (size_t)m * 4096) + lane; const GAS f32x4* gr = (const GAS f32x4*)args.in[7] + lane;
            f32x4 v[16]; float s = 0.f;
#ifdef OLD_TAILS
            const bool smp = false;
#else
            const bool smp = m >= M_PROMPT;
#endif
            if (smp) {
                const GAS f32x4* pp = (const GAS f32x4*)(ws + WS_PART2) + (size_t)(m - M_PROMPT) * 1024 + lane;
#pragma unroll
                for (int j = 0; j < 16; ++j) { f32x4 t[16];
#pragma unroll
                    for (int sp = 0; sp < 16; ++sp) t[sp] = pp[(size_t)sp * 128 * 1024 + 64 * j];
                    const f32x4 a = ((t[0] + t[1]) + (t[2] + t[3])) + ((t[4] + t[5]) + (t[6] + t[7])) + (((t[8] + t[9]) + (t[10] + t[11])) + ((t[12] + t[13]) + (t[14] + t[15])));
                    v[j] = a; s += (a.x * a.x + a.y * a.y) + (a.z * a.z + a.w * a.w); }
            } else {
                const GAS v2u* tb = (const GAS v2u*)(proj + (size_t)m * 4096) + lane; v2u tv[16];
#pragma unroll
                for (int j = 0; j < 16; ++j) tv[j] = tb[64 * j];
#pragma unroll
                for (int j = 0; j < 16; ++j) { v[j].x = bflo(tv[j].x); v[j].y = bfhi(tv[j].x); v[j].z = bflo(tv[j].y); v[j].w = bfhi(tv[j].y); }
                s = ssq[(size_t)m * 64 + lane];
            }
            s = wave_sum(s);
            const float rstd = 1.0f / sqrtf(s * (1.f / 4096.f) + NORM_EPS);
#pragma unroll
            for (int hh = 0; hh < 2; ++hh) { f32x4 xv[8], gv[8];
#pragma unroll
                for (int j = 0; j < 8; ++j) { xv[j] = xr[64 * (8 * hh + j)]; gv[j] = gr[64 * (8 * hh + j)]; }
#pragma unroll
                for (int j = 0; j < 8; ++j) { const f32x4 x1 = xv[j] + v[8 * hh + j] * rstd * gv[j]; v[8 * hh + j] = x1;
                    if (smp) tr[64 * (8 * hh + j)] = x1;
                    else { v2u o; o.x = cvt2(x1.x, x1.y); o.y = cvt2(x1.z, x1.w); ((GAS v2u*)(ws + WS_X1B) + (size_t)m * 1024 + lane)[64 * (8 * hh + j)] = o; } } }
            rms_row_to_bf16(v, args.in[25], hbuf + (size_t)m * 4096, lane);
        }
    }
    SEAM(6);
    if (IN(7)) _Pragma("unroll") for (int _r = 0; _r < 1 + ((REP_MASK >> 7) & 1); ++_r) {
        pg8::Gemm g{hbuf, Wt_gu, MPAD, 2 * D_FF, 4096, 4096, 4096}; pg8::StaticOrder S; S.init(MPAD, 2 * D_FF, G, (int)blockIdx.x);
        pg8::EpiSwiGLU E{act, D_FF};
        STAGGER(STAG_US3);
        pg8::gemm_phase<pg8::EpiSwiGLU, pg8::StaticOrder, GP_ALIGN, GP_SP2>(lds + RING_OFF, g, S, E);
    }
    SEAM(7);
    if (IN(8)) _Pragma("unroll") for (int _r = 0; _r < 1 + ((REP_MASK >> 8) & 1); ++_r) {
#ifdef OLD_TAILS
        { pg8::Gemm g{act, Wt_dn, MPAD, 4096, D_FF, D_FF, D_FF}; pg8::StaticOrder S; S.init(MPAD, 4096, G, (int)blockIdx.x);
        pg8::EpiBf16Ssq E{hbuf, 4096, ssq};
        pg8::gemm_phase<pg8::EpiBf16Ssq, pg8::StaticOrder, GP_ALIGN, GP_SP2>(lds + RING_OFF, g, S, E); }
#else
        pg8::Gemm g{act, Wt_dn, M_PROMPT, 4096, D_FF, D_FF, D_FF}; pg8::StaticOrder S; S.init(M_PROMPT, 4096, G, (int)blockIdx.x);
        pg8::EpiBf16Ssq E{hbuf, 4096, ssq};
        STAGGER(STAG_US4);
        pg8::gemm_phase<pg8::EpiBf16Ssq, pg8::StaticOrder, GP_ALIGN, GP_SP2>(lds + RING_OFF, g, S, E);
#ifdef REP_G4MAIN
        pg8::gemm_phase<pg8::EpiBf16Ssq, pg8::StaticOrder, GP_ALIGN, GP_SP2>(lds + RING_OFF, g, S, E);
#endif
        pg8::EpiF32Part Et{(float*)(ws + WS_PART4), 4096};
        pg8::Gemm ga{act, Wt_dn, MPAD, 4096, 768, D_FF, D_FF}; pg8::TailOrder Sa{16 * 6, G, (int)blockIdx.x - 160, 0, 768, 0};
        pg8::gemm_phase<pg8::EpiF32Part, pg8::TailOrder, GP_ALIGN, GP_SP2>(lds + RING_OFF, ga, Sa, Et);
        pg8::Gemm gb{act, Wt_dn, MPAD, 4096, 640, D_FF, D_FF}; pg8::TailOrder Sb{16 * 10, G, (int)blockIdx.x < 160 ? (int)blockIdx.x : -1, 4608, 640, 6};
        pg8::gemm_phase<pg8::EpiF32Part, pg8::TailOrder, GP_ALIGN, GP_SP2>(lds + RING_OFF, gb, Sb, Et);
#ifdef REP_G4TAIL
        pg8::gemm_phase<pg8::EpiF32Part, pg8::TailOrder, GP_ALIGN, GP_SP2>(lds + RING_OFF, ga, Sa, Et);
        pg8::gemm_phase<pg8::EpiF32Part, pg8::TailOrder, GP_ALIGN, GP_SP2>(lds + RING_OFF, gb, Sb, Et);
#endif
#endif
    }
    SEAM(8);
    if (IN(9)) _Pragma("unroll") for (int _r = 0; _r < 1 + ((REP_MASK >> 9) & 1); ++_r) {
        for (int m = gw; m < M_REAL; m += NGW) {
            GAS f32x4* orow = (GAS f32x4*)(args.out + O_Y + (size_t)m * 4096) + lane; const GAS v2u* fr = (const GAS v2u*)(hbuf + (size_t)m * 4096) + lane; const GAS f32x4* gr = (const GAS f32x4*)args.in[26] + lane;
            f32x4 f[16]; float s = 0.f;
#ifdef OLD_TAILS
            const bool smp = false;
#else
            const bool smp = m >= M_PROMPT;
#endif
            if (smp) { const GAS f32x4* fs = (const GAS f32x4*)(ws + WS_PART4) + (size_t)(m - M_PROMPT) * 1024 + lane;
#pragma unroll
                for (int j = 0; j < 16; ++j) { f32x4 t[16];
#pragma unroll
                    for (int sp = 0; sp < 16; ++sp) t[sp] = fs[(size_t)sp * 128 * 1024 + 64 * j];
                    const f32x4 a = ((t[0] + t[1]) + (t[2] + t[3])) + ((t[4] + t[5]) + (t[6] + t[7])) + (((t[8] + t[9]) + (t[10] + t[11])) + ((t[12] + t[13]) + (t[14] + t[15])));
                    f[j] = a; s += (a.x * a.x + a.y * a.y) + (a.z * a.z + a.w * a.w); }
            } else {
                v2u fv[16];
#pragma unroll
                for (int j = 0; j < 16; ++j) fv[j] = fr[64 * j];
                s = ssq[(size_t)m * 64 + lane];
#pragma unroll
                for (int j = 0; j < 16; ++j) { f[j].x = __builtin_bit_cast(float, fv[j].x << 16); f[j].y = __builtin_bit_cast(float, fv[j].x & 0xffff0000u); f[j].z = __builtin_bit_cast(float, fv[j].y << 16); f[j].w = __builtin_bit_cast(float, fv[j].y & 0xffff0000u); }
            }
            s = wave_sum(s);
            const float rstd = 1.0f / sqrtf(s * (1.f / 4096.f) + NORM_EPS);
            const GAS v2u* xb = (const GAS v2u*)(ws + WS_X1B) + (size_t)m * 1024 + lane;
#pragma unroll
            for (int hh = 0; hh < 2; ++hh) { f32x4 xv[8], gv[8];
                if (smp) {
#pragma unroll
                    for (int j = 0; j < 8; ++j) { xv[j] = orow[64 * (8 * hh + j)]; gv[j] = gr[64 * (8 * hh + j)]; }
                } else { v2u xq[8];
#pragma unroll
                    for (int j = 0; j < 8; ++j) { xq[j] = xb[64 * (8 * hh + j)]; gv[j] = gr[64 * (8 * hh + j)]; }
#pragma unroll
                    for (int j = 0; j < 8; ++j) { xv[j].x = bflo(xq[j].x); xv[j].y = bfhi(xq[j].x); xv[j].z = bflo(xq[j].y); xv[j].w = bfhi(xq[j].y); } }
#pragma unroll
                for (int j = 0; j < 8; ++j) orow[64 * (8 * hh + j)] = xv[j] + f[8 * hh + j] * rstd * gv[j]; }
        }
    }
#undef IN
#undef SEAM
}

extern "C" void kernel_launch(void* const* d_in, const int* in_sizes, int n_in, void* d_out, int out_size, void* d_ws, size_t ws_size, hipStream_t stream) {
    static int grid = 0;
    if (grid == 0) {
        if (n_in != 30 || out_size != (int)O_END || ws_size < WS_END) { fprintf(stderr, "kernel_launch: unexpected shapes (n_in %d out %d ws %zu)\n", n_in, out_size, ws_size); grid = -1; return; }
        int dev = 0, cus = 0, per_cu = 0;
        if (hipGetDevice(&dev) != hipSuccess || hipDeviceGetAttribute(&cus, hipDeviceAttributeMultiprocessorCount, dev) != hipSuccess) { grid = -1; return; }
        if (hipFuncSetAttribute((const void*)hymba_fwd, hipFuncAttributeMaxDynamicSharedMemorySize, LDS_BYTES) != hipSuccess) { grid = -1; return; }
        if (hipOccupancyMaxActiveBlocksPerMultiprocessor(&per_cu, (const void*)hymba_fwd, NWAVES * 64, LDS_BYTES) != hipSuccess || per_cu < 1) { fprintf(stderr, "kernel_launch: occupancy query says %d\n", per_cu); }
        (void)hipGetLastError();
        grid = cus;
    }
    if (grid < 0) return;
    if (hipMemsetAsync((char*)d_ws + WS_CTL, 0, CTL_ZERO_BYTES, stream) != hipSuccess) return;
    Args a{};
    for (int i = 0; i < 30; ++i) a.in[i] = (const float*)d_in[i];
    a.out = (float*)d_out; a.ws = (unsigned char*)d_ws;
    if (MK_N_LAUNCHES == 1) { a.ph_lo = 0; a.ph_hi = NPH; hipLaunchKernelGGL(hymba_fwd, dim3(grid), dim3(NWAVES * 64), LDS_BYTES, stream, a); }
    else for (int p = 0; p < NPH; ++p) { a.ph_lo = p; a.ph_hi = p + 1; hipLaunchKernelGGL(hymba_fwd, dim3(grid), dim3(NWAVES * 64), LDS_BYTES, stream, a); }
}
```
